# Optimizing an MI355X kernel written in HIP

```python
import jax, jax.numpy as jnp
from jax import lax
import numpy as np

D_MODEL = 1024
BATCH = 8
SEQ = 2048
DEPTH = 4
DEC_BATCH = 128
DEC_SEQ = 1
PAST_LEN = 16384
PAGE_SIZE = 128

N_META = 16
N_EVEN = (DEPTH + 1) // 2
N_ODD = DEPTH // 2
H_A = 4
DK_A = 128
DV_A = 256
RET_CHUNK = 128
ROPE_BASE = 10000.0
W_B = 1024
NB_B = 8
BS_B = W_B // NB_B
CONV_B = 4
LRU_C = 8.0
HS_C = 64
H_C = D_MODEL // HS_C
LORA_W = 64
LORA_A = 64
LORA_V = 32
LORA_G = 128
GN_EPS_C = 64e-5
D_FF = 2816
CONV_F = 3
EPS = 1e-6
IN_WIDTH = 2 * H_A * DK_A + 2 * H_A * DV_A + 2 * W_B
MIX_WIDTH = H_A * DV_A + W_B

kernel_name = 'hybrid_retention_rglru_rwkv7_convffn_step'


def rms_norm(x, g):
    xf = x.astype(jnp.float32)
    y = xf * lax.rsqrt(jnp.mean(xf * xf, axis=-1, keepdims=True) + EPS)
    return (y * g.astype(jnp.float32)).astype(x.dtype)


def causal_dwconv(x, buf, w, b):
    K = w.shape[0]
    T = x.shape[1]
    xc = jnp.concatenate([buf.astype(x.dtype), x], axis=1)
    y = b + sum(w[j] * xc[:, j:j + T] for j in range(K))
    return y, xc[:, T:]


def rotary(x, pos):
    half = x.shape[-1] // 2
    inv = ROPE_BASE ** (-jnp.linspace(0.0, 1.0, half, dtype=jnp.float32))
    ang = pos.astype(jnp.float32)[:, None] * inv[None, :]
    cos = jnp.cos(ang)[None, :, None, :]
    sin = jnp.sin(ang)[None, :, None, :]
    x1, x2 = x[..., :half], x[..., half:]
    return jnp.concatenate([x1 * cos - x2 * sin, x1 * sin + x2 * cos], axis=-1)


def retention_chunk(S, qkv, log_g):
    q, k, v = qkv
    C = q.shape[1]
    idx = jnp.arange(C, dtype=jnp.float32)
    diff = idx[:, None] - idx[None, :]
    mask = jnp.where(diff >= 0, jnp.exp(log_g[:, None, None] * jnp.maximum(diff, 0.0)[None]), 0.0)
    scores = jnp.einsum('bchd,bshd->bhcs', q, k) * mask[None]
    o = jnp.einsum('bhcs,bshe->bche', scores, v)
    dec_in = jnp.exp((idx[:, None] + 1.0) * log_g[None, :])
    o = o + jnp.einsum('bchd,bhde->bche', q, S) * dec_in[None, :, :, None]
    dec_k = jnp.exp((C - 1.0 - idx)[:, None] * log_g[None, :])
    S_new = jnp.exp(C * log_g)[None, :, None, None] * S + jnp.einsum('bshd,bshe->bhde', k * dec_k[None, :, :, None], v)
    return S_new, o


def retention_seq(q, k, v, S0, log_g, lead):
    outs = []
    S = S0
    if lead > 0:
        S, o = retention_chunk(S, (q[:, :lead], k[:, :lead], v[:, :lead]), log_g)
        outs.append(o)
    q, k, v = q[:, lead:], k[:, lead:], v[:, lead:]
    B, T = q.shape[0], q.shape[1]
    C = RET_CHUNK if T % RET_CHUNK == 0 else T
    N = T // C
    split = lambda t: jnp.moveaxis(t.reshape((B, N, C) + t.shape[2:]), 1, 0)
    S, o = lax.scan(lambda s, c: retention_chunk(s, c, log_g), S, (split(q), split(k), split(v)))
    outs.append(jnp.moveaxis(o, 0, 1).reshape(B, T, H_A, DV_A))
    return jnp.concatenate(outs, axis=1), S


def linear_combine(left, right):
    a1, b1 = left
    a2, b2 = right
    return a1 * a2, a2 * b1 + b2


def retention_lru_mixer(h, pos, lead, s_ret, s_lru, s_conv, p):
    B, T, _ = h.shape
    f32 = jnp.float32
    qk, vg = H_A * DK_A, H_A * DV_A
    z = h @ p['w_in']
    q, k, v, g_a, x_b, g_b = jnp.split(z, [qk, 2 * qk, 2 * qk + vg, 2 * qk + 2 * vg, 2 * qk + 2 * vg + W_B], axis=-1)
    log_g = jnp.log1p(-jnp.exp2(-5.0 - jnp.arange(H_A, dtype=f32)))
    q = rotary(q.reshape(B, T, H_A, DK_A).astype(f32), pos)
    k = rotary(k.reshape(B, T, H_A, DK_A).astype(f32), pos) * (DK_A ** -0.5)
    v = v.reshape(B, T, H_A, DV_A).astype(f32)
    o, s_ret_new = retention_seq(q, k, v, s_ret.astype(f32), log_g, lead)
    mu = jnp.mean(o, axis=-1, keepdims=True)
    var = jnp.mean(jnp.square(o - mu), axis=-1, keepdims=True)
    o = ((o - mu) * lax.rsqrt(var + EPS)).reshape(B, T, vg) * p['ret_gn'].astype(f32)
    y_a = jax.nn.silu(g_a.astype(f32)) * o
    xc, s_conv_new = causal_dwconv(x_b, s_conv, p['conv_w'], p['conv_b'])
    xg = xc.reshape(B, T, NB_B, BS_B)
    r = jax.nn.sigmoid((jnp.einsum('btgc,gcd->btgd', xg, p['wa']).reshape(B, T, W_B) + p['ba']).astype(f32))
    i = jax.nn.sigmoid((jnp.einsum('btgc,gcd->btgd', xg, p['wx']).reshape(B, T, W_B) + p['bx']).astype(f32))
    log_a = -LRU_C * r * jax.nn.softplus(-p['lam'].astype(f32))
    a = jnp.exp(log_a)
    u = jnp.sqrt(-jnp.expm1(2.0 * log_a)) * (i * xc.astype(f32))
    u = u.at[:, 0].add(a[:, 0] * s_lru.astype(f32))
    _, hs = lax.associative_scan(linear_combine, (a, u), axis=1)
    y_b = hs * jax.nn.gelu(g_b.astype(f32))
    out = jnp.concatenate([y_a, y_b], axis=-1).astype(h.dtype) @ p['w_out']
    return out, s_ret_new, hs[:, -1], s_conv_new


def rwkv7_step(S, inp):
    r_t, w_t, k_t, v_t, a_t, b_t = inp
    sa = jnp.einsum('bhij,bhj->bhi', S, a_t)
    S = S * w_t[:, :, None, :] + sa[..., None] * b_t[:, :, None, :] + v_t[..., None] * k_t[:, :, None, :]
    y = jnp.einsum('bhij,bhj->bhi', S, r_t)
    return S, y


def rwkv7_mixer(h, s0, shift0, v_first, p, vp):
    B, T, D = h.shape
    f32 = jnp.float32
    hprev = jnp.concatenate([shift0.astype(h.dtype)[:, None], h[:, :-1]], axis=1)
    xx = hprev - h
    xr, xw, xk, xv, xa, xg = (h + xx * p['mix'][n] for n in range(6))
    r = xr @ p['w_r']
    k = xk @ p['w_k']
    v = xv @ p['w_v']
    w_log = -jax.nn.softplus(-(p['w0'] + jnp.tanh(xw @ p['w1']) @ p['w2']).astype(f32)) - 0.5
    decay = jnp.exp(-jnp.exp(w_log))
    if vp is None:
        v_first = v
    else:
        v = v + (v_first - v) * jax.nn.sigmoid(vp['v0'] + (xv @ vp['v1']) @ vp['v2'])
    a = jax.nn.sigmoid(p['a0'] + (xa @ p['a1']) @ p['a2'])
    g = jax.nn.sigmoid(xg @ p['g1']) @ p['g2']
    heads = lambda t: t.reshape(B, T, H_C, HS_C).astype(f32)
    kk = heads(k * p['k_k'])
    kk = kk * lax.rsqrt(jnp.maximum(jnp.sum(kk * kk, axis=-1, keepdims=True), 1e-24))
    k = k * (1 + (a - 1) * p['k_a'])
    rh, kh, vh, ah = heads(r), heads(k), heads(v), heads(a)
    wh = decay.reshape(B, T, H_C, HS_C)
    tm = lambda t: jnp.moveaxis(t, 1, 0)
    s_new, ys = lax.scan(rwkv7_step, s0.astype(f32), (tm(rh), tm(wh), tm(kh), tm(vh), tm(-kk), tm(kk * ah)))
    ys = jnp.moveaxis(ys, 0, 1)
    mu = jnp.mean(ys, axis=-1, keepdims=True)
    var = jnp.mean(jnp.square(ys - mu), axis=-1, keepdims=True)
    o = ((ys - mu) * lax.rsqrt(var + GN_EPS_C)).reshape(B, T, D) * p['gn_g'].astype(f32) + p['gn_b'].astype(f32)
    bonus = jnp.sum(rh * kh * p['r_k'].astype(f32), axis=-1, keepdims=True) * vh
    o = (o + bonus.reshape(B, T, D)) * g.astype(f32)
    return o.astype(h.dtype) @ p['w_o'], s_new, h[:, -1], v_first


def conv_ffn(h, buf, p):
    u = h @ p['w_up']
    ug, uv = u[..., :D_FF], u[..., D_FF:]
    c, buf_new = causal_dwconv(ug, buf, p['conv_w'], p['conv_b'])
    return (jax.nn.gelu(c) * uv) @ p['w_down'], buf_new


def trunk(x, pos, lead, states, weights):
    st_ret, st_lru, st_lconv, st_rwkv, st_shift, st_ffn = states
    ev, od, vps, ff, norm_mix_g, norm_ffn_g, norm_final_g = weights
    n_ret, n_lru, n_lconv, n_rwkv, n_shift, n_ffn = [], [], [], [], [], []
    v_first = None
    for li in range(DEPTH):
        j = li // 2
        h = rms_norm(x, norm_mix_g[li])
        if li % 2 == 0:
            mix, s_ret, s_lru, s_lconv = retention_lru_mixer(h, pos, lead, st_ret[j], st_lru[j], st_lconv[j], ev[j])
            n_ret.append(s_ret)
            n_lru.append(s_lru)
            n_lconv.append(s_lconv)
        else:
            mix, s_rwkv, s_shift, v_first = rwkv7_mixer(h, st_rwkv[j], st_shift[j], v_first, od[j], vps[j])
            n_rwkv.append(s_rwkv)
            n_shift.append(s_shift)
        x = x + mix
        f, s_ffn = conv_ffn(rms_norm(x, norm_ffn_g[li]), st_ffn[li], ff[li])
        x = x + f
        n_ffn.append(s_ffn)
    stack = lambda lst, ref: jnp.stack(lst).astype(ref.dtype)
    return (rms_norm(x, norm_final_g), stack(n_ret, st_ret), stack(n_lru, st_lru), stack(n_lconv, st_lconv),
            stack(n_rwkv, st_rwkv), stack(n_shift, st_shift), stack(n_ffn, st_ffn))


def setup_inputs(seed: int = 0) -> dict:
    key = jax.random.key(seed)
    keys = iter(jax.random.split(key, 96))
    f32 = jnp.float32
    D = D_MODEL

    def nrm(shape, scale=1.0):
        return jax.random.normal(next(keys), shape, f32) * scale

    def unif(shape, lo, hi):
        return jax.random.uniform(next(keys), shape, f32, lo, hi)

    lam_a = unif((N_EVEN, W_B), 0.9, 0.999)
    return {
        'x_prompt': nrm((BATCH, SEQ, D)),
        'x_sample': nrm((DEC_BATCH, DEC_SEQ, D)),
        'state_ret': nrm((N_EVEN, DEC_BATCH, H_A, DK_A, DV_A), 0.1),
        'state_lru': nrm((N_EVEN, DEC_BATCH, W_B), 0.5),
        'state_lru_conv': nrm((N_EVEN, DEC_BATCH, CONV_B - 1, W_B)),
        'state_rwkv': nrm((N_ODD, DEC_BATCH, H_C, HS_C, HS_C), 0.1),
        'state_shift': nrm((N_ODD, DEC_BATCH, D)),
        'state_ffn_conv': nrm((DEPTH, DEC_BATCH, CONV_F - 1, D_FF)),
        'meta_tokens': nrm((N_META, D)),
        'norm_mix_g': 1.0 + nrm((DEPTH, D), 0.02),
        'norm_ffn_g': 1.0 + nrm((DEPTH, D), 0.02),
        'norm_final_g': 1.0 + nrm((D,), 0.02),
        'ev_w_in': nrm((N_EVEN, D, IN_WIDTH), D ** -0.5),
        'ev_ret_gn_g': 1.0 + nrm((N_EVEN, H_A * DV_A), 0.02),
        'ev_lru_conv_w': nrm((N_EVEN, CONV_B, W_B), CONV_B ** -0.5),
        'ev_lru_conv_b': nrm((N_EVEN, W_B), 0.01),
        'ev_lru_wa': nrm((N_EVEN, NB_B, BS_B, BS_B), BS_B ** -0.5),
        'ev_lru_ba': nrm((N_EVEN, W_B), 0.01),
        'ev_lru_wx': nrm((N_EVEN, NB_B, BS_B, BS_B), BS_B ** -0.5),
        'ev_lru_bx': nrm((N_EVEN, W_B), 0.01),
        'ev_lru_lambda': jnp.log(lam_a) - jnp.log1p(-lam_a),
        'ev_w_out': nrm((N_EVEN, MIX_WIDTH, D), MIX_WIDTH ** -0.5),
        'od_mix': unif((N_ODD, 6, D), 0.0, 1.0),
        'od_w_r': nrm((N_ODD, D, D), D ** -0.5),
        'od_w_k': nrm((N_ODD, D, D), D ** -0.5),
        'od_w_v': nrm((N_ODD, D, D), D ** -0.5),
        'od_w0': unif((N_ODD, D), -6.0, 1.0),
        'od_w1': nrm((N_ODD, D, LORA_W), D ** -0.5),
        'od_w2': nrm((N_ODD, LORA_W, D), 0.1 * LORA_W ** -0.5),
        'od_a0': nrm((N_ODD, D), 0.1),
        'od_a1': nrm((N_ODD, D, LORA_A), D ** -0.5),
        'od_a2': nrm((N_ODD, LORA_A, D), 0.1 * LORA_A ** -0.5),
        'od_v0': nrm((N_ODD - 1, D), 0.1),
        'od_v1': nrm((N_ODD - 1, D, LORA_V), D ** -0.5),
        'od_v2': nrm((N_ODD - 1, LORA_V, D), 0.1 * LORA_V ** -0.5),
        'od_g1': nrm((N_ODD, D, LORA_G), D ** -0.5),
        'od_g2': nrm((N_ODD, LORA_G, D), LORA_G ** -0.5),
        'od_k_k': 0.85 + nrm((N_ODD, D), 0.02),
        'od_k_a': 1.0 + nrm((N_ODD, D), 0.02),
        'od_r_k': nrm((N_ODD, H_C, HS_C), 0.1),
        'od_gn_g': 1.0 + nrm((N_ODD, D), 0.02),
        'od_gn_b': nrm((N_ODD, D), 0.01),
        'od_w_o': nrm((N_ODD, D, D), D ** -0.5),
        'ff_w_up': nrm((DEPTH, D, 2 * D_FF), D ** -0.5),
        'ff_conv_w': nrm((DEPTH, CONV_F, D_FF), CONV_F ** -0.5),
        'ff_conv_b': nrm((DEPTH, D_FF), 0.01),
        'ff_w_down': nrm((DEPTH, D_FF, D), D_FF ** -0.5),
    }


def reference(x_prompt, x_sample, state_ret, state_lru, state_lru_conv, state_rwkv, state_shift, state_ffn_conv,
              meta_tokens, norm_mix_g, norm_ffn_g, norm_final_g,
              ev_w_in, ev_ret_gn_g, ev_lru_conv_w, ev_lru_conv_b, ev_lru_wa, ev_lru_ba, ev_lru_wx, ev_lru_bx,
              ev_lru_lambda, ev_w_out,
              od_mix, od_w_r, od_w_k, od_w_v, od_w0, od_w1, od_w2, od_a0, od_a1, od_a2, od_v0, od_v1, od_v2,
              od_g1, od_g2, od_k_k, od_k_a, od_r_k, od_gn_g, od_gn_b, od_w_o,
              ff_w_up, ff_conv_w, ff_conv_b, ff_w_down):
    ev = [dict(w_in=ev_w_in[j], ret_gn=ev_ret_gn_g[j], conv_w=ev_lru_conv_w[j], conv_b=ev_lru_conv_b[j],
               wa=ev_lru_wa[j], ba=ev_lru_ba[j], wx=ev_lru_wx[j], bx=ev_lru_bx[j], lam=ev_lru_lambda[j],
               w_out=ev_w_out[j]) for j in range(N_EVEN)]
    od = [dict(mix=od_mix[j], w_r=od_w_r[j], w_k=od_w_k[j], w_v=od_w_v[j], w0=od_w0[j], w1=od_w1[j], w2=od_w2[j],
               a0=od_a0[j], a1=od_a1[j], a2=od_a2[j], g1=od_g1[j], g2=od_g2[j], k_k=od_k_k[j], k_a=od_k_a[j],
               r_k=od_r_k[j], gn_g=od_gn_g[j], gn_b=od_gn_b[j], w_o=od_w_o[j]) for j in range(N_ODD)]
    vps = [None] + [dict(v0=od_v0[j], v1=od_v1[j], v2=od_v2[j]) for j in range(N_ODD - 1)]
    ff = [dict(w_up=ff_w_up[l], conv_w=ff_conv_w[l], conv_b=ff_conv_b[l], w_down=ff_w_down[l]) for l in range(DEPTH)]
    weights = (ev, od, vps, ff, norm_mix_g, norm_ffn_g, norm_final_g)
    sample_states = (state_ret, state_lru, state_lru_conv, state_rwkv, state_shift, state_ffn_conv)

    bp = x_prompt.shape[0]
    meta = jnp.broadcast_to(meta_tokens.astype(x_prompt.dtype)[None], (bp, N_META, D_MODEL))
    xp = jnp.concatenate([meta, x_prompt], axis=1)
    pos_p = jnp.arange(xp.shape[1], dtype=jnp.int32)
    prompt_states = tuple(jnp.zeros((s.shape[0], bp) + s.shape[2:], x_prompt.dtype) for s in sample_states)
    yp, ret_p, lru_p, lru_conv_p, rwkv_p, shift_p, ffn_conv_p = trunk(xp, pos_p, N_META, prompt_states, weights)

    pos_s = PAST_LEN + jnp.arange(x_sample.shape[1], dtype=jnp.int32)
    ys, ret_s, lru_s, lru_conv_s, rwkv_s, shift_s, ffn_conv_s = trunk(x_sample, pos_s, 0, sample_states, weights)

    return (yp[:, N_META:], ys, ret_p, lru_p, lru_conv_p, rwkv_p, shift_p, ffn_conv_p,
            ret_s, lru_s, lru_conv_s, rwkv_s, shift_s, ffn_conv_s)
```

```cpp
#include <hip/hip_runtime.h>
#include <cstdio>
#include <cstdint>

#define GAS __attribute__((address_space(1)))
#define LAS __attribute__((address_space(3)))
#define DEVI __device__ __forceinline__
typedef unsigned short bf16;
typedef float f32x4 __attribute__((ext_vector_type(4)));
typedef unsigned u32x2 __attribute__((ext_vector_type(2)));
typedef float f32x2_t __attribute__((ext_vector_type(2)));
typedef unsigned u32x4 __attribute__((ext_vector_type(4)));

#ifndef FAST
#define FAST 1023
#endif
#ifndef REP_SCAN
#define REP_SCAN 1
#endif
#ifndef REP_ACT
#define REP_ACT 1
#endif
#ifndef REP_MIX
#define REP_MIX 1
#endif
#ifndef REP_PRO
#define REP_PRO 1
#endif
#ifndef FUSE_ACT
#define FUSE_ACT 1
#endif
#ifndef REP_G
#define REP_G 1
#endif
#ifndef REP_NORM
#define REP_NORM 1
#endif
constexpr int D = 1024, TP = 2064, NMETA = 16, SEQ = 2048, BP = 8, BS = 128;
constexpr int MP = BP * TP;
constexpr int M = MP + BS;
constexpr int NIN = 5120, DFF = 2816, NUP = 2 * DFF;
constexpr int M_MAIN = 16384;
constexpr int LML = 640;
constexpr int NWAVES = 8, NT = NWAVES * 64;

constexpr size_t MiB = 1u << 20;
constexpr size_t WS_CTL = 0, CTL_ZERO_BYTES = 1 * MiB;
constexpr size_t WS_RS = 1 * MiB;
constexpr size_t WS_ROPE = 3 * MiB;
constexpr size_t WS_WB = 5 * MiB;
constexpr size_t WS_X = 124 * MiB;
constexpr size_t WS_R = 124 * MiB;
constexpr size_t WS_XB = 189 * MiB;
constexpr size_t WS_BIG = 222 * MiB;
constexpr size_t SZ_ACT1 = (size_t)M * D * 2;
constexpr size_t WS_Z = WS_BIG, WS_MIX = WS_BIG + 163 * MiB;
constexpr size_t WS_U = WS_BIG, WS_ACT = WS_BIG + 179 * MiB;
constexpr size_t WS_XMIX = WS_BIG, WS_K = WS_BIG + 195 * MiB, WS_V = WS_BIG + 228 * MiB;
constexpr size_t WS_WDEC = WS_BIG, WS_AG = WS_BIG + 65 * MiB, WS_GG = WS_AG + SZ_ACT1, WS_VG = WS_GG + SZ_ACT1, WS_O = WS_VG + SZ_ACT1;
constexpr size_t WS_END = WS_BIG + 270 * MiB;
static_assert(WS_O + SZ_ACT1 <= WS_K && WS_ACT + (size_t)M * DFF * 2 <= WS_END && WS_V + SZ_ACT1 <= WS_END && WS_MIX + (size_t)M * 2048 * 2 <= WS_END, "ws map");
constexpr size_t DO_VFIRST = 0, DO_LMID = 33 * MiB;
static_assert(DO_LMID + (size_t)M * LML * 2 <= (size_t)BP * SEQ * D * 4, "d_out scratch");

constexpr size_t O_YP = 0, O_YS = O_YP + (size_t)BP * SEQ * D, O_RETP = O_YS + (size_t)BS * D, O_LRUP = O_RETP + (size_t)2 * BP * 4 * 128 * 256,
    O_LCONVP = O_LRUP + (size_t)2 * BP * 1024, O_RWKVP = O_LCONVP + (size_t)2 * BP * 3 * 1024, O_SHIFTP = O_RWKVP + (size_t)2 * BP * 16 * 64 * 64,
    O_FCONVP = O_SHIFTP + (size_t)2 * BP * 1024, O_RETS = O_FCONVP + (size_t)4 * BP * 2 * DFF, O_LRUS = O_RETS + (size_t)2 * BS * 4 * 128 * 256,
    O_LCONVS = O_LRUS + (size_t)2 * BS * 1024, O_RWKVS = O_LCONVS + (size_t)2 * BS * 3 * 1024, O_SHIFTS = O_RWKVS + (size_t)2 * BS * 16 * 64 * 64,
    O_FCONVS = O_SHIFTS + (size_t)2 * BS * 1024, O_END = O_FCONVS + (size_t)4 * BS * 2 * DFF;

enum { I_XP = 0, I_XS, I_SRET, I_SLRU, I_SLCONV, I_SRWKV, I_SSHIFT, I_SFCONV, I_META, I_NMIX, I_NFFN, I_NFIN,
       I_EWIN, I_ERGN, I_ECW, I_ECB, I_EWA, I_EBA, I_EWX, I_EBX, I_ELAM, I_EWOUT,
       I_OMIX, I_OWR, I_OWK, I_OWV, I_OW0, I_OW1, I_OW2, I_OA0, I_OA1, I_OA2, I_OV0, I_OV1, I_OV2, I_OG1, I_OG2, I_OKK, I_OKA, I_ORK, I_OGNG, I_OGNB, I_OWO,
       I_FWUP, I_FCW, I_FCB, I_FWDN, N_IN };

constexpr int RING_BYTES = 143360, LDSCTL_OFF = RING_BYTES, MISC_OFF = LDSCTL_OFF + 320, LDS_BYTES = 147456;

DEVI float bf2f(bf16 v) { return __uint_as_float((unsigned)v << 16); }
typedef __bf16 hbf16x2_t __attribute__((ext_vector_type(2)));
DEVI unsigned pk2(float lo, float hi) { const f32x2_t v = (f32x2_t){lo, hi}; return __builtin_bit_cast(unsigned, __builtin_convertvector(v, hbf16x2_t)); }
DEVI bf16 f2bf(float f) { return (bf16)(pk2(f, f) & 0xffffu); }
DEVI float wave_sum(float v) {
#pragma unroll
    for (int o = 1; o < 64; o <<= 1) v += __shfl_xor(v, o);
    return v;
}
DEVI float rcpf_(float x) { return __builtin_amdgcn_rcpf(x); }
DEVI float sigmoidf_(float x) { return rcpf_(1.f + __expf(-x)); }
DEVI float siluf_(float x) { return x * rcpf_(1.f + __expf(-x)); }
DEVI float tanhf_(float x) { return 2.f * rcpf_(1.f + __expf(-2.f * x)) - 1.f; }
DEVI float geluf_(float x) { return x * rcpf_(1.f + __expf(-1.5957691216057308f * (x + 0.044715f * x * x * x))); }
DEVI float softplusf_(float x) { return fmaxf(x, 0.f) + log1pf(__expf(-fabsf(x))); }

#define XB_TMO      128
#define XB_XCNT(j)  (256  + 64 * (j))
#define XB_XSUB(j)  (1280 + 64 * (j))
#define XB_XGEN(j)  (2304 + 64 * (j))
#define XB_TOP      3328
#define XB_TOPGEN   3392
#define XCD_BAR_WORDS 3456
#define XB_SPIN_CAP (1u << 22)
DEVI unsigned xb_ld(unsigned* p)              { return __hip_atomic_load(p, __ATOMIC_RELAXED, __HIP_MEMORY_SCOPE_AGENT); }
DEVI unsigned xb_add(unsigned* p, unsigned v) { return __hip_atomic_fetch_add(p, v, __ATOMIC_RELAXED, __HIP_MEMORY_SCOPE_AGENT); }
DEVI unsigned xb_xcc_id() { return (unsigned)__builtin_amdgcn_s_getreg((3 << 11) | 20) & 0xFu; }
#define XB_SPIN(cond, bar) do { unsigned _sp = 0; while (cond) { __builtin_amdgcn_s_sleep(1); \
    if ((++_sp & 255u) == 0u) { if (xb_ld(&(bar)[XB_TMO])) break; if (_sp > XB_SPIN_CAP) { atomicAdd(&(bar)[XB_TMO], 1u); break; } } } } while (0)
struct XcdBarrier { unsigned* bar; unsigned x; volatile LAS unsigned* st; };
DEVI XcdBarrier xcd_barrier_post(unsigned* bar, volatile LAS unsigned* st) {
    XcdBarrier b; b.bar = bar; b.x = xb_xcc_id(); b.st = st;
    if (threadIdx.x == 0) (void)xb_add(&bar[XB_XCNT(b.x)], 1u);
    return b;
}
DEVI void xcd_barrier_complete(unsigned* bar, unsigned x, unsigned& nloc, unsigned& nx) {
    const unsigned G = gridDim.x * gridDim.y * gridDim.z;
    unsigned sum, cnt, mine, sp = 0u;
    for (;;) {
        sum = 0u; cnt = 0u; mine = 0u;
#pragma unroll
        for (unsigned j = 0; j < 16; ++j) { const unsigned c = xb_ld(&bar[XB_XCNT(j)]); sum += c; cnt += (c > 0u) ? 1u : 0u; mine = (j == x) ? c : mine; }
        if (sum == G) break;
        __builtin_amdgcn_s_sleep(1);
        if ((++sp & 255u) == 0u) { if (xb_ld(&bar[XB_TMO])) break; if (sp > XB_SPIN_CAP) { atomicAdd(&bar[XB_TMO], 1u); break; } }
    }
    nloc = mine > 0u ? mine : 1u; nx = cnt > 0u ? cnt : 1u;
}
DEVI void xcd_barrier(const XcdBarrier& b) {
    asm volatile("s_waitcnt vmcnt(0)" ::: "memory");
    __syncthreads();
    if (threadIdx.x == 0) {
        unsigned* bar = b.bar;
        __builtin_amdgcn_s_waitcnt(0);
        unsigned nloc = b.st[0], nx = b.st[1];
        if (nloc == 0u) { xcd_barrier_complete(bar, b.x, nloc, nx); b.st[0] = nloc; b.st[1] = nx; }
        const unsigned old = xb_add(&bar[XB_XSUB(b.x)], 1u);
        const unsigned gen = old / nloc;
        if (old + 1u == (gen + 1u) * nloc) {
            __builtin_amdgcn_fence(__ATOMIC_RELEASE, "agent");
            asm volatile("s_waitcnt vmcnt(0)" ::: "memory");
            const unsigned og = xb_add(&bar[XB_TOP], 1u);
            const unsigned tg = og / nx;
            if (og + 1u == (tg + 1u) * nx) xb_add(&bar[XB_TOPGEN], 1u);
            else XB_SPIN(xb_ld(&bar[XB_TOPGEN]) == tg, bar);
            __builtin_amdgcn_fence(__ATOMIC_ACQUIRE, "agent");
            xb_add(&bar[XB_XGEN(b.x)], 1u);
            asm volatile("s_waitcnt vmcnt(0)" ::: "memory");
        } else {
            XB_SPIN(xb_ld(&bar[XB_XGEN(b.x)]) == gen, bar);
            __builtin_amdgcn_fence(__ATOMIC_ACQUIRE, "agent");
            asm volatile("s_waitcnt vmcnt(0)" ::: "memory");
        }
    }
    __syncthreads();
}

struct Args { const float* in[N_IN]; float* out; unsigned char* ws; };
constexpr int PTAB_OFF = MISC_OFF + 128;
struct InTab { const LAS unsigned long long* t;
    DEVI const float* operator[](int i) const { const unsigned long long v = t[i];
        const unsigned lo = __builtin_amdgcn_readfirstlane((unsigned)v), hi = __builtin_amdgcn_readfirstlane((unsigned)(v >> 32));
        return (const float*)(const __attribute__((address_space(1))) float*)(((unsigned long long)hi << 32) | lo); } };
struct PArgs { InTab in; };

struct Ctx {
    LAS unsigned char* lds;
    int tid, lane, wave, G, bid;
    unsigned char* ws; float* out;
};
DEVI int row_pos(int row) { return row < MP ? (row % TP) : TP; }
DEVI float row_rstd(const float* RS, int row) {
    const f32x4* p = (const f32x4*)(RS + (size_t)row * 16);
    const f32x4 a = p[0], b = p[1], c = p[2], d = p[3];
    const float s = ((a.x + a.y) + (a.z + a.w)) + ((b.x + b.y) + (b.z + b.w)) + ((c.x + c.y) + (c.z + c.w)) + ((d.x + d.y) + (d.z + d.w));
    return __builtin_amdgcn_rsqf(s * (1.0f / D) + 1e-6f);
}
DEVI float row_rstd_q(const float* RS, int row, int fq) {
    const f32x4 a = *(const f32x4*)(RS + (size_t)row * 16 + 4 * fq);
    float s = (a.x + a.y) + (a.z + a.w);
    u32x2 r = __builtin_amdgcn_permlane16_swap(__float_as_uint(s), __float_as_uint(s), false, false); s = __uint_as_float(r.x) + __uint_as_float(r.y);
    r = __builtin_amdgcn_permlane32_swap(__float_as_uint(s), __float_as_uint(s), false, false); s = __uint_as_float(r.x) + __uint_as_float(r.y);
    return __builtin_amdgcn_rsqf(s * (1.0f / D) + 1e-6f);
}

DEVI void n_prologue(const Ctx& c, const PArgs& a) {
    float* X = (float*)(c.ws + WS_X); bf16* XB = (bf16*)(c.ws + WS_XB); float* RS = (float*)(c.ws + WS_RS);
    const int gw = c.bid * NWAVES + c.wave, NGW = c.G * NWAVES;
    for (int row = gw; row < M; row += NGW) {
        const float* src;
        if (row < MP) { const int b = row / TP, t = row % TP; src = t < NMETA ? a.in[I_META] + (size_t)t * D : a.in[I_XP] + ((size_t)b * SEQ + (t - NMETA)) * D; }
        else src = a.in[I_XS] + (size_t)(row - MP) * D;
        float ss = 0.f;
#pragma unroll
        for (int j = 0; j < 4; ++j) {
            const f32x4 v = __builtin_nontemporal_load((const f32x4*)(src + j * 256 + c.lane * 4));
            (void)X;
            u32x2 w; w.x = pk2(v.x, v.y); w.y = pk2(v.z, v.w);
            *(u32x2*)(XB + (size_t)row * D + j * 256 + c.lane * 4) = w;
            ss += (v.x * v.x + v.y * v.y) + (v.z * v.z + v.w * v.w);
        }
        ss = wave_sum(ss);
        if (c.lane < 16) RS[(size_t)row * 16 + c.lane] = c.lane == 0 ? ss : 0.f;
    }
    float* ROPE = (float*)(c.ws + WS_ROPE);
    for (int e = c.bid * NT + c.tid; e < (TP + 1) * 64; e += c.G * NT) {
        const int p = e >> 6, d = e & 63;
        const double pos = p < TP ? (double)p : 16384.0;
        const double inv = exp(-9.210340371976184 * ((double)d / 63.0));
        const double rev = pos * inv * 0.15915494309189535;
        const float fr = (float)(rev - rint(rev));
        ROPE[2 * e] = __builtin_amdgcn_cosf(fr); ROPE[2 * e + 1] = __builtin_amdgcn_sinf(fr);
    }
}

DEVI void ngemm_tile(const Ctx& c, const bf16* A, int lda, const float* W, int ldw, int ncv, int K, const float* gain, int row0, float (&acc)[4][4]) {
    LAS float* As = (LAS float*)c.lds;
    LAS float* Bs = (LAS float*)(c.lds + 8192);
#pragma unroll
    for (int j = 0; j < 4; ++j)
#pragma unroll
        for (int i = 0; i < 4; ++i) acc[j][i] = 0.f;
    const int ar = c.tid >> 4, ak = (c.tid & 15) * 2;
    for (int k0 = 0; k0 < K; k0 += 32) {
        __syncthreads();
        { const unsigned v = *(const unsigned*)(A + (size_t)(row0 + ar) * lda + k0 + ak);
          float lo = __uint_as_float(v << 16), hi = __uint_as_float(v & 0xffff0000u);
          if (gain) { lo *= gain[k0 + ak]; hi *= gain[k0 + ak + 1]; }
          As[ar * 33 + ak] = lo; As[ar * 33 + ak + 1] = hi; }
#pragma unroll
        for (int i = 0; i < 16; ++i) { const int idx = i * NT + c.tid, kk = idx >> 8, cc = idx & 255;
            Bs[idx] = cc < ncv ? W[(size_t)(k0 + kk) * ldw + cc] : 0.f; }
        __syncthreads();
#pragma unroll 8
        for (int kk = 0; kk < 32; ++kk) {
            float av[4], bv[4];
#pragma unroll
            for (int j = 0; j < 4; ++j) av[j] = As[(c.wave * 4 + j) * 33 + kk];
#pragma unroll
            for (int i = 0; i < 4; ++i) bv[i] = Bs[kk * 256 + c.lane + 64 * i];
#pragma unroll
            for (int j = 0; j < 4; ++j)
#pragma unroll
                for (int i = 0; i < 4; ++i) acc[j][i] += av[j] * bv[i];
        }
    }
}

DEVI void nepi_residual(const Ctx& c, int row0, int pn, const float (&acc)[4][4], bool write_xb) {
    float* X = (float*)(c.ws + WS_X); bf16* XB = (bf16*)(c.ws + WS_XB); float* RS = (float*)(c.ws + WS_RS);
#pragma unroll
    for (int j = 0; j < 4; ++j) { const int row = row0 + 4 * c.wave + j; float ss = 0.f;
#pragma unroll
        for (int i = 0; i < 4; ++i) { const int col = pn * 256 + c.lane + 64 * i; const float v = X[(size_t)row * D + col] + acc[j][i];
            X[(size_t)row * D + col] = v; if (write_xb) XB[(size_t)row * D + col] = f2bf(v); ss += v * v; }
        ss = wave_sum(ss);
        if (c.lane < 4) RS[(size_t)row * 16 + pn * 4 + c.lane] = c.lane == 0 ? ss : 0.f; }
}

DEVI void n_even_in(const Ctx& c, const PArgs& a, int li) {
    const int j = li >> 1;
    const bf16* XB = (const bf16*)(c.ws + WS_XB); const float* RS = (const float*)(c.ws + WS_RS); const float* ROPE = (const float*)(c.ws + WS_ROPE);
    bf16* Z = (bf16*)(c.ws + WS_Z);
    const float* W = a.in[I_EWIN] + (size_t)j * D * NIN; const float* gain = a.in[I_NMIX] + (size_t)li * D;
    const int ntn = NIN / 256, nu = (M / 32) * ntn;
    for (int u = c.bid; u < nu; u += c.G) {
        const int pn = u % ntn, row0 = (u / ntn) * 32;
        float acc[4][4];
        ngemm_tile(c, XB, D, W + pn * 256, NIN, 256, D, gain, row0, acc);
#pragma unroll
        for (int jj = 0; jj < 4; ++jj) { const int row = row0 + 4 * c.wave + jj; const float rs = row_rstd(RS, row);
            float v[4];
#pragma unroll
            for (int i = 0; i < 4; ++i) v[i] = acc[jj][i] * rs;
            if (pn < 4) {
                const float cs = ROPE[((size_t)row_pos(row) * 64 + c.lane) * 2], sn = ROPE[((size_t)row_pos(row) * 64 + c.lane) * 2 + 1];
                const float sc = pn >= 2 ? 0.08838834764831845f : 1.f;
                const float a0 = v[0] * cs - v[1] * sn, a1 = v[0] * sn + v[1] * cs, b0 = v[2] * cs - v[3] * sn, b1 = v[2] * sn + v[3] * cs;
                v[0] = a0 * sc; v[1] = a1 * sc; v[2] = b0 * sc; v[3] = b1 * sc;
            } else if (pn >= 8 && pn < 12) {
#pragma unroll
                for (int i = 0; i < 4; ++i) v[i] = siluf_(v[i]);
            } else if (pn >= 16) {
#pragma unroll
                for (int i = 0; i < 4; ++i) v[i] = geluf_(v[i]);
            }
#pragma unroll
            for (int i = 0; i < 4; ++i) Z[(size_t)row * NIN + pn * 256 + c.lane + 64 * i] = f2bf(v[i]); }
    }
}

DEVI void n_ret_unit(const Ctx& c, const PArgs& a, int j, int hd, int row0, int ntok, const float* S0, float* Sout) {
    const bf16* Z = (const bf16*)(c.ws + WS_Z); bf16* MIX = (bf16*)(c.ws + WS_MIX);
    LAS float* qs = (LAS float*)c.lds;
    LAS float* ks = qs + 8 * 128;
    LAS float* vs = ks + 8 * 128;
    LAS float* op = vs + 8 * 256;
    const int e = c.tid & 255, half = c.tid >> 8;
    const float gamma = 1.f - exp2f(-5.f - (float)hd);
    const float* gn = a.in[I_ERGN] + (size_t)j * 1024 + hd * 256;
    float S[64];
    if (S0) { const float* sp = S0 + (size_t)half * 64 * 256 + e;
#pragma unroll
        for (int d8 = 0; d8 < 8; ++d8) { asm volatile("" ::: "memory");
#pragma unroll
            for (int dd = 0; dd < 8; ++dd) S[d8 * 8 + dd] = sp[(size_t)(d8 * 8 + dd) * 256]; }
    } else {
#pragma unroll
        for (int dd = 0; dd < 64; ++dd) S[dd] = 0.f; }
    for (int t0 = 0; t0 < ntok; t0 += 8) {
        __syncthreads();
#pragma unroll
        for (int i = 0; i < 8; ++i) { const int idx = i * NT + c.tid, tt = idx >> 9, cc = idx & 511; const int row = row0 + t0 + tt;
            float v = 0.f;
            if (t0 + tt < ntok) { const int col = cc < 128 ? hd * 128 + cc : (cc < 256 ? 512 + hd * 128 + (cc - 128) : 1024 + hd * 256 + (cc - 256)); v = bf2f(Z[(size_t)row * NIN + col]); }
            if (cc < 128) qs[tt * 128 + cc] = v; else if (cc < 256) ks[tt * 128 + cc - 128] = v; else vs[tt * 256 + cc - 256] = v; }
        __syncthreads();
        for (int tt = 0; tt < 8; ++tt) {
            if (t0 + tt < ntok) {
                const float ve = vs[tt * 256 + e]; float o = 0.f;
#pragma unroll
                for (int dd = 0; dd < 64; ++dd) { S[dd] = gamma * S[dd] + ks[tt * 128 + half * 64 + dd] * ve; o += qs[tt * 128 + half * 64 + dd] * S[dd]; }
                op[(tt * 2 + half) * 256 + e] = o;
            }
        }
        __syncthreads();
        { const int tt = c.wave; const int row = row0 + t0 + tt;
          if (t0 + tt < ntok) {
              float o[4]; float s = 0.f;
#pragma unroll
              for (int i = 0; i < 4; ++i) { const int ee = c.lane + 64 * i; o[i] = op[(tt * 2) * 256 + ee] + op[(tt * 2 + 1) * 256 + ee]; s += o[i]; }
              const float mu = wave_sum(s) * (1.f / 256.f); float q = 0.f;
#pragma unroll
              for (int i = 0; i < 4; ++i) { o[i] -= mu; q += o[i] * o[i]; }
              const float rstd = __builtin_amdgcn_rsqf(wave_sum(q) * (1.f / 256.f) + 1e-6f);
#pragma unroll
              for (int i = 0; i < 4; ++i) { const int ee = c.lane + 64 * i; const float ga = bf2f(Z[(size_t)row * NIN + 2048 + hd * 256 + ee]);
                  MIX[(size_t)row * 2048 + hd * 256 + ee] = f2bf(ga * o[i] * rstd * gn[ee]); }
          } }
    }
    { float* sp = Sout + (size_t)half * 64 * 256 + e;
#pragma unroll
      for (int d8 = 0; d8 < 8; ++d8) { asm volatile("" ::: "memory");
#pragma unroll
          for (int dd = 0; dd < 8; ++dd) sp[(size_t)(d8 * 8 + dd) * 256] = S[d8 * 8 + dd]; } }
    __syncthreads();
}

DEVI void n_lru_unit(const Ctx& c, const PArgs& a, int j, int g, int row0, int ntok, const float* hist  , const float* h0  , float* out_h, float* out_conv) {
    const bf16* Z = (const bf16*)(c.ws + WS_Z); bf16* MIX = (bf16*)(c.ws + WS_MIX);
    LAS float* xcs = (LAS float*)c.lds;
    const int d = c.tid >> 2, p = c.tid & 3, ch = g * 128 + d;
    float wa[32], wx[32];
    { const float* WA = a.in[I_EWA] + ((size_t)(j * 8 + g) * 128 + 32 * p) * 128 + d; const float* WX = a.in[I_EWX] + ((size_t)(j * 8 + g) * 128 + 32 * p) * 128 + d;
#pragma unroll
      for (int cc = 0; cc < 32; ++cc) { wa[cc] = WA[(size_t)cc * 128]; wx[cc] = WX[(size_t)cc * 128]; } }
    const float* CW = a.in[I_ECW] + (size_t)j * 4 * 1024;
    const float cw0 = CW[ch], cw1 = CW[1024 + ch], cw2 = CW[2048 + ch], cw3 = CW[3072 + ch], cb = a.in[I_ECB][(size_t)j * 1024 + ch];
    const float ba = a.in[I_EBA][(size_t)j * 1024 + ch], bx = a.in[I_EBX][(size_t)j * 1024 + ch];
    const float sp = softplusf_(-a.in[I_ELAM][(size_t)j * 1024 + ch]);
    float x1 = hist ? hist[2 * 1024 + ch] : 0.f, x2 = hist ? hist[1024 + ch] : 0.f, x3 = hist ? hist[ch] : 0.f;
    float h = h0 ? h0[ch] : 0.f;
    for (int t = 0; t < ntok; ++t) {
        const int row = row0 + t;
        float xcv = 0.f;
        if (p == 0) { const float xb = bf2f(Z[(size_t)row * NIN + 3072 + ch]); xcv = cb + cw3 * xb + cw2 * x1 + cw1 * x2 + cw0 * x3; x3 = x2; x2 = x1; x1 = xb; xcs[d] = xcv; }
        __syncthreads();
        float sr = 0.f, si = 0.f;
#pragma unroll
        for (int cc = 0; cc < 32; ++cc) { const float xv = xcs[32 * p + cc]; sr += xv * wa[cc]; si += xv * wx[cc]; }
        sr += __shfl_xor(sr, 1); sr += __shfl_xor(sr, 2); si += __shfl_xor(si, 1); si += __shfl_xor(si, 2);
        if (p == 0) {
            const float r = sigmoidf_(sr + ba), ig = sigmoidf_(si + bx);
            const float la = -8.f * r * sp, av = __expf(la), u = sqrtf(-expm1f(2.f * la)) * (ig * xcv);
            h = av * h + u;
            MIX[(size_t)row * 2048 + 1024 + ch] = f2bf(h * bf2f(Z[(size_t)row * NIN + 4096 + ch]));
        }
        __syncthreads();
    }
    if (p == 0) { out_h[ch] = h; out_conv[ch] = x3; out_conv[1024 + ch] = x2; out_conv[2048 + ch] = x1; }
}

DEVI void n_even_mix(const Ctx& c, const PArgs& a, int li) {
    const int j = li >> 1;
    const int NU = 32 + 64 + 512 + 1024;
    for (int u = c.bid; u < NU; u += c.G) {
        if (u < 32 || (u >= 96 && u < 608)) {
            const bool pr = u < 32; const int v = pr ? u : u - 96, b = v >> 2, hd = v & 3;
            const float* S0 = pr ? nullptr : a.in[I_SRET] + ((size_t)(j * BS + b) * 4 + hd) * 128 * 256;
            float* So = pr ? c.out + O_RETP + ((size_t)(j * BP + b) * 4 + hd) * 128 * 256 : c.out + O_RETS + ((size_t)(j * BS + b) * 4 + hd) * 128 * 256;
            n_ret_unit(c, a, j, hd, pr ? b * TP : MP + b, pr ? TP : 1, S0, So);
        } else {
            const bool pr = u < 96; const int v = pr ? u - 32 : u - 608, b = v >> 3, g = v & 7;
            const float* hist = pr ? nullptr : a.in[I_SLCONV] + (size_t)(j * BS + b) * 3 * 1024;
            const float* h0 = pr ? nullptr : a.in[I_SLRU] + (size_t)(j * BS + b) * 1024;
            float* oh = pr ? c.out + O_LRUP + (size_t)(j * BP + b) * 1024 : c.out + O_LRUS + (size_t)(j * BS + b) * 1024;
            float* oc = pr ? c.out + O_LCONVP + (size_t)(j * BP + b) * 3 * 1024 : c.out + O_LCONVS + (size_t)(j * BS + b) * 3 * 1024;
            n_lru_unit(c, a, j, g, pr ? b * TP : MP + b, pr ? TP : 1, hist, h0, oh, oc);
        }
    }
}

DEVI void n_gemm_residual(const Ctx& c, const bf16* A, int lda, const float* W, int K, bool write_xb) {
    const int nu = (M / 32) * 4;
    for (int u = c.bid; u < nu; u += c.G) {
        const int pn = u & 3, row0 = (u >> 2) * 32;
        float acc[4][4];
        ngemm_tile(c, A, lda, W + pn * 256, D, 256, K, nullptr, row0, acc);
        nepi_residual(c, row0, pn, acc, write_xb);
    }
}

DEVI void n_ffn_up(const Ctx& c, const PArgs& a, int li) {
    const bf16* XB = (const bf16*)(c.ws + WS_XB); const float* RS = (const float*)(c.ws + WS_RS); bf16* U = (bf16*)(c.ws + WS_U);
    const float* W = a.in[I_FWUP] + (size_t)li * D * NUP; const float* gain = a.in[I_NFFN] + (size_t)li * D;
    const int ntn = NUP / 256, nu = (M / 32) * ntn;
    for (int u = c.bid; u < nu; u += c.G) {
        const int pn = u % ntn, row0 = (u / ntn) * 32;
        float acc[4][4];
        ngemm_tile(c, XB, D, W + pn * 256, NUP, 256, D, gain, row0, acc);
#pragma unroll
        for (int jj = 0; jj < 4; ++jj) { const int row = row0 + 4 * c.wave + jj; const float rs = row_rstd(RS, row);
#pragma unroll
            for (int i = 0; i < 4; ++i) U[(size_t)row * NUP + pn * 256 + c.lane + 64 * i] = f2bf(acc[jj][i] * rs); }
    }
}

DEVI void n_ffn_act(const Ctx& c, const PArgs& a, int li) {
    const bf16* U = (const bf16*)(c.ws + WS_U); bf16* ACT = (bf16*)(c.ws + WS_ACT);
    const float* CW = a.in[I_FCW] + (size_t)li * 3 * DFF; const float* CB = a.in[I_FCB] + (size_t)li * DFF;
    const size_t total = (size_t)M * DFF;
    for (size_t e = (size_t)c.bid * NT + c.tid; e < total; e += (size_t)c.G * NT) {
        const int row = (int)(e / DFF), col = (int)(e % DFF);
        const float u0 = bf2f(U[(size_t)row * NUP + col]); float u1, u2;
        if (row < MP) { const int b = row / TP, t = row % TP;
            u1 = t >= 1 ? bf2f(U[(size_t)(row - 1) * NUP + col]) : 0.f; u2 = t >= 2 ? bf2f(U[(size_t)(row - 2) * NUP + col]) : 0.f;
            if (t >= TP - 2) c.out[O_FCONVP + ((size_t)(li * BP + b) * 2 + (t - (TP - 2))) * DFF + col] = u0;
        } else { const int b = row - MP; const float* st = a.in[I_SFCONV] + (size_t)(li * BS + b) * 2 * DFF;
            u1 = st[DFF + col]; u2 = st[col];
            float* so = c.out + O_FCONVS + (size_t)(li * BS + b) * 2 * DFF; so[col] = u1; so[DFF + col] = u0; }
        const float cv = CB[col] + CW[2 * DFF + col] * u0 + CW[DFF + col] * u1 + CW[col] * u2;
        ACT[(size_t)row * DFF + col] = f2bf(geluf_(cv) * bf2f(U[(size_t)row * NUP + DFF + col]));
    }
}

DEVI void n_odd_norm(const Ctx& c, const PArgs& a, int li) {
    const int j = li >> 1;
    const bf16* XB = (const bf16*)(c.ws + WS_XB); const float* RS = (const float*)(c.ws + WS_RS); bf16* XM = (bf16*)(c.ws + WS_XMIX);
    const float* gain = a.in[I_NMIX] + (size_t)li * D; const float* mix = a.in[I_OMIX] + (size_t)j * 6 * D;
    const int gw = c.bid * NWAVES + c.wave, NGW = c.G * NWAVES;
    for (int row = gw; row < M; row += NGW) {
        const float rs = row_rstd(RS, row);
        const bool prompt = row < MP; const int b = prompt ? row / TP : row - MP, t = prompt ? row % TP : 0;
        const float rsp = (prompt && t > 0) ? row_rstd(RS, row - 1) : 0.f;
#pragma unroll
        for (int q = 0; q < 4; ++q) { const int col = q * 256 + c.lane * 4;
            const u32x2 xw_ = *(const u32x2*)(XB + (size_t)row * D + col); const f32x4 xv = (f32x4){__uint_as_float(xw_.x << 16), __uint_as_float(xw_.x & 0xffff0000u), __uint_as_float(xw_.y << 16), __uint_as_float(xw_.y & 0xffff0000u)}; const f32x4 gv = *(const f32x4*)(gain + col);
            const f32x4 h = xv * rs * gv; f32x4 hp;
            if (prompt) { if (t > 0) { const u32x2 pw_ = *(const u32x2*)(XB + (size_t)(row - 1) * D + col); hp = (f32x4){__uint_as_float(pw_.x << 16), __uint_as_float(pw_.x & 0xffff0000u), __uint_as_float(pw_.y << 16), __uint_as_float(pw_.y & 0xffff0000u)} * rsp * gv; } else hp = (f32x4){0.f, 0.f, 0.f, 0.f}; }
            else hp = *(const f32x4*)(a.in[I_SSHIFT] + (size_t)(j * BS + b) * D + col);
            const f32x4 xx = hp - h;
#pragma unroll
            for (int n = 0; n < 6; ++n) { const f32x4 mv = *(const f32x4*)(mix + (size_t)n * D + col); const f32x4 o = h + xx * mv;
                u32x2 w; w.x = pk2(o.x, o.y); w.y = pk2(o.z, o.w); *(u32x2*)(XM + ((size_t)n * M + row) * D + col) = w; }
            if (prompt) { if (t == TP - 1) *(f32x4*)(c.out + O_SHIFTP + (size_t)(j * BP + b) * D + col) = h; }
            else *(f32x4*)(c.out + O_SHIFTS + (size_t)(j * BS + b) * D + col) = h; }
    }
}

DEVI void n_odd_in(const Ctx& c, const PArgs& a, int li) {
    const int j = li >> 1;
    const bf16* XM = (const bf16*)(c.ws + WS_XMIX);
    bf16* R = (bf16*)(c.ws + WS_R); bf16* Kb = (bf16*)(c.ws + WS_K); bf16* Vb = j == 0 ? (bf16*)((unsigned char*)c.out + DO_VFIRST) : (bf16*)(c.ws + WS_V);
    bf16* LM = (bf16*)((unsigned char*)c.out + DO_LMID);
    const int nu = (M / 32) * 16;
    for (int u = c.bid; u < nu; u += c.G) {
        const int pn = u & 15, row0 = (u >> 4) * 32;
        if (pn == 13 && j == 0) continue;
        const bf16* A; const float* W; int ldw, ncv;
        if (pn < 4) { A = XM + (size_t)0 * M * D; W = a.in[I_OWR] + (size_t)j * D * D + pn * 256; ldw = D; ncv = 256; }
        else if (pn < 8) { A = XM + (size_t)2 * M * D; W = a.in[I_OWK] + (size_t)j * D * D + (pn - 4) * 256; ldw = D; ncv = 256; }
        else if (pn < 12) { A = XM + (size_t)3 * M * D; W = a.in[I_OWV] + (size_t)j * D * D + (pn - 8) * 256; ldw = D; ncv = 256; }
        else if (pn == 12) { A = XM + (size_t)5 * M * D; W = a.in[I_OG1] + (size_t)j * D * 128; ldw = 128; ncv = 128; }
        else if (pn == 13) { A = XM + (size_t)3 * M * D; W = a.in[I_OV1]; ldw = 32; ncv = 32; }
        else if (pn == 14) { A = XM + (size_t)1 * M * D; W = a.in[I_OW1] + (size_t)j * D * 64; ldw = 64; ncv = 64; }
        else { A = XM + (size_t)4 * M * D; W = a.in[I_OA1] + (size_t)j * D * 64; ldw = 64; ncv = 64; }
        float acc[4][4];
        ngemm_tile(c, A, D, W, ldw, ncv, D, nullptr, row0, acc);
#pragma unroll
        for (int jj = 0; jj < 4; ++jj) { const int row = row0 + 4 * c.wave + jj;
#pragma unroll
            for (int i = 0; i < 4; ++i) { const int cl = c.lane + 64 * i; const float v = acc[jj][i];
                if (pn < 4) R[(size_t)row * D + pn * 256 + cl] = f2bf(v);
                else if (pn < 8) Kb[(size_t)row * D + (pn - 4) * 256 + cl] = f2bf(v);
                else if (pn < 12) Vb[(size_t)row * D + (pn - 8) * 256 + cl] = f2bf(v);
                else if (pn == 12) { if (cl < 128) LM[(size_t)row * LML + cl] = f2bf(sigmoidf_(v)); }
                else if (pn == 13) { if (cl < 128) LM[(size_t)row * LML + 128 + cl] = f2bf(v); }
                else if (pn == 14) { if (cl < 128) LM[(size_t)row * LML + 256 + cl] = f2bf(tanhf_(v)); }
                else LM[(size_t)row * LML + 384 + cl] = f2bf(v); } }
    }
}

DEVI void n_odd_lora(const Ctx& c, const PArgs& a, int li) {
    const int j = li >> 1;
    const bf16* LM = (const bf16*)((unsigned char*)c.out + DO_LMID);
    float* WD = (float*)(c.ws + WS_WDEC); bf16* AG = (bf16*)(c.ws + WS_AG); bf16* VG = (bf16*)(c.ws + WS_VG); bf16* GG = (bf16*)(c.ws + WS_GG);
    const int nu = (M / 32) * 16;
    for (int u = c.bid; u < nu; u += c.G) {
        const int pn = u & 15, grp = pn >> 2, pc = pn & 3, row0 = (u >> 4) * 32;
        if (grp == 2 && j == 0) continue;
        const bf16* A; const float* W; int K;
        if (grp == 0) { A = LM + 256; W = a.in[I_OW2] + (size_t)j * 64 * D; K = 64; }
        else if (grp == 1) { A = LM + 384; W = a.in[I_OA2] + (size_t)j * 64 * D; K = 64; }
        else if (grp == 2) { A = LM + 128; W = a.in[I_OV2]; K = 32; }
        else { A = LM; W = a.in[I_OG2] + (size_t)j * 128 * D; K = 128; }
        float acc[4][4];
        ngemm_tile(c, A, LML, W + pc * 256, D, 256, K, nullptr, row0, acc);
#pragma unroll
        for (int jj = 0; jj < 4; ++jj) { const int row = row0 + 4 * c.wave + jj;
#pragma unroll
            for (int i = 0; i < 4; ++i) { const int col = pc * 256 + c.lane + 64 * i; const float v = acc[jj][i];
                if (grp == 0) { const float wl = -softplusf_(-(a.in[I_OW0][(size_t)j * D + col] + v)) - 0.5f; WD[(size_t)row * D + col] = __expf(-__expf(wl)); }
                else if (grp == 1) AG[(size_t)row * D + col] = f2bf(sigmoidf_(a.in[I_OA0][(size_t)j * D + col] + v));
                else if (grp == 2) VG[(size_t)row * D + col] = f2bf(sigmoidf_(a.in[I_OV0][col] + v));
                else GG[(size_t)row * D + col] = f2bf(v); } }
    }
}

DEVI void n_rwkv_unit(const Ctx& c, const PArgs& a, int j, int hd, int row0, int ntok, const float* S0, float* Sout) {
    const bf16* R = (const bf16*)(c.ws + WS_R); const bf16* Kb = (const bf16*)(c.ws + WS_K);
    const bf16* VF = (const bf16*)((unsigned char*)c.out + DO_VFIRST); const bf16* Vb = j == 0 ? VF : (const bf16*)(c.ws + WS_V);
    const float* WD = (const float*)(c.ws + WS_WDEC); const bf16* AG = (const bf16*)(c.ws + WS_AG); const bf16* VG = (const bf16*)(c.ws + WS_VG); const bf16* GG = (const bf16*)(c.ws + WS_GG);
    bf16* O = (bf16*)(c.ws + WS_O);
    LAS float* rs_ = (LAS float*)c.lds;
    LAS float* ws_ = rs_ + 512; LAS float* ks_ = ws_ + 512; LAS float* vs_ = ks_ + 512; LAS float* as_ = vs_ + 512; LAS float* bs_ = as_ + 512; LAS float* ys_ = bs_ + 512; LAS float* bon = ys_ + 512;
    const int i = c.tid >> 3, q = c.tid & 7;
    const int st = c.wave, sc = c.lane, ch = hd * 64 + sc;
    const float kkc = a.in[I_OKK][(size_t)j * D + ch], kac = a.in[I_OKA][(size_t)j * D + ch], rkc = a.in[I_ORK][(size_t)j * D + ch];
    const float gng = a.in[I_OGNG][(size_t)j * D + ch], gnb = a.in[I_OGNB][(size_t)j * D + ch];
    float s[8];
#pragma unroll
    for (int jj = 0; jj < 8; ++jj) s[jj] = 0.f;
    if (S0) {
#pragma unroll
        for (int jj = 0; jj < 8; ++jj) s[jj] = S0[(size_t)i * 64 + 8 * q + jj]; }
    for (int t0 = 0; t0 < ntok; t0 += 8) {
        __syncthreads();
        const int row = row0 + t0 + st; const bool valid = t0 + st < ntok;
        float gg = 0.f;
        { float r = 0.f, k = 0.f, v = 0.f, w = 1.f, ag = 0.f;
          if (valid) { const size_t o = (size_t)row * D + ch; r = bf2f(R[o]); k = bf2f(Kb[o]); v = bf2f(Vb[o]); w = WD[o]; ag = bf2f(AG[o]); gg = bf2f(GG[o]);
              if (j == 1) { const float vf = bf2f(VF[o]); v = v + (vf - v) * bf2f(VG[o]); } }
          float kk = k * kkc; const float ss = wave_sum(kk * kk); kk = kk / sqrtf(fmaxf(ss, 1e-24f));
          const float km = k * (1.f + (ag - 1.f) * kac);
          const float bsum = wave_sum(r * km * rkc);
          rs_[st * 64 + sc] = r; ws_[st * 64 + sc] = w; ks_[st * 64 + sc] = km; vs_[st * 64 + sc] = v; as_[st * 64 + sc] = -kk; bs_[st * 64 + sc] = kk * ag;
          if (sc == 0) bon[st] = bsum; }
        __syncthreads();
        for (int tt = 0; tt < 8; ++tt) {
            if (t0 + tt < ntok) {
                float sa = 0.f;
#pragma unroll
                for (int jj = 0; jj < 8; ++jj) sa += s[jj] * as_[tt * 64 + 8 * q + jj];
                sa += __shfl_xor(sa, 1); sa += __shfl_xor(sa, 2); sa += __shfl_xor(sa, 4);
                const float vi = vs_[tt * 64 + i]; float y = 0.f;
#pragma unroll
                for (int jj = 0; jj < 8; ++jj) { const int cj = tt * 64 + 8 * q + jj; s[jj] = s[jj] * ws_[cj] + sa * bs_[cj] + vi * ks_[cj]; y += s[jj] * rs_[cj]; }
                y += __shfl_xor(y, 1); y += __shfl_xor(y, 2); y += __shfl_xor(y, 4);
                if (q == 0) ys_[tt * 64 + i] = y;
            }
        }
        __syncthreads();
        if (valid) {
            const float y = ys_[st * 64 + sc];
            const float mu = wave_sum(y) * (1.f / 64.f); const float dy = y - mu; const float var = wave_sum(dy * dy) * (1.f / 64.f);
            float o = dy / sqrtf(var + 64e-5f) * gng + gnb;
            o = (o + bon[st] * vs_[st * 64 + sc]) * gg;
            O[(size_t)row * D + ch] = f2bf(o);
        }
    }
#pragma unroll
    for (int jj = 0; jj < 8; ++jj) Sout[(size_t)i * 64 + 8 * q + jj] = s[jj];
    __syncthreads();
}
DEVI void n_odd_scan(const Ctx& c, const PArgs& a, int li) {
    const int j = li >> 1;
    const int NU = 128 + 2048;
    for (int u = c.bid; u < NU; u += c.G) {
        const bool pr = u < 128; const int v = pr ? u : u - 128, b = v >> 4, hd = v & 15;
        const float* S0 = pr ? nullptr : a.in[I_SRWKV] + ((size_t)(j * BS + b) * 16 + hd) * 4096;
        float* So = pr ? c.out + O_RWKVP + ((size_t)(j * BP + b) * 16 + hd) * 4096 : c.out + O_RWKVS + ((size_t)(j * BS + b) * 16 + hd) * 4096;
        n_rwkv_unit(c, a, j, hd, pr ? b * TP : MP + b, pr ? TP : 1, S0, So);
    }
}

DEVI void n_final(const Ctx& c, const PArgs& a) {
    const bf16* XB = (const bf16*)(c.ws + WS_XB); const float* RS = (const float*)(c.ws + WS_RS); const float* gain = a.in[I_NFIN];
    const int gw = c.bid * NWAVES + c.wave, NGW = c.G * NWAVES;
    for (int row = gw; row < M; row += NGW) {
        float* dst;
        if (row < MP) { const int b = row / TP, t = row % TP; if (t < NMETA) continue; dst = c.out + O_YP + ((size_t)b * SEQ + (t - NMETA)) * D; }
        else dst = c.out + O_YS + (size_t)(row - MP) * D;
        const float rs = row_rstd(RS, row);
#pragma unroll
        for (int q = 0; q < 4; ++q) { const int col = q * 256 + c.lane * 4;
            const u32x2 xw_ = *(const u32x2*)(XB + (size_t)row * D + col); const f32x4 yv_ = (f32x4){__uint_as_float(xw_.x << 16), __uint_as_float(xw_.x & 0xffff0000u), __uint_as_float(xw_.y << 16), __uint_as_float(xw_.y & 0xffff0000u)} * rs * *(const f32x4*)(gain + col); __builtin_nontemporal_store(yv_, (f32x4*)(dst + col)); }
    }
}

namespace pg8 {
typedef short bf16x8 __attribute__((ext_vector_type(8)));
constexpr int BM = 256, BK = 64, HALF = 128, HTB = HALF * BK * 2, STAGE_BYTES = 8 * HTB, NXCD = 8, WGM = 8;
__host__ __device__ __forceinline__ int lds_byte(int r, int c) { const int st = (r >> 4) * 2 + (c >> 5), rr = r & 15, cc = c & 31, ob = rr * 64 + cc * 2; return st * 1024 + (ob ^ (((ob >> 9) & 1) << 5)); }
__host__ __device__ __forceinline__ void stage_rc(int b, int& R, int& C) { const int st = b / 1024, sb = b % 1024, swz = sb ^ (((sb >> 9) & 1) << 5); R = (st >> 1) * 16 + swz / 64; C = (st & 1) * 32 + (swz % 64) / 2; }
__host__ __device__ __forceinline__ int perm32(int rho) { const int n = rho >> 4, i = rho & 15; return 8 * (i >> 2) + 4 * n + (i & 3); }
struct Unit { int pm, pn; };
struct Gemm { const bf16* A; const bf16* Bt; int M, N, K, lda; unsigned long long asel; size_t astride; };
struct StaticOrder {
    int nM, nN, nwg, G, c;
    __device__ __forceinline__ void init(int M_, int N_, int G_, int c_) { nM = M_ / BM; nN = N_ / BM; nwg = nM * nN; G = G_; c = c_; }
    __device__ __forceinline__ bool next(int i, Unit& u) const {
        const long L = (long)i * G + c; if (L >= nwg) return false;
        int wgid = (int)L; { const int q = nwg / NXCD, r = nwg % NXCD, xcd = wgid % NXCD, off = wgid / NXCD; wgid = (xcd < r ? xcd * (q + 1) : r * (q + 1) + (xcd - r) * q) + off; }
        const int nig = WGM * nN, gid = wgid / nig, fm = gid * WGM, gsz = (nM - fm) < WGM ? (nM - fm) : WGM;
        u.pm = fm + ((wgid % nig) % gsz); u.pn = (wgid % nig) / gsz; return true;
    }
};
DEVI unsigned cvt_pk_bf16(float lo, float hi) { return pk2(lo, hi); }

template <class Epi>
DEVI void gemm_phase(LAS unsigned char* lds, const int tid, const Gemm g, const StaticOrder& S, const Epi& E) {
    const int wid = __builtin_amdgcn_readfirstlane(tid >> 6), lane = tid & 63, wr = wid >> 2, wc = wid & 3, fr = lane & 15, fq = lane >> 4;
    const int K = g.K, nt = K / BK, lda = g.lda;
    unsigned voffA[2], voffB[2];
#pragma unroll
    for (int i = 0; i < 2; ++i) { int R, C; stage_rc(tid * 16 + i * 8192, R, C); const int Rb = Epi::PERM ? ((R & ~31) + perm32(R & 31)) : R;
        voffA[i] = (unsigned)(R * lda + C) * 2u; voffB[i] = (unsigned)(Rb * K + C) * 2u; }
    const size_t kstep = (size_t)(BK * 2);
    const size_t hstepA = (size_t)HALF * lda * 2, hstepB = (size_t)HALF * K * 2;
    const size_t tstepA = 2 * hstepA, tstepB = 2 * hstepB;
    const unsigned ldsw = (unsigned)wid * 1024u;
    const int aoff = lds_byte(wr * 64 + fr, fq * 8), boff = lds_byte(wc * 32 + fr, fq * 8);
#define PG8_SA(b, h) (((b) * 2 + (h)) * HTB)
#define PG8_SB(b, h) ((4 + (b) * 2 + (h)) * HTB)
#define PG8_STAGE(bufoff, gbase, voff) do { _Pragma("unroll") for (int _i = 0; _i < 2; ++_i) \
        __builtin_amdgcn_global_load_lds((const unsigned*)((const char*)(gbase) + (voff)[_i]), (LAS unsigned*)(lds + (bufoff) + ldsw + _i * 8192), 16, 0, 0); } while (0)
#define PG8_LDA(dst, b, h) do { _Pragma("unroll") for (int m = 0; m < 4; ++m) _Pragma("unroll") for (int k = 0; k < 2; ++k) dst[m][k] = *(const LAS bf16x8*)(lds + PG8_SA(b, h) + aoff + m * 2048 + k * 1024); } while (0)
#define PG8_LDB(dst, b, h) do { _Pragma("unroll") for (int n = 0; n < 2; ++n) _Pragma("unroll") for (int k = 0; k < 2; ++k) dst[n][k] = *(const LAS bf16x8*)(lds + PG8_SB(b, h) + boff + n * 2048 + k * 1024); } while (0)
#define PG8_MMA(ai, bj, At, Bt) do { __builtin_amdgcn_s_setprio(1); _Pragma("unroll") for (int m = 0; m < 4; ++m) _Pragma("unroll") for (int n = 0; n < 2; ++n) _Pragma("unroll") for (int k = 0; k < 2; ++k) \
        acc[ai][bj][m][n] = __builtin_amdgcn_mfma_f32_16x16x32_bf16(Bt[n][k], At[m][k], acc[ai][bj][m][n], 0, 0, 0); __builtin_amdgcn_s_setprio(0); } while (0)
#define PG8_WAIT_V(n) asm volatile("s_waitcnt vmcnt(" #n ")" ::: "memory")
#define PG8_WAIT_L(n) asm volatile("s_waitcnt lgkmcnt(" #n ")" ::: "memory")
#define PG8_BAR __builtin_amdgcn_s_barrier()
#define PG8_SCHED __builtin_amdgcn_sched_barrier(0)
#define PG8_ABASE(u) ((const char*)(g.A + (size_t)((g.asel >> (4 * (u).pn)) & 15ull) * g.astride) + (size_t)(u).pm * tstepA)
    Unit cur, nxt; int ui = 0;
    if (!S.next(0, cur)) return;
    f32x4 acc[2][2][4][2];
#pragma unroll
    for (int a = 0; a < 2; ++a)
#pragma unroll
        for (int b = 0; b < 2; ++b)
#pragma unroll
            for (int m = 0; m < 4; ++m)
#pragma unroll
                for (int n = 0; n < 2; ++n) acc[a][b][m][n] = (f32x4){0.f, 0.f, 0.f, 0.f};
    bf16x8 At[4][2], B0[2][2], B1[2][2];
    const char* cA = PG8_ABASE(cur); const char* cB = (const char*)g.Bt + (size_t)cur.pn * tstepB;
    PG8_STAGE(PG8_SB(0, 0), cB, voffB); PG8_STAGE(PG8_SB(0, 1), cB + hstepB, voffB); PG8_STAGE(PG8_SA(0, 0), cA, voffA); PG8_STAGE(PG8_SA(0, 1), cA + hstepA, voffA);
    if (wr == 1) PG8_BAR;
    PG8_WAIT_V(2); PG8_BAR;
    PG8_STAGE(PG8_SB(1, 0), cB + kstep, voffB); PG8_STAGE(PG8_SA(1, 0), cA + kstep, voffA); PG8_STAGE(PG8_SB(1, 1), cB + hstepB + kstep, voffB);
    PG8_WAIT_V(6); PG8_BAR;
    for (;;) {
        const bool has_next = S.next(ui + 1, nxt);
        const char* nA = has_next ? PG8_ABASE(nxt) : cA; const char* nB = has_next ? (const char*)g.Bt + (size_t)nxt.pn * tstepB : cB;
        for (int t = 0; t < nt; t += 2) {
            const bool last = (t == nt - 2);
            const char* a1 = cA + (size_t)(t + 1) * kstep;
            const char* a2 = last ? nA : cA + (size_t)(t + 2) * kstep; const char* b2 = last ? nB : cB + (size_t)(t + 2) * kstep;
            const char* a3 = a2 + kstep; const char* b3 = b2 + kstep;
            PG8_LDB(B0, 0, 0); PG8_LDB(B1, 0, 1); PG8_SCHED; PG8_LDA(At, 0, 0); PG8_STAGE(PG8_SA(1, 1), a1 + hstepA, voffA);
            PG8_WAIT_V(8); PG8_WAIT_L(0); PG8_BAR; PG8_MMA(0, 0, At, B0); PG8_MMA(0, 1, At, B1); PG8_BAR; PG8_SCHED;
            PG8_LDA(At, 0, 1); PG8_STAGE(PG8_SB(0, 0), b2, voffB); PG8_STAGE(PG8_SB(0, 1), b2 + hstepB, voffB); PG8_STAGE(PG8_SA(0, 0), a2, voffA);
            PG8_WAIT_V(8); PG8_WAIT_L(0); PG8_BAR; PG8_MMA(1, 0, At, B0); PG8_MMA(1, 1, At, B1); PG8_BAR; PG8_SCHED;
            PG8_LDB(B0, 1, 0); PG8_LDB(B1, 1, 1); PG8_SCHED; PG8_LDA(At, 1, 0); PG8_STAGE(PG8_SA(0, 1), a2 + hstepA, voffA);
            PG8_WAIT_V(8); PG8_WAIT_L(0); PG8_BAR; PG8_MMA(0, 0, At, B0); PG8_MMA(0, 1, At, B1); PG8_BAR; PG8_SCHED;
            PG8_LDA(At, 1, 1); PG8_STAGE(PG8_SB(1, 0), b3, voffB); PG8_STAGE(PG8_SB(1, 1), b3 + hstepB, voffB); PG8_STAGE(PG8_SA(1, 0), a3, voffA);
            PG8_WAIT_V(8); PG8_WAIT_L(0); PG8_BAR; PG8_MMA(1, 0, At, B0); PG8_MMA(1, 1, At, B1); PG8_BAR; PG8_SCHED;
        }
        if (wr == 0) PG8_BAR;
        E(acc, cur, wr, wc, fr, fq);
        if (!has_next) break;
#pragma unroll
        for (int a = 0; a < 2; ++a)
#pragma unroll
            for (int b = 0; b < 2; ++b)
#pragma unroll
                for (int m = 0; m < 4; ++m)
#pragma unroll
                    for (int n = 0; n < 2; ++n) acc[a][b][m][n] = (f32x4){0.f, 0.f, 0.f, 0.f};
        cur = nxt; cA = nA; cB = nB; ++ui;
        if (wr == 1) PG8_BAR;
    }
    PG8_WAIT_V(0);
    PG8_BAR;
#undef PG8_SA
#undef PG8_SB
#undef PG8_STAGE
#undef PG8_LDA
#undef PG8_LDB
#undef PG8_MMA
#undef PG8_WAIT_V
#undef PG8_WAIT_L
#undef PG8_BAR
#undef PG8_SCHED
#undef PG8_ABASE
}
}

constexpr size_t WB_WIN = 0, WB_WOUT = 20 * MiB, WB_G5 = 28 * MiB, WB_G6 = 44 * MiB, WB_WO = 48 * MiB, WB_WUP = 52 * MiB, WB_WDN = 96 * MiB;
constexpr size_t SZ_WIN = 10 * MiB, SZ_WOUT = 4 * MiB, SZ_G5 = 8 * MiB, SZ_G6 = 2 * MiB, SZ_WO = 2 * MiB, SZ_WUP = 11 * MiB, SZ_WDN = (size_t)D * DFF * 2;
static_assert(WB_WDN + 4 * SZ_WDN <= 119 * MiB, "weight map");

struct WDesc { const float* W; const float* gain; bf16* dst; int ldw, Kv, Kd, Nv, Nd, map; };
DEVI WDesc wdesc(const PArgs& a, unsigned char* ws, int id) {
    WDesc w; w.gain = nullptr; w.map = 0; unsigned char* wb = ws + WS_WB;
    if (id < 2) { const int j = id; w.W = a.in[I_EWIN] + (size_t)j * D * NIN; w.ldw = NIN; w.Kv = w.Kd = D; w.Nv = w.Nd = NIN; w.gain = a.in[I_NMIX] + (size_t)(2 * j) * D; w.dst = (bf16*)(wb + WB_WIN + j * SZ_WIN); w.map = 1; }
    else if (id < 4) { const int j = id - 2; w.W = a.in[I_EWOUT] + (size_t)j * 2048 * D; w.ldw = D; w.Kv = w.Kd = 2048; w.Nv = w.Nd = D; w.dst = (bf16*)(wb + WB_WOUT + j * SZ_WOUT); }
    else if (id < 18) { const int q = id - 4, j = q / 7, p = q % 7; bf16* base = (bf16*)(wb + WB_G5 + j * SZ_G5); w.Kv = w.Kd = D;
        if (p < 3) { w.W = a.in[p == 0 ? I_OWR : (p == 1 ? I_OWK : I_OWV)] + (size_t)j * D * D; w.ldw = D; w.Nv = w.Nd = D; w.dst = base + (size_t)p * 1024 * D; }
        else if (p == 3) { w.W = a.in[I_OG1] + (size_t)j * D * 128; w.ldw = 128; w.Nv = 128; w.Nd = 256; w.dst = base + (size_t)3072 * D; }
        else if (p == 4) { w.W = a.in[I_OW1] + (size_t)j * D * 64; w.ldw = 64; w.Nv = 64; w.Nd = 256; w.dst = base + (size_t)3328 * D; }
        else if (p == 5) { w.W = a.in[I_OA1] + (size_t)j * D * 64; w.ldw = 64; w.Nv = 64; w.Nd = 256; w.dst = base + (size_t)3584 * D; }
        else { w.W = a.in[I_OV1]; w.ldw = 32; w.Nv = 32; w.Nd = j == 1 ? 256 : 0; w.dst = base + (size_t)3840 * D; } }
    else if (id < 26) { const int q = id - 18, j = q >> 2, p = q & 3; bf16* base = (bf16*)(wb + WB_G6 + j * SZ_G6); w.Kd = 256; w.ldw = D; w.Nv = w.Nd = D; w.dst = base + (size_t)p * 1024 * 256;
        if (p == 0) { w.W = a.in[I_OW2] + (size_t)j * 64 * D; w.Kv = 64; }
        else if (p == 1) { w.W = a.in[I_OA2] + (size_t)j * 64 * D; w.Kv = 64; }
        else if (p == 2) { w.W = a.in[I_OG2] + (size_t)j * 128 * D; w.Kv = 128; }
        else { w.W = a.in[I_OV2]; w.Kv = 32; if (j == 0) w.Nd = 0; } }
    else if (id < 28) { const int j = id - 26; w.W = a.in[I_OWO] + (size_t)j * D * D; w.ldw = D; w.Kv = w.Kd = D; w.Nv = w.Nd = D; w.dst = (bf16*)(wb + WB_WO + j * SZ_WO); }
    else if (id < 32) { const int li = id - 28; w.W = a.in[I_FWUP] + (size_t)li * D * NUP; w.ldw = NUP; w.Kv = w.Kd = D; w.Nv = w.Nd = NUP; w.gain = a.in[I_NFFN] + (size_t)li * D; w.dst = (bf16*)(wb + WB_WUP + li * SZ_WUP); w.map = FUSE_ACT ? 2 : 0; }
    else { const int li = id - 32; w.W = a.in[I_FWDN] + (size_t)li * DFF * D; w.ldw = D; w.Kv = w.Kd = DFF; w.Nv = w.Nd = D; w.dst = (bf16*)(wb + WB_WDN + li * SZ_WDN); }
    return w;
}
constexpr int N_WDESC = 36;
DEVI void wprep_item(const WDesc& w, LAS float* scr, int item, int lane) {
    const int nblk = w.Nd / 32, kb = item / nblk, nb = item % nblk, k0 = 64 * kb, n0 = 32 * nb;
    int sc0 = n0;
    if (w.map == 1 && n0 < 1024) { const int t = n0 >> 8, cp = n0 & 255; sc0 = 256 * t + ((cp & 127) >> 6) * 128 + (cp >> 7) * 64 + (cp & 63); }
    if (w.map == 2) { const int t = n0 >> 8, cp = n0 & 255; sc0 = cp < 128 ? 128 * t + cp : DFF + 128 * t + (cp - 128); }
    const bool nvalid = n0 < w.Nv;
#pragma unroll
    for (int i = 0; i < 8; ++i) { const int kk = 8 * i + (lane >> 3), k = k0 + kk; f32x4 v = (f32x4){0.f, 0.f, 0.f, 0.f};
        if (nvalid && k < w.Kv) { v = __builtin_nontemporal_load((const f32x4*)(w.W + (size_t)k * w.ldw + sc0 + 4 * (lane & 7))); if (w.gain) v = v * w.gain[k]; }
        LAS float* d = scr + kk * 33 + 4 * (lane & 7); d[0] = v.x; d[1] = v.y; d[2] = v.z; d[3] = v.w; }
    asm volatile("s_waitcnt lgkmcnt(0)" ::: "memory");
    const int cc = lane & 7;
#pragma unroll
    for (int jx = 0; jx < 4; ++jx) { const int n = (lane >> 3) + 8 * jx; const LAS float* s = scr + (8 * cc) * 33 + n;
        u32x4 o; o.x = pk2(s[0 * 33], s[1 * 33]); o.y = pk2(s[2 * 33], s[3 * 33]); o.z = pk2(s[4 * 33], s[5 * 33]); o.w = pk2(s[6 * 33], s[7 * 33]);
        *(u32x4*)(w.dst + (size_t)(n0 + n) * w.Kd + k0 + 8 * cc) = o; }
    asm volatile("s_waitcnt lgkmcnt(0)" ::: "memory");
}
DEVI void f_wprep(const Ctx& c, const PArgs& a, unsigned long long idmask, int gw, int NGW) {
    LAS float* scr = (LAS float*)(c.lds + c.wave * 16384);
#pragma unroll 1
    for (int id = 0; id < N_WDESC; ++id) {
        if (!((idmask >> id) & 1ull)) continue;
        const WDesc w = wdesc(a, c.ws, id);
        const int nitems = (w.Kd / 64) * (w.Nd / 32);
        const int start = (gw + id * 601) % NGW;
        for (int it = start; it < nitems; it += NGW) wprep_item(w, scr, it, c.lane);
    }
}
constexpr unsigned long long WM_L01 = (1ull << 1) | (1ull << 2) | (0x7full << 4) | (0xfull << 18) | (1ull << 26) | (3ull << 28) | (3ull << 32);
constexpr unsigned long long WM_L23 = (1ull << 3) | (0x7full << 11) | (0xfull << 22) | (1ull << 27) | (3ull << 30) | (3ull << 34);
static_assert((WM_L01 | WM_L23 | 1ull) == (1ull << 36) - 1 && (WM_L01 & WM_L23) == 0, "weight masks");

DEVI u32x4 pack8(const f32x4 a, const f32x4 b) { u32x4 w; w.x = pg8::cvt_pk_bf16(a[0], a[1]); w.y = pg8::cvt_pk_bf16(a[2], a[3]); w.z = pg8::cvt_pk_bf16(b[0], b[1]); w.w = pg8::cvt_pk_bf16(b[2], b[3]); return w; }
DEVI f32x4 map4(const f32x4 v, int act) {
    f32x4 o;
#pragma unroll
    for (int e = 0; e < 4; ++e) o[e] = act == 1 ? siluf_(v[e]) : act == 2 ? geluf_(v[e]) : act == 3 ? sigmoidf_(v[e]) : act == 4 ? tanhf_(v[e]) : v[e];
    return o;
}
struct EpiEvenIn {
    static constexpr bool PERM = true;
    bf16* Z; const float* RS; const float* ROPE;
    DEVI void operator()(const f32x4 (&acc)[2][2][4][2], const pg8::Unit& u, int wr, int wc, int fr, int fq) const {
        const int pn = u.pn;
        float rsv[2][4];
#pragma unroll
        for (int ai = 0; ai < 2; ++ai)
#pragma unroll
            for (int m = 0; m < 4; ++m) rsv[ai][m] = row_rstd_q(RS, u.pm * 256 + ai * 128 + wr * 64 + m * 16 + fr, fq);
#pragma unroll
        for (int ai = 0; ai < 2; ++ai)
#pragma unroll
            for (int m = 0; m < 4; ++m) {
                const int row = u.pm * 256 + ai * 128 + wr * 64 + m * 16 + fr; const float rs = rsv[ai][m];
                if (pn < 4) {
                    const int hl = wc >> 1, d0 = (32 * wc + 8 * fq) & 63; const float sc = (pn >= 2 ? 0.08838834764831845f : 1.f) * rs;
                    const f32x4* rp = (const f32x4*)(ROPE + ((size_t)row_pos(row) * 64 + d0) * 2);
                    const f32x4 c0 = rp[0], c1 = rp[1], c2 = rp[2], c3 = rp[3];
                    const f32x4 x1a = acc[ai][0][m][0] * sc, x1b = acc[ai][0][m][1] * sc, x2a = acc[ai][1][m][0] * sc, x2b = acc[ai][1][m][1] * sc;
                    const f32x4 csa = (f32x4){c0[0], c0[2], c1[0], c1[2]}, sna = (f32x4){c0[1], c0[3], c1[1], c1[3]}, csb = (f32x4){c2[0], c2[2], c3[0], c3[2]}, snb = (f32x4){c2[1], c2[3], c3[1], c3[3]};
                    const f32x4 y1a = x1a * csa - x2a * sna, y1b = x1b * csb - x2b * snb, y2a = x1a * sna + x2a * csa, y2b = x1b * snb + x2b * csb;
                    bf16* dst = Z + (size_t)row * NIN + pn * 256 + hl * 128 + d0;
                    *(u32x4*)dst = pack8(y1a, y1b); *(u32x4*)(dst + 64) = pack8(y2a, y2b);
                } else {
                    const int act = (pn >= 8 && pn < 12) ? 1 : (pn >= 16 ? 2 : 0);
#pragma unroll
                    for (int bj = 0; bj < 2; ++bj) { bf16* dst = Z + (size_t)row * NIN + pn * 256 + bj * 128 + wc * 32 + fq * 8;
                        *(u32x4*)dst = pack8(map4(acc[ai][bj][m][0] * rs, act), map4(acc[ai][bj][m][1] * rs, act)); }
                }
            }
    }
};
struct EpiResidual {
    static constexpr bool PERM = false;
    bf16* XB; float* RS;
    DEVI void operator()(const f32x4 (&acc)[2][2][4][2], const pg8::Unit& u, int wr, int wc, int fr, int fq) const {
#pragma unroll
        for (int ai = 0; ai < 2; ++ai)
#pragma unroll
            for (int m = 0; m < 4; ++m) {
                const int row = u.pm * 256 + ai * 128 + wr * 64 + m * 16 + fr; float ss = 0.f;
#pragma unroll
                for (int bj = 0; bj < 2; ++bj)
#pragma unroll
                    for (int n = 0; n < 2; ++n) { const size_t o = (size_t)row * D + u.pn * 256 + bj * 128 + wc * 32 + n * 16 + fq * 4;
                        const u32x2 xo = *(const u32x2*)(XB + o);
                        f32x4 v = acc[ai][bj][m][n]; v[0] += __uint_as_float(xo.x << 16); v[1] += __uint_as_float(xo.x & 0xffff0000u); v[2] += __uint_as_float(xo.y << 16); v[3] += __uint_as_float(xo.y & 0xffff0000u);
                        u32x2 w; w.x = pk2(v[0], v[1]); w.y = pk2(v[2], v[3]); *(u32x2*)(XB + o) = w;
                        ss += (v[0] * v[0] + v[1] * v[1]) + (v[2] * v[2] + v[3] * v[3]); }
                ss += __shfl_xor(ss, 16); ss += __shfl_xor(ss, 32);
                if (fq == 0) RS[(size_t)row * 16 + u.pn * 4 + wc] = ss;
            }
    }
};
struct EpiUp {
    static constexpr bool PERM = true;
    bf16* U; const float* RS;
    DEVI void operator()(const f32x4 (&acc)[2][2][4][2], const pg8::Unit& u, int wr, int wc, int fr, int fq) const {
#pragma unroll
        for (int ai = 0; ai < 2; ++ai)
#pragma unroll
            for (int m = 0; m < 4; ++m) {
                const int row = u.pm * 256 + ai * 128 + wr * 64 + m * 16 + fr; const float rs = row_rstd(RS, row);
#pragma unroll
                for (int bj = 0; bj < 2; ++bj) *(u32x4*)(U + (size_t)row * NUP + u.pn * 256 + bj * 128 + wc * 32 + fq * 8) = pack8(acc[ai][bj][m][0] * rs, acc[ai][bj][m][1] * rs);
            }
    }
};
struct EpiOddIn {
    static constexpr bool PERM = true;
    bf16 *R, *Kb, *Vb, *LM; int j;
    DEVI void operator()(const f32x4 (&acc)[2][2][4][2], const pg8::Unit& u, int wr, int wc, int fr, int fq) const {
        const int pn = u.pn; bf16* base; int pitch, off; float al, be, ga; bool ident, both;
        bf16 *r_ = R, *k_ = Kb, *v_ = Vb, *l_ = LM; asm volatile("" : "+s"(r_), "+s"(k_), "+s"(v_), "+s"(l_));
        if (pn < 12) { base = pn < 4 ? r_ : (pn < 8 ? k_ : v_); pitch = D; off = (pn & 3) * 256; ident = true; both = true; al = 1.f; be = 1.f; ga = 0.f; }
        else { base = l_; pitch = LML; off = pn == 12 ? 0 : (pn == 13 ? 256 : (pn == 14 ? 384 : 128)); ident = pn >= 14; both = pn == 14 || (pn == 12 && j == 0);
               al = pn == 13 ? 2.f : 1.f; be = al; ga = pn == 13 ? -1.f : 0.f; }
        bf16* p0 = base + off + wc * 32 + fq * 8;
#pragma unroll
        for (int ai = 0; ai < 2; ++ai)
#pragma unroll
            for (int m = 0; m < 4; ++m) {
                const int row = u.pm * 256 + ai * 128 + wr * 64 + m * 16 + fr;
#pragma unroll
                for (int bj = 0; bj < 2; ++bj) {
                    f32x4 v0 = acc[ai][bj][m][0], v1 = acc[ai][bj][m][1];
                    if (!ident) {
#pragma unroll
                        for (int e = 0; e < 4; ++e) { v0[e] = al * __builtin_amdgcn_rcpf(1.f + __expf(-be * v0[e])) + ga; v1[e] = al * __builtin_amdgcn_rcpf(1.f + __expf(-be * v1[e])) + ga; } }
                    if (bj == 0 || both) *(u32x4*)(p0 + (size_t)row * pitch + bj * 128) = pack8(v0, v1); }
            }
    }
};
struct EpiDecay {
    static constexpr bool PERM = true;
    float* WD; const float* w0;
    DEVI void operator()(const f32x4 (&acc)[2][2][4][2], const pg8::Unit& u, int wr, int wc, int fr, int fq) const {
        const int cb = u.pn * 256 + wc * 32 + fq * 8;
#pragma unroll
        for (int bj = 0; bj < 2; ++bj) {
            const f32x4 bia0 = *(const f32x4*)(w0 + cb + bj * 128), bia1 = *(const f32x4*)(w0 + cb + bj * 128 + 4);
#pragma unroll
            for (int ai = 0; ai < 2; ++ai)
#pragma unroll
                for (int m = 0; m < 4; ++m) {
                    const int row = u.pm * 256 + ai * 128 + wr * 64 + m * 16 + fr; const size_t o = (size_t)row * D + cb + bj * 128;
                    f32x4 v0_ = acc[ai][bj][m][0] + bia0, v1_ = acc[ai][bj][m][1] + bia1;
#pragma unroll
                    for (int e = 0; e < 4; ++e) { v0_[e] = __expf(-0.6065306597126334f * __builtin_amdgcn_rcpf(1.f + __expf(-v0_[e]))); v1_[e] = __expf(-0.6065306597126334f * __builtin_amdgcn_rcpf(1.f + __expf(-v1_[e]))); }
                    *(f32x4*)(WD + o) = v0_; *(f32x4*)(WD + o + 4) = v1_;
                }
        }
    }
};
struct EpiGate {
    static constexpr bool PERM = true;
    bf16* AG; const float *a0, *v0;
    DEVI void operator()(const f32x4 (&acc)[2][2][4][2], const pg8::Unit& u, int wr, int wc, int fr, int fq) const {
        const int grp = u.pn >> 2; const int cb = (u.pn & 3) * 256 + wc * 32 + fq * 8;
        const float* bp = grp == 2 ? v0 : a0; const float bsc = grp == 1 ? 0.f : 1.f;
        bf16* ob = AG + (size_t)grp * M * D;
#pragma unroll
        for (int bj = 0; bj < 2; ++bj) {
            const f32x4 bia0 = *(const f32x4*)(bp + cb + bj * 128) * bsc, bia1 = *(const f32x4*)(bp + cb + bj * 128 + 4) * bsc;
#pragma unroll
            for (int ai = 0; ai < 2; ++ai)
#pragma unroll
                for (int m = 0; m < 4; ++m) {
                    const int row = u.pm * 256 + ai * 128 + wr * 64 + m * 16 + fr; const size_t o = (size_t)row * D + cb + bj * 128;
                    f32x4 v0_ = acc[ai][bj][m][0] + bia0, v1_ = acc[ai][bj][m][1] + bia1;
                    if (grp != 1) {
#pragma unroll
                        for (int e = 0; e < 4; ++e) { v0_[e] = __builtin_amdgcn_rcpf(1.f + __expf(-v0_[e])); v1_[e] = __builtin_amdgcn_rcpf(1.f + __expf(-v1_[e])); } }
                    *(u32x4*)(ob + o) = pack8(v0_, v1_);
                }
        }
    }
};

DEVI void f_even_in(const Ctx& c, int li) {
    const int j = li >> 1;
    pg8::Gemm g{(const bf16*)(c.ws + WS_XB), (const bf16*)(c.ws + WS_WB + WB_WIN + j * SZ_WIN), M, NIN, D, D, 0ull, 0};
    pg8::StaticOrder S; S.init(M, NIN, c.G, c.bid);
    EpiEvenIn E{(bf16*)(c.ws + WS_Z), (const float*)(c.ws + WS_RS), (const float*)(c.ws + WS_ROPE)};
    pg8::gemm_phase<EpiEvenIn>(c.lds, c.tid, g, S, E);
}
DEVI void f_gemm_residual(const Ctx& c, const bf16* A, int lda, const bf16* Bt, int K, bool wxb) {
    pg8::Gemm g{A, Bt, M_MAIN, D, K, lda, 0ull, 0};
    pg8::StaticOrder S; S.init(M_MAIN, D, c.G, c.bid);
    (void)wxb; EpiResidual E{(bf16*)(c.ws + WS_XB), (float*)(c.ws + WS_RS)};
    pg8::gemm_phase<EpiResidual>(c.lds, c.tid, g, S, E);
}
DEVI void f_ffn_up(const Ctx& c, int li) {
    pg8::Gemm g{(const bf16*)(c.ws + WS_XB), (const bf16*)(c.ws + WS_WB + WB_WUP + li * SZ_WUP), M, NUP, D, D, 0ull, 0};
    pg8::StaticOrder S; S.init(M, NUP, c.G, c.bid);
    EpiUp E{(bf16*)(c.ws + WS_U), (const float*)(c.ws + WS_RS)};
    pg8::gemm_phase<EpiUp>(c.lds, c.tid, g, S, E);
}
DEVI void f_odd_in(const Ctx& c, int li) {
    const int j = li >> 1, N5 = j == 0 ? 3840 : 4096;
    pg8::Gemm g{(const bf16*)(c.ws + WS_XMIX), (const bf16*)(c.ws + WS_WB + WB_G5 + j * SZ_G5), M, N5, D, D, 0x3415333322220000ull, (size_t)M * D};
    pg8::StaticOrder S; S.init(M, N5, c.G, c.bid);
    EpiOddIn E{(bf16*)(c.ws + WS_R), (bf16*)(c.ws + WS_K), j == 0 ? (bf16*)((unsigned char*)c.out + DO_VFIRST) : (bf16*)(c.ws + WS_V), (bf16*)((unsigned char*)c.out + DO_LMID), j};
    pg8::gemm_phase<EpiOddIn>(c.lds, c.tid, g, S, E);
}
DEVI void f_odd_lora(const Ctx& c, const PArgs& a, int li) {
    const int j = li >> 1;
    const bf16* LM = (const bf16*)((unsigned char*)c.out + DO_LMID); const bf16* W6 = (const bf16*)(c.ws + WS_WB + WB_G6 + j * SZ_G6);
    int K6 = 256; asm volatile("" : "+s"(K6));
    {
        pg8::Gemm g{LM + 256, W6, M, D, K6, LML, 0ull, 0};
        pg8::StaticOrder S; S.init(M, D, c.G, c.bid);
        EpiDecay E{(float*)(c.ws + WS_WDEC), a.in[I_OW0] + (size_t)j * D};
        pg8::gemm_phase<EpiDecay>(c.lds, c.tid, g, S, E);
    }
    {
        const int N6 = j == 0 ? 2048 : 3072;
        pg8::Gemm g{LM, W6 + (size_t)1024 * 256, M, N6, K6, LML, 0x111100003333ull, 128};
        int c2 = c.bid + (c.G >> 1); if (c2 >= c.G) c2 -= c.G;
        pg8::StaticOrder S; S.init(M, N6, c.G, c2);
        EpiGate E{(bf16*)(c.ws + WS_AG), a.in[I_OA0] + (size_t)j * D, a.in[I_OV0]};
        pg8::gemm_phase<EpiGate>(c.lds, c.tid, g, S, E);
    }
}

typedef short bf16x8_t __attribute__((ext_vector_type(8)));
constexpr int LRU_XS = 0, LRU_AI = 33792, LRU_GT = LRU_AI + 128 * 136 * 2, LRU_END = LRU_GT + 128 * 256;
static_assert(LRU_END + 8 * 1024 <= RING_BYTES, "lru lds");
#define LWAIT_() asm volatile("s_waitcnt lgkmcnt(0)" ::: "memory")
#define LDS_BAR() asm volatile("s_waitcnt lgkmcnt(0)\n\ts_barrier" ::: "memory")
DEVI void f_lru_unit(const Ctx& c, const PArgs& a, int j, int g, bool sample, int b) {
    const bf16* Z = (const bf16*)(c.ws + WS_Z); bf16* MIX = (bf16*)(c.ws + WS_MIX);
    LAS unsigned char* XS = c.lds + LRU_XS; LAS unsigned char* AI = c.lds + LRU_AI; LAS unsigned char* GT = c.lds + LRU_GT;
    const int w = c.wave, fr = c.lane & 15, fq = c.lane >> 4, col = 16 * w + fr, ch = g * 128 + col;
    const int row0 = sample ? MP : b * TP, ntok = sample ? 128 : TP, nchunks = sample ? 1 : (TP + 127) / 128;
    bf16x8_t Bw[2][4];
#pragma unroll
    for (int gate = 0; gate < 2; ++gate) {
        const float* Wg = a.in[gate == 0 ? I_EWA : I_EWX] + (size_t)(j * 8 + g) * 128 * 128;
        __syncthreads();
#pragma unroll 2
        for (int i = 0; i < 8; ++i) { const unsigned p = (unsigned)(i * NT + c.tid); *(LAS f32x4*)(c.lds + p * 16u) = *(const f32x4*)(Wg + p * 4u); }
        __syncthreads();
#pragma unroll
        for (int ks = 0; ks < 4; ++ks) { bf16x8_t vv;
#pragma unroll
            for (int jj = 0; jj < 8; ++jj) vv[jj] = (short)f2bf(*(const LAS float*)(c.lds + ((32 * ks + 8 * fq + jj) * 128 + col) * 4));
            Bw[gate][ks] = vv; }
    }
    const float ba = a.in[I_EBA][(size_t)j * 1024 + ch], bx = a.in[I_EBX][(size_t)j * 1024 + ch], sp8 = 8.f * softplusf_(-a.in[I_ELAM][(size_t)j * 1024 + ch]);
    const int cc = c.tid & 127, rq = c.tid >> 7, cch = g * 128 + cc;
    const float* CW = a.in[I_ECW] + (size_t)j * 4 * 1024;
    const float cw0 = CW[cch], cw1 = CW[1024 + cch], cw2 = CW[2048 + cch], cw3 = CW[3072 + cch], cb = a.in[I_ECB][(size_t)j * 1024 + cch];
    float carry = 0.f;
    u32x4 pfx[5], pfg[4];
    const bf16* zx = Z + (size_t)row0 * NIN + 3072 + g * 128; const bf16* zg = Z + (size_t)row0 * NIN + 4096 + g * 128;
#define LRU_PREFETCH(t0) do { _Pragma("unroll") for (int i = 0; i < 5; ++i) { const int p = i * NT + c.tid, r = p >> 4, q = p & 15; const int t = (t0) - 3 + r; \
            pfx[i] = (u32x4){0u, 0u, 0u, 0u}; if (r < 131 && t >= 0) pfx[i] = *(const u32x4*)(zx + (unsigned)(t * NIN + q * 8)); } \
        _Pragma("unroll") for (int i = 0; i < 4; ++i) { const int p = i * NT + c.tid, r = p >> 4, q = p & 15; pfg[i] = *(const u32x4*)(zg + (unsigned)(((t0) + r) * NIN + q * 8)); } } while (0)
    LRU_PREFETCH(0);
    for (int ci = 0; ci < nchunks; ++ci) {
        const int t0 = ci * 128, nv = (ntok - t0) < 128 ? (ntok - t0) : 128;
        __syncthreads();
#pragma unroll
        for (int i = 0; i < 5; ++i) { const int p = i * NT + c.tid; if (p < 131 * 16) *(LAS u32x4*)(XS + p * 16) = pfx[i]; }
#pragma unroll
        for (int i = 0; i < 4; ++i) { const int p = i * NT + c.tid; *(LAS u32x4*)(GT + p * 16) = pfg[i]; }
        __syncthreads();
        if (ci + 1 < nchunks) LRU_PREFETCH(t0 + 128);
        if (!sample) {
            float x0 = bf2f(*(const LAS bf16*)(XS + ((rq * 32 + 0) * 128 + cc) * 2)), x1 = bf2f(*(const LAS bf16*)(XS + ((rq * 32 + 1) * 128 + cc) * 2)), x2 = bf2f(*(const LAS bf16*)(XS + ((rq * 32 + 2) * 128 + cc) * 2));
#pragma unroll 8
            for (int i = 0; i < 32; ++i) { const int lr = rq * 32 + i; const float x3 = bf2f(*(const LAS bf16*)(XS + ((lr + 3) * 128 + cc) * 2));
                *(LAS bf16*)(AI + (lr * 136 + cc) * 2) = f2bf(cb + cw3 * x3 + cw2 * x2 + cw1 * x1 + cw0 * x0); x0 = x1; x1 = x2; x2 = x3; }
        } else {
            const float* SC = a.in[I_SLCONV] + (size_t)j * BS * 3 * 1024 + cch; float* SCO = c.out + O_LCONVS + (size_t)j * BS * 3 * 1024 + cch;
#pragma unroll 2
            for (int i = 0; i < 32; ++i) { const int lr = rq * 32 + i; const unsigned so = (unsigned)(lr * 3 * 1024);
                const float h0 = SC[so], h1 = SC[so + 1024u], h2 = SC[so + 2048u], x3 = bf2f(*(const LAS bf16*)(XS + ((lr + 3) * 128 + cc) * 2));
                *(LAS bf16*)(AI + (lr * 136 + cc) * 2) = f2bf(cb + cw3 * x3 + cw2 * h2 + cw1 * h1 + cw0 * h0);
                SCO[so] = h1; SCO[so + 1024u] = h2; SCO[so + 2048u] = x3; }
        }
        __syncthreads();
#pragma unroll 1
        for (int m = 0; m < 8; ++m) {
            f32x4 accr_ = (f32x4){0.f, 0.f, 0.f, 0.f}, acci_ = (f32x4){0.f, 0.f, 0.f, 0.f};
#pragma unroll
            for (int ks = 0; ks < 4; ++ks) { const bf16x8_t af = *(const LAS bf16x8_t*)(AI + ((16 * m + fr) * 136 + 32 * ks + 8 * fq) * 2);
                accr_ = __builtin_amdgcn_mfma_f32_16x16x32_bf16(af, Bw[0][ks], accr_, 0, 0, 0);
                acci_ = __builtin_amdgcn_mfma_f32_16x16x32_bf16(af, Bw[1][ks], acci_, 0, 0, 0); }
            float av[4], uv[4];
#pragma unroll
            for (int r = 0; r < 4; ++r) { const int lr = 16 * m + 4 * fq + r;
                const float xcv = bf2f(*(const LAS bf16*)(AI + (lr * 136 + col) * 2));
                const float rg = sigmoidf_(accr_[r] + ba), ig = sigmoidf_(acci_[r] + bx);
                const float la = -sp8 * rg, t2 = 2.f * la;
                const float em1 = t2 > -0.02f ? t2 * (1.f + t2 * (0.5f + t2 * 0.16666667f)) : __expf(t2) - 1.f;
                av[r] = __expf(la); uv[r] = sqrtf(-em1) * (ig * xcv); }
            float hv[4];
            if (!sample) {
                const float Ai = av[0] * av[1] * av[2] * av[3], Ui = ((uv[0] * av[1] + uv[1]) * av[2] + uv[2]) * av[3] + uv[3];
                LAS f32x2_t* cs = (LAS f32x2_t*)(c.lds + LRU_END + w * 1024 + (m & 1) * 512);
                cs[fq * 16 + fr] = (f32x2_t){Ai, Ui};
                LWAIT_();
                const f32x2_t c0 = cs[fr], c1 = cs[16 + fr], c2 = cs[32 + fr], c3 = cs[48 + fr];
                const float h0e = c0.x * carry + c0.y, h1e = c1.x * h0e + c1.y, h2e = c2.x * h1e + c2.y, h3e = c3.x * h2e + c3.y;
                const float hin = fq == 0 ? carry : (fq == 1 ? h0e : (fq == 2 ? h1e : h2e));
                carry = h3e;
                hv[0] = av[0] * hin + uv[0]; hv[1] = av[1] * hv[0] + uv[1]; hv[2] = av[2] * hv[1] + uv[2]; hv[3] = av[3] * hv[2] + uv[3];
                if (nv < 128 && m == ((TP % 128) - 1) / 16 && fq == (((TP % 128) - 1) & 15) / 4) c.out[O_LRUP + (size_t)(j * BP + b) * 1024 + ch] = hv[((TP % 128) - 1) & 3];
            } else {
#pragma unroll
                for (int r = 0; r < 4; ++r) { const int lr = 16 * m + 4 * fq + r; const unsigned so = (unsigned)(lr * 1024);
                    hv[r] = av[r] * (a.in[I_SLRU] + (size_t)j * BS * 1024 + ch)[so] + uv[r]; (c.out + O_LRUS + (size_t)j * BS * 1024 + ch)[so] = hv[r]; }
            }
#pragma unroll
            for (int r = 0; r < 4; ++r) { const int lr = 16 * m + 4 * fq + r; LAS bf16* gp = (LAS bf16*)(GT + (lr * 128 + col) * 2); *gp = f2bf(hv[r] * bf2f(*gp)); }
        }
        if (!sample && nv < 128 && c.tid < 128) {
#pragma unroll
            for (int k = 0; k < 3; ++k) c.out[O_LCONVP + ((size_t)(j * BP + b) * 3 + k) * 1024 + g * 128 + c.tid] = bf2f(*(const LAS bf16*)(XS + ((nv + k) * 128 + c.tid) * 2));
        }
        __syncthreads();
#pragma unroll
        for (int i = 0; i < 4; ++i) { const int p = i * NT + c.tid, r = p >> 4, q = p & 15;
            if (r < nv) *(u32x4*)(MIX + (size_t)(row0 + t0 + r) * 2048 + 1024 + g * 128 + q * 8) = *(const LAS u32x4*)(GT + p * 16); }
    }
#undef LRU_PREFETCH
    __syncthreads();
}

#define DPP_F(v, ctrl) __builtin_bit_cast(float, __builtin_amdgcn_update_dpp(0, __builtin_bit_cast(int, (v)), (ctrl), 0xF, 0xF, true))
DEVI float red8(float x) { x += DPP_F(x, 0xB1); x += DPP_F(x, 0x4E); x += DPP_F(x, 0x141); return x; }
DEVI float red32(float x) { x += DPP_F(x, 0xB1); x += DPP_F(x, 0x4E); x += DPP_F(x, 0x141); x += DPP_F(x, 0x140); x += __shfl_xor(x, 16); return x; }
typedef unsigned long long u64x2_t __attribute__((ext_vector_type(2)));
DEVI void tr_frag2(unsigned tile, int pitch, int krow0, int col0, int fr, int fq, bf16x8_t& f0, bf16x8_t& f1) {
    const unsigned base = tile + (unsigned)((krow0 + 8 * fq + (fr >> 2)) * pitch + (col0 + 4 * (fr & 3)) * 2);
    unsigned long long a0, a1, b0, b1;
    asm volatile("ds_read_b64_tr_b16 %0, %4\n\tds_read_b64_tr_b16 %1, %5\n\tds_read_b64_tr_b16 %2, %6\n\tds_read_b64_tr_b16 %3, %7\n\ts_waitcnt lgkmcnt(0)"
                 : "=&v"(a0), "=&v"(a1), "=&v"(b0), "=&v"(b1) : "v"(base), "v"(base + 4u * (unsigned)pitch), "v"(base + 32u * (unsigned)pitch), "v"(base + 36u * (unsigned)pitch) : "memory");
    u64x2_t v0; v0.x = a0; v0.y = a1; u64x2_t v1; v1.x = b0; v1.y = b1;
    f0 = __builtin_bit_cast(bf16x8_t, v0); f1 = __builtin_bit_cast(bf16x8_t, v1);
}
DEVI void tr_frag4(unsigned tile, int pitch, int col0, int col1, int fr, int fq, bf16x8_t& f00, bf16x8_t& f01, bf16x8_t& f10, bf16x8_t& f11) {
    const unsigned b0 = tile + (unsigned)((8 * fq + (fr >> 2)) * pitch + (col0 + 4 * (fr & 3)) * 2), b1 = b0 + (unsigned)((col1 - col0) * 2);
    unsigned long long a0, a1, a2, a3, c0, c1, c2, c3;
    asm volatile("ds_read_b64_tr_b16 %0, %8\n\tds_read_b64_tr_b16 %1, %9\n\tds_read_b64_tr_b16 %2, %10\n\tds_read_b64_tr_b16 %3, %11\n\t"
                 "ds_read_b64_tr_b16 %4, %12\n\tds_read_b64_tr_b16 %5, %13\n\tds_read_b64_tr_b16 %6, %14\n\tds_read_b64_tr_b16 %7, %15\n\ts_waitcnt lgkmcnt(0)"
                 : "=&v"(a0), "=&v"(a1), "=&v"(a2), "=&v"(a3), "=&v"(c0), "=&v"(c1), "=&v"(c2), "=&v"(c3)
                 : "v"(b0), "v"(b0 + 4u * (unsigned)pitch), "v"(b0 + 32u * (unsigned)pitch), "v"(b0 + 36u * (unsigned)pitch), "v"(b1), "v"(b1 + 4u * (unsigned)pitch), "v"(b1 + 32u * (unsigned)pitch), "v"(b1 + 36u * (unsigned)pitch) : "memory");
    u64x2_t v; v.x = a0; v.y = a1; f00 = __builtin_bit_cast(bf16x8_t, v); v.x = a2; v.y = a3; f01 = __builtin_bit_cast(bf16x8_t, v);
    v.x = c0; v.y = c1; f10 = __builtin_bit_cast(bf16x8_t, v); v.x = c2; v.y = c3; f11 = __builtin_bit_cast(bf16x8_t, v);
}
constexpr int RC = 64;
constexpr int RT_QS = 0, RT_KS = RT_QS + RC * 272, RT_KD = RT_KS + RC * 272, RT_VS = RT_KD + RC * 272, RT_PS = RT_VS + RC * 528, RT_OT = RT_PS + RC * 144, RT_END = RT_OT + RC * 528;
static_assert(RT_END <= RING_BYTES, "ret lds");
DEVI void f_ret_prompt(const Ctx& c, const PArgs& a, int j, int b, int hd) {
    const bf16* Z = (const bf16*)(c.ws + WS_Z); bf16* MIX = (bf16*)(c.ws + WS_MIX);
    const unsigned L0 = (unsigned)(size_t)c.lds;
    LAS unsigned char* QS = c.lds + RT_QS; LAS unsigned char* KS = c.lds + RT_KS; LAS unsigned char* KD = c.lds + RT_KD; LAS unsigned char* VS = c.lds + RT_VS; LAS unsigned char* PS = c.lds + RT_PS;
    const int w = c.wave;
    const float l2g0 = log2f(1.f - exp2f(-5.f - (float)hd));
    const bf16* zb = Z + (size_t)(b * TP) * NIN; const int qcol = hd * 128, kcol = 512 + hd * 128, vcol = 1024 + hd * 256;
    const float* gn = a.in[I_ERGN] + (size_t)j * 1024 + hd * 256;
    f32x4 Sacc[8][2];
#pragma unroll
    for (int db = 0; db < 8; ++db) { Sacc[db][0] = (f32x4){0.f, 0.f, 0.f, 0.f}; Sacc[db][1] = (f32x4){0.f, 0.f, 0.f, 0.f}; }
    u32x4 pf[8];
#define RET_PREFETCH(t0) do { _Pragma("unroll") for (int i = 0; i < 8; ++i) { int r, col; \
            if (i < 4) { const int p = (i & 1) * NT + c.tid; r = p >> 4; col = (i < 2 ? qcol : kcol) + (p & 15) * 8; } else { const int p = (i - 4) * NT + c.tid; r = p >> 5; col = vcol + (p & 31) * 8; } \
            pf[i] = (u32x4){0u, 0u, 0u, 0u}; if ((t0) + r < TP) pf[i] = *(const u32x4*)(zb + (unsigned)(((t0) + r) * NIN + col)); } } while (0)
    RET_PREFETCH(0);
    const int nchunks = (TP + RC - 1) / RC;
#pragma unroll 1
    for (int ci = 0; ci < nchunks; ++ci) {
        const int t0 = ci * RC, nv = (TP - t0) < RC ? (TP - t0) : RC;
        int lane_ = c.lane; float l2g = l2g0; asm volatile("" : "+v"(lane_), "+v"(l2g));
        const int fr = lane_ & 15, fq = lane_ >> 4, tid_ = w * 64 + lane_;
        LDS_BAR();
#pragma unroll
        for (int i = 0; i < 8; ++i) {
            if (i < 4) { const int p = (i & 1) * NT + tid_, r = p >> 4, q = p & 15;
                *(LAS u32x4*)((i < 2 ? QS : KS) + r * 272 + q * 16) = pf[i];
                if (i >= 2) { const float dk = __builtin_amdgcn_exp2f((float)(nv - 1 - r) * l2g); u32x4 o;
#pragma unroll
                    for (int e = 0; e < 4; ++e) { const unsigned v = pf[i][e]; o[e] = pk2(__uint_as_float(v << 16) * dk, __uint_as_float(v & 0xffff0000u) * dk); }
                    *(LAS u32x4*)(KD + r * 272 + q * 16) = o; } }
            else { const int p = (i - 4) * NT + tid_, r = p >> 5, q = p & 31; *(LAS u32x4*)(VS + r * 528 + q * 16) = pf[i]; }
        }
        LDS_BAR();
        if (ci + 1 < nchunks) RET_PREFETCH(t0 + RC);
        u32x4 gcur[4];
#pragma unroll
        for (int i = 0; i < 4; ++i) { const int p = i * NT + tid_, r = p >> 5, q = p & 31; gcur[i] = (u32x4){0u, 0u, 0u, 0u};
            if (r < nv) gcur[i] = *(const u32x4*)(zb + (unsigned)((t0 + r) * NIN + 2048 + hd * 256 + q * 8)); }
        { const int cb = w >> 1;
#pragma unroll
          for (int si = 0; si < 2; ++si) { const int sb = 2 * (w & 1) + si; f32x4 pacc = (f32x4){0.f, 0.f, 0.f, 0.f};
#pragma unroll
              for (int ks = 0; ks < 4; ++ks) { const bf16x8_t af = *(const LAS bf16x8_t*)(QS + (16 * cb + fr) * 272 + (32 * ks + 8 * fq) * 2);
                  const bf16x8_t bfr = *(const LAS bf16x8_t*)(KS + (16 * sb + fr) * 272 + (32 * ks + 8 * fq) * 2);
                  pacc = __builtin_amdgcn_mfma_f32_16x16x32_bf16(af, bfr, pacc, 0, 0, 0); }
#pragma unroll
              for (int r = 0; r < 4; ++r) { const int cc = 16 * cb + 4 * fq + r, ss = 16 * sb + fr; const float v = cc >= ss ? pacc[r] * __builtin_amdgcn_exp2f((float)(cc - ss) * l2g) : 0.f;
                  *(LAS bf16*)(PS + cc * 144 + ss * 2) = f2bf(v); } } }
        f32x4 Oacc[4][2];
#pragma unroll
        for (int cb = 0; cb < 4; ++cb) { Oacc[cb][0] = (f32x4){0.f, 0.f, 0.f, 0.f}; Oacc[cb][1] = (f32x4){0.f, 0.f, 0.f, 0.f}; }
#pragma unroll
        for (int kk = 0; kk < 4; ++kk) {
            bf16x8_t sb_[2];
#pragma unroll
            for (int en = 0; en < 2; ++en) { u32x4 t; t.x = pk2(Sacc[2 * kk][en][0], Sacc[2 * kk][en][1]); t.y = pk2(Sacc[2 * kk][en][2], Sacc[2 * kk][en][3]);
                t.z = pk2(Sacc[2 * kk + 1][en][0], Sacc[2 * kk + 1][en][1]); t.w = pk2(Sacc[2 * kk + 1][en][2], Sacc[2 * kk + 1][en][3]); sb_[en] = __builtin_bit_cast(bf16x8_t, t); }
#pragma unroll
            for (int cb = 0; cb < 4; ++cb) {
                const u32x2 qa = *(const LAS u32x2*)(QS + (16 * cb + fr) * 272 + (32 * kk + 4 * fq) * 2), qb = *(const LAS u32x2*)(QS + (16 * cb + fr) * 272 + (32 * kk + 16 + 4 * fq) * 2);
                u32x4 t; t.x = qa.x; t.y = qa.y; t.z = qb.x; t.w = qb.y; const bf16x8_t af = __builtin_bit_cast(bf16x8_t, t);
                Oacc[cb][0] = __builtin_amdgcn_mfma_f32_16x16x32_bf16(af, sb_[0], Oacc[cb][0], 0, 0, 0);
                Oacc[cb][1] = __builtin_amdgcn_mfma_f32_16x16x32_bf16(af, sb_[1], Oacc[cb][1], 0, 0, 0); }
        }
#pragma unroll
        for (int cb = 0; cb < 4; ++cb)
#pragma unroll
            for (int r = 0; r < 4; ++r) { const float dc = __builtin_amdgcn_exp2f((float)(16 * cb + 4 * fq + r + 1) * l2g); Oacc[cb][0][r] *= dc; Oacc[cb][1][r] *= dc; }
        LDS_BAR();
        bf16x8_t vf[2][2];
        tr_frag4(L0 + RT_VS, 528, 32 * w, 32 * w + 16, fr, fq, vf[0][0], vf[0][1], vf[1][0], vf[1][1]);
#pragma unroll
        for (int cb = 0; cb < 4; ++cb)
#pragma unroll
            for (int ks = 0; ks < 2; ++ks) { const bf16x8_t af = *(const LAS bf16x8_t*)(PS + (16 * cb + fr) * 144 + (32 * ks + 8 * fq) * 2);
                Oacc[cb][0] = __builtin_amdgcn_mfma_f32_16x16x32_bf16(af, vf[0][ks], Oacc[cb][0], 0, 0, 0);
                Oacc[cb][1] = __builtin_amdgcn_mfma_f32_16x16x32_bf16(af, vf[1][ks], Oacc[cb][1], 0, 0, 0); }
        LAS unsigned char* OT = c.lds + RT_OT;
#pragma unroll
        for (int cb = 0; cb < 4; ++cb)
#pragma unroll
            for (int en = 0; en < 2; ++en)
#pragma unroll
                for (int r = 0; r < 4; ++r) *(LAS bf16*)(OT + (16 * cb + 4 * fq + r) * 528 + (32 * w + 16 * en + fr) * 2) = f2bf(Oacc[cb][en][r]);
        { const float dS = __builtin_amdgcn_exp2f((float)nv * l2g);
#pragma unroll
          for (int d2 = 0; d2 < 4; ++d2) {
              bf16x8_t kf[2][2]; tr_frag4(L0 + RT_KD, 272, 32 * d2, 32 * d2 + 16, fr, fq, kf[0][0], kf[0][1], kf[1][0], kf[1][1]);
#pragma unroll
              for (int dd = 0; dd < 2; ++dd) { const int db = 2 * d2 + dd; Sacc[db][0] = Sacc[db][0] * dS; Sacc[db][1] = Sacc[db][1] * dS;
#pragma unroll
                  for (int ks = 0; ks < 2; ++ks) {
                      Sacc[db][0] = __builtin_amdgcn_mfma_f32_16x16x32_bf16(kf[dd][ks], vf[0][ks], Sacc[db][0], 0, 0, 0);
                      Sacc[db][1] = __builtin_amdgcn_mfma_f32_16x16x32_bf16(kf[dd][ks], vf[1][ks], Sacc[db][1], 0, 0, 0); } } } }
        LDS_BAR();
#pragma unroll
        for (int i = 0; i < 4; ++i) { const int p = i * NT + tid_, r = p >> 5, q = p & 31;
            const u32x4 ov = *(const LAS u32x4*)(OT + r * 528 + q * 16);
            float o[8]; float s1 = 0.f, s2 = 0.f;
#pragma unroll
            for (int e = 0; e < 4; ++e) { o[2 * e] = __uint_as_float(ov[e] << 16); o[2 * e + 1] = __uint_as_float(ov[e] & 0xffff0000u); s1 += o[2 * e] + o[2 * e + 1]; s2 += o[2 * e] * o[2 * e] + o[2 * e + 1] * o[2 * e + 1]; }
            s1 = red32(s1); s2 = red32(s2);
            const float mu = s1 * (1.f / 256.f), var = fmaxf(s2 * (1.f / 256.f) - mu * mu, 0.f), rstd = __builtin_amdgcn_rsqf(var + 1e-6f);
            if (r < nv) { const u32x4 gv = gcur[i]; const f32x4 n0 = *(const f32x4*)(gn + q * 8), n1 = *(const f32x4*)(gn + q * 8 + 4);
                u32x4 out;
#pragma unroll
                for (int e = 0; e < 4; ++e) { const float g0 = __uint_as_float(gv[e] << 16), g1 = __uint_as_float(gv[e] & 0xffff0000u);
                    const float n_0 = e < 2 ? n0[2 * e] : n1[2 * e - 4], n_1 = e < 2 ? n0[2 * e + 1] : n1[2 * e - 3];
                    out[e] = pk2(g0 * (o[2 * e] - mu) * rstd * n_0, g1 * (o[2 * e + 1] - mu) * rstd * n_1); }
                *(u32x4*)(MIX + (size_t)(b * TP + t0 + r) * 2048 + hd * 256 + q * 8) = out; }
        }
    }
#undef RET_PREFETCH
    { const int fr = c.lane & 15, fq = c.lane >> 4; float* So = c.out + O_RETP + ((size_t)(j * BP + b) * 4 + hd) * 128 * 256 + 32 * w + fr;
#pragma unroll
      for (int db = 0; db < 8; ++db)
#pragma unroll
          for (int en = 0; en < 2; ++en)
#pragma unroll
              for (int r = 0; r < 4; ++r) So[(unsigned)((16 * db + 4 * fq + r) * 256 + 16 * en)] = Sacc[db][en][r]; }
    __syncthreads();
}
DEVI void f_ret_sample(const Ctx& c, const PArgs& a, int j, int b, int hd) {
    const bf16* Z = (const bf16*)(c.ws + WS_Z); bf16* MIX = (bf16*)(c.ws + WS_MIX);
    LAS float* qk = (LAS float*)c.lds;
    LAS float* op = qk + 256;
    const int row = MP + b, w = c.wave;
    const float gamma = 1.f - exp2f(-5.f - (float)hd);
    const float* S0 = a.in[I_SRET] + ((size_t)(j * BS + b) * 4 + hd) * 128 * 256 + 4 * c.lane; float* So = c.out + O_RETS + ((size_t)(j * BS + b) * 4 + hd) * 128 * 256 + 4 * c.lane;
    __syncthreads();
    if (c.tid < 256) qk[c.tid] = bf2f(Z[(size_t)row * NIN + (c.tid < 128 ? hd * 128 + c.tid : 512 + hd * 128 + c.tid - 128)]);
    const u32x2 vv = *(const u32x2*)(Z + (size_t)row * NIN + 1024 + hd * 256 + 4 * c.lane);
    const f32x4 v4 = (f32x4){__uint_as_float(vv.x << 16), __uint_as_float(vv.x & 0xffff0000u), __uint_as_float(vv.y << 16), __uint_as_float(vv.y & 0xffff0000u)};
    __syncthreads();
    f32x4 o4 = (f32x4){0.f, 0.f, 0.f, 0.f};
#pragma unroll 16
    for (int dd = 0; dd < 16; ++dd) { const int d = 16 * w + dd; f32x4 s = __builtin_nontemporal_load((const f32x4*)(S0 + (unsigned)(d * 256)));
        s = s * gamma + v4 * qk[128 + d]; __builtin_nontemporal_store(s, (f32x4*)(So + (unsigned)(d * 256))); o4 = o4 + s * qk[d]; }
    *(LAS f32x4*)(op + w * 256 + 4 * c.lane) = o4;
    __syncthreads();
    if (w == 0) {
        f32x4 o = (f32x4){0.f, 0.f, 0.f, 0.f};
#pragma unroll
        for (int ww = 0; ww < 8; ++ww) o = o + *(const LAS f32x4*)(op + ww * 256 + 4 * c.lane);
        const float mu = wave_sum((o.x + o.y) + (o.z + o.w)) * (1.f / 256.f); o = o - mu;
        const float rstd = __builtin_amdgcn_rsqf(wave_sum((o.x * o.x + o.y * o.y) + (o.z * o.z + o.w * o.w)) * (1.f / 256.f) + 1e-6f);
        const u32x2 gv = *(const u32x2*)(Z + (size_t)row * NIN + 2048 + hd * 256 + 4 * c.lane); const f32x4 n4 = *(const f32x4*)(a.in[I_ERGN] + (size_t)j * 1024 + hd * 256 + 4 * c.lane);
        u32x2 out; out.x = pk2(__uint_as_float(gv.x << 16) * o.x * rstd * n4.x, __uint_as_float(gv.x & 0xffff0000u) * o.y * rstd * n4.y);
        out.y = pk2(__uint_as_float(gv.y << 16) * o.z * rstd * n4.z, __uint_as_float(gv.y & 0xffff0000u) * o.w * rstd * n4.w);
        *(u32x2*)(MIX + (size_t)row * 2048 + hd * 256 + 4 * c.lane) = out;
    }
}

#ifndef WPB
#define WPB 180
#endif
#ifndef MIX_PART
#define MIX_PART 7
#endif
DEVI void f_even_mix(const Ctx& c, const PArgs& a, int li, int part) {
    const int j = li >> 1;
    if (c.bid < 32) { if (part & 1) f_ret_prompt(c, a, j, c.bid >> 2, c.bid & 3); }
    else if (c.bid < 104) { if (part & 2) { const bool pr = c.bid < 96; const int v = c.bid - 32;
        f_lru_unit(c, a, j, pr ? (v & 7) : (c.bid - 96), !pr, pr ? (v >> 3) : 0); } }
    if (part & 4) {
    if (c.bid >= 104) for (int u = c.bid - 104; u < 512; u += c.G - 104) f_ret_sample(c, a, j, u >> 2, u & 3);
    if (c.bid >= WPB && c.G > WPB) { __syncthreads(); f_wprep(c, a, li == 0 ? WM_L01 : WM_L23, (c.bid - WPB) * NWAVES + c.wave, (c.G - WPB) * NWAVES); }
    }
}

DEVI float gelu_fast(float x) { const float y = 1.5957691216057308f * (x + 0.044715f * x * x * x); return x * __builtin_amdgcn_rcpf(1.f + __expf(-y)); }
DEVI void f_ffn_act(const Ctx& c, const PArgs& a, int li) {
    const bf16* U = (const bf16*)(c.ws + WS_U); bf16* ACT = (bf16*)(c.ws + WS_ACT);
    const float* CW = a.in[I_FCW] + (size_t)li * 3 * DFF; const float* CB = a.in[I_FCB] + (size_t)li * DFF;
    constexpr int RCH = 32, NPC = DFF / 8, NRC = M / RCH, NITEM = NPC * NRC;
    for (int it = c.bid * NT + c.tid; it < NITEM; it += c.G * NT) {
        const int rc = it / NPC, pc = it - rc * NPC, col = pc * 8, r0 = rc * RCH;
        float w0[8], w1[8], w2[8], cb[8];
#pragma unroll
        for (int h = 0; h < 2; ++h) { const f32x4 a0 = *(const f32x4*)(CW + col + 4 * h), a1 = *(const f32x4*)(CW + DFF + col + 4 * h), a2 = *(const f32x4*)(CW + 2 * DFF + col + 4 * h), b0 = *(const f32x4*)(CB + col + 4 * h);
#pragma unroll
            for (int e = 0; e < 4; ++e) { w0[4 * h + e] = a0[e]; w1[4 * h + e] = a1[e]; w2[4 * h + e] = a2[e]; cb[4 * h + e] = b0[e]; } }
        const bf16* ub = U + (size_t)r0 * NUP + col; bf16* ab = ACT + (size_t)r0 * DFF + col;
        if (r0 < MP) {
            u32x4 p1 = (u32x4){0u, 0u, 0u, 0u}, p2 = p1;
            int t = r0 % TP;
            if (t >= 1) p1 = *(const u32x4*)(ub - NUP); if (t >= 2) p2 = *(const u32x4*)(ub - 2 * NUP);
#pragma unroll 1
            for (int i0 = 0; i0 < RCH; i0 += 8) {
                u32x4 ug[8], uv[8];
#pragma unroll
                for (int i = 0; i < 8; ++i) { ug[i] = *(const u32x4*)(ub + (unsigned)((i0 + i) * NUP)); uv[i] = *(const u32x4*)(ub + (unsigned)((i0 + i) * NUP + DFF)); }
#pragma unroll
                for (int i = 0; i < 8; ++i) {
                    if (t == 0) { p1 = (u32x4){0u, 0u, 0u, 0u}; p2 = p1; }
                    if (t >= TP - 2) { float* so = c.out + O_FCONVP + ((size_t)(li * BP + (r0 + i0 + i) / TP) * 2 + (t - (TP - 2))) * DFF + col;
#pragma unroll
                        for (int e = 0; e < 4; ++e) { so[2 * e] = __uint_as_float(ug[i][e] << 16); so[2 * e + 1] = __uint_as_float(ug[i][e] & 0xffff0000u); } }
                    u32x4 o;
#pragma unroll
                    for (int e = 0; e < 4; ++e) {
                        const float ca = cb[2 * e] + w2[2 * e] * __uint_as_float(ug[i][e] << 16) + w1[2 * e] * __uint_as_float(p1[e] << 16) + w0[2 * e] * __uint_as_float(p2[e] << 16);
                        const float cv = cb[2 * e + 1] + w2[2 * e + 1] * __uint_as_float(ug[i][e] & 0xffff0000u) + w1[2 * e + 1] * __uint_as_float(p1[e] & 0xffff0000u) + w0[2 * e + 1] * __uint_as_float(p2[e] & 0xffff0000u);
                        o[e] = pk2(gelu_fast(ca) * __uint_as_float(uv[i][e] << 16), gelu_fast(cv) * __uint_as_float(uv[i][e] & 0xffff0000u)); }
                    *(u32x4*)(ab + (unsigned)((i0 + i) * DFF)) = o;
                    p2 = p1; p1 = ug[i]; t = (t + 1 == TP) ? 0 : t + 1;
                }
            }
        } else {
#pragma unroll 1
            for (int i = 0; i < RCH; ++i) {
                const int row = r0 + i;
                const u32x4 ug = *(const u32x4*)(ub + (unsigned)(i * NUP)), uv = *(const u32x4*)(ub + (unsigned)(i * NUP + DFF));
                const float* st = a.in[I_SFCONV] + (size_t)(li * BS + row - MP) * 2 * DFF + col; float* so = c.out + O_FCONVS + (size_t)(li * BS + row - MP) * 2 * DFF + col;
                float f1[8], f2[8];
#pragma unroll
                for (int h = 0; h < 2; ++h) { const f32x4 s2 = *(const f32x4*)(st + 4 * h), s1 = *(const f32x4*)(st + DFF + 4 * h); *(f32x4*)(so + 4 * h) = s1;
#pragma unroll
                    for (int e = 0; e < 4; ++e) { f2[4 * h + e] = s2[e]; f1[4 * h + e] = s1[e]; } }
                u32x4 o;
#pragma unroll
                for (int e = 0; e < 4; ++e) { const float u0a = __uint_as_float(ug[e] << 16), u0b = __uint_as_float(ug[e] & 0xffff0000u);
                    so[DFF + 2 * e] = u0a; so[DFF + 2 * e + 1] = u0b;
                    const float ca = cb[2 * e] + w2[2 * e] * u0a + w1[2 * e] * f1[2 * e] + w0[2 * e] * f2[2 * e], cv = cb[2 * e + 1] + w2[2 * e + 1] * u0b + w1[2 * e + 1] * f1[2 * e + 1] + w0[2 * e + 1] * f2[2 * e + 1];
                    o[e] = pk2(gelu_fast(ca) * __uint_as_float(uv[e] << 16), gelu_fast(cv) * __uint_as_float(uv[e] & 0xffff0000u)); }
                *(u32x4*)(ab + (unsigned)(i * DFF)) = o;
            }
        }
    }
}

constexpr int RW_TG = 16;
constexpr int RW_BUF = 6 * RW_TG * 64 * 4;
constexpr int RW_Y = 2 * RW_BUF, RW_BON = RW_Y + RW_TG * 64 * 4, RW_END = RW_BON + RW_TG * 4;
DEVI void f_rwkv_prompt(const Ctx& c, const PArgs& a, int j, int b, int hd) {
    const bf16* R = (const bf16*)(c.ws + WS_R); const bf16* Kb = (const bf16*)(c.ws + WS_K);
    const bf16* VF = (const bf16*)((unsigned char*)c.out + DO_VFIRST); const bf16* Vb = j == 0 ? VF : (const bf16*)(c.ws + WS_V);
    const float* WD = (const float*)(c.ws + WS_WDEC); const bf16* AG = (const bf16*)(c.ws + WS_AG); const bf16* VG = (const bf16*)(c.ws + WS_VG); const bf16* GG = (const bf16*)(c.ws + WS_GG);
    bf16* O = (bf16*)(c.ws + WS_O);
    const int i = c.tid >> 3, q = c.tid & 7;
    const int st = c.tid >> 5, sc = (c.tid & 31) * 2, ch = hd * 64 + sc;
    const size_t rb = (size_t)(b * TP) * D + ch;
    const float kk0 = a.in[I_OKK][(size_t)j * D + ch], kk1 = a.in[I_OKK][(size_t)j * D + ch + 1], ka0 = a.in[I_OKA][(size_t)j * D + ch], ka1 = a.in[I_OKA][(size_t)j * D + ch + 1];
    const float rk0 = a.in[I_ORK][(size_t)j * D + ch], rk1 = a.in[I_ORK][(size_t)j * D + ch + 1];
    const float gg0 = a.in[I_OGNG][(size_t)j * D + ch], gg1 = a.in[I_OGNG][(size_t)j * D + ch + 1], gb0 = a.in[I_OGNB][(size_t)j * D + ch], gb1 = a.in[I_OGNB][(size_t)j * D + ch + 1];
    float s[8], z[8];
#pragma unroll
    for (int jj = 0; jj < 8; ++jj) { s[jj] = 0.f; z[jj] = 0.f; }
    unsigned pr_, pk_, pv_, pa_, pg_, pvf_ = 0u, pvg_ = 0u; float pw0, pw1;
#define RW_PREFETCH(t0) do { const unsigned o = (unsigned)(((t0) + st) * D); const bool ok = (t0) + st < TP; \
        pr_ = ok ? *(const unsigned*)(R + rb + o) : 0u; pk_ = ok ? *(const unsigned*)(Kb + rb + o) : 0u; pv_ = ok ? *(const unsigned*)(Vb + rb + o) : 0u; \
        pa_ = ok ? *(const unsigned*)(AG + rb + o) : 0u; pg_ = ok ? *(const unsigned*)(GG + rb + o) : 0u; \
        if (j == 1) { pvf_ = ok ? *(const unsigned*)(VF + rb + o) : 0u; pvg_ = ok ? *(const unsigned*)(VG + rb + o) : 0u; } \
        pw0 = ok ? WD[rb + o] : 1.f; pw1 = ok ? WD[rb + o + 1] : 1.f; } while (0)
    RW_PREFETCH(0);
    const int ngroups = (TP + RW_TG - 1) / RW_TG;
#pragma unroll 1
    for (int g = 0; g < ngroups; ++g) {
        const int t0 = g * RW_TG;
        LAS float* buf = (LAS float*)(c.lds + (g & 1) * RW_BUF);
        LAS float* ys = (LAS float*)(c.lds + RW_Y); LAS float* bon = (LAS float*)(c.lds + RW_BON);
        float gate0, gate1;
        { const float r0 = __uint_as_float(pr_ << 16), r1 = __uint_as_float(pr_ & 0xffff0000u), k0 = __uint_as_float(pk_ << 16), k1 = __uint_as_float(pk_ & 0xffff0000u);
          float v0 = __uint_as_float(pv_ << 16), v1 = __uint_as_float(pv_ & 0xffff0000u);
          const float a0 = __uint_as_float(pa_ << 16), a1 = __uint_as_float(pa_ & 0xffff0000u);
          gate0 = __uint_as_float(pg_ << 16); gate1 = __uint_as_float(pg_ & 0xffff0000u);
          if (j == 1) { const float f0 = __uint_as_float(pvf_ << 16), f1 = __uint_as_float(pvf_ & 0xffff0000u); v0 = v0 + (f0 - v0) * __uint_as_float(pvg_ << 16); v1 = v1 + (f1 - v1) * __uint_as_float(pvg_ & 0xffff0000u); }
          float q0 = k0 * kk0, q1 = k1 * kk1; const float ss = red32(q0 * q0 + q1 * q1); const float rn = __builtin_amdgcn_rsqf(fmaxf(ss, 1e-24f)); q0 *= rn; q1 *= rn;
          const float m0 = k0 * (1.f + (a0 - 1.f) * ka0), m1 = k1 * (1.f + (a1 - 1.f) * ka1);
          const float bs = red32(r0 * m0 * rk0 + r1 * m1 * rk1);
          const int o = st * 64 + sc;
          *(LAS f32x2_t*)(buf + o) = (f32x2_t){r0, r1}; *(LAS f32x2_t*)(buf + RW_TG * 64 + o) = (f32x2_t){pw0, pw1}; *(LAS f32x2_t*)(buf + 2 * RW_TG * 64 + o) = (f32x2_t){m0, m1};
          *(LAS f32x2_t*)(buf + 3 * RW_TG * 64 + o) = (f32x2_t){v0, v1}; *(LAS f32x2_t*)(buf + 4 * RW_TG * 64 + o) = (f32x2_t){-q0, -q1}; *(LAS f32x2_t*)(buf + 5 * RW_TG * 64 + o) = (f32x2_t){q0 * a0, q1 * a1};
          __syncthreads();
          if ((c.tid & 31) == 0) bon[st] = bs; }
        if (g + 1 < ngroups) RW_PREFETCH(t0 + RW_TG);
        const int nt = (TP - t0) < RW_TG ? (TP - t0) : RW_TG;
        if (c.tid < 256) {
#pragma unroll 4
        for (int tt = 0; tt < nt; ++tt) {
            const LAS float* p = buf + tt * 64 + 8 * q;
            const f32x4 ra = *(const LAS f32x4*)(p), rb2 = *(const LAS f32x4*)(p + 4), wa = *(const LAS f32x4*)(p + RW_TG * 64), wb = *(const LAS f32x4*)(p + RW_TG * 64 + 4);
            const f32x4 ka = *(const LAS f32x4*)(p + 2 * RW_TG * 64), kb2 = *(const LAS f32x4*)(p + 2 * RW_TG * 64 + 4), aa = *(const LAS f32x4*)(p + 4 * RW_TG * 64), ab = *(const LAS f32x4*)(p + 4 * RW_TG * 64 + 4);
            const f32x4 ba = *(const LAS f32x4*)(p + 5 * RW_TG * 64), bb = *(const LAS f32x4*)(p + 5 * RW_TG * 64 + 4);
            const float vi = buf[3 * RW_TG * 64 + tt * 64 + i], vj = buf[3 * RW_TG * 64 + tt * 64 + i + 32];
            const float sa = red8((s[0] * aa[0] + s[1] * aa[1]) + (s[2] * aa[2] + s[3] * aa[3]) + ((s[4] * ab[0] + s[5] * ab[1]) + (s[6] * ab[2] + s[7] * ab[3])));
            const float za = red8((z[0] * aa[0] + z[1] * aa[1]) + (z[2] * aa[2] + z[3] * aa[3]) + ((z[4] * ab[0] + z[5] * ab[1]) + (z[6] * ab[2] + z[7] * ab[3])));
#pragma unroll
            for (int jj = 0; jj < 4; ++jj) { s[jj] = s[jj] * wa[jj] + sa * ba[jj] + vi * ka[jj]; s[4 + jj] = s[4 + jj] * wb[jj] + sa * bb[jj] + vi * kb2[jj];
                z[jj] = z[jj] * wa[jj] + za * ba[jj] + vj * ka[jj]; z[4 + jj] = z[4 + jj] * wb[jj] + za * bb[jj] + vj * kb2[jj]; }
            const float y = red8((s[0] * ra[0] + s[1] * ra[1]) + (s[2] * ra[2] + s[3] * ra[3]) + ((s[4] * rb2[0] + s[5] * rb2[1]) + (s[6] * rb2[2] + s[7] * rb2[3])));
            const float y2 = red8((z[0] * ra[0] + z[1] * ra[1]) + (z[2] * ra[2] + z[3] * ra[3]) + ((z[4] * rb2[0] + z[5] * rb2[1]) + (z[6] * rb2[2] + z[7] * rb2[3])));
            if (q == 0) { ys[tt * 64 + i] = y; ys[tt * 64 + i + 32] = y2; }
        }
        }
        __syncthreads();
        if (t0 + st < TP) {
            const f32x2_t yv = *(const LAS f32x2_t*)(ys + st * 64 + sc), vv = *(const LAS f32x2_t*)(buf + 3 * RW_TG * 64 + st * 64 + sc);
            const float mu = red32(yv.x + yv.y) * (1.f / 64.f); const float d0 = yv.x - mu, d1 = yv.y - mu; const float var = red32(d0 * d0 + d1 * d1) * (1.f / 64.f);
            const float rs = 1.f / sqrtf(var + 64e-5f), bo = bon[st];
            const float o0 = (d0 * rs * gg0 + gb0 + bo * vv.x) * gate0, o1 = (d1 * rs * gg1 + gb1 + bo * vv.y) * gate1;
            *(unsigned*)(O + rb + (unsigned)((t0 + st) * D)) = pk2(o0, o1);
        }
    }
#undef RW_PREFETCH
    if (c.tid < 256) { float* So = c.out + O_RWKVP + ((size_t)(j * BP + b) * 16 + hd) * 4096 + i * 64 + 8 * q;
      *(f32x4*)So = (f32x4){s[0], s[1], s[2], s[3]}; *(f32x4*)(So + 4) = (f32x4){s[4], s[5], s[6], s[7]};
      *(f32x4*)(So + 2048) = (f32x4){z[0], z[1], z[2], z[3]}; *(f32x4*)(So + 2052) = (f32x4){z[4], z[5], z[6], z[7]}; }
    __syncthreads();
}
DEVI void f_rwkv_sample(const Ctx& c, const PArgs& a, int j, int b, int hd) {
    const bf16* R = (const bf16*)(c.ws + WS_R); const bf16* Kb = (const bf16*)(c.ws + WS_K);
    const bf16* VF = (const bf16*)((unsigned char*)c.out + DO_VFIRST); const bf16* Vb = j == 0 ? VF : (const bf16*)(c.ws + WS_V);
    const float* WD = (const float*)(c.ws + WS_WDEC); const bf16* AG = (const bf16*)(c.ws + WS_AG); const bf16* VG = (const bf16*)(c.ws + WS_VG); const bf16* GG = (const bf16*)(c.ws + WS_GG);
    bf16* O = (bf16*)(c.ws + WS_O);
    LAS float* buf = (LAS float*)c.lds;
    const int i = c.tid >> 3, q = c.tid & 7;
    const size_t so = ((size_t)(j * BS + b) * 16 + hd) * 4096 + i * 64 + 8 * q;
    const f32x4 sA = __builtin_nontemporal_load((const f32x4*)(a.in[I_SRWKV] + so)), sB = __builtin_nontemporal_load((const f32x4*)(a.in[I_SRWKV] + so + 4));
    float s[8] = {sA[0], sA[1], sA[2], sA[3], sB[0], sB[1], sB[2], sB[3]};
    float gate = 0.f;
    __syncthreads();
    if (c.tid < 64) { const int ch = hd * 64 + c.tid; const size_t o = (size_t)(MP + b) * D + ch;
        const float r = bf2f(R[o]), k = bf2f(Kb[o]), ag = bf2f(AG[o]), w = WD[o]; float v = bf2f(Vb[o]); gate = bf2f(GG[o]);
        if (j == 1) { const float vf = bf2f(VF[o]); v = v + (vf - v) * bf2f(VG[o]); }
        float kk = k * a.in[I_OKK][(size_t)j * D + ch]; const float ss = wave_sum(kk * kk); kk = kk / sqrtf(fmaxf(ss, 1e-24f));
        const float km = k * (1.f + (ag - 1.f) * a.in[I_OKA][(size_t)j * D + ch]);
        const float bs = wave_sum(r * km * a.in[I_ORK][(size_t)j * D + ch]);
        buf[c.tid] = r; buf[64 + c.tid] = w; buf[128 + c.tid] = km; buf[192 + c.tid] = v; buf[256 + c.tid] = -kk; buf[320 + c.tid] = kk * ag;
        if (c.tid == 0) buf[448] = bs; }
    __syncthreads();
    { float sa = 0.f;
#pragma unroll
      for (int jj = 0; jj < 8; ++jj) sa += s[jj] * buf[256 + 8 * q + jj];
      sa = red8(sa);
      const float vi = buf[192 + i]; float y = 0.f;
#pragma unroll
      for (int jj = 0; jj < 8; ++jj) { const int cj = 8 * q + jj; s[jj] = s[jj] * buf[64 + cj] + sa * buf[320 + cj] + vi * buf[128 + cj]; y += s[jj] * buf[cj]; }
      y = red8(y);
      if (q == 0) buf[384 + i] = y;
      float* Sout = c.out + O_RWKVS + so;
      __builtin_nontemporal_store((f32x4){s[0], s[1], s[2], s[3]}, (f32x4*)Sout); __builtin_nontemporal_store((f32x4){s[4], s[5], s[6], s[7]}, (f32x4*)(Sout + 4)); }
    __syncthreads();
    if (c.tid < 64) { const int ch = hd * 64 + c.tid;
        const float y = buf[384 + c.tid]; const float mu = wave_sum(y) * (1.f / 64.f); const float dy = y - mu; const float var = wave_sum(dy * dy) * (1.f / 64.f);
        float o = dy / sqrtf(var + 64e-5f) * a.in[I_OGNG][(size_t)j * D + ch] + a.in[I_OGNB][(size_t)j * D + ch];
        o = (o + buf[448] * buf[192 + c.tid]) * gate;
        O[(size_t)(MP + b) * D + ch] = f2bf(o); }
}
DEVI void f_odd_scan(const Ctx& c, const PArgs& a, int li) {
    const int j = li >> 1;
    if (c.bid < 128) f_rwkv_prompt(c, a, j, c.bid >> 4, c.bid & 15);
    else for (int u = c.bid - 128; u < 2048; u += c.G - 128) f_rwkv_sample(c, a, j, u >> 4, u & 15);
}

constexpr size_t DO_BON = 54 * MiB;
DEVI float red16(float x) { x += DPP_F(x, 0xB1); x += DPP_F(x, 0x4E); x += DPP_F(x, 0x141); x += DPP_F(x, 0x140); return x; }
constexpr int RW2_Y = 2 * RW_BUF, RW2_END = RW2_Y + 2 * RW_TG * 32 * 4;
DEVI void f_rwkv_prompt2(const Ctx& c, const PArgs& a, int j, int b, int hd, int half) {
    const bf16* R = (const bf16*)(c.ws + WS_R); const bf16* Kb = (const bf16*)(c.ws + WS_K);
    const bf16* VF = (const bf16*)((unsigned char*)c.out + DO_VFIRST); const bf16* Vb = j == 0 ? VF : (const bf16*)(c.ws + WS_V);
    const float* WD = (const float*)(c.ws + WS_WDEC); const bf16* AG = (const bf16*)(c.ws + WS_AG); const bf16* VG = (const bf16*)(c.ws + WS_VG);
    bf16* O = (bf16*)(c.ws + WS_O); float* BON = (float*)((unsigned char*)c.out + DO_BON);
    const int il = c.tid >> 4, q = c.tid & 15;
    const int st = c.tid >> 5, sc = (c.tid & 31) * 2, ch = hd * 64 + sc;
    const size_t rb = (size_t)(b * TP) * D + ch;
    const float kk0 = a.in[I_OKK][(size_t)j * D + ch], kk1 = a.in[I_OKK][(size_t)j * D + ch + 1], ka0 = a.in[I_OKA][(size_t)j * D + ch], ka1 = a.in[I_OKA][(size_t)j * D + ch + 1];
    const float rk0 = a.in[I_ORK][(size_t)j * D + ch], rk1 = a.in[I_ORK][(size_t)j * D + ch + 1];
    f32x4 s = (f32x4){0.f, 0.f, 0.f, 0.f};
    unsigned pr_, pk_, pv_, pa_, pvf_ = 0u, pvg_ = 0u; f32x2_t pw_;
#define RW2_PREFETCH(t0) do { const unsigned o = (unsigned)(((t0) + st) * D); const bool ok = (t0) + st < TP; \
        pr_ = ok ? *(const unsigned*)(R + rb + o) : 0u; pk_ = ok ? *(const unsigned*)(Kb + rb + o) : 0u; pv_ = ok ? *(const unsigned*)(Vb + rb + o) : 0u; pa_ = ok ? *(const unsigned*)(AG + rb + o) : 0u; \
        if (j == 1) { pvf_ = ok ? *(const unsigned*)(VF + rb + o) : 0u; pvg_ = ok ? *(const unsigned*)(VG + rb + o) : 0u; } \
        pw_ = ok ? *(const f32x2_t*)(WD + rb + o) : (f32x2_t){1.f, 1.f}; } while (0)
    RW2_PREFETCH(0);
    const int ngroups = (TP + RW_TG - 1) / RW_TG;
    LAS float* ys = (LAS float*)(c.lds + RW2_Y);
#pragma unroll 1
    for (int g = 0; g < ngroups; ++g) {
        const int t0 = g * RW_TG; const int nt = (TP - t0) < RW_TG ? (TP - t0) : RW_TG;
        LAS float* buf = (LAS float*)(c.lds + (g & 1) * RW_BUF);
        { const float r0 = __uint_as_float(pr_ << 16), r1 = __uint_as_float(pr_ & 0xffff0000u), k0 = __uint_as_float(pk_ << 16), k1 = __uint_as_float(pk_ & 0xffff0000u);
          float v0 = __uint_as_float(pv_ << 16), v1 = __uint_as_float(pv_ & 0xffff0000u);
          const float a0 = __uint_as_float(pa_ << 16), a1 = __uint_as_float(pa_ & 0xffff0000u);
          if (j == 1) { const float f0 = __uint_as_float(pvf_ << 16), f1 = __uint_as_float(pvf_ & 0xffff0000u); v0 = v0 + (f0 - v0) * __uint_as_float(pvg_ << 16); v1 = v1 + (f1 - v1) * __uint_as_float(pvg_ & 0xffff0000u); }
          float q0 = k0 * kk0, q1 = k1 * kk1; const float ss = red32(q0 * q0 + q1 * q1); const float rn = __builtin_amdgcn_rsqf(fmaxf(ss, 1e-24f)); q0 *= rn; q1 *= rn;
          const float m0 = k0 * (1.f + (a0 - 1.f) * ka0), m1 = k1 * (1.f + (a1 - 1.f) * ka1);
          const float bs = red32(r0 * m0 * rk0 + r1 * m1 * rk1);
          const int o = st * 64 + sc;
          *(LAS f32x2_t*)(buf + o) = (f32x2_t){r0, r1}; *(LAS f32x2_t*)(buf + RW_TG * 64 + o) = pw_; *(LAS f32x2_t*)(buf + 2 * RW_TG * 64 + o) = (f32x2_t){m0, m1};
          *(LAS f32x2_t*)(buf + 3 * RW_TG * 64 + o) = (f32x2_t){v0, v1}; *(LAS f32x2_t*)(buf + 4 * RW_TG * 64 + o) = (f32x2_t){-q0, -q1}; *(LAS f32x2_t*)(buf + 5 * RW_TG * 64 + o) = (f32x2_t){q0 * a0, q1 * a1};
          if (half == 0 && (c.tid & 31) == 0 && t0 + st < TP) BON[(size_t)(b * TP + t0 + st) * 16 + hd] = bs; }
        __syncthreads();
        if (g + 1 < ngroups) RW2_PREFETCH(t0 + RW_TG);
        {
            const LAS float* p = buf + 4 * q; const LAS float* pv = buf + 3 * RW_TG * 64 + 32 * half + il;
            f32x4 r4 = *(const LAS f32x4*)(p), w4 = *(const LAS f32x4*)(p + RW_TG * 64), k4 = *(const LAS f32x4*)(p + 2 * RW_TG * 64), a4 = *(const LAS f32x4*)(p + 4 * RW_TG * 64), b4 = *(const LAS f32x4*)(p + 5 * RW_TG * 64);
            float vi = pv[0];
#pragma unroll 2
            for (int tt = 0; tt < nt; ++tt) {
                const int tn = tt + 1 < nt ? tt + 1 : tt;
                const f32x4 nr4 = *(const LAS f32x4*)(p + tn * 64), nw4 = *(const LAS f32x4*)(p + RW_TG * 64 + tn * 64), nk4 = *(const LAS f32x4*)(p + 2 * RW_TG * 64 + tn * 64),
                            na4 = *(const LAS f32x4*)(p + 4 * RW_TG * 64 + tn * 64), nb4 = *(const LAS f32x4*)(p + 5 * RW_TG * 64 + tn * 64);
                const float nvi = pv[tn * 64];
                const float sa = red16((s[0] * a4[0] + s[1] * a4[1]) + (s[2] * a4[2] + s[3] * a4[3]));
                s = s * w4 + b4 * sa + k4 * vi;
                const float y = red16((s[0] * r4[0] + s[1] * r4[1]) + (s[2] * r4[2] + s[3] * r4[3]));
                if (q == 0) ys[tt * 32 + il] = y;
                r4 = nr4; w4 = nw4; k4 = nk4; a4 = na4; b4 = nb4; vi = nvi;
            }
        }
        __syncthreads();
        { const int tt = c.tid >> 5, cc = c.tid & 31; if (tt < nt) O[(size_t)(b * TP + t0 + tt) * D + hd * 64 + 32 * half + cc] = f2bf(ys[tt * 32 + cc]); }
    }
#undef RW2_PREFETCH
    { float* So = c.out + O_RWKVP + ((size_t)(j * BP + b) * 16 + hd) * 4096 + (32 * half + il) * 64 + 4 * q; *(f32x4*)So = s; }
    __syncthreads();
}
DEVI void f_rwkv_post(const Ctx& c, const PArgs& a, int li) {
    const int j = li >> 1;
    bf16* O = (bf16*)(c.ws + WS_O); const bf16* GG = (const bf16*)(c.ws + WS_GG); const bf16* VG = (const bf16*)(c.ws + WS_VG);
    const bf16* VF = (const bf16*)((unsigned char*)c.out + DO_VFIRST); const bf16* Vb = j == 0 ? VF : (const bf16*)(c.ws + WS_V); const float* BON = (const float*)((unsigned char*)c.out + DO_BON);
    const int pc = c.tid & 127, ch = pc * 8;
    const f32x4 g0 = *(const f32x4*)(a.in[I_OGNG] + (size_t)j * D + ch), g1 = *(const f32x4*)(a.in[I_OGNG] + (size_t)j * D + ch + 4), b0 = *(const f32x4*)(a.in[I_OGNB] + (size_t)j * D + ch), b1 = *(const f32x4*)(a.in[I_OGNB] + (size_t)j * D + ch + 4);
    for (int row = c.bid * 4 + (c.tid >> 7); row < MP; row += c.G * 4) {
        const size_t o = (size_t)row * D + ch;
        const u32x4 yv = *(const u32x4*)(O + o), vv = *(const u32x4*)(Vb + o), gv = *(const u32x4*)(GG + o);
        float y[8], v[8], gt[8];
#pragma unroll
        for (int e = 0; e < 4; ++e) { y[2 * e] = __uint_as_float(yv[e] << 16); y[2 * e + 1] = __uint_as_float(yv[e] & 0xffff0000u); v[2 * e] = __uint_as_float(vv[e] << 16); v[2 * e + 1] = __uint_as_float(vv[e] & 0xffff0000u);
            gt[2 * e] = __uint_as_float(gv[e] << 16); gt[2 * e + 1] = __uint_as_float(gv[e] & 0xffff0000u); }
        if (j == 1) { const u32x4 fv = *(const u32x4*)(VF + o), mv = *(const u32x4*)(VG + o);
#pragma unroll
            for (int e = 0; e < 4; ++e) { const float f0 = __uint_as_float(fv[e] << 16), f1 = __uint_as_float(fv[e] & 0xffff0000u), m0 = __uint_as_float(mv[e] << 16), m1 = __uint_as_float(mv[e] & 0xffff0000u);
                v[2 * e] = v[2 * e] + (f0 - v[2 * e]) * m0; v[2 * e + 1] = v[2 * e + 1] + (f1 - v[2 * e + 1]) * m1; } }
        float s1 = 0.f;
#pragma unroll
        for (int e = 0; e < 8; ++e) s1 += y[e];
        const float mu = red8(s1) * (1.f / 64.f); float s2 = 0.f;
#pragma unroll
        for (int e = 0; e < 8; ++e) { y[e] -= mu; s2 += y[e] * y[e]; }
        const float rs = __builtin_amdgcn_rsqf(red8(s2) * (1.f / 64.f) + 64e-5f), bo = BON[(size_t)row * 16 + (pc >> 3)];
        u32x4 out;
#pragma unroll
        for (int e = 0; e < 4; ++e) { const float gg0 = e < 2 ? g0[2 * e] : g1[2 * e - 4], gg1 = e < 2 ? g0[2 * e + 1] : g1[2 * e - 3], bb0 = e < 2 ? b0[2 * e] : b1[2 * e - 4], bb1 = e < 2 ? b0[2 * e + 1] : b1[2 * e - 3];
            out[e] = pk2((y[2 * e] * rs * gg0 + bb0 + bo * v[2 * e]) * gt[2 * e], (y[2 * e + 1] * rs * gg1 + bb1 + bo * v[2 * e + 1]) * gt[2 * e + 1]); }
        *(u32x4*)(O + o) = out;
    }
}
DEVI void f_odd_scan2(const Ctx& c, const PArgs& a, int li) {
    const int j = li >> 1;
    for (int u = c.bid; u < 256; u += c.G) f_rwkv_prompt2(c, a, j, u >> 5, (u >> 1) & 15, u & 1);
    for (int u = c.bid; u < 2048; u += c.G) f_rwkv_sample(c, a, j, u >> 4, u & 15);
}

constexpr int R_AF = 0, R_RF = 2048, R_BKF = 4096, R_VF = 8192, R_GF = 10240, R_RECA = 12288, R_RECB = 13312, R_PL = 14336, R_BON = 14592, RW3_REC = 14848;
constexpr int RW3_RING = 0, RW3_SCR = 8 * RW3_REC, RW3_SCRW = 5120, RW3_STAT = RW3_SCR + 4 * RW3_SCRW, RW3_END = RW3_STAT + 4096;
static_assert(RW3_END <= RING_BYTES, "rwkv3 lds");
#define DPP_RM(v, ctrl, rm) __builtin_bit_cast(float, __builtin_amdgcn_update_dpp(0, __builtin_bit_cast(int, (v)), (ctrl), (rm), 0xF, false))
DEVI float wsum64(float x) { x = red16(x); x += DPP_RM(x, 0x142, 0xA); x += DPP_RM(x, 0x143, 0xC); return __builtin_bit_cast(float, __builtin_amdgcn_readlane(__builtin_bit_cast(int, x), 63)); }
#define LWAIT() asm volatile("s_waitcnt lgkmcnt(0)" ::: "memory")
DEVI bf16x8_t frag_lohi(u32x2 lo, u32x2 hi) { u32x4 t; t.x = lo.x; t.y = lo.y; t.z = hi.x; t.w = hi.y; return __builtin_bit_cast(bf16x8_t, t); }
struct RwRaw { u32x2 r[4], k[4], v[4], a[4], g[4], f[4], m[4]; f32x4 w[4]; };
DEVI void rw3_load(const Ctx& c, RwRaw& q, int j, int b, int hd, int ck, int parts) {
    const bf16* R = (const bf16*)(c.ws + WS_R); const bf16* Kb = (const bf16*)(c.ws + WS_K);
    const bf16* VF_ = (const bf16*)((unsigned char*)c.out + DO_VFIRST); const bf16* Vb = j == 0 ? VF_ : (const bf16*)(c.ws + WS_V);
    const float* WD = (const float*)(c.ws + WS_WDEC); const bf16* AG = (const bf16*)(c.ws + WS_AG); const bf16* VG = (const bf16*)(c.ws + WS_VG); const bf16* GG = (const bf16*)(c.ws + WS_GG);
    const size_t rb = (size_t)(b * TP + ck * 16 + (c.lane & 15)) * D + hd * 64 + 4 * (c.lane >> 4);
#pragma unroll
    for (int n = 0; n < 4; ++n) { const size_t o = rb + 16 * n;
        if (parts & 4) { q.r[n] = *(const u32x2*)(R + o); q.k[n] = *(const u32x2*)(Kb + o); q.a[n] = *(const u32x2*)(AG + o); }
        if (parts & 2) q.w[n] = *(const f32x4*)(WD + o);
        if (parts & 1) { q.v[n] = *(const u32x2*)(Vb + o); q.g[n] = *(const u32x2*)(GG + o);
            if (j == 1) { q.f[n] = *(const u32x2*)(VF_ + o); q.m[n] = *(const u32x2*)(VG + o); } else { q.f[n] = (u32x2){0u, 0u}; q.m[n] = (u32x2){0u, 0u}; } } }
}
DEVI float bfe(u32x2 p, int e) { const unsigned u = e < 2 ? p.x : p.y; return (e & 1) ? __uint_as_float(u & 0xffff0000u) : __uint_as_float(u << 16); }
DEVI float fq_sum(float s) {
    u32x2 r = __builtin_amdgcn_permlane16_swap(__float_as_uint(s), __float_as_uint(s), false, false); s = __uint_as_float(r.x) + __uint_as_float(r.y);
    r = __builtin_amdgcn_permlane32_swap(__float_as_uint(s), __float_as_uint(s), false, false); return __uint_as_float(r.x) + __uint_as_float(r.y);
}
template <int S> DEVI float dpp_shr1(float x) { return __builtin_bit_cast(float, __builtin_amdgcn_update_dpp(0x3f800000, __builtin_bit_cast(int, x), 0x110 + S, 0xF, 0xF, false)); }
struct RwCoef { float kk[4][4], ka[4][4], rk[4][4]; };
#ifndef PREP_PRIO
#define PREP_PRIO 0
#endif
#ifndef CHAIN_PRIO
#define CHAIN_PRIO 3
#endif
constexpr int RW3_CF = 3072;
DEVI void rw3_prep(const Ctx& c, int j, int b, int hd, int ckn, RwRaw& q, LAS unsigned char* rec, LAS unsigned char* scr) {
    const int lane = c.lane, fr = lane & 15, fq = lane >> 4, t = fr;
    { const int lv = ((t >> 2) * 16 + 4 * fq) * 8 + (t & 3) * 2;
#pragma unroll
      for (int n = 0; n < 4; ++n)
#pragma unroll
        for (int e = 0; e < 4; ++e) { float v = bfe(q.v[n], e); if (j == 1) v = v + (bfe(q.f[n], e) - v) * bfe(q.m[n], e);
            *(LAS bf16*)(rec + R_VF + n * 512 + lv + e * 8) = f2bf(v);
            const unsigned gw = e < 2 ? q.g[n].x : q.g[n].y;
            *(LAS unsigned short*)(rec + R_GF + n * 512 + lv + e * 8) = (unsigned short)((e & 1) ? (gw >> 16) : gw); } }
    if (ckn >= 0) rw3_load(c, q, j, b, hd, ckn, 1);
    RwCoef cf;
#pragma unroll
    for (int n = 0; n < 4; ++n) { const f32x4 x0 = *(const LAS f32x4*)(scr + RW3_CF + (fq * 12 + n) * 16), x1 = *(const LAS f32x4*)(scr + RW3_CF + (fq * 12 + 4 + n) * 16), x2 = *(const LAS f32x4*)(scr + RW3_CF + (fq * 12 + 8 + n) * 16);
#pragma unroll
        for (int e = 0; e < 4; ++e) { cf.kk[n][e] = x0[e]; cf.ka[n][e] = x1[e]; cf.rk[n][e] = x2[e]; } }
    float ss = 0.f, bon = 0.f, P[4][4];
#pragma unroll
    for (int n = 0; n < 4; ++n)
#pragma unroll
        for (int e = 0; e < 4; ++e) { const float k = bfe(q.k[n], e), r = bfe(q.r[n], e), ag = bfe(q.a[n], e);
            const float kn = k * cf.kk[n][e]; ss += kn * kn;
            bon += r * (k * (1.f + (ag - 1.f) * cf.ka[n][e])) * cf.rk[n][e];
            P[n][e] = q.w[n][e]; }
    if (ckn >= 0) rw3_load(c, q, j, b, hd, ckn, 2);
    ss = fq_sum(ss); bon = fq_sum(bon);
    const float inv = __builtin_amdgcn_rsqf(fmaxf(ss, 1e-24f));
#pragma unroll
    for (int n = 0; n < 4; ++n)
#pragma unroll
        for (int e = 0; e < 4; ++e) { float x = P[n][e]; x = x * dpp_shr1<1>(x); x = x * dpp_shr1<2>(x); x = x * dpp_shr1<4>(x); x = x * dpp_shr1<8>(x); P[n][e] = x; }
    if (fq == 0) *(LAS float*)(rec + R_BON + t * 4) = bon;
    if (t == 15) {
#pragma unroll
        for (int n = 0; n < 4; ++n) *(LAS f32x4*)(rec + R_PL + (16 * n + 4 * fq) * 4) = (f32x4){P[n][0], P[n][1], P[n][2], P[n][3]}; }
    u32x4 afw[2], rfw[2], bfw[2], kfw[2];
#pragma unroll
    for (int kk = 0; kk < 2; ++kk) {
        float av[8], rv[8], bv[8], kv[8];
#pragma unroll
        for (int jj = 0; jj < 8; ++jj) { const int n = 2 * kk + (jj >> 2), e = jj & 3;
            const float k = bfe(q.k[n], e), r = bfe(q.r[n], e), ag = bfe(q.a[n], e);
            const float kn = k * cf.kk[n][e] * inv, km = k * (1.f + (ag - 1.f) * cf.ka[n][e]);
            const float Pn = P[n][e], Pm1 = dpp_shr1<1>(Pn), ip = rcpf_(Pn);
            av[jj] = -kn * Pm1; rv[jj] = r * Pn; bv[jj] = kn * ag * ip; kv[jj] = km * ip; }
        afw[kk] = (u32x4){pk2(av[0], av[1]), pk2(av[2], av[3]), pk2(av[4], av[5]), pk2(av[6], av[7])}; rfw[kk] = (u32x4){pk2(rv[0], rv[1]), pk2(rv[2], rv[3]), pk2(rv[4], rv[5]), pk2(rv[6], rv[7])};
        bfw[kk] = (u32x4){pk2(bv[0], bv[1]), pk2(bv[2], bv[3]), pk2(bv[4], bv[5]), pk2(bv[6], bv[7])}; kfw[kk] = (u32x4){pk2(kv[0], kv[1]), pk2(kv[2], kv[3]), pk2(kv[4], kv[5]), pk2(kv[6], kv[7])};
        *(LAS u32x4*)(rec + R_AF + (kk * 64 + lane) * 16) = afw[kk]; *(LAS u32x4*)(rec + R_RF + (kk * 64 + lane) * 16) = rfw[kk];
    }
    { const int lb = ((t >> 2) * 16 + 4 * fq) * 16 + (t & 3) * 2;
#pragma unroll
      for (int n = 0; n < 4; ++n)
#pragma unroll
        for (int e = 0; e < 4; ++e) { const int kk = n >> 1, jj = 4 * (n & 1) + e; const unsigned bw = bfw[kk][jj >> 1], kw = kfw[kk][jj >> 1];
            *(LAS unsigned short*)(rec + R_BKF + n * 1024 + lb + e * 16) = (unsigned short)((jj & 1) ? (bw >> 16) : bw);
            *(LAS unsigned short*)(rec + R_BKF + n * 1024 + lb + e * 16 + 8) = (unsigned short)((jj & 1) ? (kw >> 16) : kw);
        } }
    if (ckn >= 0) rw3_load(c, q, j, b, hd, ckn, 4);
    f32x4 Aab = (f32x4){0.f, 0.f, 0.f, 0.f}, Aak = Aab, Arb = Aab, Ark = Aab;
#pragma unroll
    for (int kk = 0; kk < 2; ++kk) {
        const bf16x8_t af = __builtin_bit_cast(bf16x8_t, afw[kk]), rf = __builtin_bit_cast(bf16x8_t, rfw[kk]), bf_ = __builtin_bit_cast(bf16x8_t, bfw[kk]), kf = __builtin_bit_cast(bf16x8_t, kfw[kk]);
        Aab = __builtin_amdgcn_mfma_f32_16x16x32_bf16(af, bf_, Aab, 0, 0, 0); Aak = __builtin_amdgcn_mfma_f32_16x16x32_bf16(af, kf, Aak, 0, 0, 0);
        Arb = __builtin_amdgcn_mfma_f32_16x16x32_bf16(rf, bf_, Arb, 0, 0, 0); Ark = __builtin_amdgcn_mfma_f32_16x16x32_bf16(rf, kf, Ark, 0, 0, 0); }
#pragma unroll
    for (int r = 0; r < 4; ++r) { const int t = 4 * fq + r;
        *(LAS float*)(scr + (t * 16 + fr) * 4) = t > fr ? Aab[r] : 0.f;
        *(LAS bf16*)(scr + 1024 + (t * 16 + fr) * 2) = f2bf(t > fr ? Aak[r] : 0.f);
        *(LAS bf16*)(scr + 1536 + (t * 16 + fr) * 2) = f2bf(t >= fr ? Arb[r] : 0.f);
        *(LAS bf16*)(scr + 2048 + (t * 16 + fr) * 2) = f2bf(t >= fr ? Ark[r] : 0.f); }
    LWAIT();
    float Tc[16];
#pragma unroll
    for (int t = 0; t < 16; ++t) {
        float acc = (t == fr) ? 1.f : 0.f, last = 0.f;
#pragma unroll
        for (int u4 = 0; u4 < (t + 3) / 4; ++u4) { const f32x4 ar = *(const LAS f32x4*)(scr + (t * 16 + 4 * u4) * 4);
#pragma unroll
            for (int e = 0; e < 4; ++e) { if (4 * u4 + e < t - 1) acc += ar[e] * Tc[4 * u4 + e]; if (4 * u4 + e == t - 1) last = ar[e]; } }
        Tc[t] = t > 0 ? acc + last * Tc[t > 0 ? t - 1 : 0] : acc; }
    if (fq == 0) {
#pragma unroll
        for (int t = 0; t < 16; ++t) *(LAS bf16*)(scr + 2560 + (t * 16 + fr) * 2) = f2bf(Tc[t]); }
    LWAIT();
    { const u32x2 ak = *(const LAS u32x2*)(scr + 1024 + (fr * 16 + 4 * fq) * 2), tt = *(const LAS u32x2*)(scr + 2560 + (fr * 16 + 4 * fq) * 2);
      const u32x2 rbv = *(const LAS u32x2*)(scr + 1536 + (fr * 16 + 4 * fq) * 2), rkv = *(const LAS u32x2*)(scr + 2048 + (fr * 16 + 4 * fq) * 2);
      *(LAS u32x4*)(rec + R_RECA + lane * 16) = (u32x4){ak.x, ak.y, tt.x, tt.y}; *(LAS u32x4*)(rec + R_RECB + lane * 16) = (u32x4){rbv.x, rbv.y, rkv.x, rkv.y}; }
    LWAIT();
}
DEVI void f_rwkv_chunked(const Ctx& c, const PArgs& a, int j, int b, int hd) {
    bf16* O = (bf16*)(c.ws + WS_O);
    const int w = c.wave, lane = c.lane, fr = lane & 15, fq = lane >> 4;
    constexpr int NCK = TP / 16, NGR = (NCK + 3) / 4;
    __syncthreads();
    if (w >= 4) {
        __builtin_amdgcn_s_setprio(PREP_PRIO);
        { LAS unsigned char* scr = c.lds + RW3_SCR + (w - 4) * RW3_SCRW;
          if (fr < 12) { const int n = fr & 3, which = fr >> 2; const size_t o = (size_t)j * D + hd * 64 + 16 * n + 4 * fq;
              const float* p0 = a.in[I_OKK]; const float* p1 = a.in[I_OKA]; const float* p2 = a.in[I_ORK];
              *(LAS f32x4*)(scr + RW3_CF + (fq * 12 + which * 4 + n) * 16) = *(const f32x4*)((which == 0 ? p0 : (which == 1 ? p1 : p2)) + o); }
          LWAIT(); }
        RwRaw q;
        rw3_load(c, q, j, b, hd, w - 4, 7);
        rw3_prep(c, j, b, hd, w, q, c.lds + RW3_RING + (w - 4) * RW3_REC, c.lds + RW3_SCR + (w - 4) * RW3_SCRW);
        __syncthreads();
#pragma unroll 1
        for (int g = 0; g < NGR; ++g) {
            const int ck = 4 * (g + 1) + (w - 4);
            if (ck < NCK) rw3_prep(c, j, b, hd, ck + 4 < NCK ? ck + 4 : -1, q, c.lds + RW3_RING + (((g + 1) & 1) * 4 + (w - 4)) * RW3_REC, c.lds + RW3_SCR + (w - 4) * RW3_SCRW);
            __syncthreads();
        }
    __builtin_amdgcn_s_setprio(0);
    } else {
        __builtin_amdgcn_s_setprio(CHAIN_PRIO);
        f32x4 G[4];
#pragma unroll
        for (int jb = 0; jb < 4; ++jb) G[jb] = (f32x4){0.f, 0.f, 0.f, 0.f};
        const int ch = hd * 64 + 16 * w + fr;
        const float gng = a.in[I_OGNG][(size_t)j * D + ch], gnb = a.in[I_OGNB][(size_t)j * D + ch];
        __syncthreads();
#pragma unroll 1
        for (int g = 0; g < NGR; ++g) {
            const int nck = (NCK - 4 * g) < 4 ? (NCK - 4 * g) : 4;
            f32x4 yk[4]; u32x2 vk[4], gk[4]; f32x4 bk[4];
            LAS float* stat = (LAS float*)(c.lds + RW3_STAT + (g & 1) * 2048);
#pragma unroll
            for (int q = 0; q < 4; ++q) {
                if (q < nck) {
                    const LAS unsigned char* rec = c.lds + RW3_RING + ((g & 1) * 4 + q) * RW3_REC;
                    bf16x8_t gb[2];
#pragma unroll
                    for (int kk = 0; kk < 2; ++kk) { u32x4 t; t.x = pk2(G[2 * kk][0], G[2 * kk][1]); t.y = pk2(G[2 * kk][2], G[2 * kk][3]); t.z = pk2(G[2 * kk + 1][0], G[2 * kk + 1][1]); t.w = pk2(G[2 * kk + 1][2], G[2 * kk + 1][3]); gb[kk] = __builtin_bit_cast(bf16x8_t, t); }
                    const u32x2 vf = *(const LAS u32x2*)(rec + R_VF + (w * 64 + lane) * 8); const u32x4 ra = *(const LAS u32x4*)(rec + R_RECA + lane * 16);
                    vk[q] = vf; gk[q] = *(const LAS u32x2*)(rec + R_GF + (w * 64 + lane) * 8); bk[q] = *(const LAS f32x4*)(rec + R_BON + 16 * fq);
                    const u32x2 z2 = (u32x2){0u, 0u};
                    f32x4 W = __builtin_amdgcn_mfma_f32_16x16x32_bf16(__builtin_bit_cast(bf16x8_t, ra), frag_lohi(vf, z2), (f32x4){0.f, 0.f, 0.f, 0.f}, 0, 0, 0);
                    W = __builtin_amdgcn_mfma_f32_16x16x32_bf16(*(const LAS bf16x8_t*)(rec + R_AF + lane * 16), gb[0], W, 0, 0, 0);
                    W = __builtin_amdgcn_mfma_f32_16x16x32_bf16(*(const LAS bf16x8_t*)(rec + R_AF + (64 + lane) * 16), gb[1], W, 0, 0, 0);
                    const u32x2 wlo = (u32x2){pk2(W[0], W[1]), pk2(W[2], W[3])};
                    const f32x4 U = __builtin_amdgcn_mfma_f32_16x16x32_bf16(frag_lohi((u32x2){ra.z, ra.w}, (u32x2){ra.x, ra.y}), frag_lohi(wlo, z2), (f32x4){0.f, 0.f, 0.f, 0.f}, 0, 0, 0);
                    const bf16x8_t ub = frag_lohi((u32x2){pk2(U[0], U[1]), pk2(U[2], U[3])}, vf);
                    f32x4 Y = __builtin_amdgcn_mfma_f32_16x16x32_bf16(*(const LAS bf16x8_t*)(rec + R_RF + lane * 16), gb[0], (f32x4){0.f, 0.f, 0.f, 0.f}, 0, 0, 0);
                    Y = __builtin_amdgcn_mfma_f32_16x16x32_bf16(*(const LAS bf16x8_t*)(rec + R_RF + (64 + lane) * 16), gb[1], Y, 0, 0, 0);
                    Y = __builtin_amdgcn_mfma_f32_16x16x32_bf16(*(const LAS bf16x8_t*)(rec + R_RECB + lane * 16), ub, Y, 0, 0, 0);
#pragma unroll
                    for (int jb = 0; jb < 4; ++jb) { G[jb] = __builtin_amdgcn_mfma_f32_16x16x32_bf16(*(const LAS bf16x8_t*)(rec + R_BKF + (jb * 64 + lane) * 16), ub, G[jb], 0, 0, 0);
                        G[jb] = G[jb] * *(const LAS f32x4*)(rec + R_PL + (16 * jb + 4 * fq) * 4); }
                    yk[q] = Y;
#pragma unroll
                    for (int r = 0; r < 4; ++r) { const float s1 = red16(Y[r]), s2 = red16(Y[r] * Y[r]); if (fr == 0) *(LAS f32x2_t*)(stat + ((q * 4 + w) * 16 + 4 * fq + r) * 2) = (f32x2_t){s1, s2}; }
                }
            }
            __syncthreads();
#pragma unroll
            for (int q = 0; q < 4; ++q) {
                if (q < nck) {
#pragma unroll
                    for (int r = 0; r < 4; ++r) { const int t = 4 * fq + r; float s1 = 0.f, s2 = 0.f;
#pragma unroll
                        for (int ww = 0; ww < 4; ++ww) { const f32x2_t sv = *(const LAS f32x2_t*)(stat + ((q * 4 + ww) * 16 + t) * 2); s1 += sv.x; s2 += sv.y; }
                        const float mu = s1 * (1.f / 64.f), var = fmaxf(s2 * (1.f / 64.f) - mu * mu, 0.f), rs = __builtin_amdgcn_rsqf(var + 64e-5f);
                        const unsigned vb_ = r < 2 ? vk[q].x : vk[q].y, gb_ = r < 2 ? gk[q].x : gk[q].y;
                        const float v = (r & 1) ? __uint_as_float(vb_ & 0xffff0000u) : __uint_as_float(vb_ << 16), gt = (r & 1) ? __uint_as_float(gb_ & 0xffff0000u) : __uint_as_float(gb_ << 16);
                        const float o = ((yk[q][r] - mu) * rs * gng + gnb + bk[q][r] * v) * gt;
                        O[(size_t)(b * TP + (4 * g + q) * 16 + t) * D + ch] = f2bf(o); }
                }
            }
        }
        float* So = c.out + O_RWKVP + ((size_t)(j * BP + b) * 16 + hd) * 4096 + (size_t)(16 * w + fr) * 64 + 4 * fq;
#pragma unroll
        for (int jb = 0; jb < 4; ++jb) *(f32x4*)(So + 16 * jb) = G[jb];
        __builtin_amdgcn_s_setprio(0);
    }
    __syncthreads();
}
#ifndef SSB
#define SSB 160
#endif
#ifndef SCAN_PART
#define SCAN_PART 3
#endif
DEVI void f_odd_scan3(const Ctx& c, const PArgs& a, int li, int part) {
    const int j = li >> 1;
    if (c.bid < 128) { if (part & 1) f_rwkv_chunked(c, a, j, c.bid >> 4, c.bid & 15); }
    else if ((part & 2) && c.bid >= SSB) for (int u = c.bid - SSB; u < 2048; u += c.G - SSB) f_rwkv_sample(c, a, j, u >> 4, u & 15);
}

template <int CTRL> DEVI float dppz(float x) { return __builtin_bit_cast(float, __builtin_amdgcn_update_dpp(0, __builtin_bit_cast(int, x), CTRL, 0xF, 0xF, true)); }
struct EpiUpAct {
    static constexpr bool PERM = true;
    bf16* U; bf16* ACT; const float* RS; const float* CW; const float* CB; float* FCP;
    DEVI void operator()(const f32x4 (&acc)[2][2][4][2], const pg8::Unit& u, int wr, int wc, int fr, int fq) const {
        const int f0 = u.pn * 128 + wc * 32 + fq * 8;
        f32x4 w0[2], w1[2], w2[2], cb[2];
#pragma unroll
        for (int n = 0; n < 2; ++n) { w0[n] = *(const f32x4*)(CW + f0 + 4 * n); w1[n] = *(const f32x4*)(CW + DFF + f0 + 4 * n); w2[n] = *(const f32x4*)(CW + 2 * DFF + f0 + 4 * n); cb[n] = *(const f32x4*)(CB + f0 + 4 * n); }
        float rsv[2][4];
#pragma unroll
        for (int ai = 0; ai < 2; ++ai)
#pragma unroll
            for (int m = 0; m < 4; ++m) rsv[ai][m] = row_rstd_q(RS, u.pm * 256 + ai * 128 + wr * 64 + m * 16 + fr, fq);
#pragma unroll
        for (int ai = 0; ai < 2; ++ai) {
            const int rowg = u.pm * 256 + ai * 128 + wr * 64;
            const bool sample = rowg >= MP;
            f32x4 ug[4][2];
            float rs[4];
#pragma unroll
            for (int m = 0; m < 4; ++m) { rs[m] = rsv[ai][m]; ug[m][0] = acc[ai][0][m][0] * rs[m]; ug[m][1] = acc[ai][0][m][1] * rs[m]; }
#pragma unroll
            for (int m = 3; m >= 0; --m) {
                const int row = rowg + m * 16 + fr; const int tt = sample ? 16 : (rowg + m * 16) % TP;
                const f32x4 uv0 = acc[ai][1][m][0] * rs[m], uv1 = acc[ai][1][m][1] * rs[m];
                f32x4 p1[2], p2[2];
#pragma unroll
                for (int n = 0; n < 2; ++n)
#pragma unroll
                    for (int e = 0; e < 4; ++e) {
                        const float cur = ug[m][n][e];
                        float q1 = dppz<0x111>(cur), q2 = dppz<0x112>(cur);
                        if (m > 0) { const float prv = ug[m > 0 ? m - 1 : 0][n][e]; q1 += dppz<0x10F>(prv); q2 += dppz<0x10E>(prv); }
                        p1[n][e] = q1; p2[n][e] = q2;
                        if (tt == 0) { if (fr == 0) p1[n][e] = 0.f; if (fr < 2) p2[n][e] = 0.f; } }
                const bool pending = sample || (m == 0 && fr < 2);
                if (pending || (m == 3 && fr >= 14)) *(u32x4*)(U + (size_t)row * NUP + f0) = pack8(ug[m][0], ug[m][1]);
                if (pending) *(u32x4*)(U + (size_t)row * NUP + DFF + f0) = pack8(uv0, uv1);
                else {
                    f32x4 o0, o1;
#pragma unroll
                    for (int e = 0; e < 4; ++e) { o0[e] = geluf_(cb[0][e] + w2[0][e] * ug[m][0][e] + w1[0][e] * p1[0][e] + w0[0][e] * p2[0][e]) * uv0[e];
                        o1[e] = geluf_(cb[1][e] + w2[1][e] * ug[m][1][e] + w1[1][e] * p1[1][e] + w0[1][e] * p2[1][e]) * uv1[e]; }
                    *(u32x4*)(ACT + (size_t)row * DFF + f0) = pack8(o0, o1);
                    if (tt == TP - 16 && fr >= 14) { float* so = FCP + ((size_t)(row / TP) * 2 + (fr - 14)) * DFF + f0; *(f32x4*)so = ug[m][0]; *(f32x4*)(so + 4) = ug[m][1]; }
                }
            }
        }
    }
};
DEVI void f_ffn_up_act(const Ctx& c, const PArgs& a, int li) {
    pg8::Gemm g{(const bf16*)(c.ws + WS_XB), (const bf16*)(c.ws + WS_WB + WB_WUP + li * SZ_WUP), M, NUP, D, D, 0ull, 0};
    pg8::StaticOrder S; S.init(M, NUP, c.G, c.bid);
    EpiUpAct E{(bf16*)(c.ws + WS_U), (bf16*)(c.ws + WS_ACT), (const float*)(c.ws + WS_RS), a.in[I_FCW] + (size_t)li * 3 * DFF, a.in[I_FCB] + (size_t)li * DFF, c.out + O_FCONVP + (size_t)li * BP * 2 * DFF};
    pg8::gemm_phase<EpiUpAct>(c.lds, c.tid, g, S, E);
}
DEVI void f_ffn_fix(const Ctx& c, const PArgs& a, int li) {
    const bf16* U = (const bf16*)(c.ws + WS_U); bf16* ACT = (bf16*)(c.ws + WS_ACT);
    const float* CW = a.in[I_FCW] + (size_t)li * 3 * DFF; const float* CB = a.in[I_FCB] + (size_t)li * DFF;
    constexpr int NPC = DFF / 8, NROW = (MP / 64) * 2 + BS, NITEM = NPC * NROW;
    for (int it = c.bid * NT + c.tid; it < NITEM; it += c.G * NT) {
        const int ri = it / NPC, pc = it - ri * NPC, col = pc * 8;
        const int row = ri < (MP / 64) * 2 ? (ri >> 1) * 64 + (ri & 1) : MP + (ri - (MP / 64) * 2);
        const u32x4 ug = *(const u32x4*)(U + (size_t)row * NUP + col), uv = *(const u32x4*)(U + (size_t)row * NUP + DFF + col);
        float f1[8], f2[8];
        if (row < MP) { const int t = row % TP; u32x4 p1 = (u32x4){0u, 0u, 0u, 0u}, p2 = p1;
            if (t >= 1) p1 = *(const u32x4*)(U + (size_t)(row - 1) * NUP + col); if (t >= 2) p2 = *(const u32x4*)(U + (size_t)(row - 2) * NUP + col);
#pragma unroll
            for (int e = 0; e < 4; ++e) { f1[2 * e] = __uint_as_float(p1[e] << 16); f1[2 * e + 1] = __uint_as_float(p1[e] & 0xffff0000u); f2[2 * e] = __uint_as_float(p2[e] << 16); f2[2 * e + 1] = __uint_as_float(p2[e] & 0xffff0000u); }
        } else { const float* st = a.in[I_SFCONV] + (size_t)(li * BS + row - MP) * 2 * DFF + col; float* so = c.out + O_FCONVS + (size_t)(li * BS + row - MP) * 2 * DFF + col;
#pragma unroll
            for (int h = 0; h < 2; ++h) { const f32x4 s2 = *(const f32x4*)(st + 4 * h), s1 = *(const f32x4*)(st + DFF + 4 * h); *(f32x4*)(so + 4 * h) = s1;
#pragma unroll
                for (int e = 0; e < 4; ++e) { f2[4 * h + e] = s2[e]; f1[4 * h + e] = s1[e]; } }
#pragma unroll
            for (int e = 0; e < 4; ++e) { so[DFF + 2 * e] = __uint_as_float(ug[e] << 16); so[DFF + 2 * e + 1] = __uint_as_float(ug[e] & 0xffff0000u); } }
        u32x4 o;
#pragma unroll
        for (int e = 0; e < 4; ++e) { const float u0a = __uint_as_float(ug[e] << 16), u0b = __uint_as_float(ug[e] & 0xffff0000u);
            const float ca = CB[col + 2 * e] + CW[2 * DFF + col + 2 * e] * u0a + CW[DFF + col + 2 * e] * f1[2 * e] + CW[col + 2 * e] * f2[2 * e];
            const float cv = CB[col + 2 * e + 1] + CW[2 * DFF + col + 2 * e + 1] * u0b + CW[DFF + col + 2 * e + 1] * f1[2 * e + 1] + CW[col + 2 * e + 1] * f2[2 * e + 1];
            o[e] = pk2(geluf_(ca) * __uint_as_float(uv[e] << 16), geluf_(cv) * __uint_as_float(uv[e] & 0xffff0000u)); }
        *(u32x4*)(ACT + (size_t)row * DFF + col) = o;
    }
}

DEVI void f_odd_norm(const Ctx& c, const PArgs& a, int li) {
    const int j = li >> 1;
    const bf16* XB = (const bf16*)(c.ws + WS_XB); const float* RS = (const float*)(c.ws + WS_RS); bf16* XM = (bf16*)(c.ws + WS_XMIX);
    const float* gain = a.in[I_NMIX] + (size_t)li * D; const float* mix = a.in[I_OMIX] + (size_t)j * 6 * D;
    const int gw = c.bid * NWAVES + c.wave, NGW = c.G * NWAVES;
    const int r0 = (int)(((long)gw * M) / NGW), r1 = (int)(((long)(gw + 1) * M) / NGW);
    f32x4 gv[4], mv[6][4];
#pragma unroll
    for (int q = 0; q < 4; ++q) { const int col = q * 256 + c.lane * 4; gv[q] = *(const f32x4*)(gain + col);
#pragma unroll
        for (int n = 0; n < 6; ++n) mv[n][q] = *(const f32x4*)(mix + (size_t)n * D + col); }
    f32x4 hprev[4];
#pragma unroll
    for (int q = 0; q < 4; ++q) hprev[q] = (f32x4){0.f, 0.f, 0.f, 0.f};
    for (int row = r0; row < r1; ++row) {
        const float rs = row_rstd(RS, row);
        const bool prompt = row < MP; const int b = prompt ? row / TP : row - MP, t = prompt ? row % TP : 0;
        const bool need_prev = prompt && t > 0 && row == r0;
        const float rsp = need_prev ? row_rstd(RS, row - 1) : 0.f;
#pragma unroll
        for (int q = 0; q < 4; ++q) { const int col = q * 256 + c.lane * 4;
            const u32x2 xw_ = *(const u32x2*)(XB + (size_t)row * D + col);
            const f32x4 h = (f32x4){__uint_as_float(xw_.x << 16), __uint_as_float(xw_.x & 0xffff0000u), __uint_as_float(xw_.y << 16), __uint_as_float(xw_.y & 0xffff0000u)} * rs * gv[q];
            f32x4 hp = hprev[q];
            if (!prompt) hp = *(const f32x4*)(a.in[I_SSHIFT] + (size_t)(j * BS + b) * D + col);
            else if (t == 0) hp = (f32x4){0.f, 0.f, 0.f, 0.f};
            else if (need_prev) { const u32x2 pw_ = *(const u32x2*)(XB + (size_t)(row - 1) * D + col);
                hp = (f32x4){__uint_as_float(pw_.x << 16), __uint_as_float(pw_.x & 0xffff0000u), __uint_as_float(pw_.y << 16), __uint_as_float(pw_.y & 0xffff0000u)} * rsp * gv[q]; }
            const f32x4 xx = hp - h;
#pragma unroll
            for (int n = 0; n < 6; ++n) { const f32x4 o = h + xx * mv[n][q]; u32x2 w; w.x = pk2(o.x, o.y); w.y = pk2(o.z, o.w); *(u32x2*)(XM + ((size_t)n * M + row) * D + col) = w; }
            if (prompt) { if (t == TP - 1) *(f32x4*)(c.out + O_SHIFTP + (size_t)(j * BP + b) * D + col) = h; }
            else *(f32x4*)(c.out + O_SHIFTS + (size_t)(j * BS + b) * D + col) = h;
            hprev[q] = h; }
    }
}

DEVI void f_tail_residual(const Ctx& c, const bf16* A, int lda, const bf16* Bt, int K, bool wxb) {
    float* X = (float*)(c.ws + WS_X); bf16* XB = (bf16*)(c.ws + WS_XB); float* RS = (float*)(c.ws + WS_RS);
    LAS float* red = (LAS float*)c.lds;
    const int fr = c.lane & 15, fq = c.lane >> 4, nks = K / 32;
    for (int task = c.bid; task < 256; task += c.G) {
        const int row0 = M_MAIN + (task >> 4) * 16, col0 = (task & 15) * 64;
        const bf16* ap = A + (size_t)(row0 + fr) * lda + 8 * fq; const bf16* bp = Bt + (size_t)(col0 + fr) * K + 8 * fq;
        f32x4 acc[4];
#pragma unroll
        for (int nb = 0; nb < 4; ++nb) acc[nb] = (f32x4){0.f, 0.f, 0.f, 0.f};
#pragma unroll 1
        for (int ks0 = c.wave; ks0 < nks; ks0 += 32) {
            bf16x8_t af[4], bf_[4][4];
#pragma unroll
            for (int u = 0; u < 4; ++u) { const int ks = ks0 + 8 * u; const bool ok = ks < nks; const unsigned ko = (unsigned)(32 * (ok ? ks : 0));
                af[u] = *(const bf16x8_t*)(ap + ko);
#pragma unroll
                for (int nb = 0; nb < 4; ++nb) bf_[u][nb] = *(const bf16x8_t*)(bp + (unsigned)(16 * nb * K) + ko);
                if (!ok) af[u] = (bf16x8_t){0, 0, 0, 0, 0, 0, 0, 0}; }
#pragma unroll
            for (int u = 0; u < 4; ++u)
#pragma unroll
                for (int nb = 0; nb < 4; ++nb) acc[nb] = __builtin_amdgcn_mfma_f32_16x16x32_bf16(af[u], bf_[u][nb], acc[nb], 0, 0, 0);
        }
        __syncthreads();
#pragma unroll
        for (int nb = 0; nb < 4; ++nb)
#pragma unroll
            for (int r = 0; r < 4; ++r) red[(c.wave * 16 + 4 * fq + r) * 64 + 16 * nb + fr] = acc[nb][r];
        __syncthreads();
        { const int r = c.tid >> 5, cc = 2 * (c.tid & 31); float v0 = 0.f, v1 = 0.f;
#pragma unroll
          for (int w = 0; w < 8; ++w) { const f32x2_t t = *(const LAS f32x2_t*)(red + (w * 16 + r) * 64 + cc); v0 += t.x; v1 += t.y; }
          const size_t o = (size_t)(row0 + r) * D + col0 + cc;
          const unsigned xo = *(const unsigned*)(XB + o); v0 += __uint_as_float(xo << 16); v1 += __uint_as_float(xo & 0xffff0000u);
          (void)wxb; (void)X; *(unsigned*)(XB + o) = pk2(v0, v1);
          const float ss = red32(v0 * v0 + v1 * v1);
          if ((c.tid & 31) == 0) RS[(size_t)(row0 + r) * 16 + (task & 15)] = ss; }
    }
    __syncthreads();
}

__global__ void __launch_bounds__(NT, 2) hybrid_fwd(Args args) {
    extern __shared__ __attribute__((aligned(16))) unsigned char lds_raw[];
    Ctx c;
    c.lds = (LAS unsigned char*)lds_raw;
    c.tid = threadIdx.x; c.lane = c.tid & 63; c.wave = __builtin_amdgcn_readfirstlane(c.tid >> 6);
    c.G = gridDim.x; c.bid = blockIdx.x; c.ws = args.ws; c.out = args.out;
    volatile LAS unsigned* MISC = (volatile LAS unsigned*)(c.lds + MISC_OFF);
    for (int u = c.tid; u < (LDS_BYTES - LDSCTL_OFF) / 4; u += NT) ((LAS unsigned*)(c.lds + LDSCTL_OFF))[u] = 0u;
    __syncthreads();
    if (c.tid < N_IN) ((LAS unsigned long long*)(c.lds + PTAB_OFF))[c.tid] = (unsigned long long)args.in[c.tid];
    __syncthreads();
    PArgs pa; pa.in.t = (const LAS unsigned long long*)(c.lds + PTAB_OFF);
    (void)xcd_barrier_post((unsigned*)(c.ws + WS_CTL) + 4096, MISC + 8);
#define GRID_BAR() do { XcdBarrier bar_; bar_.bar = (unsigned*)(c.ws + WS_CTL) + 4096; bar_.x = xb_xcc_id(); bar_.st = (volatile LAS unsigned*)(c.lds + MISC_OFF) + 8; xcd_barrier(bar_); } while (0)
#define RETID() do { asm volatile("" : "+s"(c.wave), "+s"(c.bid), "+s"(c.G)); asm volatile("v_mbcnt_lo_u32_b32 %0, -1, 0\n\tv_mbcnt_hi_u32_b32 %0, -1, %0" : "=v"(c.lane)); c.tid = c.wave * 64 + c.lane; } while (0)
#define PHASE(body) do { RETID(); body; GRID_BAR(); } while (0)
    for (int rep = 0; rep < REP_PRO; ++rep) PHASE({ n_prologue(c, pa); f_wprep(c, pa, 1ull, c.bid * NWAVES + c.wave, c.G * NWAVES); });
#pragma unroll 1
    for (int li = 0; li < 4; ++li) {
        const int j = li >> 1;
        if ((li & 1) == 0) {
#if FAST & 1
            for (int rep = 0; rep < REP_G; ++rep) PHASE(f_even_in(c, li));
#else
            PHASE(n_even_in(c, pa, li));
#endif
#if FAST & 32
            for (int rep = 0; rep < REP_MIX; ++rep) PHASE(f_even_mix(c, pa, li, rep == 0 ? 7 : MIX_PART));
#else
            PHASE(n_even_mix(c, pa, li));
#endif
#if FAST & 2
            PHASE({ f_gemm_residual(c, (const bf16*)(c.ws + WS_MIX), 2048, (const bf16*)(c.ws + WS_WB + WB_WOUT + j * SZ_WOUT), 2048, true); RETID(); f_tail_residual(c, (const bf16*)(c.ws + WS_MIX), 2048, (const bf16*)(c.ws + WS_WB + WB_WOUT + j * SZ_WOUT), 2048, true); });
#else
            PHASE(n_gemm_residual(c, (const bf16*)(c.ws + WS_MIX), 2048, pa.in[I_EWOUT] + (size_t)j * 2048 * D, 2048, true));
#endif
        } else {
            for (int rep = 0; rep < REP_NORM; ++rep) PHASE(f_odd_norm(c, pa, li));
#if FAST & 8
            for (int rep = 0; rep < REP_G; ++rep) PHASE(f_odd_in(c, li));
#else
            PHASE(n_odd_in(c, pa, li));
#endif
#if FAST & 16
            for (int rep = 0; rep < REP_G; ++rep) PHASE(f_odd_lora(c, pa, li));
#else
            PHASE(n_odd_lora(c, pa, li));
#endif
#if FAST & 128
#if FAST & 512
            for (int rep = 0; rep < REP_SCAN; ++rep) PHASE(f_odd_scan3(c, pa, li, rep == 0 ? 3 : SCAN_PART));
#elif FAST & 256
            for (int rep = 0; rep < REP_SCAN; ++rep) { PHASE(f_odd_scan2(c, pa, li)); PHASE(f_rwkv_post(c, pa, li)); }
#else
            for (int rep = 0; rep < REP_SCAN; ++rep) PHASE(f_odd_scan(c, pa, li));
#endif
#else
            for (int rep = 0; rep < REP_SCAN; ++rep) PHASE(n_odd_scan(c, pa, li));
#endif
#if FAST & 2
            PHASE({ f_gemm_residual(c, (const bf16*)(c.ws + WS_O), D, (const bf16*)(c.ws + WS_WB + WB_WO + j * SZ_WO), D, true); RETID(); f_tail_residual(c, (const bf16*)(c.ws + WS_O), D, (const bf16*)(c.ws + WS_WB + WB_WO + j * SZ_WO), D, true); });
#else
            PHASE(n_gemm_residual(c, (const bf16*)(c.ws + WS_O), D, pa.in[I_OWO] + (size_t)j * D * D, D, true));
#endif
        }
#if FUSE_ACT
        for (int rep = 0; rep < REP_G; ++rep) PHASE(f_ffn_up_act(c, pa, li));
        PHASE(f_ffn_fix(c, pa, li));
#else
#if FAST & 4
        for (int rep = 0; rep < REP_G; ++rep) PHASE(f_ffn_up(c, li));
#else
        PHASE(n_ffn_up(c, pa, li));
#endif
#if FAST & 64
        for (int rep = 0; rep < REP_ACT; ++rep) PHASE(f_ffn_act(c, pa, li));
#else
        for (int rep = 0; rep < REP_ACT; ++rep) PHASE(n_ffn_act(c, pa, li));
#endif
#endif
#if FAST & 2
        PHASE({ f_gemm_residual(c, (const bf16*)(c.ws + WS_ACT), DFF, (const bf16*)(c.ws + WS_WB + WB_WDN + li * SZ_WDN), DFF, li == 1); RETID(); f_tail_residual(c, (const bf16*)(c.ws + WS_ACT), DFF, (const bf16*)(c.ws + WS_WB + WB_WDN + li * SZ_WDN), DFF, li == 1);   });
#else
        PHASE(n_gemm_residual(c, (const bf16*)(c.ws + WS_ACT), DFF, pa.in[I_FWDN] + (size_t)li * DFF * D, DFF, true));
#endif
    }
    RETID(); n_final(c, pa);
#undef PHASE
}

extern "C" void kernel_launch(void* const* d_in, const int* in_sizes, int n_in, void* d_out, int out_size, void* d_ws, size_t ws_size, hipStream_t stream) {
    static int grid = 0;
    if (grid == 0) {
        if (n_in != N_IN || (size_t)out_size != O_END || ws_size < WS_END) {
            fprintf(stderr, "kernel_launch: unexpected shapes: n_in %d (want %d), out %d (want %zu), ws %zu (want >= %zu)\n", n_in, (int)N_IN, out_size, (size_t)O_END, ws_size, (size_t)WS_END);
            grid = -1; return; }
        int dev = 0, cus = 0;
        if (hipGetDevice(&dev) != hipSuccess || hipDeviceGetAttribute(&cus, hipDeviceAttributeMultiprocessorCount, dev) != hipSuccess) { grid = -1; return; }
        if (hipFuncSetAttribute((const void*)hybrid_fwd, hipFuncAttributeMaxDynamicSharedMemorySize, LDS_BYTES) != hipSuccess) { fprintf(stderr, "kernel_launch: hipFuncSetAttribute failed\n"); grid = -1; return; }
        int per_cu = 0;
        (void)hipOccupancyMaxActiveBlocksPerMultiprocessor(&per_cu, (const void*)hybrid_fwd, NT, LDS_BYTES);
        (void)hipGetLastError();
        grid = cus;
    }
    if (grid < 0) return;
    if (hipMemsetAsync((char*)d_ws + WS_CTL, 0, CTL_ZERO_BYTES, stream) != hipSuccess) return;
    Args a{};
    for (int i = 0; i < N_IN; ++i) a.in[i] = (const float*)d_in[i];
    a.out = (float*)d_out; a.ws = (unsigned char*)d_ws;
    hipLaunchKernelGGL(hybrid_fwd, dim3(grid), dim3(NT), LDS_BYTES, stream, a);
}
```

```cpp
#include <hip/hip_runtime.h>
#include <cstdio>
#include <cstdint>

#define GAS __attribute__((address_space(1)))
#define LAS __attribute__((address_space(3)))
#define DEVI __device__ __forceinline__
typedef unsigned short bf16;
typedef float f32x4 __attribute__((ext_vector_type(4)));
typedef unsigned u32x2 __attribute__((ext_vector_type(2)));
typedef float f32x2_t __attribute__((ext_vector_type(2)));
typedef unsigned u32x4 __attribute__((ext_vector_type(4)));

#ifndef FAST
#define FAST 1023
#endif
#ifndef REP_SCAN
#define REP_SCAN 1
#endif
#ifndef REP_ACT
#define REP_ACT 1
#endif
#ifndef REP_MIX
#define REP_MIX 1
#endif
#ifndef REP_PRO
#define REP_PRO 1
#endif
#ifndef FUSE_ACT
#define FUSE_ACT 1
#endif
#ifndef REP_G
#define REP_G 1
#endif
#ifndef REP_NORM
#define REP_NORM 1
#endif
constexpr int D = 1024, TP = 2064, NMETA = 16, SEQ = 2048, BP = 8, BS = 128;
constexpr int MP = BP * TP;
constexpr int M = MP + BS;
constexpr int NIN = 5120, DFF = 2816, NUP = 2 * DFF;
constexpr int M_MAIN = 16384;
constexpr int LML = 640;
constexpr int NWAVES = 8, NT = NWAVES * 64;

constexpr size_t MiB = 1u << 20;
constexpr size_t WS_CTL = 0, CTL_ZERO_BYTES = 1 * MiB;
constexpr size_t WS_RS = 1 * MiB;
constexpr size_t WS_ROPE = 3 * MiB;
constexpr size_t WS_WB = 5 * MiB;
constexpr size_t WS_X = 124 * MiB;
constexpr size_t WS_R = 124 * MiB;
constexpr size_t WS_XB = 189 * MiB;
constexpr size_t WS_BIG = 222 * MiB;
constexpr size_t SZ_ACT1 = (size_t)M * D * 2;
constexpr size_t WS_Z = WS_BIG, WS_MIX = WS_BIG + 163 * MiB;
constexpr size_t WS_U = WS_BIG, WS_ACT = WS_BIG + 179 * MiB;
constexpr size_t WS_XMIX = WS_BIG, WS_K = WS_BIG + 195 * MiB, WS_V = WS_BIG + 228 * MiB;
constexpr size_t WS_WDEC = WS_BIG, WS_AG = WS_BIG + 65 * MiB, WS_GG = WS_AG + SZ_ACT1, WS_VG = WS_GG + SZ_ACT1, WS_O = WS_VG + SZ_ACT1;
constexpr size_t WS_END = WS_BIG + 270 * MiB;
static_assert(WS_O + SZ_ACT1 <= WS_K && WS_ACT + (size_t)M * DFF * 2 <= WS_END && WS_V + SZ_ACT1 <= WS_END && WS_MIX + (size_t)M * 2048 * 2 <= WS_END, "ws map");
constexpr size_t DO_VFIRST = 0, DO_LMID = 33 * MiB;
static_assert(DO_LMID + (size_t)M * LML * 2 <= (size_t)BP * SEQ * D * 4, "d_out scratch");

constexpr size_t O_YP = 0, O_YS = O_YP + (size_t)BP * SEQ * D, O_RETP = O_YS + (size_t)BS * D, O_LRUP = O_RETP + (size_t)2 * BP * 4 * 128 * 256,
    O_LCONVP = O_LRUP + (size_t)2 * BP * 1024, O_RWKVP = O_LCONVP + (size_t)2 * BP * 3 * 1024, O_SHIFTP = O_RWKVP + (size_t)2 * BP * 16 * 64 * 64,
    O_FCONVP = O_SHIFTP + (size_t)2 * BP * 1024, O_RETS = O_FCONVP + (size_t)4 * BP * 2 * DFF, O_LRUS = O_RETS + (size_t)2 * BS * 4 * 128 * 256,
    O_LCONVS = O_LRUS + (size_t)2 * BS * 1024, O_RWKVS = O_LCONVS + (size_t)2 * BS * 3 * 1024, O_SHIFTS = O_RWKVS + (size_t)2 * BS * 16 * 64 * 64,
    O_FCONVS = O_SHIFTS + (size_t)2 * BS * 1024, O_END = O_FCONVS + (size_t)4 * BS * 2 * DFF;

enum { I_XP = 0, I_XS, I_SRET, I_SLRU, I_SLCONV, I_SRWKV, I_SSHIFT, I_SFCONV, I_META, I_NMIX, I_NFFN, I_NFIN,
       I_EWIN, I_ERGN, I_ECW, I_ECB, I_EWA, I_EBA, I_EWX, I_EBX, I_ELAM, I_EWOUT,
       I_OMIX, I_OWR, I_OWK, I_OWV, I_OW0, I_OW1, I_OW2, I_OA0, I_OA1, I_OA2, I_OV0, I_OV1, I_OV2, I_OG1, I_OG2, I_OKK, I_OKA, I_ORK, I_OGNG, I_OGNB, I_OWO,
       I_FWUP, I_FCW, I_FCB, I_FWDN, N_IN };

constexpr int RING_BYTES = 143360, LDSCTL_OFF = RING_BYTES, MISC_OFF = LDSCTL_OFF + 320, LDS_BYTES = 147456;

DEVI float bf2f(bf16 v) { return __uint_as_float((unsigned)v << 16); }
typedef __bf16 hbf16x2_t __attribute__((ext_vector_type(2)));
DEVI unsigned pk2(float lo, float hi) { const f32x2_t v = (f32x2_t){lo, hi}; return __builtin_bit_cast(unsigned, __builtin_convertvector(v, hbf16x2_t)); }
DEVI bf16 f2bf(float f) { return (bf16)(pk2(f, f) & 0xffffu); }
DEVI float wave_sum(float v) {
#pragma unroll
    for (int o = 1; o < 64; o <<= 1) v += __shfl_xor(v, o);
    return v;
}
DEVI float rcpf_(float x) { return __builtin_amdgcn_rcpf(x); }
DEVI float sigmoidf_(float x) { return rcpf_(1.f + __expf(-x)); }
DEVI float siluf_(float x) { return x * rcpf_(1.f + __expf(-x)); }
DEVI float tanhf_(float x) { return 2.f * rcpf_(1.f + __expf(-2.f * x)) - 1.f; }
DEVI float geluf_(float x) { return x * rcpf_(1.f + __expf(-1.5957691216057308f * (x + 0.044715f * x * x * x))); }
DEVI float softplusf_(float x) { return fmaxf(x, 0.f) + log1pf(__expf(-fabsf(x))); }

#define XB_TMO      128
#define XB_XCNT(j)  (256  + 64 * (j))
#define XB_XSUB(j)  (1280 + 64 * (j))
#define XB_XGEN(j)  (2304 + 64 * (j))
#define XB_TOP      3328
#define XB_TOPGEN   3392
#define XCD_BAR_WORDS 3456
#define XB_SPIN_CAP (1u << 22)
DEVI unsigned xb_ld(unsigned* p)              { return __hip_atomic_load(p, __ATOMIC_RELAXED, __HIP_MEMORY_SCOPE_AGENT); }
DEVI unsigned xb_add(unsigned* p, unsigned v) { return __hip_atomic_fetch_add(p, v, __ATOMIC_RELAXED, __HIP_MEMORY_SCOPE_AGENT); }
DEVI unsigned xb_xcc_id() { return (unsigned)__builtin_amdgcn_s_getreg((3 << 11) | 20) & 0xFu; }
#define XB_SPIN(cond, bar) do { unsigned _sp = 0; while (cond) { __builtin_amdgcn_s_sleep(1); \
    if ((++_sp & 255u) == 0u) { if (xb_ld(&(bar)[XB_TMO])) break; if (_sp > XB_SPIN_CAP) { atomicAdd(&(bar)[XB_TMO], 1u); break; } } } } while (0)
struct XcdBarrier { unsigned* bar; unsigned x; volatile LAS unsigned* st; };
DEVI XcdBarrier xcd_barrier_post(unsigned* bar, volatile LAS unsigned* st) {
    XcdBarrier b; b.bar = bar; b.x = xb_xcc_id(); b.st = st;
    if (threadIdx.x == 0) (void)xb_add(&bar[XB_XCNT(b.x)], 1u);
    return b;
}
DEVI void xcd_barrier_complete(unsigned* bar, unsigned x, unsigned& nloc, unsigned& nx) {
    const unsigned G = gridDim.x * gridDim.y * gridDim.z;
    unsigned sum, cnt, mine, sp = 0u;
    for (;;) {
        sum = 0u; cnt = 0u; mine = 0u;
#pragma unroll
        for (unsigned j = 0; j < 16; ++j) { const unsigned c = xb_ld(&bar[XB_XCNT(j)]); sum += c; cnt += (c > 0u) ? 1u : 0u; mine = (j == x) ? c : mine; }
        if (sum == G) break;
        __builtin_amdgcn_s_sleep(1);
        if ((++sp & 255u) == 0u) { if (xb_ld(&bar[XB_TMO])) break; if (sp > XB_SPIN_CAP) { atomicAdd(&bar[XB_TMO], 1u); break; } }
    }
    nloc = mine > 0u ? mine : 1u; nx = cnt > 0u ? cnt : 1u;
}
DEVI void xcd_barrier(const XcdBarrier& b) {
    asm volatile("s_waitcnt vmcnt(0)" ::: "memory");
    __syncthreads();
    if (threadIdx.x == 0) {
        unsigned* bar = b.bar;
        __builtin_amdgcn_s_waitcnt(0);
        unsigned nloc = b.st[0], nx = b.st[1];
        if (nloc == 0u) { xcd_barrier_complete(bar, b.x, nloc, nx); b.st[0] = nloc; b.st[1] = nx; }
        const unsigned old = xb_add(&bar[XB_XSUB(b.x)], 1u);
        const unsigned gen = old / nloc;
        if (old + 1u == (gen + 1u) * nloc) {
            __builtin_amdgcn_fence(__ATOMIC_RELEASE, "agent");
            asm volatile("s_waitcnt vmcnt(0)" ::: "memory");
            const unsigned og = xb_add(&bar[XB_TOP], 1u);
            const unsigned tg = og / nx;
            if (og + 1u == (tg + 1u) * nx) xb_add(&bar[XB_TOPGEN], 1u);
            else XB_SPIN(xb_ld(&bar[XB_TOPGEN]) == tg, bar);
            __builtin_amdgcn_fence(__ATOMIC_ACQUIRE, "agent");
            xb_add(&bar[XB_XGEN(b.x)], 1u);
            asm volatile("s_waitcnt vmcnt(0)" ::: "memory");
        } else {
            XB_SPIN(xb_ld(&bar[XB_XGEN(b.x)]) == gen, bar);
            __builtin_amdgcn_fence(__ATOMIC_ACQUIRE, "agent");
            asm volatile("s_waitcnt vmcnt(0)" ::: "memory");
        }
    }
    __syncthreads();
}

struct Args { const float* in[N_IN]; float* out; unsigned char* ws; };
constexpr int PTAB_OFF = MISC_OFF + 128;
struct InTab { const LAS unsigned long long* t;
    DEVI const float* operator[](int i) const { const unsigned long long v = t[i];
        const unsigned lo = __builtin_amdgcn_readfirstlane((unsigned)v), hi = __builtin_amdgcn_readfirstlane((unsigned)(v >> 32));
        return (const float*)(const __attribute__((address_space(1))) float*)(((unsigned long long)hi << 32) | lo); } };
struct PArgs { InTab in; };

struct Ctx {
    LAS unsigned char* lds;
    int tid, lane, wave, G, bid;
    unsigned char* ws; float* out;
};
DEVI int row_pos(int row) { return row < MP ? (row % TP) : TP; }
DEVI float row_rstd(const float* RS, int row) {
    const f32x4* p = (const f32x4*)(RS + (size_t)row * 16);
    const f32x4 a = p[0], b = p[1], c = p[2], d = p[3];
    const float s = ((a.x + a.y) + (a.z + a.w)) + ((b.x + b.y) + (b.z + b.w)) + ((c.x + c.y) + (c.z + c.w)) + ((d.x + d.y) + (d.z + d.w));
    return __builtin_amdgcn_rsqf(s * (1.0f / D) + 1e-6f);
}
DEVI float row_rstd_q(const float* RS, int row, int fq) {
    const f32x4 a = *(const f32x4*)(RS + (size_t)row * 16 + 4 * fq);
    float s = (a.x + a.y) + (a.z + a.w);
    u32x2 r = __builtin_amdgcn_permlane16_swap(__float_as_uint(s), __float_as_uint(s), false, false); s = __uint_as_float(r.x) + __uint_as_float(r.y);
    r = __builtin_amdgcn_permlane32_swap(__float_as_uint(s), __float_as_uint(s), false, false); s = __uint_as_float(r.x) + __uint_as_float(r.y);
    return __builtin_amdgcn_rsqf(s * (1.0f / D) + 1e-6f);
}

DEVI void n_prologue(const Ctx& c, const PArgs& a) {
    float* X = (float*)(c.ws + WS_X); bf16* XB = (bf16*)(c.ws + WS_XB); float* RS = (float*)(c.ws + WS_RS);
    const int gw = c.bid * NWAVES + c.wave, NGW = c.G * NWAVES;
    for (int row = gw; row < M; row += NGW) {
        const float* src;
        if (row < MP) { const int b = row / TP, t = row % TP; src = t < NMETA ? a.in[I_META] + (size_t)t * D : a.in[I_XP] + ((size_t)b * SEQ + (t - NMETA)) * D; }
        else src = a.in[I_XS] + (size_t)(row - MP) * D;
        float ss = 0.f;
#pragma unroll
        for (int j = 0; j < 4; ++j) {
            const f32x4 v = __builtin_nontemporal_load((const f32x4*)(src + j * 256 + c.lane * 4));
            (void)X;
            u32x2 w; w.x = pk2(v.x, v.y); w.y = pk2(v.z, v.w);
            *(u32x2*)(XB + (size_t)row * D + j * 256 + c.lane * 4) = w;
            ss += (v.x * v.x + v.y * v.y) + (v.z * v.z + v.w * v.w);
        }
        ss = wave_sum(ss);
        if (c.lane < 16) RS[(size_t)row * 16 + c.lane] = c.lane == 0 ? ss : 0.f;
    }
    float* ROPE = (float*)(c.ws + WS_ROPE);
    for (int e = c.bid * NT + c.tid; e < (TP + 1) * 64; e += c.G * NT) {
        const int p = e >> 6, d = e & 63;
        const double pos = p < TP ? (double)p : 16384.0;
        const double inv = exp(-9.210340371976184 * ((double)d / 63.0));
        const double rev = pos * inv * 0.15915494309189535;
        const float fr = (float)(rev - rint(rev));
        ROPE[2 * e] = __builtin_amdgcn_cosf(fr); ROPE[2 * e + 1] = __builtin_amdgcn_sinf(fr);
    }
}

DEVI void ngemm_tile(const Ctx& c, const bf16* A, int lda, const float* W, int ldw, int ncv, int K, const float* gain, int row0, float (&acc)[4][4]) {
    LAS float* As = (LAS float*)c.lds;
    LAS float* Bs = (LAS float*)(c.lds + 8192);
#pragma unroll
    for (int j = 0; j < 4; ++j)
#pragma unroll
        for (int i = 0; i < 4; ++i) acc[j][i] = 0.f;
    const int ar = c.tid >> 4, ak = (c.tid & 15) * 2;
    for (int k0 = 0; k0 < K; k0 += 32) {
        __syncthreads();
        { const unsigned v = *(const unsigned*)(A + (size_t)(row0 + ar) * lda + k0 + ak);
          float lo = __uint_as_float(v << 16), hi = __uint_as_float(v & 0xffff0000u);
          if (gain) { lo *= gain[k0 + ak]; hi *= gain[k0 + ak + 1]; }
          As[ar * 33 + ak] = lo; As[ar * 33 + ak + 1] = hi; }
#pragma unroll
        for (int i = 0; i < 16; ++i) { const int idx = i * NT + c.tid, kk = idx >> 8, cc = idx & 255;
            Bs[idx] = cc < ncv ? W[(size_t)(k0 + kk) * ldw + cc] : 0.f; }
        __syncthreads();
#pragma unroll 8
        for (int kk = 0; kk < 32; ++kk) {
            float av[4], bv[4];
#pragma unroll
            for (int j = 0; j < 4; ++j) av[j] = As[(c.wave * 4 + j) * 33 + kk];
#pragma unroll
            for (int i = 0; i < 4; ++i) bv[i] = Bs[kk * 256 + c.lane + 64 * i];
#pragma unroll
            for (int j = 0; j < 4; ++j)
#pragma unroll
                for (int i = 0; i < 4; ++i) acc[j][i] += av[j] * bv[i];
        }
    }
}

DEVI void nepi_residual(const Ctx& c, int row0, int pn, const float (&acc)[4][4], bool write_xb) {
    float* X = (float*)(c.ws + WS_X); bf16* XB = (bf16*)(c.ws + WS_XB); float* RS = (float*)(c.ws + WS_RS);
#pragma unroll
    for (int j = 0; j < 4; ++j) { const int row = row0 + 4 * c.wave + j; float ss = 0.f;
#pragma unroll
        for (int i = 0; i < 4; ++i) { const int col = pn * 256 + c.lane + 64 * i; const float v = X[(size_t)row * D + col] + acc[j][i];
            X[(size_t)row * D + col] = v; if (write_xb) XB[(size_t)row * D + col] = f2bf(v); ss += v * v; }
        ss = wave_sum(ss);
        if (c.lane < 4) RS[(size_t)row * 16 + pn * 4 + c.lane] = c.lane == 0 ? ss : 0.f; }
}

DEVI void n_even_in(const Ctx& c, const PArgs& a, int li) {
    const int j = li >> 1;
    const bf16* XB = (const bf16*)(c.ws + WS_XB); const float* RS = (const float*)(c.ws + WS_RS); const float* ROPE = (const float*)(c.ws + WS_ROPE);
    bf16* Z = (bf16*)(c.ws + WS_Z);
    const float* W = a.in[I_EWIN] + (size_t)j * D * NIN; const float* gain = a.in[I_NMIX] + (size_t)li * D;
    const int ntn = NIN / 256, nu = (M / 32) * ntn;
    for (int u = c.bid; u < nu; u += c.G) {
        const int pn = u % ntn, row0 = (u / ntn) * 32;
        float acc[4][4];
        ngemm_tile(c, XB, D, W + pn * 256, NIN, 256, D, gain, row0, acc);
#pragma unroll
        for (int jj = 0; jj < 4; ++jj) { const int row = row0 + 4 * c.wave + jj; const float rs = row_rstd(RS, row);
            float v[4];
#pragma unroll
            for (int i = 0; i < 4; ++i) v[i] = acc[jj][i] * rs;
            if (pn < 4) {
                const float cs = ROPE[((size_t)row_pos(row) * 64 + c.lane) * 2], sn = ROPE[((size_t)row_pos(row) * 64 + c.lane) * 2 + 1];
                const float sc = pn >= 2 ? 0.08838834764831845f : 1.f;
                const float a0 = v[0] * cs - v[1] * sn, a1 = v[0] * sn + v[1] * cs, b0 = v[2] * cs - v[3] * sn, b1 = v[2] * sn + v[3] * cs;
                v[0] = a0 * sc; v[1] = a1 * sc; v[2] = b0 * sc; v[3] = b1 * sc;
            } else if (pn >= 8 && pn < 12) {
#pragma unroll
                for (int i = 0; i < 4; ++i) v[i] = siluf_(v[i]);
            } else if (pn >= 16) {
#pragma unroll
                for (int i = 0; i < 4; ++i) v[i] = geluf_(v[i]);
            }
#pragma unroll
            for (int i = 0; i < 4; ++i) Z[(size_t)row * NIN + pn * 256 + c.lane + 64 * i] = f2bf(v[i]); }
    }
}

DEVI void n_ret_unit(const Ctx& c, const PArgs& a, int j, int hd, int row0, int ntok, const float* S0, float* Sout) {
    const bf16* Z = (const bf16*)(c.ws + WS_Z); bf16* MIX = (bf16*)(c.ws + WS_MIX);
    LAS float* qs = (LAS float*)c.lds;
    LAS float* ks = qs + 8 * 128;
    LAS float* vs = ks + 8 * 128;
    LAS float* op = vs + 8 * 256;
    const int e = c.tid & 255, half = c.tid >> 8;
    const float gamma = 1.f - exp2f(-5.f - (float)hd);
    const float* gn = a.in[I_ERGN] + (size_t)j * 1024 + hd * 256;
    float S[64];
    if (S0) { const float* sp = S0 + (size_t)half * 64 * 256 + e;
#pragma unroll
        for (int d8 = 0; d8 < 8; ++d8) { asm volatile("" ::: "memory");
#pragma unroll
            for (int dd = 0; dd < 8; ++dd) S[d8 * 8 + dd] = sp[(size_t)(d8 * 8 + dd) * 256]; }
    } else {
#pragma unroll
        for (int dd = 0; dd < 64; ++dd) S[dd] = 0.f; }
    for (int t0 = 0; t0 < ntok; t0 += 8) {
        __syncthreads();
#pragma unroll
        for (int i = 0; i < 8; ++i) { const int idx = i * NT + c.tid, tt = idx >> 9, cc = idx & 511; const int row = row0 + t0 + tt;
            float v = 0.f;
            if (t0 + tt < ntok) { const int col = cc < 128 ? hd * 128 + cc : (cc < 256 ? 512 + hd * 128 + (cc - 128) : 1024 + hd * 256 + (cc - 256)); v = bf2f(Z[(size_t)row * NIN + col]); }
            if (cc < 128) qs[tt * 128 + cc] = v; else if (cc < 256) ks[tt * 128 + cc - 128] = v; else vs[tt * 256 + cc - 256] = v; }
        __syncthreads();
        for (int tt = 0; tt < 8; ++tt) {
            if (t0 + tt < ntok) {
                const float ve = vs[tt * 256 + e]; float o = 0.f;
#pragma unroll
                for (int dd = 0; dd < 64; ++dd) { S[dd] = gamma * S[dd] + ks[tt * 128 + half * 64 + dd] * ve; o += qs[tt * 128 + half * 64 + dd] * S[dd]; }
                op[(tt * 2 + half) * 256 + e] = o;
            }
        }
        __syncthreads();
        { const int tt = c.wave; const int row = row0 + t0 + tt;
          if (t0 + tt < ntok) {
              float o[4]; float s = 0.f;
#pragma unroll
              for (int i = 0; i < 4; ++i) { const int ee = c.lane + 64 * i; o[i] = op[(tt * 2) * 256 + ee] + op[(tt * 2 + 1) * 256 + ee]; s += o[i]; }
              const float mu = wave_sum(s) * (1.f / 256.f); float q = 0.f;
#pragma unroll
              for (int i = 0; i < 4; ++i) { o[i] -= mu; q += o[i] * o[i]; }
              const float rstd = __builtin_amdgcn_rsqf(wave_sum(q) * (1.f / 256.f) + 1e-6f);
#pragma unroll
              for (int i = 0; i < 4; ++i) { const int ee = c.lane + 64 * i; const float ga = bf2f(Z[(size_t)row * NIN + 2048 + hd * 256 + ee]);
                  MIX[(size_t)row * 2048 + hd * 256 + ee] = f2bf(ga * o[i] * rstd * gn[ee]); }
          } }
    }
    { float* sp = Sout + (size_t)half * 64 * 256 + e;
#pragma unroll
      for (int d8 = 0; d8 < 8; ++d8) { asm volatile("" ::: "memory");
#pragma unroll
          for (int dd = 0; dd < 8; ++dd) sp[(size_t)(d8 * 8 + dd) * 256] = S[d8 * 8 + dd]; } }
    __syncthreads();
}

DEVI void n_lru_unit(const Ctx& c, const PArgs& a, int j, int g, int row0, int ntok, const float* hist  , const float* h0  , float* out_h, float* out_conv) {
    const bf16* Z = (const bf16*)(c.ws + WS_Z); bf16* MIX = (bf16*)(c.ws + WS_MIX);
    LAS float* xcs = (LAS float*)c.lds;
    const int d = c.tid >> 2, p = c.tid & 3, ch = g * 128 + d;
    float wa[32], wx[32];
    { const float* WA = a.in[I_EWA] + ((size_t)(j * 8 + g) * 128 + 32 * p) * 128 + d; const float* WX = a.in[I_EWX] + ((size_t)(j * 8 + g) * 128 + 32 * p) * 128 + d;
#pragma unroll
      for (int cc = 0; cc < 32; ++cc) { wa[cc] = WA[(size_t)cc * 128]; wx[cc] = WX[(size_t)cc * 128]; } }
    const float* CW = a.in[I_ECW] + (size_t)j * 4 * 1024;
    const float cw0 = CW[ch], cw1 = CW[1024 + ch], cw2 = CW[2048 + ch], cw3 = CW[3072 + ch], cb = a.in[I_ECB][(size_t)j * 1024 + ch];
    const float ba = a.in[I_EBA][(size_t)j * 1024 + ch], bx = a.in[I_EBX][(size_t)j * 1024 + ch];
    const float sp = softplusf_(-a.in[I_ELAM][(size_t)j * 1024 + ch]);
    float x1 = hist ? hist[2 * 1024 + ch] : 0.f, x2 = hist ? hist[1024 + ch] : 0.f, x3 = hist ? hist[ch] : 0.f;
    float h = h0 ? h0[ch] : 0.f;
    for (int t = 0; t < ntok; ++t) {
        const int row = row0 + t;
        float xcv = 0.f;
        if (p == 0) { const float xb = bf2f(Z[(size_t)row * NIN + 3072 + ch]); xcv = cb + cw3 * xb + cw2 * x1 + cw1 * x2 + cw0 * x3; x3 = x2; x2 = x1; x1 = xb; xcs[d] = xcv; }
        __syncthreads();
        float sr = 0.f, si = 0.f;
#pragma unroll
        for (int cc = 0; cc < 32; ++cc) { const float xv = xcs[32 * p + cc]; sr += xv * wa[cc]; si += xv * wx[cc]; }
        sr += __shfl_xor(sr, 1); sr += __shfl_xor(sr, 2); si += __shfl_xor(si, 1); si += __shfl_xor(si, 2);
        if (p == 0) {
            const float r = sigmoidf_(sr + ba), ig = sigmoidf_(si + bx);
            const float la = -8.f * r * sp, av = __expf(la), u = sqrtf(-expm1f(2.f * la)) * (ig * xcv);
            h = av * h + u;
            MIX[(size_t)row * 2048 + 1024 + ch] = f2bf(h * bf2f(Z[(size_t)row * NIN + 4096 + ch]));
        }
        __syncthreads();
    }
    if (p == 0) { out_h[ch] = h; out_conv[ch] = x3; out_conv[1024 + ch] = x2; out_conv[2048 + ch] = x1; }
}

DEVI void n_even_mix(const Ctx& c, const PArgs& a, int li) {
    const int j = li >> 1;
    const int NU = 32 + 64 + 512 + 1024;
    for (int u = c.bid; u < NU; u += c.G) {
        if (u < 32 || (u >= 96 && u < 608)) {
            const bool pr = u < 32; const int v = pr ? u : u - 96, b = v >> 2, hd = v & 3;
            const float* S0 = pr ? nullptr : a.in[I_SRET] + ((size_t)(j * BS + b) * 4 + hd) * 128 * 256;
            float* So = pr ? c.out + O_RETP + ((size_t)(j * BP + b) * 4 + hd) * 128 * 256 : c.out + O_RETS + ((size_t)(j * BS + b) * 4 + hd) * 128 * 256;
            n_ret_unit(c, a, j, hd, pr ? b * TP : MP + b, pr ? TP : 1, S0, So);
        } else {
            const bool pr = u < 96; const int v = pr ? u - 32 : u - 608, b = v >> 3, g = v & 7;
            const float* hist = pr ? nullptr : a.in[I_SLCONV] + (size_t)(j * BS + b) * 3 * 1024;
            const float* h0 = pr ? nullptr : a.in[I_SLRU] + (size_t)(j * BS + b) * 1024;
            float* oh = pr ? c.out + O_LRUP + (size_t)(j * BP + b) * 1024 : c.out + O_LRUS + (size_t)(j * BS + b) * 1024;
            float* oc = pr ? c.out + O_LCONVP + (size_t)(j * BP + b) * 3 * 1024 : c.out + O_LCONVS + (size_t)(j * BS + b) * 3 * 1024;
            n_lru_unit(c, a, j, g, pr ? b * TP : MP + b, pr ? TP : 1, hist, h0, oh, oc);
        }
    }
}

DEVI void n_gemm_residual(const Ctx& c, const bf16* A, int lda, const float* W, int K, bool write_xb) {
    const int nu = (M / 32) * 4;
    for (int u = c.bid; u < nu; u += c.G) {
        const int pn = u & 3, row0 = (u >> 2) * 32;
        float acc[4][4];
        ngemm_tile(c, A, lda, W + pn * 256, D, 256, K, nullptr, row0, acc);
        nepi_residual(c, row0, pn, acc, write_xb);
    }
}

DEVI void n_ffn_up(const Ctx& c, const PArgs& a, int li) {
    const bf16* XB = (const bf16*)(c.ws + WS_XB); const float* RS = (const float*)(c.ws + WS_RS); bf16* U = (bf16*)(c.ws + WS_U);
    const float* W = a.in[I_FWUP] + (size_t)li * D * NUP; const float* gain = a.in[I_NFFN] + (size_t)li * D;
    const int ntn = NUP / 256, nu = (M / 32) * ntn;
    for (int u = c.bid; u < nu; u += c.G) {
        const int pn = u % ntn, row0 = (u / ntn) * 32;
        float acc[4][4];
        ngemm_tile(c, XB, D, W + pn * 256, NUP, 256, D, gain, row0, acc);
#pragma unroll
        for (int jj = 0; jj < 4; ++jj) { const int row = row0 + 4 * c.wave + jj; const float rs = row_rstd(RS, row);
#pragma unroll
            for (int i = 0; i < 4; ++i) U[(size_t)row * NUP + pn * 256 + c.lane + 64 * i] = f2bf(acc[jj][i] * rs); }
    }
}

DEVI void n_ffn_act(const Ctx& c, const PArgs& a, int li) {
    const bf16* U = (const bf16*)(c.ws + WS_U); bf16* ACT = (bf16*)(c.ws + WS_ACT);
    const float* CW = a.in[I_FCW] + (size_t)li * 3 * DFF; const float* CB = a.in[I_FCB] + (size_t)li * DFF;
    const size_t total = (size_t)M * DFF;
    for (size_t e = (size_t)c.bid * NT + c.tid; e < total; e += (size_t)c.G * NT) {
        const int row = (int)(e / DFF), col = (int)(e % DFF);
        const float u0 = bf2f(U[(size_t)row * NUP + col]); float u1, u2;
        if (row < MP) { const int b = row / TP, t = row % TP;
            u1 = t >= 1 ? bf2f(U[(size_t)(row - 1) * NUP + col]) : 0.f; u2 = t >= 2 ? bf2f(U[(size_t)(row - 2) * NUP + col]) : 0.f;
            if (t >= TP - 2) c.out[O_FCONVP + ((size_t)(li * BP + b) * 2 + (t - (TP - 2))) * DFF + col] = u0;
        } else { const int b = row - MP; const float* st = a.in[I_SFCONV] + (size_t)(li * BS + b) * 2 * DFF;
            u1 = st[DFF + col]; u2 = st[col];
            float* so = c.out + O_FCONVS + (size_t)(li * BS + b) * 2 * DFF; so[col] = u1; so[DFF + col] = u0; }
        const float cv = CB[col] + CW[2 * DFF + col] * u0 + CW[DFF + col] * u1 + CW[col] * u2;
        ACT[(size_t)row * DFF + col] = f2bf(geluf_(cv) * bf2f(U[(size_t)row * NUP + DFF + col]));
    }
}

DEVI void n_odd_norm(const Ctx& c, const PArgs& a, int li) {
    const int j = li >> 1;
    const bf16* XB = (const bf16*)(c.ws + WS_XB); const float* RS = (const float*)(c.ws + WS_RS); bf16* XM = (bf16*)(c.ws + WS_XMIX);
    const float* gain = a.in[I_NMIX] + (size_t)li * D; const float* mix = a.in[I_OMIX] + (size_t)j * 6 * D;
    const int gw = c.bid * NWAVES + c.wave, NGW = c.G * NWAVES;
    for (int row = gw; row < M; row += NGW) {
        const float rs = row_rstd(RS, row);
        const bool prompt = row < MP; const int b = prompt ? row / TP : row - MP, t = prompt ? row % TP : 0;
        const float rsp = (prompt && t > 0) ? row_rstd(RS, row - 1) : 0.f;
#pragma unroll
        for (int q = 0; q < 4; ++q) { const int col = q * 256 + c.lane * 4;
            const u32x2 xw_ = *(const u32x2*)(XB + (size_t)row * D + col); const f32x4 xv = (f32x4){__uint_as_float(xw_.x << 16), __uint_as_float(xw_.x & 0xffff0000u), __uint_as_float(xw_.y << 16), __uint_as_float(xw_.y & 0xffff0000u)}; const f32x4 gv = *(const f32x4*)(gain + col);
            const f32x4 h = xv * rs * gv; f32x4 hp;
            if (prompt) { if (t > 0) { const u32x2 pw_ = *(const u32x2*)(XB + (size_t)(row - 1) * D + col); hp = (f32x4){__uint_as_float(pw_.x << 16), __uint_as_float(pw_.x & 0xffff0000u), __uint_as_float(pw_.y << 16), __uint_as_float(pw_.y & 0xffff0000u)} * rsp * gv; } else hp = (f32x4){0.f, 0.f, 0.f, 0.f}; }
            else hp = *(const f32x4*)(a.in[I_SSHIFT] + (size_t)(j * BS + b) * D + col);
            const f32x4 xx = hp - h;
#pragma unroll
            for (int n = 0; n < 6; ++n) { const f32x4 mv = *(const f32x4*)(mix + (size_t)n * D + col); const f32x4 o = h + xx * mv;
                u32x2 w; w.x = pk2(o.x, o.y); w.y = pk2(o.z, o.w); *(u32x2*)(XM + ((size_t)n * M + row) * D + col) = w; }
            if (prompt) { if (t == TP - 1) *(f32x4*)(c.out + O_SHIFTP + (size_t)(j * BP + b) * D + col) = h; }
            else *(f32x4*)(c.out + O_SHIFTS + (size_t)(j * BS + b) * D + col) = h; }
    }
}

DEVI void n_odd_in(const Ctx& c, const PArgs& a, int li) {
    const int j = li >> 1;
    const bf16* XM = (const bf16*)(c.ws + WS_XMIX);
    bf16* R = (bf16*)(c.ws + WS_R); bf16* Kb = (bf16*)(c.ws + WS_K); bf16* Vb = j == 0 ? (bf16*)((unsigned char*)c.out + DO_VFIRST) : (bf16*)(c.ws + WS_V);
    bf16* LM = (bf16*)((unsigned char*)c.out + DO_LMID);
    const int nu = (M / 32) * 16;
    for (int u = c.bid; u < nu; u += c.G) {
        const int pn = u & 15, row0 = (u >> 4) * 32;
        if (pn == 13 && j == 0) continue;
        const bf16* A; const float* W; int ldw, ncv;
        if (pn < 4) { A = XM + (size_t)0 * M * D; W = a.in[I_OWR] + (size_t)j * D * D + pn * 256; ldw = D; ncv = 256; }
        else if (pn < 8) { A = XM + (size_t)2 * M * D; W = a.in[I_OWK] + (size_t)j * D * D + (pn - 4) * 256; ldw = D; ncv = 256; }
        else if (pn < 12) { A = XM + (size_t)3 * M * D; W = a.in[I_OWV] + (size_t)j * D * D + (pn - 8) * 256; ldw = D; ncv = 256; }
        else if (pn == 12) { A = XM + (size_t)5 * M * D; W = a.in[I_OG1] + (size_t)j * D * 128; ldw = 128; ncv = 128; }
        else if (pn == 13) { A = XM + (size_t)3 * M * D; W = a.in[I_OV1]; ldw = 32; ncv = 32; }
        else if (pn == 14) { A = XM + (size_t)1 * M * D; W = a.in[I_OW1] + (size_t)j * D * 64; ldw = 64; ncv = 64; }
        else { A = XM + (size_t)4 * M * D; W = a.in[I_OA1] + (size_t)j * D * 64; ldw = 64; ncv = 64; }
        float acc[4][4];
        ngemm_tile(c, A, D, W, ldw, ncv, D, nullptr, row0, acc);
#pragma unroll
        for (int jj = 0; jj < 4; ++jj) { const int row = row0 + 4 * c.wave + jj;
#pragma unroll
            for (int i = 0; i < 4; ++i) { const int cl = c.lane + 64 * i; const float v = acc[jj][i];
                if (pn < 4) R[(size_t)row * D + pn * 256 + cl] = f2bf(v);
                else if (pn < 8) Kb[(size_t)row * D + (pn - 4) * 256 + cl] = f2bf(v);
                else if (pn < 12) Vb[(size_t)row * D + (pn - 8) * 256 + cl] = f2bf(v);
                else if (pn == 12) { if (cl < 128) LM[(size_t)row * LML + cl] = f2bf(sigmoidf_(v)); }
                else if (pn == 13) { if (cl < 128) LM[(size_t)row * LML + 128 + cl] = f2bf(v); }
                else if (pn == 14) { if (cl < 128) LM[(size_t)row * LML + 256 + cl] = f2bf(tanhf_(v)); }
                else LM[(size_t)row * LML + 384 + cl] = f2bf(v); } }
    }
}

DEVI void n_odd_lora(const Ctx& c, const PArgs& a, int li) {
    const int j = li >> 1;
    const bf16* LM = (const bf16*)((unsigned char*)c.out + DO_LMID);
    float* WD = (float*)(c.ws + WS_WDEC); bf16* AG = (bf16*)(c.ws + WS_AG); bf16* VG = (bf16*)(c.ws + WS_VG); bf16* GG = (bf16*)(c.ws + WS_GG);
    const int nu = (M / 32) * 16;
    for (int u = c.bid; u < nu; u += c.G) {
        const int pn = u & 15, grp = pn >> 2, pc = pn & 3, row0 = (u >> 4) * 32;
        if (grp == 2 && j == 0) continue;
        const bf16* A; const float* W; int K;
        if (grp == 0) { A = LM + 256; W = a.in[I_OW2] + (size_t)j * 64 * D; K = 64; }
        else if (grp == 1) { A = LM + 384; W = a.in[I_OA2] + (size_t)j * 64 * D; K = 64; }
        else if (grp == 2) { A = LM + 128; W = a.in[I_OV2]; K = 32; }
        else { A = LM; W = a.in[I_OG2] + (size_t)j * 128 * D; K = 128; }
        float acc[4][4];
        ngemm_tile(c, A, LML, W + pc * 256, D, 256, K, nullptr, row0, acc);
#pragma unroll
        for (int jj = 0; jj < 4; ++jj) { const int row = row0 + 4 * c.wave + jj;
#pragma unroll
            for (int i = 0; i < 4; ++i) { const int col = pc * 256 + c.lane + 64 * i; const float v = acc[jj][i];
                if (grp == 0) { const float wl = -softplusf_(-(a.in[I_OW0][(size_t)j * D + col] + v)) - 0.5f; WD[(size_t)row * D + col] = __expf(-__expf(wl)); }
                else if (grp == 1) AG[(size_t)row * D + col] = f2bf(sigmoidf_(a.in[I_OA0][(size_t)j * D + col] + v));
                else if (grp == 2) VG[(size_t)row * D + col] = f2bf(sigmoidf_(a.in[I_OV0][col] + v));
                else GG[(size_t)row * D + col] = f2bf(v); } }
    }
}

DEVI void n_rwkv_unit(const Ctx& c, const PArgs& a, int j, int hd, int row0, int ntok, const float* S0, float* Sout) {
    const bf16* R = (const bf16*)(c.ws + WS_R); const bf16* Kb = (const bf16*)(c.ws + WS_K);
    const bf16* VF = (const bf16*)((unsigned char*)c.out + DO_VFIRST); const bf16* Vb = j == 0 ? VF : (const bf16*)(c.ws + WS_V);
    const float* WD = (const float*)(c.ws + WS_WDEC); const bf16* AG = (const bf16*)(c.ws + WS_AG); const bf16* VG = (const bf16*)(c.ws + WS_VG); const bf16* GG = (const bf16*)(c.ws + WS_GG);
    bf16* O = (bf16*)(c.ws + WS_O);
    LAS float* rs_ = (LAS float*)c.lds;
    LAS float* ws_ = rs_ + 512; LAS float* ks_ = ws_ + 512; LAS float* vs_ = ks_ + 512; LAS float* as_ = vs_ + 512; LAS float* bs_ = as_ + 512; LAS float* ys_ = bs_ + 512; LAS float* bon = ys_ + 512;
    const int i = c.tid >> 3, q = c.tid & 7;
    const int st = c.wave, sc = c.lane, ch = hd * 64 + sc;
    const float kkc = a.in[I_OKK][(size_t)j * D + ch], kac = a.in[I_OKA][(size_t)j * D + ch], rkc = a.in[I_ORK][(size_t)j * D + ch];
    const float gng = a.in[I_OGNG][(size_t)j * D + ch], gnb = a.in[I_OGNB][(size_t)j * D + ch];
    float s[8];
#pragma unroll
    for (int jj = 0; jj < 8; ++jj) s[jj] = 0.f;
    if (S0) {
#pragma unroll
        for (int jj = 0; jj < 8; ++jj) s[jj] = S0[(size_t)i * 64 + 8 * q + jj]; }
    for (int t0 = 0; t0 < ntok; t0 += 8) {
        __syncthreads();
        const int row = row0 + t0 + st; const bool valid = t0 + st < ntok;
        float gg = 0.f;
        { float r = 0.f, k = 0.f, v = 0.f, w = 1.f, ag = 0.f;
          if (valid) { const size_t o = (size_t)row * D + ch; r = bf2f(R[o]); k = bf2f(Kb[o]); v = bf2f(Vb[o]); w = WD[o]; ag = bf2f(AG[o]); gg = bf2f(GG[o]);
              if (j == 1) { const float vf = bf2f(VF[o]); v = v + (vf - v) * bf2f(VG[o]); } }
          float kk = k * kkc; const float ss = wave_sum(kk * kk); kk = kk / sqrtf(fmaxf(ss, 1e-24f));
          const float km = k * (1.f + (ag - 1.f) * kac);
          const float bsum = wave_sum(r * km * rkc);
          rs_[st * 64 + sc] = r; ws_[st * 64 + sc] = w; ks_[st * 64 + sc] = km; vs_[st * 64 + sc] = v; as_[st * 64 + sc] = -kk; bs_[st * 64 + sc] = kk * ag;
          if (sc == 0) bon[st] = bsum; }
        __syncthreads();
        for (int tt = 0; tt < 8; ++tt) {
            if (t0 + tt < ntok) {
                float sa = 0.f;
#pragma unroll
                for (int jj = 0; jj < 8; ++jj) sa += s[jj] * as_[tt * 64 + 8 * q + jj];
                sa += __shfl_xor(sa, 1); sa += __shfl_xor(sa, 2); sa += __shfl_xor(sa, 4);
                const float vi = vs_[tt * 64 + i]; float y = 0.f;
#pragma unroll
                for (int jj = 0; jj < 8; ++jj) { const int cj = tt * 64 + 8 * q + jj; s[jj] = s[jj] * ws_[cj] + sa * bs_[cj] + vi * ks_[cj]; y += s[jj] * rs_[cj]; }
                y += __shfl_xor(y, 1); y += __shfl_xor(y, 2); y += __shfl_xor(y, 4);
                if (q == 0) ys_[tt * 64 + i] = y;
            }
        }
        __syncthreads();
        if (valid) {
            const float y = ys_[st * 64 + sc];
            const float mu = wave_sum(y) * (1.f / 64.f); const float dy = y - mu; const float var = wave_sum(dy * dy) * (1.f / 64.f);
            float o = dy / sqrtf(var + 64e-5f) * gng + gnb;
            o = (o + bon[st] * vs_[st * 64 + sc]) * gg;
            O[(size_t)row * D + ch] = f2bf(o);
        }
    }
#pragma unroll
    for (int jj = 0; jj < 8; ++jj) Sout[(size_t)i * 64 + 8 * q + jj] = s[jj];
    __syncthreads();
}
DEVI void n_odd_scan(const Ctx& c, const PArgs& a, int li) {
    const int j = li >> 1;
    const int NU = 128 + 2048;
    for (int u = c.bid; u < NU; u += c.G) {
        const bool pr = u < 128; const int v = pr ? u : u - 128, b = v >> 4, hd = v & 15;
        const float* S0 = pr ? nullptr : a.in[I_SRWKV] + ((size_t)(j * BS + b) * 16 + hd) * 4096;
        float* So = pr ? c.out + O_RWKVP + ((size_t)(j * BP + b) * 16 + hd) * 4096 : c.out + O_RWKVS + ((size_t)(j * BS + b) * 16 + hd) * 4096;
        n_rwkv_unit(c, a, j, hd, pr ? b * TP : MP + b, pr ? TP : 1, S0, So);
    }
}

DEVI void n_final(const Ctx& c, const PArgs& a) {
    const bf16* XB = (const bf16*)(c.ws + WS_XB); const float* RS = (const float*)(c.ws + WS_RS); const float* gain = a.in[I_NFIN];
    const int gw = c.bid * NWAVES + c.wave, NGW = c.G * NWAVES;
    for (int row = gw; row < M; row += NGW) {
        float* dst;
        if (row < MP) { const int b = row / TP, t = row % TP; if (t < NMETA) continue; dst = c.out + O_YP + ((size_t)b * SEQ + (t - NMETA)) * D; }
        else dst = c.out + O_YS + (size_t)(row - MP) * D;
        const float rs = row_rstd(RS, row);
#pragma unroll
        for (int q = 0; q < 4; ++q) { const int col = q * 256 + c.lane * 4;
            const u32x2 xw_ = *(const u32x2*)(XB + (size_t)row * D + col); const f32x4 yv_ = (f32x4){__uint_as_float(xw_.x << 16), __uint_as_float(xw_.x & 0xffff0000u), __uint_as_float(xw_.y << 16), __uint_as_float(xw_.y & 0xffff0000u)} * rs * *(const f32x4*)(gain + col); __builtin_nontemporal_store(yv_, (f32x4*)(dst + col)); }
    }
}

namespace pg8 {
typedef short bf16x8 __attribute__((ext_vector_type(8)));
constexpr int BM = 256, BK = 64, HALF = 128, HTB = HALF * BK * 2, STAGE_BYTES = 8 * HTB, NXCD = 8, WGM = 8;
__host__ __device__ __forceinline__ int lds_byte(int r, int c) { const int st = (r >> 4) * 2 + (c >> 5), rr = r & 15, cc = c & 31, ob = rr * 64 + cc * 2; return st * 1024 + (ob ^ (((ob >> 9) & 1) << 5)); }
__host__ __device__ __forceinline__ void stage_rc(int b, int& R, int& C) { const int st = b / 1024, sb = b % 1024, swz = sb ^ (((sb >> 9) & 1) << 5); R = (st >> 1) * 16 + swz / 64; C = (st & 1) * 32 + (swz % 64) / 2; }
__host__ __device__ __forceinline__ int perm32(int rho) { const int n = rho >> 4, i = rho & 15; return 8 * (i >> 2) + 4 * n + (i & 3); }
struct Unit { int pm, pn; };
struct Gemm { const bf16* A; const bf16* Bt; int M, N, K, lda; unsigned long long asel; size_t astride; };
struct StaticOrder {
    int nM, nN, nwg, G, c;
    __device__ __forceinline__ void init(int M_, int N_, int G_, int c_) { nM = M_ / BM; nN = N_ / BM; nwg = nM * nN; G = G_; c = c_; }
    __device__ __forceinline__ bool next(int i, Unit& u) const {
        const long L = (long)i * G + c; if (L >= nwg) return false;
        int wgid = (int)L; { const int q = nwg / NXCD, r = nwg % NXCD, xcd = wgid % NXCD, off = wgid / NXCD; wgid = (xcd < r ? xcd * (q + 1) : r * (q + 1) + (xcd - r) * q) + off; }
        const int nig = WGM * nN, gid = wgid / nig, fm = gid * WGM, gsz = (nM - fm) < WGM ? (nM - fm) : WGM;
        u.pm = fm + ((wgid % nig) % gsz); u.pn = (wgid % nig) / gsz; return true;
    }
};
DEVI unsigned cvt_pk_bf16(float lo, float hi) { return pk2(lo, hi); }

template <class Epi>
DEVI void gemm_phase(LAS unsigned char* lds, const int tid, const Gemm g, const StaticOrder& S, const Epi& E) {
    const int wid = __builtin_amdgcn_readfirstlane(tid >> 6), lane = tid & 63, wr = wid >> 2, wc = wid & 3, fr = lane & 15, fq = lane >> 4;
    const int K = g.K, nt = K / BK, lda = g.lda;
    unsigned voffA[2], voffB[2];
#pragma unroll
    for (int i = 0; i < 2; ++i) { int R, C; stage_rc(tid * 16 + i * 8192, R, C); const int Rb = Epi::PERM ? ((R & ~31) + perm32(R & 31)) : R;
        voffA[i] = (unsigned)(R * lda + C) * 2u; voffB[i] = (unsigned)(Rb * K + C) * 2u; }
    const size_t kstep = (size_t)(BK * 2);
    const size_t hstepA = (size_t)HALF * lda * 2, hstepB = (size_t)HALF * K * 2;
    const size_t tstepA = 2 * hstepA, tstepB = 2 * hstepB;
    const unsigned ldsw = (unsigned)wid * 1024u;
    const int aoff = lds_byte(wr * 64 + fr, fq * 8), boff = lds_byte(wc * 32 + fr, fq * 8);
#define PG8_SA(b, h) (((b) * 2 + (h)) * HTB)
#define PG8_SB(b, h) ((4 + (b) * 2 + (h)) * HTB)
#define PG8_STAGE(bufoff, gbase, voff) do { _Pragma("unroll") for (int _i = 0; _i < 2; ++_i) \
        __builtin_amdgcn_global_load_lds((const unsigned*)((const char*)(gbase) + (voff)[_i]), (LAS unsigned*)(lds + (bufoff) + ldsw + _i * 8192), 16, 0, 0); } while (0)
#define PG8_LDA(dst, b, h) do { _Pragma("unroll") for (int m = 0; m < 4; ++m) _Pragma("unroll") for (int k = 0; k < 2; ++k) dst[m][k] = *(const LAS bf16x8*)(lds + PG8_SA(b, h) + aoff + m * 2048 + k * 1024); } while (0)
#define PG8_LDB(dst, b, h) do { _Pragma("unroll") for (int n = 0; n < 2; ++n) _Pragma("unroll") for (int k = 0; k < 2; ++k) dst[n][k] = *(const LAS bf16x8*)(lds + PG8_SB(b, h) + boff + n * 2048 + k * 1024); } while (0)
#define PG8_MMA(ai, bj, At, Bt) do { __builtin_amdgcn_s_setprio(1); _Pragma("unroll") for (int m = 0; m < 4; ++m) _Pragma("unroll") for (int n = 0; n < 2; ++n) _Pragma("unroll") for (int k = 0; k < 2; ++k) \
        acc[ai][bj][m][n] = __builtin_amdgcn_mfma_f32_16x16x32_bf16(Bt[n][k], At[m][k], acc[ai][bj][m][n], 0, 0, 0); __builtin_amdgcn_s_setprio(0); } while (0)
#define PG8_WAIT_V(n) asm volatile("s_waitcnt vmcnt(" #n ")" ::: "memory")
#define PG8_WAIT_L(n) asm volatile("s_waitcnt lgkmcnt(" #n ")" ::: "memory")
#define PG8_BAR __builtin_amdgcn_s_barrier()
#define PG8_SCHED __builtin_amdgcn_sched_barrier(0)
#define PG8_ABASE(u) ((const char*)(g.A + (size_t)((g.asel >> (4 * (u).pn)) & 15ull) * g.astride) + (size_t)(u).pm * tstepA)
    Unit cur, nxt; int ui = 0;
    if (!S.next(0, cur)) return;
    f32x4 acc[2][2][4][2];
#pragma unroll
    for (int a = 0; a < 2; ++a)
#pragma unroll
        for (int b = 0; b < 2; ++b)
#pragma unroll
            for (int m = 0; m < 4; ++m)
#pragma unroll
                for (int n = 0; n < 2; ++n) acc[a][b][m][n] = (f32x4){0.f, 0.f, 0.f, 0.f};
    bf16x8 At[4][2], B0[2][2], B1[2][2];
    const char* cA = PG8_ABASE(cur); const char* cB = (const char*)g.Bt + (size_t)cur.pn * tstepB;
    PG8_STAGE(PG8_SB(0, 0), cB, voffB); PG8_STAGE(PG8_SB(0, 1), cB + hstepB, voffB); PG8_STAGE(PG8_SA(0, 0), cA, voffA); PG8_STAGE(PG8_SA(0, 1), cA + hstepA, voffA);
    if (wr == 1) PG8_BAR;
    PG8_WAIT_V(2); PG8_BAR;
    PG8_STAGE(PG8_SB(1, 0), cB + kstep, voffB); PG8_STAGE(PG8_SA(1, 0), cA + kstep, voffA); PG8_STAGE(PG8_SB(1, 1), cB + hstepB + kstep, voffB);
    PG8_WAIT_V(6); PG8_BAR;
    for (;;) {
        const bool has_next = S.next(ui + 1, nxt);
        const char* nA = has_next ? PG8_ABASE(nxt) : cA; const char* nB = has_next ? (const char*)g.Bt + (size_t)nxt.pn * tstepB : cB;
        for (int t = 0; t < nt; t += 2) {
            const bool last = (t == nt - 2);
            const char* a1 = cA + (size_t)(t + 1) * kstep;
            const char* a2 = last ? nA : cA + (size_t)(t + 2) * kstep; const char* b2 = last ? nB : cB + (size_t)(t + 2) * kstep;
            const char* a3 = a2 + kstep; const char* b3 = b2 + kstep;
            PG8_LDB(B0, 0, 0); PG8_LDB(B1, 0, 1); PG8_SCHED; PG8_LDA(At, 0, 0); PG8_STAGE(PG8_SA(1, 1), a1 + hstepA, voffA);
            PG8_WAIT_V(8); PG8_WAIT_L(0); PG8_BAR; PG8_MMA(0, 0, At, B0); PG8_MMA(0, 1, At, B1); PG8_BAR; PG8_SCHED;
            PG8_LDA(At, 0, 1); PG8_STAGE(PG8_SB(0, 0), b2, voffB); PG8_STAGE(PG8_SB(0, 1), b2 + hstepB, voffB); PG8_STAGE(PG8_SA(0, 0), a2, voffA);
            PG8_WAIT_V(8); PG8_WAIT_L(0); PG8_BAR; PG8_MMA(1, 0, At, B0); PG8_MMA(1, 1, At, B1); PG8_BAR; PG8_SCHED;
            PG8_LDB(B0, 1, 0); PG8_LDB(B1, 1, 1); PG8_SCHED; PG8_LDA(At, 1, 0); PG8_STAGE(PG8_SA(0, 1), a2 + hstepA, voffA);
            PG8_WAIT_V(8); PG8_WAIT_L(0); PG8_BAR; PG8_MMA(0, 0, At, B0); PG8_MMA(0, 1, At, B1); PG8_BAR; PG8_SCHED;
            PG8_LDA(At, 1, 1); PG8_STAGE(PG8_SB(1, 0), b3, voffB); PG8_STAGE(PG8_SB(1, 1), b3 + hstepB, voffB); PG8_STAGE(PG8_SA(1, 0), a3, voffA);
            PG8_WAIT_V(8); PG8_WAIT_L(0); PG8_BAR; PG8_MMA(1, 0, At, B0); PG8_MMA(1, 1, At, B1); PG8_BAR; PG8_SCHED;
        }
        if (wr == 0) PG8_BAR;
        E(acc, cur, wr, wc, fr, fq);
        if (!has_next) break;
#pragma unroll
        for (int a = 0; a < 2; ++a)
#pragma unroll
            for (int b = 0; b < 2; ++b)
#pragma unroll
                for (int m = 0; m < 4; ++m)
#pragma unroll
                    for (int n = 0; n < 2; ++n) acc[a][b][m][n] = (f32x4){0.f, 0.f, 0.f, 0.f};
        cur = nxt; cA = nA; cB = nB; ++ui;
        if (wr == 1) PG8_BAR;
    }
    PG8_WAIT_V(0);
    PG8_BAR;
#undef PG8_SA
#undef PG8_SB
#undef PG8_STAGE
#undef PG8_LDA
#undef PG8_LDB
#undef PG8_MMA
#undef PG8_WAIT_V
#undef PG8_WAIT_L
#undef PG8_BAR
#undef PG8_SCHED
#undef PG8_ABASE
}
}

constexpr size_t WB_WIN = 0, WB_WOUT = 20 * MiB, WB_G5 = 28 * MiB, WB_G6 = 44 * MiB, WB_WO = 48 * MiB, WB_WUP = 52 * MiB, WB_WDN = 96 * MiB;
constexpr size_t SZ_WIN = 10 * MiB, SZ_WOUT = 4 * MiB, SZ_G5 = 8 * MiB, SZ_G6 = 2 * MiB, SZ_WO = 2 * MiB, SZ_WUP = 11 * MiB, SZ_WDN = (size_t)D * DFF * 2;
static_assert(WB_WDN + 4 * SZ_WDN <= 119 * MiB, "weight map");

struct WDesc { const float* W; const float* gain; bf16* dst; int ldw, Kv, Kd, Nv, Nd, map; };
DEVI WDesc wdesc(const PArgs& a, unsigned char* ws, int id) {
    WDesc w; w.gain = nullptr; w.map = 0; unsigned char* wb = ws + WS_WB;
    if (id < 2) { const int j = id; w.W = a.in[I_EWIN] + (size_t)j * D * NIN; w.ldw = NIN; w.Kv = w.Kd = D; w.Nv = w.Nd = NIN; w.gain = a.in[I_NMIX] + (size_t)(2 * j) * D; w.dst = (bf16*)(wb + WB_WIN + j * SZ_WIN); w.map = 1; }
    else if (id < 4) { const int j = id - 2; w.W = a.in[I_EWOUT] + (size_t)j * 2048 * D; w.ldw = D; w.Kv = w.Kd = 2048; w.Nv = w.Nd = D; w.dst = (bf16*)(wb + WB_WOUT + j * SZ_WOUT); }
    else if (id < 18) { const int q = id - 4, j = q / 7, p = q % 7; bf16* base = (bf16*)(wb + WB_G5 + j * SZ_G5); w.Kv = w.Kd = D;
        if (p < 3) { w.W = a.in[p == 0 ? I_OWR : (p == 1 ? I_OWK : I_OWV)] + (size_t)j * D * D; w.ldw = D; w.Nv = w.Nd = D; w.dst = base + (size_t)p * 1024 * D; }
        else if (p == 3) { w.W = a.in[I_OG1] + (size_t)j * D * 128; w.ldw = 128; w.Nv = 128; w.Nd = 256; w.dst = base + (size_t)3072 * D; }
        else if (p == 4) { w.W = a.in[I_OW1] + (size_t)j * D * 64; w.ldw = 64; w.Nv = 64; w.Nd = 256; w.dst = base + (size_t)3328 * D; }
        else if (p == 5) { w.W = a.in[I_OA1] + (size_t)j * D * 64; w.ldw = 64; w.Nv = 64; w.Nd = 256; w.dst = base + (size_t)3584 * D; }
        else { w.W = a.in[I_OV1]; w.ldw = 32; w.Nv = 32; w.Nd = j == 1 ? 256 : 0; w.dst = base + (size_t)3840 * D; } }
    else if (id < 26) { const int q = id - 18, j = q >> 2, p = q & 3; bf16* base = (bf16*)(wb + WB_G6 + j * SZ_G6); w.Kd = 256; w.ldw = D; w.Nv = w.Nd = D; w.dst = base + (size_t)p * 1024 * 256;
        if (p == 0) { w.W = a.in[I_OW2] + (size_t)j * 64 * D; w.Kv = 64; }
        else if (p == 1) { w.W = a.in[I_OA2] + (size_t)j * 64 * D; w.Kv = 64; }
        else if (p == 2) { w.W = a.in[I_OG2] + (size_t)j * 128 * D; w.Kv = 128; }
        else { w.W = a.in[I_OV2]; w.Kv = 32; if (j == 0) w.Nd = 0; } }
    else if (id < 28) { const int j = id - 26; w.W = a.in[I_OWO] + (size_t)j * D * D; w.ldw = D; w.Kv = w.Kd = D; w.Nv = w.Nd = D; w.dst = (bf16*)(wb + WB_WO + j * SZ_WO); }
    else if (id < 32) { const int li = id - 28; w.W = a.in[I_FWUP] + (size_t)li * D * NUP; w.ldw = NUP; w.Kv = w.Kd = D; w.Nv = w.Nd = NUP; w.gain = a.in[I_NFFN] + (size_t)li * D; w.dst = (bf16*)(wb + WB_WUP + li * SZ_WUP); w.map = FUSE_ACT ? 2 : 0; }
    else { const int li = id - 32; w.W = a.in[I_FWDN] + (size_t)li * DFF * D; w.ldw = D; w.Kv = w.Kd = DFF; w.Nv = w.Nd = D; w.dst = (bf16*)(wb + WB_WDN + li * SZ_WDN); }
    return w;
}
constexpr int N_WDESC = 36;
DEVI void wprep_item(const WDesc& w, LAS float* scr, int item, int lane) {
    const int nblk = w.Nd / 32, kb = item / nblk, nb = item % nblk, k0 = 64 * kb, n0 = 32 * nb;
    int sc0 = n0;
    if (w.map == 1 && n0 < 1024) { const int t = n0 >> 8, cp = n0 & 255; sc0 = 256 * t + ((cp & 127) >> 6) * 128 + (cp >> 7) * 64 + (cp & 63); }
    if (w.map == 2) { const int t = n0 >> 8, cp = n0 & 255; sc0 = cp < 128 ? 128 * t + cp : DFF + 128 * t + (cp - 128); }
    const bool nvalid = n0 < w.Nv;
#pragma unroll
    for (int i = 0; i < 8; ++i) { const int kk = 8 * i + (lane >> 3), k = k0 + kk; f32x4 v = (f32x4){0.f, 0.f, 0.f, 0.f};
        if (nvalid && k < w.Kv) { v = __builtin_nontemporal_load((const f32x4*)(w.W + (size_t)k * w.ldw + sc0 + 4 * (lane & 7))); if (w.gain) v = v * w.gain[k]; }
        LAS float* d = scr + kk * 33 + 4 * (lane & 7); d[0] = v.x; d[1] = v.y; d[2] = v.z; d[3] = v.w; }
    asm volatile("s_waitcnt lgkmcnt(0)" ::: "memory");
    const int cc = lane & 7;
#pragma unroll
    for (int jx = 0; jx < 4; ++jx) { const int n = (lane >> 3) + 8 * jx; const LAS float* s = scr + (8 * cc) * 33 + n;
        u32x4 o; o.x = pk2(s[0 * 33], s[1 * 33]); o.y = pk2(s[2 * 33], s[3 * 33]); o.z = pk2(s[4 * 33], s[5 * 33]); o.w = pk2(s[6 * 33], s[7 * 33]);
        *(u32x4*)(w.dst + (size_t)(n0 + n) * w.Kd + k0 + 8 * cc) = o; }
    asm volatile("s_waitcnt lgkmcnt(0)" ::: "memory");
}
DEVI void f_wprep(const Ctx& c, const PArgs& a, unsigned long long idmask, int gw, int NGW) {
    LAS float* scr = (LAS float*)(c.lds + c.wave * 16384);
#pragma unroll 1
    for (int id = 0; id < N_WDESC; ++id) {
        if (!((idmask >> id) & 1ull)) continue;
        const WDesc w = wdesc(a, c.ws, id);
        const int nitems = (w.Kd / 64) * (w.Nd / 32);
        const int start = (gw + id * 601) % NGW;
        for (int it = start; it < nitems; it += NGW) wprep_item(w, scr, it, c.lane);
    }
}
constexpr unsigned long long WM_L01 = (1ull << 1) | (1ull << 2) | (0x7full << 4) | (0xfull << 18) | (1ull << 26) | (3ull << 28) | (3ull << 32);
constexpr unsigned long long WM_L23 = (1ull << 3) | (0x7full << 11) | (0xfull << 22) | (1ull << 27) | (3ull << 30) | (3ull << 34);
static_assert((WM_L01 | WM_L23 | 1ull) == (1ull << 36) - 1 && (WM_L01 & WM_L23) == 0, "weight masks");

DEVI u32x4 pack8(const f32x4 a, const f32x4 b) { u32x4 w; w.x = pg8::cvt_pk_bf16(a[0], a[1]); w.y = pg8::cvt_pk_bf16(a[2], a[3]); w.z = pg8::cvt_pk_bf16(b[0], b[1]); w.w = pg8::cvt_pk_bf16(b[2], b[3]); return w; }
DEVI f32x4 map4(const f32x4 v, int act) {
    f32x4 o;
#pragma unroll
    for (int e = 0; e < 4; ++e) o[e] = act == 1 ? siluf_(v[e]) : act == 2 ? geluf_(v[e]) : act == 3 ? sigmoidf_(v[e]) : act == 4 ? tanhf_(v[e]) : v[e];
    return o;
}
struct EpiEvenIn {
    static constexpr bool PERM = true;
    bf16* Z; const float* RS; const float* ROPE;
    DEVI void operator()(const f32x4 (&acc)[2][2][4][2], const pg8::Unit& u, int wr, int wc, int fr, int fq) const {
        const int pn = u.pn;
        float rsv[2][4];
#pragma unroll
        for (int ai = 0; ai < 2; ++ai)
#pragma unroll
            for (int m = 0; m < 4; ++m) rsv[ai][m] = row_rstd_q(RS, u.pm * 256 + ai * 128 + wr * 64 + m * 16 + fr, fq);
#pragma unroll
        for (int ai = 0; ai < 2; ++ai)
#pragma unroll
            for (int m = 0; m < 4; ++m) {
                const int row = u.pm * 256 + ai * 128 + wr * 64 + m * 16 + fr; const float rs = rsv[ai][m];
                if (pn < 4) {
                    const int hl = wc >> 1, d0 = (32 * wc + 8 * fq) & 63; const float sc = (pn >= 2 ? 0.08838834764831845f : 1.f) * rs;
                    const f32x4* rp = (const f32x4*)(ROPE + ((size_t)row_pos(row) * 64 + d0) * 2);
                    const f32x4 c0 = rp[0], c1 = rp[1], c2 = rp[2], c3 = rp[3];
                    const f32x4 x1a = acc[ai][0][m][0] * sc, x1b = acc[ai][0][m][1] * sc, x2a = acc[ai][1][m][0] * sc, x2b = acc[ai][1][m][1] * sc;
                    const f32x4 csa = (f32x4){c0[0], c0[2], c1[0], c1[2]}, sna = (f32x4){c0[1], c0[3], c1[1], c1[3]}, csb = (f32x4){c2[0], c2[2], c3[0], c3[2]}, snb = (f32x4){c2[1], c2[3], c3[1], c3[3]};
                    const f32x4 y1a = x1a * csa - x2a * sna, y1b = x1b * csb - x2b * snb, y2a = x1a * sna + x2a * csa, y2b = x1b * snb + x2b * csb;
                    bf16* dst = Z + (size_t)row * NIN + pn * 256 + hl * 128 + d0;
                    *(u32x4*)dst = pack8(y1a, y1b); *(u32x4*)(dst + 64) = pack8(y2a, y2b);
                } else {
                    const int act = (pn >= 8 && pn < 12) ? 1 : (pn >= 16 ? 2 : 0);
#pragma unroll
                    for (int bj = 0; bj < 2; ++bj) { bf16* dst = Z + (size_t)row * NIN + pn * 256 + bj * 128 + wc * 32 + fq * 8;
                        *(u32x4*)dst = pack8(map4(acc[ai][bj][m][0] * rs, act), map4(acc[ai][bj][m][1] * rs, act)); }
                }
            }
    }
};
struct EpiResidual {
    static constexpr bool PERM = false;
    bf16* XB; float* RS;
    DEVI void operator()(const f32x4 (&acc)[2][2][4][2], const pg8::Unit& u, int wr, int wc, int fr, int fq) const {
#pragma unroll
        for (int ai = 0; ai < 2; ++ai) {
            u32x2 xo[4][2][2];
#pragma unroll
            for (int m = 0; m < 4; ++m)
#pragma unroll
                for (int bj = 0; bj < 2; ++bj)
#pragma unroll
                    for (int n = 0; n < 2; ++n) xo[m][bj][n] = *(const u32x2*)(XB + (size_t)(u.pm * 256 + ai * 128 + wr * 64 + m * 16 + fr) * D + u.pn * 256 + bj * 128 + wc * 32 + n * 16 + fq * 4);
            asm volatile("" ::: "memory");
#pragma unroll
            for (int m = 0; m < 4; ++m) {
                const int row = u.pm * 256 + ai * 128 + wr * 64 + m * 16 + fr; float ss = 0.f;
#pragma unroll
                for (int bj = 0; bj < 2; ++bj)
#pragma unroll
                    for (int n = 0; n < 2; ++n) { const size_t o = (size_t)row * D + u.pn * 256 + bj * 128 + wc * 32 + n * 16 + fq * 4;
                        const u32x2 x_ = xo[m][bj][n];
                        f32x4 v = acc[ai][bj][m][n]; v[0] += __uint_as_float(x_.x << 16); v[1] += __uint_as_float(x_.x & 0xffff0000u); v[2] += __uint_as_float(x_.y << 16); v[3] += __uint_as_float(x_.y & 0xffff0000u);
                        u32x2 w; w.x = pk2(v[0], v[1]); w.y = pk2(v[2], v[3]); *(u32x2*)(XB + o) = w;
                        ss += (v[0] * v[0] + v[1] * v[1]) + (v[2] * v[2] + v[3] * v[3]); }
                ss += __shfl_xor(ss, 16); ss += __shfl_xor(ss, 32);
                if (fq == 0) RS[(size_t)row * 16 + u.pn * 4 + wc] = ss;
            }
        }
    }
};
struct EpiUp {
    static constexpr bool PERM = true;
    bf16* U; const float* RS;
    DEVI void operator()(const f32x4 (&acc)[2][2][4][2], const pg8::Unit& u, int wr, int wc, int fr, int fq) const {
#pragma unroll
        for (int ai = 0; ai < 2; ++ai)
#pragma unroll
            for (int m = 0; m < 4; ++m) {
                const int row = u.pm * 256 + ai * 128 + wr * 64 + m * 16 + fr; const float rs = row_rstd(RS, row);
#pragma unroll
                for (int bj = 0; bj < 2; ++bj) *(u32x4*)(U + (size_t)row * NUP + u.pn * 256 + bj * 128 + wc * 32 + fq * 8) = pack8(acc[ai][bj][m][0] * rs, acc[ai][bj][m][1] * rs);
            }
    }
};
struct EpiOddIn {
    static constexpr bool PERM = true;
    bf16 *R, *Kb, *Vb, *LM; int j;
    DEVI void operator()(const f32x4 (&acc)[2][2][4][2], const pg8::Unit& u, int wr, int wc, int fr, int fq) const {
        const int pn = u.pn; bf16* base; int pitch, off; float al, be, ga; bool ident, both;
        bf16 *r_ = R, *k_ = Kb, *v_ = Vb, *l_ = LM; asm volatile("" : "+s"(r_), "+s"(k_), "+s"(v_), "+s"(l_));
        if (pn < 12) { base = pn < 4 ? r_ : (pn < 8 ? k_ : v_); pitch = D; off = (pn & 3) * 256; ident = true; both = true; al = 1.f; be = 1.f; ga = 0.f; }
        else { base = l_; pitch = LML; off = pn == 12 ? 0 : (pn == 13 ? 256 : (pn == 14 ? 384 : 128)); ident = pn >= 14; both = pn == 14 || (pn == 12 && j == 0);
               al = pn == 13 ? 2.f : 1.f; be = al; ga = pn == 13 ? -1.f : 0.f; }
        bf16* p0 = base + off + wc * 32 + fq * 8;
#pragma unroll
        for (int ai = 0; ai < 2; ++ai)
#pragma unroll
            for (int m = 0; m < 4; ++m) {
                const int row = u.pm * 256 + ai * 128 + wr * 64 + m * 16 + fr;
#pragma unroll
                for (int bj = 0; bj < 2; ++bj) {
                    f32x4 v0 = acc[ai][bj][m][0], v1 = acc[ai][bj][m][1];
                    if (!ident) {
#pragma unroll
                        for (int e = 0; e < 4; ++e) { v0[e] = al * __builtin_amdgcn_rcpf(1.f + __expf(-be * v0[e])) + ga; v1[e] = al * __builtin_amdgcn_rcpf(1.f + __expf(-be * v1[e])) + ga; } }
                    if (bj == 0 || both) *(u32x4*)(p0 + (size_t)row * pitch + bj * 128) = pack8(v0, v1); }
            }
    }
};
struct EpiDecay {
    static constexpr bool PERM = true;
    float* WD; const float* w0;
    DEVI void operator()(const f32x4 (&acc)[2][2][4][2], const pg8::Unit& u, int wr, int wc, int fr, int fq) const {
        const int cb = u.pn * 256 + wc * 32 + fq * 8;
#pragma unroll
        for (int bj = 0; bj < 2; ++bj) {
            const f32x4 bia0 = *(const f32x4*)(w0 + cb + bj * 128), bia1 = *(const f32x4*)(w0 + cb + bj * 128 + 4);
#pragma unroll
            for (int ai = 0; ai < 2; ++ai)
#pragma unroll
                for (int m = 0; m < 4; ++m) {
                    const int row = u.pm * 256 + ai * 128 + wr * 64 + m * 16 + fr; const size_t o = (size_t)row * D + cb + bj * 128;
                    f32x4 v0_ = acc[ai][bj][m][0] + bia0, v1_ = acc[ai][bj][m][1] + bia1;
#pragma unroll
                    for (int e = 0; e < 4; ++e) { v0_[e] = __expf(-0.6065306597126334f * __builtin_amdgcn_rcpf(1.f + __expf(-v0_[e]))); v1_[e] = __expf(-0.6065306597126334f * __builtin_amdgcn_rcpf(1.f + __expf(-v1_[e]))); }
                    *(f32x4*)(WD + o) = v0_; *(f32x4*)(WD + o + 4) = v1_;
                }
        }
    }
};
struct EpiGate {
    static constexpr bool PERM = true;
    bf16* AG; const float *a0, *v0;
    DEVI void operator()(const f32x4 (&acc)[2][2][4][2], const pg8::Unit& u, int wr, int wc, int fr, int fq) const {
        const int grp = u.pn >> 2; const int cb = (u.pn & 3) * 256 + wc * 32 + fq * 8;
        const float* bp = grp == 2 ? v0 : a0; const float bsc = grp == 1 ? 0.f : 1.f;
        bf16* ob = AG + (size_t)grp * M * D;
#pragma unroll
        for (int bj = 0; bj < 2; ++bj) {
            const f32x4 bia0 = *(const f32x4*)(bp + cb + bj * 128) * bsc, bia1 = *(const f32x4*)(bp + cb + bj * 128 + 4) * bsc;
#pragma unroll
            for (int ai = 0; ai < 2; ++ai)
#pragma unroll
                for (int m = 0; m < 4; ++m) {
                    const int row = u.pm * 256 + ai * 128 + wr * 64 + m * 16 + fr; const size_t o = (size_t)row * D + cb + bj * 128;
                    f32x4 v0_ = acc[ai][bj][m][0] + bia0, v1_ = acc[ai][bj][m][1] + bia1;
                    if (grp != 1) {
#pragma unroll
                        for (int e = 0; e < 4; ++e) { v0_[e] = __builtin_amdgcn_rcpf(1.f + __expf(-v0_[e])); v1_[e] = __builtin_amdgcn_rcpf(1.f + __expf(-v1_[e])); } }
                    *(u32x4*)(ob + o) = pack8(v0_, v1_);
                }
        }
    }
};

DEVI void f_even_in(const Ctx& c, int li) {
    const int j = li >> 1;
    pg8::Gemm g{(const bf16*)(c.ws + WS_XB), (const bf16*)(c.ws + WS_WB + WB_WIN + j * SZ_WIN), M, NIN, D, D, 0ull, 0};
    pg8::StaticOrder S; S.init(M, NIN, c.G, c.bid);
    EpiEvenIn E{(bf16*)(c.ws + WS_Z), (const float*)(c.ws + WS_RS), (const float*)(c.ws + WS_ROPE)};
    pg8::gemm_phase<EpiEvenIn>(c.lds, c.tid, g, S, E);
}
DEVI void f_gemm_residual(const Ctx& c, const bf16* A, int lda, const bf16* Bt, int K, bool wxb) {
    pg8::Gemm g{A, Bt, M_MAIN, D, K, lda, 0ull, 0};
    pg8::StaticOrder S; S.init(M_MAIN, D, c.G, c.bid);
    (void)wxb; EpiResidual E{(bf16*)(c.ws + WS_XB), (float*)(c.ws + WS_RS)};
    pg8::gemm_phase<EpiResidual>(c.lds, c.tid, g, S, E);
}
DEVI void f_ffn_up(const Ctx& c, int li) {
    pg8::Gemm g{(const bf16*)(c.ws + WS_XB), (const bf16*)(c.ws + WS_WB + WB_WUP + li * SZ_WUP), M, NUP, D, D, 0ull, 0};
    pg8::StaticOrder S; S.init(M, NUP, c.G, c.bid);
    EpiUp E{(bf16*)(c.ws + WS_U), (const float*)(c.ws + WS_RS)};
    pg8::gemm_phase<EpiUp>(c.lds, c.tid, g, S, E);
}
DEVI void f_odd_in(const Ctx& c, int li) {
    const int j = li >> 1, N5 = j == 0 ? 3840 : 4096;
    pg8::Gemm g{(const bf16*)(c.ws + WS_XMIX), (const bf16*)(c.ws + WS_WB + WB_G5 + j * SZ_G5), M, N5, D, D, 0x3415333322220000ull, (size_t)M * D};
    pg8::StaticOrder S; S.init(M, N5, c.G, c.bid);
    EpiOddIn E{(bf16*)(c.ws + WS_R), (bf16*)(c.ws + WS_K), j == 0 ? (bf16*)((unsigned char*)c.out + DO_VFIRST) : (bf16*)(c.ws + WS_V), (bf16*)((unsigned char*)c.out + DO_LMID), j};
    pg8::gemm_phase<EpiOddIn>(c.lds, c.tid, g, S, E);
}
DEVI void f_odd_lora(const Ctx& c, const PArgs& a, int li) {
    const int j = li >> 1;
    const bf16* LM = (const bf16*)((unsigned char*)c.out + DO_LMID); const bf16* W6 = (const bf16*)(c.ws + WS_WB + WB_G6 + j * SZ_G6);
    int K6 = 256; asm volatile("" : "+s"(K6));
    {
        pg8::Gemm g{LM + 256, W6, M, D, K6, LML, 0ull, 0};
        pg8::StaticOrder S; S.init(M, D, c.G, c.bid);
        EpiDecay E{(float*)(c.ws + WS_WDEC), a.in[I_OW0] + (size_t)j * D};
        pg8::gemm_phase<EpiDecay>(c.lds, c.tid, g, S, E);
    }
    {
        const int N6 = j == 0 ? 2048 : 3072;
        pg8::Gemm g{LM, W6 + (size_t)1024 * 256, M, N6, K6, LML, 0x111100003333ull, 128};
        int c2 = c.bid + (c.G >> 1); if (c2 >= c.G) c2 -= c.G;
        pg8::StaticOrder S; S.init(M, N6, c.G, c2);
        EpiGate E{(bf16*)(c.ws + WS_AG), a.in[I_OA0] + (size_t)j * D, a.in[I_OV0]};
        pg8::gemm_phase<EpiGate>(c.lds, c.tid, g, S, E);
    }
}

typedef short bf16x8_t __attribute__((ext_vector_type(8)));
constexpr int LRU_XS = 0, LRU_AI = 33792, LRU_GT = LRU_AI + 128 * 136 * 2, LRU_END = LRU_GT + 128 * 256;
static_assert(LRU_END + 8 * 1024 <= RING_BYTES, "lru lds");
#define LWAIT_() asm volatile("s_waitcnt lgkmcnt(0)" ::: "memory")
#define LDS_BAR() asm volatile("s_waitcnt lgkmcnt(0)\n\ts_barrier" ::: "memory")
DEVI void f_lru_unit(const Ctx& c, const PArgs& a, int j, int g, bool sample, int b) {
    const bf16* Z = (const bf16*)(c.ws + WS_Z); bf16* MIX = (bf16*)(c.ws + WS_MIX);
    LAS unsigned char* XS = c.lds + LRU_XS; LAS unsigned char* AI = c.lds + LRU_AI; LAS unsigned char* GT = c.lds + LRU_GT;
    const int w = c.wave, fr = c.lane & 15, fq = c.lane >> 4, col = 16 * w + fr, ch = g * 128 + col;
    const int row0 = sample ? MP : b * TP, ntok = sample ? 128 : TP, nchunks = sample ? 1 : (TP + 127) / 128;
    bf16x8_t Bw[2][4];
#pragma unroll
    for (int gate = 0; gate < 2; ++gate) {
        const float* Wg = a.in[gate == 0 ? I_EWA : I_EWX] + (size_t)(j * 8 + g) * 128 * 128;
        __syncthreads();
#pragma unroll 2
        for (int i = 0; i < 8; ++i) { const unsigned p = (unsigned)(i * NT + c.tid); *(LAS f32x4*)(c.lds + p * 16u) = *(const f32x4*)(Wg + p * 4u); }
        __syncthreads();
#pragma unroll
        for (int ks = 0; ks < 4; ++ks) { bf16x8_t vv;
#pragma unroll
            for (int jj = 0; jj < 8; ++jj) vv[jj] = (short)f2bf(*(const LAS float*)(c.lds + ((32 * ks + 8 * fq + jj) * 128 + col) * 4));
            Bw[gate][ks] = vv; }
    }
    const float ba = a.in[I_EBA][(size_t)j * 1024 + ch], bx = a.in[I_EBX][(size_t)j * 1024 + ch], sp8 = 8.f * softplusf_(-a.in[I_ELAM][(size_t)j * 1024 + ch]);
    const int cc = c.tid & 127, rq = c.tid >> 7, cch = g * 128 + cc;
    const float* CW = a.in[I_ECW] + (size_t)j * 4 * 1024;
    const float cw0 = CW[cch], cw1 = CW[1024 + cch], cw2 = CW[2048 + cch], cw3 = CW[3072 + cch], cb = a.in[I_ECB][(size_t)j * 1024 + cch];
    float carry = 0.f;
    u32x4 pfx[5], pfg[4];
    const bf16* zx = Z + (size_t)row0 * NIN + 3072 + g * 128; const bf16* zg = Z + (size_t)row0 * NIN + 4096 + g * 128;
#define LRU_PREFETCH(t0) do { _Pragma("unroll") for (int i = 0; i < 5; ++i) { const int p = i * NT + c.tid, r = p >> 4, q = p & 15; const int t = (t0) - 3 + r; \
            pfx[i] = (u32x4){0u, 0u, 0u, 0u}; if (r < 131 && t >= 0) pfx[i] = *(const u32x4*)(zx + (unsigned)(t * NIN + q * 8)); } \
        _Pragma("unroll") for (int i = 0; i < 4; ++i) { const int p = i * NT + c.tid, r = p >> 4, q = p & 15; pfg[i] = *(const u32x4*)(zg + (unsigned)(((t0) + r) * NIN + q * 8)); } } while (0)
    LRU_PREFETCH(0);
    for (int ci = 0; ci < nchunks; ++ci) {
        const int t0 = ci * 128, nv = (ntok - t0) < 128 ? (ntok - t0) : 128;
        __syncthreads();
#pragma unroll
        for (int i = 0; i < 5; ++i) { const int p = i * NT + c.tid; if (p < 131 * 16) *(LAS u32x4*)(XS + p * 16) = pfx[i]; }
#pragma unroll
        for (int i = 0; i < 4; ++i) { const int p = i * NT + c.tid; *(LAS u32x4*)(GT + p * 16) = pfg[i]; }
        __syncthreads();
        if (ci + 1 < nchunks) LRU_PREFETCH(t0 + 128);
        if (!sample) {
            float x0 = bf2f(*(const LAS bf16*)(XS + ((rq * 32 + 0) * 128 + cc) * 2)), x1 = bf2f(*(const LAS bf16*)(XS + ((rq * 32 + 1) * 128 + cc) * 2)), x2 = bf2f(*(const LAS bf16*)(XS + ((rq * 32 + 2) * 128 + cc) * 2));
#pragma unroll 8
            for (int i = 0; i < 32; ++i) { const int lr = rq * 32 + i; const float x3 = bf2f(*(const LAS bf16*)(XS + ((lr + 3) * 128 + cc) * 2));
                *(LAS bf16*)(AI + (lr * 136 + cc) * 2) = f2bf(cb + cw3 * x3 + cw2 * x2 + cw1 * x1 + cw0 * x0); x0 = x1; x1 = x2; x2 = x3; }
        } else {
            const float* SC = a.in[I_SLCONV] + (size_t)j * BS * 3 * 1024 + cch; float* SCO = c.out + O_LCONVS + (size_t)j * BS * 3 * 1024 + cch;
#pragma unroll 2
            for (int i = 0; i < 32; ++i) { const int lr = rq * 32 + i; const unsigned so = (unsigned)(lr * 3 * 1024);
                const float h0 = SC[so], h1 = SC[so + 1024u], h2 = SC[so + 2048u], x3 = bf2f(*(const LAS bf16*)(XS + ((lr + 3) * 128 + cc) * 2));
                *(LAS bf16*)(AI + (lr * 136 + cc) * 2) = f2bf(cb + cw3 * x3 + cw2 * h2 + cw1 * h1 + cw0 * h0);
                SCO[so] = h1; SCO[so + 1024u] = h2; SCO[so + 2048u] = x3; }
        }
        __syncthreads();
#pragma unroll 1
        for (int m = 0; m < 8; ++m) {
            f32x4 accr_ = (f32x4){0.f, 0.f, 0.f, 0.f}, acci_ = (f32x4){0.f, 0.f, 0.f, 0.f};
#pragma unroll
            for (int ks = 0; ks < 4; ++ks) { const bf16x8_t af = *(const LAS bf16x8_t*)(AI + ((16 * m + fr) * 136 + 32 * ks + 8 * fq) * 2);
                accr_ = __builtin_amdgcn_mfma_f32_16x16x32_bf16(af, Bw[0][ks], accr_, 0, 0, 0);
                acci_ = __builtin_amdgcn_mfma_f32_16x16x32_bf16(af, Bw[1][ks], acci_, 0, 0, 0); }
            float av[4], uv[4];
#pragma unroll
            for (int r = 0; r < 4; ++r) { const int lr = 16 * m + 4 * fq + r;
                const float xcv = bf2f(*(const LAS bf16*)(AI + (lr * 136 + col) * 2));
                const float rg = sigmoidf_(accr_[r] + ba), ig = sigmoidf_(acci_[r] + bx);
                const float la = -sp8 * rg, t2 = 2.f * la;
                const float em1 = t2 > -0.02f ? t2 * (1.f + t2 * (0.5f + t2 * 0.16666667f)) : __expf(t2) - 1.f;
                av[r] = __expf(la); uv[r] = sqrtf(-em1) * (ig * xcv); }
            float hv[4];
            if (!sample) {
                const float Ai = av[0] * av[1] * av[2] * av[3], Ui = ((uv[0] * av[1] + uv[1]) * av[2] + uv[2]) * av[3] + uv[3];
                LAS f32x2_t* cs = (LAS f32x2_t*)(c.lds + LRU_END + w * 1024 + (m & 1) * 512);
                cs[fq * 16 + fr] = (f32x2_t){Ai, Ui};
                LWAIT_();
                const f32x2_t c0 = cs[fr], c1 = cs[16 + fr], c2 = cs[32 + fr], c3 = cs[48 + fr];
                const float h0e = c0.x * carry + c0.y, h1e = c1.x * h0e + c1.y, h2e = c2.x * h1e + c2.y, h3e = c3.x * h2e + c3.y;
                const float hin = fq == 0 ? carry : (fq == 1 ? h0e : (fq == 2 ? h1e : h2e));
                carry = h3e;
                hv[0] = av[0] * hin + uv[0]; hv[1] = av[1] * hv[0] + uv[1]; hv[2] = av[2] * hv[1] + uv[2]; hv[3] = av[3] * hv[2] + uv[3];
                if (nv < 128 && m == ((TP % 128) - 1) / 16 && fq == (((TP % 128) - 1) & 15) / 4) c.out[O_LRUP + (size_t)(j * BP + b) * 1024 + ch] = hv[((TP % 128) - 1) & 3];
            } else {
#pragma unroll
                for (int r = 0; r < 4; ++r) { const int lr = 16 * m + 4 * fq + r; const unsigned so = (unsigned)(lr * 1024);
                    hv[r] = av[r] * (a.in[I_SLRU] + (size_t)j * BS * 1024 + ch)[so] + uv[r]; (c.out + O_LRUS + (size_t)j * BS * 1024 + ch)[so] = hv[r]; }
            }
#pragma unroll
            for (int r = 0; r < 4; ++r) { const int lr = 16 * m + 4 * fq + r; LAS bf16* gp = (LAS bf16*)(GT + (lr * 128 + col) * 2); *gp = f2bf(hv[r] * bf2f(*gp)); }
        }
        if (!sample && nv < 128 && c.tid < 128) {
#pragma unroll
            for (int k = 0; k < 3; ++k) c.out[O_LCONVP + ((size_t)(j * BP + b) * 3 + k) * 1024 + g * 128 + c.tid] = bf2f(*(const LAS bf16*)(XS + ((nv + k) * 128 + c.tid) * 2));
        }
        __syncthreads();
#pragma unroll
        for (int i = 0; i < 4; ++i) { const int p = i * NT + c.tid, r = p >> 4, q = p & 15;
            if (r < nv) *(u32x4*)(MIX + (size_t)(row0 + t0 + r) * 2048 + 1024 + g * 128 + q * 8) = *(const LAS u32x4*)(GT + p * 16); }
    }
#undef LRU_PREFETCH
    __syncthreads();
}

#define DPP_F(v, ctrl) __builtin_bit_cast(float, __builtin_amdgcn_update_dpp(0, __builtin_bit_cast(int, (v)), (ctrl), 0xF, 0xF, true))
DEVI float red8(float x) { x += DPP_F(x, 0xB1); x += DPP_F(x, 0x4E); x += DPP_F(x, 0x141); return x; }
DEVI float red32(float x) { x += DPP_F(x, 0xB1); x += DPP_F(x, 0x4E); x += DPP_F(x, 0x141); x += DPP_F(x, 0x140); x += __shfl_xor(x, 16); return x; }
typedef unsigned long long u64x2_t __attribute__((ext_vector_type(2)));
DEVI void tr_frag2(unsigned tile, int pitch, int krow0, int col0, int fr, int fq, bf16x8_t& f0, bf16x8_t& f1) {
    const unsigned base = tile + (unsigned)((krow0 + 8 * fq + (fr >> 2)) * pitch + (col0 + 4 * (fr & 3)) * 2);
    unsigned long long a0, a1, b0, b1;
    asm volatile("ds_read_b64_tr_b16 %0, %4\n\tds_read_b64_tr_b16 %1, %5\n\tds_read_b64_tr_b16 %2, %6\n\tds_read_b64_tr_b16 %3, %7\n\ts_waitcnt lgkmcnt(0)"
                 : "=&v"(a0), "=&v"(a1), "=&v"(b0), "=&v"(b1) : "v"(base), "v"(base + 4u * (unsigned)pitch), "v"(base + 32u * (unsigned)pitch), "v"(base + 36u * (unsigned)pitch) : "memory");
    u64x2_t v0; v0.x = a0; v0.y = a1; u64x2_t v1; v1.x = b0; v1.y = b1;
    f0 = __builtin_bit_cast(bf16x8_t, v0); f1 = __builtin_bit_cast(bf16x8_t, v1);
}
DEVI void tr_frag4(unsigned tile, int pitch, int col0, int col1, int fr, int fq, bf16x8_t& f00, bf16x8_t& f01, bf16x8_t& f10, bf16x8_t& f11) {
    const unsigned b0 = tile + (unsigned)((8 * fq + (fr >> 2)) * pitch + (col0 + 4 * (fr & 3)) * 2), b1 = b0 + (unsigned)((col1 - col0) * 2);
    unsigned long long a0, a1, a2, a3, c0, c1, c2, c3;
    asm volatile("ds_read_b64_tr_b16 %0, %8\n\tds_read_b64_tr_b16 %1, %9\n\tds_read_b64_tr_b16 %2, %10\n\tds_read_b64_tr_b16 %3, %11\n\t"
                 "ds_read_b64_tr_b16 %4, %12\n\tds_read_b64_tr_b16 %5, %13\n\tds_read_b64_tr_b16 %6, %14\n\tds_read_b64_tr_b16 %7, %15\n\ts_waitcnt lgkmcnt(0)"
                 : "=&v"(a0), "=&v"(a1), "=&v"(a2), "=&v"(a3), "=&v"(c0), "=&v"(c1), "=&v"(c2), "=&v"(c3)
                 : "v"(b0), "v"(b0 + 4u * (unsigned)pitch), "v"(b0 + 32u * (unsigned)pitch), "v"(b0 + 36u * (unsigned)pitch), "v"(b1), "v"(b1 + 4u * (unsigned)pitch), "v"(b1 + 32u * (unsigned)pitch), "v"(b1 + 36u * (unsigned)pitch) : "memory");
    u64x2_t v; v.x = a0; v.y = a1; f00 = __builtin_bit_cast(bf16x8_t, v); v.x = a2; v.y = a3; f01 = __builtin_bit_cast(bf16x8_t, v);
    v.x = c0; v.y = c1; f10 = __builtin_bit_cast(bf16x8_t, v); v.x = c2; v.y = c3; f11 = __builtin_bit_cast(bf16x8_t, v);
}
constexpr int RC = 64;
constexpr int RT_QS = 0, RT_KS = RT_QS + RC * 272, RT_KD = RT_KS + RC * 272, RT_VS = RT_KD + RC * 272, RT_PS = RT_VS + RC * 528, RT_OT = RT_PS + RC * 144, RT_END = RT_OT + RC * 528;
static_assert(RT_END <= RING_BYTES, "ret lds");
DEVI void f_ret_prompt(const Ctx& c, const PArgs& a, int j, int b, int hd) {
    const bf16* Z = (const bf16*)(c.ws + WS_Z); bf16* MIX = (bf16*)(c.ws + WS_MIX);
    const unsigned L0 = (unsigned)(size_t)c.lds;
    LAS unsigned char* QS = c.lds + RT_QS; LAS unsigned char* KS = c.lds + RT_KS; LAS unsigned char* KD = c.lds + RT_KD; LAS unsigned char* VS = c.lds + RT_VS; LAS unsigned char* PS = c.lds + RT_PS;
    const int w = c.wave;
    const float l2g0 = log2f(1.f - exp2f(-5.f - (float)hd));
    const bf16* zb = Z + (size_t)(b * TP) * NIN; const int qcol = hd * 128, kcol = 512 + hd * 128, vcol = 1024 + hd * 256;
    const float* gn = a.in[I_ERGN] + (size_t)j * 1024 + hd * 256;
    f32x4 Sacc[8][2];
#pragma unroll
    for (int db = 0; db < 8; ++db) { Sacc[db][0] = (f32x4){0.f, 0.f, 0.f, 0.f}; Sacc[db][1] = (f32x4){0.f, 0.f, 0.f, 0.f}; }
    u32x4 pf[8];
#define RET_PREFETCH(t0) do { _Pragma("unroll") for (int i = 0; i < 8; ++i) { int r, col; \
            if (i < 4) { const int p = (i & 1) * NT + c.tid; r = p >> 4; col = (i < 2 ? qcol : kcol) + (p & 15) * 8; } else { const int p = (i - 4) * NT + c.tid; r = p >> 5; col = vcol + (p & 31) * 8; } \
            pf[i] = (u32x4){0u, 0u, 0u, 0u}; if ((t0) + r < TP) pf[i] = *(const u32x4*)(zb + (unsigned)(((t0) + r) * NIN + col)); } } while (0)
    RET_PREFETCH(0);
    const int nchunks = (TP + RC - 1) / RC;
#pragma unroll 1
    for (int ci = 0; ci < nchunks; ++ci) {
        const int t0 = ci * RC, nv = (TP - t0) < RC ? (TP - t0) : RC;
        int lane_ = c.lane; float l2g = l2g0; asm volatile("" : "+v"(lane_), "+v"(l2g));
        const int fr = lane_ & 15, fq = lane_ >> 4, tid_ = w * 64 + lane_;
        LDS_BAR();
#pragma unroll
        for (int i = 0; i < 8; ++i) {
            if (i < 4) { const int p = (i & 1) * NT + tid_, r = p >> 4, q = p & 15;
                *(LAS u32x4*)((i < 2 ? QS : KS) + r * 272 + q * 16) = pf[i];
                if (i >= 2) { const float dk = __builtin_amdgcn_exp2f((float)(nv - 1 - r) * l2g); u32x4 o;
#pragma unroll
                    for (int e = 0; e < 4; ++e) { const unsigned v = pf[i][e]; o[e] = pk2(__uint_as_float(v << 16) * dk, __uint_as_float(v & 0xffff0000u) * dk); }
                    *(LAS u32x4*)(KD + r * 272 + q * 16) = o; } }
            else { const int p = (i - 4) * NT + tid_, r = p >> 5, q = p & 31; *(LAS u32x4*)(VS + r * 528 + q * 16) = pf[i]; }
        }
        LDS_BAR();
        if (ci + 1 < nchunks) RET_PREFETCH(t0 + RC);
        u32x4 gcur[4];
#pragma unroll
        for (int i = 0; i < 4; ++i) { const int p = i * NT + tid_, r = p >> 5, q = p & 31; gcur[i] = (u32x4){0u, 0u, 0u, 0u};
            if (r < nv) gcur[i] = *(const u32x4*)(zb + (unsigned)((t0 + r) * NIN + 2048 + hd * 256 + q * 8)); }
        { const int cb = w >> 1;
#pragma unroll
          for (int si = 0; si < 2; ++si) { const int sb = 2 * (w & 1) + si; f32x4 pacc = (f32x4){0.f, 0.f, 0.f, 0.f};
#pragma unroll
              for (int ks = 0; ks < 4; ++ks) { const bf16x8_t af = *(const LAS bf16x8_t*)(QS + (16 * cb + fr) * 272 + (32 * ks + 8 * fq) * 2);
                  const bf16x8_t bfr = *(const LAS bf16x8_t*)(KS + (16 * sb + fr) * 272 + (32 * ks + 8 * fq) * 2);
                  pacc = __builtin_amdgcn_mfma_f32_16x16x32_bf16(af, bfr, pacc, 0, 0, 0); }
#pragma unroll
              for (int r = 0; r < 4; ++r) { const int cc = 16 * cb + 4 * fq + r, ss = 16 * sb + fr; const float v = cc >= ss ? pacc[r] * __builtin_amdgcn_exp2f((float)(cc - ss) * l2g) : 0.f;
                  *(LAS bf16*)(PS + cc * 144 + ss * 2) = f2bf(v); } } }
        f32x4 Oacc[4][2];
#pragma unroll
        for (int cb = 0; cb < 4; ++cb) { Oacc[cb][0] = (f32x4){0.f, 0.f, 0.f, 0.f}; Oacc[cb][1] = (f32x4){0.f, 0.f, 0.f, 0.f}; }
#pragma unroll
        for (int kk = 0; kk < 4; ++kk) {
            bf16x8_t sb_[2];
#pragma unroll
            for (int en = 0; en < 2; ++en) { u32x4 t; t.x = pk2(Sacc[2 * kk][en][0], Sacc[2 * kk][en][1]); t.y = pk2(Sacc[2 * kk][en][2], Sacc[2 * kk][en][3]);
                t.z = pk2(Sacc[2 * kk + 1][en][0], Sacc[2 * kk + 1][en][1]); t.w = pk2(Sacc[2 * kk + 1][en][2], Sacc[2 * kk + 1][en][3]); sb_[en] = __builtin_bit_cast(bf16x8_t, t); }
#pragma unroll
            for (int cb = 0; cb < 4; ++cb) {
                const u32x2 qa = *(const LAS u32x2*)(QS + (16 * cb + fr) * 272 + (32 * kk + 4 * fq) * 2), qb = *(const LAS u32x2*)(QS + (16 * cb + fr) * 272 + (32 * kk + 16 + 4 * fq) * 2);
                u32x4 t; t.x = qa.x; t.y = qa.y; t.z = qb.x; t.w = qb.y; const bf16x8_t af = __builtin_bit_cast(bf16x8_t, t);
                Oacc[cb][0] = __builtin_amdgcn_mfma_f32_16x16x32_bf16(af, sb_[0], Oacc[cb][0], 0, 0, 0);
                Oacc[cb][1] = __builtin_amdgcn_mfma_f32_16x16x32_bf16(af, sb_[1], Oacc[cb][1], 0, 0, 0); }
        }
#pragma unroll
        for (int cb = 0; cb < 4; ++cb)
#pragma unroll
            for (int r = 0; r < 4; ++r) { const float dc = __builtin_amdgcn_exp2f((float)(16 * cb + 4 * fq + r + 1) * l2g); Oacc[cb][0][r] *= dc; Oacc[cb][1][r] *= dc; }
        LDS_BAR();
        bf16x8_t vf[2][2];
        tr_frag4(L0 + RT_VS, 528, 32 * w, 32 * w + 16, fr, fq, vf[0][0], vf[0][1], vf[1][0], vf[1][1]);
#pragma unroll
        for (int cb = 0; cb < 4; ++cb)
#pragma unroll
            for (int ks = 0; ks < 2; ++ks) { const bf16x8_t af = *(const LAS bf16x8_t*)(PS + (16 * cb + fr) * 144 + (32 * ks + 8 * fq) * 2);
                Oacc[cb][0] = __builtin_amdgcn_mfma_f32_16x16x32_bf16(af, vf[0][ks], Oacc[cb][0], 0, 0, 0);
                Oacc[cb][1] = __builtin_amdgcn_mfma_f32_16x16x32_bf16(af, vf[1][ks], Oacc[cb][1], 0, 0, 0); }
        LAS unsigned char* OT = c.lds + RT_OT;
#pragma unroll
        for (int cb = 0; cb < 4; ++cb)
#pragma unroll
            for (int en = 0; en < 2; ++en)
#pragma unroll
                for (int r = 0; r < 4; ++r) *(LAS bf16*)(OT + (16 * cb + 4 * fq + r) * 528 + (32 * w + 16 * en + fr) * 2) = f2bf(Oacc[cb][en][r]);
        { const float dS = __builtin_amdgcn_exp2f((float)nv * l2g);
#pragma unroll
          for (int d2 = 0; d2 < 4; ++d2) {
              bf16x8_t kf[2][2]; tr_frag4(L0 + RT_KD, 272, 32 * d2, 32 * d2 + 16, fr, fq, kf[0][0], kf[0][1], kf[1][0], kf[1][1]);
#pragma unroll
              for (int dd = 0; dd < 2; ++dd) { const int db = 2 * d2 + dd; Sacc[db][0] = Sacc[db][0] * dS; Sacc[db][1] = Sacc[db][1] * dS;
#pragma unroll
                  for (int ks = 0; ks < 2; ++ks) {
                      Sacc[db][0] = __builtin_amdgcn_mfma_f32_16x16x32_bf16(kf[dd][ks], vf[0][ks], Sacc[db][0], 0, 0, 0);
                      Sacc[db][1] = __builtin_amdgcn_mfma_f32_16x16x32_bf16(kf[dd][ks], vf[1][ks], Sacc[db][1], 0, 0, 0); } } } }
        LDS_BAR();
#pragma unroll
        for (int i = 0; i < 4; ++i) { const int p = i * NT + tid_, r = p >> 5, q = p & 31;
            const u32x4 ov = *(const LAS u32x4*)(OT + r * 528 + q * 16);
            float o[8]; float s1 = 0.f, s2 = 0.f;
#pragma unroll
            for (int e = 0; e < 4; ++e) { o[2 * e] = __uint_as_float(ov[e] << 16); o[2 * e + 1] = __uint_as_float(ov[e] & 0xffff0000u); s1 += o[2 * e] + o[2 * e + 1]; s2 += o[2 * e] * o[2 * e] + o[2 * e + 1] * o[2 * e + 1]; }
            s1 = red32(s1); s2 = red32(s2);
            const float mu = s1 * (1.f / 256.f), var = fmaxf(s2 * (1.f / 256.f) - mu * mu, 0.f), rstd = __builtin_amdgcn_rsqf(var + 1e-6f);
            if (r < nv) { const u32x4 gv = gcur[i]; const f32x4 n0 = *(const f32x4*)(gn + q * 8), n1 = *(const f32x4*)(gn + q * 8 + 4);
                u32x4 out;
#pragma unroll
                for (int e = 0; e < 4; ++e) { const float g0 = __uint_as_float(gv[e] << 16), g1 = __uint_as_float(gv[e] & 0xffff0000u);
                    const float n_0 = e < 2 ? n0[2 * e] : n1[2 * e - 4], n_1 = e < 2 ? n0[2 * e + 1] : n1[2 * e - 3];
                    out[e] = pk2(g0 * (o[2 * e] - mu) * rstd * n_0, g1 * (o[2 * e + 1] - mu) * rstd * n_1); }
                *(u32x4*)(MIX + (size_t)(b * TP + t0 + r) * 2048 + hd * 256 + q * 8) = out; }
        }
    }
#undef RET_PREFETCH
    { const int fr = c.lane & 15, fq = c.lane >> 4; float* So = c.out + O_RETP + ((size_t)(j * BP + b) * 4 + hd) * 128 * 256 + 32 * w + fr;
#pragma unroll
      for (int db = 0; db < 8; ++db)
#pragma unroll
          for (int en = 0; en < 2; ++en)
#pragma unroll
              for (int r = 0; r < 4; ++r) So[(unsigned)((16 * db + 4 * fq + r) * 256 + 16 * en)] = Sacc[db][en][r]; }
    __syncthreads();
}
DEVI void f_ret_sample(const Ctx& c, const PArgs& a, int j, int b, int hd) {
    const bf16* Z = (const bf16*)(c.ws + WS_Z); bf16* MIX = (bf16*)(c.ws + WS_MIX);
    LAS float* qk = (LAS float*)c.lds;
    LAS float* op = qk + 256;
    const int row = MP + b, w = c.wave;
    const float gamma = 1.f - exp2f(-5.f - (float)hd);
    const float* S0 = a.in[I_SRET] + ((size_t)(j * BS + b) * 4 + hd) * 128 * 256 + 4 * c.lane; float* So = c.out + O_RETS + ((size_t)(j * BS + b) * 4 + hd) * 128 * 256 + 4 * c.lane;
    __syncthreads();
    if (c.tid < 256) qk[c.tid] = bf2f(Z[(size_t)row * NIN + (c.tid < 128 ? hd * 128 + c.tid : 512 + hd * 128 + c.tid - 128)]);
    const u32x2 vv = *(const u32x2*)(Z + (size_t)row * NIN + 1024 + hd * 256 + 4 * c.lane);
    const f32x4 v4 = (f32x4){__uint_as_float(vv.x << 16), __uint_as_float(vv.x & 0xffff0000u), __uint_as_float(vv.y << 16), __uint_as_float(vv.y & 0xffff0000u)};
    __syncthreads();
    f32x4 o4 = (f32x4){0.f, 0.f, 0.f, 0.f};
#pragma unroll 16
    for (int dd = 0; dd < 16; ++dd) { const int d = 16 * w + dd; f32x4 s = __builtin_nontemporal_load((const f32x4*)(S0 + (unsigned)(d * 256)));
        s = s * gamma + v4 * qk[128 + d]; __builtin_nontemporal_store(s, (f32x4*)(So + (unsigned)(d * 256))); o4 = o4 + s * qk[d]; }
    *(LAS f32x4*)(op + w * 256 + 4 * c.lane) = o4;
    __syncthreads();
    if (w == 0) {
        f32x4 o = (f32x4){0.f, 0.f, 0.f, 0.f};
#pragma unroll
        for (int ww = 0; ww < 8; ++ww) o = o + *(const LAS f32x4*)(op + ww * 256 + 4 * c.lane);
        const float mu = wave_sum((o.x + o.y) + (o.z + o.w)) * (1.f / 256.f); o = o - mu;
        const float rstd = __builtin_amdgcn_rsqf(wave_sum((o.x * o.x + o.y * o.y) + (o.z * o.z + o.w * o.w)) * (1.f / 256.f) + 1e-6f);
        const u32x2 gv = *(const u32x2*)(Z + (size_t)row * NIN + 2048 + hd * 256 + 4 * c.lane); const f32x4 n4 = *(const f32x4*)(a.in[I_ERGN] + (size_t)j * 1024 + hd * 256 + 4 * c.lane);
        u32x2 out; out.x = pk2(__uint_as_float(gv.x << 16) * o.x * rstd * n4.x, __uint_as_float(gv.x & 0xffff0000u) * o.y * rstd * n4.y);
        out.y = pk2(__uint_as_float(gv.y << 16) * o.z * rstd * n4.z, __uint_as_float(gv.y & 0xffff0000u) * o.w * rstd * n4.w);
        *(u32x2*)(MIX + (size_t)row * 2048 + hd * 256 + 4 * c.lane) = out;
    }
}

#ifndef WPB
#define WPB 180
#endif
#ifndef MIX_PART
#define MIX_PART 7
#endif
DEVI void f_even_mix(const Ctx& c, const PArgs& a, int li, int part) {
    const int j = li >> 1;
    if (c.bid < 32) { if (part & 1) f_ret_prompt(c, a, j, c.bid >> 2, c.bid & 3); }
    else if (c.bid < 104) { if (part & 2) { const bool pr = c.bid < 96; const int v = c.bid - 32;
        f_lru_unit(c, a, j, pr ? (v & 7) : (c.bid - 96), !pr, pr ? (v >> 3) : 0); } }
    if (part & 4) {
    if (c.bid >= 104) for (int u = c.bid - 104; u < 512; u += c.G - 104) f_ret_sample(c, a, j, u >> 2, u & 3);
    if (c.bid >= WPB && c.G > WPB) { __syncthreads(); f_wprep(c, a, li == 0 ? WM_L01 : WM_L23, (c.bid - WPB) * NWAVES + c.wave, (c.G - WPB) * NWAVES); }
    }
}

DEVI float gelu_fast(float x) { const float y = 1.5957691216057308f * (x + 0.044715f * x * x * x); return x * __builtin_amdgcn_rcpf(1.f + __expf(-y)); }
DEVI void f_ffn_act(const Ctx& c, const PArgs& a, int li) {
    const bf16* U = (const bf16*)(c.ws + WS_U); bf16* ACT = (bf16*)(c.ws + WS_ACT);
    const float* CW = a.in[I_FCW] + (size_t)li * 3 * DFF; const float* CB = a.in[I_FCB] + (size_t)li * DFF;
    constexpr int RCH = 32, NPC = DFF / 8, NRC = M / RCH, NITEM = NPC * NRC;
    for (int it = c.bid * NT + c.tid; it < NITEM; it += c.G * NT) {
        const int rc = it / NPC, pc = it - rc * NPC, col = pc * 8, r0 = rc * RCH;
        float w0[8], w1[8], w2[8], cb[8];
#pragma unroll
        for (int h = 0; h < 2; ++h) { const f32x4 a0 = *(const f32x4*)(CW + col + 4 * h), a1 = *(const f32x4*)(CW + DFF + col + 4 * h), a2 = *(const f32x4*)(CW + 2 * DFF + col + 4 * h), b0 = *(const f32x4*)(CB + col + 4 * h);
#pragma unroll
            for (int e = 0; e < 4; ++e) { w0[4 * h + e] = a0[e]; w1[4 * h + e] = a1[e]; w2[4 * h + e] = a2[e]; cb[4 * h + e] = b0[e]; } }
        const bf16* ub = U + (size_t)r0 * NUP + col; bf16* ab = ACT + (size_t)r0 * DFF + col;
        if (r0 < MP) {
            u32x4 p1 = (u32x4){0u, 0u, 0u, 0u}, p2 = p1;
            int t = r0 % TP;
            if (t >= 1) p1 = *(const u32x4*)(ub - NUP); if (t >= 2) p2 = *(const u32x4*)(ub - 2 * NUP);
#pragma unroll 1
            for (int i0 = 0; i0 < RCH; i0 += 8) {
                u32x4 ug[8], uv[8];
#pragma unroll
                for (int i = 0; i < 8; ++i) { ug[i] = *(const u32x4*)(ub + (unsigned)((i0 + i) * NUP)); uv[i] = *(const u32x4*)(ub + (unsigned)((i0 + i) * NUP + DFF)); }
#pragma unroll
                for (int i = 0; i < 8; ++i) {
                    if (t == 0) { p1 = (u32x4){0u, 0u, 0u, 0u}; p2 = p1; }
                    if (t >= TP - 2) { float* so = c.out + O_FCONVP + ((size_t)(li * BP + (r0 + i0 + i) / TP) * 2 + (t - (TP - 2))) * DFF + col;
#pragma unroll
                        for (int e = 0; e < 4; ++e) { so[2 * e] = __uint_as_float(ug[i][e] << 16); so[2 * e + 1] = __uint_as_float(ug[i][e] & 0xffff0000u); } }
                    u32x4 o;
#pragma unroll
                    for (int e = 0; e < 4; ++e) {
                        const float ca = cb[2 * e] + w2[2 * e] * __uint_as_float(ug[i][e] << 16) + w1[2 * e] * __uint_as_float(p1[e] << 16) + w0[2 * e] * __uint_as_float(p2[e] << 16);
                        const float cv = cb[2 * e + 1] + w2[2 * e + 1] * __uint_as_float(ug[i][e] & 0xffff0000u) + w1[2 * e + 1] * __uint_as_float(p1[e] & 0xffff0000u) + w0[2 * e + 1] * __uint_as_float(p2[e] & 0xffff0000u);
                        o[e] = pk2(gelu_fast(ca) * __uint_as_float(uv[i][e] << 16), gelu_fast(cv) * __uint_as_float(uv[i][e] & 0xffff0000u)); }
                    *(u32x4*)(ab + (unsigned)((i0 + i) * DFF)) = o;
                    p2 = p1; p1 = ug[i]; t = (t + 1 == TP) ? 0 : t + 1;
                }
            }
        } else {
#pragma unroll 1
            for (int i = 0; i < RCH; ++i) {
                const int row = r0 + i;
                const u32x4 ug = *(const u32x4*)(ub + (unsigned)(i * NUP)), uv = *(const u32x4*)(ub + (unsigned)(i * NUP + DFF));
                const float* st = a.in[I_SFCONV] + (size_t)(li * BS + row - MP) * 2 * DFF + col; float* so = c.out + O_FCONVS + (size_t)(li * BS + row - MP) * 2 * DFF + col;
                float f1[8], f2[8];
#pragma unroll
                for (int h = 0; h < 2; ++h) { const f32x4 s2 = *(const f32x4*)(st + 4 * h), s1 = *(const f32x4*)(st + DFF + 4 * h); *(f32x4*)(so + 4 * h) = s1;
#pragma unroll
                    for (int e = 0; e < 4; ++e) { f2[4 * h + e] = s2[e]; f1[4 * h + e] = s1[e]; } }
                u32x4 o;
#pragma unroll
                for (int e = 0; e < 4; ++e) { const float u0a = __uint_as_float(ug[e] << 16), u0b = __uint_as_float(ug[e] & 0xffff0000u);
                    so[DFF + 2 * e] = u0a; so[DFF + 2 * e + 1] = u0b;
                    const float ca = cb[2 * e] + w2[2 * e] * u0a + w1[2 * e] * f1[2 * e] + w0[2 * e] * f2[2 * e], cv = cb[2 * e + 1] + w2[2 * e + 1] * u0b + w1[2 * e + 1] * f1[2 * e + 1] + w0[2 * e + 1] * f2[2 * e + 1];
                    o[e] = pk2(gelu_fast(ca) * __uint_as_float(uv[e] << 16), gelu_fast(cv) * __uint_as_float(uv[e] & 0xffff0000u)); }
                *(u32x4*)(ab + (unsigned)(i * DFF)) = o;
            }
        }
    }
}

constexpr int RW_TG = 16;
constexpr int RW_BUF = 6 * RW_TG * 64 * 4;
constexpr int RW_Y = 2 * RW_BUF, RW_BON = RW_Y + RW_TG * 64 * 4, RW_END = RW_BON + RW_TG * 4;
DEVI void f_rwkv_prompt(const Ctx& c, const PArgs& a, int j, int b, int hd) {
    const bf16* R = (const bf16*)(c.ws + WS_R); const bf16* Kb = (const bf16*)(c.ws + WS_K);
    const bf16* VF = (const bf16*)((unsigned char*)c.out + DO_VFIRST); const bf16* Vb = j == 0 ? VF : (const bf16*)(c.ws + WS_V);
    const float* WD = (const float*)(c.ws + WS_WDEC); const bf16* AG = (const bf16*)(c.ws + WS_AG); const bf16* VG = (const bf16*)(c.ws + WS_VG); const bf16* GG = (const bf16*)(c.ws + WS_GG);
    bf16* O = (bf16*)(c.ws + WS_O);
    const int i = c.tid >> 3, q = c.tid & 7;
    const int st = c.tid >> 5, sc = (c.tid & 31) * 2, ch = hd * 64 + sc;
    const size_t rb = (size_t)(b * TP) * D + ch;
    const float kk0 = a.in[I_OKK][(size_t)j * D + ch], kk1 = a.in[I_OKK][(size_t)j * D + ch + 1], ka0 = a.in[I_OKA][(size_t)j * D + ch], ka1 = a.in[I_OKA][(size_t)j * D + ch + 1];
    const float rk0 = a.in[I_ORK][(size_t)j * D + ch], rk1 = a.in[I_ORK][(size_t)j * D + ch + 1];
    const float gg0 = a.in[I_OGNG][(size_t)j * D + ch], gg1 = a.in[I_OGNG][(size_t)j * D + ch + 1], gb0 = a.in[I_OGNB][(size_t)j * D + ch], gb1 = a.in[I_OGNB][(size_t)j * D + ch + 1];
    float s[8], z[8];
#pragma unroll
    for (int jj = 0; jj < 8; ++jj) { s[jj] = 0.f; z[jj] = 0.f; }
    unsigned pr_, pk_, pv_, pa_, pg_, pvf_ = 0u, pvg_ = 0u; float pw0, pw1;
#define RW_PREFETCH(t0) do { const unsigned o = (unsigned)(((t0) + st) * D); const bool ok = (t0) + st < TP; \
        pr_ = ok ? *(const unsigned*)(R + rb + o) : 0u; pk_ = ok ? *(const unsigned*)(Kb + rb + o) : 0u; pv_ = ok ? *(const unsigned*)(Vb + rb + o) : 0u; \
        pa_ = ok ? *(const unsigned*)(AG + rb + o) : 0u; pg_ = ok ? *(const unsigned*)(GG + rb + o) : 0u; \
        if (j == 1) { pvf_ = ok ? *(const unsigned*)(VF + rb + o) : 0u; pvg_ = ok ? *(const unsigned*)(VG + rb + o) : 0u; } \
        pw0 = ok ? WD[rb + o] : 1.f; pw1 = ok ? WD[rb + o + 1] : 1.f; } while (0)
    RW_PREFETCH(0);
    const int ngroups = (TP + RW_TG - 1) / RW_TG;
#pragma unroll 1
    for (int g = 0; g < ngroups; ++g) {
        const int t0 = g * RW_TG;
        LAS float* buf = (LAS float*)(c.lds + (g & 1) * RW_BUF);
        LAS float* ys = (LAS float*)(c.lds + RW_Y); LAS float* bon = (LAS float*)(c.lds + RW_BON);
        float gate0, gate1;
        { const float r0 = __uint_as_float(pr_ << 16), r1 = __uint_as_float(pr_ & 0xffff0000u), k0 = __uint_as_float(pk_ << 16), k1 = __uint_as_float(pk_ & 0xffff0000u);
          float v0 = __uint_as_float(pv_ << 16), v1 = __uint_as_float(pv_ & 0xffff0000u);
          const float a0 = __uint_as_float(pa_ << 16), a1 = __uint_as_float(pa_ & 0xffff0000u);
          gate0 = __uint_as_float(pg_ << 16); gate1 = __uint_as_float(pg_ & 0xffff0000u);
          if (j == 1) { const float f0 = __uint_as_float(pvf_ << 16), f1 = __uint_as_float(pvf_ & 0xffff0000u); v0 = v0 + (f0 - v0) * __uint_as_float(pvg_ << 16); v1 = v1 + (f1 - v1) * __uint_as_float(pvg_ & 0xffff0000u); }
          float q0 = k0 * kk0, q1 = k1 * kk1; const float ss = red32(q0 * q0 + q1 * q1); const float rn = __builtin_amdgcn_rsqf(fmaxf(ss, 1e-24f)); q0 *= rn; q1 *= rn;
          const float m0 = k0 * (1.f + (a0 - 1.f) * ka0), m1 = k1 * (1.f + (a1 - 1.f) * ka1);
          const float bs = red32(r0 * m0 * rk0 + r1 * m1 * rk1);
          const int o = st * 64 + sc;
          *(LAS f32x2_t*)(buf + o) = (f32x2_t){r0, r1}; *(LAS f32x2_t*)(buf + RW_TG * 64 + o) = (f32x2_t){pw0, pw1}; *(LAS f32x2_t*)(buf + 2 * RW_TG * 64 + o) = (f32x2_t){m0, m1};
          *(LAS f32x2_t*)(buf + 3 * RW_TG * 64 + o) = (f32x2_t){v0, v1}; *(LAS f32x2_t*)(buf + 4 * RW_TG * 64 + o) = (f32x2_t){-q0, -q1}; *(LAS f32x2_t*)(buf + 5 * RW_TG * 64 + o) = (f32x2_t){q0 * a0, q1 * a1};
          __syncthreads();
          if ((c.tid & 31) == 0) bon[st] = bs; }
        if (g + 1 < ngroups) RW_PREFETCH(t0 + RW_TG);
        const int nt = (TP - t0) < RW_TG ? (TP - t0) : RW_TG;
        if (c.tid < 256) {
#pragma unroll 4
        for (int tt = 0; tt < nt; ++tt) {
            const LAS float* p = buf + tt * 64 + 8 * q;
            const f32x4 ra = *(const LAS f32x4*)(p), rb2 = *(const LAS f32x4*)(p + 4), wa = *(const LAS f32x4*)(p + RW_TG * 64), wb = *(const LAS f32x4*)(p + RW_TG * 64 + 4);
            const f32x4 ka = *(const LAS f32x4*)(p + 2 * RW_TG * 64), kb2 = *(const LAS f32x4*)(p + 2 * RW_TG * 64 + 4), aa = *(const LAS f32x4*)(p + 4 * RW_TG * 64), ab = *(const LAS f32x4*)(p + 4 * RW_TG * 64 + 4);
            const f32x4 ba = *(const LAS f32x4*)(p + 5 * RW_TG * 64), bb = *(const LAS f32x4*)(p + 5 * RW_TG * 64 + 4);
            const float vi = buf[3 * RW_TG * 64 + tt * 64 + i], vj = buf[3 * RW_TG * 64 + tt * 64 + i + 32];
            const float sa = red8((s[0] * aa[0] + s[1] * aa[1]) + (s[2] * aa[2] + s[3] * aa[3]) + ((s[4] * ab[0] + s[5] * ab[1]) + (s[6] * ab[2] + s[7] * ab[3])));
            const float za = red8((z[0] * aa[0] + z[1] * aa[1]) + (z[2] * aa[2] + z[3] * aa[3]) + ((z[4] * ab[0] + z[5] * ab[1]) + (z[6] * ab[2] + z[7] * ab[3])));
#pragma unroll
            for (int jj = 0; jj < 4; ++jj) { s[jj] = s[jj] * wa[jj] + sa * ba[jj] + vi * ka[jj]; s[4 + jj] = s[4 + jj] * wb[jj] + sa * bb[jj] + vi * kb2[jj];
                z[jj] = z[jj] * wa[jj] + za * ba[jj] + vj * ka[jj]; z[4 + jj] = z[4 + jj] * wb[jj] + za * bb[jj] + vj * kb2[jj]; }
            const float y = red8((s[0] * ra[0] + s[1] * ra[1]) + (s[2] * ra[2] + s[3] * ra[3]) + ((s[4] * rb2[0] + s[5] * rb2[1]) + (s[6] * rb2[2] + s[7] * rb2[3])));
            const float y2 = red8((z[0] * ra[0] + z[1] * ra[1]) + (z[2] * ra[2] + z[3] * ra[3]) + ((z[4] * rb2[0] + z[5] * rb2[1]) + (z[6] * rb2[2] + z[7] * rb2[3])));
            if (q == 0) { ys[tt * 64 + i] = y; ys[tt * 64 + i + 32] = y2; }
        }
        }
        __syncthreads();
        if (t0 + st < TP) {
            const f32x2_t yv = *(const LAS f32x2_t*)(ys + st * 64 + sc), vv = *(const LAS f32x2_t*)(buf + 3 * RW_TG * 64 + st * 64 + sc);
            const float mu = red32(yv.x + yv.y) * (1.f / 64.f); const float d0 = yv.x - mu, d1 = yv.y - mu; const float var = red32(d0 * d0 + d1 * d1) * (1.f / 64.f);
            const float rs = 1.f / sqrtf(var + 64e-5f), bo = bon[st];
            const float o0 = (d0 * rs * gg0 + gb0 + bo * vv.x) * gate0, o1 = (d1 * rs * gg1 + gb1 + bo * vv.y) * gate1;
            *(unsigned*)(O + rb + (unsigned)((t0 + st) * D)) = pk2(o0, o1);
        }
    }
#undef RW_PREFETCH
    if (c.tid < 256) { float* So = c.out + O_RWKVP + ((size_t)(j * BP + b) * 16 + hd) * 4096 + i * 64 + 8 * q;
      *(f32x4*)So = (f32x4){s[0], s[1], s[2], s[3]}; *(f32x4*)(So + 4) = (f32x4){s[4], s[5], s[6], s[7]};
      *(f32x4*)(So + 2048) = (f32x4){z[0], z[1], z[2], z[3]}; *(f32x4*)(So + 2052) = (f32x4){z[4], z[5], z[6], z[7]}; }
    __syncthreads();
}
DEVI void f_rwkv_sample(const Ctx& c, const PArgs& a, int j, int b, int hd) {
    const bf16* R = (const bf16*)(c.ws + WS_R); const bf16* Kb = (const bf16*)(c.ws + WS_K);
    const bf16* VF = (const bf16*)((unsigned char*)c.out + DO_VFIRST); const bf16* Vb = j == 0 ? VF : (const bf16*)(c.ws + WS_V);
    const float* WD = (const float*)(c.ws + WS_WDEC); const bf16* AG = (const bf16*)(c.ws + WS_AG); const bf16* VG = (const bf16*)(c.ws + WS_VG); const bf16* GG = (const bf16*)(c.ws + WS_GG);
    bf16* O = (bf16*)(c.ws + WS_O);
    LAS float* buf = (LAS float*)c.lds;
    const int i = c.tid >> 3, q = c.tid & 7;
    const size_t so = ((size_t)(j * BS + b) * 16 + hd) * 4096 + i * 64 + 8 * q;
    const f32x4 sA = __builtin_nontemporal_load((const f32x4*)(a.in[I_SRWKV] + so)), sB = __builtin_nontemporal_load((const f32x4*)(a.in[I_SRWKV] + so + 4));
    float s[8] = {sA[0], sA[1], sA[2], sA[3], sB[0], sB[1], sB[2], sB[3]};
    float gate = 0.f;
    __syncthreads();
    if (c.tid < 64) { const int ch = hd * 64 + c.tid; const size_t o = (size_t)(MP + b) * D + ch;
        const float r = bf2f(R[o]), k = bf2f(Kb[o]), ag = bf2f(AG[o]), w = WD[o]; float v = bf2f(Vb[o]); gate = bf2f(GG[o]);
        if (j == 1) { const float vf = bf2f(VF[o]); v = v + (vf - v) * bf2f(VG[o]); }
        float kk = k * a.in[I_OKK][(size_t)j * D + ch]; const float ss = wave_sum(kk * kk); kk = kk / sqrtf(fmaxf(ss, 1e-24f));
        const float km = k * (1.f + (ag - 1.f) * a.in[I_OKA][(size_t)j * D + ch]);
        const float bs = wave_sum(r * km * a.in[I_ORK][(size_t)j * D + ch]);
        buf[c.tid] = r; buf[64 + c.tid] = w; buf[128 + c.tid] = km; buf[192 + c.tid] = v; buf[256 + c.tid] = -kk; buf[320 + c.tid] = kk * ag;
        if (c.tid == 0) buf[448] = bs; }
    __syncthreads();
    { float sa = 0.f;
#pragma unroll
      for (int jj = 0; jj < 8; ++jj) sa += s[jj] * buf[256 + 8 * q + jj];
      sa = red8(sa);
      const float vi = buf[192 + i]; float y = 0.f;
#pragma unroll
      for (int jj = 0; jj < 8; ++jj) { const int cj = 8 * q + jj; s[jj] = s[jj] * buf[64 + cj] + sa * buf[320 + cj] + vi * buf[128 + cj]; y += s[jj] * buf[cj]; }
      y = red8(y);
      if (q == 0) buf[384 + i] = y;
      float* Sout = c.out + O_RWKVS + so;
      __builtin_nontemporal_store((f32x4){s[0], s[1], s[2], s[3]}, (f32x4*)Sout); __builtin_nontemporal_store((f32x4){s[4], s[5], s[6], s[7]}, (f32x4*)(Sout + 4)); }
    __syncthreads();
    if (c.tid < 64) { const int ch = hd * 64 + c.tid;
        const float y = buf[384 + c.tid]; const float mu = wave_sum(y) * (1.f / 64.f); const float dy = y - mu; const float var = wave_sum(dy * dy) * (1.f / 64.f);
        float o = dy / sqrtf(var + 64e-5f) * a.in[I_OGNG][(size_t)j * D + ch] + a.in[I_OGNB][(size_t)j * D + ch];
        o = (o + buf[448] * buf[192 + c.tid]) * gate;
        O[(size_t)(MP + b) * D + ch] = f2bf(o); }
}
DEVI void f_odd_scan(const Ctx& c, const PArgs& a, int li) {
    const int j = li >> 1;
    if (c.bid < 128) f_rwkv_prompt(c, a, j, c.bid >> 4, c.bid & 15);
    else for (int u = c.bid - 128; u < 2048; u += c.G - 128) f_rwkv_sample(c, a, j, u >> 4, u & 15);
}

constexpr size_t DO_BON = 54 * MiB;
DEVI float red16(float x) { x += DPP_F(x, 0xB1); x += DPP_F(x, 0x4E); x += DPP_F(x, 0x141); x += DPP_F(x, 0x140); return x; }
constexpr int RW2_Y = 2 * RW_BUF, RW2_END = RW2_Y + 2 * RW_TG * 32 * 4;
DEVI void f_rwkv_prompt2(const Ctx& c, const PArgs& a, int j, int b, int hd, int half) {
    const bf16* R = (const bf16*)(c.ws + WS_R); const bf16* Kb = (const bf16*)(c.ws + WS_K);
    const bf16* VF = (const bf16*)((unsigned char*)c.out + DO_VFIRST); const bf16* Vb = j == 0 ? VF : (const bf16*)(c.ws + WS_V);
    const float* WD = (const float*)(c.ws + WS_WDEC); const bf16* AG = (const bf16*)(c.ws + WS_AG); const bf16* VG = (const bf16*)(c.ws + WS_VG);
    bf16* O = (bf16*)(c.ws + WS_O); float* BON = (float*)((unsigned char*)c.out + DO_BON);
    const int il = c.tid >> 4, q = c.tid & 15;
    const int st = c.tid >> 5, sc = (c.tid & 31) * 2, ch = hd * 64 + sc;
    const size_t rb = (size_t)(b * TP) * D + ch;
    const float kk0 = a.in[I_OKK][(size_t)j * D + ch], kk1 = a.in[I_OKK][(size_t)j * D + ch + 1], ka0 = a.in[I_OKA][(size_t)j * D + ch], ka1 = a.in[I_OKA][(size_t)j * D + ch + 1];
    const float rk0 = a.in[I_ORK][(size_t)j * D + ch], rk1 = a.in[I_ORK][(size_t)j * D + ch + 1];
    f32x4 s = (f32x4){0.f, 0.f, 0.f, 0.f};
    unsigned pr_, pk_, pv_, pa_, pvf_ = 0u, pvg_ = 0u; f32x2_t pw_;
#define RW2_PREFETCH(t0) do { const unsigned o = (unsigned)(((t0) + st) * D); const bool ok = (t0) + st < TP; \
        pr_ = ok ? *(const unsigned*)(R + rb + o) : 0u; pk_ = ok ? *(const unsigned*)(Kb + rb + o) : 0u; pv_ = ok ? *(const unsigned*)(Vb + rb + o) : 0u; pa_ = ok ? *(const unsigned*)(AG + rb + o) : 0u; \
        if (j == 1) { pvf_ = ok ? *(const unsigned*)(VF + rb + o) : 0u; pvg_ = ok ? *(const unsigned*)(VG + rb + o) : 0u; } \
        pw_ = ok ? *(const f32x2_t*)(WD + rb + o) : (f32x2_t){1.f, 1.f}; } while (0)
    RW2_PREFETCH(0);
    const int ngroups = (TP + RW_TG - 1) / RW_TG;
    LAS float* ys = (LAS float*)(c.lds + RW2_Y);
#pragma unroll 1
    for (int g = 0; g < ngroups; ++g) {
        const int t0 = g * RW_TG; const int nt = (TP - t0) < RW_TG ? (TP - t0) : RW_TG;
        LAS float* buf = (LAS float*)(c.lds + (g & 1) * RW_BUF);
        { const float r0 = __uint_as_float(pr_ << 16), r1 = __uint_as_float(pr_ & 0xffff0000u), k0 = __uint_as_float(pk_ << 16), k1 = __uint_as_float(pk_ & 0xffff0000u);
          float v0 = __uint_as_float(pv_ << 16), v1 = __uint_as_float(pv_ & 0xffff0000u);
          const float a0 = __uint_as_float(pa_ << 16), a1 = __uint_as_float(pa_ & 0xffff0000u);
          if (j == 1) { const float f0 = __uint_as_float(pvf_ << 16), f1 = __uint_as_float(pvf_ & 0xffff0000u); v0 = v0 + (f0 - v0) * __uint_as_float(pvg_ << 16); v1 = v1 + (f1 - v1) * __uint_as_float(pvg_ & 0xffff0000u); }
          float q0 = k0 * kk0, q1 = k1 * kk1; const float ss = red32(q0 * q0 + q1 * q1); const float rn = __builtin_amdgcn_rsqf(fmaxf(ss, 1e-24f)); q0 *= rn; q1 *= rn;
          const float m0 = k0 * (1.f + (a0 - 1.f) * ka0), m1 = k1 * (1.f + (a1 - 1.f) * ka1);
          const float bs = red32(r0 * m0 * rk0 + r1 * m1 * rk1);
          const int o = st * 64 + sc;
          *(LAS f32x2_t*)(buf + o) = (f32x2_t){r0, r1}; *(LAS f32x2_t*)(buf + RW_TG * 64 + o) = pw_; *(LAS f32x2_t*)(buf + 2 * RW_TG * 64 + o) = (f32x2_t){m0, m1};
          *(LAS f32x2_t*)(buf + 3 * RW_TG * 64 + o) = (f32x2_t){v0, v1}; *(LAS f32x2_t*)(buf + 4 * RW_TG * 64 + o) = (f32x2_t){-q0, -q1}; *(LAS f32x2_t*)(buf + 5 * RW_TG * 64 + o) = (f32x2_t){q0 * a0, q1 * a1};
          if (half == 0 && (c.tid & 31) == 0 && t0 + st < TP) BON[(size_t)(b * TP + t0 + st) * 16 + hd] = bs; }
        __syncthreads();
        if (g + 1 < ngroups) RW2_PREFETCH(t0 + RW_TG);
        {
            const LAS float* p = buf + 4 * q; const LAS float* pv = buf + 3 * RW_TG * 64 + 32 * half + il;
            f32x4 r4 = *(const LAS f32x4*)(p), w4 = *(const LAS f32x4*)(p + RW_TG * 64), k4 = *(const LAS f32x4*)(p + 2 * RW_TG * 64), a4 = *(const LAS f32x4*)(p + 4 * RW_TG * 64), b4 = *(const LAS f32x4*)(p + 5 * RW_TG * 64);
            float vi = pv[0];
#pragma unroll 2
            for (int tt = 0; tt < nt; ++tt) {
                const int tn = tt + 1 < nt ? tt + 1 : tt;
                const f32x4 nr4 = *(const LAS f32x4*)(p + tn * 64), nw4 = *(const LAS f32x4*)(p + RW_TG * 64 + tn * 64), nk4 = *(const LAS f32x4*)(p + 2 * RW_TG * 64 + tn * 64),
                            na4 = *(const LAS f32x4*)(p + 4 * RW_TG * 64 + tn * 64), nb4 = *(const LAS f32x4*)(p + 5 * RW_TG * 64 + tn * 64);
                const float nvi = pv[tn * 64];
                const float sa = red16((s[0] * a4[0] + s[1] * a4[1]) + (s[2] * a4[2] + s[3] * a4[3]));
                s = s * w4 + b4 * sa + k4 * vi;
                const float y = red16((s[0] * r4[0] + s[1] * r4[1]) + (s[2] * r4[2] + s[3] * r4[3]));
                if (q == 0) ys[tt * 32 + il] = y;
                r4 = nr4; w4 = nw4; k4 = nk4; a4 = na4; b4 = nb4; vi = nvi;
            }
        }
        __syncthreads();
        { const int tt = c.tid >> 5, cc = c.tid & 31; if (tt < nt) O[(size_t)(b * TP + t0 + tt) * D + hd * 64 + 32 * half + cc] = f2bf(ys[tt * 32 + cc]); }
    }
#undef RW2_PREFETCH
    { float* So = c.out + O_RWKVP + ((size_t)(j * BP + b) * 16 + hd) * 4096 + (32 * half + il) * 64 + 4 * q; *(f32x4*)So = s; }
    __syncthreads();
}
DEVI void f_rwkv_post(const Ctx& c, const PArgs& a, int li) {
    const int j = li >> 1;
    bf16* O = (bf16*)(c.ws + WS_O); const bf16* GG = (const bf16*)(c.ws + WS_GG); const bf16* VG = (const bf16*)(c.ws + WS_VG);
    const bf16* VF = (const bf16*)((unsigned char*)c.out + DO_VFIRST); const bf16* Vb = j == 0 ? VF : (const bf16*)(c.ws + WS_V); const float* BON = (const float*)((unsigned char*)c.out + DO_BON);
    const int pc = c.tid & 127, ch = pc * 8;
    const f32x4 g0 = *(const f32x4*)(a.in[I_OGNG] + (size_t)j * D + ch), g1 = *(const f32x4*)(a.in[I_OGNG] + (size_t)j * D + ch + 4), b0 = *(const f32x4*)(a.in[I_OGNB] + (size_t)j * D + ch), b1 = *(const f32x4*)(a.in[I_OGNB] + (size_t)j * D + ch + 4);
    for (int row = c.bid * 4 + (c.tid >> 7); row < MP; row += c.G * 4) {
        const size_t o = (size_t)row * D + ch;
        const u32x4 yv = *(const u32x4*)(O + o), vv = *(const u32x4*)(Vb + o), gv = *(const u32x4*)(GG + o);
        float y[8], v[8], gt[8];
#pragma unroll
        for (int e = 0; e < 4; ++e) { y[2 * e] = __uint_as_float(yv[e] << 16); y[2 * e + 1] = __uint_as_float(yv[e] & 0xffff0000u); v[2 * e] = __uint_as_float(vv[e] << 16); v[2 * e + 1] = __uint_as_float(vv[e] & 0xffff0000u);
            gt[2 * e] = __uint_as_float(gv[e] << 16); gt[2 * e + 1] = __uint_as_float(gv[e] & 0xffff0000u); }
        if (j == 1) { const u32x4 fv = *(const u32x4*)(VF + o), mv = *(const u32x4*)(VG + o);
#pragma unroll
            for (int e = 0; e < 4; ++e) { const float f0 = __uint_as_float(fv[e] << 16), f1 = __uint_as_float(fv[e] & 0xffff0000u), m0 = __uint_as_float(mv[e] << 16), m1 = __uint_as_float(mv[e] & 0xffff0000u);
                v[2 * e] = v[2 * e] + (f0 - v[2 * e]) * m0; v[2 * e + 1] = v[2 * e + 1] + (f1 - v[2 * e + 1]) * m1; } }
        float s1 = 0.f;
#pragma unroll
        for (int e = 0; e < 8; ++e) s1 += y[e];
        const float mu = red8(s1) * (1.f / 64.f); float s2 = 0.f;
#pragma unroll
        for (int e = 0; e < 8; ++e) { y[e] -= mu; s2 += y[e] * y[e]; }
        const float rs = __builtin_amdgcn_rsqf(red8(s2) * (1.f / 64.f) + 64e-5f), bo = BON[(size_t)row * 16 + (pc >> 3)];
        u32x4 out;
#pragma unroll
        for (int e = 0; e < 4; ++e) { const float gg0 = e < 2 ? g0[2 * e] : g1[2 * e - 4], gg1 = e < 2 ? g0[2 * e + 1] : g1[2 * e - 3], bb0 = e < 2 ? b0[2 * e] : b1[2 * e - 4], bb1 = e < 2 ? b0[2 * e + 1] : b1[2 * e - 3];
            out[e] = pk2((y[2 * e] * rs * gg0 + bb0 + bo * v[2 * e]) * gt[2 * e], (y[2 * e + 1] * rs * gg1 + bb1 + bo * v[2 * e + 1]) * gt[2 * e + 1]); }
        *(u32x4*)(O + o) = out;
    }
}
DEVI void f_odd_scan2(const Ctx& c, const PArgs& a, int li) {
    const int j = li >> 1;
    for (int u = c.bid; u < 256; u += c.G) f_rwkv_prompt2(c, a, j, u >> 5, (u >> 1) & 15, u & 1);
    for (int u = c.bid; u < 2048; u += c.G) f_rwkv_sample(c, a, j, u >> 4, u & 15);
}

constexpr int R_AF = 0, R_RF = 2048, R_BKF = 4096, R_VF = 8192, R_GF = 10240, R_RECA = 12288, R_RECB = 13312, R_PL = 14336, R_BON = 14592, RW3_REC = 14848;
constexpr int RW3_RING = 0, RW3_SCR = 8 * RW3_REC, RW3_SCRW = 5120, RW3_STAT = RW3_SCR + 4 * RW3_SCRW, RW3_END = RW3_STAT + 4096;
static_assert(RW3_END <= RING_BYTES, "rwkv3 lds");
#define DPP_RM(v, ctrl, rm) __builtin_bit_cast(float, __builtin_amdgcn_update_dpp(0, __builtin_bit_cast(int, (v)), (ctrl), (rm), 0xF, false))
DEVI float wsum64(float x) { x = red16(x); x += DPP_RM(x, 0x142, 0xA); x += DPP_RM(x, 0x143, 0xC); return __builtin_bit_cast(float, __builtin_amdgcn_readlane(__builtin_bit_cast(int, x), 63)); }
#define LWAIT() asm volatile("s_waitcnt lgkmcnt(0)" ::: "memory")
DEVI bf16x8_t frag_lohi(u32x2 lo, u32x2 hi) { u32x4 t; t.x = lo.x; t.y = lo.y; t.z = hi.x; t.w = hi.y; return __builtin_bit_cast(bf16x8_t, t); }
struct RwRaw { u32x2 r[4], k[4], v[4], a[4], g[4], f[4], m[4]; f32x4 w[4]; };
DEVI void rw3_load(const Ctx& c, RwRaw& q, int j, int b, int hd, int ck, int parts) {
    const bf16* R = (const bf16*)(c.ws + WS_R); const bf16* Kb = (const bf16*)(c.ws + WS_K);
    const bf16* VF_ = (const bf16*)((unsigned char*)c.out + DO_VFIRST); const bf16* Vb = j == 0 ? VF_ : (const bf16*)(c.ws + WS_V);
    const float* WD = (const float*)(c.ws + WS_WDEC); const bf16* AG = (const bf16*)(c.ws + WS_AG); const bf16* VG = (const bf16*)(c.ws + WS_VG); const bf16* GG = (const bf16*)(c.ws + WS_GG);
    const size_t rb = (size_t)(b * TP + ck * 16 + (c.lane & 15)) * D + hd * 64 + 4 * (c.lane >> 4);
#pragma unroll
    for (int n = 0; n < 4; ++n) { const size_t o = rb + 16 * n;
        if (parts & 4) { q.r[n] = *(const u32x2*)(R + o); q.k[n] = *(const u32x2*)(Kb + o); q.a[n] = *(const u32x2*)(AG + o); }
        if (parts & 2) q.w[n] = *(const f32x4*)(WD + o);
        if (parts & 1) { q.v[n] = *(const u32x2*)(Vb + o); q.g[n] = *(const u32x2*)(GG + o);
            if (j == 1) { q.f[n] = *(const u32x2*)(VF_ + o); q.m[n] = *(const u32x2*)(VG + o); } else { q.f[n] = (u32x2){0u, 0u}; q.m[n] = (u32x2){0u, 0u}; } } }
}
DEVI float bfe(u32x2 p, int e) { const unsigned u = e < 2 ? p.x : p.y; return (e & 1) ? __uint_as_float(u & 0xffff0000u) : __uint_as_float(u << 16); }
DEVI float fq_sum(float s) {
    u32x2 r = __builtin_amdgcn_permlane16_swap(__float_as_uint(s), __float_as_uint(s), false, false); s = __uint_as_float(r.x) + __uint_as_float(r.y);
    r = __builtin_amdgcn_permlane32_swap(__float_as_uint(s), __float_as_uint(s), false, false); return __uint_as_float(r.x) + __uint_as_float(r.y);
}
template <int S> DEVI float dpp_shr1(float x) { return __builtin_bit_cast(float, __builtin_amdgcn_update_dpp(0x3f800000, __builtin_bit_cast(int, x), 0x110 + S, 0xF, 0xF, false)); }
struct RwCoef { float kk[4][4], ka[4][4], rk[4][4]; };
#ifndef PREP_PRIO
#define PREP_PRIO 0
#endif
#ifndef CHAIN_PRIO
#define CHAIN_PRIO 3
#endif
constexpr int RW3_CF = 3072;
DEVI void rw3_prep(const Ctx& c, int j, int b, int hd, int ckn, RwRaw& q, LAS unsigned char* rec, LAS unsigned char* scr) {
    const int lane = c.lane, fr = lane & 15, fq = lane >> 4, t = fr;
    { const int lv = ((t >> 2) * 16 + 4 * fq) * 8 + (t & 3) * 2;
#pragma unroll
      for (int n = 0; n < 4; ++n)
#pragma unroll
        for (int e = 0; e < 4; ++e) { float v = bfe(q.v[n], e); if (j == 1) v = v + (bfe(q.f[n], e) - v) * bfe(q.m[n], e);
            *(LAS bf16*)(rec + R_VF + n * 512 + lv + e * 8) = f2bf(v);
            const unsigned gw = e < 2 ? q.g[n].x : q.g[n].y;
            *(LAS unsigned short*)(rec + R_GF + n * 512 + lv + e * 8) = (unsigned short)((e & 1) ? (gw >> 16) : gw); } }
    if (ckn >= 0) rw3_load(c, q, j, b, hd, ckn, 1);
    RwCoef cf;
#pragma unroll
    for (int n = 0; n < 4; ++n) { const f32x4 x0 = *(const LAS f32x4*)(scr + RW3_CF + (fq * 12 + n) * 16), x1 = *(const LAS f32x4*)(scr + RW3_CF + (fq * 12 + 4 + n) * 16), x2 = *(const LAS f32x4*)(scr + RW3_CF + (fq * 12 + 8 + n) * 16);
#pragma unroll
        for (int e = 0; e < 4; ++e) { cf.kk[n][e] = x0[e]; cf.ka[n][e] = x1[e]; cf.rk[n][e] = x2[e]; } }
    float ss = 0.f, bon = 0.f, P[4][4];
#pragma unroll
    for (int n = 0; n < 4; ++n)
#pragma unroll
        for (int e = 0; e < 4; ++e) { const float k = bfe(q.k[n], e), r = bfe(q.r[n], e), ag = bfe(q.a[n], e);
            const float kn = k * cf.kk[n][e]; ss += kn * kn;
            bon += r * (k * (1.f + (ag - 1.f) * cf.ka[n][e])) * cf.rk[n][e];
            P[n][e] = q.w[n][e]; }
    if (ckn >= 0) rw3_load(c, q, j, b, hd, ckn, 2);
    ss = fq_sum(ss); bon = fq_sum(bon);
    const float inv = __builtin_amdgcn_rsqf(fmaxf(ss, 1e-24f));
#pragma unroll
    for (int n = 0; n < 4; ++n)
#pragma unroll
        for (int e = 0; e < 4; ++e) { float x = P[n][e]; x = x * dpp_shr1<1>(x); x = x * dpp_shr1<2>(x); x = x * dpp_shr1<4>(x); x = x * dpp_shr1<8>(x); P[n][e] = x; }
    if (fq == 0) *(LAS float*)(rec + R_BON + t * 4) = bon;
    if (t == 15) {
#pragma unroll
        for (int n = 0; n < 4; ++n) *(LAS f32x4*)(rec + R_PL + (16 * n + 4 * fq) * 4) = (f32x4){P[n][0], P[n][1], P[n][2], P[n][3]}; }
    u32x4 afw[2], rfw[2], bfw[2], kfw[2];
#pragma unroll
    for (int kk = 0; kk < 2; ++kk) {
        float av[8], rv[8], bv[8], kv[8];
#pragma unroll
        for (int jj = 0; jj < 8; ++jj) { const int n = 2 * kk + (jj >> 2), e = jj & 3;
            const float k = bfe(q.k[n], e), r = bfe(q.r[n], e), ag = bfe(q.a[n], e);
            const float kn = k * cf.kk[n][e] * inv, km = k * (1.f + (ag - 1.f) * cf.ka[n][e]);
            const float Pn = P[n][e], Pm1 = dpp_shr1<1>(Pn), ip = rcpf_(Pn);
            av[jj] = -kn * Pm1; rv[jj] = r * Pn; bv[jj] = kn * ag * ip; kv[jj] = km * ip; }
        afw[kk] = (u32x4){pk2(av[0], av[1]), pk2(av[2], av[3]), pk2(av[4], av[5]), pk2(av[6], av[7])}; rfw[kk] = (u32x4){pk2(rv[0], rv[1]), pk2(rv[2], rv[3]), pk2(rv[4], rv[5]), pk2(rv[6], rv[7])};
        bfw[kk] = (u32x4){pk2(bv[0], bv[1]), pk2(bv[2], bv[3]), pk2(bv[4], bv[5]), pk2(bv[6], bv[7])}; kfw[kk] = (u32x4){pk2(kv[0], kv[1]), pk2(kv[2], kv[3]), pk2(kv[4], kv[5]), pk2(kv[6], kv[7])};
        *(LAS u32x4*)(rec + R_AF + (kk * 64 + lane) * 16) = afw[kk]; *(LAS u32x4*)(rec + R_RF + (kk * 64 + lane) * 16) = rfw[kk];
    }
    { const int lb = ((t >> 2) * 16 + 4 * fq) * 16 + (t & 3) * 2;
#pragma unroll
      for (int n = 0; n < 4; ++n)
#pragma unroll
        for (int e = 0; e < 4; ++e) { const int kk = n >> 1, jj = 4 * (n & 1) + e; const unsigned bw = bfw[kk][jj >> 1], kw = kfw[kk][jj >> 1];
            *(LAS unsigned short*)(rec + R_BKF + n * 1024 + lb + e * 16) = (unsigned short)((jj & 1) ? (bw >> 16) : bw);
            *(LAS unsigned short*)(rec + R_BKF + n * 1024 + lb + e * 16 + 8) = (unsigned short)((jj & 1) ? (kw >> 16) : kw);
        } }
    if (ckn >= 0) rw3_load(c, q, j, b, hd, ckn, 4);
    f32x4 Aab = (f32x4){0.f, 0.f, 0.f, 0.f}, Aak = Aab, Arb = Aab, Ark = Aab;
#pragma unroll
    for (int kk = 0; kk < 2; ++kk) {
        const bf16x8_t af = __builtin_bit_cast(bf16x8_t, afw[kk]), rf = __builtin_bit_cast(bf16x8_t, rfw[kk]), bf_ = __builtin_bit_cast(bf16x8_t, bfw[kk]), kf = __builtin_bit_cast(bf16x8_t, kfw[kk]);
        Aab = __builtin_amdgcn_mfma_f32_16x16x32_bf16(af, bf_, Aab, 0, 0, 0); Aak = __builtin_amdgcn_mfma_f32_16x16x32_bf16(af, kf, Aak, 0, 0, 0);
        Arb = __builtin_amdgcn_mfma_f32_16x16x32_bf16(rf, bf_, Arb, 0, 0, 0); Ark = __builtin_amdgcn_mfma_f32_16x16x32_bf16(rf, kf, Ark, 0, 0, 0); }
#pragma unroll
    for (int r = 0; r < 4; ++r) { const int t = 4 * fq + r;
        *(LAS float*)(scr + (t * 16 + fr) * 4) = t > fr ? Aab[r] : 0.f;
        *(LAS bf16*)(scr + 1024 + (t * 16 + fr) * 2) = f2bf(t > fr ? Aak[r] : 0.f);
        *(LAS bf16*)(scr + 1536 + (t * 16 + fr) * 2) = f2bf(t >= fr ? Arb[r] : 0.f);
        *(LAS bf16*)(scr + 2048 + (t * 16 + fr) * 2) = f2bf(t >= fr ? Ark[r] : 0.f); }
    LWAIT();
    float Tc[16];
#pragma unroll
    for (int t = 0; t < 16; ++t) {
        float acc = (t == fr) ? 1.f : 0.f, last = 0.f;
#pragma unroll
        for (int u4 = 0; u4 < (t + 3) / 4; ++u4) { const f32x4 ar = *(const LAS f32x4*)(scr + (t * 16 + 4 * u4) * 4);
#pragma unroll
            for (int e = 0; e < 4; ++e) { if (4 * u4 + e < t - 1) acc += ar[e] * Tc[4 * u4 + e]; if (4 * u4 + e == t - 1) last = ar[e]; } }
        Tc[t] = t > 0 ? acc + last * Tc[t > 0 ? t - 1 : 0] : acc; }
    if (fq == 0) {
#pragma unroll
        for (int t = 0; t < 16; ++t) *(LAS bf16*)(scr + 2560 + (t * 16 + fr) * 2) = f2bf(Tc[t]); }
    LWAIT();
    { const u32x2 ak = *(const LAS u32x2*)(scr + 1024 + (fr * 16 + 4 * fq) * 2), tt = *(const LAS u32x2*)(scr + 2560 + (fr * 16 + 4 * fq) * 2);
      const u32x2 rbv = *(const LAS u32x2*)(scr + 1536 + (fr * 16 + 4 * fq) * 2), rkv = *(const LAS u32x2*)(scr + 2048 + (fr * 16 + 4 * fq) * 2);
      *(LAS u32x4*)(rec + R_RECA + lane * 16) = (u32x4){ak.x, ak.y, tt.x, tt.y}; *(LAS u32x4*)(rec + R_RECB + lane * 16) = (u32x4){rbv.x, rbv.y, rkv.x, rkv.y}; }
    LWAIT();
}
DEVI void f_rwkv_chunked(const Ctx& c, const PArgs& a, int j, int b, int hd) {
    bf16* O = (bf16*)(c.ws + WS_O);
    const int w = c.wave, lane = c.lane, fr = lane & 15, fq = lane >> 4;
    constexpr int NCK = TP / 16, NGR = (NCK + 3) / 4;
    __syncthreads();
    if (w >= 4) {
        __builtin_amdgcn_s_setprio(PREP_PRIO);
        { LAS unsigned char* scr = c.lds + RW3_SCR + (w - 4) * RW3_SCRW;
          if (fr < 12) { const int n = fr & 3, which = fr >> 2; const size_t o = (size_t)j * D + hd * 64 + 16 * n + 4 * fq;
              const float* p0 = a.in[I_OKK]; const float* p1 = a.in[I_OKA]; const float* p2 = a.in[I_ORK];
              *(LAS f32x4*)(scr + RW3_CF + (fq * 12 + which * 4 + n) * 16) = *(const f32x4*)((which == 0 ? p0 : (which == 1 ? p1 : p2)) + o); }
          LWAIT(); }
        RwRaw q;
        rw3_load(c, q, j, b, hd, w - 4, 7);
        rw3_prep(c, j, b, hd, w, q, c.lds + RW3_RING + (w - 4) * RW3_REC, c.lds + RW3_SCR + (w - 4) * RW3_SCRW);
        __syncthreads();
#pragma unroll 1
        for (int g = 0; g < NGR; ++g) {
            const int ck = 4 * (g + 1) + (w - 4);
            if (ck < NCK) rw3_prep(c, j, b, hd, ck + 4 < NCK ? ck + 4 : -1, q, c.lds + RW3_RING + (((g + 1) & 1) * 4 + (w - 4)) * RW3_REC, c.lds + RW3_SCR + (w - 4) * RW3_SCRW);
            __syncthreads();
        }
    __builtin_amdgcn_s_setprio(0);
    } else {
        __builtin_amdgcn_s_setprio(CHAIN_PRIO);
        f32x4 G[4];
#pragma unroll
        for (int jb = 0; jb < 4; ++jb) G[jb] = (f32x4){0.f, 0.f, 0.f, 0.f};
        const int ch = hd * 64 + 16 * w + fr;
        const float gng = a.in[I_OGNG][(size_t)j * D + ch], gnb = a.in[I_OGNB][(size_t)j * D + ch];
        __syncthreads();
#pragma unroll 1
        for (int g = 0; g < NGR; ++g) {
            const int nck = (NCK - 4 * g) < 4 ? (NCK - 4 * g) : 4;
            f32x4 yk[4]; u32x2 vk[4], gk[4]; f32x4 bk[4];
            LAS float* stat = (LAS float*)(c.lds + RW3_STAT + (g & 1) * 2048);
#pragma unroll
            for (int q = 0; q < 4; ++q) {
                if (q < nck) {
                    const LAS unsigned char* rec = c.lds + RW3_RING + ((g & 1) * 4 + q) * RW3_REC;
                    bf16x8_t gb[2];
#pragma unroll
                    for (int kk = 0; kk < 2; ++kk) { u32x4 t; t.x = pk2(G[2 * kk][0], G[2 * kk][1]); t.y = pk2(G[2 * kk][2], G[2 * kk][3]); t.z = pk2(G[2 * kk + 1][0], G[2 * kk + 1][1]); t.w = pk2(G[2 * kk + 1][2], G[2 * kk + 1][3]); gb[kk] = __builtin_bit_cast(bf16x8_t, t); }
                    const u32x2 vf = *(const LAS u32x2*)(rec + R_VF + (w * 64 + lane) * 8); const u32x4 ra = *(const LAS u32x4*)(rec + R_RECA + lane * 16);
                    vk[q] = vf; gk[q] = *(const LAS u32x2*)(rec + R_GF + (w * 64 + lane) * 8); bk[q] = *(const LAS f32x4*)(rec + R_BON + 16 * fq);
                    const u32x2 z2 = (u32x2){0u, 0u};
                    f32x4 W = __builtin_amdgcn_mfma_f32_16x16x32_bf16(__builtin_bit_cast(bf16x8_t, ra), frag_lohi(vf, z2), (f32x4){0.f, 0.f, 0.f, 0.f}, 0, 0, 0);
                    W = __builtin_amdgcn_mfma_f32_16x16x32_bf16(*(const LAS bf16x8_t*)(rec + R_AF + lane * 16), gb[0], W, 0, 0, 0);
                    W = __builtin_amdgcn_mfma_f32_16x16x32_bf16(*(const LAS bf16x8_t*)(rec + R_AF + (64 + lane) * 16), gb[1], W, 0, 0, 0);
                    const u32x2 wlo = (u32x2){pk2(W[0], W[1]), pk2(W[2], W[3])};
                    const f32x4 U = __builtin_amdgcn_mfma_f32_16x16x32_bf16(frag_lohi((u32x2){ra.z, ra.w}, (u32x2){ra.x, ra.y}), frag_lohi(wlo, z2), (f32x4){0.f, 0.f, 0.f, 0.f}, 0, 0, 0);
                    const bf16x8_t ub = frag_lohi((u32x2){pk2(U[0], U[1]), pk2(U[2], U[3])}, vf);
                    f32x4 Y = __builtin_amdgcn_mfma_f32_16x16x32_bf16(*(const LAS bf16x8_t*)(rec + R_RF + lane * 16), gb[0], (f32x4){0.f, 0.f, 0.f, 0.f}, 0, 0, 0);
                    Y = __builtin_amdgcn_mfma_f32_16x16x32_bf16(*(const LAS bf16x8_t*)(rec + R_RF + (64 + lane) * 16), gb[1], Y, 0, 0, 0);
                    Y = __builtin_amdgcn_mfma_f32_16x16x32_bf16(*(const LAS bf16x8_t*)(rec + R_RECB + lane * 16), ub, Y, 0, 0, 0);
#pragma unroll
                    for (int jb = 0; jb < 4; ++jb) { G[jb] = __builtin_amdgcn_mfma_f32_16x16x32_bf16(*(const LAS bf16x8_t*)(rec + R_BKF + (jb * 64 + lane) * 16), ub, G[jb], 0, 0, 0);
                        G[jb] = G[jb] * *(const LAS f32x4*)(rec + R_PL + (16 * jb + 4 * fq) * 4); }
                    yk[q] = Y;
#pragma unroll
                    for (int r = 0; r < 4; ++r) { const float s1 = red16(Y[r]), s2 = red16(Y[r] * Y[r]); if (fr == 0) *(LAS f32x2_t*)(stat + ((q * 4 + w) * 16 + 4 * fq + r) * 2) = (f32x2_t){s1, s2}; }
                }
            }
            __syncthreads();
#pragma unroll
            for (int q = 0; q < 4; ++q) {
                if (q < nck) {
#pragma unroll
                    for (int r = 0; r < 4; ++r) { const int t = 4 * fq + r; float s1 = 0.f, s2 = 0.f;
#pragma unroll
                        for (int ww = 0; ww < 4; ++ww) { const f32x2_t sv = *(const LAS f32x2_t*)(stat + ((q * 4 + ww) * 16 + t) * 2); s1 += sv.x; s2 += sv.y; }
                        const float mu = s1 * (1.f / 64.f), var = fmaxf(s2 * (1.f / 64.f) - mu * mu, 0.f), rs = __builtin_amdgcn_rsqf(var + 64e-5f);
                        const unsigned vb_ = r < 2 ? vk[q].x : vk[q].y, gb_ = r < 2 ? gk[q].x : gk[q].y;
                        const float v = (r & 1) ? __uint_as_float(vb_ & 0xffff0000u) : __uint_as_float(vb_ << 16), gt = (r & 1) ? __uint_as_float(gb_ & 0xffff0000u) : __uint_as_float(gb_ << 16);
                        const float o = ((yk[q][r] - mu) * rs * gng + gnb + bk[q][r] * v) * gt;
                        O[(size_t)(b * TP + (4 * g + q) * 16 + t) * D + ch] = f2bf(o); }
                }
            }
        }
        float* So = c.out + O_RWKVP + ((size_t)(j * BP + b) * 16 + hd) * 4096 + (size_t)(16 * w + fr) * 64 + 4 * fq;
#pragma unroll
        for (int jb = 0; jb < 4; ++jb) *(f32x4*)(So + 16 * jb) = G[jb];
        __builtin_amdgcn_s_setprio(0);
    }
    __syncthreads();
}
#ifndef SSB
#define SSB 160
#endif
#ifndef SCAN_PART
#define SCAN_PART 3
#endif
DEVI void f_odd_scan3(const Ctx& c, const PArgs& a, int li, int part) {
    const int j = li >> 1;
    if (c.bid < 128) { if (part & 1) f_rwkv_chunked(c, a, j, c.bid >> 4, c.bid & 15); }
    else if ((part & 2) && c.bid >= SSB) for (int u = c.bid - SSB; u < 2048; u += c.G - SSB) f_rwkv_sample(c, a, j, u >> 4, u & 15);
}

template <int CTRL> DEVI float dppz(float x) { return __builtin_bit_cast(float, __builtin_amdgcn_update_dpp(0, __builtin_bit_cast(int, x), CTRL, 0xF, 0xF, true)); }
struct EpiUpAct {
    static constexpr bool PERM = true;
    bf16* U; bf16* ACT; const float* RS; const float* CW; const float* CB; float* FCP;
    DEVI void operator()(const f32x4 (&acc)[2][2][4][2], const pg8::Unit& u, int wr, int wc, int fr, int fq) const {
        const int f0 = u.pn * 128 + wc * 32 + fq * 8;
        f32x4 w0[2], w1[2], w2[2], cb[2];
#pragma unroll
        for (int n = 0; n < 2; ++n) { w0[n] = *(const f32x4*)(CW + f0 + 4 * n); w1[n] = *(const f32x4*)(CW + DFF + f0 + 4 * n); w2[n] = *(const f32x4*)(CW + 2 * DFF + f0 + 4 * n); cb[n] = *(const f32x4*)(CB + f0 + 4 * n); }
        float rsv[2][4];
#pragma unroll
        for (int ai = 0; ai < 2; ++ai)
#pragma unroll
            for (int m = 0; m < 4; ++m) rsv[ai][m] = row_rstd_q(RS, u.pm * 256 + ai * 128 + wr * 64 + m * 16 + fr, fq);
#pragma unroll
        for (int ai = 0; ai < 2; ++ai) {
            const int rowg = u.pm * 256 + ai * 128 + wr * 64;
            const bool sample = rowg >= MP;
            f32x4 ug[4][2];
            float rs[4];
#pragma unroll
            for (int m = 0; m < 4; ++m) { rs[m] = rsv[ai][m]; ug[m][0] = acc[ai][0][m][0] * rs[m]; ug[m][1] = acc[ai][0][m][1] * rs[m]; }
#pragma unroll
            for (int m = 3; m >= 0; --m) {
                const int row = rowg + m * 16 + fr; const int tt = sample ? 16 : (rowg + m * 16) % TP;
                const f32x4 uv0 = acc[ai][1][m][0] * rs[m], uv1 = acc[ai][1][m][1] * rs[m];
                f32x4 p1[2], p2[2];
#pragma unroll
                for (int n = 0; n < 2; ++n)
#pragma unroll
                    for (int e = 0; e < 4; ++e) {
                        const float cur = ug[m][n][e];
                        float q1 = dppz<0x111>(cur), q2 = dppz<0x112>(cur);
                        if (m > 0) { const float prv = ug[m > 0 ? m - 1 : 0][n][e]; q1 += dppz<0x10F>(prv); q2 += dppz<0x10E>(prv); }
                        p1[n][e] = q1; p2[n][e] = q2;
                        if (tt == 0) { if (fr == 0) p1[n][e] = 0.f; if (fr < 2) p2[n][e] = 0.f; } }
                const bool pending = sample || (m == 0 && fr < 2);
                if (pending || (m == 3 && fr >= 14)) *(u32x4*)(U + (size_t)row * NUP + f0) = pack8(ug[m][0], ug[m][1]);
                if (pending) *(u32x4*)(U + (size_t)row * NUP + DFF + f0) = pack8(uv0, uv1);
                else {
                    f32x4 o0, o1;
#pragma unroll
                    for (int e = 0; e < 4; ++e) { o0[e] = geluf_(cb[0][e] + w2[0][e] * ug[m][0][e] + w1[0][e] * p1[0][e] + w0[0][e] * p2[0][e]) * uv0[e];
                        o1[e] = geluf_(cb[1][e] + w2[1][e] * ug[m][1][e] + w1[1][e] * p1[1][e] + w0[1][e] * p2[1][e]) * uv1[e]; }
                    *(u32x4*)(ACT + (size_t)row * DFF + f0) = pack8(o0, o1);
                    if (tt == TP - 16 && fr >= 14) { float* so = FCP + ((size_t)(row / TP) * 2 + (fr - 14)) * DFF + f0; *(f32x4*)so = ug[m][0]; *(f32x4*)(so + 4) = ug[m][1]; }
                }
            }
        }
    }
};
DEVI void f_ffn_up_act(const Ctx& c, const PArgs& a, int li) {
    pg8::Gemm g{(const bf16*)(c.ws + WS_XB), (const bf16*)(c.ws + WS_WB + WB_WUP + li * SZ_WUP), M, NUP, D, D, 0ull, 0};
    pg8::StaticOrder S; S.init(M, NUP, c.G, c.bid);
    EpiUpAct E{(bf16*)(c.ws + WS_U), (bf16*)(c.ws + WS_ACT), (const float*)(c.ws + WS_RS), a.in[I_FCW] + (size_t)li * 3 * DFF, a.in[I_FCB] + (size_t)li * DFF, c.out + O_FCONVP + (size_t)li * BP * 2 * DFF};
    pg8::gemm_phase<EpiUpAct>(c.lds, c.tid, g, S, E);
}
DEVI void f_ffn_fix(const Ctx& c, const PArgs& a, int li) {
    const bf16* U = (const bf16*)(c.ws + WS_U); bf16* ACT = (bf16*)(c.ws + WS_ACT);
    const float* CW = a.in[I_FCW] + (size_t)li * 3 * DFF; const float* CB = a.in[I_FCB] + (size_t)li * DFF;
    constexpr int NPC = DFF / 8, NROW = (MP / 64) * 2 + BS, NITEM = NPC * NROW;
    for (int it = c.bid * NT + c.tid; it < NITEM; it += c.G * NT) {
        const int ri = it / NPC, pc = it - ri * NPC, col = pc * 8;
        const int row = ri < (MP / 64) * 2 ? (ri >> 1) * 64 + (ri & 1) : MP + (ri - (MP / 64) * 2);
        const u32x4 ug = *(const u32x4*)(U + (size_t)row * NUP + col), uv = *(const u32x4*)(U + (size_t)row * NUP + DFF + col);
        float f1[8], f2[8];
        if (row < MP) { const int t = row % TP; u32x4 p1 = (u32x4){0u, 0u, 0u, 0u}, p2 = p1;
            if (t >= 1) p1 = *(const u32x4*)(U + (size_t)(row - 1) * NUP + col); if (t >= 2) p2 = *(const u32x4*)(U + (size_t)(row - 2) * NUP + col);
#pragma unroll
            for (int e = 0; e < 4; ++e) { f1[2 * e] = __uint_as_float(p1[e] << 16); f1[2 * e + 1] = __uint_as_float(p1[e] & 0xffff0000u); f2[2 * e] = __uint_as_float(p2[e] << 16); f2[2 * e + 1] = __uint_as_float(p2[e] & 0xffff0000u); }
        } else { const float* st = a.in[I_SFCONV] + (size_t)(li * BS + row - MP) * 2 * DFF + col; float* so = c.out + O_FCONVS + (size_t)(li * BS + row - MP) * 2 * DFF + col;
#pragma unroll
            for (int h = 0; h < 2; ++h) { const f32x4 s2 = *(const f32x4*)(st + 4 * h), s1 = *(const f32x4*)(st + DFF + 4 * h); *(f32x4*)(so + 4 * h) = s1;
#pragma unroll
                for (int e = 0; e < 4; ++e) { f2[4 * h + e] = s2[e]; f1[4 * h + e] = s1[e]; } }
#pragma unroll
            for (int e = 0; e < 4; ++e) { so[DFF + 2 * e] = __uint_as_float(ug[e] << 16); so[DFF + 2 * e + 1] = __uint_as_float(ug[e] & 0xffff0000u); } }
        u32x4 o;
#pragma unroll
        for (int e = 0; e < 4; ++e) { const float u0a = __uint_as_float(ug[e] << 16), u0b = __uint_as_float(ug[e] & 0xffff0000u);
            const float ca = CB[col + 2 * e] + CW[2 * DFF + col + 2 * e] * u0a + CW[DFF + col + 2 * e] * f1[2 * e] + CW[col + 2 * e] * f2[2 * e];
            const float cv = CB[col + 2 * e + 1] + CW[2 * DFF + col + 2 * e + 1] * u0b + CW[DFF + col + 2 * e + 1] * f1[2 * e + 1] + CW[col + 2 * e + 1] * f2[2 * e + 1];
            o[e] = pk2(geluf_(ca) * __uint_as_float(uv[e] << 16), geluf_(cv) * __uint_as_float(uv[e] & 0xffff0000u)); }
        *(u32x4*)(ACT + (size_t)row * DFF + col) = o;
    }
}

DEVI void f_odd_norm(const Ctx& c, const PArgs& a, int li) {
    const int j = li >> 1;
    const bf16* XB = (const bf16*)(c.ws + WS_XB); const float* RS = (const float*)(c.ws + WS_RS); bf16* XM = (bf16*)(c.ws + WS_XMIX);
    const float* gain = a.in[I_NMIX] + (size_t)li * D; const float* mix = a.in[I_OMIX] + (size_t)j * 6 * D;
    const int gw = c.bid * NWAVES + c.wave, NGW = c.G * NWAVES;
    const int r0 = (int)(((long)gw * M) / NGW), r1 = (int)(((long)(gw + 1) * M) / NGW);
    f32x4 gv[4], mv[6][4];
#pragma unroll
    for (int q = 0; q < 4; ++q) { const int col = q * 256 + c.lane * 4; gv[q] = *(const f32x4*)(gain + col);
#pragma unroll
        for (int n = 0; n < 6; ++n) mv[n][q] = *(const f32x4*)(mix + (size_t)n * D + col); }
    f32x4 hprev[4];
#pragma unroll
    for (int q = 0; q < 4; ++q) hprev[q] = (f32x4){0.f, 0.f, 0.f, 0.f};
    for (int row = r0; row < r1; ++row) {
        const float rs = row_rstd(RS, row);
        const bool prompt = row < MP; const int b = prompt ? row / TP : row - MP, t = prompt ? row % TP : 0;
        const bool need_prev = prompt && t > 0 && row == r0;
        const float rsp = need_prev ? row_rstd(RS, row - 1) : 0.f;
#pragma unroll
        for (int q = 0; q < 4; ++q) { const int col = q * 256 + c.lane * 4;
            const u32x2 xw_ = *(const u32x2*)(XB + (size_t)row * D + col);
            const f32x4 h = (f32x4){__uint_as_float(xw_.x << 16), __uint_as_float(xw_.x & 0xffff0000u), __uint_as_float(xw_.y << 16), __uint_as_float(xw_.y & 0xffff0000u)} * rs * gv[q];
            f32x4 hp = hprev[q];
            if (!prompt) hp = *(const f32x4*)(a.in[I_SSHIFT] + (size_t)(j * BS + b) * D + col);
            else if (t == 0) hp = (f32x4){0.f, 0.f, 0.f, 0.f};
            else if (need_prev) { const u32x2 pw_ = *(const u32x2*)(XB + (size_t)(row - 1) * D + col);
                hp = (f32x4){__uint_as_float(pw_.x << 16), __uint_as_float(pw_.x & 0xffff0000u), __uint_as_float(pw_.y << 16), __uint_as_float(pw_.y & 0xffff0000u)} * rsp * gv[q]; }
            const f32x4 xx = hp - h;
#pragma unroll
            for (int n = 0; n < 6; ++n) { const f32x4 o = h + xx * mv[n][q]; u32x2 w; w.x = pk2(o.x, o.y); w.y = pk2(o.z, o.w); *(u32x2*)(XM + ((size_t)n * M + row) * D + col) = w; }
            if (prompt) { if (t == TP - 1) *(f32x4*)(c.out + O_SHIFTP + (size_t)(j * BP + b) * D + col) = h; }
            else *(f32x4*)(c.out + O_SHIFTS + (size_t)(j * BS + b) * D + col) = h;
            hprev[q] = h; }
    }
}

DEVI void f_tail_residual(const Ctx& c, const bf16* A, int lda, const bf16* Bt, int K, bool wxb) {
    float* X = (float*)(c.ws + WS_X); bf16* XB = (bf16*)(c.ws + WS_XB); float* RS = (float*)(c.ws + WS_RS);
    LAS float* red = (LAS float*)c.lds;
    const int fr = c.lane & 15, fq = c.lane >> 4, nks = K / 32;
    for (int task = c.bid; task < 256; task += c.G) {
        const int row0 = M_MAIN + (task >> 4) * 16, col0 = (task & 15) * 64;
        const bf16* ap = A + (size_t)(row0 + fr) * lda + 8 * fq; const bf16* bp = Bt + (size_t)(col0 + fr) * K + 8 * fq;
        f32x4 acc[4];
#pragma unroll
        for (int nb = 0; nb < 4; ++nb) acc[nb] = (f32x4){0.f, 0.f, 0.f, 0.f};
#pragma unroll 1
        for (int ks0 = c.wave; ks0 < nks; ks0 += 32) {
            bf16x8_t af[4], bf_[4][4];
#pragma unroll
            for (int u = 0; u < 4; ++u) { const int ks = ks0 + 8 * u; const bool ok = ks < nks; const unsigned ko = (unsigned)(32 * (ok ? ks : 0));
                af[u] = *(const bf16x8_t*)(ap + ko);
#pragma unroll
                for (int nb = 0; nb < 4; ++nb) bf_[u][nb] = *(const bf16x8_t*)(bp + (unsigned)(16 * nb * K) + ko);
                if (!ok) af[u] = (bf16x8_t){0, 0, 0, 0, 0, 0, 0, 0}; }
#pragma unroll
            for (int u = 0; u < 4; ++u)
#pragma unroll
                for (int nb = 0; nb < 4; ++nb) acc[nb] = __builtin_amdgcn_mfma_f32_16x16x32_bf16(af[u], bf_[u][nb], acc[nb], 0, 0, 0);
        }
        __syncthreads();
#pragma unroll
        for (int nb = 0; nb < 4; ++nb)
#pragma unroll
            for (int r = 0; r < 4; ++r) red[(c.wave * 16 + 4 * fq + r) * 64 + 16 * nb + fr] = acc[nb][r];
        __syncthreads();
        { const int r = c.tid >> 5, cc = 2 * (c.tid & 31); float v0 = 0.f, v1 = 0.f;
#pragma unroll
          for (int w = 0; w < 8; ++w) { const f32x2_t t = *(const LAS f32x2_t*)(red + (w * 16 + r) * 64 + cc); v0 += t.x; v1 += t.y; }
          const size_t o = (size_t)(row0 + r) * D + col0 + cc;
          const unsigned xo = *(const unsigned*)(XB + o); v0 += __uint_as_float(xo << 16); v1 += __uint_as_float(xo & 0xffff0000u);
          (void)wxb; (void)X; *(unsigned*)(XB + o) = pk2(v0, v1);
          const float ss = red32(v0 * v0 + v1 * v1);
          if ((c.tid & 31) == 0) RS[(size_t)(row0 + r) * 16 + (task & 15)] = ss; }
    }
    __syncthreads();
}

__global__ void __launch_bounds__(NT, 2) hybrid_fwd(Args args) {
    extern __shared__ __attribute__((aligned(16))) unsigned char lds_raw[];
    Ctx c;
    c.lds = (LAS unsigned char*)lds_raw;
    c.tid = threadIdx.x; c.lane = c.tid & 63; c.wave = __builtin_amdgcn_readfirstlane(c.tid >> 6);
    c.G = gridDim.x; c.bid = blockIdx.x; c.ws = args.ws; c.out = args.out;
    volatile LAS unsigned* MISC = (volatile LAS unsigned*)(c.lds + MISC_OFF);
    for (int u = c.tid; u < (LDS_BYTES - LDSCTL_OFF) / 4; u += NT) ((LAS unsigned*)(c.lds + LDSCTL_OFF))[u] = 0u;
    __syncthreads();
    if (c.tid < N_IN) ((LAS unsigned long long*)(c.lds + PTAB_OFF))[c.tid] = (unsigned long long)args.in[c.tid];
    __syncthreads();
    PArgs pa; pa.in.t = (const LAS unsigned long long*)(c.lds + PTAB_OFF);
    (void)xcd_barrier_post((unsigned*)(c.ws + WS_CTL) + 4096, MISC + 8);
#define GRID_BAR() do { XcdBarrier bar_; bar_.bar = (unsigned*)(c.ws + WS_CTL) + 4096; bar_.x = xb_xcc_id(); bar_.st = (volatile LAS unsigned*)(c.lds + MISC_OFF) + 8; xcd_barrier(bar_); } while (0)
#define RETID() do { asm volatile("" : "+s"(c.wave), "+s"(c.bid), "+s"(c.G)); asm volatile("v_mbcnt_lo_u32_b32 %0, -1, 0\n\tv_mbcnt_hi_u32_b32 %0, -1, %0" : "=v"(c.lane)); c.tid = c.wave * 64 + c.lane; } while (0)
#define PHASE(body) do { RETID(); body; GRID_BAR(); } while (0)
    for (int rep = 0; rep < REP_PRO; ++rep) PHASE({ n_prologue(c, pa); f_wprep(c, pa, 1ull, c.bid * NWAVES + c.wave, c.G * NWAVES); });
#pragma unroll 1
    for (int li = 0; li < 4; ++li) {
        const int j = li >> 1;
        if ((li & 1) == 0) {
#if FAST & 1
            for (int rep = 0; rep < REP_G; ++rep) PHASE(f_even_in(c, li));
#else
            PHASE(n_even_in(c, pa, li));
#endif
#if FAST & 32
            for (int rep = 0; rep < REP_MIX; ++rep) PHASE(f_even_mix(c, pa, li, rep == 0 ? 7 : MIX_PART));
#else
            PHASE(n_even_mix(c, pa, li));
#endif
#if FAST & 2
            PHASE({ f_gemm_residual(c, (const bf16*)(c.ws + WS_MIX), 2048, (const bf16*)(c.ws + WS_WB + WB_WOUT + j * SZ_WOUT), 2048, true); RETID(); f_tail_residual(c, (const bf16*)(c.ws + WS_MIX), 2048, (const bf16*)(c.ws + WS_WB + WB_WOUT + j * SZ_WOUT), 2048, true); });
#else
            PHASE(n_gemm_residual(c, (const bf16*)(c.ws + WS_MIX), 2048, pa.in[I_EWOUT] + (size_t)j * 2048 * D, 2048, true));
#endif
        } else {
            for (int rep = 0; rep < REP_NORM; ++rep) PHASE(f_odd_norm(c, pa, li));
#if FAST & 8
            for (int rep = 0; rep < REP_G; ++rep) PHASE(f_odd_in(c, li));
#else
            PHASE(n_odd_in(c, pa, li));
#endif
#if FAST & 16
            for (int rep = 0; rep < REP_G; ++rep) PHASE(f_odd_lora(c, pa, li));
#else
            PHASE(n_odd_lora(c, pa, li));
#endif
#if FAST & 128
#if FAST & 512
            for (int rep = 0; rep < REP_SCAN; ++rep) PHASE(f_odd_scan3(c, pa, li, rep == 0 ? 3 : SCAN_PART));
#elif FAST & 256
            for (int rep = 0; rep < REP_SCAN; ++rep) { PHASE(f_odd_scan2(c, pa, li)); PHASE(f_rwkv_post(c, pa, li)); }
#else
            for (int rep = 0; rep < REP_SCAN; ++rep) PHASE(f_odd_scan(c, pa, li));
#endif
#else
            for (int rep = 0; rep < REP_SCAN; ++rep) PHASE(n_odd_scan(c, pa, li));
#endif
#if FAST & 2
            PHASE({ f_gemm_residual(c, (const bf16*)(c.ws + WS_O), D, (const bf16*)(c.ws + WS_WB + WB_WO + j * SZ_WO), D, true); RETID(); f_tail_residual(c, (const bf16*)(c.ws + WS_O), D, (const bf16*)(c.ws + WS_WB + WB_WO + j * SZ_WO), D, true); });
#else
            PHASE(n_gemm_residual(c, (const bf16*)(c.ws + WS_O), D, pa.in[I_OWO] + (size_t)j * D * D, D, true));
#endif
        }
#if FUSE_ACT
        for (int rep = 0; rep < REP_G; ++rep) PHASE(f_ffn_up_act(c, pa, li));
        PHASE(f_ffn_fix(c, pa, li));
#else
#if FAST & 4
        for (int rep = 0; rep < REP_G; ++rep) PHASE(f_ffn_up(c, li));
#else
        PHASE(n_ffn_up(c, pa, li));
#endif
#if FAST & 64
        for (int rep = 0; rep < REP_ACT; ++rep) PHASE(f_ffn_act(c, pa, li));
#else
        for (int rep = 0; rep < REP_ACT; ++rep) PHASE(n_ffn_act(c, pa, li));
#endif
#endif
#if FAST & 2
        PHASE({ f_gemm_residual(c, (const bf16*)(c.ws + WS_ACT), DFF, (const bf16*)(c.ws + WS_WB + WB_WDN + li * SZ_WDN), DFF, li == 1); RETID(); f_tail_residual(c, (const bf16*)(c.ws + WS_ACT), DFF, (const bf16*)(c.ws + WS_WB + WB_WDN + li * SZ_WDN), DFF, li == 1);   });
#else
        PHASE(n_gemm_residual(c, (const bf16*)(c.ws + WS_ACT), DFF, pa.in[I_FWDN] + (size_t)li * DFF * D, DFF, true));
#endif
    }
    RETID(); n_final(c, pa);
#undef PHASE
}

extern "C" void kernel_launch(void* const* d_in, const int* in_sizes, int n_in, void* d_out, int out_size, void* d_ws, size_t ws_size, hipStream_t stream) {
    static int grid = 0;
    if (grid == 0) {
        if (n_in != N_IN || (size_t)out_size != O_END || ws_size < WS_END) {
            fprintf(stderr, "kernel_launch: unexpected shapes: n_in %d (want %d), out %d (want %zu), ws %zu (want >= %zu)\n", n_in, (int)N_IN, out_size, (size_t)O_END, ws_size, (size_t)WS_END);
            grid = -1; return; }
        int dev = 0, cus = 0;
        if (hipGetDevice(&dev) != hipSuccess || hipDeviceGetAttribute(&cus, hipDeviceAttributeMultiprocessorCount, dev) != hipSuccess) { grid = -1; return; }
        if (hipFuncSetAttribute((const void*)hybrid_fwd, hipFuncAttributeMaxDynamicSharedMemorySize, LDS_BYTES) != hipSuccess) { fprintf(stderr, "kernel_launch: hipFuncSetAttribute failed\n"); grid = -1; return; }
        int per_cu = 0;
        (void)hipOccupancyMaxActiveBlocksPerMultiprocessor(&per_cu, (const void*)hybrid_fwd, NT, LDS_BYTES);
        (void)hipGetLastError();
        grid = cus;
    }
    if (grid < 0) return;
    if (hipMemsetAsync((char*)d_ws + WS_CTL, 0, CTL_ZERO_BYTES, stream) != hipSuccess) return;
    Args a{};
    for (int i = 0; i < N_IN; ++i) a.in[i] = (const float*)d_in[i];
    a.out = (float*)d_out; a.ws = (unsigned char*)d_ws;
    hipLaunchKernelGGL(hybrid_fwd, dim3(grid), dim3(NT), LDS_BYTES, stream, a);
}
```

```cpp
#include <hip/hip_runtime.h>
#include <cstdio>
#include <cstdint>

#define GAS __attribute__((address_space(1)))
#define LAS __attribute__((address_space(3)))
#define DEVI __device__ __forceinline__
typedef unsigned short bf16;
typedef float f32x4 __attribute__((ext_vector_type(4)));
typedef unsigned u32x2 __attribute__((ext_vector_type(2)));
typedef float f32x2_t __attribute__((ext_vector_type(2)));
typedef unsigned u32x4 __attribute__((ext_vector_type(4)));

#ifndef FAST
#define FAST 1023
#endif
#ifndef REP_SCAN
#define REP_SCAN 1
#endif
#ifndef REP_ACT
#define REP_ACT 1
#endif
#ifndef REP_MIX
#define REP_MIX 1
#endif
#ifndef REP_PRO
#define REP_PRO 1
#endif
#ifndef FUSE_ACT
#define FUSE_ACT 1
#endif
#ifndef REP_G
#define REP_G 1
#endif
#ifndef REP_NORM
#define REP_NORM 1
#endif
constexpr int D = 1024, TP = 2064, NMETA = 16, SEQ = 2048, BP = 8, BS = 128;
constexpr int MP = BP * TP;
constexpr int M = MP + BS;
constexpr int NIN = 5120, DFF = 2816, NUP = 2 * DFF;
constexpr int M_MAIN = 16384;
constexpr int LML = 640;
constexpr int NWAVES = 8, NT = NWAVES * 64;

constexpr size_t MiB = 1u << 20;
constexpr size_t WS_CTL = 0, CTL_ZERO_BYTES = 1 * MiB;
constexpr size_t WS_RS = 1 * MiB;
constexpr size_t WS_ROPE = 3 * MiB;
constexpr size_t WS_WB = 5 * MiB;
constexpr size_t WS_X = 124 * MiB;
constexpr size_t WS_R = 124 * MiB;
constexpr size_t WS_XB = 189 * MiB;
constexpr size_t WS_BIG = 222 * MiB;
constexpr size_t SZ_ACT1 = (size_t)M * D * 2;
constexpr size_t WS_Z = WS_BIG, WS_MIX = WS_BIG + 163 * MiB;
constexpr size_t WS_U = WS_BIG, WS_ACT = WS_BIG + 179 * MiB;
constexpr size_t WS_XMIX = WS_BIG, WS_K = WS_BIG + 195 * MiB, WS_V = WS_BIG + 228 * MiB;
constexpr size_t WS_WDEC = WS_BIG, WS_AG = WS_BIG + 65 * MiB, WS_GG = WS_AG + SZ_ACT1, WS_VG = WS_GG + SZ_ACT1, WS_O = WS_VG + SZ_ACT1;
constexpr size_t WS_END = WS_BIG + 270 * MiB;
static_assert(WS_O + SZ_ACT1 <= WS_K && WS_ACT + (size_t)M * DFF * 2 <= WS_END && WS_V + SZ_ACT1 <= WS_END && WS_MIX + (size_t)M * 2048 * 2 <= WS_END, "ws map");
constexpr size_t DO_VFIRST = 0, DO_LMID = 33 * MiB;
static_assert(DO_LMID + (size_t)M * LML * 2 <= (size_t)BP * SEQ * D * 4, "d_out scratch");

constexpr size_t O_YP = 0, O_YS = O_YP + (size_t)BP * SEQ * D, O_RETP = O_YS + (size_t)BS * D, O_LRUP = O_RETP + (size_t)2 * BP * 4 * 128 * 256,
    O_LCONVP = O_LRUP + (size_t)2 * BP * 1024, O_RWKVP = O_LCONVP + (size_t)2 * BP * 3 * 1024, O_SHIFTP = O_RWKVP + (size_t)2 * BP * 16 * 64 * 64,
    O_FCONVP = O_SHIFTP + (size_t)2 * BP * 1024, O_RETS = O_FCONVP + (size_t)4 * BP * 2 * DFF, O_LRUS = O_RETS + (size_t)2 * BS * 4 * 128 * 256,
    O_LCONVS = O_LRUS + (size_t)2 * BS * 1024, O_RWKVS = O_LCONVS + (size_t)2 * BS * 3 * 1024, O_SHIFTS = O_RWKVS + (size_t)2 * BS * 16 * 64 * 64,
    O_FCONVS = O_SHIFTS + (size_t)2 * BS * 1024, O_END = O_FCONVS + (size_t)4 * BS * 2 * DFF;

enum { I_XP = 0, I_XS, I_SRET, I_SLRU, I_SLCONV, I_SRWKV, I_SSHIFT, I_SFCONV, I_META, I_NMIX, I_NFFN, I_NFIN,
       I_EWIN, I_ERGN, I_ECW, I_ECB, I_EWA, I_EBA, I_EWX, I_EBX, I_ELAM, I_EWOUT,
       I_OMIX, I_OWR, I_OWK, I_OWV, I_OW0, I_OW1, I_OW2, I_OA0, I_OA1, I_OA2, I_OV0, I_OV1, I_OV2, I_OG1, I_OG2, I_OKK, I_OKA, I_ORK, I_OGNG, I_OGNB, I_OWO,
       I_FWUP, I_FCW, I_FCB, I_FWDN, N_IN };

constexpr int RING_BYTES = 143360, LDSCTL_OFF = RING_BYTES, MISC_OFF = LDSCTL_OFF + 320, LDS_BYTES = 147456;

DEVI float bf2f(bf16 v) { return __uint_as_float((unsigned)v << 16); }
typedef __bf16 hbf16x2_t __attribute__((ext_vector_type(2)));
DEVI unsigned pk2(float lo, float hi) { const f32x2_t v = (f32x2_t){lo, hi}; return __builtin_bit_cast(unsigned, __builtin_convertvector(v, hbf16x2_t)); }
DEVI bf16 f2bf(float f) { return (bf16)(pk2(f, f) & 0xffffu); }
DEVI float wave_sum(float v) {
#pragma unroll
    for (int o = 1; o < 64; o <<= 1) v += __shfl_xor(v, o);
    return v;
}
DEVI float rcpf_(float x) { return __builtin_amdgcn_rcpf(x); }
DEVI float sigmoidf_(float x) { return rcpf_(1.f + __expf(-x)); }
DEVI float siluf_(float x) { return x * rcpf_(1.f + __expf(-x)); }
DEVI float tanhf_(float x) { return 2.f * rcpf_(1.f + __expf(-2.f * x)) - 1.f; }
DEVI float geluf_(float x) { return x * rcpf_(1.f + __expf(-1.5957691216057308f * (x + 0.044715f * x * x * x))); }
DEVI float softplusf_(float x) { return fmaxf(x, 0.f) + log1pf(__expf(-fabsf(x))); }

#define XB_TMO      128
#define XB_XCNT(j)  (256  + 64 * (j))
#define XB_XSUB(j)  (1280 + 64 * (j))
#define XB_XGEN(j)  (2304 + 64 * (j))
#define XB_TOP      3328
#define XB_TOPGEN   3392
#define XCD_BAR_WORDS 3456
#define XB_SPIN_CAP (1u << 22)
DEVI unsigned xb_ld(unsigned* p)              { return __hip_atomic_load(p, __ATOMIC_RELAXED, __HIP_MEMORY_SCOPE_AGENT); }
DEVI unsigned xb_add(unsigned* p, unsigned v) { return __hip_atomic_fetch_add(p, v, __ATOMIC_RELAXED, __HIP_MEMORY_SCOPE_AGENT); }
DEVI unsigned xb_xcc_id() { return (unsigned)__builtin_amdgcn_s_getreg((3 << 11) | 20) & 0xFu; }
#define XB_SPIN(cond, bar) do { unsigned _sp = 0; while (cond) { __builtin_amdgcn_s_sleep(1); \
    if ((++_sp & 255u) == 0u) { if (xb_ld(&(bar)[XB_TMO])) break; if (_sp > XB_SPIN_CAP) { atomicAdd(&(bar)[XB_TMO], 1u); break; } } } } while (0)
struct XcdBarrier { unsigned* bar; unsigned x; volatile LAS unsigned* st; };
DEVI XcdBarrier xcd_barrier_post(unsigned* bar, volatile LAS unsigned* st) {
    XcdBarrier b; b.bar = bar; b.x = xb_xcc_id(); b.st = st;
    if (threadIdx.x == 0) (void)xb_add(&bar[XB_XCNT(b.x)], 1u);
    return b;
}
DEVI void xcd_barrier_complete(unsigned* bar, unsigned x, unsigned& nloc, unsigned& nx) {
    const unsigned G = gridDim.x * gridDim.y * gridDim.z;
    unsigned sum, cnt, mine, sp = 0u;
    for (;;) {
        sum = 0u; cnt = 0u; mine = 0u;
#pragma unroll
        for (unsigned j = 0; j < 16; ++j) { const unsigned c = xb_ld(&bar[XB_XCNT(j)]); sum += c; cnt += (c > 0u) ? 1u : 0u; mine = (j == x) ? c : mine; }
        if (sum == G) break;
        __builtin_amdgcn_s_sleep(1);
        if ((++sp & 255u) == 0u) { if (xb_ld(&bar[XB_TMO])) break; if (sp > XB_SPIN_CAP) { atomicAdd(&bar[XB_TMO], 1u); break; } }
    }
    nloc = mine > 0u ? mine : 1u; nx = cnt > 0u ? cnt : 1u;
}
DEVI void xcd_barrier(const XcdBarrier& b) {
    asm volatile("s_waitcnt vmcnt(0)" ::: "memory");
    __syncthreads();
    if (threadIdx.x == 0) {
        unsigned* bar = b.bar;
        __builtin_amdgcn_s_waitcnt(0);
        unsigned nloc = b.st[0], nx = b.st[1];
        if (nloc == 0u) { xcd_barrier_complete(bar, b.x, nloc, nx); b.st[0] = nloc; b.st[1] = nx; }
        const unsigned old = xb_add(&bar[XB_XSUB(b.x)], 1u);
        const unsigned gen = old / nloc;
        if (old + 1u == (gen + 1u) * nloc) {
            __builtin_amdgcn_fence(__ATOMIC_RELEASE, "agent");
            asm volatile("s_waitcnt vmcnt(0)" ::: "memory");
            const unsigned og = xb_add(&bar[XB_TOP], 1u);
            const unsigned tg = og / nx;
            if (og + 1u == (tg + 1u) * nx) xb_add(&bar[XB_TOPGEN], 1u);
            else XB_SPIN(xb_ld(&bar[XB_TOPGEN]) == tg, bar);
            __builtin_amdgcn_fence(__ATOMIC_ACQUIRE, "agent");
            xb_add(&bar[XB_XGEN(b.x)], 1u);
            asm volatile("s_waitcnt vmcnt(0)" ::: "memory");
        } else {
            XB_SPIN(xb_ld(&bar[XB_XGEN(b.x)]) == gen, bar);
            __builtin_amdgcn_fence(__ATOMIC_ACQUIRE, "agent");
            asm volatile("s_waitcnt vmcnt(0)" ::: "memory");
        }
    }
    __syncthreads();
}

struct Args { const float* in[N_IN]; float* out; unsigned char* ws; };
constexpr int PTAB_OFF = MISC_OFF + 128;
struct InTab { const LAS unsigned long long* t;
    DEVI const float* operator[](int i) const { const unsigned long long v = t[i];
        const unsigned lo = __builtin_amdgcn_readfirstlane((unsigned)v), hi = __builtin_amdgcn_readfirstlane((unsigned)(v >> 32));
        return (const float*)(const __attribute__((address_space(1))) float*)(((unsigned long long)hi << 32) | lo); } };
struct PArgs { InTab in; };

struct Ctx {
    LAS unsigned char* lds;
    int tid, lane, wave, G, bid;
    unsigned char* ws; float* out;
};
DEVI int row_pos(int row) { return row < MP ? (row % TP) : TP; }
DEVI float row_rstd(const float* RS, int row) {
    const f32x4* p = (const f32x4*)(RS + (size_t)row * 16);
    const f32x4 a = p[0], b = p[1], c = p[2], d = p[3];
    const float s = ((a.x + a.y) + (a.z + a.w)) + ((b.x + b.y) + (b.z + b.w)) + ((c.x + c.y) + (c.z + c.w)) + ((d.x + d.y) + (d.z + d.w));
    return __builtin_amdgcn_rsqf(s * (1.0f / D) + 1e-6f);
}
DEVI float row_rstd_fin(const f32x4 a) {
    float s = (a.x + a.y) + (a.z + a.w);
    u32x2 r = __builtin_amdgcn_permlane16_swap(__float_as_uint(s), __float_as_uint(s), false, false); s = __uint_as_float(r.x) + __uint_as_float(r.y);
    r = __builtin_amdgcn_permlane32_swap(__float_as_uint(s), __float_as_uint(s), false, false); s = __uint_as_float(r.x) + __uint_as_float(r.y);
    return __builtin_amdgcn_rsqf(s * (1.0f / D) + 1e-6f);
}

DEVI void n_prologue(const Ctx& c, const PArgs& a) {
    float* X = (float*)(c.ws + WS_X); bf16* XB = (bf16*)(c.ws + WS_XB); float* RS = (float*)(c.ws + WS_RS);
    const int gw = c.bid * NWAVES + c.wave, NGW = c.G * NWAVES;
    for (int row = gw; row < M; row += NGW) {
        const float* src;
        if (row < MP) { const int b = row / TP, t = row % TP; src = t < NMETA ? a.in[I_META] + (size_t)t * D : a.in[I_XP] + ((size_t)b * SEQ + (t - NMETA)) * D; }
        else src = a.in[I_XS] + (size_t)(row - MP) * D;
        float ss = 0.f;
#pragma unroll
        for (int j = 0; j < 4; ++j) {
            const f32x4 v = __builtin_nontemporal_load((const f32x4*)(src + j * 256 + c.lane * 4));
            (void)X;
            u32x2 w; w.x = pk2(v.x, v.y); w.y = pk2(v.z, v.w);
            *(u32x2*)(XB + (size_t)row * D + j * 256 + c.lane * 4) = w;
            ss += (v.x * v.x + v.y * v.y) + (v.z * v.z + v.w * v.w);
        }
        ss = wave_sum(ss);
        if (c.lane < 16) RS[(size_t)row * 16 + c.lane] = c.lane == 0 ? ss : 0.f;
    }
    float* ROPE = (float*)(c.ws + WS_ROPE);
    for (int e = c.bid * NT + c.tid; e < (TP + 1) * 64; e += c.G * NT) {
        const int p = e >> 6, d = e & 63;
        const double pos = p < TP ? (double)p : 16384.0;
        const double inv = exp(-9.210340371976184 * ((double)d / 63.0));
        const double rev = pos * inv * 0.15915494309189535;
        const float fr = (float)(rev - rint(rev));
        ROPE[2 * e] = __builtin_amdgcn_cosf(fr); ROPE[2 * e + 1] = __builtin_amdgcn_sinf(fr);
    }
}

DEVI void ngemm_tile(const Ctx& c, const bf16* A, int lda, const float* W, int ldw, int ncv, int K, const float* gain, int row0, float (&acc)[4][4]) {
    LAS float* As = (LAS float*)c.lds;
    LAS float* Bs = (LAS float*)(c.lds + 8192);
#pragma unroll
    for (int j = 0; j < 4; ++j)
#pragma unroll
        for (int i = 0; i < 4; ++i) acc[j][i] = 0.f;
    const int ar = c.tid >> 4, ak = (c.tid & 15) * 2;
    for (int k0 = 0; k0 < K; k0 += 32) {
        __syncthreads();
        { const unsigned v = *(const unsigned*)(A + (size_t)(row0 + ar) * lda + k0 + ak);
          float lo = __uint_as_float(v << 16), hi = __uint_as_float(v & 0xffff0000u);
          if (gain) { lo *= gain[k0 + ak]; hi *= gain[k0 + ak + 1]; }
          As[ar * 33 + ak] = lo; As[ar * 33 + ak + 1] = hi; }
#pragma unroll
        for (int i = 0; i < 16; ++i) { const int idx = i * NT + c.tid, kk = idx >> 8, cc = idx & 255;
            Bs[idx] = cc < ncv ? W[(size_t)(k0 + kk) * ldw + cc] : 0.f; }
        __syncthreads();
#pragma unroll 8
        for (int kk = 0; kk < 32; ++kk) {
            float av[4], bv[4];
#pragma unroll
            for (int j = 0; j < 4; ++j) av[j] = As[(c.wave * 4 + j) * 33 + kk];
#pragma unroll
            for (int i = 0; i < 4; ++i) bv[i] = Bs[kk * 256 + c.lane + 64 * i];
#pragma unroll
            for (int j = 0; j < 4; ++j)
#pragma unroll
                for (int i = 0; i < 4; ++i) acc[j][i] += av[j] * bv[i];
        }
    }
}

DEVI void nepi_residual(const Ctx& c, int row0, int pn, const float (&acc)[4][4], bool write_xb) {
    float* X = (float*)(c.ws + WS_X); bf16* XB = (bf16*)(c.ws + WS_XB); float* RS = (float*)(c.ws + WS_RS);
#pragma unroll
    for (int j = 0; j < 4; ++j) { const int row = row0 + 4 * c.wave + j; float ss = 0.f;
#pragma unroll
        for (int i = 0; i < 4; ++i) { const int col = pn * 256 + c.lane + 64 * i; const float v = X[(size_t)row * D + col] + acc[j][i];
            X[(size_t)row * D + col] = v; if (write_xb) XB[(size_t)row * D + col] = f2bf(v); ss += v * v; }
        ss = wave_sum(ss);
        if (c.lane < 4) RS[(size_t)row * 16 + pn * 4 + c.lane] = c.lane == 0 ? ss : 0.f; }
}

DEVI void n_even_in(const Ctx& c, const PArgs& a, int li) {
    const int j = li >> 1;
    const bf16* XB = (const bf16*)(c.ws + WS_XB); const float* RS = (const float*)(c.ws + WS_RS); const float* ROPE = (const float*)(c.ws + WS_ROPE);
    bf16* Z = (bf16*)(c.ws + WS_Z);
    const float* W = a.in[I_EWIN] + (size_t)j * D * NIN; const float* gain = a.in[I_NMIX] + (size_t)li * D;
    const int ntn = NIN / 256, nu = (M / 32) * ntn;
    for (int u = c.bid; u < nu; u += c.G) {
        const int pn = u % ntn, row0 = (u / ntn) * 32;
        float acc[4][4];
        ngemm_tile(c, XB, D, W + pn * 256, NIN, 256, D, gain, row0, acc);
#pragma unroll
        for (int jj = 0; jj < 4; ++jj) { const int row = row0 + 4 * c.wave + jj; const float rs = row_rstd(RS, row);
            float v[4];
#pragma unroll
            for (int i = 0; i < 4; ++i) v[i] = acc[jj][i] * rs;
            if (pn < 4) {
                const float cs = ROPE[((size_t)row_pos(row) * 64 + c.lane) * 2], sn = ROPE[((size_t)row_pos(row) * 64 + c.lane) * 2 + 1];
                const float sc = pn >= 2 ? 0.08838834764831845f : 1.f;
                const float a0 = v[0] * cs - v[1] * sn, a1 = v[0] * sn + v[1] * cs, b0 = v[2] * cs - v[3] * sn, b1 = v[2] * sn + v[3] * cs;
                v[0] = a0 * sc; v[1] = a1 * sc; v[2] = b0 * sc; v[3] = b1 * sc;
            } else if (pn >= 8 && pn < 12) {
#pragma unroll
                for (int i = 0; i < 4; ++i) v[i] = siluf_(v[i]);
            } else if (pn >= 16) {
#pragma unroll
                for (int i = 0; i < 4; ++i) v[i] = geluf_(v[i]);
            }
#pragma unroll
            for (int i = 0; i < 4; ++i) Z[(size_t)row * NIN + pn * 256 + c.lane + 64 * i] = f2bf(v[i]); }
    }
}

DEVI void n_ret_unit(const Ctx& c, const PArgs& a, int j, int hd, int row0, int ntok, const float* S0, float* Sout) {
    const bf16* Z = (const bf16*)(c.ws + WS_Z); bf16* MIX = (bf16*)(c.ws + WS_MIX);
    LAS float* qs = (LAS float*)c.lds;
    LAS float* ks = qs + 8 * 128;
    LAS float* vs = ks + 8 * 128;
    LAS float* op = vs + 8 * 256;
    const int e = c.tid & 255, half = c.tid >> 8;
    const float gamma = 1.f - exp2f(-5.f - (float)hd);
    const float* gn = a.in[I_ERGN] + (size_t)j * 1024 + hd * 256;
    float S[64];
    if (S0) { const float* sp = S0 + (size_t)half * 64 * 256 + e;
#pragma unroll
        for (int d8 = 0; d8 < 8; ++d8) { asm volatile("" ::: "memory");
#pragma unroll
            for (int dd = 0; dd < 8; ++dd) S[d8 * 8 + dd] = sp[(size_t)(d8 * 8 + dd) * 256]; }
    } else {
#pragma unroll
        for (int dd = 0; dd < 64; ++dd) S[dd] = 0.f; }
    for (int t0 = 0; t0 < ntok; t0 += 8) {
        __syncthreads();
#pragma unroll
        for (int i = 0; i < 8; ++i) { const int idx = i * NT + c.tid, tt = idx >> 9, cc = idx & 511; const int row = row0 + t0 + tt;
            float v = 0.f;
            if (t0 + tt < ntok) { const int col = cc < 128 ? hd * 128 + cc : (cc < 256 ? 512 + hd * 128 + (cc - 128) : 1024 + hd * 256 + (cc - 256)); v = bf2f(Z[(size_t)row * NIN + col]); }
            if (cc < 128) qs[tt * 128 + cc] = v; else if (cc < 256) ks[tt * 128 + cc - 128] = v; else vs[tt * 256 + cc - 256] = v; }
        __syncthreads();
        for (int tt = 0; tt < 8; ++tt) {
            if (t0 + tt < ntok) {
                const float ve = vs[tt * 256 + e]; float o = 0.f;
#pragma unroll
                for (int dd = 0; dd < 64; ++dd) { S[dd] = gamma * S[dd] + ks[tt * 128 + half * 64 + dd] * ve; o += qs[tt * 128 + half * 64 + dd] * S[dd]; }
                op[(tt * 2 + half) * 256 + e] = o;
            }
        }
        __syncthreads();
        { const int tt = c.wave; const int row = row0 + t0 + tt;
          if (t0 + tt < ntok) {
              float o[4]; float s = 0.f;
#pragma unroll
              for (int i = 0; i < 4; ++i) { const int ee = c.lane + 64 * i; o[i] = op[(tt * 2) * 256 + ee] + op[(tt * 2 + 1) * 256 + ee]; s += o[i]; }
              const float mu = wave_sum(s) * (1.f / 256.f); float q = 0.f;
#pragma unroll
              for (int i = 0; i < 4; ++i) { o[i] -= mu; q += o[i] * o[i]; }
              const float rstd = __builtin_amdgcn_rsqf(wave_sum(q) * (1.f / 256.f) + 1e-6f);
#pragma unroll
              for (int i = 0; i < 4; ++i) { const int ee = c.lane + 64 * i; const float ga = bf2f(Z[(size_t)row * NIN + 2048 + hd * 256 + ee]);
                  MIX[(size_t)row * 2048 + hd * 256 + ee] = f2bf(ga * o[i] * rstd * gn[ee]); }
          } }
    }
    { float* sp = Sout + (size_t)half * 64 * 256 + e;
#pragma unroll
      for (int d8 = 0; d8 < 8; ++d8) { asm volatile("" ::: "memory");
#pragma unroll
          for (int dd = 0; dd < 8; ++dd) sp[(size_t)(d8 * 8 + dd) * 256] = S[d8 * 8 + dd]; } }
    __syncthreads();
}

DEVI void n_lru_unit(const Ctx& c, const PArgs& a, int j, int g, int row0, int ntok, const float* hist  , const float* h0  , float* out_h, float* out_conv) {
    const bf16* Z = (const bf16*)(c.ws + WS_Z); bf16* MIX = (bf16*)(c.ws + WS_MIX);
    LAS float* xcs = (LAS float*)c.lds;
    const int d = c.tid >> 2, p = c.tid & 3, ch = g * 128 + d;
    float wa[32], wx[32];
    { const float* WA = a.in[I_EWA] + ((size_t)(j * 8 + g) * 128 + 32 * p) * 128 + d; const float* WX = a.in[I_EWX] + ((size_t)(j * 8 + g) * 128 + 32 * p) * 128 + d;
#pragma unroll
      for (int cc = 0; cc < 32; ++cc) { wa[cc] = WA[(size_t)cc * 128]; wx[cc] = WX[(size_t)cc * 128]; } }
    const float* CW = a.in[I_ECW] + (size_t)j * 4 * 1024;
    const float cw0 = CW[ch], cw1 = CW[1024 + ch], cw2 = CW[2048 + ch], cw3 = CW[3072 + ch], cb = a.in[I_ECB][(size_t)j * 1024 + ch];
    const float ba = a.in[I_EBA][(size_t)j * 1024 + ch], bx = a.in[I_EBX][(size_t)j * 1024 + ch];
    const float sp = softplusf_(-a.in[I_ELAM][(size_t)j * 1024 + ch]);
    float x1 = hist ? hist[2 * 1024 + ch] : 0.f, x2 = hist ? hist[1024 + ch] : 0.f, x3 = hist ? hist[ch] : 0.f;
    float h = h0 ? h0[ch] : 0.f;
    for (int t = 0; t < ntok; ++t) {
        const int row = row0 + t;
        float xcv = 0.f;
        if (p == 0) { const float xb = bf2f(Z[(size_t)row * NIN + 3072 + ch]); xcv = cb + cw3 * xb + cw2 * x1 + cw1 * x2 + cw0 * x3; x3 = x2; x2 = x1; x1 = xb; xcs[d] = xcv; }
        __syncthreads();
        float sr = 0.f, si = 0.f;
#pragma unroll
        for (int cc = 0; cc < 32; ++cc) { const float xv = xcs[32 * p + cc]; sr += xv * wa[cc]; si += xv * wx[cc]; }
        sr += __shfl_xor(sr, 1); sr += __shfl_xor(sr, 2); si += __shfl_xor(si, 1); si += __shfl_xor(si, 2);
        if (p == 0) {
            const float r = sigmoidf_(sr + ba), ig = sigmoidf_(si + bx);
            const float la = -8.f * r * sp, av = __expf(la), u = sqrtf(-expm1f(2.f * la)) * (ig * xcv);
            h = av * h + u;
            MIX[(size_t)row * 2048 + 1024 + ch] = f2bf(h * bf2f(Z[(size_t)row * NIN + 4096 + ch]));
        }
        __syncthreads();
    }
    if (p == 0) { out_h[ch] = h; out_conv[ch] = x3; out_conv[1024 + ch] = x2; out_conv[2048 + ch] = x1; }
}

DEVI void n_even_mix(const Ctx& c, const PArgs& a, int li) {
    const int j = li >> 1;
    const int NU = 32 + 64 + 512 + 1024;
    for (int u = c.bid; u < NU; u += c.G) {
        if (u < 32 || (u >= 96 && u < 608)) {
            const bool pr = u < 32; const int v = pr ? u : u - 96, b = v >> 2, hd = v & 3;
            const float* S0 = pr ? nullptr : a.in[I_SRET] + ((size_t)(j * BS + b) * 4 + hd) * 128 * 256;
            float* So = pr ? c.out + O_RETP + ((size_t)(j * BP + b) * 4 + hd) * 128 * 256 : c.out + O_RETS + ((size_t)(j * BS + b) * 4 + hd) * 128 * 256;
            n_ret_unit(c, a, j, hd, pr ? b * TP : MP + b, pr ? TP : 1, S0, So);
        } else {
            const bool pr = u < 96; const int v = pr ? u - 32 : u - 608, b = v >> 3, g = v & 7;
            const float* hist = pr ? nullptr : a.in[I_SLCONV] + (size_t)(j * BS + b) * 3 * 1024;
            const float* h0 = pr ? nullptr : a.in[I_SLRU] + (size_t)(j * BS + b) * 1024;
            float* oh = pr ? c.out + O_LRUP + (size_t)(j * BP + b) * 1024 : c.out + O_LRUS + (size_t)(j * BS + b) * 1024;
            float* oc = pr ? c.out + O_LCONVP + (size_t)(j * BP + b) * 3 * 1024 : c.out + O_LCONVS + (size_t)(j * BS + b) * 3 * 1024;
            n_lru_unit(c, a, j, g, pr ? b * TP : MP + b, pr ? TP : 1, hist, h0, oh, oc);
        }
    }
}

DEVI void n_gemm_residual(const Ctx& c, const bf16* A, int lda, const float* W, int K, bool write_xb) {
    const int nu = (M / 32) * 4;
    for (int u = c.bid; u < nu; u += c.G) {
        const int pn = u & 3, row0 = (u >> 2) * 32;
        float acc[4][4];
        ngemm_tile(c, A, lda, W + pn * 256, D, 256, K, nullptr, row0, acc);
        nepi_residual(c, row0, pn, acc, write_xb);
    }
}

DEVI void n_ffn_up(const Ctx& c, const PArgs& a, int li) {
    const bf16* XB = (const bf16*)(c.ws + WS_XB); const float* RS = (const float*)(c.ws + WS_RS); bf16* U = (bf16*)(c.ws + WS_U);
    const float* W = a.in[I_FWUP] + (size_t)li * D * NUP; const float* gain = a.in[I_NFFN] + (size_t)li * D;
    const int ntn = NUP / 256, nu = (M / 32) * ntn;
    for (int u = c.bid; u < nu; u += c.G) {
        const int pn = u % ntn, row0 = (u / ntn) * 32;
        float acc[4][4];
        ngemm_tile(c, XB, D, W + pn * 256, NUP, 256, D, gain, row0, acc);
#pragma unroll
        for (int jj = 0; jj < 4; ++jj) { const int row = row0 + 4 * c.wave + jj; const float rs = row_rstd(RS, row);
#pragma unroll
            for (int i = 0; i < 4; ++i) U[(size_t)row * NUP + pn * 256 + c.lane + 64 * i] = f2bf(acc[jj][i] * rs); }
    }
}

DEVI void n_ffn_act(const Ctx& c, const PArgs& a, int li) {
    const bf16* U = (const bf16*)(c.ws + WS_U); bf16* ACT = (bf16*)(c.ws + WS_ACT);
    const float* CW = a.in[I_FCW] + (size_t)li * 3 * DFF; const float* CB = a.in[I_FCB] + (size_t)li * DFF;
    const size_t total = (size_t)M * DFF;
    for (size_t e = (size_t)c.bid * NT + c.tid; e < total; e += (size_t)c.G * NT) {
        const int row = (int)(e / DFF), col = (int)(e % DFF);
        const float u0 = bf2f(U[(size_t)row * NUP + col]); float u1, u2;
        if (row < MP) { const int b = row / TP, t = row % TP;
            u1 = t >= 1 ? bf2f(U[(size_t)(row - 1) * NUP + col]) : 0.f; u2 = t >= 2 ? bf2f(U[(size_t)(row - 2) * NUP + col]) : 0.f;
            if (t >= TP - 2) c.out[O_FCONVP + ((size_t)(li * BP + b) * 2 + (t - (TP - 2))) * DFF + col] = u0;
        } else { const int b = row - MP; const float* st = a.in[I_SFCONV] + (size_t)(li * BS + b) * 2 * DFF;
            u1 = st[DFF + col]; u2 = st[col];
            float* so = c.out + O_FCONVS + (size_t)(li * BS + b) * 2 * DFF; so[col] = u1; so[DFF + col] = u0; }
        const float cv = CB[col] + CW[2 * DFF + col] * u0 + CW[DFF + col] * u1 + CW[col] * u2;
        ACT[(size_t)row * DFF + col] = f2bf(geluf_(cv) * bf2f(U[(size_t)row * NUP + DFF + col]));
    }
}

DEVI void n_odd_norm(const Ctx& c, const PArgs& a, int li) {
    const int j = li >> 1;
    const bf16* XB = (const bf16*)(c.ws + WS_XB); const float* RS = (const float*)(c.ws + WS_RS); bf16* XM = (bf16*)(c.ws + WS_XMIX);
    const float* gain = a.in[I_NMIX] + (size_t)li * D; const float* mix = a.in[I_OMIX] + (size_t)j * 6 * D;
    const int gw = c.bid * NWAVES + c.wave, NGW = c.G * NWAVES;
    for (int row = gw; row < M; row += NGW) {
        const float rs = row_rstd(RS, row);
        const bool prompt = row < MP; const int b = prompt ? row / TP : row - MP, t = prompt ? row % TP : 0;
        const float rsp = (prompt && t > 0) ? row_rstd(RS, row - 1) : 0.f;
#pragma unroll
        for (int q = 0; q < 4; ++q) { const int col = q * 256 + c.lane * 4;
            const u32x2 xw_ = *(const u32x2*)(XB + (size_t)row * D + col); const f32x4 xv = (f32x4){__uint_as_float(xw_.x << 16), __uint_as_float(xw_.x & 0xffff0000u), __uint_as_float(xw_.y << 16), __uint_as_float(xw_.y & 0xffff0000u)}; const f32x4 gv = *(const f32x4*)(gain + col);
            const f32x4 h = xv * rs * gv; f32x4 hp;
            if (prompt) { if (t > 0) { const u32x2 pw_ = *(const u32x2*)(XB + (size_t)(row - 1) * D + col); hp = (f32x4){__uint_as_float(pw_.x << 16), __uint_as_float(pw_.x & 0xffff0000u), __uint_as_float(pw_.y << 16), __uint_as_float(pw_.y & 0xffff0000u)} * rsp * gv; } else hp = (f32x4){0.f, 0.f, 0.f, 0.f}; }
            else hp = *(const f32x4*)(a.in[I_SSHIFT] + (size_t)(j * BS + b) * D + col);
            const f32x4 xx = hp - h;
#pragma unroll
            for (int n = 0; n < 6; ++n) { const f32x4 mv = *(const f32x4*)(mix + (size_t)n * D + col); const f32x4 o = h + xx * mv;
                u32x2 w; w.x = pk2(o.x, o.y); w.y = pk2(o.z, o.w); *(u32x2*)(XM + ((size_t)n * M + row) * D + col) = w; }
            if (prompt) { if (t == TP - 1) *(f32x4*)(c.out + O_SHIFTP + (size_t)(j * BP + b) * D + col) = h; }
            else *(f32x4*)(c.out + O_SHIFTS + (size_t)(j * BS + b) * D + col) = h; }
    }
}

DEVI void n_odd_in(const Ctx& c, const PArgs& a, int li) {
    const int j = li >> 1;
    const bf16* XM = (const bf16*)(c.ws + WS_XMIX);
    bf16* R = (bf16*)(c.ws + WS_R); bf16* Kb = (bf16*)(c.ws + WS_K); bf16* Vb = j == 0 ? (bf16*)((unsigned char*)c.out + DO_VFIRST) : (bf16*)(c.ws + WS_V);
    bf16* LM = (bf16*)((unsigned char*)c.out + DO_LMID);
    const int nu = (M / 32) * 16;
    for (int u = c.bid; u < nu; u += c.G) {
        const int pn = u & 15, row0 = (u >> 4) * 32;
        if (pn == 13 && j == 0) continue;
        const bf16* A; const float* W; int ldw, ncv;
        if (pn < 4) { A = XM + (size_t)0 * M * D; W = a.in[I_OWR] + (size_t)j * D * D + pn * 256; ldw = D; ncv = 256; }
        else if (pn < 8) { A = XM + (size_t)2 * M * D; W = a.in[I_OWK] + (size_t)j * D * D + (pn - 4) * 256; ldw = D; ncv = 256; }
        else if (pn < 12) { A = XM + (size_t)3 * M * D; W = a.in[I_OWV] + (size_t)j * D * D + (pn - 8) * 256; ldw = D; ncv = 256; }
        else if (pn == 12) { A = XM + (size_t)5 * M * D; W = a.in[I_OG1] + (size_t)j * D * 128; ldw = 128; ncv = 128; }
        else if (pn == 13) { A = XM + (size_t)3 * M * D; W = a.in[I_OV1]; ldw = 32; ncv = 32; }
        else if (pn == 14) { A = XM + (size_t)1 * M * D; W = a.in[I_OW1] + (size_t)j * D * 64; ldw = 64; ncv = 64; }
        else { A = XM + (size_t)4 * M * D; W = a.in[I_OA1] + (size_t)j * D * 64; ldw = 64; ncv = 64; }
        float acc[4][4];
        ngemm_tile(c, A, D, W, ldw, ncv, D, nullptr, row0, acc);
#pragma unroll
        for (int jj = 0; jj < 4; ++jj) { const int row = row0 + 4 * c.wave + jj;
#pragma unroll
            for (int i = 0; i < 4; ++i) { const int cl = c.lane + 64 * i; const float v = acc[jj][i];
                if (pn < 4) R[(size_t)row * D + pn * 256 + cl] = f2bf(v);
                else if (pn < 8) Kb[(size_t)row * D + (pn - 4) * 256 + cl] = f2bf(v);
                else if (pn < 12) Vb[(size_t)row * D + (pn - 8) * 256 + cl] = f2bf(v);
                else if (pn == 12) { if (cl < 128) LM[(size_t)row * LML + cl] = f2bf(sigmoidf_(v)); }
                else if (pn == 13) { if (cl < 128) LM[(size_t)row * LML + 128 + cl] = f2bf(v); }
                else if (pn == 14) { if (cl < 128) LM[(size_t)row * LML + 256 + cl] = f2bf(tanhf_(v)); }
                else LM[(size_t)row * LML + 384 + cl] = f2bf(v); } }
    }
}

DEVI void n_odd_lora(const Ctx& c, const PArgs& a, int li) {
    const int j = li >> 1;
    const bf16* LM = (const bf16*)((unsigned char*)c.out + DO_LMID);
    float* WD = (float*)(c.ws + WS_WDEC); bf16* AG = (bf16*)(c.ws + WS_AG); bf16* VG = (bf16*)(c.ws + WS_VG); bf16* GG = (bf16*)(c.ws + WS_GG);
    const int nu = (M / 32) * 16;
    for (int u = c.bid; u < nu; u += c.G) {
        const int pn = u & 15, grp = pn >> 2, pc = pn & 3, row0 = (u >> 4) * 32;
        if (grp == 2 && j == 0) continue;
        const bf16* A; const float* W; int K;
        if (grp == 0) { A = LM + 256; W = a.in[I_OW2] + (size_t)j * 64 * D; K = 64; }
        else if (grp == 1) { A = LM + 384; W = a.in[I_OA2] + (size_t)j * 64 * D; K = 64; }
        else if (grp == 2) { A = LM + 128; W = a.in[I_OV2]; K = 32; }
        else { A = LM; W = a.in[I_OG2] + (size_t)j * 128 * D; K = 128; }
        float acc[4][4];
        ngemm_tile(c, A, LML, W + pc * 256, D, 256, K, nullptr, row0, acc);
#pragma unroll
        for (int jj = 0; jj < 4; ++jj) { const int row = row0 + 4 * c.wave + jj;
#pragma unroll
            for (int i = 0; i < 4; ++i) { const int col = pc * 256 + c.lane + 64 * i; const float v = acc[jj][i];
                if (grp == 0) { const float wl = -softplusf_(-(a.in[I_OW0][(size_t)j * D + col] + v)) - 0.5f; WD[(size_t)row * D + col] = __expf(-__expf(wl)); }
                else if (grp == 1) AG[(size_t)row * D + col] = f2bf(sigmoidf_(a.in[I_OA0][(size_t)j * D + col] + v));
                else if (grp == 2) VG[(size_t)row * D + col] = f2bf(sigmoidf_(a.in[I_OV0][col] + v));
                else GG[(size_t)row * D + col] = f2bf(v); } }
    }
}

DEVI void n_rwkv_unit(const Ctx& c, const PArgs& a, int j, int hd, int row0, int ntok, const float* S0, float* Sout) {
    const bf16* R = (const bf16*)(c.ws + WS_R); const bf16* Kb = (const bf16*)(c.ws + WS_K);
    const bf16* VF = (const bf16*)((unsigned char*)c.out + DO_VFIRST); const bf16* Vb = j == 0 ? VF : (const bf16*)(c.ws + WS_V);
    const float* WD = (const float*)(c.ws + WS_WDEC); const bf16* AG = (const bf16*)(c.ws + WS_AG); const bf16* VG = (const bf16*)(c.ws + WS_VG); const bf16* GG = (const bf16*)(c.ws + WS_GG);
    bf16* O = (bf16*)(c.ws + WS_O);
    LAS float* rs_ = (LAS float*)c.lds;
    LAS float* ws_ = rs_ + 512; LAS float* ks_ = ws_ + 512; LAS float* vs_ = ks_ + 512; LAS float* as_ = vs_ + 512; LAS float* bs_ = as_ + 512; LAS float* ys_ = bs_ + 512; LAS float* bon = ys_ + 512;
    const int i = c.tid >> 3, q = c.tid & 7;
    const int st = c.wave, sc = c.lane, ch = hd * 64 + sc;
    const float kkc = a.in[I_OKK][(size_t)j * D + ch], kac = a.in[I_OKA][(size_t)j * D + ch], rkc = a.in[I_ORK][(size_t)j * D + ch];
    const float gng = a.in[I_OGNG][(size_t)j * D + ch], gnb = a.in[I_OGNB][(size_t)j * D + ch];
    float s[8];
#pragma unroll
    for (int jj = 0; jj < 8; ++jj) s[jj] = 0.f;
    if (S0) {
#pragma unroll
        for (int jj = 0; jj < 8; ++jj) s[jj] = S0[(size_t)i * 64 + 8 * q + jj]; }
    for (int t0 = 0; t0 < ntok; t0 += 8) {
        __syncthreads();
        const int row = row0 + t0 + st; const bool valid = t0 + st < ntok;
        float gg = 0.f;
        { float r = 0.f, k = 0.f, v = 0.f, w = 1.f, ag = 0.f;
          if (valid) { const size_t o = (size_t)row * D + ch; r = bf2f(R[o]); k = bf2f(Kb[o]); v = bf2f(Vb[o]); w = WD[o]; ag = bf2f(AG[o]); gg = bf2f(GG[o]);
              if (j == 1) { const float vf = bf2f(VF[o]); v = v + (vf - v) * bf2f(VG[o]); } }
          float kk = k * kkc; const float ss = wave_sum(kk * kk); kk = kk / sqrtf(fmaxf(ss, 1e-24f));
          const float km = k * (1.f + (ag - 1.f) * kac);
          const float bsum = wave_sum(r * km * rkc);
          rs_[st * 64 + sc] = r; ws_[st * 64 + sc] = w; ks_[st * 64 + sc] = km; vs_[st * 64 + sc] = v; as_[st * 64 + sc] = -kk; bs_[st * 64 + sc] = kk * ag;
          if (sc == 0) bon[st] = bsum; }
        __syncthreads();
        for (int tt = 0; tt < 8; ++tt) {
            if (t0 + tt < ntok) {
                float sa = 0.f;
#pragma unroll
                for (int jj = 0; jj < 8; ++jj) sa += s[jj] * as_[tt * 64 + 8 * q + jj];
                sa += __shfl_xor(sa, 1); sa += __shfl_xor(sa, 2); sa += __shfl_xor(sa, 4);
                const float vi = vs_[tt * 64 + i]; float y = 0.f;
#pragma unroll
                for (int jj = 0; jj < 8; ++jj) { const int cj = tt * 64 + 8 * q + jj; s[jj] = s[jj] * ws_[cj] + sa * bs_[cj] + vi * ks_[cj]; y += s[jj] * rs_[cj]; }
                y += __shfl_xor(y, 1); y += __shfl_xor(y, 2); y += __shfl_xor(y, 4);
                if (q == 0) ys_[tt * 64 + i] = y;
            }
        }
        __syncthreads();
        if (valid) {
            const float y = ys_[st * 64 + sc];
            const float mu = wave_sum(y) * (1.f / 64.f); const float dy = y - mu; const float var = wave_sum(dy * dy) * (1.f / 64.f);
            float o = dy / sqrtf(var + 64e-5f) * gng + gnb;
            o = (o + bon[st] * vs_[st * 64 + sc]) * gg;
            O[(size_t)row * D + ch] = f2bf(o);
        }
    }
#pragma unroll
    for (int jj = 0; jj < 8; ++jj) Sout[(size_t)i * 64 + 8 * q + jj] = s[jj];
    __syncthreads();
}
DEVI void n_odd_scan(const Ctx& c, const PArgs& a, int li) {
    const int j = li >> 1;
    const int NU = 128 + 2048;
    for (int u = c.bid; u < NU; u += c.G) {
        const bool pr = u < 128; const int v = pr ? u : u - 128, b = v >> 4, hd = v & 15;
        const float* S0 = pr ? nullptr : a.in[I_SRWKV] + ((size_t)(j * BS + b) * 16 + hd) * 4096;
        float* So = pr ? c.out + O_RWKVP + ((size_t)(j * BP + b) * 16 + hd) * 4096 : c.out + O_RWKVS + ((size_t)(j * BS + b) * 16 + hd) * 4096;
        n_rwkv_unit(c, a, j, hd, pr ? b * TP : MP + b, pr ? TP : 1, S0, So);
    }
}

DEVI void n_final(const Ctx& c, const PArgs& a) {
    const bf16* XB = (const bf16*)(c.ws + WS_XB); const float* RS = (const float*)(c.ws + WS_RS); const float* gain = a.in[I_NFIN];
    const int gw = c.bid * NWAVES + c.wave, NGW = c.G * NWAVES;
    for (int row = gw; row < M; row += NGW) {
        float* dst;
        if (row < MP) { const int b = row / TP, t = row % TP; if (t < NMETA) continue; dst = c.out + O_YP + ((size_t)b * SEQ + (t - NMETA)) * D; }
        else dst = c.out + O_YS + (size_t)(row - MP) * D;
        const float rs = row_rstd(RS, row);
#pragma unroll
        for (int q = 0; q < 4; ++q) { const int col = q * 256 + c.lane * 4;
            const u32x2 xw_ = *(const u32x2*)(XB + (size_t)row * D + col); const f32x4 yv_ = (f32x4){__uint_as_float(xw_.x << 16), __uint_as_float(xw_.x & 0xffff0000u), __uint_as_float(xw_.y << 16), __uint_as_float(xw_.y & 0xffff0000u)} * rs * *(const f32x4*)(gain + col); __builtin_nontemporal_store(yv_, (f32x4*)(dst + col)); }
    }
}

namespace pg8 {
typedef short bf16x8 __attribute__((ext_vector_type(8)));
constexpr int BM = 256, BK = 64, HALF = 128, HTB = HALF * BK * 2, STAGE_BYTES = 8 * HTB, NXCD = 8, WGM = 8;
__host__ __device__ __forceinline__ int lds_byte(int r, int c) { const int st = (r >> 4) * 2 + (c >> 5), rr = r & 15, cc = c & 31, ob = rr * 64 + cc * 2; return st * 1024 + (ob ^ (((ob >> 9) & 1) << 5)); }
__host__ __device__ __forceinline__ void stage_rc(int b, int& R, int& C) { const int st = b / 1024, sb = b % 1024, swz = sb ^ (((sb >> 9) & 1) << 5); R = (st >> 1) * 16 + swz / 64; C = (st & 1) * 32 + (swz % 64) / 2; }
__host__ __device__ __forceinline__ int perm32(int rho) { const int n = rho >> 4, i = rho & 15; return 8 * (i >> 2) + 4 * n + (i & 3); }
struct Unit { int pm, pn; };
struct Gemm { const bf16* A; const bf16* Bt; int M, N, K, lda; unsigned long long asel; size_t astride; };
struct StaticOrder {
    int nM, nN, nwg, G, c;
    __device__ __forceinline__ void init(int M_, int N_, int G_, int c_) { nM = M_ / BM; nN = N_ / BM; nwg = nM * nN; G = G_; c = c_; }
    __device__ __forceinline__ bool next(int i, Unit& u) const {
        const long L = (long)i * G + c; if (L >= nwg) return false;
        int wgid = (int)L; { const int q = nwg / NXCD, r = nwg % NXCD, xcd = wgid % NXCD, off = wgid / NXCD; wgid = (xcd < r ? xcd * (q + 1) : r * (q + 1) + (xcd - r) * q) + off; }
        const int nig = WGM * nN, gid = wgid / nig, fm = gid * WGM, gsz = (nM - fm) < WGM ? (nM - fm) : WGM;
        u.pm = fm + ((wgid % nig) % gsz); u.pn = (wgid % nig) / gsz; return true;
    }
};
DEVI unsigned cvt_pk_bf16(float lo, float hi) { return pk2(lo, hi); }

template <class Epi>
DEVI void gemm_phase(LAS unsigned char* lds, const int tid, const Gemm g, const StaticOrder& S, const Epi& E) {
    const int wid = __builtin_amdgcn_readfirstlane(tid >> 6), lane = tid & 63, wr = wid >> 2, wc = wid & 3, fr = lane & 15, fq = lane >> 4;
    const int K = g.K, nt = K / BK, lda = g.lda;
    unsigned voffA[2], voffB[2];
#pragma unroll
    for (int i = 0; i < 2; ++i) { int R, C; stage_rc(tid * 16 + i * 8192, R, C); const int Rb = Epi::PERM ? ((R & ~31) + perm32(R & 31)) : R;
        voffA[i] = (unsigned)(R * lda + C) * 2u; voffB[i] = (unsigned)(Rb * K + C) * 2u; }
    const size_t kstep = (size_t)(BK * 2);
    const size_t hstepA = (size_t)HALF * lda * 2, hstepB = (size_t)HALF * K * 2;
    const size_t tstepA = 2 * hstepA, tstepB = 2 * hstepB;
    const unsigned ldsw = (unsigned)wid * 1024u;
    const int aoff = lds_byte(wr * 64 + fr, fq * 8), boff = lds_byte(wc * 32 + fr, fq * 8);
#define PG8_SA(b, h) (((b) * 2 + (h)) * HTB)
#define PG8_SB(b, h) ((4 + (b) * 2 + (h)) * HTB)
#define PG8_STAGE(bufoff, gbase, voff) do { _Pragma("unroll") for (int _i = 0; _i < 2; ++_i) \
        __builtin_amdgcn_global_load_lds((const unsigned*)((const char*)(gbase) + (voff)[_i]), (LAS unsigned*)(lds + (bufoff) + ldsw + _i * 8192), 16, 0, 0); } while (0)
#define PG8_LDA(dst, b, h) do { _Pragma("unroll") for (int m = 0; m < 4; ++m) _Pragma("unroll") for (int k = 0; k < 2; ++k) dst[m][k] = *(const LAS bf16x8*)(lds + PG8_SA(b, h) + aoff + m * 2048 + k * 1024); } while (0)
#define PG8_LDB(dst, b, h) do { _Pragma("unroll") for (int n = 0; n < 2; ++n) _Pragma("unroll") for (int k = 0; k < 2; ++k) dst[n][k] = *(const LAS bf16x8*)(lds + PG8_SB(b, h) + boff + n * 2048 + k * 1024); } while (0)
#define PG8_MMA(ai, bj, At, Bt) do { __builtin_amdgcn_s_setprio(1); _Pragma("unroll") for (int m = 0; m < 4; ++m) _Pragma("unroll") for (int n = 0; n < 2; ++n) _Pragma("unroll") for (int k = 0; k < 2; ++k) \
        acc[ai][bj][m][n] = __builtin_amdgcn_mfma_f32_16x16x32_bf16(Bt[n][k], At[m][k], acc[ai][bj][m][n], 0, 0, 0); __builtin_amdgcn_s_setprio(0); } while (0)
#define PG8_WAIT_V(n) asm volatile("s_waitcnt vmcnt(" #n ")" ::: "memory")
#define PG8_WAIT_L(n) asm volatile("s_waitcnt lgkmcnt(" #n ")" ::: "memory")
#define PG8_BAR __builtin_amdgcn_s_barrier()
#define PG8_SCHED __builtin_amdgcn_sched_barrier(0)
#define PG8_ABASE(u) ((const char*)(g.A + (size_t)((g.asel >> (4 * (u).pn)) & 15ull) * g.astride) + (size_t)(u).pm * tstepA)
    Unit cur, nxt; int ui = 0;
    if (!S.next(0, cur)) return;
    f32x4 acc[2][2][4][2];
#pragma unroll
    for (int a = 0; a < 2; ++a)
#pragma unroll
        for (int b = 0; b < 2; ++b)
#pragma unroll
            for (int m = 0; m < 4; ++m)
#pragma unroll
                for (int n = 0; n < 2; ++n) acc[a][b][m][n] = (f32x4){0.f, 0.f, 0.f, 0.f};
    bf16x8 At[4][2], B0[2][2], B1[2][2];
    const char* cA = PG8_ABASE(cur); const char* cB = (const char*)g.Bt + (size_t)cur.pn * tstepB;
    PG8_STAGE(PG8_SB(0, 0), cB, voffB); PG8_STAGE(PG8_SB(0, 1), cB + hstepB, voffB); PG8_STAGE(PG8_SA(0, 0), cA, voffA); PG8_STAGE(PG8_SA(0, 1), cA + hstepA, voffA);
    if (wr == 1) PG8_BAR;
    PG8_WAIT_V(2); PG8_BAR;
    PG8_STAGE(PG8_SB(1, 0), cB + kstep, voffB); PG8_STAGE(PG8_SA(1, 0), cA + kstep, voffA); PG8_STAGE(PG8_SB(1, 1), cB + hstepB + kstep, voffB);
    PG8_WAIT_V(6); PG8_BAR;
    for (;;) {
        const bool has_next = S.next(ui + 1, nxt);
        const char* nA = has_next ? PG8_ABASE(nxt) : cA; const char* nB = has_next ? (const char*)g.Bt + (size_t)nxt.pn * tstepB : cB;
        for (int t = 0; t < nt; t += 2) {
            const bool last = (t == nt - 2);
            const char* a1 = cA + (size_t)(t + 1) * kstep;
            const char* a2 = last ? nA : cA + (size_t)(t + 2) * kstep; const char* b2 = last ? nB : cB + (size_t)(t + 2) * kstep;
            const char* a3 = a2 + kstep; const char* b3 = b2 + kstep;
            PG8_LDB(B0, 0, 0); PG8_LDB(B1, 0, 1); PG8_SCHED; PG8_LDA(At, 0, 0); PG8_STAGE(PG8_SA(1, 1), a1 + hstepA, voffA);
            PG8_WAIT_V(8); PG8_WAIT_L(0); PG8_BAR; PG8_MMA(0, 0, At, B0); PG8_MMA(0, 1, At, B1); PG8_BAR; PG8_SCHED;
            PG8_LDA(At, 0, 1); PG8_STAGE(PG8_SB(0, 0), b2, voffB); PG8_STAGE(PG8_SB(0, 1), b2 + hstepB, voffB); PG8_STAGE(PG8_SA(0, 0), a2, voffA);
            PG8_WAIT_V(8); PG8_WAIT_L(0); PG8_BAR; PG8_MMA(1, 0, At, B0); PG8_MMA(1, 1, At, B1); PG8_BAR; PG8_SCHED;
            PG8_LDB(B0, 1, 0); PG8_LDB(B1, 1, 1); PG8_SCHED; PG8_LDA(At, 1, 0); PG8_STAGE(PG8_SA(0, 1), a2 + hstepA, voffA);
            PG8_WAIT_V(8); PG8_WAIT_L(0); PG8_BAR; PG8_MMA(0, 0, At, B0); PG8_MMA(0, 1, At, B1); PG8_BAR; PG8_SCHED;
            PG8_LDA(At, 1, 1); PG8_STAGE(PG8_SB(1, 0), b3, voffB); PG8_STAGE(PG8_SB(1, 1), b3 + hstepB, voffB); PG8_STAGE(PG8_SA(1, 0), a3, voffA);
            PG8_WAIT_V(8); PG8_WAIT_L(0); PG8_BAR; PG8_MMA(1, 0, At, B0); PG8_MMA(1, 1, At, B1); PG8_BAR; PG8_SCHED;
        }
        if (wr == 0) PG8_BAR;
        E(acc, cur, wr, wc, fr, fq);
        if (!has_next) break;
#pragma unroll
        for (int a = 0; a < 2; ++a)
#pragma unroll
            for (int b = 0; b < 2; ++b)
#pragma unroll
                for (int m = 0; m < 4; ++m)
#pragma unroll
                    for (int n = 0; n < 2; ++n) acc[a][b][m][n] = (f32x4){0.f, 0.f, 0.f, 0.f};
        cur = nxt; cA = nA; cB = nB; ++ui;
        if (wr == 1) PG8_BAR;
    }
    PG8_WAIT_V(0);
    PG8_BAR;
#undef PG8_SA
#undef PG8_SB
#undef PG8_STAGE
#undef PG8_LDA
#undef PG8_LDB
#undef PG8_MMA
#undef PG8_WAIT_V
#undef PG8_WAIT_L
#undef PG8_BAR
#undef PG8_SCHED
#undef PG8_ABASE
}
}

constexpr size_t WB_WIN = 0, WB_WOUT = 20 * MiB, WB_G5 = 28 * MiB, WB_G6 = 44 * MiB, WB_WO = 48 * MiB, WB_WUP = 52 * MiB, WB_WDN = 96 * MiB;
constexpr size_t SZ_WIN = 10 * MiB, SZ_WOUT = 4 * MiB, SZ_G5 = 8 * MiB, SZ_G6 = 2 * MiB, SZ_WO = 2 * MiB, SZ_WUP = 11 * MiB, SZ_WDN = (size_t)D * DFF * 2;
static_assert(WB_WDN + 4 * SZ_WDN <= 119 * MiB, "weight map");

struct WDesc { const float* W; const float* gain; bf16* dst; int ldw, Kv, Kd, Nv, Nd, map; };
DEVI WDesc wdesc(const PArgs& a, unsigned char* ws, int id) {
    WDesc w; w.gain = nullptr; w.map = 0; unsigned char* wb = ws + WS_WB;
    if (id < 2) { const int j = id; w.W = a.in[I_EWIN] + (size_t)j * D * NIN; w.ldw = NIN; w.Kv = w.Kd = D; w.Nv = w.Nd = NIN; w.gain = a.in[I_NMIX] + (size_t)(2 * j) * D; w.dst = (bf16*)(wb + WB_WIN + j * SZ_WIN); w.map = 1; }
    else if (id < 4) { const int j = id - 2; w.W = a.in[I_EWOUT] + (size_t)j * 2048 * D; w.ldw = D; w.Kv = w.Kd = 2048; w.Nv = w.Nd = D; w.dst = (bf16*)(wb + WB_WOUT + j * SZ_WOUT); }
    else if (id < 18) { const int q = id - 4, j = q / 7, p = q % 7; bf16* base = (bf16*)(wb + WB_G5 + j * SZ_G5); w.Kv = w.Kd = D;
        if (p < 3) { w.W = a.in[p == 0 ? I_OWR : (p == 1 ? I_OWK : I_OWV)] + (size_t)j * D * D; w.ldw = D; w.Nv = w.Nd = D; w.dst = base + (size_t)p * 1024 * D; }
        else if (p == 3) { w.W = a.in[I_OG1] + (size_t)j * D * 128; w.ldw = 128; w.Nv = 128; w.Nd = 256; w.dst = base + (size_t)3072 * D; }
        else if (p == 4) { w.W = a.in[I_OW1] + (size_t)j * D * 64; w.ldw = 64; w.Nv = 64; w.Nd = 256; w.dst = base + (size_t)3328 * D; }
        else if (p == 5) { w.W = a.in[I_OA1] + (size_t)j * D * 64; w.ldw = 64; w.Nv = 64; w.Nd = 256; w.dst = base + (size_t)3584 * D; }
        else { w.W = a.in[I_OV1]; w.ldw = 32; w.Nv = 32; w.Nd = j == 1 ? 256 : 0; w.dst = base + (size_t)3840 * D; } }
    else if (id < 26) { const int q = id - 18, j = q >> 2, p = q & 3; bf16* base = (bf16*)(wb + WB_G6 + j * SZ_G6); w.Kd = 256; w.ldw = D; w.Nv = w.Nd = D; w.dst = base + (size_t)p * 1024 * 256;
        if (p == 0) { w.W = a.in[I_OW2] + (size_t)j * 64 * D; w.Kv = 64; }
        else if (p == 1) { w.W = a.in[I_OA2] + (size_t)j * 64 * D; w.Kv = 64; }
        else if (p == 2) { w.W = a.in[I_OG2] + (size_t)j * 128 * D; w.Kv = 128; }
        else { w.W = a.in[I_OV2]; w.Kv = 32; if (j == 0) w.Nd = 0; } }
    else if (id < 28) { const int j = id - 26; w.W = a.in[I_OWO] + (size_t)j * D * D; w.ldw = D; w.Kv = w.Kd = D; w.Nv = w.Nd = D; w.dst = (bf16*)(wb + WB_WO + j * SZ_WO); }
    else if (id < 32) { const int li = id - 28; w.W = a.in[I_FWUP] + (size_t)li * D * NUP; w.ldw = NUP; w.Kv = w.Kd = D; w.Nv = w.Nd = NUP; w.gain = a.in[I_NFFN] + (size_t)li * D; w.dst = (bf16*)(wb + WB_WUP + li * SZ_WUP); w.map = FUSE_ACT ? 2 : 0; }
    else { const int li = id - 32; w.W = a.in[I_FWDN] + (size_t)li * DFF * D; w.ldw = D; w.Kv = w.Kd = DFF; w.Nv = w.Nd = D; w.dst = (bf16*)(wb + WB_WDN + li * SZ_WDN); }
    return w;
}
constexpr int N_WDESC = 36;
DEVI void wprep_item(const WDesc& w, LAS float* scr, int item, int lane) {
    const int nblk = w.Nd / 32, kb = item / nblk, nb = item % nblk, k0 = 64 * kb, n0 = 32 * nb;
    int sc0 = n0;
    if (w.map == 1 && n0 < 1024) { const int t = n0 >> 8, cp = n0 & 255; sc0 = 256 * t + ((cp & 127) >> 6) * 128 + (cp >> 7) * 64 + (cp & 63); }
    if (w.map == 2) { const int t = n0 >> 8, cp = n0 & 255; sc0 = cp < 128 ? 128 * t + cp : DFF + 128 * t + (cp - 128); }
    const bool nvalid = n0 < w.Nv;
#pragma unroll
    for (int i = 0; i < 8; ++i) { const int kk = 8 * i + (lane >> 3), k = k0 + kk; f32x4 v = (f32x4){0.f, 0.f, 0.f, 0.f};
        if (nvalid && k < w.Kv) { v = __builtin_nontemporal_load((const f32x4*)(w.W + (size_t)k * w.ldw + sc0 + 4 * (lane & 7))); if (w.gain) v = v * w.gain[k]; }
        LAS float* d = scr + kk * 33 + 4 * (lane & 7); d[0] = v.x; d[1] = v.y; d[2] = v.z; d[3] = v.w; }
    asm volatile("s_waitcnt lgkmcnt(0)" ::: "memory");
    const int cc = lane & 7;
#pragma unroll
    for (int jx = 0; jx < 4; ++jx) { const int n = (lane >> 3) + 8 * jx; const LAS float* s = scr + (8 * cc) * 33 + n;
        u32x4 o; o.x = pk2(s[0 * 33], s[1 * 33]); o.y = pk2(s[2 * 33], s[3 * 33]); o.z = pk2(s[4 * 33], s[5 * 33]); o.w = pk2(s[6 * 33], s[7 * 33]);
        *(u32x4*)(w.dst + (size_t)(n0 + n) * w.Kd + k0 + 8 * cc) = o; }
    asm volatile("s_waitcnt lgkmcnt(0)" ::: "memory");
}
DEVI void f_wprep(const Ctx& c, const PArgs& a, unsigned long long idmask, int gw, int NGW) {
    LAS float* scr = (LAS float*)(c.lds + c.wave * 16384);
#pragma unroll 1
    for (int id = 0; id < N_WDESC; ++id) {
        if (!((idmask >> id) & 1ull)) continue;
        const WDesc w = wdesc(a, c.ws, id);
        const int nitems = (w.Kd / 64) * (w.Nd / 32);
        const int start = (gw + id * 601) % NGW;
        for (int it = start; it < nitems; it += NGW) wprep_item(w, scr, it, c.lane);
    }
}
constexpr unsigned long long WM_L01 = (1ull << 1) | (1ull << 2) | (0x7full << 4) | (0xfull << 18) | (1ull << 26) | (3ull << 28) | (3ull << 32);
constexpr unsigned long long WM_L23 = (1ull << 3) | (0x7full << 11) | (0xfull << 22) | (1ull << 27) | (3ull << 30) | (3ull << 34);
static_assert((WM_L01 | WM_L23 | 1ull) == (1ull << 36) - 1 && (WM_L01 & WM_L23) == 0, "weight masks");

DEVI u32x4 pack8(const f32x4 a, const f32x4 b) { u32x4 w; w.x = pg8::cvt_pk_bf16(a[0], a[1]); w.y = pg8::cvt_pk_bf16(a[2], a[3]); w.z = pg8::cvt_pk_bf16(b[0], b[1]); w.w = pg8::cvt_pk_bf16(b[2], b[3]); return w; }
DEVI f32x4 map4(const f32x4 v, int act) {
    f32x4 o;
#pragma unroll
    for (int e = 0; e < 4; ++e) o[e] = act == 1 ? siluf_(v[e]) : act == 2 ? geluf_(v[e]) : act == 3 ? sigmoidf_(v[e]) : act == 4 ? tanhf_(v[e]) : v[e];
    return o;
}
struct EpiEvenIn {
    static constexpr bool PERM = true;
    bf16* Z; const float* RS; const float* ROPE;
    DEVI void operator()(const f32x4 (&acc)[2][2][4][2], const pg8::Unit& u, int wr, int wc, int fr, int fq) const {
        const int pn = u.pn;
        float rsv[2][4];
        { f32x4 rq[2][4];
#pragma unroll
          for (int ai = 0; ai < 2; ++ai)
#pragma unroll
            for (int m = 0; m < 4; ++m) rq[ai][m] = *(const f32x4*)(RS + (size_t)(u.pm * 256 + ai * 128 + wr * 64 + m * 16 + fr) * 16 + 4 * fq);
          asm volatile("" ::: "memory");
#pragma unroll
          for (int ai = 0; ai < 2; ++ai)
#pragma unroll
            for (int m = 0; m < 4; ++m) rsv[ai][m] = row_rstd_fin(rq[ai][m]); }
#pragma unroll
        for (int ai = 0; ai < 2; ++ai)
#pragma unroll
            for (int m = 0; m < 4; ++m) {
                const int row = u.pm * 256 + ai * 128 + wr * 64 + m * 16 + fr; const float rs = rsv[ai][m];
                if (pn < 4) {
                    const int hl = wc >> 1, d0 = (32 * wc + 8 * fq) & 63; const float sc = (pn >= 2 ? 0.08838834764831845f : 1.f) * rs;
                    const f32x4* rp = (const f32x4*)(ROPE + ((size_t)row_pos(row) * 64 + d0) * 2);
                    const f32x4 c0 = rp[0], c1 = rp[1], c2 = rp[2], c3 = rp[3];
                    const f32x4 x1a = acc[ai][0][m][0] * sc, x1b = acc[ai][0][m][1] * sc, x2a = acc[ai][1][m][0] * sc, x2b = acc[ai][1][m][1] * sc;
                    const f32x4 csa = (f32x4){c0[0], c0[2], c1[0], c1[2]}, sna = (f32x4){c0[1], c0[3], c1[1], c1[3]}, csb = (f32x4){c2[0], c2[2], c3[0], c3[2]}, snb = (f32x4){c2[1], c2[3], c3[1], c3[3]};
                    const f32x4 y1a = x1a * csa - x2a * sna, y1b = x1b * csb - x2b * snb, y2a = x1a * sna + x2a * csa, y2b = x1b * snb + x2b * csb;
                    bf16* dst = Z + (size_t)row * NIN + pn * 256 + hl * 128 + d0;
                    *(u32x4*)dst = pack8(y1a, y1b); *(u32x4*)(dst + 64) = pack8(y2a, y2b);
                } else {
                    const int act = (pn >= 8 && pn < 12) ? 1 : (pn >= 16 ? 2 : 0);
#pragma unroll
                    for (int bj = 0; bj < 2; ++bj) { bf16* dst = Z + (size_t)row * NIN + pn * 256 + bj * 128 + wc * 32 + fq * 8;
                        *(u32x4*)dst = pack8(map4(acc[ai][bj][m][0] * rs, act), map4(acc[ai][bj][m][1] * rs, act)); }
                }
            }
    }
};
struct EpiResidual {
    static constexpr bool PERM = false;
    bf16* XB; float* RS;
    DEVI void operator()(const f32x4 (&acc)[2][2][4][2], const pg8::Unit& u, int wr, int wc, int fr, int fq) const {
#pragma unroll
        for (int ai = 0; ai < 2; ++ai) {
            u32x2 xo[4][2][2];
#pragma unroll
            for (int m = 0; m < 4; ++m)
#pragma unroll
                for (int bj = 0; bj < 2; ++bj)
#pragma unroll
                    for (int n = 0; n < 2; ++n) xo[m][bj][n] = *(const u32x2*)(XB + (size_t)(u.pm * 256 + ai * 128 + wr * 64 + m * 16 + fr) * D + u.pn * 256 + bj * 128 + wc * 32 + n * 16 + fq * 4);
            asm volatile("" ::: "memory");
#pragma unroll
            for (int m = 0; m < 4; ++m) {
                const int row = u.pm * 256 + ai * 128 + wr * 64 + m * 16 + fr; float ss = 0.f;
#pragma unroll
                for (int bj = 0; bj < 2; ++bj)
#pragma unroll
                    for (int n = 0; n < 2; ++n) { const size_t o = (size_t)row * D + u.pn * 256 + bj * 128 + wc * 32 + n * 16 + fq * 4;
                        const u32x2 x_ = xo[m][bj][n];
                        f32x4 v = acc[ai][bj][m][n]; v[0] += __uint_as_float(x_.x << 16); v[1] += __uint_as_float(x_.x & 0xffff0000u); v[2] += __uint_as_float(x_.y << 16); v[3] += __uint_as_float(x_.y & 0xffff0000u);
                        u32x2 w; w.x = pk2(v[0], v[1]); w.y = pk2(v[2], v[3]); *(u32x2*)(XB + o) = w;
                        ss += (v[0] * v[0] + v[1] * v[1]) + (v[2] * v[2] + v[3] * v[3]); }
                ss += __shfl_xor(ss, 16); ss += __shfl_xor(ss, 32);
                if (fq == 0) RS[(size_t)row * 16 + u.pn * 4 + wc] = ss;
            }
        }
    }
};
struct EpiUp {
    static constexpr bool PERM = true;
    bf16* U; const float* RS;
    DEVI void operator()(const f32x4 (&acc)[2][2][4][2], const pg8::Unit& u, int wr, int wc, int fr, int fq) const {
#pragma unroll
        for (int ai = 0; ai < 2; ++ai)
#pragma unroll
            for (int m = 0; m < 4; ++m) {
                const int row = u.pm * 256 + ai * 128 + wr * 64 + m * 16 + fr; const float rs = row_rstd(RS, row);
#pragma unroll
                for (int bj = 0; bj < 2; ++bj) *(u32x4*)(U + (size_t)row * NUP + u.pn * 256 + bj * 128 + wc * 32 + fq * 8) = pack8(acc[ai][bj][m][0] * rs, acc[ai][bj][m][1] * rs);
            }
    }
};
struct EpiOddIn {
    static constexpr bool PERM = true;
    bf16 *R, *Kb, *Vb, *LM; int j;
    DEVI void operator()(const f32x4 (&acc)[2][2][4][2], const pg8::Unit& u, int wr, int wc, int fr, int fq) const {
        const int pn = u.pn; bf16* base; int pitch, off; float al, be, ga; bool ident, both;
        bf16 *r_ = R, *k_ = Kb, *v_ = Vb, *l_ = LM; asm volatile("" : "+s"(r_), "+s"(k_), "+s"(v_), "+s"(l_));
        if (pn < 12) { base = pn < 4 ? r_ : (pn < 8 ? k_ : v_); pitch = D; off = (pn & 3) * 256; ident = true; both = true; al = 1.f; be = 1.f; ga = 0.f; }
        else { base = l_; pitch = LML; off = pn == 12 ? 0 : (pn == 13 ? 256 : (pn == 14 ? 384 : 128)); ident = pn >= 14; both = pn == 14 || (pn == 12 && j == 0);
               al = pn == 13 ? 2.f : 1.f; be = al; ga = pn == 13 ? -1.f : 0.f; }
        bf16* p0 = base + off + wc * 32 + fq * 8;
#pragma unroll
        for (int ai = 0; ai < 2; ++ai)
#pragma unroll
            for (int m = 0; m < 4; ++m) {
                const int row = u.pm * 256 + ai * 128 + wr * 64 + m * 16 + fr;
#pragma unroll
                for (int bj = 0; bj < 2; ++bj) {
                    f32x4 v0 = acc[ai][bj][m][0], v1 = acc[ai][bj][m][1];
                    if (!ident) {
#pragma unroll
                        for (int e = 0; e < 4; ++e) { v0[e] = al * __builtin_amdgcn_rcpf(1.f + __expf(-be * v0[e])) + ga; v1[e] = al * __builtin_amdgcn_rcpf(1.f + __expf(-be * v1[e])) + ga; } }
                    if (bj == 0 || both) *(u32x4*)(p0 + (size_t)row * pitch + bj * 128) = pack8(v0, v1); }
            }
    }
};
struct EpiDecay {
    static constexpr bool PERM = true;
    float* WD; const float* w0;
    DEVI void operator()(const f32x4 (&acc)[2][2][4][2], const pg8::Unit& u, int wr, int wc, int fr, int fq) const {
        const int cb = u.pn * 256 + wc * 32 + fq * 8;
#pragma unroll
        for (int bj = 0; bj < 2; ++bj) {
            const f32x4 bia0 = *(const f32x4*)(w0 + cb + bj * 128), bia1 = *(const f32x4*)(w0 + cb + bj * 128 + 4);
#pragma unroll
            for (int ai = 0; ai < 2; ++ai)
#pragma unroll
                for (int m = 0; m < 4; ++m) {
                    const int row = u.pm * 256 + ai * 128 + wr * 64 + m * 16 + fr; const size_t o = (size_t)row * D + cb + bj * 128;
                    f32x4 v0_ = acc[ai][bj][m][0] + bia0, v1_ = acc[ai][bj][m][1] + bia1;
#pragma unroll
                    for (int e = 0; e < 4; ++e) { v0_[e] = __expf(-0.6065306597126334f * __builtin_amdgcn_rcpf(1.f + __expf(-v0_[e]))); v1_[e] = __expf(-0.6065306597126334f * __builtin_amdgcn_rcpf(1.f + __expf(-v1_[e]))); }
                    *(f32x4*)(WD + o) = v0_; *(f32x4*)(WD + o + 4) = v1_;
                }
        }
    }
};
struct EpiGate {
    static constexpr bool PERM = true;
    bf16* AG; const float *a0, *v0;
    DEVI void operator()(const f32x4 (&acc)[2][2][4][2], const pg8::Unit& u, int wr, int wc, int fr, int fq) const {
        const int grp = u.pn >> 2; const int cb = (u.pn & 3) * 256 + wc * 32 + fq * 8;
        const float* bp = grp == 2 ? v0 : a0; const float bsc = grp == 1 ? 0.f : 1.f;
        bf16* ob = AG + (size_t)grp * M * D;
#pragma unroll
        for (int bj = 0; bj < 2; ++bj) {
            const f32x4 bia0 = *(const f32x4*)(bp + cb + bj * 128) * bsc, bia1 = *(const f32x4*)(bp + cb + bj * 128 + 4) * bsc;
#pragma unroll
            for (int ai = 0; ai < 2; ++ai)
#pragma unroll
                for (int m = 0; m < 4; ++m) {
                    const int row = u.pm * 256 + ai * 128 + wr * 64 + m * 16 + fr; const size_t o = (size_t)row * D + cb + bj * 128;
                    f32x4 v0_ = acc[ai][bj][m][0] + bia0, v1_ = acc[ai][bj][m][1] + bia1;
                    if (grp != 1) {
#pragma unroll
                        for (int e = 0; e < 4; ++e) { v0_[e] = __builtin_amdgcn_rcpf(1.f + __expf(-v0_[e])); v1_[e] = __builtin_amdgcn_rcpf(1.f + __expf(-v1_[e])); } }
                    *(u32x4*)(ob + o) = pack8(v0_, v1_);
                }
        }
    }
};

DEVI void f_even_in(const Ctx& c, int li) {
    const int j = li >> 1;
    pg8::Gemm g{(const bf16*)(c.ws + WS_XB), (const bf16*)(c.ws + WS_WB + WB_WIN + j * SZ_WIN), M, NIN, D, D, 0ull, 0};
    pg8::StaticOrder S; S.init(M, NIN, c.G, c.bid);
    EpiEvenIn E{(bf16*)(c.ws + WS_Z), (const float*)(c.ws + WS_RS), (const float*)(c.ws + WS_ROPE)};
    pg8::gemm_phase<EpiEvenIn>(c.lds, c.tid, g, S, E);
}
DEVI void f_gemm_residual(const Ctx& c, const bf16* A, int lda, const bf16* Bt, int K, bool wxb) {
    pg8::Gemm g{A, Bt, M_MAIN, D, K, lda, 0ull, 0};
    pg8::StaticOrder S; S.init(M_MAIN, D, c.G, c.bid);
    (void)wxb; EpiResidual E{(bf16*)(c.ws + WS_XB), (float*)(c.ws + WS_RS)};
    pg8::gemm_phase<EpiResidual>(c.lds, c.tid, g, S, E);
}
DEVI void f_ffn_up(const Ctx& c, int li) {
    pg8::Gemm g{(const bf16*)(c.ws + WS_XB), (const bf16*)(c.ws + WS_WB + WB_WUP + li * SZ_WUP), M, NUP, D, D, 0ull, 0};
    pg8::StaticOrder S; S.init(M, NUP, c.G, c.bid);
    EpiUp E{(bf16*)(c.ws + WS_U), (const float*)(c.ws + WS_RS)};
    pg8::gemm_phase<EpiUp>(c.lds, c.tid, g, S, E);
}
DEVI void f_odd_in(const Ctx& c, int li) {
    const int j = li >> 1, N5 = j == 0 ? 3840 : 4096;
    pg8::Gemm g{(const bf16*)(c.ws + WS_XMIX), (const bf16*)(c.ws + WS_WB + WB_G5 + j * SZ_G5), M, N5, D, D, 0x3415333322220000ull, (size_t)M * D};
    pg8::StaticOrder S; S.init(M, N5, c.G, c.bid);
    EpiOddIn E{(bf16*)(c.ws + WS_R), (bf16*)(c.ws + WS_K), j == 0 ? (bf16*)((unsigned char*)c.out + DO_VFIRST) : (bf16*)(c.ws + WS_V), (bf16*)((unsigned char*)c.out + DO_LMID), j};
    pg8::gemm_phase<EpiOddIn>(c.lds, c.tid, g, S, E);
}
DEVI void f_odd_lora(const Ctx& c, const PArgs& a, int li) {
    const int j = li >> 1;
    const bf16* LM = (const bf16*)((unsigned char*)c.out + DO_LMID); const bf16* W6 = (const bf16*)(c.ws + WS_WB + WB_G6 + j * SZ_G6);
    int K6 = 256; asm volatile("" : "+s"(K6));
    {
        pg8::Gemm g{LM + 256, W6, M, D, K6, LML, 0ull, 0};
        pg8::StaticOrder S; S.init(M, D, c.G, c.bid);
        EpiDecay E{(float*)(c.ws + WS_WDEC), a.in[I_OW0] + (size_t)j * D};
        pg8::gemm_phase<EpiDecay>(c.lds, c.tid, g, S, E);
    }
    {
        const int N6 = j == 0 ? 2048 : 3072;
        pg8::Gemm g{LM, W6 + (size_t)1024 * 256, M, N6, K6, LML, 0x111100003333ull, 128};
        int c2 = c.bid + (c.G >> 1); if (c2 >= c.G) c2 -= c.G;
        pg8::StaticOrder S; S.init(M, N6, c.G, c2);
        EpiGate E{(bf16*)(c.ws + WS_AG), a.in[I_OA0] + (size_t)j * D, a.in[I_OV0]};
        pg8::gemm_phase<EpiGate>(c.lds, c.tid, g, S, E);
    }
}

typedef short bf16x8_t __attribute__((ext_vector_type(8)));
constexpr int LRU_XS = 0, LRU_AI = 33792, LRU_GT = LRU_AI + 128 * 136 * 2, LRU_END = LRU_GT + 128 * 256;
static_assert(LRU_END + 8 * 1024 <= RING_BYTES, "lru lds");
#define LWAIT_() asm volatile("s_waitcnt lgkmcnt(0)" ::: "memory")
#define LDS_BAR() asm volatile("s_waitcnt lgkmcnt(0)\n\ts_barrier" ::: "memory")
DEVI void f_lru_unit(const Ctx& c, const PArgs& a, int j, int g, bool sample, int b) {
    const bf16* Z = (const bf16*)(c.ws + WS_Z); bf16* MIX = (bf16*)(c.ws + WS_MIX);
    LAS unsigned char* XS = c.lds + LRU_XS; LAS unsigned char* AI = c.lds + LRU_AI; LAS unsigned char* GT = c.lds + LRU_GT;
    const int w = c.wave, fr = c.lane & 15, fq = c.lane >> 4, col = 16 * w + fr, ch = g * 128 + col;
    const int row0 = sample ? MP : b * TP, ntok = sample ? 128 : TP, nchunks = sample ? 1 : (TP + 127) / 128;
    bf16x8_t Bw[2][4];
#pragma unroll
    for (int gate = 0; gate < 2; ++gate) {
        const float* Wg = a.in[gate == 0 ? I_EWA : I_EWX] + (size_t)(j * 8 + g) * 128 * 128;
        __syncthreads();
#pragma unroll 2
        for (int i = 0; i < 8; ++i) { const unsigned p = (unsigned)(i * NT + c.tid); *(LAS f32x4*)(c.lds + p * 16u) = *(const f32x4*)(Wg + p * 4u); }
        __syncthreads();
#pragma unroll
        for (int ks = 0; ks < 4; ++ks) { bf16x8_t vv;
#pragma unroll
            for (int jj = 0; jj < 8; ++jj) vv[jj] = (short)f2bf(*(const LAS float*)(c.lds + ((32 * ks + 8 * fq + jj) * 128 + col) * 4));
            Bw[gate][ks] = vv; }
    }
    const float ba = a.in[I_EBA][(size_t)j * 1024 + ch], bx = a.in[I_EBX][(size_t)j * 1024 + ch], sp8 = 8.f * softplusf_(-a.in[I_ELAM][(size_t)j * 1024 + ch]);
    const int cc = c.tid & 127, rq = c.tid >> 7, cch = g * 128 + cc;
    const float* CW = a.in[I_ECW] + (size_t)j * 4 * 1024;
    const float cw0 = CW[cch], cw1 = CW[1024 + cch], cw2 = CW[2048 + cch], cw3 = CW[3072 + cch], cb = a.in[I_ECB][(size_t)j * 1024 + cch];
    float carry = 0.f;
    u32x4 pfx[5], pfg[4];
    const bf16* zx = Z + (size_t)row0 * NIN + 3072 + g * 128; const bf16* zg = Z + (size_t)row0 * NIN + 4096 + g * 128;
#define LRU_PREFETCH(t0) do { _Pragma("unroll") for (int i = 0; i < 5; ++i) { const int p = i * NT + c.tid, r = p >> 4, q = p & 15; const int t = (t0) - 3 + r; \
            pfx[i] = (u32x4){0u, 0u, 0u, 0u}; if (r < 131 && t >= 0) pfx[i] = *(const u32x4*)(zx + (unsigned)(t * NIN + q * 8)); } \
        _Pragma("unroll") for (int i = 0; i < 4; ++i) { const int p = i * NT + c.tid, r = p >> 4, q = p & 15; pfg[i] = *(const u32x4*)(zg + (unsigned)(((t0) + r) * NIN + q * 8)); } } while (0)
    LRU_PREFETCH(0);
    for (int ci = 0; ci < nchunks; ++ci) {
        const int t0 = ci * 128, nv = (ntok - t0) < 128 ? (ntok - t0) : 128;
        __syncthreads();
#pragma unroll
        for (int i = 0; i < 5; ++i) { const int p = i * NT + c.tid; if (p < 131 * 16) *(LAS u32x4*)(XS + p * 16) = pfx[i]; }
#pragma unroll
        for (int i = 0; i < 4; ++i) { const int p = i * NT + c.tid; *(LAS u32x4*)(GT + p * 16) = pfg[i]; }
        __syncthreads();
        if (ci + 1 < nchunks) LRU_PREFETCH(t0 + 128);
        if (!sample) {
            float x0 = bf2f(*(const LAS bf16*)(XS + ((rq * 32 + 0) * 128 + cc) * 2)), x1 = bf2f(*(const LAS bf16*)(XS + ((rq * 32 + 1) * 128 + cc) * 2)), x2 = bf2f(*(const LAS bf16*)(XS + ((rq * 32 + 2) * 128 + cc) * 2));
#pragma unroll 8
            for (int i = 0; i < 32; ++i) { const int lr = rq * 32 + i; const float x3 = bf2f(*(const LAS bf16*)(XS + ((lr + 3) * 128 + cc) * 2));
                *(LAS bf16*)(AI + (lr * 136 + cc) * 2) = f2bf(cb + cw3 * x3 + cw2 * x2 + cw1 * x1 + cw0 * x0); x0 = x1; x1 = x2; x2 = x3; }
        } else {
            const float* SC = a.in[I_SLCONV] + (size_t)j * BS * 3 * 1024 + cch; float* SCO = c.out + O_LCONVS + (size_t)j * BS * 3 * 1024 + cch;
#pragma unroll 2
            for (int i = 0; i < 32; ++i) { const int lr = rq * 32 + i; const unsigned so = (unsigned)(lr * 3 * 1024);
                const float h0 = SC[so], h1 = SC[so + 1024u], h2 = SC[so + 2048u], x3 = bf2f(*(const LAS bf16*)(XS + ((lr + 3) * 128 + cc) * 2));
                *(LAS bf16*)(AI + (lr * 136 + cc) * 2) = f2bf(cb + cw3 * x3 + cw2 * h2 + cw1 * h1 + cw0 * h0);
                SCO[so] = h1; SCO[so + 1024u] = h2; SCO[so + 2048u] = x3; }
        }
        __syncthreads();
#pragma unroll 1
        for (int m = 0; m < 8; ++m) {
            f32x4 accr_ = (f32x4){0.f, 0.f, 0.f, 0.f}, acci_ = (f32x4){0.f, 0.f, 0.f, 0.f};
#pragma unroll
            for (int ks = 0; ks < 4; ++ks) { const bf16x8_t af = *(const LAS bf16x8_t*)(AI + ((16 * m + fr) * 136 + 32 * ks + 8 * fq) * 2);
                accr_ = __builtin_amdgcn_mfma_f32_16x16x32_bf16(af, Bw[0][ks], accr_, 0, 0, 0);
                acci_ = __builtin_amdgcn_mfma_f32_16x16x32_bf16(af, Bw[1][ks], acci_, 0, 0, 0); }
            float av[4], uv[4];
#pragma unroll
            for (int r = 0; r < 4; ++r) { const int lr = 16 * m + 4 * fq + r;
                const float xcv = bf2f(*(const LAS bf16*)(AI + (lr * 136 + col) * 2));
                const float rg = sigmoidf_(accr_[r] + ba), ig = sigmoidf_(acci_[r] + bx);
                const float la = -sp8 * rg, t2 = 2.f * la;
                const float em1 = t2 > -0.02f ? t2 * (1.f + t2 * (0.5f + t2 * 0.16666667f)) : __expf(t2) - 1.f;
                av[r] = __expf(la); uv[r] = sqrtf(-em1) * (ig * xcv); }
            float hv[4];
            if (!sample) {
                const float Ai = av[0] * av[1] * av[2] * av[3], Ui = ((uv[0] * av[1] + uv[1]) * av[2] + uv[2]) * av[3] + uv[3];
                LAS f32x2_t* cs = (LAS f32x2_t*)(c.lds + LRU_END + w * 1024 + (m & 1) * 512);
                cs[fq * 16 + fr] = (f32x2_t){Ai, Ui};
                LWAIT_();
                const f32x2_t c0 = cs[fr], c1 = cs[16 + fr], c2 = cs[32 + fr], c3 = cs[48 + fr];
                const float h0e = c0.x * carry + c0.y, h1e = c1.x * h0e + c1.y, h2e = c2.x * h1e + c2.y, h3e = c3.x * h2e + c3.y;
                const float hin = fq == 0 ? carry : (fq == 1 ? h0e : (fq == 2 ? h1e : h2e));
                carry = h3e;
                hv[0] = av[0] * hin + uv[0]; hv[1] = av[1] * hv[0] + uv[1]; hv[2] = av[2] * hv[1] + uv[2]; hv[3] = av[3] * hv[2] + uv[3];
                if (nv < 128 && m == ((TP % 128) - 1) / 16 && fq == (((TP % 128) - 1) & 15) / 4) c.out[O_LRUP + (size_t)(j * BP + b) * 1024 + ch] = hv[((TP % 128) - 1) & 3];
            } else {
#pragma unroll
                for (int r = 0; r < 4; ++r) { const int lr = 16 * m + 4 * fq + r; const unsigned so = (unsigned)(lr * 1024);
                    hv[r] = av[r] * (a.in[I_SLRU] + (size_t)j * BS * 1024 + ch)[so] + uv[r]; (c.out + O_LRUS + (size_t)j * BS * 1024 + ch)[so] = hv[r]; }
            }
#pragma unroll
            for (int r = 0; r < 4; ++r) { const int lr = 16 * m + 4 * fq + r; LAS bf16* gp = (LAS bf16*)(GT + (lr * 128 + col) * 2); *gp = f2bf(hv[r] * bf2f(*gp)); }
        }
        if (!sample && nv < 128 && c.tid < 128) {
#pragma unroll
            for (int k = 0; k < 3; ++k) c.out[O_LCONVP + ((size_t)(j * BP + b) * 3 + k) * 1024 + g * 128 + c.tid] = bf2f(*(const LAS bf16*)(XS + ((nv + k) * 128 + c.tid) * 2));
        }
        __syncthreads();
#pragma unroll
        for (int i = 0; i < 4; ++i) { const int p = i * NT + c.tid, r = p >> 4, q = p & 15;
            if (r < nv) *(u32x4*)(MIX + (size_t)(row0 + t0 + r) * 2048 + 1024 + g * 128 + q * 8) = *(const LAS u32x4*)(GT + p * 16); }
    }
#undef LRU_PREFETCH
    __syncthreads();
}

#define DPP_F(v, ctrl) __builtin_bit_cast(float, __builtin_amdgcn_update_dpp(0, __builtin_bit_cast(int, (v)), (ctrl), 0xF, 0xF, true))
DEVI float red8(float x) { x += DPP_F(x, 0xB1); x += DPP_F(x, 0x4E); x += DPP_F(x, 0x141); return x; }
DEVI float red32(float x) { x += DPP_F(x, 0xB1); x += DPP_F(x, 0x4E); x += DPP_F(x, 0x141); x += DPP_F(x, 0x140); x += __shfl_xor(x, 16); return x; }
typedef unsigned long long u64x2_t __attribute__((ext_vector_type(2)));
DEVI void tr_frag2(unsigned tile, int pitch, int krow0, int col0, int fr, int fq, bf16x8_t& f0, bf16x8_t& f1) {
    const unsigned base = tile + (unsigned)((krow0 + 8 * fq + (fr >> 2)) * pitch + (col0 + 4 * (fr & 3)) * 2);
    unsigned long long a0, a1, b0, b1;
    asm volatile("ds_read_b64_tr_b16 %0, %4\n\tds_read_b64_tr_b16 %1, %5\n\tds_read_b64_tr_b16 %2, %6\n\tds_read_b64_tr_b16 %3, %7\n\ts_waitcnt lgkmcnt(0)"
                 : "=&v"(a0), "=&v"(a1), "=&v"(b0), "=&v"(b1) : "v"(base), "v"(base + 4u * (unsigned)pitch), "v"(base + 32u * (unsigned)pitch), "v"(base + 36u * (unsigned)pitch) : "memory");
    u64x2_t v0; v0.x = a0; v0.y = a1; u64x2_t v1; v1.x = b0; v1.y = b1;
    f0 = __builtin_bit_cast(bf16x8_t, v0); f1 = __builtin_bit_cast(bf16x8_t, v1);
}
DEVI void tr_frag4(unsigned tile, int pitch, int col0, int col1, int fr, int fq, bf16x8_t& f00, bf16x8_t& f01, bf16x8_t& f10, bf16x8_t& f11) {
    const unsigned b0 = tile + (unsigned)((8 * fq + (fr >> 2)) * pitch + (col0 + 4 * (fr & 3)) * 2), b1 = b0 + (unsigned)((col1 - col0) * 2);
    unsigned long long a0, a1, a2, a3, c0, c1, c2, c3;
    asm volatile("ds_read_b64_tr_b16 %0, %8\n\tds_read_b64_tr_b16 %1, %9\n\tds_read_b64_tr_b16 %2, %10\n\tds_read_b64_tr_b16 %3, %11\n\t"
                 "ds_read_b64_tr_b16 %4, %12\n\tds_read_b64_tr_b16 %5, %13\n\tds_read_b64_tr_b16 %6, %14\n\tds_read_b64_tr_b16 %7, %15\n\ts_waitcnt lgkmcnt(0)"
                 : "=&v"(a0), "=&v"(a1), "=&v"(a2), "=&v"(a3), "=&v"(c0), "=&v"(c1), "=&v"(c2), "=&v"(c3)
                 : "v"(b0), "v"(b0 + 4u * (unsigned)pitch), "v"(b0 + 32u * (unsigned)pitch), "v"(b0 + 36u * (unsigned)pitch), "v"(b1), "v"(b1 + 4u * (unsigned)pitch), "v"(b1 + 32u * (unsigned)pitch), "v"(b1 + 36u * (unsigned)pitch) : "memory");
    u64x2_t v; v.x = a0; v.y = a1; f00 = __builtin_bit_cast(bf16x8_t, v); v.x = a2; v.y = a3; f01 = __builtin_bit_cast(bf16x8_t, v);
    v.x = c0; v.y = c1; f10 = __builtin_bit_cast(bf16x8_t, v); v.x = c2; v.y = c3; f11 = __builtin_bit_cast(bf16x8_t, v);
}
constexpr int RC = 64;
constexpr int RT_QS = 0, RT_KS = RT_QS + RC * 272, RT_KD = RT_KS + RC * 272, RT_VS = RT_KD + RC * 272, RT_PS = RT_VS + RC * 528, RT_OT = RT_PS + RC * 144, RT_END = RT_OT + RC * 528;
static_assert(RT_END <= RING_BYTES, "ret lds");
DEVI void f_ret_prompt(const Ctx& c, const PArgs& a, int j, int b, int hd) {
    const bf16* Z = (const bf16*)(c.ws + WS_Z); bf16* MIX = (bf16*)(c.ws + WS_MIX);
    const unsigned L0 = (unsigned)(size_t)c.lds;
    LAS unsigned char* QS = c.lds + RT_QS; LAS unsigned char* KS = c.lds + RT_KS; LAS unsigned char* KD = c.lds + RT_KD; LAS unsigned char* VS = c.lds + RT_VS; LAS unsigned char* PS = c.lds + RT_PS;
    const int w = c.wave;
    const float l2g0 = log2f(1.f - exp2f(-5.f - (float)hd));
    const bf16* zb = Z + (size_t)(b * TP) * NIN; const int qcol = hd * 128, kcol = 512 + hd * 128, vcol = 1024 + hd * 256;
    const float* gn = a.in[I_ERGN] + (size_t)j * 1024 + hd * 256;
    f32x4 Sacc[8][2];
#pragma unroll
    for (int db = 0; db < 8; ++db) { Sacc[db][0] = (f32x4){0.f, 0.f, 0.f, 0.f}; Sacc[db][1] = (f32x4){0.f, 0.f, 0.f, 0.f}; }
    u32x4 pf[8];
#define RET_PREFETCH(t0) do { _Pragma("unroll") for (int i = 0; i < 8; ++i) { int r, col; \
            if (i < 4) { const int p = (i & 1) * NT + c.tid; r = p >> 4; col = (i < 2 ? qcol : kcol) + (p & 15) * 8; } else { const int p = (i - 4) * NT + c.tid; r = p >> 5; col = vcol + (p & 31) * 8; } \
            pf[i] = (u32x4){0u, 0u, 0u, 0u}; if ((t0) + r < TP) pf[i] = *(const u32x4*)(zb + (unsigned)(((t0) + r) * NIN + col)); } } while (0)
    RET_PREFETCH(0);
    const int nchunks = (TP + RC - 1) / RC;
#pragma unroll 1
    for (int ci = 0; ci < nchunks; ++ci) {
        const int t0 = ci * RC, nv = (TP - t0) < RC ? (TP - t0) : RC;
        int lane_ = c.lane; float l2g = l2g0; asm volatile("" : "+v"(lane_), "+v"(l2g));
        const int fr = lane_ & 15, fq = lane_ >> 4, tid_ = w * 64 + lane_;
        LDS_BAR();
#pragma unroll
        for (int i = 0; i < 8; ++i) {
            if (i < 4) { const int p = (i & 1) * NT + tid_, r = p >> 4, q = p & 15;
                *(LAS u32x4*)((i < 2 ? QS : KS) + r * 272 + q * 16) = pf[i];
                if (i >= 2) { const float dk = __builtin_amdgcn_exp2f((float)(nv - 1 - r) * l2g); u32x4 o;
#pragma unroll
                    for (int e = 0; e < 4; ++e) { const unsigned v = pf[i][e]; o[e] = pk2(__uint_as_float(v << 16) * dk, __uint_as_float(v & 0xffff0000u) * dk); }
                    *(LAS u32x4*)(KD + r * 272 + q * 16) = o; } }
            else { const int p = (i - 4) * NT + tid_, r = p >> 5, q = p & 31; *(LAS u32x4*)(VS + r * 528 + q * 16) = pf[i]; }
        }
        LDS_BAR();
        if (ci + 1 < nchunks) RET_PREFETCH(t0 + RC);
        u32x4 gcur[4];
#pragma unroll
        for (int i = 0; i < 4; ++i) { const int p = i * NT + tid_, r = p >> 5, q = p & 31; gcur[i] = (u32x4){0u, 0u, 0u, 0u};
            if (r < nv) gcur[i] = *(const u32x4*)(zb + (unsigned)((t0 + r) * NIN + 2048 + hd * 256 + q * 8)); }
        { const int cb = w >> 1;
#pragma unroll
          for (int si = 0; si < 2; ++si) { const int sb = 2 * (w & 1) + si; f32x4 pacc = (f32x4){0.f, 0.f, 0.f, 0.f};
#pragma unroll
              for (int ks = 0; ks < 4; ++ks) { const bf16x8_t af = *(const LAS bf16x8_t*)(QS + (16 * cb + fr) * 272 + (32 * ks + 8 * fq) * 2);
                  const bf16x8_t bfr = *(const LAS bf16x8_t*)(KS + (16 * sb + fr) * 272 + (32 * ks + 8 * fq) * 2);
                  pacc = __builtin_amdgcn_mfma_f32_16x16x32_bf16(af, bfr, pacc, 0, 0, 0); }
#pragma unroll
              for (int r = 0; r < 4; ++r) { const int cc = 16 * cb + 4 * fq + r, ss = 16 * sb + fr; const float v = cc >= ss ? pacc[r] * __builtin_amdgcn_exp2f((float)(cc - ss) * l2g) : 0.f;
                  *(LAS bf16*)(PS + cc * 144 + ss * 2) = f2bf(v); } } }
        f32x4 Oacc[4][2];
#pragma unroll
        for (int cb = 0; cb < 4; ++cb) { Oacc[cb][0] = (f32x4){0.f, 0.f, 0.f, 0.f}; Oacc[cb][1] = (f32x4){0.f, 0.f, 0.f, 0.f}; }
#pragma unroll
        for (int kk = 0; kk < 4; ++kk) {
            bf16x8_t sb_[2];
#pragma unroll
            for (int en = 0; en < 2; ++en) { u32x4 t; t.x = pk2(Sacc[2 * kk][en][0], Sacc[2 * kk][en][1]); t.y = pk2(Sacc[2 * kk][en][2], Sacc[2 * kk][en][3]);
                t.z = pk2(Sacc[2 * kk + 1][en][0], Sacc[2 * kk + 1][en][1]); t.w = pk2(Sacc[2 * kk + 1][en][2], Sacc[2 * kk + 1][en][3]); sb_[en] = __builtin_bit_cast(bf16x8_t, t); }
#pragma unroll
            for (int cb = 0; cb < 4; ++cb) {
                const u32x2 qa = *(const LAS u32x2*)(QS + (16 * cb + fr) * 272 + (32 * kk + 4 * fq) * 2), qb = *(const LAS u32x2*)(QS + (16 * cb + fr) * 272 + (32 * kk + 16 + 4 * fq) * 2);
                u32x4 t; t.x = qa.x; t.y = qa.y; t.z = qb.x; t.w = qb.y; const bf16x8_t af = __builtin_bit_cast(bf16x8_t, t);
                Oacc[cb][0] = __builtin_amdgcn_mfma_f32_16x16x32_bf16(af, sb_[0], Oacc[cb][0], 0, 0, 0);
                Oacc[cb][1] = __builtin_amdgcn_mfma_f32_16x16x32_bf16(af, sb_[1], Oacc[cb][1], 0, 0, 0); }
        }
#pragma unroll
        for (int cb = 0; cb < 4; ++cb)
#pragma unroll
            for (int r = 0; r < 4; ++r) { const float dc = __builtin_amdgcn_exp2f((float)(16 * cb + 4 * fq + r + 1) * l2g); Oacc[cb][0][r] *= dc; Oacc[cb][1][r] *= dc; }
        LDS_BAR();
        bf16x8_t vf[2][2];
        tr_frag4(L0 + RT_VS, 528, 32 * w, 32 * w + 16, fr, fq, vf[0][0], vf[0][1], vf[1][0], vf[1][1]);
#pragma unroll
        for (int cb = 0; cb < 4; ++cb)
#pragma unroll
            for (int ks = 0; ks < 2; ++ks) { const bf16x8_t af = *(const LAS bf16x8_t*)(PS + (16 * cb + fr) * 144 + (32 * ks + 8 * fq) * 2);
                Oacc[cb][0] = __builtin_amdgcn_mfma_f32_16x16x32_bf16(af, vf[0][ks], Oacc[cb][0], 0, 0, 0);
                Oacc[cb][1] = __builtin_amdgcn_mfma_f32_16x16x32_bf16(af, vf[1][ks], Oacc[cb][1], 0, 0, 0); }
        LAS unsigned char* OT = c.lds + RT_OT;
#pragma unroll
        for (int cb = 0; cb < 4; ++cb)
#pragma unroll
            for (int en = 0; en < 2; ++en)
#pragma unroll
                for (int r = 0; r < 4; ++r) *(LAS bf16*)(OT + (16 * cb + 4 * fq + r) * 528 + (32 * w + 16 * en + fr) * 2) = f2bf(Oacc[cb][en][r]);
        { const float dS = __builtin_amdgcn_exp2f((float)nv * l2g);
#pragma unroll
          for (int d2 = 0; d2 < 4; ++d2) {
              bf16x8_t kf[2][2]; tr_frag4(L0 + RT_KD, 272, 32 * d2, 32 * d2 + 16, fr, fq, kf[0][0], kf[0][1], kf[1][0], kf[1][1]);
#pragma unroll
              for (int dd = 0; dd < 2; ++dd) { const int db = 2 * d2 + dd; Sacc[db][0] = Sacc[db][0] * dS; Sacc[db][1] = Sacc[db][1] * dS;
#pragma unroll
                  for (int ks = 0; ks < 2; ++ks) {
                      Sacc[db][0] = __builtin_amdgcn_mfma_f32_16x16x32_bf16(kf[dd][ks], vf[0][ks], Sacc[db][0], 0, 0, 0);
                      Sacc[db][1] = __builtin_amdgcn_mfma_f32_16x16x32_bf16(kf[dd][ks], vf[1][ks], Sacc[db][1], 0, 0, 0); } } } }
        LDS_BAR();
#pragma unroll
        for (int i = 0; i < 4; ++i) { const int p = i * NT + tid_, r = p >> 5, q = p & 31;
            const u32x4 ov = *(const LAS u32x4*)(OT + r * 528 + q * 16);
            float o[8]; float s1 = 0.f, s2 = 0.f;
#pragma unroll
            for (int e = 0; e < 4; ++e) { o[2 * e] = __uint_as_float(ov[e] << 16); o[2 * e + 1] = __uint_as_float(ov[e] & 0xffff0000u); s1 += o[2 * e] + o[2 * e + 1]; s2 += o[2 * e] * o[2 * e] + o[2 * e + 1] * o[2 * e + 1]; }
            s1 = red32(s1); s2 = red32(s2);
            const float mu = s1 * (1.f / 256.f), var = fmaxf(s2 * (1.f / 256.f) - mu * mu, 0.f), rstd = __builtin_amdgcn_rsqf(var + 1e-6f);
            if (r < nv) { const u32x4 gv = gcur[i]; const f32x4 n0 = *(const f32x4*)(gn + q * 8), n1 = *(const f32x4*)(gn + q * 8 + 4);
                u32x4 out;
#pragma unroll
                for (int e = 0; e < 4; ++e) { const float g0 = __uint_as_float(gv[e] << 16), g1 = __uint_as_float(gv[e] & 0xffff0000u);
                    const float n_0 = e < 2 ? n0[2 * e] : n1[2 * e - 4], n_1 = e < 2 ? n0[2 * e + 1] : n1[2 * e - 3];
                    out[e] = pk2(g0 * (o[2 * e] - mu) * rstd * n_0, g1 * (o[2 * e + 1] - mu) * rstd * n_1); }
                *(u32x4*)(MIX + (size_t)(b * TP + t0 + r) * 2048 + hd * 256 + q * 8) = out; }
        }
    }
#undef RET_PREFETCH
    { const int fr = c.lane & 15, fq = c.lane >> 4; float* So = c.out + O_RETP + ((size_t)(j * BP + b) * 4 + hd) * 128 * 256 + 32 * w + fr;
#pragma unroll
      for (int db = 0; db < 8; ++db)
#pragma unroll
          for (int en = 0; en < 2; ++en)
#pragma unroll
              for (int r = 0; r < 4; ++r) So[(unsigned)((16 * db + 4 * fq + r) * 256 + 16 * en)] = Sacc[db][en][r]; }
    __syncthreads();
}
DEVI void f_ret_sample(const Ctx& c, const PArgs& a, int j, int b, int hd) {
    const bf16* Z = (const bf16*)(c.ws + WS_Z); bf16* MIX = (bf16*)(c.ws + WS_MIX);
    LAS float* qk = (LAS float*)c.lds;
    LAS float* op = qk + 256;
    const int row = MP + b, w = c.wave;
    const float gamma = 1.f - exp2f(-5.f - (float)hd);
    const float* S0 = a.in[I_SRET] + ((size_t)(j * BS + b) * 4 + hd) * 128 * 256 + 4 * c.lane; float* So = c.out + O_RETS + ((size_t)(j * BS + b) * 4 + hd) * 128 * 256 + 4 * c.lane;
    __syncthreads();
    if (c.tid < 256) qk[c.tid] = bf2f(Z[(size_t)row * NIN + (c.tid < 128 ? hd * 128 + c.tid : 512 + hd * 128 + c.tid - 128)]);
    const u32x2 vv = *(const u32x2*)(Z + (size_t)row * NIN + 1024 + hd * 256 + 4 * c.lane);
    const f32x4 v4 = (f32x4){__uint_as_float(vv.x << 16), __uint_as_float(vv.x & 0xffff0000u), __uint_as_float(vv.y << 16), __uint_as_float(vv.y & 0xffff0000u)};
    __syncthreads();
    f32x4 o4 = (f32x4){0.f, 0.f, 0.f, 0.f};
#pragma unroll 16
    for (int dd = 0; dd < 16; ++dd) { const int d = 16 * w + dd; f32x4 s = __builtin_nontemporal_load((const f32x4*)(S0 + (unsigned)(d * 256)));
        s = s * gamma + v4 * qk[128 + d]; __builtin_nontemporal_store(s, (f32x4*)(So + (unsigned)(d * 256))); o4 = o4 + s * qk[d]; }
    *(LAS f32x4*)(op + w * 256 + 4 * c.lane) = o4;
    __syncthreads();
    if (w == 0) {
        f32x4 o = (f32x4){0.f, 0.f, 0.f, 0.f};
#pragma unroll
        for (int ww = 0; ww < 8; ++ww) o = o + *(const LAS f32x4*)(op + ww * 256 + 4 * c.lane);
        const float mu = wave_sum((o.x + o.y) + (o.z + o.w)) * (1.f / 256.f); o = o - mu;
        const float rstd = __builtin_amdgcn_rsqf(wave_sum((o.x * o.x + o.y * o.y) + (o.z * o.z + o.w * o.w)) * (1.f / 256.f) + 1e-6f);
        const u32x2 gv = *(const u32x2*)(Z + (size_t)row * NIN + 2048 + hd * 256 + 4 * c.lane); const f32x4 n4 = *(const f32x4*)(a.in[I_ERGN] + (size_t)j * 1024 + hd * 256 + 4 * c.lane);
        u32x2 out; out.x = pk2(__uint_as_float(gv.x << 16) * o.x * rstd * n4.x, __uint_as_float(gv.x & 0xffff0000u) * o.y * rstd * n4.y);
        out.y = pk2(__uint_as_float(gv.y << 16) * o.z * rstd * n4.z, __uint_as_float(gv.y & 0xffff0000u) * o.w * rstd * n4.w);
        *(u32x2*)(MIX + (size_t)row * 2048 + hd * 256 + 4 * c.lane) = out;
    }
}

#ifndef WPB
#define WPB 180
#endif
#ifndef MIX_PART
#define MIX_PART 7
#endif
DEVI void f_even_mix(const Ctx& c, const PArgs& a, int li, int part) {
    const int j = li >> 1;
    if (c.bid < 32) { if (part & 1) f_ret_prompt(c, a, j, c.bid >> 2, c.bid & 3); }
    else if (c.bid < 104) { if (part & 2) { const bool pr = c.bid < 96; const int v = c.bid - 32;
        f_lru_unit(c, a, j, pr ? (v & 7) : (c.bid - 96), !pr, pr ? (v >> 3) : 0); } }
    if (part & 4) {
    if (c.bid >= 104) for (int u = c.bid - 104; u < 512; u += c.G - 104) f_ret_sample(c, a, j, u >> 2, u & 3);
    if (c.bid >= WPB && c.G > WPB) { __syncthreads(); f_wprep(c, a, li == 0 ? WM_L01 : WM_L23, (c.bid - WPB) * NWAVES + c.wave, (c.G - WPB) * NWAVES); }
    }
}

DEVI float gelu_fast(float x) { const float y = 1.5957691216057308f * (x + 0.044715f * x * x * x); return x * __builtin_amdgcn_rcpf(1.f + __expf(-y)); }
DEVI void f_ffn_act(const Ctx& c, const PArgs& a, int li) {
    const bf16* U = (const bf16*)(c.ws + WS_U); bf16* ACT = (bf16*)(c.ws + WS_ACT);
    const float* CW = a.in[I_FCW] + (size_t)li * 3 * DFF; const float* CB = a.in[I_FCB] + (size_t)li * DFF;
    constexpr int RCH = 32, NPC = DFF / 8, NRC = M / RCH, NITEM = NPC * NRC;
    for (int it = c.bid * NT + c.tid; it < NITEM; it += c.G * NT) {
        const int rc = it / NPC, pc = it - rc * NPC, col = pc * 8, r0 = rc * RCH;
        float w0[8], w1[8], w2[8], cb[8];
#pragma unroll
        for (int h = 0; h < 2; ++h) { const f32x4 a0 = *(const f32x4*)(CW + col + 4 * h), a1 = *(const f32x4*)(CW + DFF + col + 4 * h), a2 = *(const f32x4*)(CW + 2 * DFF + col + 4 * h), b0 = *(const f32x4*)(CB + col + 4 * h);
#pragma unroll
            for (int e = 0; e < 4; ++e) { w0[4 * h + e] = a0[e]; w1[4 * h + e] = a1[e]; w2[4 * h + e] = a2[e]; cb[4 * h + e] = b0[e]; } }
        const bf16* ub = U + (size_t)r0 * NUP + col; bf16* ab = ACT + (size_t)r0 * DFF + col;
        if (r0 < MP) {
            u32x4 p1 = (u32x4){0u, 0u, 0u, 0u}, p2 = p1;
            int t = r0 % TP;
            if (t >= 1) p1 = *(const u32x4*)(ub - NUP); if (t >= 2) p2 = *(const u32x4*)(ub - 2 * NUP);
#pragma unroll 1
            for (int i0 = 0; i0 < RCH; i0 += 8) {
                u32x4 ug[8], uv[8];
#pragma unroll
                for (int i = 0; i < 8; ++i) { ug[i] = *(const u32x4*)(ub + (unsigned)((i0 + i) * NUP)); uv[i] = *(const u32x4*)(ub + (unsigned)((i0 + i) * NUP + DFF)); }
#pragma unroll
                for (int i = 0; i < 8; ++i) {
                    if (t == 0) { p1 = (u32x4){0u, 0u, 0u, 0u}; p2 = p1; }
                    if (t >= TP - 2) { float* so = c.out + O_FCONVP + ((size_t)(li * BP + (r0 + i0 + i) / TP) * 2 + (t - (TP - 2))) * DFF + col;
#pragma unroll
                        for (int e = 0; e < 4; ++e) { so[2 * e] = __uint_as_float(ug[i][e] << 16); so[2 * e + 1] = __uint_as_float(ug[i][e] & 0xffff0000u); } }
                    u32x4 o;
#pragma unroll
                    for (int e = 0; e < 4; ++e) {
                        const float ca = cb[2 * e] + w2[2 * e] * __uint_as_float(ug[i][e] << 16) + w1[2 * e] * __uint_as_float(p1[e] << 16) + w0[2 * e] * __uint_as_float(p2[e] << 16);
                        const float cv = cb[2 * e + 1] + w2[2 * e + 1] * __uint_as_float(ug[i][e] & 0xffff0000u) + w1[2 * e + 1] * __uint_as_float(p1[e] & 0xffff0000u) + w0[2 * e + 1] * __uint_as_float(p2[e] & 0xffff0000u);
                        o[e] = pk2(gelu_fast(ca) * __uint_as_float(uv[i][e] << 16), gelu_fast(cv) * __uint_as_float(uv[i][e] & 0xffff0000u)); }
                    *(u32x4*)(ab + (unsigned)((i0 + i) * DFF)) = o;
                    p2 = p1; p1 = ug[i]; t = (t + 1 == TP) ? 0 : t + 1;
                }
            }
        } else {
#pragma unroll 1
            for (int i = 0; i < RCH; ++i) {
                const int row = r0 + i;
                const u32x4 ug = *(const u32x4*)(ub + (unsigned)(i * NUP)), uv = *(const u32x4*)(ub + (unsigned)(i * NUP + DFF));
                const float* st = a.in[I_SFCONV] + (size_t)(li * BS + row - MP) * 2 * DFF + col; float* so = c.out + O_FCONVS + (size_t)(li * BS + row - MP) * 2 * DFF + col;
                float f1[8], f2[8];
#pragma unroll
                for (int h = 0; h < 2; ++h) { const f32x4 s2 = *(const f32x4*)(st + 4 * h), s1 = *(const f32x4*)(st + DFF + 4 * h); *(f32x4*)(so + 4 * h) = s1;
#pragma unroll
                    for (int e = 0; e < 4; ++e) { f2[4 * h + e] = s2[e]; f1[4 * h + e] = s1[e]; } }
                u32x4 o;
#pragma unroll
                for (int e = 0; e < 4; ++e) { const float u0a = __uint_as_float(ug[e] << 16), u0b = __uint_as_float(ug[e] & 0xffff0000u);
                    so[DFF + 2 * e] = u0a; so[DFF + 2 * e + 1] = u0b;
                    const float ca = cb[2 * e] + w2[2 * e] * u0a + w1[2 * e] * f1[2 * e] + w0[2 * e] * f2[2 * e], cv = cb[2 * e + 1] + w2[2 * e + 1] * u0b + w1[2 * e + 1] * f1[2 * e + 1] + w0[2 * e + 1] * f2[2 * e + 1];
                    o[e] = pk2(gelu_fast(ca) * __uint_as_float(uv[e] << 16), gelu_fast(cv) * __uint_as_float(uv[e] & 0xffff0000u)); }
                *(u32x4*)(ab + (unsigned)(i * DFF)) = o;
            }
        }
    }
}

constexpr int RW_TG = 16;
constexpr int RW_BUF = 6 * RW_TG * 64 * 4;
constexpr int RW_Y = 2 * RW_BUF, RW_BON = RW_Y + RW_TG * 64 * 4, RW_END = RW_BON + RW_TG * 4;
DEVI void f_rwkv_prompt(const Ctx& c, const PArgs& a, int j, int b, int hd) {
    const bf16* R = (const bf16*)(c.ws + WS_R); const bf16* Kb = (const bf16*)(c.ws + WS_K);
    const bf16* VF = (const bf16*)((unsigned char*)c.out + DO_VFIRST); const bf16* Vb = j == 0 ? VF : (const bf16*)(c.ws + WS_V);
    const float* WD = (const float*)(c.ws + WS_WDEC); const bf16* AG = (const bf16*)(c.ws + WS_AG); const bf16* VG = (const bf16*)(c.ws + WS_VG); const bf16* GG = (const bf16*)(c.ws + WS_GG);
    bf16* O = (bf16*)(c.ws + WS_O);
    const int i = c.tid >> 3, q = c.tid & 7;
    const int st = c.tid >> 5, sc = (c.tid & 31) * 2, ch = hd * 64 + sc;
    const size_t rb = (size_t)(b * TP) * D + ch;
    const float kk0 = a.in[I_OKK][(size_t)j * D + ch], kk1 = a.in[I_OKK][(size_t)j * D + ch + 1], ka0 = a.in[I_OKA][(size_t)j * D + ch], ka1 = a.in[I_OKA][(size_t)j * D + ch + 1];
    const float rk0 = a.in[I_ORK][(size_t)j * D + ch], rk1 = a.in[I_ORK][(size_t)j * D + ch + 1];
    const float gg0 = a.in[I_OGNG][(size_t)j * D + ch], gg1 = a.in[I_OGNG][(size_t)j * D + ch + 1], gb0 = a.in[I_OGNB][(size_t)j * D + ch], gb1 = a.in[I_OGNB][(size_t)j * D + ch + 1];
    float s[8], z[8];
#pragma unroll
    for (int jj = 0; jj < 8; ++jj) { s[jj] = 0.f; z[jj] = 0.f; }
    unsigned pr_, pk_, pv_, pa_, pg_, pvf_ = 0u, pvg_ = 0u; float pw0, pw1;
#define RW_PREFETCH(t0) do { const unsigned o = (unsigned)(((t0) + st) * D); const bool ok = (t0) + st < TP; \
        pr_ = ok ? *(const unsigned*)(R + rb + o) : 0u; pk_ = ok ? *(const unsigned*)(Kb + rb + o) : 0u; pv_ = ok ? *(const unsigned*)(Vb + rb + o) : 0u; \
        pa_ = ok ? *(const unsigned*)(AG + rb + o) : 0u; pg_ = ok ? *(const unsigned*)(GG + rb + o) : 0u; \
        if (j == 1) { pvf_ = ok ? *(const unsigned*)(VF + rb + o) : 0u; pvg_ = ok ? *(const unsigned*)(VG + rb + o) : 0u; } \
        pw0 = ok ? WD[rb + o] : 1.f; pw1 = ok ? WD[rb + o + 1] : 1.f; } while (0)
    RW_PREFETCH(0);
    const int ngroups = (TP + RW_TG - 1) / RW_TG;
#pragma unroll 1
    for (int g = 0; g < ngroups; ++g) {
        const int t0 = g * RW_TG;
        LAS float* buf = (LAS float*)(c.lds + (g & 1) * RW_BUF);
        LAS float* ys = (LAS float*)(c.lds + RW_Y); LAS float* bon = (LAS float*)(c.lds + RW_BON);
        float gate0, gate1;
        { const float r0 = __uint_as_float(pr_ << 16), r1 = __uint_as_float(pr_ & 0xffff0000u), k0 = __uint_as_float(pk_ << 16), k1 = __uint_as_float(pk_ & 0xffff0000u);
          float v0 = __uint_as_float(pv_ << 16), v1 = __uint_as_float(pv_ & 0xffff0000u);
          const float a0 = __uint_as_float(pa_ << 16), a1 = __uint_as_float(pa_ & 0xffff0000u);
          gate0 = __uint_as_float(pg_ << 16); gate1 = __uint_as_float(pg_ & 0xffff0000u);
          if (j == 1) { const float f0 = __uint_as_float(pvf_ << 16), f1 = __uint_as_float(pvf_ & 0xffff0000u); v0 = v0 + (f0 - v0) * __uint_as_float(pvg_ << 16); v1 = v1 + (f1 - v1) * __uint_as_float(pvg_ & 0xffff0000u); }
          float q0 = k0 * kk0, q1 = k1 * kk1; const float ss = red32(q0 * q0 + q1 * q1); const float rn = __builtin_amdgcn_rsqf(fmaxf(ss, 1e-24f)); q0 *= rn; q1 *= rn;
          const float m0 = k0 * (1.f + (a0 - 1.f) * ka0), m1 = k1 * (1.f + (a1 - 1.f) * ka1);
          const float bs = red32(r0 * m0 * rk0 + r1 * m1 * rk1);
          const int o = st * 64 + sc;
          *(LAS f32x2_t*)(buf + o) = (f32x2_t){r0, r1}; *(LAS f32x2_t*)(buf + RW_TG * 64 + o) = (f32x2_t){pw0, pw1}; *(LAS f32x2_t*)(buf + 2 * RW_TG * 64 + o) = (f32x2_t){m0, m1};
          *(LAS f32x2_t*)(buf + 3 * RW_TG * 64 + o) = (f32x2_t){v0, v1}; *(LAS f32x2_t*)(buf + 4 * RW_TG * 64 + o) = (f32x2_t){-q0, -q1}; *(LAS f32x2_t*)(buf + 5 * RW_TG * 64 + o) = (f32x2_t){q0 * a0, q1 * a1};
          __syncthreads();
          if ((c.tid & 31) == 0) bon[st] = bs; }
        if (g + 1 < ngroups) RW_PREFETCH(t0 + RW_TG);
        const int nt = (TP - t0) < RW_TG ? (TP - t0) : RW_TG;
        if (c.tid < 256) {
#pragma unroll 4
        for (int tt = 0; tt < nt; ++tt) {
            const LAS float* p = buf + tt * 64 + 8 * q;
            const f32x4 ra = *(const LAS f32x4*)(p), rb2 = *(const LAS f32x4*)(p + 4), wa = *(const LAS f32x4*)(p + RW_TG * 64), wb = *(const LAS f32x4*)(p + RW_TG * 64 + 4);
            const f32x4 ka = *(const LAS f32x4*)(p + 2 * RW_TG * 64), kb2 = *(const LAS f32x4*)(p + 2 * RW_TG * 64 + 4), aa = *(const LAS f32x4*)(p + 4 * RW_TG * 64), ab = *(const LAS f32x4*)(p + 4 * RW_TG * 64 + 4);
            const f32x4 ba = *(const LAS f32x4*)(p + 5 * RW_TG * 64), bb = *(const LAS f32x4*)(p + 5 * RW_TG * 64 + 4);
            const float vi = buf[3 * RW_TG * 64 + tt * 64 + i], vj = buf[3 * RW_TG * 64 + tt * 64 + i + 32];
            const float sa = red8((s[0] * aa[0] + s[1] * aa[1]) + (s[2] * aa[2] + s[3] * aa[3]) + ((s[4] * ab[0] + s[5] * ab[1]) + (s[6] * ab[2] + s[7] * ab[3])));
            const float za = red8((z[0] * aa[0] + z[1] * aa[1]) + (z[2] * aa[2] + z[3] * aa[3]) + ((z[4] * ab[0] + z[5] * ab[1]) + (z[6] * ab[2] + z[7] * ab[3])));
#pragma unroll
            for (int jj = 0; jj < 4; ++jj) { s[jj] = s[jj] * wa[jj] + sa * ba[jj] + vi * ka[jj]; s[4 + jj] = s[4 + jj] * wb[jj] + sa * bb[jj] + vi * kb2[jj];
                z[jj] = z[jj] * wa[jj] + za * ba[jj] + vj * ka[jj]; z[4 + jj] = z[4 + jj] * wb[jj] + za * bb[jj] + vj * kb2[jj]; }
            const float y = red8((s[0] * ra[0] + s[1] * ra[1]) + (s[2] * ra[2] + s[3] * ra[3]) + ((s[4] * rb2[0] + s[5] * rb2[1]) + (s[6] * rb2[2] + s[7] * rb2[3])));
            const float y2 = red8((z[0] * ra[0] + z[1] * ra[1]) + (z[2] * ra[2] + z[3] * ra[3]) + ((z[4] * rb2[0] + z[5] * rb2[1]) + (z[6] * rb2[2] + z[7] * rb2[3])));
            if (q == 0) { ys[tt * 64 + i] = y; ys[tt * 64 + i + 32] = y2; }
        }
        }
        __syncthreads();
        if (t0 + st < TP) {
            const f32x2_t yv = *(const LAS f32x2_t*)(ys + st * 64 + sc), vv = *(const LAS f32x2_t*)(buf + 3 * RW_TG * 64 + st * 64 + sc);
            const float mu = red32(yv.x + yv.y) * (1.f / 64.f); const float d0 = yv.x - mu, d1 = yv.y - mu; const float var = red32(d0 * d0 + d1 * d1) * (1.f / 64.f);
            const float rs = 1.f / sqrtf(var + 64e-5f), bo = bon[st];
            const float o0 = (d0 * rs * gg0 + gb0 + bo * vv.x) * gate0, o1 = (d1 * rs * gg1 + gb1 + bo * vv.y) * gate1;
            *(unsigned*)(O + rb + (unsigned)((t0 + st) * D)) = pk2(o0, o1);
        }
    }
#undef RW_PREFETCH
    if (c.tid < 256) { float* So = c.out + O_RWKVP + ((size_t)(j * BP + b) * 16 + hd) * 4096 + i * 64 + 8 * q;
      *(f32x4*)So = (f32x4){s[0], s[1], s[2], s[3]}; *(f32x4*)(So + 4) = (f32x4){s[4], s[5], s[6], s[7]};
      *(f32x4*)(So + 2048) = (f32x4){z[0], z[1], z[2], z[3]}; *(f32x4*)(So + 2052) = (f32x4){z[4], z[5], z[6], z[7]}; }
    __syncthreads();
}
DEVI void f_rwkv_sample(const Ctx& c, const PArgs& a, int j, int b, int hd) {
    const bf16* R = (const bf16*)(c.ws + WS_R); const bf16* Kb = (const bf16*)(c.ws + WS_K);
    const bf16* VF = (const bf16*)((unsigned char*)c.out + DO_VFIRST); const bf16* Vb = j == 0 ? VF : (const bf16*)(c.ws + WS_V);
    const float* WD = (const float*)(c.ws + WS_WDEC); const bf16* AG = (const bf16*)(c.ws + WS_AG); const bf16* VG = (const bf16*)(c.ws + WS_VG); const bf16* GG = (const bf16*)(c.ws + WS_GG);
    bf16* O = (bf16*)(c.ws + WS_O);
    LAS float* buf = (LAS float*)c.lds;
    const int i = c.tid >> 3, q = c.tid & 7;
    const size_t so = ((size_t)(j * BS + b) * 16 + hd) * 4096 + i * 64 + 8 * q;
    const f32x4 sA = __builtin_nontemporal_load((const f32x4*)(a.in[I_SRWKV] + so)), sB = __builtin_nontemporal_load((const f32x4*)(a.in[I_SRWKV] + so + 4));
    float s[8] = {sA[0], sA[1], sA[2], sA[3], sB[0], sB[1], sB[2], sB[3]};
    float gate = 0.f;
    __syncthreads();
    if (c.tid < 64) { const int ch = hd * 64 + c.tid; const size_t o = (size_t)(MP + b) * D + ch;
        const float r = bf2f(R[o]), k = bf2f(Kb[o]), ag = bf2f(AG[o]), w = WD[o]; float v = bf2f(Vb[o]); gate = bf2f(GG[o]);
        if (j == 1) { const float vf = bf2f(VF[o]); v = v + (vf - v) * bf2f(VG[o]); }
        float kk = k * a.in[I_OKK][(size_t)j * D + ch]; const float ss = wave_sum(kk * kk); kk = kk / sqrtf(fmaxf(ss, 1e-24f));
        const float km = k * (1.f + (ag - 1.f) * a.in[I_OKA][(size_t)j * D + ch]);
        const float bs = wave_sum(r * km * a.in[I_ORK][(size_t)j * D + ch]);
        buf[c.tid] = r; buf[64 + c.tid] = w; buf[128 + c.tid] = km; buf[192 + c.tid] = v; buf[256 + c.tid] = -kk; buf[320 + c.tid] = kk * ag;
        if (c.tid == 0) buf[448] = bs; }
    __syncthreads();
    { float sa = 0.f;
#pragma unroll
      for (int jj = 0; jj < 8; ++jj) sa += s[jj] * buf[256 + 8 * q + jj];
      sa = red8(sa);
      const float vi = buf[192 + i]; float y = 0.f;
#pragma unroll
      for (int jj = 0; jj < 8; ++jj) { const int cj = 8 * q + jj; s[jj] = s[jj] * buf[64 + cj] + sa * buf[320 + cj] + vi * buf[128 + cj]; y += s[jj] * buf[cj]; }
      y = red8(y);
      if (q == 0) buf[384 + i] = y;
      float* Sout = c.out + O_RWKVS + so;
      __builtin_nontemporal_store((f32x4){s[0], s[1], s[2], s[3]}, (f32x4*)Sout); __builtin_nontemporal_store((f32x4){s[4], s[5], s[6], s[7]}, (f32x4*)(Sout + 4)); }
    __syncthreads();
    if (c.tid < 64) { const int ch = hd * 64 + c.tid;
        const float y = buf[384 + c.tid]; const float mu = wave_sum(y) * (1.f / 64.f); const float dy = y - mu; const float var = wave_sum(dy * dy) * (1.f / 64.f);
        float o = dy / sqrtf(var + 64e-5f) * a.in[I_OGNG][(size_t)j * D + ch] + a.in[I_OGNB][(size_t)j * D + ch];
        o = (o + buf[448] * buf[192 + c.tid]) * gate;
        O[(size_t)(MP + b) * D + ch] = f2bf(o); }
}
DEVI void f_odd_scan(const Ctx& c, const PArgs& a, int li) {
    const int j = li >> 1;
    if (c.bid < 128) f_rwkv_prompt(c, a, j, c.bid >> 4, c.bid & 15);
    else for (int u = c.bid - 128; u < 2048; u += c.G - 128) f_rwkv_sample(c, a, j, u >> 4, u & 15);
}

constexpr size_t DO_BON = 54 * MiB;
DEVI float red16(float x) { x += DPP_F(x, 0xB1); x += DPP_F(x, 0x4E); x += DPP_F(x, 0x141); x += DPP_F(x, 0x140); return x; }
constexpr int RW2_Y = 2 * RW_BUF, RW2_END = RW2_Y + 2 * RW_TG * 32 * 4;
DEVI void f_rwkv_prompt2(const Ctx& c, const PArgs& a, int j, int b, int hd, int half) {
    const bf16* R = (const bf16*)(c.ws + WS_R); const bf16* Kb = (const bf16*)(c.ws + WS_K);
    const bf16* VF = (const bf16*)((unsigned char*)c.out + DO_VFIRST); const bf16* Vb = j == 0 ? VF : (const bf16*)(c.ws + WS_V);
    const float* WD = (const float*)(c.ws + WS_WDEC); const bf16* AG = (const bf16*)(c.ws + WS_AG); const bf16* VG = (const bf16*)(c.ws + WS_VG);
    bf16* O = (bf16*)(c.ws + WS_O); float* BON = (float*)((unsigned char*)c.out + DO_BON);
    const int il = c.tid >> 4, q = c.tid & 15;
    const int st = c.tid >> 5, sc = (c.tid & 31) * 2, ch = hd * 64 + sc;
    const size_t rb = (size_t)(b * TP) * D + ch;
    const float kk0 = a.in[I_OKK][(size_t)j * D + ch], kk1 = a.in[I_OKK][(size_t)j * D + ch + 1], ka0 = a.in[I_OKA][(size_t)j * D + ch], ka1 = a.in[I_OKA][(size_t)j * D + ch + 1];
    const float rk0 = a.in[I_ORK][(size_t)j * D + ch], rk1 = a.in[I_ORK][(size_t)j * D + ch + 1];
    f32x4 s = (f32x4){0.f, 0.f, 0.f, 0.f};
    unsigned pr_, pk_, pv_, pa_, pvf_ = 0u, pvg_ = 0u; f32x2_t pw_;
#define RW2_PREFETCH(t0) do { const unsigned o = (unsigned)(((t0) + st) * D); const bool ok = (t0) + st < TP; \
        pr_ = ok ? *(const unsigned*)(R + rb + o) : 0u; pk_ = ok ? *(const unsigned*)(Kb + rb + o) : 0u; pv_ = ok ? *(const unsigned*)(Vb + rb + o) : 0u; pa_ = ok ? *(const unsigned*)(AG + rb + o) : 0u; \
        if (j == 1) { pvf_ = ok ? *(const unsigned*)(VF + rb + o) : 0u; pvg_ = ok ? *(const unsigned*)(VG + rb + o) : 0u; } \
        pw_ = ok ? *(const f32x2_t*)(WD + rb + o) : (f32x2_t){1.f, 1.f}; } while (0)
    RW2_PREFETCH(0);
    const int ngroups = (TP + RW_TG - 1) / RW_TG;
    LAS float* ys = (LAS float*)(c.lds + RW2_Y);
#pragma unroll 1
    for (int g = 0; g < ngroups; ++g) {
        const int t0 = g * RW_TG; const int nt = (TP - t0) < RW_TG ? (TP - t0) : RW_TG;
        LAS float* buf = (LAS float*)(c.lds + (g & 1) * RW_BUF);
        { const float r0 = __uint_as_float(pr_ << 16), r1 = __uint_as_float(pr_ & 0xffff0000u), k0 = __uint_as_float(pk_ << 16), k1 = __uint_as_float(pk_ & 0xffff0000u);
          float v0 = __uint_as_float(pv_ << 16), v1 = __uint_as_float(pv_ & 0xffff0000u);
          const float a0 = __uint_as_float(pa_ << 16), a1 = __uint_as_float(pa_ & 0xffff0000u);
          if (j == 1) { const float f0 = __uint_as_float(pvf_ << 16), f1 = __uint_as_float(pvf_ & 0xffff0000u); v0 = v0 + (f0 - v0) * __uint_as_float(pvg_ << 16); v1 = v1 + (f1 - v1) * __uint_as_float(pvg_ & 0xffff0000u); }
          float q0 = k0 * kk0, q1 = k1 * kk1; const float ss = red32(q0 * q0 + q1 * q1); const float rn = __builtin_amdgcn_rsqf(fmaxf(ss, 1e-24f)); q0 *= rn; q1 *= rn;
          const float m0 = k0 * (1.f + (a0 - 1.f) * ka0), m1 = k1 * (1.f + (a1 - 1.f) * ka1);
          const float bs = red32(r0 * m0 * rk0 + r1 * m1 * rk1);
          const int o = st * 64 + sc;
          *(LAS f32x2_t*)(buf + o) = (f32x2_t){r0, r1}; *(LAS f32x2_t*)(buf + RW_TG * 64 + o) = pw_; *(LAS f32x2_t*)(buf + 2 * RW_TG * 64 + o) = (f32x2_t){m0, m1};
          *(LAS f32x2_t*)(buf + 3 * RW_TG * 64 + o) = (f32x2_t){v0, v1}; *(LAS f32x2_t*)(buf + 4 * RW_TG * 64 + o) = (f32x2_t){-q0, -q1}; *(LAS f32x2_t*)(buf + 5 * RW_TG * 64 + o) = (f32x2_t){q0 * a0, q1 * a1};
          if (half == 0 && (c.tid & 31) == 0 && t0 + st < TP) BON[(size_t)(b * TP + t0 + st) * 16 + hd] = bs; }
        __syncthreads();
        if (g + 1 < ngroups) RW2_PREFETCH(t0 + RW_TG);
        {
            const LAS float* p = buf + 4 * q; const LAS float* pv = buf + 3 * RW_TG * 64 + 32 * half + il;
            f32x4 r4 = *(const LAS f32x4*)(p), w4 = *(const LAS f32x4*)(p + RW_TG * 64), k4 = *(const LAS f32x4*)(p + 2 * RW_TG * 64), a4 = *(const LAS f32x4*)(p + 4 * RW_TG * 64), b4 = *(const LAS f32x4*)(p + 5 * RW_TG * 64);
            float vi = pv[0];
#pragma unroll 2
            for (int tt = 0; tt < nt; ++tt) {
                const int tn = tt + 1 < nt ? tt + 1 : tt;
                const f32x4 nr4 = *(const LAS f32x4*)(p + tn * 64), nw4 = *(const LAS f32x4*)(p + RW_TG * 64 + tn * 64), nk4 = *(const LAS f32x4*)(p + 2 * RW_TG * 64 + tn * 64),
                            na4 = *(const LAS f32x4*)(p + 4 * RW_TG * 64 + tn * 64), nb4 = *(const LAS f32x4*)(p + 5 * RW_TG * 64 + tn * 64);
                const float nvi = pv[tn * 64];
                const float sa = red16((s[0] * a4[0] + s[1] * a4[1]) + (s[2] * a4[2] + s[3] * a4[3]));
                s = s * w4 + b4 * sa + k4 * vi;
                const float y = red16((s[0] * r4[0] + s[1] * r4[1]) + (s[2] * r4[2] + s[3] * r4[3]));
                if (q == 0) ys[tt * 32 + il] = y;
                r4 = nr4; w4 = nw4; k4 = nk4; a4 = na4; b4 = nb4; vi = nvi;
            }
        }
        __syncthreads();
        { const int tt = c.tid >> 5, cc = c.tid & 31; if (tt < nt) O[(size_t)(b * TP + t0 + tt) * D + hd * 64 + 32 * half + cc] = f2bf(ys[tt * 32 + cc]); }
    }
#undef RW2_PREFETCH
    { float* So = c.out + O_RWKVP + ((size_t)(j * BP + b) * 16 + hd) * 4096 + (32 * half + il) * 64 + 4 * q; *(f32x4*)So = s; }
    __syncthreads();
}
DEVI void f_rwkv_post(const Ctx& c, const PArgs& a, int li) {
    const int j = li >> 1;
    bf16* O = (bf16*)(c.ws + WS_O); const bf16* GG = (const bf16*)(c.ws + WS_GG); const bf16* VG = (const bf16*)(c.ws + WS_VG);
    const bf16* VF = (const bf16*)((unsigned char*)c.out + DO_VFIRST); const bf16* Vb = j == 0 ? VF : (const bf16*)(c.ws + WS_V); const float* BON = (const float*)((unsigned char*)c.out + DO_BON);
    const int pc = c.tid & 127, ch = pc * 8;
    const f32x4 g0 = *(const f32x4*)(a.in[I_OGNG] + (size_t)j * D + ch), g1 = *(const f32x4*)(a.in[I_OGNG] + (size_t)j * D + ch + 4), b0 = *(const f32x4*)(a.in[I_OGNB] + (size_t)j * D + ch), b1 = *(const f32x4*)(a.in[I_OGNB] + (size_t)j * D + ch + 4);
    for (int row = c.bid * 4 + (c.tid >> 7); row < MP; row += c.G * 4) {
        const size_t o = (size_t)row * D + ch;
        const u32x4 yv = *(const u32x4*)(O + o), vv = *(const u32x4*)(Vb + o), gv = *(const u32x4*)(GG + o);
        float y[8], v[8], gt[8];
#pragma unroll
        for (int e = 0; e < 4; ++e) { y[2 * e] = __uint_as_float(yv[e] << 16); y[2 * e + 1] = __uint_as_float(yv[e] & 0xffff0000u); v[2 * e] = __uint_as_float(vv[e] << 16); v[2 * e + 1] = __uint_as_float(vv[e] & 0xffff0000u);
            gt[2 * e] = __uint_as_float(gv[e] << 16); gt[2 * e + 1] = __uint_as_float(gv[e] & 0xffff0000u); }
        if (j == 1) { const u32x4 fv = *(const u32x4*)(VF + o), mv = *(const u32x4*)(VG + o);
#pragma unroll
            for (int e = 0; e < 4; ++e) { const float f0 = __uint_as_float(fv[e] << 16), f1 = __uint_as_float(fv[e] & 0xffff0000u), m0 = __uint_as_float(mv[e] << 16), m1 = __uint_as_float(mv[e] & 0xffff0000u);
                v[2 * e] = v[2 * e] + (f0 - v[2 * e]) * m0; v[2 * e + 1] = v[2 * e + 1] + (f1 - v[2 * e + 1]) * m1; } }
        float s1 = 0.f;
#pragma unroll
        for (int e = 0; e < 8; ++e) s1 += y[e];
        const float mu = red8(s1) * (1.f / 64.f); float s2 = 0.f;
#pragma unroll
        for (int e = 0; e < 8; ++e) { y[e] -= mu; s2 += y[e] * y[e]; }
        const float rs = __builtin_amdgcn_rsqf(red8(s2) * (1.f / 64.f) + 64e-5f), bo = BON[(size_t)row * 16 + (pc >> 3)];
        u32x4 out;
#pragma unroll
        for (int e = 0; e < 4; ++e) { const float gg0 = e < 2 ? g0[2 * e] : g1[2 * e - 4], gg1 = e < 2 ? g0[2 * e + 1] : g1[2 * e - 3], bb0 = e < 2 ? b0[2 * e] : b1[2 * e - 4], bb1 = e < 2 ? b0[2 * e + 1] : b1[2 * e - 3];
            out[e] = pk2((y[2 * e] * rs * gg0 + bb0 + bo * v[2 * e]) * gt[2 * e], (y[2 * e + 1] * rs * gg1 + bb1 + bo * v[2 * e + 1]) * gt[2 * e + 1]); }
        *(u32x4*)(O + o) = out;
    }
}
DEVI void f_odd_scan2(const Ctx& c, const PArgs& a, int li) {
    const int j = li >> 1;
    for (int u = c.bid; u < 256; u += c.G) f_rwkv_prompt2(c, a, j, u >> 5, (u >> 1) & 15, u & 1);
    for (int u = c.bid; u < 2048; u += c.G) f_rwkv_sample(c, a, j, u >> 4, u & 15);
}

constexpr int R_AF = 0, R_RF = 2048, R_BKF = 4096, R_VF = 8192, R_GF = 10240, R_RECA = 12288, R_RECB = 13312, R_PL = 14336, R_BON = 14592, RW3_REC = 14848;
constexpr int RW3_RING = 0, RW3_SCR = 8 * RW3_REC, RW3_SCRW = 5120, RW3_STAT = RW3_SCR + 4 * RW3_SCRW, RW3_END = RW3_STAT + 4096;
static_assert(RW3_END <= RING_BYTES, "rwkv3 lds");
#define DPP_RM(v, ctrl, rm) __builtin_bit_cast(float, __builtin_amdgcn_update_dpp(0, __builtin_bit_cast(int, (v)), (ctrl), (rm), 0xF, false))
DEVI float wsum64(float x) { x = red16(x); x += DPP_RM(x, 0x142, 0xA); x += DPP_RM(x, 0x143, 0xC); return __builtin_bit_cast(float, __builtin_amdgcn_readlane(__builtin_bit_cast(int, x), 63)); }
#define LWAIT() asm volatile("s_waitcnt lgkmcnt(0)" ::: "memory")
DEVI bf16x8_t frag_lohi(u32x2 lo, u32x2 hi) { u32x4 t; t.x = lo.x; t.y = lo.y; t.z = hi.x; t.w = hi.y; return __builtin_bit_cast(bf16x8_t, t); }
struct RwRaw { u32x2 r[4], k[4], v[4], a[4], g[4], f[4], m[4]; f32x4 w[4]; };
DEVI void rw3_load(const Ctx& c, RwRaw& q, int j, int b, int hd, int ck, int parts) {
    const bf16* R = (const bf16*)(c.ws + WS_R); const bf16* Kb = (const bf16*)(c.ws + WS_K);
    const bf16* VF_ = (const bf16*)((unsigned char*)c.out + DO_VFIRST); const bf16* Vb = j == 0 ? VF_ : (const bf16*)(c.ws + WS_V);
    const float* WD = (const float*)(c.ws + WS_WDEC); const bf16* AG = (const bf16*)(c.ws + WS_AG); const bf16* VG = (const bf16*)(c.ws + WS_VG); const bf16* GG = (const bf16*)(c.ws + WS_GG);
    const size_t rb = (size_t)(b * TP + ck * 16 + (c.lane & 15)) * D + hd * 64 + 4 * (c.lane >> 4);
#pragma unroll
    for (int n = 0; n < 4; ++n) { const size_t o = rb + 16 * n;
        if (parts & 4) { q.r[n] = *(const u32x2*)(R + o); q.k[n] = *(const u32x2*)(Kb + o); q.a[n] = *(const u32x2*)(AG + o); }
        if (parts & 2) q.w[n] = *(const f32x4*)(WD + o);
        if (parts & 1) { q.v[n] = *(const u32x2*)(Vb + o); q.g[n] = *(const u32x2*)(GG + o);
            if (j == 1) { q.f[n] = *(const u32x2*)(VF_ + o); q.m[n] = *(const u32x2*)(VG + o); } else { q.f[n] = (u32x2){0u, 0u}; q.m[n] = (u32x2){0u, 0u}; } } }
}
DEVI float bfe(u32x2 p, int e) { const unsigned u = e < 2 ? p.x : p.y; return (e & 1) ? __uint_as_float(u & 0xffff0000u) : __uint_as_float(u << 16); }
DEVI float fq_sum(float s) {
    u32x2 r = __builtin_amdgcn_permlane16_swap(__float_as_uint(s), __float_as_uint(s), false, false); s = __uint_as_float(r.x) + __uint_as_float(r.y);
    r = __builtin_amdgcn_permlane32_swap(__float_as_uint(s), __float_as_uint(s), false, false); return __uint_as_float(r.x) + __uint_as_float(r.y);
}
template <int S> DEVI float dpp_shr1(float x) { return __builtin_bit_cast(float, __builtin_amdgcn_update_dpp(0x3f800000, __builtin_bit_cast(int, x), 0x110 + S, 0xF, 0xF, false)); }
struct RwCoef { float kk[4][4], ka[4][4], rk[4][4]; };
#ifndef PREP_PRIO
#define PREP_PRIO 0
#endif
#ifndef CHAIN_PRIO
#define CHAIN_PRIO 3
#endif
constexpr int RW3_CF = 3072;
DEVI void rw3_prep(const Ctx& c, int j, int b, int hd, int ckn, RwRaw& q, LAS unsigned char* rec, LAS unsigned char* scr) {
    const int lane = c.lane, fr = lane & 15, fq = lane >> 4, t = fr;
    { const int lv = ((t >> 2) * 16 + 4 * fq) * 8 + (t & 3) * 2;
#pragma unroll
      for (int n = 0; n < 4; ++n)
#pragma unroll
        for (int e = 0; e < 4; ++e) { float v = bfe(q.v[n], e); if (j == 1) v = v + (bfe(q.f[n], e) - v) * bfe(q.m[n], e);
            *(LAS bf16*)(rec + R_VF + n * 512 + lv + e * 8) = f2bf(v);
            const unsigned gw = e < 2 ? q.g[n].x : q.g[n].y;
            *(LAS unsigned short*)(rec + R_GF + n * 512 + lv + e * 8) = (unsigned short)((e & 1) ? (gw >> 16) : gw); } }
    if (ckn >= 0) rw3_load(c, q, j, b, hd, ckn, 1);
    RwCoef cf;
#pragma unroll
    for (int n = 0; n < 4; ++n) { const f32x4 x0 = *(const LAS f32x4*)(scr + RW3_CF + (fq * 12 + n) * 16), x1 = *(const LAS f32x4*)(scr + RW3_CF + (fq * 12 + 4 + n) * 16), x2 = *(const LAS f32x4*)(scr + RW3_CF + (fq * 12 + 8 + n) * 16);
#pragma unroll
        for (int e = 0; e < 4; ++e) { cf.kk[n][e] = x0[e]; cf.ka[n][e] = x1[e]; cf.rk[n][e] = x2[e]; } }
    float ss = 0.f, bon = 0.f, P[4][4];
#pragma unroll
    for (int n = 0; n < 4; ++n)
#pragma unroll
        for (int e = 0; e < 4; ++e) { const float k = bfe(q.k[n], e), r = bfe(q.r[n], e), ag = bfe(q.a[n], e);
            const float kn = k * cf.kk[n][e]; ss += kn * kn;
            bon += r * (k * (1.f + (ag - 1.f) * cf.ka[n][e])) * cf.rk[n][e];
            P[n][e] = q.w[n][e]; }
    if (ckn >= 0) rw3_load(c, q, j, b, hd, ckn, 2);
    ss = fq_sum(ss); bon = fq_sum(bon);
    const float inv = __builtin_amdgcn_rsqf(fmaxf(ss, 1e-24f));
#pragma unroll
    for (int n = 0; n < 4; ++n)
#pragma unroll
        for (int e = 0; e < 4; ++e) { float x = P[n][e]; x = x * dpp_shr1<1>(x); x = x * dpp_shr1<2>(x); x = x * dpp_shr1<4>(x); x = x * dpp_shr1<8>(x); P[n][e] = x; }
    if (fq == 0) *(LAS float*)(rec + R_BON + t * 4) = bon;
    if (t == 15) {
#pragma unroll
        for (int n = 0; n < 4; ++n) *(LAS f32x4*)(rec + R_PL + (16 * n + 4 * fq) * 4) = (f32x4){P[n][0], P[n][1], P[n][2], P[n][3]}; }
    u32x4 afw[2], rfw[2], bfw[2], kfw[2];
#pragma unroll
    for (int kk = 0; kk < 2; ++kk) {
        float av[8], rv[8], bv[8], kv[8];
#pragma unroll
        for (int jj = 0; jj < 8; ++jj) { const int n = 2 * kk + (jj >> 2), e = jj & 3;
            const float k = bfe(q.k[n], e), r = bfe(q.r[n], e), ag = bfe(q.a[n], e);
            const float kn = k * cf.kk[n][e] * inv, km = k * (1.f + (ag - 1.f) * cf.ka[n][e]);
            const float Pn = P[n][e], Pm1 = dpp_shr1<1>(Pn), ip = rcpf_(Pn);
            av[jj] = -kn * Pm1; rv[jj] = r * Pn; bv[jj] = kn * ag * ip; kv[jj] = km * ip; }
        afw[kk] = (u32x4){pk2(av[0], av[1]), pk2(av[2], av[3]), pk2(av[4], av[5]), pk2(av[6], av[7])}; rfw[kk] = (u32x4){pk2(rv[0], rv[1]), pk2(rv[2], rv[3]), pk2(rv[4], rv[5]), pk2(rv[6], rv[7])};
        bfw[kk] = (u32x4){pk2(bv[0], bv[1]), pk2(bv[2], bv[3]), pk2(bv[4], bv[5]), pk2(bv[6], bv[7])}; kfw[kk] = (u32x4){pk2(kv[0], kv[1]), pk2(kv[2], kv[3]), pk2(kv[4], kv[5]), pk2(kv[6], kv[7])};
        *(LAS u32x4*)(rec + R_AF + (kk * 64 + lane) * 16) = afw[kk]; *(LAS u32x4*)(rec + R_RF + (kk * 64 + lane) * 16) = rfw[kk];
    }
    { const int lb = ((t >> 2) * 16 + 4 * fq) * 16 + (t & 3) * 2;
#pragma unroll
      for (int n = 0; n < 4; ++n)
#pragma unroll
        for (int e = 0; e < 4; ++e) { const int kk = n >> 1, jj = 4 * (n & 1) + e; const unsigned bw = bfw[kk][jj >> 1], kw = kfw[kk][jj >> 1];
            *(LAS unsigned short*)(rec + R_BKF + n * 1024 + lb + e * 16) = (unsigned short)((jj & 1) ? (bw >> 16) : bw);
            *(LAS unsigned short*)(rec + R_BKF + n * 1024 + lb + e * 16 + 8) = (unsigned short)((jj & 1) ? (kw >> 16) : kw);
        } }
    if (ckn >= 0) rw3_load(c, q, j, b, hd, ckn, 4);
    f32x4 Aab = (f32x4){0.f, 0.f, 0.f, 0.f}, Aak = Aab, Arb = Aab, Ark = Aab;
#pragma unroll
    for (int kk = 0; kk < 2; ++kk) {
        const bf16x8_t af = __builtin_bit_cast(bf16x8_t, afw[kk]), rf = __builtin_bit_cast(bf16x8_t, rfw[kk]), bf_ = __builtin_bit_cast(bf16x8_t, bfw[kk]), kf = __builtin_bit_cast(bf16x8_t, kfw[kk]);
        Aab = __builtin_amdgcn_mfma_f32_16x16x32_bf16(af, bf_, Aab, 0, 0, 0); Aak = __builtin_amdgcn_mfma_f32_16x16x32_bf16(af, kf, Aak, 0, 0, 0);
        Arb = __builtin_amdgcn_mfma_f32_16x16x32_bf16(rf, bf_, Arb, 0, 0, 0); Ark = __builtin_amdgcn_mfma_f32_16x16x32_bf16(rf, kf, Ark, 0, 0, 0); }
#pragma unroll
    for (int r = 0; r < 4; ++r) { const int t = 4 * fq + r;
        *(LAS float*)(scr + (t * 16 + fr) * 4) = t > fr ? Aab[r] : 0.f;
        *(LAS bf16*)(scr + 1024 + (t * 16 + fr) * 2) = f2bf(t > fr ? Aak[r] : 0.f);
        *(LAS bf16*)(scr + 1536 + (t * 16 + fr) * 2) = f2bf(t >= fr ? Arb[r] : 0.f);
        *(LAS bf16*)(scr + 2048 + (t * 16 + fr) * 2) = f2bf(t >= fr ? Ark[r] : 0.f); }
    LWAIT();
    float Tc[16];
#pragma unroll
    for (int t = 0; t < 16; ++t) {
        float acc = (t == fr) ? 1.f : 0.f, last = 0.f;
#pragma unroll
        for (int u4 = 0; u4 < (t + 3) / 4; ++u4) { const f32x4 ar = *(const LAS f32x4*)(scr + (t * 16 + 4 * u4) * 4);
#pragma unroll
            for (int e = 0; e < 4; ++e) { if (4 * u4 + e < t - 1) acc += ar[e] * Tc[4 * u4 + e]; if (4 * u4 + e == t - 1) last = ar[e]; } }
        Tc[t] = t > 0 ? acc + last * Tc[t > 0 ? t - 1 : 0] : acc; }
    if (fq == 0) {
#pragma unroll
        for (int t = 0; t < 16; ++t) *(LAS bf16*)(scr + 2560 + (t * 16 + fr) * 2) = f2bf(Tc[t]); }
    LWAIT();
    { const u32x2 ak = *(const LAS u32x2*)(scr + 1024 + (fr * 16 + 4 * fq) * 2), tt = *(const LAS u32x2*)(scr + 2560 + (fr * 16 + 4 * fq) * 2);
      const u32x2 rbv = *(const LAS u32x2*)(scr + 1536 + (fr * 16 + 4 * fq) * 2), rkv = *(const LAS u32x2*)(scr + 2048 + (fr * 16 + 4 * fq) * 2);
      *(LAS u32x4*)(rec + R_RECA + lane * 16) = (u32x4){ak.x, ak.y, tt.x, tt.y}; *(LAS u32x4*)(rec + R_RECB + lane * 16) = (u32x4){rbv.x, rbv.y, rkv.x, rkv.y}; }
    LWAIT();
}
DEVI void f_rwkv_chunked(const Ctx& c, const PArgs& a, int j, int b, int hd) {
    bf16* O = (bf16*)(c.ws + WS_O);
    const int w = c.wave, lane = c.lane, fr = lane & 15, fq = lane >> 4;
    constexpr int NCK = TP / 16, NGR = (NCK + 3) / 4;
    __syncthreads();
    if (w >= 4) {
        __builtin_amdgcn_s_setprio(PREP_PRIO);
        { LAS unsigned char* scr = c.lds + RW3_SCR + (w - 4) * RW3_SCRW;
          if (fr < 12) { const int n = fr & 3, which = fr >> 2; const size_t o = (size_t)j * D + hd * 64 + 16 * n + 4 * fq;
              const float* p0 = a.in[I_OKK]; const float* p1 = a.in[I_OKA]; const float* p2 = a.in[I_ORK];
              *(LAS f32x4*)(scr + RW3_CF + (fq * 12 + which * 4 + n) * 16) = *(const f32x4*)((which == 0 ? p0 : (which == 1 ? p1 : p2)) + o); }
          LWAIT(); }
        RwRaw q;
        rw3_load(c, q, j, b, hd, w - 4, 7);
        rw3_prep(c, j, b, hd, w, q, c.lds + RW3_RING + (w - 4) * RW3_REC, c.lds + RW3_SCR + (w - 4) * RW3_SCRW);
        __syncthreads();
#pragma unroll 1
        for (int g = 0; g < NGR; ++g) {
            const int ck = 4 * (g + 1) + (w - 4);
            if (ck < NCK) rw3_prep(c, j, b, hd, ck + 4 < NCK ? ck + 4 : -1, q, c.lds + RW3_RING + (((g + 1) & 1) * 4 + (w - 4)) * RW3_REC, c.lds + RW3_SCR + (w - 4) * RW3_SCRW);
            __syncthreads();
        }
    __builtin_amdgcn_s_setprio(0);
    } else {
        __builtin_amdgcn_s_setprio(CHAIN_PRIO);
        f32x4 G[4];
#pragma unroll
        for (int jb = 0; jb < 4; ++jb) G[jb] = (f32x4){0.f, 0.f, 0.f, 0.f};
        const int ch = hd * 64 + 16 * w + fr;
        const float gng = a.in[I_OGNG][(size_t)j * D + ch], gnb = a.in[I_OGNB][(size_t)j * D + ch];
        __syncthreads();
#pragma unroll 1
        for (int g = 0; g < NGR; ++g) {
            const int nck = (NCK - 4 * g) < 4 ? (NCK - 4 * g) : 4;
            f32x4 yk[4]; u32x2 vk[4], gk[4]; f32x4 bk[4];
            LAS float* stat = (LAS float*)(c.lds + RW3_STAT + (g & 1) * 2048);
#pragma unroll
            for (int q = 0; q < 4; ++q) {
                if (q < nck) {
                    const LAS unsigned char* rec = c.lds + RW3_RING + ((g & 1) * 4 + q) * RW3_REC;
                    bf16x8_t gb[2];
#pragma unroll
                    for (int kk = 0; kk < 2; ++kk) { u32x4 t; t.x = pk2(G[2 * kk][0], G[2 * kk][1]); t.y = pk2(G[2 * kk][2], G[2 * kk][3]); t.z = pk2(G[2 * kk + 1][0], G[2 * kk + 1][1]); t.w = pk2(G[2 * kk + 1][2], G[2 * kk + 1][3]); gb[kk] = __builtin_bit_cast(bf16x8_t, t); }
                    const u32x2 vf = *(const LAS u32x2*)(rec + R_VF + (w * 64 + lane) * 8); const u32x4 ra = *(const LAS u32x4*)(rec + R_RECA + lane * 16);
                    vk[q] = vf; gk[q] = *(const LAS u32x2*)(rec + R_GF + (w * 64 + lane) * 8); bk[q] = *(const LAS f32x4*)(rec + R_BON + 16 * fq);
                    const u32x2 z2 = (u32x2){0u, 0u};
                    f32x4 W = __builtin_amdgcn_mfma_f32_16x16x32_bf16(__builtin_bit_cast(bf16x8_t, ra), frag_lohi(vf, z2), (f32x4){0.f, 0.f, 0.f, 0.f}, 0, 0, 0);
                    W = __builtin_amdgcn_mfma_f32_16x16x32_bf16(*(const LAS bf16x8_t*)(rec + R_AF + lane * 16), gb[0], W, 0, 0, 0);
                    W = __builtin_amdgcn_mfma_f32_16x16x32_bf16(*(const LAS bf16x8_t*)(rec + R_AF + (64 + lane) * 16), gb[1], W, 0, 0, 0);
                    const u32x2 wlo = (u32x2){pk2(W[0], W[1]), pk2(W[2], W[3])};
                    const f32x4 U = __builtin_amdgcn_mfma_f32_16x16x32_bf16(frag_lohi((u32x2){ra.z, ra.w}, (u32x2){ra.x, ra.y}), frag_lohi(wlo, z2), (f32x4){0.f, 0.f, 0.f, 0.f}, 0, 0, 0);
                    const bf16x8_t ub = frag_lohi((u32x2){pk2(U[0], U[1]), pk2(U[2], U[3])}, vf);
                    f32x4 Y = __builtin_amdgcn_mfma_f32_16x16x32_bf16(*(const LAS bf16x8_t*)(rec + R_RF + lane * 16), gb[0], (f32x4){0.f, 0.f, 0.f, 0.f}, 0, 0, 0);
                    Y = __builtin_amdgcn_mfma_f32_16x16x32_bf16(*(const LAS bf16x8_t*)(rec + R_RF + (64 + lane) * 16), gb[1], Y, 0, 0, 0);
                    Y = __builtin_amdgcn_mfma_f32_16x16x32_bf16(*(const LAS bf16x8_t*)(rec + R_RECB + lane * 16), ub, Y, 0, 0, 0);
#pragma unroll
                    for (int jb = 0; jb < 4; ++jb) { G[jb] = __builtin_amdgcn_mfma_f32_16x16x32_bf16(*(const LAS bf16x8_t*)(rec + R_BKF + (jb * 64 + lane) * 16), ub, G[jb], 0, 0, 0);
                        G[jb] = G[jb] * *(const LAS f32x4*)(rec + R_PL + (16 * jb + 4 * fq) * 4); }
                    yk[q] = Y;
#pragma unroll
                    for (int r = 0; r < 4; ++r) { const float s1 = red16(Y[r]), s2 = red16(Y[r] * Y[r]); if (fr == 0) *(LAS f32x2_t*)(stat + ((q * 4 + w) * 16 + 4 * fq + r) * 2) = (f32x2_t){s1, s2}; }
                }
            }
            __syncthreads();
#pragma unroll
            for (int q = 0; q < 4; ++q) {
                if (q < nck) {
#pragma unroll
                    for (int r = 0; r < 4; ++r) { const int t = 4 * fq + r; float s1 = 0.f, s2 = 0.f;
#pragma unroll
                        for (int ww = 0; ww < 4; ++ww) { const f32x2_t sv = *(const LAS f32x2_t*)(stat + ((q * 4 + ww) * 16 + t) * 2); s1 += sv.x; s2 += sv.y; }
                        const float mu = s1 * (1.f / 64.f), var = fmaxf(s2 * (1.f / 64.f) - mu * mu, 0.f), rs = __builtin_amdgcn_rsqf(var + 64e-5f);
                        const unsigned vb_ = r < 2 ? vk[q].x : vk[q].y, gb_ = r < 2 ? gk[q].x : gk[q].y;
                        const float v = (r & 1) ? __uint_as_float(vb_ & 0xffff0000u) : __uint_as_float(vb_ << 16), gt = (r & 1) ? __uint_as_float(gb_ & 0xffff0000u) : __uint_as_float(gb_ << 16);
                        const float o = ((yk[q][r] - mu) * rs * gng + gnb + bk[q][r] * v) * gt;
                        O[(size_t)(b * TP + (4 * g + q) * 16 + t) * D + ch] = f2bf(o); }
                }
            }
        }
        float* So = c.out + O_RWKVP + ((size_t)(j * BP + b) * 16 + hd) * 4096 + (size_t)(16 * w + fr) * 64 + 4 * fq;
#pragma unroll
        for (int jb = 0; jb < 4; ++jb) *(f32x4*)(So + 16 * jb) = G[jb];
        __builtin_amdgcn_s_setprio(0);
    }
    __syncthreads();
}
#ifndef SSB
#define SSB 160
#endif
#ifndef SCAN_PART
#define SCAN_PART 3
#endif
DEVI void f_odd_scan3(const Ctx& c, const PArgs& a, int li, int part) {
    const int j = li >> 1;
    if (c.bid < 128) { if (part & 1) f_rwkv_chunked(c, a, j, c.bid >> 4, c.bid & 15); }
    else if ((part & 2) && c.bid >= SSB) for (int u = c.bid - SSB; u < 2048; u += c.G - SSB) f_rwkv_sample(c, a, j, u >> 4, u & 15);
}

template <int CTRL> DEVI float dppz(float x) { return __builtin_bit_cast(float, __builtin_amdgcn_update_dpp(0, __builtin_bit_cast(int, x), CTRL, 0xF, 0xF, true)); }
struct EpiUpAct {
    static constexpr bool PERM = true;
    bf16* U; bf16* ACT; const float* RS; const float* CW; const float* CB; float* FCP;
    DEVI void operator()(const f32x4 (&acc)[2][2][4][2], const pg8::Unit& u, int wr, int wc, int fr, int fq) const {
        const int f0 = u.pn * 128 + wc * 32 + fq * 8;
        f32x4 w0[2], w1[2], w2[2], cb[2];
#pragma unroll
        for (int n = 0; n < 2; ++n) { w0[n] = *(const f32x4*)(CW + f0 + 4 * n); w1[n] = *(const f32x4*)(CW + DFF + f0 + 4 * n); w2[n] = *(const f32x4*)(CW + 2 * DFF + f0 + 4 * n); cb[n] = *(const f32x4*)(CB + f0 + 4 * n); }
        float rsv[2][4];
        { f32x4 rq[2][4];
#pragma unroll
          for (int ai = 0; ai < 2; ++ai)
#pragma unroll
            for (int m = 0; m < 4; ++m) rq[ai][m] = *(const f32x4*)(RS + (size_t)(u.pm * 256 + ai * 128 + wr * 64 + m * 16 + fr) * 16 + 4 * fq);
          asm volatile("" ::: "memory");
#pragma unroll
          for (int ai = 0; ai < 2; ++ai)
#pragma unroll
            for (int m = 0; m < 4; ++m) rsv[ai][m] = row_rstd_fin(rq[ai][m]); }
#pragma unroll
        for (int ai = 0; ai < 2; ++ai) {
            const int rowg = u.pm * 256 + ai * 128 + wr * 64;
            const bool sample = rowg >= MP;
            f32x4 ug[4][2];
            float rs[4];
#pragma unroll
            for (int m = 0; m < 4; ++m) { rs[m] = rsv[ai][m]; ug[m][0] = acc[ai][0][m][0] * rs[m]; ug[m][1] = acc[ai][0][m][1] * rs[m]; }
#pragma unroll
            for (int m = 3; m >= 0; --m) {
                const int row = rowg + m * 16 + fr; const int tt = sample ? 16 : (rowg + m * 16) % TP;
                const f32x4 uv0 = acc[ai][1][m][0] * rs[m], uv1 = acc[ai][1][m][1] * rs[m];
                f32x4 p1[2], p2[2];
#pragma unroll
                for (int n = 0; n < 2; ++n)
#pragma unroll
                    for (int e = 0; e < 4; ++e) {
                        const float cur = ug[m][n][e];
                        float q1 = dppz<0x111>(cur), q2 = dppz<0x112>(cur);
                        if (m > 0) { const float prv = ug[m > 0 ? m - 1 : 0][n][e]; q1 += dppz<0x10F>(prv); q2 += dppz<0x10E>(prv); }
                        p1[n][e] = q1; p2[n][e] = q2;
                        if (tt == 0) { if (fr == 0) p1[n][e] = 0.f; if (fr < 2) p2[n][e] = 0.f; } }
                const bool pending = sample || (m == 0 && fr < 2);
                if (pending || (m == 3 && fr >= 14)) *(u32x4*)(U + (size_t)row * NUP + f0) = pack8(ug[m][0], ug[m][1]);
                if (pending) *(u32x4*)(U + (size_t)row * NUP + DFF + f0) = pack8(uv0, uv1);
                else {
                    f32x4 o0, o1;
#pragma unroll
                    for (int e = 0; e < 4; ++e) { o0[e] = geluf_(cb[0][e] + w2[0][e] * ug[m][0][e] + w1[0][e] * p1[0][e] + w0[0][e] * p2[0][e]) * uv0[e];
                        o1[e] = geluf_(cb[1][e] + w2[1][e] * ug[m][1][e] + w1[1][e] * p1[1][e] + w0[1][e] * p2[1][e]) * uv1[e]; }
                    *(u32x4*)(ACT + (size_t)row * DFF + f0) = pack8(o0, o1);
                    if (tt == TP - 16 && fr >= 14) { float* so = FCP + ((size_t)(row / TP) * 2 + (fr - 14)) * DFF + f0; *(f32x4*)so = ug[m][0]; *(f32x4*)(so + 4) = ug[m][1]; }
                }
            }
        }
    }
};
DEVI void f_ffn_up_act(const Ctx& c, const PArgs& a, int li) {
    pg8::Gemm g{(const bf16*)(c.ws + WS_XB), (const bf16*)(c.ws + WS_WB + WB_WUP + li * SZ_WUP), M, NUP, D, D, 0ull, 0};
    pg8::StaticOrder S; S.init(M, NUP, c.G, c.bid);
    EpiUpAct E{(bf16*)(c.ws + WS_U), (bf16*)(c.ws + WS_ACT), (const float*)(c.ws + WS_RS), a.in[I_FCW] + (size_t)li * 3 * DFF, a.in[I_FCB] + (size_t)li * DFF, c.out + O_FCONVP + (size_t)li * BP * 2 * DFF};
    pg8::gemm_phase<EpiUpAct>(c.lds, c.tid, g, S, E);
}
DEVI void f_ffn_fix(const Ctx& c, const PArgs& a, int li) {
    const bf16* U = (const bf16*)(c.ws + WS_U); bf16* ACT = (bf16*)(c.ws + WS_ACT);
    const float* CW = a.in[I_FCW] + (size_t)li * 3 * DFF; const float* CB = a.in[I_FCB] + (size_t)li * DFF;
    constexpr int NPC = DFF / 8, NROW = (MP / 64) * 2 + BS, NITEM = NPC * NROW;
    for (int it = c.bid * NT + c.tid; it < NITEM; it += c.G * NT) {
        const int ri = it / NPC, pc = it - ri * NPC, col = pc * 8;
        const int row = ri < (MP / 64) * 2 ? (ri >> 1) * 64 + (ri & 1) : MP + (ri - (MP / 64) * 2);
        const u32x4 ug = *(const u32x4*)(U + (size_t)row * NUP + col), uv = *(const u32x4*)(U + (size_t)row * NUP + DFF + col);
        float f1[8], f2[8];
        if (row < MP) { const int t = row % TP; u32x4 p1 = (u32x4){0u, 0u, 0u, 0u}, p2 = p1;
            if (t >= 1) p1 = *(const u32x4*)(U + (size_t)(row - 1) * NUP + col); if (t >= 2) p2 = *(const u32x4*)(U + (size_t)(row - 2) * NUP + col);
#pragma unroll
            for (int e = 0; e < 4; ++e) { f1[2 * e] = __uint_as_float(p1[e] << 16); f1[2 * e + 1] = __uint_as_float(p1[e] & 0xffff0000u); f2[2 * e] = __uint_as_float(p2[e] << 16); f2[2 * e + 1] = __uint_as_float(p2[e] & 0xffff0000u); }
        } else { const float* st = a.in[I_SFCONV] + (size_t)(li * BS + row - MP) * 2 * DFF + col; float* so = c.out + O_FCONVS + (size_t)(li * BS + row - MP) * 2 * DFF + col;
#pragma unroll
            for (int h = 0; h < 2; ++h) { const f32x4 s2 = *(const f32x4*)(st + 4 * h), s1 = *(const f32x4*)(st + DFF + 4 * h); *(f32x4*)(so + 4 * h) = s1;
#pragma unroll
                for (int e = 0; e < 4; ++e) { f2[4 * h + e] = s2[e]; f1[4 * h + e] = s1[e]; } }
#pragma unroll
            for (int e = 0; e < 4; ++e) { so[DFF + 2 * e] = __uint_as_float(ug[e] << 16); so[DFF + 2 * e + 1] = __uint_as_float(ug[e] & 0xffff0000u); } }
        u32x4 o;
#pragma unroll
        for (int e = 0; e < 4; ++e) { const float u0a = __uint_as_float(ug[e] << 16), u0b = __uint_as_float(ug[e] & 0xffff0000u);
            const float ca = CB[col + 2 * e] + CW[2 * DFF + col + 2 * e] * u0a + CW[DFF + col + 2 * e] * f1[2 * e] + CW[col + 2 * e] * f2[2 * e];
            const float cv = CB[col + 2 * e + 1] + CW[2 * DFF + col + 2 * e + 1] * u0b + CW[DFF + col + 2 * e + 1] * f1[2 * e + 1] + CW[col + 2 * e + 1] * f2[2 * e + 1];
            o[e] = pk2(geluf_(ca) * __uint_as_float(uv[e] << 16), geluf_(cv) * __uint_as_float(uv[e] & 0xffff0000u)); }
        *(u32x4*)(ACT + (size_t)row * DFF + col) = o;
    }
}

DEVI void f_odd_norm(const Ctx& c, const PArgs& a, int li) {
    const int j = li >> 1;
    const bf16* XB = (const bf16*)(c.ws + WS_XB); const float* RS = (const float*)(c.ws + WS_RS); bf16* XM = (bf16*)(c.ws + WS_XMIX);
    const float* gain = a.in[I_NMIX] + (size_t)li * D; const float* mix = a.in[I_OMIX] + (size_t)j * 6 * D;
    const int gw = c.bid * NWAVES + c.wave, NGW = c.G * NWAVES;
    const int r0 = (int)(((long)gw * M) / NGW), r1 = (int)(((long)(gw + 1) * M) / NGW);
    f32x4 gv[4], mv[6][4];
#pragma unroll
    for (int q = 0; q < 4; ++q) { const int col = q * 256 + c.lane * 4; gv[q] = *(const f32x4*)(gain + col);
#pragma unroll
        for (int n = 0; n < 6; ++n) mv[n][q] = *(const f32x4*)(mix + (size_t)n * D + col); }
    f32x4 hprev[4];
#pragma unroll
    for (int q = 0; q < 4; ++q) hprev[q] = (f32x4){0.f, 0.f, 0.f, 0.f};
    for (int row = r0; row < r1; ++row) {
        const float rs = row_rstd(RS, row);
        const bool prompt = row < MP; const int b = prompt ? row / TP : row - MP, t = prompt ? row % TP : 0;
        const bool need_prev = prompt && t > 0 && row == r0;
        const float rsp = need_prev ? row_rstd(RS, row - 1) : 0.f;
#pragma unroll
        for (int q = 0; q < 4; ++q) { const int col = q * 256 + c.lane * 4;
            const u32x2 xw_ = *(const u32x2*)(XB + (size_t)row * D + col);
            const f32x4 h = (f32x4){__uint_as_float(xw_.x << 16), __uint_as_float(xw_.x & 0xffff0000u), __uint_as_float(xw_.y << 16), __uint_as_float(xw_.y & 0xffff0000u)} * rs * gv[q];
            f32x4 hp = hprev[q];
            if (!prompt) hp = *(const f32x4*)(a.in[I_SSHIFT] + (size_t)(j * BS + b) * D + col);
            else if (t == 0) hp = (f32x4){0.f, 0.f, 0.f, 0.f};
            else if (need_prev) { const u32x2 pw_ = *(const u32x2*)(XB + (size_t)(row - 1) * D + col);
                hp = (f32x4){__uint_as_float(pw_.x << 16), __uint_as_float(pw_.x & 0xffff0000u), __uint_as_float(pw_.y << 16), __uint_as_float(pw_.y & 0xffff0000u)} * rsp * gv[q]; }
            const f32x4 xx = hp - h;
#pragma unroll
            for (int n = 0; n < 6; ++n) { const f32x4 o = h + xx * mv[n][q]; u32x2 w; w.x = pk2(o.x, o.y); w.y = pk2(o.z, o.w); *(u32x2*)(XM + ((size_t)n * M + row) * D + col) = w; }
            if (prompt) { if (t == TP - 1) *(f32x4*)(c.out + O_SHIFTP + (size_t)(j * BP + b) * D + col) = h; }
            else *(f32x4*)(c.out + O_SHIFTS + (size_t)(j * BS + b) * D + col) = h;
            hprev[q] = h; }
    }
}

DEVI void f_tail_residual(const Ctx& c, const bf16* A, int lda, const bf16* Bt, int K, bool wxb) {
    float* X = (float*)(c.ws + WS_X); bf16* XB = (bf16*)(c.ws + WS_XB); float* RS = (float*)(c.ws + WS_RS);
    LAS float* red = (LAS float*)c.lds;
    const int fr = c.lane & 15, fq = c.lane >> 4, nks = K / 32;
    for (int task = c.bid; task < 256; task += c.G) {
        const int row0 = M_MAIN + (task >> 4) * 16, col0 = (task & 15) * 64;
        const bf16* ap = A + (size_t)(row0 + fr) * lda + 8 * fq; const bf16* bp = Bt + (size_t)(col0 + fr) * K + 8 * fq;
        f32x4 acc[4];
#pragma unroll
        for (int nb = 0; nb < 4; ++nb) acc[nb] = (f32x4){0.f, 0.f, 0.f, 0.f};
#pragma unroll 1
        for (int ks0 = c.wave; ks0 < nks; ks0 += 32) {
            bf16x8_t af[4], bf_[4][4];
#pragma unroll
            for (int u = 0; u < 4; ++u) { const int ks = ks0 + 8 * u; const bool ok = ks < nks; const unsigned ko = (unsigned)(32 * (ok ? ks : 0));
                af[u] = *(const bf16x8_t*)(ap + ko);
#pragma unroll
                for (int nb = 0; nb < 4; ++nb) bf_[u][nb] = *(const bf16x8_t*)(bp + (unsigned)(16 * nb * K) + ko);
                if (!ok) af[u] = (bf16x8_t){0, 0, 0, 0, 0, 0, 0, 0}; }
#pragma unroll
            for (int u = 0; u < 4; ++u)
#pragma unroll
                for (int nb = 0; nb < 4; ++nb) acc[nb] = __builtin_amdgcn_mfma_f32_16x16x32_bf16(af[u], bf_[u][nb], acc[nb], 0, 0, 0);
        }
        __syncthreads();
#pragma unroll
        for (int nb = 0; nb < 4; ++nb)
#pragma unroll
            for (int r = 0; r < 4; ++r) red[(c.wave * 16 + 4 * fq + r) * 64 + 16 * nb + fr] = acc[nb][r];
        __syncthreads();
        { const int r = c.tid >> 5, cc = 2 * (c.tid & 31); float v0 = 0.f, v1 = 0.f;
#pragma unroll
          for (int w = 0; w < 8; ++w) { const f32x2_t t = *(const LAS f32x2_t*)(red + (w * 16 + r) * 64 + cc); v0 += t.x; v1 += t.y; }
          const size_t o = (size_t)(row0 + r) * D + col0 + cc;
          const unsigned xo = *(const unsigned*)(XB + o); v0 += __uint_as_float(xo << 16); v1 += __uint_as_float(xo & 0xffff0000u);
          (void)wxb; (void)X; *(unsigned*)(XB + o) = pk2(v0, v1);
          const float ss = red32(v0 * v0 + v1 * v1);
          if ((c.tid & 31) == 0) RS[(size_t)(row0 + r) * 16 + (task & 15)] = ss; }
    }
    __syncthreads();
}

__global__ void __launch_bounds__(NT, 2) hybrid_fwd(Args args) {
    extern __shared__ __attribute__((aligned(16))) unsigned char lds_raw[];
    Ctx c;
    c.lds = (LAS unsigned char*)lds_raw;
    c.tid = threadIdx.x; c.lane = c.tid & 63; c.wave = __builtin_amdgcn_readfirstlane(c.tid >> 6);
    c.G = gridDim.x; c.bid = blockIdx.x; c.ws = args.ws; c.out = args.out;
    volatile LAS unsigned* MISC = (volatile LAS unsigned*)(c.lds + MISC_OFF);
    for (int u = c.tid; u < (LDS_BYTES - LDSCTL_OFF) / 4; u += NT) ((LAS unsigned*)(c.lds + LDSCTL_OFF))[u] = 0u;
    __syncthreads();
    if (c.tid < N_IN) ((LAS unsigned long long*)(c.lds + PTAB_OFF))[c.tid] = (unsigned long long)args.in[c.tid];
    __syncthreads();
    PArgs pa; pa.in.t = (const LAS unsigned long long*)(c.lds + PTAB_OFF);
    (void)xcd_barrier_post((unsigned*)(c.ws + WS_CTL) + 4096, MISC + 8);
#define GRID_BAR() do { XcdBarrier bar_; bar_.bar = (unsigned*)(c.ws + WS_CTL) + 4096; bar_.x = xb_xcc_id(); bar_.st = (volatile LAS unsigned*)(c.lds + MISC_OFF) + 8; xcd_barrier(bar_); } while (0)
#define RETID() do { asm volatile("" : "+s"(c.wave), "+s"(c.bid), "+s"(c.G)); asm volatile("v_mbcnt_lo_u32_b32 %0, -1, 0\n\tv_mbcnt_hi_u32_b32 %0, -1, %0" : "=v"(c.lane)); c.tid = c.wave * 64 + c.lane; } while (0)
#define PHASE(body) do { RETID(); body; GRID_BAR(); } while (0)
    for (int rep = 0; rep < REP_PRO; ++rep) PHASE({ n_prologue(c, pa); f_wprep(c, pa, 1ull, c.bid * NWAVES + c.wave, c.G * NWAVES); });
#pragma unroll 1
    for (int li = 0; li < 4; ++li) {
        const int j = li >> 1;
        if ((li & 1) == 0) {
#if FAST & 1
            for (int rep = 0; rep < REP_G; ++rep) PHASE(f_even_in(c, li));
#else
            PHASE(n_even_in(c, pa, li));
#endif
#if FAST & 32
            for (int rep = 0; rep < REP_MIX; ++rep) PHASE(f_even_mix(c, pa, li, rep == 0 ? 7 : MIX_PART));
#else
            PHASE(n_even_mix(c, pa, li));
#endif
#if FAST & 2
            PHASE({ f_gemm_residual(c, (const bf16*)(c.ws + WS_MIX), 2048, (const bf16*)(c.ws + WS_WB + WB_WOUT + j * SZ_WOUT), 2048, true); RETID(); f_tail_residual(c, (const bf16*)(c.ws + WS_MIX), 2048, (const bf16*)(c.ws + WS_WB + WB_WOUT + j * SZ_WOUT), 2048, true); });
#else
            PHASE(n_gemm_residual(c, (const bf16*)(c.ws + WS_MIX), 2048, pa.in[I_EWOUT] + (size_t)j * 2048 * D, 2048, true));
#endif
        } else {
            for (int rep = 0; rep < REP_NORM; ++rep) PHASE(f_odd_norm(c, pa, li));
#if FAST & 8
            for (int rep = 0; rep < REP_G; ++rep) PHASE(f_odd_in(c, li));
#else
            PHASE(n_odd_in(c, pa, li));
#endif
#if FAST & 16
            for (int rep = 0; rep < REP_G; ++rep) PHASE(f_odd_lora(c, pa, li));
#else
            PHASE(n_odd_lora(c, pa, li));
#endif
#if FAST & 128
#if FAST & 512
            for (int rep = 0; rep < REP_SCAN; ++rep) PHASE(f_odd_scan3(c, pa, li, rep == 0 ? 3 : SCAN_PART));
#elif FAST & 256
            for (int rep = 0; rep < REP_SCAN; ++rep) { PHASE(f_odd_scan2(c, pa, li)); PHASE(f_rwkv_post(c, pa, li)); }
#else
            for (int rep = 0; rep < REP_SCAN; ++rep) PHASE(f_odd_scan(c, pa, li));
#endif
#else
            for (int rep = 0; rep < REP_SCAN; ++rep) PHASE(n_odd_scan(c, pa, li));
#endif
#if FAST & 2
            PHASE({ f_gemm_residual(c, (const bf16*)(c.ws + WS_O), D, (const bf16*)(c.ws + WS_WB + WB_WO + j * SZ_WO), D, true); RETID(); f_tail_residual(c, (const bf16*)(c.ws + WS_O), D, (const bf16*)(c.ws + WS_WB + WB_WO + j * SZ_WO), D, true); });
#else
            PHASE(n_gemm_residual(c, (const bf16*)(c.ws + WS_O), D, pa.in[I_OWO] + (size_t)j * D * D, D, true));
#endif
        }
#if FUSE_ACT
        for (int rep = 0; rep < REP_G; ++rep) PHASE(f_ffn_up_act(c, pa, li));
        PHASE(f_ffn_fix(c, pa, li));
#else
#if FAST & 4
        for (int rep = 0; rep < REP_G; ++rep) PHASE(f_ffn_up(c, li));
#else
        PHASE(n_ffn_up(c, pa, li));
#endif
#if FAST & 64
        for (int rep = 0; rep < REP_ACT; ++rep) PHASE(f_ffn_act(c, pa, li));
#else
        for (int rep = 0; rep < REP_ACT; ++rep) PHASE(n_ffn_act(c, pa, li));
#endif
#endif
#if FAST & 2
        PHASE({ f_gemm_residual(c, (const bf16*)(c.ws + WS_ACT), DFF, (const bf16*)(c.ws + WS_WB + WB_WDN + li * SZ_WDN), DFF, li == 1); RETID(); f_tail_residual(c, (const bf16*)(c.ws + WS_ACT), DFF, (const bf16*)(c.ws + WS_WB + WB_WDN + li * SZ_WDN), DFF, li == 1);   });
#else
        PHASE(n_gemm_residual(c, (const bf16*)(c.ws + WS_ACT), DFF, pa.in[I_FWDN] + (size_t)li * DFF * D, DFF, true));
#endif
    }
    RETID(); n_final(c, pa);
#undef PHASE
}

extern "C" void kernel_launch(void* const* d_in, const int* in_sizes, int n_in, void* d_out, int out_size, void* d_ws, size_t ws_size, hipStream_t stream) {
    static int grid = 0;
    if (grid == 0) {
        if (n_in != N_IN || (size_t)out_size != O_END || ws_size < WS_END) {
            fprintf(stderr, "kernel_launch: unexpected shapes: n_in %d (want %d), out %d (want %zu), ws %zu (want >= %zu)\n", n_in, (int)N_IN, out_size, (size_t)O_END, ws_size, (size_t)WS_END);
            grid = -1; return; }
        int dev = 0, cus = 0;
        if (hipGetDevice(&dev) != hipSuccess || hipDeviceGetAttribute(&cus, hipDeviceAttributeMultiprocessorCount, dev) != hipSuccess) { grid = -1; return; }
        if (hipFuncSetAttribute((const void*)hybrid_fwd, hipFuncAttributeMaxDynamicSharedMemorySize, LDS_BYTES) != hipSuccess) { fprintf(stderr, "kernel_launch: hipFuncSetAttribute failed\n"); grid = -1; return; }
        int per_cu = 0;
        (void)hipOccupancyMaxActiveBlocksPerMultiprocessor(&per_cu, (const void*)hybrid_fwd, NT, LDS_BYTES);
        (void)hipGetLastError();
        grid = cus;
    }
    if (grid < 0) return;
    if (hipMemsetAsync((char*)d_ws + WS_CTL, 0, CTL_ZERO_BYTES, stream) != hipSuccess) return;
    Args a{};
    for (int i = 0; i < N_IN; ++i) a.in[i] = (const float*)d_in[i];
    a.out = (float*)d_out; a.ws = (unsigned char*)d_ws;
    hipLaunchKernelGGL(hybrid_fwd, dim3(grid), dim3(NT), LDS_BYTES, stream, a);
}
```

```cpp
#include <hip/hip_runtime.h>
#include <cstdio>
#include <cstdint>

#define GAS __attribute__((address_space(1)))
#define LAS __attribute__((address_space(3)))
#define DEVI __device__ __forceinline__
typedef unsigned short bf16;
typedef float f32x4 __attribute__((ext_vector_type(4)));
typedef unsigned u32x2 __attribute__((ext_vector_type(2)));
typedef float f32x2_t __attribute__((ext_vector_type(2)));
typedef unsigned u32x4 __attribute__((ext_vector_type(4)));

#ifndef FAST
#define FAST 1023
#endif
#ifndef REP_SCAN
#define REP_SCAN 1
#endif
#ifndef REP_ACT
#define REP_ACT 1
#endif
#ifndef REP_MIX
#define REP_MIX 1
#endif
#ifndef REP_PRO
#define REP_PRO 1
#endif
#ifndef FUSE_ACT
#define FUSE_ACT 1
#endif
#ifndef REP_G
#define REP_G 1
#endif
#ifndef REP_NORM
#define REP_NORM 1
#endif
constexpr int D = 1024, TP = 2064, NMETA = 16, SEQ = 2048, BP = 8, BS = 128;
constexpr int MP = BP * TP;
constexpr int M = MP + BS;
constexpr int NIN = 5120, DFF = 2816, NUP = 2 * DFF;
constexpr int M_MAIN = 16384;
constexpr int LML = 640;
constexpr int NWAVES = 8, NT = NWAVES * 64;

constexpr size_t MiB = 1u << 20;
constexpr size_t WS_CTL = 0, CTL_ZERO_BYTES = 1 * MiB;
constexpr size_t WS_RS = 1 * MiB;
constexpr size_t WS_ROPE = 3 * MiB;
constexpr size_t WS_WB = 5 * MiB;
constexpr size_t WS_X = 124 * MiB;
constexpr size_t WS_R = 124 * MiB;
constexpr size_t WS_XB = 189 * MiB;
constexpr size_t WS_BIG = 222 * MiB;
constexpr size_t SZ_ACT1 = (size_t)M * D * 2;
constexpr size_t WS_Z = WS_BIG, WS_MIX = WS_BIG + 163 * MiB;
constexpr size_t WS_U = WS_BIG, WS_ACT = WS_BIG + 179 * MiB;
constexpr size_t WS_XMIX = WS_BIG, WS_K = WS_BIG + 195 * MiB, WS_V = WS_BIG + 228 * MiB;
constexpr size_t WS_WDEC = WS_BIG, WS_AG = WS_BIG + 65 * MiB, WS_GG = WS_AG + SZ_ACT1, WS_VG = WS_GG + SZ_ACT1, WS_O = WS_VG + SZ_ACT1;
constexpr size_t WS_END = WS_BIG + 270 * MiB;
static_assert(WS_O + SZ_ACT1 <= WS_K && WS_ACT + (size_t)M * DFF * 2 <= WS_END && WS_V + SZ_ACT1 <= WS_END && WS_MIX + (size_t)M * 2048 * 2 <= WS_END, "ws map");
constexpr size_t DO_VFIRST = 0, DO_LMID = 33 * MiB;
static_assert(DO_LMID + (size_t)M * LML * 2 <= (size_t)BP * SEQ * D * 4, "d_out scratch");

constexpr size_t O_YP = 0, O_YS = O_YP + (size_t)BP * SEQ * D, O_RETP = O_YS + (size_t)BS * D, O_LRUP = O_RETP + (size_t)2 * BP * 4 * 128 * 256,
    O_LCONVP = O_LRUP + (size_t)2 * BP * 1024, O_RWKVP = O_LCONVP + (size_t)2 * BP * 3 * 1024, O_SHIFTP = O_RWKVP + (size_t)2 * BP * 16 * 64 * 64,
    O_FCONVP = O_SHIFTP + (size_t)2 * BP * 1024, O_RETS = O_FCONVP + (size_t)4 * BP * 2 * DFF, O_LRUS = O_RETS + (size_t)2 * BS * 4 * 128 * 256,
    O_LCONVS = O_LRUS + (size_t)2 * BS * 1024, O_RWKVS = O_LCONVS + (size_t)2 * BS * 3 * 1024, O_SHIFTS = O_RWKVS + (size_t)2 * BS * 16 * 64 * 64,
    O_FCONVS = O_SHIFTS + (size_t)2 * BS * 1024, O_END = O_FCONVS + (size_t)4 * BS * 2 * DFF;

enum { I_XP = 0, I_XS, I_SRET, I_SLRU, I_SLCONV, I_SRWKV, I_SSHIFT, I_SFCONV, I_META, I_NMIX, I_NFFN, I_NFIN,
       I_EWIN, I_ERGN, I_ECW, I_ECB, I_EWA, I_EBA, I_EWX, I_EBX, I_ELAM, I_EWOUT,
       I_OMIX, I_OWR, I_OWK, I_OWV, I_OW0, I_OW1, I_OW2, I_OA0, I_OA1, I_OA2, I_OV0, I_OV1, I_OV2, I_OG1, I_OG2, I_OKK, I_OKA, I_ORK, I_OGNG, I_OGNB, I_OWO,
       I_FWUP, I_FCW, I_FCB, I_FWDN, N_IN };

constexpr int RING_BYTES = 143360, LDSCTL_OFF = RING_BYTES, MISC_OFF = LDSCTL_OFF + 320, LDS_BYTES = 147456;

DEVI float bf2f(bf16 v) { return __uint_as_float((unsigned)v << 16); }
typedef __bf16 hbf16x2_t __attribute__((ext_vector_type(2)));
DEVI unsigned pk2(float lo, float hi) { const f32x2_t v = (f32x2_t){lo, hi}; return __builtin_bit_cast(unsigned, __builtin_convertvector(v, hbf16x2_t)); }
DEVI bf16 f2bf(float f) { return (bf16)(pk2(f, f) & 0xffffu); }
DEVI float wave_sum(float v) {
#pragma unroll
    for (int o = 1; o < 64; o <<= 1) v += __shfl_xor(v, o);
    return v;
}
DEVI float rcpf_(float x) { return __builtin_amdgcn_rcpf(x); }
DEVI float sigmoidf_(float x) { return rcpf_(1.f + __expf(-x)); }
DEVI float siluf_(float x) { return x * rcpf_(1.f + __expf(-x)); }
DEVI float tanhf_(float x) { return 2.f * rcpf_(1.f + __expf(-2.f * x)) - 1.f; }
DEVI float geluf_(float x) { return x * rcpf_(1.f + __expf(-1.5957691216057308f * (x + 0.044715f * x * x * x))); }
DEVI float softplusf_(float x) { return fmaxf(x, 0.f) + log1pf(__expf(-fabsf(x))); }

#define XB_TMO      128
#define XB_XCNT(j)  (256  + 64 * (j))
#define XB_XSUB(j)  (1280 + 64 * (j))
#define XB_XGEN(j)  (2304 + 64 * (j))
#define XB_TOP      3328
#define XB_TOPGEN   3392
#define XCD_BAR_WORDS 3456
#define XB_SPIN_CAP (1u << 22)
DEVI unsigned xb_ld(unsigned* p)              { return __hip_atomic_load(p, __ATOMIC_RELAXED, __HIP_MEMORY_SCOPE_AGENT); }
DEVI unsigned xb_add(unsigned* p, unsigned v) { return __hip_atomic_fetch_add(p, v, __ATOMIC_RELAXED, __HIP_MEMORY_SCOPE_AGENT); }
DEVI unsigned xb_xcc_id() { return (unsigned)__builtin_amdgcn_s_getreg((3 << 11) | 20) & 0xFu; }
#define XB_SPIN(cond, bar) do { unsigned _sp = 0; while (cond) { __builtin_amdgcn_s_sleep(1); \
    if ((++_sp & 255u) == 0u) { if (xb_ld(&(bar)[XB_TMO])) break; if (_sp > XB_SPIN_CAP) { atomicAdd(&(bar)[XB_TMO], 1u); break; } } } } while (0)
struct XcdBarrier { unsigned* bar; unsigned x; volatile LAS unsigned* st; };
DEVI XcdBarrier xcd_barrier_post(unsigned* bar, volatile LAS unsigned* st) {
    XcdBarrier b; b.bar = bar; b.x = xb_xcc_id(); b.st = st;
    if (threadIdx.x == 0) (void)xb_add(&bar[XB_XCNT(b.x)], 1u);
    return b;
}
DEVI void xcd_barrier_complete(unsigned* bar, unsigned x, unsigned& nloc, unsigned& nx) {
    const unsigned G = gridDim.x * gridDim.y * gridDim.z;
    unsigned sum, cnt, mine, sp = 0u;
    for (;;) {
        sum = 0u; cnt = 0u; mine = 0u;
#pragma unroll
        for (unsigned j = 0; j < 16; ++j) { const unsigned c = xb_ld(&bar[XB_XCNT(j)]); sum += c; cnt += (c > 0u) ? 1u : 0u; mine = (j == x) ? c : mine; }
        if (sum == G) break;
        __builtin_amdgcn_s_sleep(1);
        if ((++sp & 255u) == 0u) { if (xb_ld(&bar[XB_TMO])) break; if (sp > XB_SPIN_CAP) { atomicAdd(&bar[XB_TMO], 1u); break; } }
    }
    nloc = mine > 0u ? mine : 1u; nx = cnt > 0u ? cnt : 1u;
}
DEVI void xcd_barrier(const XcdBarrier& b) {
    asm volatile("s_waitcnt vmcnt(0)" ::: "memory");
    __syncthreads();
    if (threadIdx.x == 0) {
        unsigned* bar = b.bar;
        __builtin_amdgcn_s_waitcnt(0);
        unsigned nloc = b.st[0], nx = b.st[1];
        if (nloc == 0u) { xcd_barrier_complete(bar, b.x, nloc, nx); b.st[0] = nloc; b.st[1] = nx; }
        const unsigned old = xb_add(&bar[XB_XSUB(b.x)], 1u);
        const unsigned gen = old / nloc;
        if (old + 1u == (gen + 1u) * nloc) {
            __builtin_amdgcn_fence(__ATOMIC_RELEASE, "agent");
            asm volatile("s_waitcnt vmcnt(0)" ::: "memory");
            const unsigned og = xb_add(&bar[XB_TOP], 1u);
            const unsigned tg = og / nx;
            if (og + 1u == (tg + 1u) * nx) xb_add(&bar[XB_TOPGEN], 1u);
            else XB_SPIN(xb_ld(&bar[XB_TOPGEN]) == tg, bar);
            __builtin_amdgcn_fence(__ATOMIC_ACQUIRE, "agent");
            xb_add(&bar[XB_XGEN(b.x)], 1u);
            asm volatile("s_waitcnt vmcnt(0)" ::: "memory");
        } else {
            XB_SPIN(xb_ld(&bar[XB_XGEN(b.x)]) == gen, bar);
            __builtin_amdgcn_fence(__ATOMIC_ACQUIRE, "agent");
            asm volatile("s_waitcnt vmcnt(0)" ::: "memory");
        }
    }
    __syncthreads();
}

struct Args { const float* in[N_IN]; float* out; unsigned char* ws; };
constexpr int PTAB_OFF = MISC_OFF + 128;
struct InTab { const LAS unsigned long long* t;
    DEVI const float* operator[](int i) const { const unsigned long long v = t[i];
        const unsigned lo = __builtin_amdgcn_readfirstlane((unsigned)v), hi = __builtin_amdgcn_readfirstlane((unsigned)(v >> 32));
        return (const float*)(const __attribute__((address_space(1))) float*)(((unsigned long long)hi << 32) | lo); } };
struct PArgs { InTab in; };

struct Ctx {
    LAS unsigned char* lds;
    int tid, lane, wave, G, bid;
    unsigned char* ws; float* out;
};
DEVI int row_pos(int row) { return row < MP ? (row % TP) : TP; }
DEVI float row_rstd(const float* RS, int row) {
    const f32x4* p = (const f32x4*)(RS + (size_t)row * 16);
    const f32x4 a = p[0], b = p[1], c = p[2], d = p[3];
    const float s = ((a.x + a.y) + (a.z + a.w)) + ((b.x + b.y) + (b.z + b.w)) + ((c.x + c.y) + (c.z + c.w)) + ((d.x + d.y) + (d.z + d.w));
    return __builtin_amdgcn_rsqf(s * (1.0f / D) + 1e-6f);
}
DEVI float row_rstd_fin(const f32x4 a) {
    float s = (a.x + a.y) + (a.z + a.w);
    u32x2 r = __builtin_amdgcn_permlane16_swap(__float_as_uint(s), __float_as_uint(s), false, false); s = __uint_as_float(r.x) + __uint_as_float(r.y);
    r = __builtin_amdgcn_permlane32_swap(__float_as_uint(s), __float_as_uint(s), false, false); s = __uint_as_float(r.x) + __uint_as_float(r.y);
    return __builtin_amdgcn_rsqf(s * (1.0f / D) + 1e-6f);
}

DEVI void n_prologue(const Ctx& c, const PArgs& a) {
    float* X = (float*)(c.ws + WS_X); bf16* XB = (bf16*)(c.ws + WS_XB); float* RS = (float*)(c.ws + WS_RS);
    const int gw = c.bid * NWAVES + c.wave, NGW = c.G * NWAVES;
    for (int row = gw; row < M; row += NGW) {
        const float* src;
        if (row < MP) { const int b = row / TP, t = row % TP; src = t < NMETA ? a.in[I_META] + (size_t)t * D : a.in[I_XP] + ((size_t)b * SEQ + (t - NMETA)) * D; }
        else src = a.in[I_XS] + (size_t)(row - MP) * D;
        float ss = 0.f;
#pragma unroll
        for (int j = 0; j < 4; ++j) {
            const f32x4 v = __builtin_nontemporal_load((const f32x4*)(src + j * 256 + c.lane * 4));
            (void)X;
            u32x2 w; w.x = pk2(v.x, v.y); w.y = pk2(v.z, v.w);
            *(u32x2*)(XB + (size_t)row * D + j * 256 + c.lane * 4) = w;
            ss += (v.x * v.x + v.y * v.y) + (v.z * v.z + v.w * v.w);
        }
        ss = wave_sum(ss);
        if (c.lane < 16) RS[(size_t)row * 16 + c.lane] = c.lane == 0 ? ss : 0.f;
    }
    float* ROPE = (float*)(c.ws + WS_ROPE);
    for (int e = c.bid * NT + c.tid; e < (TP + 1) * 64; e += c.G * NT) {
        const int p = e >> 6, d = e & 63;
        const double pos = p < TP ? (double)p : 16384.0;
        const double inv = exp(-9.210340371976184 * ((double)d / 63.0));
        const double rev = pos * inv * 0.15915494309189535;
        const float fr = (float)(rev - rint(rev));
        ROPE[2 * e] = __builtin_amdgcn_cosf(fr); ROPE[2 * e + 1] = __builtin_amdgcn_sinf(fr);
    }
}

DEVI void ngemm_tile(const Ctx& c, const bf16* A, int lda, const float* W, int ldw, int ncv, int K, const float* gain, int row0, float (&acc)[4][4]) {
    LAS float* As = (LAS float*)c.lds;
    LAS float* Bs = (LAS float*)(c.lds + 8192);
#pragma unroll
    for (int j = 0; j < 4; ++j)
#pragma unroll
        for (int i = 0; i < 4; ++i) acc[j][i] = 0.f;
    const int ar = c.tid >> 4, ak = (c.tid & 15) * 2;
    for (int k0 = 0; k0 < K; k0 += 32) {
        __syncthreads();
        { const unsigned v = *(const unsigned*)(A + (size_t)(row0 + ar) * lda + k0 + ak);
          float lo = __uint_as_float(v << 16), hi = __uint_as_float(v & 0xffff0000u);
          if (gain) { lo *= gain[k0 + ak]; hi *= gain[k0 + ak + 1]; }
          As[ar * 33 + ak] = lo; As[ar * 33 + ak + 1] = hi; }
#pragma unroll
        for (int i = 0; i < 16; ++i) { const int idx = i * NT + c.tid, kk = idx >> 8, cc = idx & 255;
            Bs[idx] = cc < ncv ? W[(size_t)(k0 + kk) * ldw + cc] : 0.f; }
        __syncthreads();
#pragma unroll 8
        for (int kk = 0; kk < 32; ++kk) {
            float av[4], bv[4];
#pragma unroll
            for (int j = 0; j < 4; ++j) av[j] = As[(c.wave * 4 + j) * 33 + kk];
#pragma unroll
            for (int i = 0; i < 4; ++i) bv[i] = Bs[kk * 256 + c.lane + 64 * i];
#pragma unroll
            for (int j = 0; j < 4; ++j)
#pragma unroll
                for (int i = 0; i < 4; ++i) acc[j][i] += av[j] * bv[i];
        }
    }
}

DEVI void nepi_residual(const Ctx& c, int row0, int pn, const float (&acc)[4][4], bool write_xb) {
    float* X = (float*)(c.ws + WS_X); bf16* XB = (bf16*)(c.ws + WS_XB); float* RS = (float*)(c.ws + WS_RS);
#pragma unroll
    for (int j = 0; j < 4; ++j) { const int row = row0 + 4 * c.wave + j; float ss = 0.f;
#pragma unroll
        for (int i = 0; i < 4; ++i) { const int col = pn * 256 + c.lane + 64 * i; const float v = X[(size_t)row * D + col] + acc[j][i];
            X[(size_t)row * D + col] = v; if (write_xb) XB[(size_t)row * D + col] = f2bf(v); ss += v * v; }
        ss = wave_sum(ss);
        if (c.lane < 4) RS[(size_t)row * 16 + pn * 4 + c.lane] = c.lane == 0 ? ss : 0.f; }
}

DEVI void n_even_in(const Ctx& c, const PArgs& a, int li) {
    const int j = li >> 1;
    const bf16* XB = (const bf16*)(c.ws + WS_XB); const float* RS = (const float*)(c.ws + WS_RS); const float* ROPE = (const float*)(c.ws + WS_ROPE);
    bf16* Z = (bf16*)(c.ws + WS_Z);
    const float* W = a.in[I_EWIN] + (size_t)j * D * NIN; const float* gain = a.in[I_NMIX] + (size_t)li * D;
    const int ntn = NIN / 256, nu = (M / 32) * ntn;
    for (int u = c.bid; u < nu; u += c.G) {
        const int pn = u % ntn, row0 = (u / ntn) * 32;
        float acc[4][4];
        ngemm_tile(c, XB, D, W + pn * 256, NIN, 256, D, gain, row0, acc);
#pragma unroll
        for (int jj = 0; jj < 4; ++jj) { const int row = row0 + 4 * c.wave + jj; const float rs = row_rstd(RS, row);
            float v[4];
#pragma unroll
            for (int i = 0; i < 4; ++i) v[i] = acc[jj][i] * rs;
            if (pn < 4) {
                const float cs = ROPE[((size_t)row_pos(row) * 64 + c.lane) * 2], sn = ROPE[((size_t)row_pos(row) * 64 + c.lane) * 2 + 1];
                const float sc = pn >= 2 ? 0.08838834764831845f : 1.f;
                const float a0 = v[0] * cs - v[1] * sn, a1 = v[0] * sn + v[1] * cs, b0 = v[2] * cs - v[3] * sn, b1 = v[2] * sn + v[3] * cs;
                v[0] = a0 * sc; v[1] = a1 * sc; v[2] = b0 * sc; v[3] = b1 * sc;
            } else if (pn >= 8 && pn < 12) {
#pragma unroll
                for (int i = 0; i < 4; ++i) v[i] = siluf_(v[i]);
            } else if (pn >= 16) {
#pragma unroll
                for (int i = 0; i < 4; ++i) v[i] = geluf_(v[i]);
            }
#pragma unroll
            for (int i = 0; i < 4; ++i) Z[(size_t)row * NIN + pn * 256 + c.lane + 64 * i] = f2bf(v[i]); }
    }
}

DEVI void n_ret_unit(const Ctx& c, const PArgs& a, int j, int hd, int row0, int ntok, const float* S0, float* Sout) {
    const bf16* Z = (const bf16*)(c.ws + WS_Z); bf16* MIX = (bf16*)(c.ws + WS_MIX);
    LAS float* qs = (LAS float*)c.lds;
    LAS float* ks = qs + 8 * 128;
    LAS float* vs = ks + 8 * 128;
    LAS float* op = vs + 8 * 256;
    const int e = c.tid & 255, half = c.tid >> 8;
    const float gamma = 1.f - exp2f(-5.f - (float)hd);
    const float* gn = a.in[I_ERGN] + (size_t)j * 1024 + hd * 256;
    float S[64];
    if (S0) { const float* sp = S0 + (size_t)half * 64 * 256 + e;
#pragma unroll
        for (int d8 = 0; d8 < 8; ++d8) { asm volatile("" ::: "memory");
#pragma unroll
            for (int dd = 0; dd < 8; ++dd) S[d8 * 8 + dd] = sp[(size_t)(d8 * 8 + dd) * 256]; }
    } else {
#pragma unroll
        for (int dd = 0; dd < 64; ++dd) S[dd] = 0.f; }
    for (int t0 = 0; t0 < ntok; t0 += 8) {
        __syncthreads();
#pragma unroll
        for (int i = 0; i < 8; ++i) { const int idx = i * NT + c.tid, tt = idx >> 9, cc = idx & 511; const int row = row0 + t0 + tt;
            float v = 0.f;
            if (t0 + tt < ntok) { const int col = cc < 128 ? hd * 128 + cc : (cc < 256 ? 512 + hd * 128 + (cc - 128) : 1024 + hd * 256 + (cc - 256)); v = bf2f(Z[(size_t)row * NIN + col]); }
            if (cc < 128) qs[tt * 128 + cc] = v; else if (cc < 256) ks[tt * 128 + cc - 128] = v; else vs[tt * 256 + cc - 256] = v; }
        __syncthreads();
        for (int tt = 0; tt < 8; ++tt) {
            if (t0 + tt < ntok) {
                const float ve = vs[tt * 256 + e]; float o = 0.f;
#pragma unroll
                for (int dd = 0; dd < 64; ++dd) { S[dd] = gamma * S[dd] + ks[tt * 128 + half * 64 + dd] * ve; o += qs[tt * 128 + half * 64 + dd] * S[dd]; }
                op[(tt * 2 + half) * 256 + e] = o;
            }
        }
        __syncthreads();
        { const int tt = c.wave; const int row = row0 + t0 + tt;
          if (t0 + tt < ntok) {
              float o[4]; float s = 0.f;
#pragma unroll
              for (int i = 0; i < 4; ++i) { const int ee = c.lane + 64 * i; o[i] = op[(tt * 2) * 256 + ee] + op[(tt * 2 + 1) * 256 + ee]; s += o[i]; }
              const float mu = wave_sum(s) * (1.f / 256.f); float q = 0.f;
#pragma unroll
              for (int i = 0; i < 4; ++i) { o[i] -= mu; q += o[i] * o[i]; }
              const float rstd = __builtin_amdgcn_rsqf(wave_sum(q) * (1.f / 256.f) + 1e-6f);
#pragma unroll
              for (int i = 0; i < 4; ++i) { const int ee = c.lane + 64 * i; const float ga = bf2f(Z[(size_t)row * NIN + 2048 + hd * 256 + ee]);
                  MIX[(size_t)row * 2048 + hd * 256 + ee] = f2bf(ga * o[i] * rstd * gn[ee]); }
          } }
    }
    { float* sp = Sout + (size_t)half * 64 * 256 + e;
#pragma unroll
      for (int d8 = 0; d8 < 8; ++d8) { asm volatile("" ::: "memory");
#pragma unroll
          for (int dd = 0; dd < 8; ++dd) sp[(size_t)(d8 * 8 + dd) * 256] = S[d8 * 8 + dd]; } }
    __syncthreads();
}

DEVI void n_lru_unit(const Ctx& c, const PArgs& a, int j, int g, int row0, int ntok, const float* hist  , const float* h0  , float* out_h, float* out_conv) {
    const bf16* Z = (const bf16*)(c.ws + WS_Z); bf16* MIX = (bf16*)(c.ws + WS_MIX);
    LAS float* xcs = (LAS float*)c.lds;
    const int d = c.tid >> 2, p = c.tid & 3, ch = g * 128 + d;
    float wa[32], wx[32];
    { const float* WA = a.in[I_EWA] + ((size_t)(j * 8 + g) * 128 + 32 * p) * 128 + d; const float* WX = a.in[I_EWX] + ((size_t)(j * 8 + g) * 128 + 32 * p) * 128 + d;
#pragma unroll
      for (int cc = 0; cc < 32; ++cc) { wa[cc] = WA[(size_t)cc * 128]; wx[cc] = WX[(size_t)cc * 128]; } }
    const float* CW = a.in[I_ECW] + (size_t)j * 4 * 1024;
    const float cw0 = CW[ch], cw1 = CW[1024 + ch], cw2 = CW[2048 + ch], cw3 = CW[3072 + ch], cb = a.in[I_ECB][(size_t)j * 1024 + ch];
    const float ba = a.in[I_EBA][(size_t)j * 1024 + ch], bx = a.in[I_EBX][(size_t)j * 1024 + ch];
    const float sp = softplusf_(-a.in[I_ELAM][(size_t)j * 1024 + ch]);
    float x1 = hist ? hist[2 * 1024 + ch] : 0.f, x2 = hist ? hist[1024 + ch] : 0.f, x3 = hist ? hist[ch] : 0.f;
    float h = h0 ? h0[ch] : 0.f;
    for (int t = 0; t < ntok; ++t) {
        const int row = row0 + t;
        float xcv = 0.f;
        if (p == 0) { const float xb = bf2f(Z[(size_t)row * NIN + 3072 + ch]); xcv = cb + cw3 * xb + cw2 * x1 + cw1 * x2 + cw0 * x3; x3 = x2; x2 = x1; x1 = xb; xcs[d] = xcv; }
        __syncthreads();
        float sr = 0.f, si = 0.f;
#pragma unroll
        for (int cc = 0; cc < 32; ++cc) { const float xv = xcs[32 * p + cc]; sr += xv * wa[cc]; si += xv * wx[cc]; }
        sr += __shfl_xor(sr, 1); sr += __shfl_xor(sr, 2); si += __shfl_xor(si, 1); si += __shfl_xor(si, 2);
        if (p == 0) {
            const float r = sigmoidf_(sr + ba), ig = sigmoidf_(si + bx);
            const float la = -8.f * r * sp, av = __expf(la), u = sqrtf(-expm1f(2.f * la)) * (ig * xcv);
            h = av * h + u;
            MIX[(size_t)row * 2048 + 1024 + ch] = f2bf(h * bf2f(Z[(size_t)row * NIN + 4096 + ch]));
        }
        __syncthreads();
    }
    if (p == 0) { out_h[ch] = h; out_conv[ch] = x3; out_conv[1024 + ch] = x2; out_conv[2048 + ch] = x1; }
}

DEVI void n_even_mix(const Ctx& c, const PArgs& a, int li) {
    const int j = li >> 1;
    const int NU = 32 + 64 + 512 + 1024;
    for (int u = c.bid; u < NU; u += c.G) {
        if (u < 32 || (u >= 96 && u < 608)) {
            const bool pr = u < 32; const int v = pr ? u : u - 96, b = v >> 2, hd = v & 3;
            const float* S0 = pr ? nullptr : a.in[I_SRET] + ((size_t)(j * BS + b) * 4 + hd) * 128 * 256;
            float* So = pr ? c.out + O_RETP + ((size_t)(j * BP + b) * 4 + hd) * 128 * 256 : c.out + O_RETS + ((size_t)(j * BS + b) * 4 + hd) * 128 * 256;
            n_ret_unit(c, a, j, hd, pr ? b * TP : MP + b, pr ? TP : 1, S0, So);
        } else {
            const bool pr = u < 96; const int v = pr ? u - 32 : u - 608, b = v >> 3, g = v & 7;
            const float* hist = pr ? nullptr : a.in[I_SLCONV] + (size_t)(j * BS + b) * 3 * 1024;
            const float* h0 = pr ? nullptr : a.in[I_SLRU] + (size_t)(j * BS + b) * 1024;
            float* oh = pr ? c.out + O_LRUP + (size_t)(j * BP + b) * 1024 : c.out + O_LRUS + (size_t)(j * BS + b) * 1024;
            float* oc = pr ? c.out + O_LCONVP + (size_t)(j * BP + b) * 3 * 1024 : c.out + O_LCONVS + (size_t)(j * BS + b) * 3 * 1024;
            n_lru_unit(c, a, j, g, pr ? b * TP : MP + b, pr ? TP : 1, hist, h0, oh, oc);
        }
    }
}

DEVI void n_gemm_residual(const Ctx& c, const bf16* A, int lda, const float* W, int K, bool write_xb) {
    const int nu = (M / 32) * 4;
    for (int u = c.bid; u < nu; u += c.G) {
        const int pn = u & 3, row0 = (u >> 2) * 32;
        float acc[4][4];
        ngemm_tile(c, A, lda, W + pn * 256, D, 256, K, nullptr, row0, acc);
        nepi_residual(c, row0, pn, acc, write_xb);
    }
}

DEVI void n_ffn_up(const Ctx& c, const PArgs& a, int li) {
    const bf16* XB = (const bf16*)(c.ws + WS_XB); const float* RS = (const float*)(c.ws + WS_RS); bf16* U = (bf16*)(c.ws + WS_U);
    const float* W = a.in[I_FWUP] + (size_t)li * D * NUP; const float* gain = a.in[I_NFFN] + (size_t)li * D;
    const int ntn = NUP / 256, nu = (M / 32) * ntn;
    for (int u = c.bid; u < nu; u += c.G) {
        const int pn = u % ntn, row0 = (u / ntn) * 32;
        float acc[4][4];
        ngemm_tile(c, XB, D, W + pn * 256, NUP, 256, D, gain, row0, acc);
#pragma unroll
        for (int jj = 0; jj < 4; ++jj) { const int row = row0 + 4 * c.wave + jj; const float rs = row_rstd(RS, row);
#pragma unroll
            for (int i = 0; i < 4; ++i) U[(size_t)row * NUP + pn * 256 + c.lane + 64 * i] = f2bf(acc[jj][i] * rs); }
    }
}

DEVI void n_ffn_act(const Ctx& c, const PArgs& a, int li) {
    const bf16* U = (const bf16*)(c.ws + WS_U); bf16* ACT = (bf16*)(c.ws + WS_ACT);
    const float* CW = a.in[I_FCW] + (size_t)li * 3 * DFF; const float* CB = a.in[I_FCB] + (size_t)li * DFF;
    const size_t total = (size_t)M * DFF;
    for (size_t e = (size_t)c.bid * NT + c.tid; e < total; e += (size_t)c.G * NT) {
        const int row = (int)(e / DFF), col = (int)(e % DFF);
        const float u0 = bf2f(U[(size_t)row * NUP + col]); float u1, u2;
        if (row < MP) { const int b = row / TP, t = row % TP;
            u1 = t >= 1 ? bf2f(U[(size_t)(row - 1) * NUP + col]) : 0.f; u2 = t >= 2 ? bf2f(U[(size_t)(row - 2) * NUP + col]) : 0.f;
            if (t >= TP - 2) c.out[O_FCONVP + ((size_t)(li * BP + b) * 2 + (t - (TP - 2))) * DFF + col] = u0;
        } else { const int b = row - MP; const float* st = a.in[I_SFCONV] + (size_t)(li * BS + b) * 2 * DFF;
            u1 = st[DFF + col]; u2 = st[col];
            float* so = c.out + O_FCONVS + (size_t)(li * BS + b) * 2 * DFF; so[col] = u1; so[DFF + col] = u0; }
        const float cv = CB[col] + CW[2 * DFF + col] * u0 + CW[DFF + col] * u1 + CW[col] * u2;
        ACT[(size_t)row * DFF + col] = f2bf(geluf_(cv) * bf2f(U[(size_t)row * NUP + DFF + col]));
    }
}

DEVI void n_odd_norm(const Ctx& c, const PArgs& a, int li) {
    const int j = li >> 1;
    const bf16* XB = (const bf16*)(c.ws + WS_XB); const float* RS = (const float*)(c.ws + WS_RS); bf16* XM = (bf16*)(c.ws + WS_XMIX);
    const float* gain = a.in[I_NMIX] + (size_t)li * D; const float* mix = a.in[I_OMIX] + (size_t)j * 6 * D;
    const int gw = c.bid * NWAVES + c.wave, NGW = c.G * NWAVES;
    for (int row = gw; row < M; row += NGW) {
        const float rs = row_rstd(RS, row);
        const bool prompt = row < MP; const int b = prompt ? row / TP : row - MP, t = prompt ? row % TP : 0;
        const float rsp = (prompt && t > 0) ? row_rstd(RS, row - 1) : 0.f;
#pragma unroll
        for (int q = 0; q < 4; ++q) { const int col = q * 256 + c.lane * 4;
            const u32x2 xw_ = *(const u32x2*)(XB + (size_t)row * D + col); const f32x4 xv = (f32x4){__uint_as_float(xw_.x << 16), __uint_as_float(xw_.x & 0xffff0000u), __uint_as_float(xw_.y << 16), __uint_as_float(xw_.y & 0xffff0000u)}; const f32x4 gv = *(const f32x4*)(gain + col);
            const f32x4 h = xv * rs * gv; f32x4 hp;
            if (prompt) { if (t > 0) { const u32x2 pw_ = *(const u32x2*)(XB + (size_t)(row - 1) * D + col); hp = (f32x4){__uint_as_float(pw_.x << 16), __uint_as_float(pw_.x & 0xffff0000u), __uint_as_float(pw_.y << 16), __uint_as_float(pw_.y & 0xffff0000u)} * rsp * gv; } else hp = (f32x4){0.f, 0.f, 0.f, 0.f}; }
            else hp = *(const f32x4*)(a.in[I_SSHIFT] + (size_t)(j * BS + b) * D + col);
            const f32x4 xx = hp - h;
#pragma unroll
            for (int n = 0; n < 6; ++n) { const f32x4 mv = *(const f32x4*)(mix + (size_t)n * D + col); const f32x4 o = h + xx * mv;
                u32x2 w; w.x = pk2(o.x, o.y); w.y = pk2(o.z, o.w); *(u32x2*)(XM + ((size_t)n * M + row) * D + col) = w; }
            if (prompt) { if (t == TP - 1) *(f32x4*)(c.out + O_SHIFTP + (size_t)(j * BP + b) * D + col) = h; }
            else *(f32x4*)(c.out + O_SHIFTS + (size_t)(j * BS + b) * D + col) = h; }
    }
}

DEVI void n_odd_in(const Ctx& c, const PArgs& a, int li) {
    const int j = li >> 1;
    const bf16* XM = (const bf16*)(c.ws + WS_XMIX);
    bf16* R = (bf16*)(c.ws + WS_R); bf16* Kb = (bf16*)(c.ws + WS_K); bf16* Vb = j == 0 ? (bf16*)((unsigned char*)c.out + DO_VFIRST) : (bf16*)(c.ws + WS_V);
    bf16* LM = (bf16*)((unsigned char*)c.out + DO_LMID);
    const int nu = (M / 32) * 16;
    for (int u = c.bid; u < nu; u += c.G) {
        const int pn = u & 15, row0 = (u >> 4) * 32;
        if (pn == 13 && j == 0) continue;
        const bf16* A; const float* W; int ldw, ncv;
        if (pn < 4) { A = XM + (size_t)0 * M * D; W = a.in[I_OWR] + (size_t)j * D * D + pn * 256; ldw = D; ncv = 256; }
        else if (pn < 8) { A = XM + (size_t)2 * M * D; W = a.in[I_OWK] + (size_t)j * D * D + (pn - 4) * 256; ldw = D; ncv = 256; }
        else if (pn < 12) { A = XM + (size_t)3 * M * D; W = a.in[I_OWV] + (size_t)j * D * D + (pn - 8) * 256; ldw = D; ncv = 256; }
        else if (pn == 12) { A = XM + (size_t)5 * M * D; W = a.in[I_OG1] + (size_t)j * D * 128; ldw = 128; ncv = 128; }
        else if (pn == 13) { A = XM + (size_t)3 * M * D; W = a.in[I_OV1]; ldw = 32; ncv = 32; }
        else if (pn == 14) { A = XM + (size_t)1 * M * D; W = a.in[I_OW1] + (size_t)j * D * 64; ldw = 64; ncv = 64; }
        else { A = XM + (size_t)4 * M * D; W = a.in[I_OA1] + (size_t)j * D * 64; ldw = 64; ncv = 64; }
        float acc[4][4];
        ngemm_tile(c, A, D, W, ldw, ncv, D, nullptr, row0, acc);
#pragma unroll
        for (int jj = 0; jj < 4; ++jj) { const int row = row0 + 4 * c.wave + jj;
#pragma unroll
            for (int i = 0; i < 4; ++i) { const int cl = c.lane + 64 * i; const float v = acc[jj][i];
                if (pn < 4) R[(size_t)row * D + pn * 256 + cl] = f2bf(v);
                else if (pn < 8) Kb[(size_t)row * D + (pn - 4) * 256 + cl] = f2bf(v);
                else if (pn < 12) Vb[(size_t)row * D + (pn - 8) * 256 + cl] = f2bf(v);
                else if (pn == 12) { if (cl < 128) LM[(size_t)row * LML + cl] = f2bf(sigmoidf_(v)); }
                else if (pn == 13) { if (cl < 128) LM[(size_t)row * LML + 128 + cl] = f2bf(v); }
                else if (pn == 14) { if (cl < 128) LM[(size_t)row * LML + 256 + cl] = f2bf(tanhf_(v)); }
                else LM[(size_t)row * LML + 384 + cl] = f2bf(v); } }
    }
}

DEVI void n_odd_lora(const Ctx& c, const PArgs& a, int li) {
    const int j = li >> 1;
    const bf16* LM = (const bf16*)((unsigned char*)c.out + DO_LMID);
    float* WD = (float*)(c.ws + WS_WDEC); bf16* AG = (bf16*)(c.ws + WS_AG); bf16* VG = (bf16*)(c.ws + WS_VG); bf16* GG = (bf16*)(c.ws + WS_GG);
    const int nu = (M / 32) * 16;
    for (int u = c.bid; u < nu; u += c.G) {
        const int pn = u & 15, grp = pn >> 2, pc = pn & 3, row0 = (u >> 4) * 32;
        if (grp == 2 && j == 0) continue;
        const bf16* A; const float* W; int K;
        if (grp == 0) { A = LM + 256; W = a.in[I_OW2] + (size_t)j * 64 * D; K = 64; }
        else if (grp == 1) { A = LM + 384; W = a.in[I_OA2] + (size_t)j * 64 * D; K = 64; }
        else if (grp == 2) { A = LM + 128; W = a.in[I_OV2]; K = 32; }
        else { A = LM; W = a.in[I_OG2] + (size_t)j * 128 * D; K = 128; }
        float acc[4][4];
        ngemm_tile(c, A, LML, W + pc * 256, D, 256, K, nullptr, row0, acc);
#pragma unroll
        for (int jj = 0; jj < 4; ++jj) { const int row = row0 + 4 * c.wave + jj;
#pragma unroll
            for (int i = 0; i < 4; ++i) { const int col = pc * 256 + c.lane + 64 * i; const float v = acc[jj][i];
                if (grp == 0) { const float wl = -softplusf_(-(a.in[I_OW0][(size_t)j * D + col] + v)) - 0.5f; WD[(size_t)row * D + col] = __expf(-__expf(wl)); }
                else if (grp == 1) AG[(size_t)row * D + col] = f2bf(sigmoidf_(a.in[I_OA0][(size_t)j * D + col] + v));
                else if (grp == 2) VG[(size_t)row * D + col] = f2bf(sigmoidf_(a.in[I_OV0][col] + v));
                else GG[(size_t)row * D + col] = f2bf(v); } }
    }
}

DEVI void n_rwkv_unit(const Ctx& c, const PArgs& a, int j, int hd, int row0, int ntok, const float* S0, float* Sout) {
    const bf16* R = (const bf16*)(c.ws + WS_R); const bf16* Kb = (const bf16*)(c.ws + WS_K);
    const bf16* VF = (const bf16*)((unsigned char*)c.out + DO_VFIRST); const bf16* Vb = j == 0 ? VF : (const bf16*)(c.ws + WS_V);
    const float* WD = (const float*)(c.ws + WS_WDEC); const bf16* AG = (const bf16*)(c.ws + WS_AG); const bf16* VG = (const bf16*)(c.ws + WS_VG); const bf16* GG = (const bf16*)(c.ws + WS_GG);
    bf16* O = (bf16*)(c.ws + WS_O);
    LAS float* rs_ = (LAS float*)c.lds;
    LAS float* ws_ = rs_ + 512; LAS float* ks_ = ws_ + 512; LAS float* vs_ = ks_ + 512; LAS float* as_ = vs_ + 512; LAS float* bs_ = as_ + 512; LAS float* ys_ = bs_ + 512; LAS float* bon = ys_ + 512;
    const int i = c.tid >> 3, q = c.tid & 7;
    const int st = c.wave, sc = c.lane, ch = hd * 64 + sc;
    const float kkc = a.in[I_OKK][(size_t)j * D + ch], kac = a.in[I_OKA][(size_t)j * D + ch], rkc = a.in[I_ORK][(size_t)j * D + ch];
    const float gng = a.in[I_OGNG][(size_t)j * D + ch], gnb = a.in[I_OGNB][(size_t)j * D + ch];
    float s[8];
#pragma unroll
    for (int jj = 0; jj < 8; ++jj) s[jj] = 0.f;
    if (S0) {
#pragma unroll
        for (int jj = 0; jj < 8; ++jj) s[jj] = S0[(size_t)i * 64 + 8 * q + jj]; }
    for (int t0 = 0; t0 < ntok; t0 += 8) {
        __syncthreads();
        const int row = row0 + t0 + st; const bool valid = t0 + st < ntok;
        float gg = 0.f;
        { float r = 0.f, k = 0.f, v = 0.f, w = 1.f, ag = 0.f;
          if (valid) { const size_t o = (size_t)row * D + ch; r = bf2f(R[o]); k = bf2f(Kb[o]); v = bf2f(Vb[o]); w = WD[o]; ag = bf2f(AG[o]); gg = bf2f(GG[o]);
              if (j == 1) { const float vf = bf2f(VF[o]); v = v + (vf - v) * bf2f(VG[o]); } }
          float kk = k * kkc; const float ss = wave_sum(kk * kk); kk = kk / sqrtf(fmaxf(ss, 1e-24f));
          const float km = k * (1.f + (ag - 1.f) * kac);
          const float bsum = wave_sum(r * km * rkc);
          rs_[st * 64 + sc] = r; ws_[st * 64 + sc] = w; ks_[st * 64 + sc] = km; vs_[st * 64 + sc] = v; as_[st * 64 + sc] = -kk; bs_[st * 64 + sc] = kk * ag;
          if (sc == 0) bon[st] = bsum; }
        __syncthreads();
        for (int tt = 0; tt < 8; ++tt) {
            if (t0 + tt < ntok) {
                float sa = 0.f;
#pragma unroll
                for (int jj = 0; jj < 8; ++jj) sa += s[jj] * as_[tt * 64 + 8 * q + jj];
                sa += __shfl_xor(sa, 1); sa += __shfl_xor(sa, 2); sa += __shfl_xor(sa, 4);
                const float vi = vs_[tt * 64 + i]; float y = 0.f;
#pragma unroll
                for (int jj = 0; jj < 8; ++jj) { const int cj = tt * 64 + 8 * q + jj; s[jj] = s[jj] * ws_[cj] + sa * bs_[cj] + vi * ks_[cj]; y += s[jj] * rs_[cj]; }
                y += __shfl_xor(y, 1); y += __shfl_xor(y, 2); y += __shfl_xor(y, 4);
                if (q == 0) ys_[tt * 64 + i] = y;
            }
        }
        __syncthreads();
        if (valid) {
            const float y = ys_[st * 64 + sc];
            const float mu = wave_sum(y) * (1.f / 64.f); const float dy = y - mu; const float var = wave_sum(dy * dy) * (1.f / 64.f);
            float o = dy / sqrtf(var + 64e-5f) * gng + gnb;
            o = (o + bon[st] * vs_[st * 64 + sc]) * gg;
            O[(size_t)row * D + ch] = f2bf(o);
        }
    }
#pragma unroll
    for (int jj = 0; jj < 8; ++jj) Sout[(size_t)i * 64 + 8 * q + jj] = s[jj];
    __syncthreads();
}
DEVI void n_odd_scan(const Ctx& c, const PArgs& a, int li) {
    const int j = li >> 1;
    const int NU = 128 + 2048;
    for (int u = c.bid; u < NU; u += c.G) {
        const bool pr = u < 128; const int v = pr ? u : u - 128, b = v >> 4, hd = v & 15;
        const float* S0 = pr ? nullptr : a.in[I_SRWKV] + ((size_t)(j * BS + b) * 16 + hd) * 4096;
        float* So = pr ? c.out + O_RWKVP + ((size_t)(j * BP + b) * 16 + hd) * 4096 : c.out + O_RWKVS + ((size_t)(j * BS + b) * 16 + hd) * 4096;
        n_rwkv_unit(c, a, j, hd, pr ? b * TP : MP + b, pr ? TP : 1, S0, So);
    }
}

DEVI void n_final(const Ctx& c, const PArgs& a) {
    const bf16* XB = (const bf16*)(c.ws + WS_XB); const float* RS = (const float*)(c.ws + WS_RS); const float* gain = a.in[I_NFIN];
    const int gw = c.bid * NWAVES + c.wave, NGW = c.G * NWAVES;
    for (int row = gw; row < M; row += NGW) {
        float* dst;
        if (row < MP) { const int b = row / TP, t = row % TP; if (t < NMETA) continue; dst = c.out + O_YP + ((size_t)b * SEQ + (t - NMETA)) * D; }
        else dst = c.out + O_YS + (size_t)(row - MP) * D;
        const float rs = row_rstd(RS, row);
#pragma unroll
        for (int q = 0; q < 4; ++q) { const int col = q * 256 + c.lane * 4;
            const u32x2 xw_ = *(const u32x2*)(XB + (size_t)row * D + col); const f32x4 yv_ = (f32x4){__uint_as_float(xw_.x << 16), __uint_as_float(xw_.x & 0xffff0000u), __uint_as_float(xw_.y << 16), __uint_as_float(xw_.y & 0xffff0000u)} * rs * *(const f32x4*)(gain + col); __builtin_nontemporal_store(yv_, (f32x4*)(dst + col)); }
    }
}

namespace pg8 {
typedef short bf16x8 __attribute__((ext_vector_type(8)));
constexpr int BM = 256, BK = 64, HALF = 128, HTB = HALF * BK * 2, STAGE_BYTES = 8 * HTB, NXCD = 8, WGM = 8;
__host__ __device__ __forceinline__ int lds_byte(int r, int c) { const int st = (r >> 4) * 2 + (c >> 5), rr = r & 15, cc = c & 31, ob = rr * 64 + cc * 2; return st * 1024 + (ob ^ (((ob >> 9) & 1) << 5)); }
__host__ __device__ __forceinline__ void stage_rc(int b, int& R, int& C) { const int st = b / 1024, sb = b % 1024, swz = sb ^ (((sb >> 9) & 1) << 5); R = (st >> 1) * 16 + swz / 64; C = (st & 1) * 32 + (swz % 64) / 2; }
__host__ __device__ __forceinline__ int perm32(int rho) { const int n = rho >> 4, i = rho & 15; return 8 * (i >> 2) + 4 * n + (i & 3); }
struct Unit { int pm, pn; };
struct Gemm { const bf16* A; const bf16* Bt; int M, N, K, lda; unsigned long long asel; size_t astride; };
struct StaticOrder {
    int nM, nN, nwg, G, c;
    __device__ __forceinline__ void init(int M_, int N_, int G_, int c_) { nM = M_ / BM; nN = N_ / BM; nwg = nM * nN; G = G_; c = c_; }
    __device__ __forceinline__ bool next(int i, Unit& u) const {
        const long L = (long)i * G + c; if (L >= nwg) return false;
        int wgid = (int)L; { const int q = nwg / NXCD, r = nwg % NXCD, xcd = wgid % NXCD, off = wgid / NXCD; wgid = (xcd < r ? xcd * (q + 1) : r * (q + 1) + (xcd - r) * q) + off; }
        const int nig = WGM * nN, gid = wgid / nig, fm = gid * WGM, gsz = (nM - fm) < WGM ? (nM - fm) : WGM;
        u.pm = fm + ((wgid % nig) % gsz); u.pn = (wgid % nig) / gsz; return true;
    }
};
DEVI unsigned cvt_pk_bf16(float lo, float hi) { return pk2(lo, hi); }

template <class Epi>
DEVI void gemm_phase(LAS unsigned char* lds, const int tid, const Gemm g, const StaticOrder& S, const Epi& E) {
    const int wid = __builtin_amdgcn_readfirstlane(tid >> 6), lane = tid & 63, wr = wid >> 2, wc = wid & 3, fr = lane & 15, fq = lane >> 4;
    const int K = g.K, nt = K / BK, lda = g.lda;
    unsigned voffA[2], voffB[2];
#pragma unroll
    for (int i = 0; i < 2; ++i) { int R, C; stage_rc(tid * 16 + i * 8192, R, C); const int Rb = Epi::PERM ? ((R & ~31) + perm32(R & 31)) : R;
        voffA[i] = (unsigned)(R * lda + C) * 2u; voffB[i] = (unsigned)(Rb * K + C) * 2u; }
    const size_t kstep = (size_t)(BK * 2);
    const size_t hstepA = (size_t)HALF * lda * 2, hstepB = (size_t)HALF * K * 2;
    const size_t tstepA = 2 * hstepA, tstepB = 2 * hstepB;
    const unsigned ldsw = (unsigned)wid * 1024u;
    const int aoff = lds_byte(wr * 64 + fr, fq * 8), boff = lds_byte(wc * 32 + fr, fq * 8);
#define PG8_SA(b, h) (((b) * 2 + (h)) * HTB)
#define PG8_SB(b, h) ((4 + (b) * 2 + (h)) * HTB)
#define PG8_STAGE(bufoff, gbase, voff) do { _Pragma("unroll") for (int _i = 0; _i < 2; ++_i) \
        __builtin_amdgcn_global_load_lds((const unsigned*)((const char*)(gbase) + (voff)[_i]), (LAS unsigned*)(lds + (bufoff) + ldsw + _i * 8192), 16, 0, 0); } while (0)
#define PG8_LDA(dst, b, h) do { _Pragma("unroll") for (int m = 0; m < 4; ++m) _Pragma("unroll") for (int k = 0; k < 2; ++k) dst[m][k] = *(const LAS bf16x8*)(lds + PG8_SA(b, h) + aoff + m * 2048 + k * 1024); } while (0)
#define PG8_LDB(dst, b, h) do { _Pragma("unroll") for (int n = 0; n < 2; ++n) _Pragma("unroll") for (int k = 0; k < 2; ++k) dst[n][k] = *(const LAS bf16x8*)(lds + PG8_SB(b, h) + boff + n * 2048 + k * 1024); } while (0)
#define PG8_MMA(ai, bj, At, Bt) do { __builtin_amdgcn_s_setprio(1); _Pragma("unroll") for (int m = 0; m < 4; ++m) _Pragma("unroll") for (int n = 0; n < 2; ++n) _Pragma("unroll") for (int k = 0; k < 2; ++k) \
        acc[ai][bj][m][n] = __builtin_amdgcn_mfma_f32_16x16x32_bf16(Bt[n][k], At[m][k], acc[ai][bj][m][n], 0, 0, 0); __builtin_amdgcn_s_setprio(0); } while (0)
#define PG8_WAIT_V(n) asm volatile("s_waitcnt vmcnt(" #n ")" ::: "memory")
#define PG8_WAIT_L(n) asm volatile("s_waitcnt lgkmcnt(" #n ")" ::: "memory")
#define PG8_BAR __builtin_amdgcn_s_barrier()
#define PG8_SCHED __builtin_amdgcn_sched_barrier(0)
#define PG8_ABASE(u) ((const char*)(g.A + (size_t)((g.asel >> (4 * (u).pn)) & 15ull) * g.astride) + (size_t)(u).pm * tstepA)
    Unit cur, nxt; int ui = 0;
    if (!S.next(0, cur)) return;
    f32x4 acc[2][2][4][2];
#pragma unroll
    for (int a = 0; a < 2; ++a)
#pragma unroll
        for (int b = 0; b < 2; ++b)
#pragma unroll
            for (int m = 0; m < 4; ++m)
#pragma unroll
                for (int n = 0; n < 2; ++n) acc[a][b][m][n] = (f32x4){0.f, 0.f, 0.f, 0.f};
    bf16x8 At[4][2], B0[2][2], B1[2][2];
    const char* cA = PG8_ABASE(cur); const char* cB = (const char*)g.Bt + (size_t)cur.pn * tstepB;
    PG8_STAGE(PG8_SB(0, 0), cB, voffB); PG8_STAGE(PG8_SB(0, 1), cB + hstepB, voffB); PG8_STAGE(PG8_SA(0, 0), cA, voffA); PG8_STAGE(PG8_SA(0, 1), cA + hstepA, voffA);
    if (wr == 1) PG8_BAR;
    PG8_WAIT_V(2); PG8_BAR;
    PG8_STAGE(PG8_SB(1, 0), cB + kstep, voffB); PG8_STAGE(PG8_SA(1, 0), cA + kstep, voffA); PG8_STAGE(PG8_SB(1, 1), cB + hstepB + kstep, voffB);
    PG8_WAIT_V(6); PG8_BAR;
    for (;;) {
        const bool has_next = S.next(ui + 1, nxt);
        const char* nA = has_next ? PG8_ABASE(nxt) : cA; const char* nB = has_next ? (const char*)g.Bt + (size_t)nxt.pn * tstepB : cB;
        for (int t = 0; t < nt; t += 2) {
            const bool last = (t == nt - 2);
            const char* a1 = cA + (size_t)(t + 1) * kstep;
            const char* a2 = last ? nA : cA + (size_t)(t + 2) * kstep; const char* b2 = last ? nB : cB + (size_t)(t + 2) * kstep;
            const char* a3 = a2 + kstep; const char* b3 = b2 + kstep;
            PG8_LDB(B0, 0, 0); PG8_LDB(B1, 0, 1); PG8_SCHED; PG8_LDA(At, 0, 0); PG8_STAGE(PG8_SA(1, 1), a1 + hstepA, voffA);
            PG8_WAIT_V(8); PG8_WAIT_L(0); PG8_BAR; PG8_MMA(0, 0, At, B0); PG8_MMA(0, 1, At, B1); PG8_BAR; PG8_SCHED;
            PG8_LDA(At, 0, 1); PG8_STAGE(PG8_SB(0, 0), b2, voffB); PG8_STAGE(PG8_SB(0, 1), b2 + hstepB, voffB); PG8_STAGE(PG8_SA(0, 0), a2, voffA);
            PG8_WAIT_V(8); PG8_WAIT_L(0); PG8_BAR; PG8_MMA(1, 0, At, B0); PG8_MMA(1, 1, At, B1); PG8_BAR; PG8_SCHED;
            PG8_LDB(B0, 1, 0); PG8_LDB(B1, 1, 1); PG8_SCHED; PG8_LDA(At, 1, 0); PG8_STAGE(PG8_SA(0, 1), a2 + hstepA, voffA);
            PG8_WAIT_V(8); PG8_WAIT_L(0); PG8_BAR; PG8_MMA(0, 0, At, B0); PG8_MMA(0, 1, At, B1); PG8_BAR; PG8_SCHED;
            PG8_LDA(At, 1, 1); PG8_STAGE(PG8_SB(1, 0), b3, voffB); PG8_STAGE(PG8_SB(1, 1), b3 + hstepB, voffB); PG8_STAGE(PG8_SA(1, 0), a3, voffA);
            PG8_WAIT_V(8); PG8_WAIT_L(0); PG8_BAR; PG8_MMA(1, 0, At, B0); PG8_MMA(1, 1, At, B1); PG8_BAR; PG8_SCHED;
        }
        if (wr == 0) PG8_BAR;
        E(acc, cur, wr, wc, fr, fq);
        if (!has_next) break;
#pragma unroll
        for (int a = 0; a < 2; ++a)
#pragma unroll
            for (int b = 0; b < 2; ++b)
#pragma unroll
                for (int m = 0; m < 4; ++m)
#pragma unroll
                    for (int n = 0; n < 2; ++n) acc[a][b][m][n] = (f32x4){0.f, 0.f, 0.f, 0.f};
        cur = nxt; cA = nA; cB = nB; ++ui;
        if (wr == 1) PG8_BAR;
    }
    PG8_WAIT_V(0);
    PG8_BAR;
#undef PG8_SA
#undef PG8_SB
#undef PG8_STAGE
#undef PG8_LDA
#undef PG8_LDB
#undef PG8_MMA
#undef PG8_WAIT_V
#undef PG8_WAIT_L
#undef PG8_BAR
#undef PG8_SCHED
#undef PG8_ABASE
}
}

constexpr size_t WB_WIN = 0, WB_WOUT = 20 * MiB, WB_G5 = 28 * MiB, WB_G6 = 44 * MiB, WB_WO = 48 * MiB, WB_WUP = 52 * MiB, WB_WDN = 96 * MiB;
constexpr size_t SZ_WIN = 10 * MiB, SZ_WOUT = 4 * MiB, SZ_G5 = 8 * MiB, SZ_G6 = 2 * MiB, SZ_WO = 2 * MiB, SZ_WUP = 11 * MiB, SZ_WDN = (size_t)D * DFF * 2;
static_assert(WB_WDN + 4 * SZ_WDN <= 119 * MiB, "weight map");

struct WDesc { const float* W; const float* gain; bf16* dst; int ldw, Kv, Kd, Nv, Nd, map; };
DEVI WDesc wdesc(const PArgs& a, unsigned char* ws, int id) {
    WDesc w; w.gain = nullptr; w.map = 0; unsigned char* wb = ws + WS_WB;
    if (id < 2) { const int j = id; w.W = a.in[I_EWIN] + (size_t)j * D * NIN; w.ldw = NIN; w.Kv = w.Kd = D; w.Nv = w.Nd = NIN; w.gain = a.in[I_NMIX] + (size_t)(2 * j) * D; w.dst = (bf16*)(wb + WB_WIN + j * SZ_WIN); w.map = 1; }
    else if (id < 4) { const int j = id - 2; w.W = a.in[I_EWOUT] + (size_t)j * 2048 * D; w.ldw = D; w.Kv = w.Kd = 2048; w.Nv = w.Nd = D; w.dst = (bf16*)(wb + WB_WOUT + j * SZ_WOUT); }
    else if (id < 18) { const int q = id - 4, j = q / 7, p = q % 7; bf16* base = (bf16*)(wb + WB_G5 + j * SZ_G5); w.Kv = w.Kd = D;
        if (p < 3) { w.W = a.in[p == 0 ? I_OWR : (p == 1 ? I_OWK : I_OWV)] + (size_t)j * D * D; w.ldw = D; w.Nv = w.Nd = D; w.dst = base + (size_t)p * 1024 * D; }
        else if (p == 3) { w.W = a.in[I_OG1] + (size_t)j * D * 128; w.ldw = 128; w.Nv = 128; w.Nd = 256; w.dst = base + (size_t)3072 * D; }
        else if (p == 4) { w.W = a.in[I_OW1] + (size_t)j * D * 64; w.ldw = 64; w.Nv = 64; w.Nd = 256; w.dst = base + (size_t)3328 * D; }
        else if (p == 5) { w.W = a.in[I_OA1] + (size_t)j * D * 64; w.ldw = 64; w.Nv = 64; w.Nd = 256; w.dst = base + (size_t)3584 * D; }
        else { w.W = a.in[I_OV1]; w.ldw = 32; w.Nv = 32; w.Nd = j == 1 ? 256 : 0; w.dst = base + (size_t)3840 * D; } }
    else if (id < 26) { const int q = id - 18, j = q >> 2, p = q & 3; bf16* base = (bf16*)(wb + WB_G6 + j * SZ_G6); w.Kd = 256; w.ldw = D; w.Nv = w.Nd = D; w.dst = base + (size_t)p * 1024 * 256;
        if (p == 0) { w.W = a.in[I_OW2] + (size_t)j * 64 * D; w.Kv = 64; }
        else if (p == 1) { w.W = a.in[I_OA2] + (size_t)j * 64 * D; w.Kv = 64; }
        else if (p == 2) { w.W = a.in[I_OG2] + (size_t)j * 128 * D; w.Kv = 128; }
        else { w.W = a.in[I_OV2]; w.Kv = 32; if (j == 0) w.Nd = 0; } }
    else if (id < 28) { const int j = id - 26; w.W = a.in[I_OWO] + (size_t)j * D * D; w.ldw = D; w.Kv = w.Kd = D; w.Nv = w.Nd = D; w.dst = (bf16*)(wb + WB_WO + j * SZ_WO); }
    else if (id < 32) { const int li = id - 28; w.W = a.in[I_FWUP] + (size_t)li * D * NUP; w.ldw = NUP; w.Kv = w.Kd = D; w.Nv = w.Nd = NUP; w.gain = a.in[I_NFFN] + (size_t)li * D; w.dst = (bf16*)(wb + WB_WUP + li * SZ_WUP); w.map = FUSE_ACT ? 2 : 0; }
    else { const int li = id - 32; w.W = a.in[I_FWDN] + (size_t)li * DFF * D; w.ldw = D; w.Kv = w.Kd = DFF; w.Nv = w.Nd = D; w.dst = (bf16*)(wb + WB_WDN + li * SZ_WDN); }
    return w;
}
constexpr int N_WDESC = 36;
DEVI void wprep_item(const WDesc& w, LAS float* scr, int item, int lane) {
    const int nblk = w.Nd / 32, kb = item / nblk, nb = item % nblk, k0 = 64 * kb, n0 = 32 * nb;
    int sc0 = n0;
    if (w.map == 1 && n0 < 1024) { const int t = n0 >> 8, cp = n0 & 255; sc0 = 256 * t + ((cp & 127) >> 6) * 128 + (cp >> 7) * 64 + (cp & 63); }
    if (w.map == 2) { const int t = n0 >> 8, cp = n0 & 255; sc0 = cp < 128 ? 128 * t + cp : DFF + 128 * t + (cp - 128); }
    const bool nvalid = n0 < w.Nv;
#pragma unroll
    for (int i = 0; i < 8; ++i) { const int kk = 8 * i + (lane >> 3), k = k0 + kk; f32x4 v = (f32x4){0.f, 0.f, 0.f, 0.f};
        if (nvalid && k < w.Kv) { v = __builtin_nontemporal_load((const f32x4*)(w.W + (size_t)k * w.ldw + sc0 + 4 * (lane & 7))); if (w.gain) v = v * w.gain[k]; }
        LAS float* d = scr + kk * 33 + 4 * (lane & 7); d[0] = v.x; d[1] = v.y; d[2] = v.z; d[3] = v.w; }
    asm volatile("s_waitcnt lgkmcnt(0)" ::: "memory");
    const int cc = lane & 7;
#pragma unroll
    for (int jx = 0; jx < 4; ++jx) { const int n = (lane >> 3) + 8 * jx; const LAS float* s = scr + (8 * cc) * 33 + n;
        u32x4 o; o.x = pk2(s[0 * 33], s[1 * 33]); o.y = pk2(s[2 * 33], s[3 * 33]); o.z = pk2(s[4 * 33], s[5 * 33]); o.w = pk2(s[6 * 33], s[7 * 33]);
        *(u32x4*)(w.dst + (size_t)(n0 + n) * w.Kd + k0 + 8 * cc) = o; }
    asm volatile("s_waitcnt lgkmcnt(0)" ::: "memory");
}
DEVI void f_wprep(const Ctx& c, const PArgs& a, unsigned long long idmask, int gw, int NGW) {
    LAS float* scr = (LAS float*)(c.lds + c.wave * 16384);
#pragma unroll 1
    for (int id = 0; id < N_WDESC; ++id) {
        if (!((idmask >> id) & 1ull)) continue;
        const WDesc w = wdesc(a, c.ws, id);
        const int nitems = (w.Kd / 64) * (w.Nd / 32);
        const int start = (gw + id * 601) % NGW;
        for (int it = start; it < nitems; it += NGW) wprep_item(w, scr, it, c.lane);
    }
}
constexpr unsigned long long WM_L01 = (1ull << 1) | (1ull << 2) | (0x7full << 4) | (0xfull << 18) | (1ull << 26) | (3ull << 28) | (3ull << 32);
constexpr unsigned long long WM_L23 = (1ull << 3) | (0x7full << 11) | (0xfull << 22) | (1ull << 27) | (3ull << 30) | (3ull << 34);
static_assert((WM_L01 | WM_L23 | 1ull) == (1ull << 36) - 1 && (WM_L01 & WM_L23) == 0, "weight masks");

DEVI u32x4 pack8(const f32x4 a, const f32x4 b) { u32x4 w; w.x = pg8::cvt_pk_bf16(a[0], a[1]); w.y = pg8::cvt_pk_bf16(a[2], a[3]); w.z = pg8::cvt_pk_bf16(b[0], b[1]); w.w = pg8::cvt_pk_bf16(b[2], b[3]); return w; }
DEVI f32x4 map4(const f32x4 v, int act) {
    f32x4 o;
#pragma unroll
    for (int e = 0; e < 4; ++e) o[e] = act == 1 ? siluf_(v[e]) : act == 2 ? geluf_(v[e]) : act == 3 ? sigmoidf_(v[e]) : act == 4 ? tanhf_(v[e]) : v[e];
    return o;
}
struct EpiEvenIn {
    static constexpr bool PERM = true;
    bf16* Z; const float* RS; const float* ROPE;
    DEVI void operator()(const f32x4 (&acc)[2][2][4][2], const pg8::Unit& u, int wr, int wc, int fr, int fq) const {
        const int pn = u.pn;
        float rsv[2][4];
        { f32x4 rq[2][4];
#pragma unroll
          for (int ai = 0; ai < 2; ++ai)
#pragma unroll
            for (int m = 0; m < 4; ++m) rq[ai][m] = *(const f32x4*)(RS + (size_t)(u.pm * 256 + ai * 128 + wr * 64 + m * 16 + fr) * 16 + 4 * fq);
          asm volatile("" ::: "memory");
#pragma unroll
          for (int ai = 0; ai < 2; ++ai)
#pragma unroll
            for (int m = 0; m < 4; ++m) rsv[ai][m] = row_rstd_fin(rq[ai][m]); }
#pragma unroll
        for (int ai = 0; ai < 2; ++ai)
#pragma unroll
            for (int m = 0; m < 4; ++m) {
                const int row = u.pm * 256 + ai * 128 + wr * 64 + m * 16 + fr; const float rs = rsv[ai][m];
                if (pn < 4) {
                    const int hl = wc >> 1, d0 = (32 * wc + 8 * fq) & 63; const float sc = (pn >= 2 ? 0.08838834764831845f : 1.f) * rs;
                    const f32x4* rp = (const f32x4*)(ROPE + ((size_t)row_pos(row) * 64 + d0) * 2);
                    const f32x4 c0 = rp[0], c1 = rp[1], c2 = rp[2], c3 = rp[3];
                    const f32x4 x1a = acc[ai][0][m][0] * sc, x1b = acc[ai][0][m][1] * sc, x2a = acc[ai][1][m][0] * sc, x2b = acc[ai][1][m][1] * sc;
                    const f32x4 csa = (f32x4){c0[0], c0[2], c1[0], c1[2]}, sna = (f32x4){c0[1], c0[3], c1[1], c1[3]}, csb = (f32x4){c2[0], c2[2], c3[0], c3[2]}, snb = (f32x4){c2[1], c2[3], c3[1], c3[3]};
                    const f32x4 y1a = x1a * csa - x2a * sna, y1b = x1b * csb - x2b * snb, y2a = x1a * sna + x2a * csa, y2b = x1b * snb + x2b * csb;
                    bf16* dst = Z + (size_t)row * NIN + pn * 256 + hl * 128 + d0;
                    *(u32x4*)dst = pack8(y1a, y1b); *(u32x4*)(dst + 64) = pack8(y2a, y2b);
                } else {
                    const int act = (pn >= 8 && pn < 12) ? 1 : (pn >= 16 ? 2 : 0);
#pragma unroll
                    for (int bj = 0; bj < 2; ++bj) { bf16* dst = Z + (size_t)row * NIN + pn * 256 + bj * 128 + wc * 32 + fq * 8;
                        *(u32x4*)dst = pack8(map4(acc[ai][bj][m][0] * rs, act), map4(acc[ai][bj][m][1] * rs, act)); }
                }
            }
    }
};
struct EpiResidual {
    static constexpr bool PERM = false;
    bf16* XB; float* RS;
    DEVI void operator()(const f32x4 (&acc)[2][2][4][2], const pg8::Unit& u, int wr, int wc, int fr, int fq) const {
#pragma unroll
        for (int ai = 0; ai < 2; ++ai) {
            u32x2 xo[4][2][2];
#pragma unroll
            for (int m = 0; m < 4; ++m)
#pragma unroll
                for (int bj = 0; bj < 2; ++bj)
#pragma unroll
                    for (int n = 0; n < 2; ++n) xo[m][bj][n] = *(const u32x2*)(XB + (size_t)(u.pm * 256 + ai * 128 + wr * 64 + m * 16 + fr) * D + u.pn * 256 + bj * 128 + wc * 32 + n * 16 + fq * 4);
            asm volatile("" ::: "memory");
#pragma unroll
            for (int m = 0; m < 4; ++m) {
                const int row = u.pm * 256 + ai * 128 + wr * 64 + m * 16 + fr; float ss = 0.f;
#pragma unroll
                for (int bj = 0; bj < 2; ++bj)
#pragma unroll
                    for (int n = 0; n < 2; ++n) { const size_t o = (size_t)row * D + u.pn * 256 + bj * 128 + wc * 32 + n * 16 + fq * 4;
                        const u32x2 x_ = xo[m][bj][n];
                        f32x4 v = acc[ai][bj][m][n]; v[0] += __uint_as_float(x_.x << 16); v[1] += __uint_as_float(x_.x & 0xffff0000u); v[2] += __uint_as_float(x_.y << 16); v[3] += __uint_as_float(x_.y & 0xffff0000u);
                        u32x2 w; w.x = pk2(v[0], v[1]); w.y = pk2(v[2], v[3]); *(u32x2*)(XB + o) = w;
                        ss += (v[0] * v[0] + v[1] * v[1]) + (v[2] * v[2] + v[3] * v[3]); }
                ss += __shfl_xor(ss, 16); ss += __shfl_xor(ss, 32);
                if (fq == 0) RS[(size_t)row * 16 + u.pn * 4 + wc] = ss;
            }
        }
    }
};
struct EpiUp {
    static constexpr bool PERM = true;
    bf16* U; const float* RS;
    DEVI void operator()(const f32x4 (&acc)[2][2][4][2], const pg8::Unit& u, int wr, int wc, int fr, int fq) const {
#pragma unroll
        for (int ai = 0; ai < 2; ++ai)
#pragma unroll
            for (int m = 0; m < 4; ++m) {
                const int row = u.pm * 256 + ai * 128 + wr * 64 + m * 16 + fr; const float rs = row_rstd(RS, row);
#pragma unroll
                for (int bj = 0; bj < 2; ++bj) *(u32x4*)(U + (size_t)row * NUP + u.pn * 256 + bj * 128 + wc * 32 + fq * 8) = pack8(acc[ai][bj][m][0] * rs, acc[ai][bj][m][1] * rs);
            }
    }
};
struct EpiOddIn {
    static constexpr bool PERM = true;
    bf16 *R, *Kb, *Vb, *LM; int j;
    DEVI void operator()(const f32x4 (&acc)[2][2][4][2], const pg8::Unit& u, int wr, int wc, int fr, int fq) const {
        const int pn = u.pn; bf16* base; int pitch, off; float al, be, ga; bool ident, both;
        bf16 *r_ = R, *k_ = Kb, *v_ = Vb, *l_ = LM; asm volatile("" : "+s"(r_), "+s"(k_), "+s"(v_), "+s"(l_));
        if (pn < 12) { base = pn < 4 ? r_ : (pn < 8 ? k_ : v_); pitch = D; off = (pn & 3) * 256; ident = true; both = true; al = 1.f; be = 1.f; ga = 0.f; }
        else { base = l_; pitch = LML; off = pn == 12 ? 0 : (pn == 13 ? 256 : (pn == 14 ? 384 : 128)); ident = pn >= 14; both = pn == 14 || (pn == 12 && j == 0);
               al = pn == 13 ? 2.f : 1.f; be = al; ga = pn == 13 ? -1.f : 0.f; }
        bf16* p0 = base + off + wc * 32 + fq * 8;
#pragma unroll
        for (int ai = 0; ai < 2; ++ai)
#pragma unroll
            for (int m = 0; m < 4; ++m) {
                const int row = u.pm * 256 + ai * 128 + wr * 64 + m * 16 + fr;
#pragma unroll
                for (int bj = 0; bj < 2; ++bj) {
                    f32x4 v0 = acc[ai][bj][m][0], v1 = acc[ai][bj][m][1];
                    if (!ident) {
#pragma unroll
                        for (int e = 0; e < 4; ++e) { v0[e] = al * __builtin_amdgcn_rcpf(1.f + __expf(-be * v0[e])) + ga; v1[e] = al * __builtin_amdgcn_rcpf(1.f + __expf(-be * v1[e])) + ga; } }
                    if (bj == 0 || both) *(u32x4*)(p0 + (size_t)row * pitch + bj * 128) = pack8(v0, v1); }
            }
    }
};
struct EpiDecay {
    static constexpr bool PERM = true;
    float* WD; const float* w0;
    DEVI void operator()(const f32x4 (&acc)[2][2][4][2], const pg8::Unit& u, int wr, int wc, int fr, int fq) const {
        const int cb = u.pn * 256 + wc * 32 + fq * 8;
#pragma unroll
        for (int bj = 0; bj < 2; ++bj) {
            const f32x4 bia0 = *(const f32x4*)(w0 + cb + bj * 128), bia1 = *(const f32x4*)(w0 + cb + bj * 128 + 4);
#pragma unroll
            for (int ai = 0; ai < 2; ++ai)
#pragma unroll
                for (int m = 0; m < 4; ++m) {
                    const int row = u.pm * 256 + ai * 128 + wr * 64 + m * 16 + fr; const size_t o = (size_t)row * D + cb + bj * 128;
                    f32x4 v0_ = acc[ai][bj][m][0] + bia0, v1_ = acc[ai][bj][m][1] + bia1;
#pragma unroll
                    for (int e = 0; e < 4; ++e) { v0_[e] = __expf(-0.6065306597126334f * __builtin_amdgcn_rcpf(1.f + __expf(-v0_[e]))); v1_[e] = __expf(-0.6065306597126334f * __builtin_amdgcn_rcpf(1.f + __expf(-v1_[e]))); }
                    *(f32x4*)(WD + o) = v0_; *(f32x4*)(WD + o + 4) = v1_;
                }
        }
    }
};
struct EpiGate {
    static constexpr bool PERM = true;
    bf16* AG; const float *a0, *v0;
    DEVI void operator()(const f32x4 (&acc)[2][2][4][2], const pg8::Unit& u, int wr, int wc, int fr, int fq) const {
        const int grp = u.pn >> 2; const int cb = (u.pn & 3) * 256 + wc * 32 + fq * 8;
        const float* bp = grp == 2 ? v0 : a0; const float bsc = grp == 1 ? 0.f : 1.f;
        bf16* ob = AG + (size_t)grp * M * D;
#pragma unroll
        for (int bj = 0; bj < 2; ++bj) {
            const f32x4 bia0 = *(const f32x4*)(bp + cb + bj * 128) * bsc, bia1 = *(const f32x4*)(bp + cb + bj * 128 + 4) * bsc;
#pragma unroll
            for (int ai = 0; ai < 2; ++ai)
#pragma unroll
                for (int m = 0; m < 4; ++m) {
                    const int row = u.pm * 256 + ai * 128 + wr * 64 + m * 16 + fr; const size_t o = (size_t)row * D + cb + bj * 128;
                    f32x4 v0_ = acc[ai][bj][m][0] + bia0, v1_ = acc[ai][bj][m][1] + bia1;
                    if (grp != 1) {
#pragma unroll
                        for (int e = 0; e < 4; ++e) { v0_[e] = __builtin_amdgcn_rcpf(1.f + __expf(-v0_[e])); v1_[e] = __builtin_amdgcn_rcpf(1.f + __expf(-v1_[e])); } }
                    *(u32x4*)(ob + o) = pack8(v0_, v1_);
                }
        }
    }
};

DEVI void f_even_in(const Ctx& c, int li) {
    const int j = li >> 1;
    pg8::Gemm g{(const bf16*)(c.ws + WS_XB), (const bf16*)(c.ws + WS_WB + WB_WIN + j * SZ_WIN), M, NIN, D, D, 0ull, 0};
    pg8::StaticOrder S; S.init(M, NIN, c.G, c.bid);
    EpiEvenIn E{(bf16*)(c.ws + WS_Z), (const float*)(c.ws + WS_RS), (const float*)(c.ws + WS_ROPE)};
    pg8::gemm_phase<EpiEvenIn>(c.lds, c.tid, g, S, E);
}
DEVI void f_gemm_residual(const Ctx& c, const bf16* A, int lda, const bf16* Bt, int K, bool wxb) {
    pg8::Gemm g{A, Bt, M_MAIN, D, K, lda, 0ull, 0};
    pg8::StaticOrder S; S.init(M_MAIN, D, c.G, c.bid);
    (void)wxb; EpiResidual E{(bf16*)(c.ws + WS_XB), (float*)(c.ws + WS_RS)};
    pg8::gemm_phase<EpiResidual>(c.lds, c.tid, g, S, E);
}
DEVI void f_ffn_up(const Ctx& c, int li) {
    pg8::Gemm g{(const bf16*)(c.ws + WS_XB), (const bf16*)(c.ws + WS_WB + WB_WUP + li * SZ_WUP), M, NUP, D, D, 0ull, 0};
    pg8::StaticOrder S; S.init(M, NUP, c.G, c.bid);
    EpiUp E{(bf16*)(c.ws + WS_U), (const float*)(c.ws + WS_RS)};
    pg8::gemm_phase<EpiUp>(c.lds, c.tid, g, S, E);
}
DEVI void f_odd_in(const Ctx& c, int li) {
    const int j = li >> 1, N5 = j == 0 ? 3840 : 4096;
    pg8::Gemm g{(const bf16*)(c.ws + WS_XMIX), (const bf16*)(c.ws + WS_WB + WB_G5 + j * SZ_G5), M, N5, D, D, 0x3415333322220000ull, (size_t)M * D};
    pg8::StaticOrder S; S.init(M, N5, c.G, c.bid);
    EpiOddIn E{(bf16*)(c.ws + WS_R), (bf16*)(c.ws + WS_K), j == 0 ? (bf16*)((unsigned char*)c.out + DO_VFIRST) : (bf16*)(c.ws + WS_V), (bf16*)((unsigned char*)c.out + DO_LMID), j};
    pg8::gemm_phase<EpiOddIn>(c.lds, c.tid, g, S, E);
}
DEVI void f_odd_lora(const Ctx& c, const PArgs& a, int li) {
    const int j = li >> 1;
    const bf16* LM = (const bf16*)((unsigned char*)c.out + DO_LMID); const bf16* W6 = (const bf16*)(c.ws + WS_WB + WB_G6 + j * SZ_G6);
    int K6 = 256; asm volatile("" : "+s"(K6));
    {
        pg8::Gemm g{LM + 256, W6, M, D, K6, LML, 0ull, 0};
        pg8::StaticOrder S; S.init(M, D, c.G, c.bid);
        EpiDecay E{(float*)(c.ws + WS_WDEC), a.in[I_OW0] + (size_t)j * D};
        pg8::gemm_phase<EpiDecay>(c.lds, c.tid, g, S, E);
    }
    {
        const int N6 = j == 0 ? 2048 : 3072;
        pg8::Gemm g{LM, W6 + (size_t)1024 * 256, M, N6, K6, LML, 0x111100003333ull, 128};
        int c2 = c.bid + (c.G >> 1); if (c2 >= c.G) c2 -= c.G;
        pg8::StaticOrder S; S.init(M, N6, c.G, c2);
        EpiGate E{(bf16*)(c.ws + WS_AG), a.in[I_OA0] + (size_t)j * D, a.in[I_OV0]};
        pg8::gemm_phase<EpiGate>(c.lds, c.tid, g, S, E);
    }
}

typedef short bf16x8_t __attribute__((ext_vector_type(8)));
constexpr int LRU_XS = 0, LRU_AI = 33792, LRU_GT = LRU_AI + 128 * 136 * 2, LRU_END = LRU_GT + 128 * 256;
static_assert(LRU_END + 8 * 1024 <= RING_BYTES, "lru lds");
#define LWAIT_() asm volatile("s_waitcnt lgkmcnt(0)" ::: "memory")
#define LDS_BAR() asm volatile("s_waitcnt lgkmcnt(0)\n\ts_barrier" ::: "memory")
DEVI void f_lru_unit(const Ctx& c, const PArgs& a, int j, int g, bool sample, int b) {
    const bf16* Z = (const bf16*)(c.ws + WS_Z); bf16* MIX = (bf16*)(c.ws + WS_MIX);
    LAS unsigned char* XS = c.lds + LRU_XS; LAS unsigned char* AI = c.lds + LRU_AI; LAS unsigned char* GT = c.lds + LRU_GT;
    const int w = c.wave, fr = c.lane & 15, fq = c.lane >> 4, col = 16 * w + fr, ch = g * 128 + col;
    const int row0 = sample ? MP : b * TP, ntok = sample ? 128 : TP, nchunks = sample ? 1 : (TP + 127) / 128;
    bf16x8_t Bw[2][4];
#pragma unroll
    for (int gate = 0; gate < 2; ++gate) {
        const float* Wg = a.in[gate == 0 ? I_EWA : I_EWX] + (size_t)(j * 8 + g) * 128 * 128;
        __syncthreads();
        { f32x4 wv[8];
#pragma unroll
          for (int i = 0; i < 8; ++i) wv[i] = *(const f32x4*)(Wg + (unsigned)(i * NT + c.tid) * 4u);
          asm volatile("" ::: "memory");
#pragma unroll
          for (int i = 0; i < 8; ++i) *(LAS f32x4*)(c.lds + (unsigned)(i * NT + c.tid) * 16u) = wv[i]; }
        __syncthreads();
#pragma unroll
        for (int ks = 0; ks < 4; ++ks) { bf16x8_t vv;
#pragma unroll
            for (int jj = 0; jj < 8; ++jj) vv[jj] = (short)f2bf(*(const LAS float*)(c.lds + ((32 * ks + 8 * fq + jj) * 128 + col) * 4));
            Bw[gate][ks] = vv; }
    }
    const float ba = a.in[I_EBA][(size_t)j * 1024 + ch], bx = a.in[I_EBX][(size_t)j * 1024 + ch], sp8 = 8.f * softplusf_(-a.in[I_ELAM][(size_t)j * 1024 + ch]);
    const int cc = c.tid & 127, rq = c.tid >> 7, cch = g * 128 + cc;
    const float* CW = a.in[I_ECW] + (size_t)j * 4 * 1024;
    const float cw0 = CW[cch], cw1 = CW[1024 + cch], cw2 = CW[2048 + cch], cw3 = CW[3072 + cch], cb = a.in[I_ECB][(size_t)j * 1024 + cch];
    float carry = 0.f;
    u32x4 pfx[5], pfg[4];
    const bf16* zx = Z + (size_t)row0 * NIN + 3072 + g * 128; const bf16* zg = Z + (size_t)row0 * NIN + 4096 + g * 128;
#define LRU_PREFETCH(t0) do { _Pragma("unroll") for (int i = 0; i < 5; ++i) { const int p = i * NT + c.tid, r = p >> 4, q = p & 15; const int t = (t0) - 3 + r; \
            pfx[i] = (u32x4){0u, 0u, 0u, 0u}; if (r < 131 && t >= 0) pfx[i] = *(const u32x4*)(zx + (unsigned)(t * NIN + q * 8)); } \
        _Pragma("unroll") for (int i = 0; i < 4; ++i) { const int p = i * NT + c.tid, r = p >> 4, q = p & 15; pfg[i] = *(const u32x4*)(zg + (unsigned)(((t0) + r) * NIN + q * 8)); } } while (0)
    LRU_PREFETCH(0);
    for (int ci = 0; ci < nchunks; ++ci) {
        const int t0 = ci * 128, nv = (ntok - t0) < 128 ? (ntok - t0) : 128;
        __syncthreads();
#pragma unroll
        for (int i = 0; i < 5; ++i) { const int p = i * NT + c.tid; if (p < 131 * 16) *(LAS u32x4*)(XS + p * 16) = pfx[i]; }
#pragma unroll
        for (int i = 0; i < 4; ++i) { const int p = i * NT + c.tid; *(LAS u32x4*)(GT + p * 16) = pfg[i]; }
        __syncthreads();
        if (ci + 1 < nchunks) LRU_PREFETCH(t0 + 128);
        if (!sample) {
            float x0 = bf2f(*(const LAS bf16*)(XS + ((rq * 32 + 0) * 128 + cc) * 2)), x1 = bf2f(*(const LAS bf16*)(XS + ((rq * 32 + 1) * 128 + cc) * 2)), x2 = bf2f(*(const LAS bf16*)(XS + ((rq * 32 + 2) * 128 + cc) * 2));
#pragma unroll 8
            for (int i = 0; i < 32; ++i) { const int lr = rq * 32 + i; const float x3 = bf2f(*(const LAS bf16*)(XS + ((lr + 3) * 128 + cc) * 2));
                *(LAS bf16*)(AI + (lr * 136 + cc) * 2) = f2bf(cb + cw3 * x3 + cw2 * x2 + cw1 * x1 + cw0 * x0); x0 = x1; x1 = x2; x2 = x3; }
        } else {
            const float* SC = a.in[I_SLCONV] + (size_t)j * BS * 3 * 1024 + cch; float* SCO = c.out + O_LCONVS + (size_t)j * BS * 3 * 1024 + cch;
#pragma unroll 2
            for (int i = 0; i < 32; ++i) { const int lr = rq * 32 + i; const unsigned so = (unsigned)(lr * 3 * 1024);
                const float h0 = SC[so], h1 = SC[so + 1024u], h2 = SC[so + 2048u], x3 = bf2f(*(const LAS bf16*)(XS + ((lr + 3) * 128 + cc) * 2));
                *(LAS bf16*)(AI + (lr * 136 + cc) * 2) = f2bf(cb + cw3 * x3 + cw2 * h2 + cw1 * h1 + cw0 * h0);
                SCO[so] = h1; SCO[so + 1024u] = h2; SCO[so + 2048u] = x3; }
        }
        __syncthreads();
#pragma unroll 1
        for (int m = 0; m < 8; ++m) {
            f32x4 accr_ = (f32x4){0.f, 0.f, 0.f, 0.f}, acci_ = (f32x4){0.f, 0.f, 0.f, 0.f};
#pragma unroll
            for (int ks = 0; ks < 4; ++ks) { const bf16x8_t af = *(const LAS bf16x8_t*)(AI + ((16 * m + fr) * 136 + 32 * ks + 8 * fq) * 2);
                accr_ = __builtin_amdgcn_mfma_f32_16x16x32_bf16(af, Bw[0][ks], accr_, 0, 0, 0);
                acci_ = __builtin_amdgcn_mfma_f32_16x16x32_bf16(af, Bw[1][ks], acci_, 0, 0, 0); }
            float av[4], uv[4];
#pragma unroll
            for (int r = 0; r < 4; ++r) { const int lr = 16 * m + 4 * fq + r;
                const float xcv = bf2f(*(const LAS bf16*)(AI + (lr * 136 + col) * 2));
                const float rg = sigmoidf_(accr_[r] + ba), ig = sigmoidf_(acci_[r] + bx);
                const float la = -sp8 * rg, t2 = 2.f * la;
                const float em1 = t2 > -0.02f ? t2 * (1.f + t2 * (0.5f + t2 * 0.16666667f)) : __expf(t2) - 1.f;
                av[r] = __expf(la); uv[r] = sqrtf(-em1) * (ig * xcv); }
            float hv[4];
            if (!sample) {
                const float Ai = av[0] * av[1] * av[2] * av[3], Ui = ((uv[0] * av[1] + uv[1]) * av[2] + uv[2]) * av[3] + uv[3];
                LAS f32x2_t* cs = (LAS f32x2_t*)(c.lds + LRU_END + w * 1024 + (m & 1) * 512);
                cs[fq * 16 + fr] = (f32x2_t){Ai, Ui};
                LWAIT_();
                const f32x2_t c0 = cs[fr], c1 = cs[16 + fr], c2 = cs[32 + fr], c3 = cs[48 + fr];
                const float h0e = c0.x * carry + c0.y, h1e = c1.x * h0e + c1.y, h2e = c2.x * h1e + c2.y, h3e = c3.x * h2e + c3.y;
                const float hin = fq == 0 ? carry : (fq == 1 ? h0e : (fq == 2 ? h1e : h2e));
                carry = h3e;
                hv[0] = av[0] * hin + uv[0]; hv[1] = av[1] * hv[0] + uv[1]; hv[2] = av[2] * hv[1] + uv[2]; hv[3] = av[3] * hv[2] + uv[3];
                if (nv < 128 && m == ((TP % 128) - 1) / 16 && fq == (((TP % 128) - 1) & 15) / 4) c.out[O_LRUP + (size_t)(j * BP + b) * 1024 + ch] = hv[((TP % 128) - 1) & 3];
            } else {
#pragma unroll
                for (int r = 0; r < 4; ++r) { const int lr = 16 * m + 4 * fq + r; const unsigned so = (unsigned)(lr * 1024);
                    hv[r] = av[r] * (a.in[I_SLRU] + (size_t)j * BS * 1024 + ch)[so] + uv[r]; (c.out + O_LRUS + (size_t)j * BS * 1024 + ch)[so] = hv[r]; }
            }
#pragma unroll
            for (int r = 0; r < 4; ++r) { const int lr = 16 * m + 4 * fq + r; LAS bf16* gp = (LAS bf16*)(GT + (lr * 128 + col) * 2); *gp = f2bf(hv[r] * bf2f(*gp)); }
        }
        if (!sample && nv < 128 && c.tid < 128) {
#pragma unroll
            for (int k = 0; k < 3; ++k) c.out[O_LCONVP + ((size_t)(j * BP + b) * 3 + k) * 1024 + g * 128 + c.tid] = bf2f(*(const LAS bf16*)(XS + ((nv + k) * 128 + c.tid) * 2));
        }
        __syncthreads();
#pragma unroll
        for (int i = 0; i < 4; ++i) { const int p = i * NT + c.tid, r = p >> 4, q = p & 15;
            if (r < nv) *(u32x4*)(MIX + (size_t)(row0 + t0 + r) * 2048 + 1024 + g * 128 + q * 8) = *(const LAS u32x4*)(GT + p * 16); }
    }
#undef LRU_PREFETCH
    __syncthreads();
}

#define DPP_F(v, ctrl) __builtin_bit_cast(float, __builtin_amdgcn_update_dpp(0, __builtin_bit_cast(int, (v)), (ctrl), 0xF, 0xF, true))
DEVI float red8(float x) { x += DPP_F(x, 0xB1); x += DPP_F(x, 0x4E); x += DPP_F(x, 0x141); return x; }
DEVI float red32(float x) { x += DPP_F(x, 0xB1); x += DPP_F(x, 0x4E); x += DPP_F(x, 0x141); x += DPP_F(x, 0x140); x += __shfl_xor(x, 16); return x; }
typedef unsigned long long u64x2_t __attribute__((ext_vector_type(2)));
DEVI void tr_frag2(unsigned tile, int pitch, int krow0, int col0, int fr, int fq, bf16x8_t& f0, bf16x8_t& f1) {
    const unsigned base = tile + (unsigned)((krow0 + 8 * fq + (fr >> 2)) * pitch + (col0 + 4 * (fr & 3)) * 2);
    unsigned long long a0, a1, b0, b1;
    asm volatile("ds_read_b64_tr_b16 %0, %4\n\tds_read_b64_tr_b16 %1, %5\n\tds_read_b64_tr_b16 %2, %6\n\tds_read_b64_tr_b16 %3, %7\n\ts_waitcnt lgkmcnt(0)"
                 : "=&v"(a0), "=&v"(a1), "=&v"(b0), "=&v"(b1) : "v"(base), "v"(base + 4u * (unsigned)pitch), "v"(base + 32u * (unsigned)pitch), "v"(base + 36u * (unsigned)pitch) : "memory");
    u64x2_t v0; v0.x = a0; v0.y = a1; u64x2_t v1; v1.x = b0; v1.y = b1;
    f0 = __builtin_bit_cast(bf16x8_t, v0); f1 = __builtin_bit_cast(bf16x8_t, v1);
}
DEVI void tr_frag4(unsigned tile, int pitch, int col0, int col1, int fr, int fq, bf16x8_t& f00, bf16x8_t& f01, bf16x8_t& f10, bf16x8_t& f11) {
    const unsigned b0 = tile + (unsigned)((8 * fq + (fr >> 2)) * pitch + (col0 + 4 * (fr & 3)) * 2), b1 = b0 + (unsigned)((col1 - col0) * 2);
    unsigned long long a0, a1, a2, a3, c0, c1, c2, c3;
    asm volatile("ds_read_b64_tr_b16 %0, %8\n\tds_read_b64_tr_b16 %1, %9\n\tds_read_b64_tr_b16 %2, %10\n\tds_read_b64_tr_b16 %3, %11\n\t"
                 "ds_read_b64_tr_b16 %4, %12\n\tds_read_b64_tr_b16 %5, %13\n\tds_read_b64_tr_b16 %6, %14\n\tds_read_b64_tr_b16 %7, %15\n\ts_waitcnt lgkmcnt(0)"
                 : "=&v"(a0), "=&v"(a1), "=&v"(a2), "=&v"(a3), "=&v"(c0), "=&v"(c1), "=&v"(c2), "=&v"(c3)
                 : "v"(b0), "v"(b0 + 4u * (unsigned)pitch), "v"(b0 + 32u * (unsigned)pitch), "v"(b0 + 36u * (unsigned)pitch), "v"(b1), "v"(b1 + 4u * (unsigned)pitch), "v"(b1 + 32u * (unsigned)pitch), "v"(b1 + 36u * (unsigned)pitch) : "memory");
    u64x2_t v; v.x = a0; v.y = a1; f00 = __builtin_bit_cast(bf16x8_t, v); v.x = a2; v.y = a3; f01 = __builtin_bit_cast(bf16x8_t, v);
    v.x = c0; v.y = c1; f10 = __builtin_bit_cast(bf16x8_t, v); v.x = c2; v.y = c3; f11 = __builtin_bit_cast(bf16x8_t, v);
}
constexpr int RC = 64;
constexpr int RT_QS = 0, RT_KS = RT_QS + RC * 272, RT_KD = RT_KS + RC * 272, RT_VS = RT_KD + RC * 272, RT_PS = RT_VS + RC * 528, RT_OT = RT_PS + RC * 144, RT_END = RT_OT + RC * 528;
static_assert(RT_END <= RING_BYTES, "ret lds");
DEVI void f_ret_prompt(const Ctx& c, const PArgs& a, int j, int b, int hd) {
    const bf16* Z = (const bf16*)(c.ws + WS_Z); bf16* MIX = (bf16*)(c.ws + WS_MIX);
    const unsigned L0 = (unsigned)(size_t)c.lds;
    LAS unsigned char* QS = c.lds + RT_QS; LAS unsigned char* KS = c.lds + RT_KS; LAS unsigned char* KD = c.lds + RT_KD; LAS unsigned char* VS = c.lds + RT_VS; LAS unsigned char* PS = c.lds + RT_PS;
    const int w = c.wave;
    const float l2g0 = log2f(1.f - exp2f(-5.f - (float)hd));
    const bf16* zb = Z + (size_t)(b * TP) * NIN; const int qcol = hd * 128, kcol = 512 + hd * 128, vcol = 1024 + hd * 256;
    const float* gn = a.in[I_ERGN] + (size_t)j * 1024 + hd * 256;
    f32x4 Sacc[8][2];
#pragma unroll
    for (int db = 0; db < 8; ++db) { Sacc[db][0] = (f32x4){0.f, 0.f, 0.f, 0.f}; Sacc[db][1] = (f32x4){0.f, 0.f, 0.f, 0.f}; }
    u32x4 pf[8];
#define RET_PREFETCH(t0) do { _Pragma("unroll") for (int i = 0; i < 8; ++i) { int r, col; \
            if (i < 4) { const int p = (i & 1) * NT + c.tid; r = p >> 4; col = (i < 2 ? qcol : kcol) + (p & 15) * 8; } else { const int p = (i - 4) * NT + c.tid; r = p >> 5; col = vcol + (p & 31) * 8; } \
            pf[i] = (u32x4){0u, 0u, 0u, 0u}; if ((t0) + r < TP) pf[i] = *(const u32x4*)(zb + (unsigned)(((t0) + r) * NIN + col)); } } while (0)
    RET_PREFETCH(0);
    const int nchunks = (TP + RC - 1) / RC;
#pragma unroll 1
    for (int ci = 0; ci < nchunks; ++ci) {
        const int t0 = ci * RC, nv = (TP - t0) < RC ? (TP - t0) : RC;
        int lane_ = c.lane; float l2g = l2g0; asm volatile("" : "+v"(lane_), "+v"(l2g));
        const int fr = lane_ & 15, fq = lane_ >> 4, tid_ = w * 64 + lane_;
        LDS_BAR();
#pragma unroll
        for (int i = 0; i < 8; ++i) {
            if (i < 4) { const int p = (i & 1) * NT + tid_, r = p >> 4, q = p & 15;
                *(LAS u32x4*)((i < 2 ? QS : KS) + r * 272 + q * 16) = pf[i];
                if (i >= 2) { const float dk = __builtin_amdgcn_exp2f((float)(nv - 1 - r) * l2g); u32x4 o;
#pragma unroll
                    for (int e = 0; e < 4; ++e) { const unsigned v = pf[i][e]; o[e] = pk2(__uint_as_float(v << 16) * dk, __uint_as_float(v & 0xffff0000u) * dk); }
                    *(LAS u32x4*)(KD + r * 272 + q * 16) = o; } }
            else { const int p = (i - 4) * NT + tid_, r = p >> 5, q = p & 31; *(LAS u32x4*)(VS + r * 528 + q * 16) = pf[i]; }
        }
        LDS_BAR();
        if (ci + 1 < nchunks) RET_PREFETCH(t0 + RC);
        u32x4 gcur[4];
#pragma unroll
        for (int i = 0; i < 4; ++i) { const int p = i * NT + tid_, r = p >> 5, q = p & 31; gcur[i] = (u32x4){0u, 0u, 0u, 0u};
            if (r < nv) gcur[i] = *(const u32x4*)(zb + (unsigned)((t0 + r) * NIN + 2048 + hd * 256 + q * 8)); }
        { const int cb = w >> 1;
#pragma unroll
          for (int si = 0; si < 2; ++si) { const int sb = 2 * (w & 1) + si; f32x4 pacc = (f32x4){0.f, 0.f, 0.f, 0.f};
#pragma unroll
              for (int ks = 0; ks < 4; ++ks) { const bf16x8_t af = *(const LAS bf16x8_t*)(QS + (16 * cb + fr) * 272 + (32 * ks + 8 * fq) * 2);
                  const bf16x8_t bfr = *(const LAS bf16x8_t*)(KS + (16 * sb + fr) * 272 + (32 * ks + 8 * fq) * 2);
                  pacc = __builtin_amdgcn_mfma_f32_16x16x32_bf16(af, bfr, pacc, 0, 0, 0); }
#pragma unroll
              for (int r = 0; r < 4; ++r) { const int cc = 16 * cb + 4 * fq + r, ss = 16 * sb + fr; const float v = cc >= ss ? pacc[r] * __builtin_amdgcn_exp2f((float)(cc - ss) * l2g) : 0.f;
                  *(LAS bf16*)(PS + cc * 144 + ss * 2) = f2bf(v); } } }
        f32x4 Oacc[4][2];
#pragma unroll
        for (int cb = 0; cb < 4; ++cb) { Oacc[cb][0] = (f32x4){0.f, 0.f, 0.f, 0.f}; Oacc[cb][1] = (f32x4){0.f, 0.f, 0.f, 0.f}; }
#pragma unroll
        for (int kk = 0; kk < 4; ++kk) {
            bf16x8_t sb_[2];
#pragma unroll
            for (int en = 0; en < 2; ++en) { u32x4 t; t.x = pk2(Sacc[2 * kk][en][0], Sacc[2 * kk][en][1]); t.y = pk2(Sacc[2 * kk][en][2], Sacc[2 * kk][en][3]);
                t.z = pk2(Sacc[2 * kk + 1][en][0], Sacc[2 * kk + 1][en][1]); t.w = pk2(Sacc[2 * kk + 1][en][2], Sacc[2 * kk + 1][en][3]); sb_[en] = __builtin_bit_cast(bf16x8_t, t); }
#pragma unroll
            for (int cb = 0; cb < 4; ++cb) {
                const u32x2 qa = *(const LAS u32x2*)(QS + (16 * cb + fr) * 272 + (32 * kk + 4 * fq) * 2), qb = *(const LAS u32x2*)(QS + (16 * cb + fr) * 272 + (32 * kk + 16 + 4 * fq) * 2);
                u32x4 t; t.x = qa.x; t.y = qa.y; t.z = qb.x; t.w = qb.y; const bf16x8_t af = __builtin_bit_cast(bf16x8_t, t);
                Oacc[cb][0] = __builtin_amdgcn_mfma_f32_16x16x32_bf16(af, sb_[0], Oacc[cb][0], 0, 0, 0);
                Oacc[cb][1] = __builtin_amdgcn_mfma_f32_16x16x32_bf16(af, sb_[1], Oacc[cb][1], 0, 0, 0); }
        }
#pragma unroll
        for (int cb = 0; cb < 4; ++cb)
#pragma unroll
            for (int r = 0; r < 4; ++r) { const float dc = __builtin_amdgcn_exp2f((float)(16 * cb + 4 * fq + r + 1) * l2g); Oacc[cb][0][r] *= dc; Oacc[cb][1][r] *= dc; }
        LDS_BAR();
        bf16x8_t vf[2][2];
        tr_frag4(L0 + RT_VS, 528, 32 * w, 32 * w + 16, fr, fq, vf[0][0], vf[0][1], vf[1][0], vf[1][1]);
#pragma unroll
        for (int cb = 0; cb < 4; ++cb)
#pragma unroll
            for (int ks = 0; ks < 2; ++ks) { const bf16x8_t af = *(const LAS bf16x8_t*)(PS + (16 * cb + fr) * 144 + (32 * ks + 8 * fq) * 2);
                Oacc[cb][0] = __builtin_amdgcn_mfma_f32_16x16x32_bf16(af, vf[0][ks], Oacc[cb][0], 0, 0, 0);
                Oacc[cb][1] = __builtin_amdgcn_mfma_f32_16x16x32_bf16(af, vf[1][ks], Oacc[cb][1], 0, 0, 0); }
        LAS unsigned char* OT = c.lds + RT_OT;
#pragma unroll
        for (int cb = 0; cb < 4; ++cb)
#pragma unroll
            for (int en = 0; en < 2; ++en)
#pragma unroll
                for (int r = 0; r < 4; ++r) *(LAS bf16*)(OT + (16 * cb + 4 * fq + r) * 528 + (32 * w + 16 * en + fr) * 2) = f2bf(Oacc[cb][en][r]);
        { const float dS = __builtin_amdgcn_exp2f((float)nv * l2g);
#pragma unroll
          for (int d2 = 0; d2 < 4; ++d2) {
              bf16x8_t kf[2][2]; tr_frag4(L0 + RT_KD, 272, 32 * d2, 32 * d2 + 16, fr, fq, kf[0][0], kf[0][1], kf[1][0], kf[1][1]);
#pragma unroll
              for (int dd = 0; dd < 2; ++dd) { const int db = 2 * d2 + dd; Sacc[db][0] = Sacc[db][0] * dS; Sacc[db][1] = Sacc[db][1] * dS;
#pragma unroll
                  for (int ks = 0; ks < 2; ++ks) {
                      Sacc[db][0] = __builtin_amdgcn_mfma_f32_16x16x32_bf16(kf[dd][ks], vf[0][ks], Sacc[db][0], 0, 0, 0);
                      Sacc[db][1] = __builtin_amdgcn_mfma_f32_16x16x32_bf16(kf[dd][ks], vf[1][ks], Sacc[db][1], 0, 0, 0); } } } }
        LDS_BAR();
#pragma unroll
        for (int i = 0; i < 4; ++i) { const int p = i * NT + tid_, r = p >> 5, q = p & 31;
            const u32x4 ov = *(const LAS u32x4*)(OT + r * 528 + q * 16);
            float o[8]; float s1 = 0.f, s2 = 0.f;
#pragma unroll
            for (int e = 0; e < 4; ++e) { o[2 * e] = __uint_as_float(ov[e] << 16); o[2 * e + 1] = __uint_as_float(ov[e] & 0xffff0000u); s1 += o[2 * e] + o[2 * e + 1]; s2 += o[2 * e] * o[2 * e] + o[2 * e + 1] * o[2 * e + 1]; }
            s1 = red32(s1); s2 = red32(s2);
            const float mu = s1 * (1.f / 256.f), var = fmaxf(s2 * (1.f / 256.f) - mu * mu, 0.f), rstd = __builtin_amdgcn_rsqf(var + 1e-6f);
            if (r < nv) { const u32x4 gv = gcur[i]; const f32x4 n0 = *(const f32x4*)(gn + q * 8), n1 = *(const f32x4*)(gn + q * 8 + 4);
                u32x4 out;
#pragma unroll
                for (int e = 0; e < 4; ++e) { const float g0 = __uint_as_float(gv[e] << 16), g1 = __uint_as_float(gv[e] & 0xffff0000u);
                    const float n_0 = e < 2 ? n0[2 * e] : n1[2 * e - 4], n_1 = e < 2 ? n0[2 * e + 1] : n1[2 * e - 3];
                    out[e] = pk2(g0 * (o[2 * e] - mu) * rstd * n_0, g1 * (o[2 * e + 1] - mu) * rstd * n_1); }
                *(u32x4*)(MIX + (size_t)(b * TP + t0 + r) * 2048 + hd * 256 + q * 8) = out; }
        }
    }
#undef RET_PREFETCH
    { const int fr = c.lane & 15, fq = c.lane >> 4; float* So = c.out + O_RETP + ((size_t)(j * BP + b) * 4 + hd) * 128 * 256 + 32 * w + fr;
#pragma unroll
      for (int db = 0; db < 8; ++db)
#pragma unroll
          for (int en = 0; en < 2; ++en)
#pragma unroll
              for (int r = 0; r < 4; ++r) So[(unsigned)((16 * db + 4 * fq + r) * 256 + 16 * en)] = Sacc[db][en][r]; }
    __syncthreads();
}
DEVI void f_ret_sample(const Ctx& c, const PArgs& a, int j, int b, int hd) {
    const bf16* Z = (const bf16*)(c.ws + WS_Z); bf16* MIX = (bf16*)(c.ws + WS_MIX);
    LAS float* qk = (LAS float*)c.lds;
    LAS float* op = qk + 256;
    const int row = MP + b, w = c.wave;
    const float gamma = 1.f - exp2f(-5.f - (float)hd);
    const float* S0 = a.in[I_SRET] + ((size_t)(j * BS + b) * 4 + hd) * 128 * 256 + 4 * c.lane; float* So = c.out + O_RETS + ((size_t)(j * BS + b) * 4 + hd) * 128 * 256 + 4 * c.lane;
    __syncthreads();
    if (c.tid < 256) qk[c.tid] = bf2f(Z[(size_t)row * NIN + (c.tid < 128 ? hd * 128 + c.tid : 512 + hd * 128 + c.tid - 128)]);
    const u32x2 vv = *(const u32x2*)(Z + (size_t)row * NIN + 1024 + hd * 256 + 4 * c.lane);
    const f32x4 v4 = (f32x4){__uint_as_float(vv.x << 16), __uint_as_float(vv.x & 0xffff0000u), __uint_as_float(vv.y << 16), __uint_as_float(vv.y & 0xffff0000u)};
    __syncthreads();
    f32x4 o4 = (f32x4){0.f, 0.f, 0.f, 0.f};
#pragma unroll 16
    for (int dd = 0; dd < 16; ++dd) { const int d = 16 * w + dd; f32x4 s = __builtin_nontemporal_load((const f32x4*)(S0 + (unsigned)(d * 256)));
        s = s * gamma + v4 * qk[128 + d]; __builtin_nontemporal_store(s, (f32x4*)(So + (unsigned)(d * 256))); o4 = o4 + s * qk[d]; }
    *(LAS f32x4*)(op + w * 256 + 4 * c.lane) = o4;
    __syncthreads();
    if (w == 0) {
        f32x4 o = (f32x4){0.f, 0.f, 0.f, 0.f};
#pragma unroll
        for (int ww = 0; ww < 8; ++ww) o = o + *(const LAS f32x4*)(op + ww * 256 + 4 * c.lane);
        const float mu = wave_sum((o.x + o.y) + (o.z + o.w)) * (1.f / 256.f); o = o - mu;
        const float rstd = __builtin_amdgcn_rsqf(wave_sum((o.x * o.x + o.y * o.y) + (o.z * o.z + o.w * o.w)) * (1.f / 256.f) + 1e-6f);
        const u32x2 gv = *(const u32x2*)(Z + (size_t)row * NIN + 2048 + hd * 256 + 4 * c.lane); const f32x4 n4 = *(const f32x4*)(a.in[I_ERGN] + (size_t)j * 1024 + hd * 256 + 4 * c.lane);
        u32x2 out; out.x = pk2(__uint_as_float(gv.x << 16) * o.x * rstd * n4.x, __uint_as_float(gv.x & 0xffff0000u) * o.y * rstd * n4.y);
        out.y = pk2(__uint_as_float(gv.y << 16) * o.z * rstd * n4.z, __uint_as_float(gv.y & 0xffff0000u) * o.w * rstd * n4.w);
        *(u32x2*)(MIX + (size_t)row * 2048 + hd * 256 + 4 * c.lane) = out;
    }
}

#ifndef WPB
#define WPB 180
#endif
#ifndef MIX_PART
#define MIX_PART 7
#endif
DEVI void f_even_mix(const Ctx& c, const PArgs& a, int li, int part) {
    const int j = li >> 1;
    if (c.bid < 32) { if (part & 1) f_ret_prompt(c, a, j, c.bid >> 2, c.bid & 3); }
    else if (c.bid < 104) { if (part & 2) { const bool pr = c.bid < 96; const int v = c.bid - 32;
        f_lru_unit(c, a, j, pr ? (v & 7) : (c.bid - 96), !pr, pr ? (v >> 3) : 0); } }
    if (part & 4) {
    if (c.bid >= 104) for (int u = c.bid - 104; u < 512; u += c.G - 104) f_ret_sample(c, a, j, u >> 2, u & 3);
    if (c.bid >= WPB && c.G > WPB) { __syncthreads(); f_wprep(c, a, li == 0 ? WM_L01 : WM_L23, (c.bid - WPB) * NWAVES + c.wave, (c.G - WPB) * NWAVES); }
    }
}

DEVI float gelu_fast(float x) { const float y = 1.5957691216057308f * (x + 0.044715f * x * x * x); return x * __builtin_amdgcn_rcpf(1.f + __expf(-y)); }
DEVI void f_ffn_act(const Ctx& c, const PArgs& a, int li) {
    const bf16* U = (const bf16*)(c.ws + WS_U); bf16* ACT = (bf16*)(c.ws + WS_ACT);
    const float* CW = a.in[I_FCW] + (size_t)li * 3 * DFF; const float* CB = a.in[I_FCB] + (size_t)li * DFF;
    constexpr int RCH = 32, NPC = DFF / 8, NRC = M / RCH, NITEM = NPC * NRC;
    for (int it = c.bid * NT + c.tid; it < NITEM; it += c.G * NT) {
        const int rc = it / NPC, pc = it - rc * NPC, col = pc * 8, r0 = rc * RCH;
        float w0[8], w1[8], w2[8], cb[8];
#pragma unroll
        for (int h = 0; h < 2; ++h) { const f32x4 a0 = *(const f32x4*)(CW + col + 4 * h), a1 = *(const f32x4*)(CW + DFF + col + 4 * h), a2 = *(const f32x4*)(CW + 2 * DFF + col + 4 * h), b0 = *(const f32x4*)(CB + col + 4 * h);
#pragma unroll
            for (int e = 0; e < 4; ++e) { w0[4 * h + e] = a0[e]; w1[4 * h + e] = a1[e]; w2[4 * h + e] = a2[e]; cb[4 * h + e] = b0[e]; } }
        const bf16* ub = U + (size_t)r0 * NUP + col; bf16* ab = ACT + (size_t)r0 * DFF + col;
        if (r0 < MP) {
            u32x4 p1 = (u32x4){0u, 0u, 0u, 0u}, p2 = p1;
            int t = r0 % TP;
            if (t >= 1) p1 = *(const u32x4*)(ub - NUP); if (t >= 2) p2 = *(const u32x4*)(ub - 2 * NUP);
#pragma unroll 1
            for (int i0 = 0; i0 < RCH; i0 += 8) {
                u32x4 ug[8], uv[8];
#pragma unroll
                for (int i = 0; i < 8; ++i) { ug[i] = *(const u32x4*)(ub + (unsigned)((i0 + i) * NUP)); uv[i] = *(const u32x4*)(ub + (unsigned)((i0 + i) * NUP + DFF)); }
#pragma unroll
                for (int i = 0; i < 8; ++i) {
                    if (t == 0) { p1 = (u32x4){0u, 0u, 0u, 0u}; p2 = p1; }
                    if (t >= TP - 2) { float* so = c.out + O_FCONVP + ((size_t)(li * BP + (r0 + i0 + i) / TP) * 2 + (t - (TP - 2))) * DFF + col;
#pragma unroll
                        for (int e = 0; e < 4; ++e) { so[2 * e] = __uint_as_float(ug[i][e] << 16); so[2 * e + 1] = __uint_as_float(ug[i][e] & 0xffff0000u); } }
                    u32x4 o;
#pragma unroll
                    for (int e = 0; e < 4; ++e) {
                        const float ca = cb[2 * e] + w2[2 * e] * __uint_as_float(ug[i][e] << 16) + w1[2 * e] * __uint_as_float(p1[e] << 16) + w0[2 * e] * __uint_as_float(p2[e] << 16);
                        const float cv = cb[2 * e + 1] + w2[2 * e + 1] * __uint_as_float(ug[i][e] & 0xffff0000u) + w1[2 * e + 1] * __uint_as_float(p1[e] & 0xffff0000u) + w0[2 * e + 1] * __uint_as_float(p2[e] & 0xffff0000u);
                        o[e] = pk2(gelu_fast(ca) * __uint_as_float(uv[i][e] << 16), gelu_fast(cv) * __uint_as_float(uv[i][e] & 0xffff0000u)); }
                    *(u32x4*)(ab + (unsigned)((i0 + i) * DFF)) = o;
                    p2 = p1; p1 = ug[i]; t = (t + 1 == TP) ? 0 : t + 1;
                }
            }
        } else {
#pragma unroll 1
            for (int i = 0; i < RCH; ++i) {
                const int row = r0 + i;
                const u32x4 ug = *(const u32x4*)(ub + (unsigned)(i * NUP)), uv = *(const u32x4*)(ub + (unsigned)(i * NUP + DFF));
                const float* st = a.in[I_SFCONV] + (size_t)(li * BS + row - MP) * 2 * DFF + col; float* so = c.out + O_FCONVS + (size_t)(li * BS + row - MP) * 2 * DFF + col;
                float f1[8], f2[8];
#pragma unroll
                for (int h = 0; h < 2; ++h) { const f32x4 s2 = *(const f32x4*)(st + 4 * h), s1 = *(const f32x4*)(st + DFF + 4 * h); *(f32x4*)(so + 4 * h) = s1;
#pragma unroll
                    for (int e = 0; e < 4; ++e) { f2[4 * h + e] = s2[e]; f1[4 * h + e] = s1[e]; } }
                u32x4 o;
#pragma unroll
                for (int e = 0; e < 4; ++e) { const float u0a = __uint_as_float(ug[e] << 16), u0b = __uint_as_float(ug[e] & 0xffff0000u);
                    so[DFF + 2 * e] = u0a; so[DFF + 2 * e + 1] = u0b;
                    const float ca = cb[2 * e] + w2[2 * e] * u0a + w1[2 * e] * f1[2 * e] + w0[2 * e] * f2[2 * e], cv = cb[2 * e + 1] + w2[2 * e + 1] * u0b + w1[2 * e + 1] * f1[2 * e + 1] + w0[2 * e + 1] * f2[2 * e + 1];
                    o[e] = pk2(gelu_fast(ca) * __uint_as_float(uv[e] << 16), gelu_fast(cv) * __uint_as_float(uv[e] & 0xffff0000u)); }
                *(u32x4*)(ab + (unsigned)(i * DFF)) = o;
            }
        }
    }
}

constexpr int RW_TG = 16;
constexpr int RW_BUF = 6 * RW_TG * 64 * 4;
constexpr int RW_Y = 2 * RW_BUF, RW_BON = RW_Y + RW_TG * 64 * 4, RW_END = RW_BON + RW_TG * 4;
DEVI void f_rwkv_prompt(const Ctx& c, const PArgs& a, int j, int b, int hd) {
    const bf16* R = (const bf16*)(c.ws + WS_R); const bf16* Kb = (const bf16*)(c.ws + WS_K);
    const bf16* VF = (const bf16*)((unsigned char*)c.out + DO_VFIRST); const bf16* Vb = j == 0 ? VF : (const bf16*)(c.ws + WS_V);
    const float* WD = (const float*)(c.ws + WS_WDEC); const bf16* AG = (const bf16*)(c.ws + WS_AG); const bf16* VG = (const bf16*)(c.ws + WS_VG); const bf16* GG = (const bf16*)(c.ws + WS_GG);
    bf16* O = (bf16*)(c.ws + WS_O);
    const int i = c.tid >> 3, q = c.tid & 7;
    const int st = c.tid >> 5, sc = (c.tid & 31) * 2, ch = hd * 64 + sc;
    const size_t rb = (size_t)(b * TP) * D + ch;
    const float kk0 = a.in[I_OKK][(size_t)j * D + ch], kk1 = a.in[I_OKK][(size_t)j * D + ch + 1], ka0 = a.in[I_OKA][(size_t)j * D + ch], ka1 = a.in[I_OKA][(size_t)j * D + ch + 1];
    const float rk0 = a.in[I_ORK][(size_t)j * D + ch], rk1 = a.in[I_ORK][(size_t)j * D + ch + 1];
    const float gg0 = a.in[I_OGNG][(size_t)j * D + ch], gg1 = a.in[I_OGNG][(size_t)j * D + ch + 1], gb0 = a.in[I_OGNB][(size_t)j * D + ch], gb1 = a.in[I_OGNB][(size_t)j * D + ch + 1];
    float s[8], z[8];
#pragma unroll
    for (int jj = 0; jj < 8; ++jj) { s[jj] = 0.f; z[jj] = 0.f; }
    unsigned pr_, pk_, pv_, pa_, pg_, pvf_ = 0u, pvg_ = 0u; float pw0, pw1;
#define RW_PREFETCH(t0) do { const unsigned o = (unsigned)(((t0) + st) * D); const bool ok = (t0) + st < TP; \
        pr_ = ok ? *(const unsigned*)(R + rb + o) : 0u; pk_ = ok ? *(const unsigned*)(Kb + rb + o) : 0u; pv_ = ok ? *(const unsigned*)(Vb + rb + o) : 0u; \
        pa_ = ok ? *(const unsigned*)(AG + rb + o) : 0u; pg_ = ok ? *(const unsigned*)(GG + rb + o) : 0u; \
        if (j == 1) { pvf_ = ok ? *(const unsigned*)(VF + rb + o) : 0u; pvg_ = ok ? *(const unsigned*)(VG + rb + o) : 0u; } \
        pw0 = ok ? WD[rb + o] : 1.f; pw1 = ok ? WD[rb + o + 1] : 1.f; } while (0)
    RW_PREFETCH(0);
    const int ngroups = (TP + RW_TG - 1) / RW_TG;
#pragma unroll 1
    for (int g = 0; g < ngroups; ++g) {
        const int t0 = g * RW_TG;
        LAS float* buf = (LAS float*)(c.lds + (g & 1) * RW_BUF);
        LAS float* ys = (LAS float*)(c.lds + RW_Y); LAS float* bon = (LAS float*)(c.lds + RW_BON);
        float gate0, gate1;
        { const float r0 = __uint_as_float(pr_ << 16), r1 = __uint_as_float(pr_ & 0xffff0000u), k0 = __uint_as_float(pk_ << 16), k1 = __uint_as_float(pk_ & 0xffff0000u);
          float v0 = __uint_as_float(pv_ << 16), v1 = __uint_as_float(pv_ & 0xffff0000u);
          const float a0 = __uint_as_float(pa_ << 16), a1 = __uint_as_float(pa_ & 0xffff0000u);
          gate0 = __uint_as_float(pg_ << 16); gate1 = __uint_as_float(pg_ & 0xffff0000u);
          if (j == 1) { const float f0 = __uint_as_float(pvf_ << 16), f1 = __uint_as_float(pvf_ & 0xffff0000u); v0 = v0 + (f0 - v0) * __uint_as_float(pvg_ << 16); v1 = v1 + (f1 - v1) * __uint_as_float(pvg_ & 0xffff0000u); }
          float q0 = k0 * kk0, q1 = k1 * kk1; const float ss = red32(q0 * q0 + q1 * q1); const float rn = __builtin_amdgcn_rsqf(fmaxf(ss, 1e-24f)); q0 *= rn; q1 *= rn;
          const float m0 = k0 * (1.f + (a0 - 1.f) * ka0), m1 = k1 * (1.f + (a1 - 1.f) * ka1);
          const float bs = red32(r0 * m0 * rk0 + r1 * m1 * rk1);
          const int o = st * 64 + sc;
          *(LAS f32x2_t*)(buf + o) = (f32x2_t){r0, r1}; *(LAS f32x2_t*)(buf + RW_TG * 64 + o) = (f32x2_t){pw0, pw1}; *(LAS f32x2_t*)(buf + 2 * RW_TG * 64 + o) = (f32x2_t){m0, m1};
          *(LAS f32x2_t*)(buf + 3 * RW_TG * 64 + o) = (f32x2_t){v0, v1}; *(LAS f32x2_t*)(buf + 4 * RW_TG * 64 + o) = (f32x2_t){-q0, -q1}; *(LAS f32x2_t*)(buf + 5 * RW_TG * 64 + o) = (f32x2_t){q0 * a0, q1 * a1};
          __syncthreads();
          if ((c.tid & 31) == 0) bon[st] = bs; }
        if (g + 1 < ngroups) RW_PREFETCH(t0 + RW_TG);
        const int nt = (TP - t0) < RW_TG ? (TP - t0) : RW_TG;
        if (c.tid < 256) {
#pragma unroll 4
        for (int tt = 0; tt < nt; ++tt) {
            const LAS float* p = buf + tt * 64 + 8 * q;
            const f32x4 ra = *(const LAS f32x4*)(p), rb2 = *(const LAS f32x4*)(p + 4), wa = *(const LAS f32x4*)(p + RW_TG * 64), wb = *(const LAS f32x4*)(p + RW_TG * 64 + 4);
            const f32x4 ka = *(const LAS f32x4*)(p + 2 * RW_TG * 64), kb2 = *(const LAS f32x4*)(p + 2 * RW_TG * 64 + 4), aa = *(const LAS f32x4*)(p + 4 * RW_TG * 64), ab = *(const LAS f32x4*)(p + 4 * RW_TG * 64 + 4);
            const f32x4 ba = *(const LAS f32x4*)(p + 5 * RW_TG * 64), bb = *(const LAS f32x4*)(p + 5 * RW_TG * 64 + 4);
            const float vi = buf[3 * RW_TG * 64 + tt * 64 + i], vj = buf[3 * RW_TG * 64 + tt * 64 + i + 32];
            const float sa = red8((s[0] * aa[0] + s[1] * aa[1]) + (s[2] * aa[2] + s[3] * aa[3]) + ((s[4] * ab[0] + s[5] * ab[1]) + (s[6] * ab[2] + s[7] * ab[3])));
            const float za = red8((z[0] * aa[0] + z[1] * aa[1]) + (z[2] * aa[2] + z[3] * aa[3]) + ((z[4] * ab[0] + z[5] * ab[1]) + (z[6] * ab[2] + z[7] * ab[3])));
#pragma unroll
            for (int jj = 0; jj < 4; ++jj) { s[jj] = s[jj] * wa[jj] + sa * ba[jj] + vi * ka[jj]; s[4 + jj] = s[4 + jj] * wb[jj] + sa * bb[jj] + vi * kb2[jj];
                z[jj] = z[jj] * wa[jj] + za * ba[jj] + vj * ka[jj]; z[4 + jj] = z[4 + jj] * wb[jj] + za * bb[jj] + vj * kb2[jj]; }
            const float y = red8((s[0] * ra[0] + s[1] * ra[1]) + (s[2] * ra[2] + s[3] * ra[3]) + ((s[4] * rb2[0] + s[5] * rb2[1]) + (s[6] * rb2[2] + s[7] * rb2[3])));
            const float y2 = red8((z[0] * ra[0] + z[1] * ra[1]) + (z[2] * ra[2] + z[3] * ra[3]) + ((z[4] * rb2[0] + z[5] * rb2[1]) + (z[6] * rb2[2] + z[7] * rb2[3])));
            if (q == 0) { ys[tt * 64 + i] = y; ys[tt * 64 + i + 32] = y2; }
        }
        }
        __syncthreads();
        if (t0 + st < TP) {
            const f32x2_t yv = *(const LAS f32x2_t*)(ys + st * 64 + sc), vv = *(const LAS f32x2_t*)(buf + 3 * RW_TG * 64 + st * 64 + sc);
            const float mu = red32(yv.x + yv.y) * (1.f / 64.f); const float d0 = yv.x - mu, d1 = yv.y - mu; const float var = red32(d0 * d0 + d1 * d1) * (1.f / 64.f);
            const float rs = 1.f / sqrtf(var + 64e-5f), bo = bon[st];
            const float o0 = (d0 * rs * gg0 + gb0 + bo * vv.x) * gate0, o1 = (d1 * rs * gg1 + gb1 + bo * vv.y) * gate1;
            *(unsigned*)(O + rb + (unsigned)((t0 + st) * D)) = pk2(o0, o1);
        }
    }
#undef RW_PREFETCH
    if (c.tid < 256) { float* So = c.out + O_RWKVP + ((size_t)(j * BP + b) * 16 + hd) * 4096 + i * 64 + 8 * q;
      *(f32x4*)So = (f32x4){s[0], s[1], s[2], s[3]}; *(f32x4*)(So + 4) = (f32x4){s[4], s[5], s[6], s[7]};
      *(f32x4*)(So + 2048) = (f32x4){z[0], z[1], z[2], z[3]}; *(f32x4*)(So + 2052) = (f32x4){z[4], z[5], z[6], z[7]}; }
    __syncthreads();
}
DEVI void f_rwkv_sample(const Ctx& c, const PArgs& a, int j, int b, int hd) {
    const bf16* R = (const bf16*)(c.ws + WS_R); const bf16* Kb = (const bf16*)(c.ws + WS_K);
    const bf16* VF = (const bf16*)((unsigned char*)c.out + DO_VFIRST); const bf16* Vb = j == 0 ? VF : (const bf16*)(c.ws + WS_V);
    const float* WD = (const float*)(c.ws + WS_WDEC); const bf16* AG = (const bf16*)(c.ws + WS_AG); const bf16* VG = (const bf16*)(c.ws + WS_VG); const bf16* GG = (const bf16*)(c.ws + WS_GG);
    bf16* O = (bf16*)(c.ws + WS_O);
    LAS float* buf = (LAS float*)c.lds;
    const int i = c.tid >> 3, q = c.tid & 7;
    const size_t so = ((size_t)(j * BS + b) * 16 + hd) * 4096 + i * 64 + 8 * q;
    const f32x4 sA = __builtin_nontemporal_load((const f32x4*)(a.in[I_SRWKV] + so)), sB = __builtin_nontemporal_load((const f32x4*)(a.in[I_SRWKV] + so + 4));
    float s[8] = {sA[0], sA[1], sA[2], sA[3], sB[0], sB[1], sB[2], sB[3]};
    float gate = 0.f;
    __syncthreads();
    if (c.tid < 64) { const int ch = hd * 64 + c.tid; const size_t o = (size_t)(MP + b) * D + ch;
        const float r = bf2f(R[o]), k = bf2f(Kb[o]), ag = bf2f(AG[o]), w = WD[o]; float v = bf2f(Vb[o]); gate = bf2f(GG[o]);
        if (j == 1) { const float vf = bf2f(VF[o]); v = v + (vf - v) * bf2f(VG[o]); }
        float kk = k * a.in[I_OKK][(size_t)j * D + ch]; const float ss = wave_sum(kk * kk); kk = kk / sqrtf(fmaxf(ss, 1e-24f));
        const float km = k * (1.f + (ag - 1.f) * a.in[I_OKA][(size_t)j * D + ch]);
        const float bs = wave_sum(r * km * a.in[I_ORK][(size_t)j * D + ch]);
        buf[c.tid] = r; buf[64 + c.tid] = w; buf[128 + c.tid] = km; buf[192 + c.tid] = v; buf[256 + c.tid] = -kk; buf[320 + c.tid] = kk * ag;
        if (c.tid == 0) buf[448] = bs; }
    __syncthreads();
    { float sa = 0.f;
#pragma unroll
      for (int jj = 0; jj < 8; ++jj) sa += s[jj] * buf[256 + 8 * q + jj];
      sa = red8(sa);
      const float vi = buf[192 + i]; float y = 0.f;
#pragma unroll
      for (int jj = 0; jj < 8; ++jj) { const int cj = 8 * q + jj; s[jj] = s[jj] * buf[64 + cj] + sa * buf[320 + cj] + vi * buf[128 + cj]; y += s[jj] * buf[cj]; }
      y = red8(y);
      if (q == 0) buf[384 + i] = y;
      float* Sout = c.out + O_RWKVS + so;
      __builtin_nontemporal_store((f32x4){s[0], s[1], s[2], s[3]}, (f32x4*)Sout); __builtin_nontemporal_store((f32x4){s[4], s[5], s[6], s[7]}, (f32x4*)(Sout + 4)); }
    __syncthreads();
    if (c.tid < 64) { const int ch = hd * 64 + c.tid;
        const float y = buf[384 + c.tid]; const float mu = wave_sum(y) * (1.f / 64.f); const float dy = y - mu; const float var = wave_sum(dy * dy) * (1.f / 64.f);
        float o = dy / sqrtf(var + 64e-5f) * a.in[I_OGNG][(size_t)j * D + ch] + a.in[I_OGNB][(size_t)j * D + ch];
        o = (o + buf[448] * buf[192 + c.tid]) * gate;
        O[(size_t)(MP + b) * D + ch] = f2bf(o); }
}
DEVI void f_odd_scan(const Ctx& c, const PArgs& a, int li) {
    const int j = li >> 1;
    if (c.bid < 128) f_rwkv_prompt(c, a, j, c.bid >> 4, c.bid & 15);
    else for (int u = c.bid - 128; u < 2048; u += c.G - 128) f_rwkv_sample(c, a, j, u >> 4, u & 15);
}

constexpr size_t DO_BON = 54 * MiB;
DEVI float red16(float x) { x += DPP_F(x, 0xB1); x += DPP_F(x, 0x4E); x += DPP_F(x, 0x141); x += DPP_F(x, 0x140); return x; }
constexpr int RW2_Y = 2 * RW_BUF, RW2_END = RW2_Y + 2 * RW_TG * 32 * 4;
DEVI void f_rwkv_prompt2(const Ctx& c, const PArgs& a, int j, int b, int hd, int half) {
    const bf16* R = (const bf16*)(c.ws + WS_R); const bf16* Kb = (const bf16*)(c.ws + WS_K);
    const bf16* VF = (const bf16*)((unsigned char*)c.out + DO_VFIRST); const bf16* Vb = j == 0 ? VF : (const bf16*)(c.ws + WS_V);
    const float* WD = (const float*)(c.ws + WS_WDEC); const bf16* AG = (const bf16*)(c.ws + WS_AG); const bf16* VG = (const bf16*)(c.ws + WS_VG);
    bf16* O = (bf16*)(c.ws + WS_O); float* BON = (float*)((unsigned char*)c.out + DO_BON);
    const int il = c.tid >> 4, q = c.tid & 15;
    const int st = c.tid >> 5, sc = (c.tid & 31) * 2, ch = hd * 64 + sc;
    const size_t rb = (size_t)(b * TP) * D + ch;
    const float kk0 = a.in[I_OKK][(size_t)j * D + ch], kk1 = a.in[I_OKK][(size_t)j * D + ch + 1], ka0 = a.in[I_OKA][(size_t)j * D + ch], ka1 = a.in[I_OKA][(size_t)j * D + ch + 1];
    const float rk0 = a.in[I_ORK][(size_t)j * D + ch], rk1 = a.in[I_ORK][(size_t)j * D + ch + 1];
    f32x4 s = (f32x4){0.f, 0.f, 0.f, 0.f};
    unsigned pr_, pk_, pv_, pa_, pvf_ = 0u, pvg_ = 0u; f32x2_t pw_;
#define RW2_PREFETCH(t0) do { const unsigned o = (unsigned)(((t0) + st) * D); const bool ok = (t0) + st < TP; \
        pr_ = ok ? *(const unsigned*)(R + rb + o) : 0u; pk_ = ok ? *(const unsigned*)(Kb + rb + o) : 0u; pv_ = ok ? *(const unsigned*)(Vb + rb + o) : 0u; pa_ = ok ? *(const unsigned*)(AG + rb + o) : 0u; \
        if (j == 1) { pvf_ = ok ? *(const unsigned*)(VF + rb + o) : 0u; pvg_ = ok ? *(const unsigned*)(VG + rb + o) : 0u; } \
        pw_ = ok ? *(const f32x2_t*)(WD + rb + o) : (f32x2_t){1.f, 1.f}; } while (0)
    RW2_PREFETCH(0);
    const int ngroups = (TP + RW_TG - 1) / RW_TG;
    LAS float* ys = (LAS float*)(c.lds + RW2_Y);
#pragma unroll 1
    for (int g = 0; g < ngroups; ++g) {
        const int t0 = g * RW_TG; const int nt = (TP - t0) < RW_TG ? (TP - t0) : RW_TG;
        LAS float* buf = (LAS float*)(c.lds + (g & 1) * RW_BUF);
        { const float r0 = __uint_as_float(pr_ << 16), r1 = __uint_as_float(pr_ & 0xffff0000u), k0 = __uint_as_float(pk_ << 16), k1 = __uint_as_float(pk_ & 0xffff0000u);
          float v0 = __uint_as_float(pv_ << 16), v1 = __uint_as_float(pv_ & 0xffff0000u);
          const float a0 = __uint_as_float(pa_ << 16), a1 = __uint_as_float(pa_ & 0xffff0000u);
          if (j == 1) { const float f0 = __uint_as_float(pvf_ << 16), f1 = __uint_as_float(pvf_ & 0xffff0000u); v0 = v0 + (f0 - v0) * __uint_as_float(pvg_ << 16); v1 = v1 + (f1 - v1) * __uint_as_float(pvg_ & 0xffff0000u); }
          float q0 = k0 * kk0, q1 = k1 * kk1; const float ss = red32(q0 * q0 + q1 * q1); const float rn = __builtin_amdgcn_rsqf(fmaxf(ss, 1e-24f)); q0 *= rn; q1 *= rn;
          const float m0 = k0 * (1.f + (a0 - 1.f) * ka0), m1 = k1 * (1.f + (a1 - 1.f) * ka1);
          const float bs = red32(r0 * m0 * rk0 + r1 * m1 * rk1);
          const int o = st * 64 + sc;
          *(LAS f32x2_t*)(buf + o) = (f32x2_t){r0, r1}; *(LAS f32x2_t*)(buf + RW_TG * 64 + o) = pw_; *(LAS f32x2_t*)(buf + 2 * RW_TG * 64 + o) = (f32x2_t){m0, m1};
          *(LAS f32x2_t*)(buf + 3 * RW_TG * 64 + o) = (f32x2_t){v0, v1}; *(LAS f32x2_t*)(buf + 4 * RW_TG * 64 + o) = (f32x2_t){-q0, -q1}; *(LAS f32x2_t*)(buf + 5 * RW_TG * 64 + o) = (f32x2_t){q0 * a0, q1 * a1};
          if (half == 0 && (c.tid & 31) == 0 && t0 + st < TP) BON[(size_t)(b * TP + t0 + st) * 16 + hd] = bs; }
        __syncthreads();
        if (g + 1 < ngroups) RW2_PREFETCH(t0 + RW_TG);
        {
            const LAS float* p = buf + 4 * q; const LAS float* pv = buf + 3 * RW_TG * 64 + 32 * half + il;
            f32x4 r4 = *(const LAS f32x4*)(p), w4 = *(const LAS f32x4*)(p + RW_TG * 64), k4 = *(const LAS f32x4*)(p + 2 * RW_TG * 64), a4 = *(const LAS f32x4*)(p + 4 * RW_TG * 64), b4 = *(const LAS f32x4*)(p + 5 * RW_TG * 64);
            float vi = pv[0];
#pragma unroll 2
            for (int tt = 0; tt < nt; ++tt) {
                const int tn = tt + 1 < nt ? tt + 1 : tt;
                const f32x4 nr4 = *(const LAS f32x4*)(p + tn * 64), nw4 = *(const LAS f32x4*)(p + RW_TG * 64 + tn * 64), nk4 = *(const LAS f32x4*)(p + 2 * RW_TG * 64 + tn * 64),
                            na4 = *(const LAS f32x4*)(p + 4 * RW_TG * 64 + tn * 64), nb4 = *(const LAS f32x4*)(p + 5 * RW_TG * 64 + tn * 64);
                const float nvi = pv[tn * 64];
                const float sa = red16((s[0] * a4[0] + s[1] * a4[1]) + (s[2] * a4[2] + s[3] * a4[3]));
                s = s * w4 + b4 * sa + k4 * vi;
                const float y = red16((s[0] * r4[0] + s[1] * r4[1]) + (s[2] * r4[2] + s[3] * r4[3]));
                if (q == 0) ys[tt * 32 + il] = y;
                r4 = nr4; w4 = nw4; k4 = nk4; a4 = na4; b4 = nb4; vi = nvi;
            }
        }
        __syncthreads();
        { const int tt = c.tid >> 5, cc = c.tid & 31; if (tt < nt) O[(size_t)(b * TP + t0 + tt) * D + hd * 64 + 32 * half + cc] = f2bf(ys[tt * 32 + cc]); }
    }
#undef RW2_PREFETCH
    { float* So = c.out + O_RWKVP + ((size_t)(j * BP + b) * 16 + hd) * 4096 + (32 * half + il) * 64 + 4 * q; *(f32x4*)So = s; }
    __syncthreads();
}
DEVI void f_rwkv_post(const Ctx& c, const PArgs& a, int li) {
    const int j = li >> 1;
    bf16* O = (bf16*)(c.ws + WS_O); const bf16* GG = (const bf16*)(c.ws + WS_GG); const bf16* VG = (const bf16*)(c.ws + WS_VG);
    const bf16* VF = (const bf16*)((unsigned char*)c.out + DO_VFIRST); const bf16* Vb = j == 0 ? VF : (const bf16*)(c.ws + WS_V); const float* BON = (const float*)((unsigned char*)c.out + DO_BON);
    const int pc = c.tid & 127, ch = pc * 8;
    const f32x4 g0 = *(const f32x4*)(a.in[I_OGNG] + (size_t)j * D + ch), g1 = *(const f32x4*)(a.in[I_OGNG] + (size_t)j * D + ch + 4), b0 = *(const f32x4*)(a.in[I_OGNB] + (size_t)j * D + ch), b1 = *(const f32x4*)(a.in[I_OGNB] + (size_t)j * D + ch + 4);
    for (int row = c.bid * 4 + (c.tid >> 7); row < MP; row += c.G * 4) {
        const size_t o = (size_t)row * D + ch;
        const u32x4 yv = *(const u32x4*)(O + o), vv = *(const u32x4*)(Vb + o), gv = *(const u32x4*)(GG + o);
        float y[8], v[8], gt[8];
#pragma unroll
        for (int e = 0; e < 4; ++e) { y[2 * e] = __uint_as_float(yv[e] << 16); y[2 * e + 1] = __uint_as_float(yv[e] & 0xffff0000u); v[2 * e] = __uint_as_float(vv[e] << 16); v[2 * e + 1] = __uint_as_float(vv[e] & 0xffff0000u);
            gt[2 * e] = __uint_as_float(gv[e] << 16); gt[2 * e + 1] = __uint_as_float(gv[e] & 0xffff0000u); }
        if (j == 1) { const u32x4 fv = *(const u32x4*)(VF + o), mv = *(const u32x4*)(VG + o);
#pragma unroll
            for (int e = 0; e < 4; ++e) { const float f0 = __uint_as_float(fv[e] << 16), f1 = __uint_as_float(fv[e] & 0xffff0000u), m0 = __uint_as_float(mv[e] << 16), m1 = __uint_as_float(mv[e] & 0xffff0000u);
                v[2 * e] = v[2 * e] + (f0 - v[2 * e]) * m0; v[2 * e + 1] = v[2 * e + 1] + (f1 - v[2 * e + 1]) * m1; } }
        float s1 = 0.f;
#pragma unroll
        for (int e = 0; e < 8; ++e) s1 += y[e];
        const float mu = red8(s1) * (1.f / 64.f); float s2 = 0.f;
#pragma unroll
        for (int e = 0; e < 8; ++e) { y[e] -= mu; s2 += y[e] * y[e]; }
        const float rs = __builtin_amdgcn_rsqf(red8(s2) * (1.f / 64.f) + 64e-5f), bo = BON[(size_t)row * 16 + (pc >> 3)];
        u32x4 out;
#pragma unroll
        for (int e = 0; e < 4; ++e) { const float gg0 = e < 2 ? g0[2 * e] : g1[2 * e - 4], gg1 = e < 2 ? g0[2 * e + 1] : g1[2 * e - 3], bb0 = e < 2 ? b0[2 * e] : b1[2 * e - 4], bb1 = e < 2 ? b0[2 * e + 1] : b1[2 * e - 3];
            out[e] = pk2((y[2 * e] * rs * gg0 + bb0 + bo * v[2 * e]) * gt[2 * e], (y[2 * e + 1] * rs * gg1 + bb1 + bo * v[2 * e + 1]) * gt[2 * e + 1]); }
        *(u32x4*)(O + o) = out;
    }
}
DEVI void f_odd_scan2(const Ctx& c, const PArgs& a, int li) {
    const int j = li >> 1;
    for (int u = c.bid; u < 256; u += c.G) f_rwkv_prompt2(c, a, j, u >> 5, (u >> 1) & 15, u & 1);
    for (int u = c.bid; u < 2048; u += c.G) f_rwkv_sample(c, a, j, u >> 4, u & 15);
}

constexpr int R_AF = 0, R_RF = 2048, R_BKF = 4096, R_VF = 8192, R_GF = 10240, R_RECA = 12288, R_RECB = 13312, R_PL = 14336, R_BON = 14592, RW3_REC = 14848;
constexpr int RW3_RING = 0, RW3_SCR = 8 * RW3_REC, RW3_SCRW = 5120, RW3_STAT = RW3_SCR + 4 * RW3_SCRW, RW3_END = RW3_STAT + 4096;
static_assert(RW3_END <= RING_BYTES, "rwkv3 lds");
#define DPP_RM(v, ctrl, rm) __builtin_bit_cast(float, __builtin_amdgcn_update_dpp(0, __builtin_bit_cast(int, (v)), (ctrl), (rm), 0xF, false))
DEVI float wsum64(float x) { x = red16(x); x += DPP_RM(x, 0x142, 0xA); x += DPP_RM(x, 0x143, 0xC); return __builtin_bit_cast(float, __builtin_amdgcn_readlane(__builtin_bit_cast(int, x), 63)); }
#define LWAIT() asm volatile("s_waitcnt lgkmcnt(0)" ::: "memory")
DEVI bf16x8_t frag_lohi(u32x2 lo, u32x2 hi) { u32x4 t; t.x = lo.x; t.y = lo.y; t.z = hi.x; t.w = hi.y; return __builtin_bit_cast(bf16x8_t, t); }
struct RwRaw { u32x2 r[4], k[4], v[4], a[4], g[4], f[4], m[4]; f32x4 w[4]; };
DEVI void rw3_load(const Ctx& c, RwRaw& q, int j, int b, int hd, int ck, int parts) {
    const bf16* R = (const bf16*)(c.ws + WS_R); const bf16* Kb = (const bf16*)(c.ws + WS_K);
    const bf16* VF_ = (const bf16*)((unsigned char*)c.out + DO_VFIRST); const bf16* Vb = j == 0 ? VF_ : (const bf16*)(c.ws + WS_V);
    const float* WD = (const float*)(c.ws + WS_WDEC); const bf16* AG = (const bf16*)(c.ws + WS_AG); const bf16* VG = (const bf16*)(c.ws + WS_VG); const bf16* GG = (const bf16*)(c.ws + WS_GG);
    const size_t rb = (size_t)(b * TP + ck * 16 + (c.lane & 15)) * D + hd * 64 + 4 * (c.lane >> 4);
#pragma unroll
    for (int n = 0; n < 4; ++n) { const size_t o = rb + 16 * n;
        if (parts & 4) { q.r[n] = *(const u32x2*)(R + o); q.k[n] = *(const u32x2*)(Kb + o); q.a[n] = *(const u32x2*)(AG + o); }
        if (parts & 2) q.w[n] = *(const f32x4*)(WD + o);
        if (parts & 1) { q.v[n] = *(const u32x2*)(Vb + o); q.g[n] = *(const u32x2*)(GG + o);
            if (j == 1) { q.f[n] = *(const u32x2*)(VF_ + o); q.m[n] = *(const u32x2*)(VG + o); } else { q.f[n] = (u32x2){0u, 0u}; q.m[n] = (u32x2){0u, 0u}; } } }
}
DEVI float bfe(u32x2 p, int e) { const unsigned u = e < 2 ? p.x : p.y; return (e & 1) ? __uint_as_float(u & 0xffff0000u) : __uint_as_float(u << 16); }
DEVI float fq_sum(float s) {
    u32x2 r = __builtin_amdgcn_permlane16_swap(__float_as_uint(s), __float_as_uint(s), false, false); s = __uint_as_float(r.x) + __uint_as_float(r.y);
    r = __builtin_amdgcn_permlane32_swap(__float_as_uint(s), __float_as_uint(s), false, false); return __uint_as_float(r.x) + __uint_as_float(r.y);
}
template <int S> DEVI float dpp_shr1(float x) { return __builtin_bit_cast(float, __builtin_amdgcn_update_dpp(0x3f800000, __builtin_bit_cast(int, x), 0x110 + S, 0xF, 0xF, false)); }
struct RwCoef { float kk[4][4], ka[4][4], rk[4][4]; };
#ifndef PREP_PRIO
#define PREP_PRIO 0
#endif
#ifndef CHAIN_PRIO
#define CHAIN_PRIO 3
#endif
constexpr int RW3_CF = 3072;
DEVI void rw3_prep(const Ctx& c, int j, int b, int hd, int ckn, RwRaw& q, LAS unsigned char* rec, LAS unsigned char* scr) {
    const int lane = c.lane, fr = lane & 15, fq = lane >> 4, t = fr;
    { const int lv = ((t >> 2) * 16 + 4 * fq) * 8 + (t & 3) * 2;
#pragma unroll
      for (int n = 0; n < 4; ++n)
#pragma unroll
        for (int e = 0; e < 4; ++e) { float v = bfe(q.v[n], e); if (j == 1) v = v + (bfe(q.f[n], e) - v) * bfe(q.m[n], e);
            *(LAS bf16*)(rec + R_VF + n * 512 + lv + e * 8) = f2bf(v);
            const unsigned gw = e < 2 ? q.g[n].x : q.g[n].y;
            *(LAS unsigned short*)(rec + R_GF + n * 512 + lv + e * 8) = (unsigned short)((e & 1) ? (gw >> 16) : gw); } }
    if (ckn >= 0) rw3_load(c, q, j, b, hd, ckn, 1);
    RwCoef cf;
#pragma unroll
    for (int n = 0; n < 4; ++n) { const f32x4 x0 = *(const LAS f32x4*)(scr + RW3_CF + (fq * 12 + n) * 16), x1 = *(const LAS f32x4*)(scr + RW3_CF + (fq * 12 + 4 + n) * 16), x2 = *(const LAS f32x4*)(scr + RW3_CF + (fq * 12 + 8 + n) * 16);
#pragma unroll
        for (int e = 0; e < 4; ++e) { cf.kk[n][e] = x0[e]; cf.ka[n][e] = x1[e]; cf.rk[n][e] = x2[e]; } }
    float ss = 0.f, bon = 0.f, P[4][4];
#pragma unroll
    for (int n = 0; n < 4; ++n)
#pragma unroll
        for (int e = 0; e < 4; ++e) { const float k = bfe(q.k[n], e), r = bfe(q.r[n], e), ag = bfe(q.a[n], e);
            const float kn = k * cf.kk[n][e]; ss += kn * kn;
            bon += r * (k * (1.f + (ag - 1.f) * cf.ka[n][e])) * cf.rk[n][e];
            P[n][e] = q.w[n][e]; }
    if (ckn >= 0) rw3_load(c, q, j, b, hd, ckn, 2);
    ss = fq_sum(ss); bon = fq_sum(bon);
    const float inv = __builtin_amdgcn_rsqf(fmaxf(ss, 1e-24f));
#pragma unroll
    for (int n = 0; n < 4; ++n)
#pragma unroll
        for (int e = 0; e < 4; ++e) { float x = P[n][e]; x = x * dpp_shr1<1>(x); x = x * dpp_shr1<2>(x); x = x * dpp_shr1<4>(x); x = x * dpp_shr1<8>(x); P[n][e] = x; }
    if (fq == 0) *(LAS float*)(rec + R_BON + t * 4) = bon;
    if (t == 15) {
#pragma unroll
        for (int n = 0; n < 4; ++n) *(LAS f32x4*)(rec + R_PL + (16 * n + 4 * fq) * 4) = (f32x4){P[n][0], P[n][1], P[n][2], P[n][3]}; }
    u32x4 afw[2], rfw[2], bfw[2], kfw[2];
#pragma unroll
    for (int kk = 0; kk < 2; ++kk) {
        float av[8], rv[8], bv[8], kv[8];
#pragma unroll
        for (int jj = 0; jj < 8; ++jj) { const int n = 2 * kk + (jj >> 2), e = jj & 3;
            const float k = bfe(q.k[n], e), r = bfe(q.r[n], e), ag = bfe(q.a[n], e);
            const float kn = k * cf.kk[n][e] * inv, km = k * (1.f + (ag - 1.f) * cf.ka[n][e]);
            const float Pn = P[n][e], Pm1 = dpp_shr1<1>(Pn), ip = rcpf_(Pn);
            av[jj] = -kn * Pm1; rv[jj] = r * Pn; bv[jj] = kn * ag * ip; kv[jj] = km * ip; }
        afw[kk] = (u32x4){pk2(av[0], av[1]), pk2(av[2], av[3]), pk2(av[4], av[5]), pk2(av[6], av[7])}; rfw[kk] = (u32x4){pk2(rv[0], rv[1]), pk2(rv[2], rv[3]), pk2(rv[4], rv[5]), pk2(rv[6], rv[7])};
        bfw[kk] = (u32x4){pk2(bv[0], bv[1]), pk2(bv[2], bv[3]), pk2(bv[4], bv[5]), pk2(bv[6], bv[7])}; kfw[kk] = (u32x4){pk2(kv[0], kv[1]), pk2(kv[2], kv[3]), pk2(kv[4], kv[5]), pk2(kv[6], kv[7])};
        *(LAS u32x4*)(rec + R_AF + (kk * 64 + lane) * 16) = afw[kk]; *(LAS u32x4*)(rec + R_RF + (kk * 64 + lane) * 16) = rfw[kk];
    }
    { const int lb = ((t >> 2) * 16 + 4 * fq) * 16 + (t & 3) * 2;
#pragma unroll
      for (int n = 0; n < 4; ++n)
#pragma unroll
        for (int e = 0; e < 4; ++e) { const int kk = n >> 1, jj = 4 * (n & 1) + e; const unsigned bw = bfw[kk][jj >> 1], kw = kfw[kk][jj >> 1];
            *(LAS unsigned short*)(rec + R_BKF + n * 1024 + lb + e * 16) = (unsigned short)((jj & 1) ? (bw >> 16) : bw);
            *(LAS unsigned short*)(rec + R_BKF + n * 1024 + lb + e * 16 + 8) = (unsigned short)((jj & 1) ? (kw >> 16) : kw);
        } }
    if (ckn >= 0) rw3_load(c, q, j, b, hd, ckn, 4);
    f32x4 Aab = (f32x4){0.f, 0.f, 0.f, 0.f}, Aak = Aab, Arb = Aab, Ark = Aab;
#pragma unroll
    for (int kk = 0; kk < 2; ++kk) {
        const bf16x8_t af = __builtin_bit_cast(bf16x8_t, afw[kk]), rf = __builtin_bit_cast(bf16x8_t, rfw[kk]), bf_ = __builtin_bit_cast(bf16x8_t, bfw[kk]), kf = __builtin_bit_cast(bf16x8_t, kfw[kk]);
        Aab = __builtin_amdgcn_mfma_f32_16x16x32_bf16(af, bf_, Aab, 0, 0, 0); Aak = __builtin_amdgcn_mfma_f32_16x16x32_bf16(af, kf, Aak, 0, 0, 0);
        Arb = __builtin_amdgcn_mfma_f32_16x16x32_bf16(rf, bf_, Arb, 0, 0, 0); Ark = __builtin_amdgcn_mfma_f32_16x16x32_bf16(rf, kf, Ark, 0, 0, 0); }
#pragma unroll
    for (int r = 0; r < 4; ++r) { const int t = 4 * fq + r;
        *(LAS float*)(scr + (t * 16 + fr) * 4) = t > fr ? Aab[r] : 0.f;
        *(LAS bf16*)(scr + 1024 + (t * 16 + fr) * 2) = f2bf(t > fr ? Aak[r] : 0.f);
        *(LAS bf16*)(scr + 1536 + (t * 16 + fr) * 2) = f2bf(t >= fr ? Arb[r] : 0.f);
        *(LAS bf16*)(scr + 2048 + (t * 16 + fr) * 2) = f2bf(t >= fr ? Ark[r] : 0.f); }
    LWAIT();
    float Tc[16];
#pragma unroll
    for (int t = 0; t < 16; ++t) {
        float acc = (t == fr) ? 1.f : 0.f, last = 0.f;
#pragma unroll
        for (int u4 = 0; u4 < (t + 3) / 4; ++u4) { const f32x4 ar = *(const LAS f32x4*)(scr + (t * 16 + 4 * u4) * 4);
#pragma unroll
            for (int e = 0; e < 4; ++e) { if (4 * u4 + e < t - 1) acc += ar[e] * Tc[4 * u4 + e]; if (4 * u4 + e == t - 1) last = ar[e]; } }
        Tc[t] = t > 0 ? acc + last * Tc[t > 0 ? t - 1 : 0] : acc; }
    if (fq == 0) {
#pragma unroll
        for (int t = 0; t < 16; ++t) *(LAS bf16*)(scr + 2560 + (t * 16 + fr) * 2) = f2bf(Tc[t]); }
    LWAIT();
    { const u32x2 ak = *(const LAS u32x2*)(scr + 1024 + (fr * 16 + 4 * fq) * 2), tt = *(const LAS u32x2*)(scr + 2560 + (fr * 16 + 4 * fq) * 2);
      const u32x2 rbv = *(const LAS u32x2*)(scr + 1536 + (fr * 16 + 4 * fq) * 2), rkv = *(const LAS u32x2*)(scr + 2048 + (fr * 16 + 4 * fq) * 2);
      *(LAS u32x4*)(rec + R_RECA + lane * 16) = (u32x4){ak.x, ak.y, tt.x, tt.y}; *(LAS u32x4*)(rec + R_RECB + lane * 16) = (u32x4){rbv.x, rbv.y, rkv.x, rkv.y}; }
    LWAIT();
}
DEVI void f_rwkv_chunked(const Ctx& c, const PArgs& a, int j, int b, int hd) {
    bf16* O = (bf16*)(c.ws + WS_O);
    const int w = c.wave, lane = c.lane, fr = lane & 15, fq = lane >> 4;
    constexpr int NCK = TP / 16, NGR = (NCK + 3) / 4;
    __syncthreads();
    if (w >= 4) {
        __builtin_amdgcn_s_setprio(PREP_PRIO);
        { LAS unsigned char* scr = c.lds + RW3_SCR + (w - 4) * RW3_SCRW;
          if (fr < 12) { const int n = fr & 3, which = fr >> 2; const size_t o = (size_t)j * D + hd * 64 + 16 * n + 4 * fq;
              const float* p0 = a.in[I_OKK]; const float* p1 = a.in[I_OKA]; const float* p2 = a.in[I_ORK];
              *(LAS f32x4*)(scr + RW3_CF + (fq * 12 + which * 4 + n) * 16) = *(const f32x4*)((which == 0 ? p0 : (which == 1 ? p1 : p2)) + o); }
          LWAIT(); }
        RwRaw q;
        rw3_load(c, q, j, b, hd, w - 4, 7);
        rw3_prep(c, j, b, hd, w, q, c.lds + RW3_RING + (w - 4) * RW3_REC, c.lds + RW3_SCR + (w - 4) * RW3_SCRW);
        __syncthreads();
#pragma unroll 1
        for (int g = 0; g < NGR; ++g) {
            const int ck = 4 * (g + 1) + (w - 4);
            if (ck < NCK) rw3_prep(c, j, b, hd, ck + 4 < NCK ? ck + 4 : -1, q, c.lds + RW3_RING + (((g + 1) & 1) * 4 + (w - 4)) * RW3_REC, c.lds + RW3_SCR + (w - 4) * RW3_SCRW);
            __syncthreads();
        }
    __builtin_amdgcn_s_setprio(0);
    } else {
        __builtin_amdgcn_s_setprio(CHAIN_PRIO);
        f32x4 G[4];
#pragma unroll
        for (int jb = 0; jb < 4; ++jb) G[jb] = (f32x4){0.f, 0.f, 0.f, 0.f};
        const int ch = hd * 64 + 16 * w + fr;
        const float gng = a.in[I_OGNG][(size_t)j * D + ch], gnb = a.in[I_OGNB][(size_t)j * D + ch];
        __syncthreads();
#pragma unroll 1
        for (int g = 0; g < NGR; ++g) {
            const int nck = (NCK - 4 * g) < 4 ? (NCK - 4 * g) : 4;
            f32x4 yk[4]; u32x2 vk[4], gk[4]; f32x4 bk[4];
            LAS float* stat = (LAS float*)(c.lds + RW3_STAT + (g & 1) * 2048);
#pragma unroll
            for (int q = 0; q < 4; ++q) {
                if (q < nck) {
                    const LAS unsigned char* rec = c.lds + RW3_RING + ((g & 1) * 4 + q) * RW3_REC;
                    bf16x8_t gb[2];
#pragma unroll
                    for (int kk = 0; kk < 2; ++kk) { u32x4 t; t.x = pk2(G[2 * kk][0], G[2 * kk][1]); t.y = pk2(G[2 * kk][2], G[2 * kk][3]); t.z = pk2(G[2 * kk + 1][0], G[2 * kk + 1][1]); t.w = pk2(G[2 * kk + 1][2], G[2 * kk + 1][3]); gb[kk] = __builtin_bit_cast(bf16x8_t, t); }
                    const u32x2 vf = *(const LAS u32x2*)(rec + R_VF + (w * 64 + lane) * 8); const u32x4 ra = *(const LAS u32x4*)(rec + R_RECA + lane * 16);
                    vk[q] = vf; gk[q] = *(const LAS u32x2*)(rec + R_GF + (w * 64 + lane) * 8); bk[q] = *(const LAS f32x4*)(rec + R_BON + 16 * fq);
                    const u32x2 z2 = (u32x2){0u, 0u};
                    f32x4 W = __builtin_amdgcn_mfma_f32_16x16x32_bf16(__builtin_bit_cast(bf16x8_t, ra), frag_lohi(vf, z2), (f32x4){0.f, 0.f, 0.f, 0.f}, 0, 0, 0);
                    W = __builtin_amdgcn_mfma_f32_16x16x32_bf16(*(const LAS bf16x8_t*)(rec + R_AF + lane * 16), gb[0], W, 0, 0, 0);
                    W = __builtin_amdgcn_mfma_f32_16x16x32_bf16(*(const LAS bf16x8_t*)(rec + R_AF + (64 + lane) * 16), gb[1], W, 0, 0, 0);
                    const u32x2 wlo = (u32x2){pk2(W[0], W[1]), pk2(W[2], W[3])};
                    const f32x4 U = __builtin_amdgcn_mfma_f32_16x16x32_bf16(frag_lohi((u32x2){ra.z, ra.w}, (u32x2){ra.x, ra.y}), frag_lohi(wlo, z2), (f32x4){0.f, 0.f, 0.f, 0.f}, 0, 0, 0);
                    const bf16x8_t ub = frag_lohi((u32x2){pk2(U[0], U[1]), pk2(U[2], U[3])}, vf);
                    f32x4 Y = __builtin_amdgcn_mfma_f32_16x16x32_bf16(*(const LAS bf16x8_t*)(rec + R_RF + lane * 16), gb[0], (f32x4){0.f, 0.f, 0.f, 0.f}, 0, 0, 0);
                    Y = __builtin_amdgcn_mfma_f32_16x16x32_bf16(*(const LAS bf16x8_t*)(rec + R_RF + (64 + lane) * 16), gb[1], Y, 0, 0, 0);
                    Y = __builtin_amdgcn_mfma_f32_16x16x32_bf16(*(const LAS bf16x8_t*)(rec + R_RECB + lane * 16), ub, Y, 0, 0, 0);
#pragma unroll
                    for (int jb = 0; jb < 4; ++jb) { G[jb] = __builtin_amdgcn_mfma_f32_16x16x32_bf16(*(const LAS bf16x8_t*)(rec + R_BKF + (jb * 64 + lane) * 16), ub, G[jb], 0, 0, 0);
                        G[jb] = G[jb] * *(const LAS f32x4*)(rec + R_PL + (16 * jb + 4 * fq) * 4); }
                    yk[q] = Y;
#pragma unroll
                    for (int r = 0; r < 4; ++r) { const float s1 = red16(Y[r]), s2 = red16(Y[r] * Y[r]); if (fr == 0) *(LAS f32x2_t*)(stat + ((q * 4 + w) * 16 + 4 * fq + r) * 2) = (f32x2_t){s1, s2}; }
                }
            }
            __syncthreads();
#pragma unroll
            for (int q = 0; q < 4; ++q) {
                if (q < nck) {
#pragma unroll
                    for (int r = 0; r < 4; ++r) { const int t = 4 * fq + r; float s1 = 0.f, s2 = 0.f;
#pragma unroll
                        for (int ww = 0; ww < 4; ++ww) { const f32x2_t sv = *(const LAS f32x2_t*)(stat + ((q * 4 + ww) * 16 + t) * 2); s1 += sv.x; s2 += sv.y; }
                        const float mu = s1 * (1.f / 64.f), var = fmaxf(s2 * (1.f / 64.f) - mu * mu, 0.f), rs = __builtin_amdgcn_rsqf(var + 64e-5f);
                        const unsigned vb_ = r < 2 ? vk[q].x : vk[q].y, gb_ = r < 2 ? gk[q].x : gk[q].y;
                        const float v = (r & 1) ? __uint_as_float(vb_ & 0xffff0000u) : __uint_as_float(vb_ << 16), gt = (r & 1) ? __uint_as_float(gb_ & 0xffff0000u) : __uint_as_float(gb_ << 16);
                        const float o = ((yk[q][r] - mu) * rs * gng + gnb + bk[q][r] * v) * gt;
                        O[(size_t)(b * TP + (4 * g + q) * 16 + t) * D + ch] = f2bf(o); }
                }
            }
        }
        float* So = c.out + O_RWKVP + ((size_t)(j * BP + b) * 16 + hd) * 4096 + (size_t)(16 * w + fr) * 64 + 4 * fq;
#pragma unroll
        for (int jb = 0; jb < 4; ++jb) *(f32x4*)(So + 16 * jb) = G[jb];
        __builtin_amdgcn_s_setprio(0);
    }
    __syncthreads();
}
#ifndef SSB
#define SSB 160
#endif
#ifndef SCAN_PART
#define SCAN_PART 3
#endif
DEVI void f_odd_scan3(const Ctx& c, const PArgs& a, int li, int part) {
    const int j = li >> 1;
    if (c.bid < 128) { if (part & 1) f_rwkv_chunked(c, a, j, c.bid >> 4, c.bid & 15); }
    else if ((part & 2) && c.bid >= SSB) for (int u = c.bid - SSB; u < 2048; u += c.G - SSB) f_rwkv_sample(c, a, j, u >> 4, u & 15);
}

template <int CTRL> DEVI float dppz(float x) { return __builtin_bit_cast(float, __builtin_amdgcn_update_dpp(0, __builtin_bit_cast(int, x), CTRL, 0xF, 0xF, true)); }
struct EpiUpAct {
    static constexpr bool PERM = true;
    bf16* U; bf16* ACT; const float* RS; const float* CW; const float* CB; float* FCP;
    DEVI void operator()(const f32x4 (&acc)[2][2][4][2], const pg8::Unit& u, int wr, int wc, int fr, int fq) const {
        const int f0 = u.pn * 128 + wc * 32 + fq * 8;
        f32x4 w0[2], w1[2], w2[2], cb[2];
#pragma unroll
        for (int n = 0; n < 2; ++n) { w0[n] = *(const f32x4*)(CW + f0 + 4 * n); w1[n] = *(const f32x4*)(CW + DFF + f0 + 4 * n); w2[n] = *(const f32x4*)(CW + 2 * DFF + f0 + 4 * n); cb[n] = *(const f32x4*)(CB + f0 + 4 * n); }
        float rsv[2][4];
        { f32x4 rq[2][4];
#pragma unroll
          for (int ai = 0; ai < 2; ++ai)
#pragma unroll
            for (int m = 0; m < 4; ++m) rq[ai][m] = *(const f32x4*)(RS + (size_t)(u.pm * 256 + ai * 128 + wr * 64 + m * 16 + fr) * 16 + 4 * fq);
          asm volatile("" ::: "memory");
#pragma unroll
          for (int ai = 0; ai < 2; ++ai)
#pragma unroll
            for (int m = 0; m < 4; ++m) rsv[ai][m] = row_rstd_fin(rq[ai][m]); }
#pragma unroll
        for (int ai = 0; ai < 2; ++ai) {
            const int rowg = u.pm * 256 + ai * 128 + wr * 64;
            const bool sample = rowg >= MP;
            f32x4 ug[4][2];
            float rs[4];
#pragma unroll
            for (int m = 0; m < 4; ++m) { rs[m] = rsv[ai][m]; ug[m][0] = acc[ai][0][m][0] * rs[m]; ug[m][1] = acc[ai][0][m][1] * rs[m]; }
#pragma unroll
            for (int m = 3; m >= 0; --m) {
                const int row = rowg + m * 16 + fr; const int tt = sample ? 16 : (rowg + m * 16) % TP;
                const f32x4 uv0 = acc[ai][1][m][0] * rs[m], uv1 = acc[ai][1][m][1] * rs[m];
                f32x4 p1[2], p2[2];
#pragma unroll
                for (int n = 0; n < 2; ++n)
#pragma unroll
                    for (int e = 0; e < 4; ++e) {
                        const float cur = ug[m][n][e];
                        float q1 = dppz<0x111>(cur), q2 = dppz<0x112>(cur);
                        if (m > 0) { const float prv = ug[m > 0 ? m - 1 : 0][n][e]; q1 += dppz<0x10F>(prv); q2 += dppz<0x10E>(prv); }
                        p1[n][e] = q1; p2[n][e] = q2;
                        if (tt == 0) { if (fr == 0) p1[n][e] = 0.f; if (fr < 2) p2[n][e] = 0.f; } }
                const bool pending = sample || (m == 0 && fr < 2);
                if (pending || (m == 3 && fr >= 14)) *(u32x4*)(U + (size_t)row * NUP + f0) = pack8(ug[m][0], ug[m][1]);
                if (pending) *(u32x4*)(U + (size_t)row * NUP + DFF + f0) = pack8(uv0, uv1);
                else {
                    f32x4 o0, o1;
#pragma unroll
                    for (int e = 0; e < 4; ++e) { o0[e] = geluf_(cb[0][e] + w2[0][e] * ug[m][0][e] + w1[0][e] * p1[0][e] + w0[0][e] * p2[0][e]) * uv0[e];
                        o1[e] = geluf_(cb[1][e] + w2[1][e] * ug[m][1][e] + w1[1][e] * p1[1][e] + w0[1][e] * p2[1][e]) * uv1[e]; }
                    *(u32x4*)(ACT + (size_t)row * DFF + f0) = pack8(o0, o1);
                    if (tt == TP - 16 && fr >= 14) { float* so = FCP + ((size_t)(row / TP) * 2 + (fr - 14)) * DFF + f0; *(f32x4*)so = ug[m][0]; *(f32x4*)(so + 4) = ug[m][1]; }
                }
            }
        }
    }
};
DEVI void f_ffn_up_act(const Ctx& c, const PArgs& a, int li) {
    pg8::Gemm g{(const bf16*)(c.ws + WS_XB), (const bf16*)(c.ws + WS_WB + WB_WUP + li * SZ_WUP), M, NUP, D, D, 0ull, 0};
    pg8::StaticOrder S; S.init(M, NUP, c.G, c.bid);
    EpiUpAct E{(bf16*)(c.ws + WS_U), (bf16*)(c.ws + WS_ACT), (const float*)(c.ws + WS_RS), a.in[I_FCW] + (size_t)li * 3 * DFF, a.in[I_FCB] + (size_t)li * DFF, c.out + O_FCONVP + (size_t)li * BP * 2 * DFF};
    pg8::gemm_phase<EpiUpAct>(c.lds, c.tid, g, S, E);
}
DEVI void f_ffn_fix(const Ctx& c, const PArgs& a, int li) {
    const bf16* U = (const bf16*)(c.ws + WS_U); bf16* ACT = (bf16*)(c.ws + WS_ACT);
    const float* CW = a.in[I_FCW] + (size_t)li * 3 * DFF; const float* CB = a.in[I_FCB] + (size_t)li * DFF;
    constexpr int NPC = DFF / 8, NROW = (MP / 64) * 2 + BS, NITEM = NPC * NROW;
    for (int it = c.bid * NT + c.tid; it < NITEM; it += c.G * NT) {
        const int ri = it / NPC, pc = it - ri * NPC, col = pc * 8;
        const int row = ri < (MP / 64) * 2 ? (ri >> 1) * 64 + (ri & 1) : MP + (ri - (MP / 64) * 2);
        const u32x4 ug = *(const u32x4*)(U + (size_t)row * NUP + col), uv = *(const u32x4*)(U + (size_t)row * NUP + DFF + col);
        float f1[8], f2[8];
        if (row < MP) { const int t = row % TP; u32x4 p1 = (u32x4){0u, 0u, 0u, 0u}, p2 = p1;
            if (t >= 1) p1 = *(const u32x4*)(U + (size_t)(row - 1) * NUP + col); if (t >= 2) p2 = *(const u32x4*)(U + (size_t)(row - 2) * NUP + col);
#pragma unroll
            for (int e = 0; e < 4; ++e) { f1[2 * e] = __uint_as_float(p1[e] << 16); f1[2 * e + 1] = __uint_as_float(p1[e] & 0xffff0000u); f2[2 * e] = __uint_as_float(p2[e] << 16); f2[2 * e + 1] = __uint_as_float(p2[e] & 0xffff0000u); }
        } else { const float* st = a.in[I_SFCONV] + (size_t)(li * BS + row - MP) * 2 * DFF + col; float* so = c.out + O_FCONVS + (size_t)(li * BS + row - MP) * 2 * DFF + col;
#pragma unroll
            for (int h = 0; h < 2; ++h) { const f32x4 s2 = *(const f32x4*)(st + 4 * h), s1 = *(const f32x4*)(st + DFF + 4 * h); *(f32x4*)(so + 4 * h) = s1;
#pragma unroll
                for (int e = 0; e < 4; ++e) { f2[4 * h + e] = s2[e]; f1[4 * h + e] = s1[e]; } }
#pragma unroll
            for (int e = 0; e < 4; ++e) { so[DFF + 2 * e] = __uint_as_float(ug[e] << 16); so[DFF + 2 * e + 1] = __uint_as_float(ug[e] & 0xffff0000u); } }
        u32x4 o;
#pragma unroll
        for (int e = 0; e < 4; ++e) { const float u0a = __uint_as_float(ug[e] << 16), u0b = __uint_as_float(ug[e] & 0xffff0000u);
            const float ca = CB[col + 2 * e] + CW[2 * DFF + col + 2 * e] * u0a + CW[DFF + col + 2 * e] * f1[2 * e] + CW[col + 2 * e] * f2[2 * e];
            const float cv = CB[col + 2 * e + 1] + CW[2 * DFF + col + 2 * e + 1] * u0b + CW[DFF + col + 2 * e + 1] * f1[2 * e + 1] + CW[col + 2 * e + 1] * f2[2 * e + 1];
            o[e] = pk2(geluf_(ca) * __uint_as_float(uv[e] << 16), geluf_(cv) * __uint_as_float(uv[e] & 0xffff0000u)); }
        *(u32x4*)(ACT + (size_t)row * DFF + col) = o;
    }
}

DEVI void f_odd_norm(const Ctx& c, const PArgs& a, int li) {
    const int j = li >> 1;
    const bf16* XB = (const bf16*)(c.ws + WS_XB); const float* RS = (const float*)(c.ws + WS_RS); bf16* XM = (bf16*)(c.ws + WS_XMIX);
    const float* gain = a.in[I_NMIX] + (size_t)li * D; const float* mix = a.in[I_OMIX] + (size_t)j * 6 * D;
    const int gw = c.bid * NWAVES + c.wave, NGW = c.G * NWAVES;
    const int r0 = (int)(((long)gw * M) / NGW), r1 = (int)(((long)(gw + 1) * M) / NGW);
    f32x4 gv[4], mv[6][4];
#pragma unroll
    for (int q = 0; q < 4; ++q) { const int col = q * 256 + c.lane * 4; gv[q] = *(const f32x4*)(gain + col);
#pragma unroll
        for (int n = 0; n < 6; ++n) mv[n][q] = *(const f32x4*)(mix + (size_t)n * D + col); }
    f32x4 hprev[4];
#pragma unroll
    for (int q = 0; q < 4; ++q) hprev[q] = (f32x4){0.f, 0.f, 0.f, 0.f};
    for (int row = r0; row < r1; ++row) {
        const float rs = row_rstd(RS, row);
        const bool prompt = row < MP; const int b = prompt ? row / TP : row - MP, t = prompt ? row % TP : 0;
        const bool need_prev = prompt && t > 0 && row == r0;
        const float rsp = need_prev ? row_rstd(RS, row - 1) : 0.f;
#pragma unroll
        for (int q = 0; q < 4; ++q) { const int col = q * 256 + c.lane * 4;
            const u32x2 xw_ = *(const u32x2*)(XB + (size_t)row * D + col);
            const f32x4 h = (f32x4){__uint_as_float(xw_.x << 16), __uint_as_float(xw_.x & 0xffff0000u), __uint_as_float(xw_.y << 16), __uint_as_float(xw_.y & 0xffff0000u)} * rs * gv[q];
            f32x4 hp = hprev[q];
            if (!prompt) hp = *(const f32x4*)(a.in[I_SSHIFT] + (size_t)(j * BS + b) * D + col);
            else if (t == 0) hp = (f32x4){0.f, 0.f, 0.f, 0.f};
            else if (need_prev) { const u32x2 pw_ = *(const u32x2*)(XB + (size_t)(row - 1) * D + col);
                hp = (f32x4){__uint_as_float(pw_.x << 16), __uint_as_float(pw_.x & 0xffff0000u), __uint_as_float(pw_.y << 16), __uint_as_float(pw_.y & 0xffff0000u)} * rsp * gv[q]; }
            const f32x4 xx = hp - h;
#pragma unroll
            for (int n = 0; n < 6; ++n) { const f32x4 o = h + xx * mv[n][q]; u32x2 w; w.x = pk2(o.x, o.y); w.y = pk2(o.z, o.w); *(u32x2*)(XM + ((size_t)n * M + row) * D + col) = w; }
            if (prompt) { if (t == TP - 1) *(f32x4*)(c.out + O_SHIFTP + (size_t)(j * BP + b) * D + col) = h; }
            else *(f32x4*)(c.out + O_SHIFTS + (size_t)(j * BS + b) * D + col) = h;
            hprev[q] = h; }
    }
}

DEVI void f_tail_residual(const Ctx& c, const bf16* A, int lda, const bf16* Bt, int K, bool wxb) {
    float* X = (float*)(c.ws + WS_X); bf16* XB = (bf16*)(c.ws + WS_XB); float* RS = (float*)(c.ws + WS_RS);
    LAS float* red = (LAS float*)c.lds;
    const int fr = c.lane & 15, fq = c.lane >> 4, nks = K / 32;
    for (int task = c.bid; task < 256; task += c.G) {
        const int row0 = M_MAIN + (task >> 4) * 16, col0 = (task & 15) * 64;
        const bf16* ap = A + (size_t)(row0 + fr) * lda + 8 * fq; const bf16* bp = Bt + (size_t)(col0 + fr) * K + 8 * fq;
        f32x4 acc[4];
#pragma unroll
        for (int nb = 0; nb < 4; ++nb) acc[nb] = (f32x4){0.f, 0.f, 0.f, 0.f};
#pragma unroll 1
        for (int ks0 = c.wave; ks0 < nks; ks0 += 32) {
            bf16x8_t af[4], bf_[4][4];
#pragma unroll
            for (int u = 0; u < 4; ++u) { const int ks = ks0 + 8 * u; const bool ok = ks < nks; const unsigned ko = (unsigned)(32 * (ok ? ks : 0));
                af[u] = *(const bf16x8_t*)(ap + ko);
#pragma unroll
                for (int nb = 0; nb < 4; ++nb) bf_[u][nb] = *(const bf16x8_t*)(bp + (unsigned)(16 * nb * K) + ko);
                if (!ok) af[u] = (bf16x8_t){0, 0, 0, 0, 0, 0, 0, 0}; }
#pragma unroll
            for (int u = 0; u < 4; ++u)
#pragma unroll
                for (int nb = 0; nb < 4; ++nb) acc[nb] = __builtin_amdgcn_mfma_f32_16x16x32_bf16(af[u], bf_[u][nb], acc[nb], 0, 0, 0);
        }
        __syncthreads();
#pragma unroll
        for (int nb = 0; nb < 4; ++nb)
#pragma unroll
            for (int r = 0; r < 4; ++r) red[(c.wave * 16 + 4 * fq + r) * 64 + 16 * nb + fr] = acc[nb][r];
        __syncthreads();
        { const int r = c.tid >> 5, cc = 2 * (c.tid & 31); float v0 = 0.f, v1 = 0.f;
#pragma unroll
          for (int w = 0; w < 8; ++w) { const f32x2_t t = *(const LAS f32x2_t*)(red + (w * 16 + r) * 64 + cc); v0 += t.x; v1 += t.y; }
          const size_t o = (size_t)(row0 + r) * D + col0 + cc;
          const unsigned xo = *(const unsigned*)(XB + o); v0 += __uint_as_float(xo << 16); v1 += __uint_as_float(xo & 0xffff0000u);
          (void)wxb; (void)X; *(unsigned*)(XB + o) = pk2(v0, v1);
          const float ss = red32(v0 * v0 + v1 * v1);
          if ((c.tid & 31) == 0) RS[(size_t)(row0 + r) * 16 + (task & 15)] = ss; }
    }
    __syncthreads();
}

__global__ void __launch_bounds__(NT, 2) hybrid_fwd(Args args) {
    extern __shared__ __attribute__((aligned(16))) unsigned char lds_raw[];
    Ctx c;
    c.lds = (LAS unsigned char*)lds_raw;
    c.tid = threadIdx.x; c.lane = c.tid & 63; c.wave = __builtin_amdgcn_readfirstlane(c.tid >> 6);
    c.G = gridDim.x; c.bid = blockIdx.x; c.ws = args.ws; c.out = args.out;
    volatile LAS unsigned* MISC = (volatile LAS unsigned*)(c.lds + MISC_OFF);
    for (int u = c.tid; u < (LDS_BYTES - LDSCTL_OFF) / 4; u += NT) ((LAS unsigned*)(c.lds + LDSCTL_OFF))[u] = 0u;
    __syncthreads();
    if (c.tid < N_IN) ((LAS unsigned long long*)(c.lds + PTAB_OFF))[c.tid] = (unsigned long long)args.in[c.tid];
    __syncthreads();
    PArgs pa; pa.in.t = (const LAS unsigned long long*)(c.lds + PTAB_OFF);
    (void)xcd_barrier_post((unsigned*)(c.ws + WS_CTL) + 4096, MISC + 8);
#define GRID_BAR() do { XcdBarrier bar_; bar_.bar = (unsigned*)(c.ws + WS_CTL) + 4096; bar_.x = xb_xcc_id(); bar_.st = (volatile LAS unsigned*)(c.lds + MISC_OFF) + 8; xcd_barrier(bar_); } while (0)
#define RETID() do { asm volatile("" : "+s"(c.wave), "+s"(c.bid), "+s"(c.G)); asm volatile("v_mbcnt_lo_u32_b32 %0, -1, 0\n\tv_mbcnt_hi_u32_b32 %0, -1, %0" : "=v"(c.lane)); c.tid = c.wave * 64 + c.lane; } while (0)
#define PHASE(body) do { RETID(); body; GRID_BAR(); } while (0)
    for (int rep = 0; rep < REP_PRO; ++rep) PHASE({ n_prologue(c, pa); f_wprep(c, pa, 1ull, c.bid * NWAVES + c.wave, c.G * NWAVES); });
#pragma unroll 1
    for (int li = 0; li < 4; ++li) {
        const int j = li >> 1;
        if ((li & 1) == 0) {
#if FAST & 1
            for (int rep = 0; rep < REP_G; ++rep) PHASE(f_even_in(c, li));
#else
            PHASE(n_even_in(c, pa, li));
#endif
#if FAST & 32
            for (int rep = 0; rep < REP_MIX; ++rep) PHASE(f_even_mix(c, pa, li, rep == 0 ? 7 : MIX_PART));
#else
            PHASE(n_even_mix(c, pa, li));
#endif
#if FAST & 2
            PHASE({ f_gemm_residual(c, (const bf16*)(c.ws + WS_MIX), 2048, (const bf16*)(c.ws + WS_WB + WB_WOUT + j * SZ_WOUT), 2048, true); RETID(); f_tail_residual(c, (const bf16*)(c.ws + WS_MIX), 2048, (const bf16*)(c.ws + WS_WB + WB_WOUT + j * SZ_WOUT), 2048, true); });
#else
            PHASE(n_gemm_residual(c, (const bf16*)(c.ws + WS_MIX), 2048, pa.in[I_EWOUT] + (size_t)j * 2048 * D, 2048, true));
#endif
        } else {
            for (int rep = 0; rep < REP_NORM; ++rep) PHASE(f_odd_norm(c, pa, li));
#if FAST & 8
            for (int rep = 0; rep < REP_G; ++rep) PHASE(f_odd_in(c, li));
#else
            PHASE(n_odd_in(c, pa, li));
#endif
#if FAST & 16
            for (int rep = 0; rep < REP_G; ++rep) PHASE(f_odd_lora(c, pa, li));
#else
            PHASE(n_odd_lora(c, pa, li));
#endif
#if FAST & 128
#if FAST & 512
            for (int rep = 0; rep < REP_SCAN; ++rep) PHASE(f_odd_scan3(c, pa, li, rep == 0 ? 3 : SCAN_PART));
#elif FAST & 256
            for (int rep = 0; rep < REP_SCAN; ++rep) { PHASE(f_odd_scan2(c, pa, li)); PHASE(f_rwkv_post(c, pa, li)); }
#else
            for (int rep = 0; rep < REP_SCAN; ++rep) PHASE(f_odd_scan(c, pa, li));
#endif
#else
            for (int rep = 0; rep < REP_SCAN; ++rep) PHASE(n_odd_scan(c, pa, li));
#endif
#if FAST & 2
            PHASE({ f_gemm_residual(c, (const bf16*)(c.ws + WS_O), D, (const bf16*)(c.ws + WS_WB + WB_WO + j * SZ_WO), D, true); RETID(); f_tail_residual(c, (const bf16*)(c.ws + WS_O), D, (const bf16*)(c.ws + WS_WB + WB_WO + j * SZ_WO), D, true); });
#else
            PHASE(n_gemm_residual(c, (const bf16*)(c.ws + WS_O), D, pa.in[I_OWO] + (size_t)j * D * D, D, true));
#endif
        }
#if FUSE_ACT
        for (int rep = 0; rep < REP_G; ++rep) PHASE(f_ffn_up_act(c, pa, li));
        PHASE(f_ffn_fix(c, pa, li));
#else
#if FAST & 4
        for (int rep = 0; rep < REP_G; ++rep) PHASE(f_ffn_up(c, li));
#else
        PHASE(n_ffn_up(c, pa, li));
#endif
#if FAST & 64
        for (int rep = 0; rep < REP_ACT; ++rep) PHASE(f_ffn_act(c, pa, li));
#else
        for (int rep = 0; rep < REP_ACT; ++rep) PHASE(n_ffn_act(c, pa, li));
#endif
#endif
#if FAST & 2
        PHASE({ f_gemm_residual(c, (const bf16*)(c.ws + WS_ACT), DFF, (const bf16*)(c.ws + WS_WB + WB_WDN + li * SZ_WDN), DFF, li == 1); RETID(); f_tail_residual(c, (const bf16*)(c.ws + WS_ACT), DFF, (const bf16*)(c.ws + WS_WB + WB_WDN + li * SZ_WDN), DFF, li == 1);   });
#else
        PHASE(n_gemm_residual(c, (const bf16*)(c.ws + WS_ACT), DFF, pa.in[I_FWDN] + (size_t)li * DFF * D, DFF, true));
#endif
    }
    RETID(); n_final(c, pa);
#undef PHASE
}

extern "C" void kernel_launch(void* const* d_in, const int* in_sizes, int n_in, void* d_out, int out_size, void* d_ws, size_t ws_size, hipStream_t stream) {
    static int grid = 0;
    if (grid == 0) {
        if (n_in != N_IN || (size_t)out_size != O_END || ws_size < WS_END) {
            fprintf(stderr, "kernel_launch: unexpected shapes: n_in %d (want %d), out %d (want %zu), ws %zu (want >= %zu)\n", n_in, (int)N_IN, out_size, (size_t)O_END, ws_size, (size_t)WS_END);
            grid = -1; return; }
        int dev = 0, cus = 0;
        if (hipGetDevice(&dev) != hipSuccess || hipDeviceGetAttribute(&cus, hipDeviceAttributeMultiprocessorCount, dev) != hipSuccess) { grid = -1; return; }
        if (hipFuncSetAttribute((const void*)hybrid_fwd, hipFuncAttributeMaxDynamicSharedMemorySize, LDS_BYTES) != hipSuccess) { fprintf(stderr, "kernel_launch: hipFuncSetAttribute failed\n"); grid = -1; return; }
        int per_cu = 0;
        (void)hipOccupancyMaxActiveBlocksPerMultiprocessor(&per_cu, (const void*)hybrid_fwd, NT, LDS_BYTES);
        (void)hipGetLastError();
        grid = cus;
    }
    if (grid < 0) return;
    if (hipMemsetAsync((char*)d_ws + WS_CTL, 0, CTL_ZERO_BYTES, stream) != hipSuccess) return;
    Args a{};
    for (int i = 0; i < N_IN; ++i) a.in[i] = (const float*)d_in[i];
    a.out = (float*)d_out; a.ws = (unsigned char*)d_ws;
    hipLaunchKernelGGL(hybrid_fwd, dim3(grid), dim3(NT), LDS_BYTES, stream, a);
}
```

```cpp
#include <hip/hip_runtime.h>
#include <cstdio>
#include <cstdint>

#define GAS __attribute__((address_space(1)))
#define LAS __attribute__((address_space(3)))
#define DEVI __device__ __forceinline__
typedef unsigned short bf16;
typedef float f32x4 __attribute__((ext_vector_type(4)));
typedef unsigned u32x2 __attribute__((ext_vector_type(2)));
typedef float f32x2_t __attribute__((ext_vector_type(2)));
typedef unsigned u32x4 __attribute__((ext_vector_type(4)));

#ifndef FAST
#define FAST 1023
#endif
#ifndef REP_SCAN
#define REP_SCAN 1
#endif
#ifndef REP_ACT
#define REP_ACT 1
#endif
#ifndef REP_MIX
#define REP_MIX 1
#endif
#ifndef REP_PRO
#define REP_PRO 1
#endif
#ifndef FUSE_ACT
#define FUSE_ACT 1
#endif
#ifndef REP_G
#define REP_G 1
#endif
#ifndef REP_NORM
#define REP_NORM 1
#endif
constexpr int D = 1024, TP = 2064, NMETA = 16, SEQ = 2048, BP = 8, BS = 128;
constexpr int MP = BP * TP;
constexpr int M = MP + BS;
constexpr int NIN = 5120, DFF = 2816, NUP = 2 * DFF;
constexpr int M_MAIN = 16384;
constexpr int LML = 640;
constexpr int NWAVES = 8, NT = NWAVES * 64;

constexpr size_t MiB = 1u << 20;
constexpr size_t WS_CTL = 0, CTL_ZERO_BYTES = 1 * MiB;
constexpr size_t WS_RS = 1 * MiB;
constexpr size_t WS_ROPE = 3 * MiB;
constexpr size_t WS_WB = 5 * MiB;
constexpr size_t WS_X = 124 * MiB;
constexpr size_t WS_R = 124 * MiB;
constexpr size_t WS_XB = 189 * MiB;
constexpr size_t WS_BIG = 222 * MiB;
constexpr size_t SZ_ACT1 = (size_t)M * D * 2;
constexpr size_t WS_Z = WS_BIG, WS_MIX = WS_BIG + 163 * MiB;
constexpr size_t WS_U = WS_BIG, WS_ACT = WS_BIG + 179 * MiB;
constexpr size_t WS_XMIX = WS_BIG, WS_K = WS_BIG + 195 * MiB, WS_V = WS_BIG + 228 * MiB;
constexpr size_t WS_WDEC = WS_BIG, WS_AG = WS_BIG + 65 * MiB, WS_GG = WS_AG + SZ_ACT1, WS_VG = WS_GG + SZ_ACT1, WS_O = WS_VG + SZ_ACT1;
constexpr size_t WS_END = WS_BIG + 270 * MiB;
static_assert(WS_O + SZ_ACT1 <= WS_K && WS_ACT + (size_t)M * DFF * 2 <= WS_END && WS_V + SZ_ACT1 <= WS_END && WS_MIX + (size_t)M * 2048 * 2 <= WS_END, "ws map");
constexpr size_t DO_VFIRST = 0, DO_LMID = 33 * MiB;
static_assert(DO_LMID + (size_t)M * LML * 2 <= (size_t)BP * SEQ * D * 4, "d_out scratch");

constexpr size_t O_YP = 0, O_YS = O_YP + (size_t)BP * SEQ * D, O_RETP = O_YS + (size_t)BS * D, O_LRUP = O_RETP + (size_t)2 * BP * 4 * 128 * 256,
    O_LCONVP = O_LRUP + (size_t)2 * BP * 1024, O_RWKVP = O_LCONVP + (size_t)2 * BP * 3 * 1024, O_SHIFTP = O_RWKVP + (size_t)2 * BP * 16 * 64 * 64,
    O_FCONVP = O_SHIFTP + (size_t)2 * BP * 1024, O_RETS = O_FCONVP + (size_t)4 * BP * 2 * DFF, O_LRUS = O_RETS + (size_t)2 * BS * 4 * 128 * 256,
    O_LCONVS = O_LRUS + (size_t)2 * BS * 1024, O_RWKVS = O_LCONVS + (size_t)2 * BS * 3 * 1024, O_SHIFTS = O_RWKVS + (size_t)2 * BS * 16 * 64 * 64,
    O_FCONVS = O_SHIFTS + (size_t)2 * BS * 1024, O_END = O_FCONVS + (size_t)4 * BS * 2 * DFF;

enum { I_XP = 0, I_XS, I_SRET, I_SLRU, I_SLCONV, I_SRWKV, I_SSHIFT, I_SFCONV, I_META, I_NMIX, I_NFFN, I_NFIN,
       I_EWIN, I_ERGN, I_ECW, I_ECB, I_EWA, I_EBA, I_EWX, I_EBX, I_ELAM, I_EWOUT,
       I_OMIX, I_OWR, I_OWK, I_OWV, I_OW0, I_OW1, I_OW2, I_OA0, I_OA1, I_OA2, I_OV0, I_OV1, I_OV2, I_OG1, I_OG2, I_OKK, I_OKA, I_ORK, I_OGNG, I_OGNB, I_OWO,
       I_FWUP, I_FCW, I_FCB, I_FWDN, N_IN };

constexpr int RING_BYTES = 143360, LDSCTL_OFF = RING_BYTES, MISC_OFF = LDSCTL_OFF + 320, LDS_BYTES = 147456;

DEVI float bf2f(bf16 v) { return __uint_as_float((unsigned)v << 16); }
typedef __bf16 hbf16x2_t __attribute__((ext_vector_type(2)));
DEVI unsigned pk2(float lo, float hi) { const f32x2_t v = (f32x2_t){lo, hi}; return __builtin_bit_cast(unsigned, __builtin_convertvector(v, hbf16x2_t)); }
DEVI bf16 f2bf(float f) { return (bf16)(pk2(f, f) & 0xffffu); }
DEVI float wave_sum(float v) {
#pragma unroll
    for (int o = 1; o < 64; o <<= 1) v += __shfl_xor(v, o);
    return v;
}
DEVI float rcpf_(float x) { return __builtin_amdgcn_rcpf(x); }
DEVI float sigmoidf_(float x) { return rcpf_(1.f + __expf(-x)); }
DEVI float siluf_(float x) { return x * rcpf_(1.f + __expf(-x)); }
DEVI float tanhf_(float x) { return 2.f * rcpf_(1.f + __expf(-2.f * x)) - 1.f; }
DEVI float geluf_(float x) { return x * rcpf_(1.f + __expf(-1.5957691216057308f * (x + 0.044715f * x * x * x))); }
DEVI float softplusf_(float x) { return fmaxf(x, 0.f) + log1pf(__expf(-fabsf(x))); }

#define XB_TMO      128
#define XB_XCNT(j)  (256  + 64 * (j))
#define XB_XSUB(j)  (1280 + 64 * (j))
#define XB_XGEN(j)  (2304 + 64 * (j))
#define XB_TOP      3328
#define XB_TOPGEN   3392
#define XCD_BAR_WORDS 3456
#define XB_SPIN_CAP (1u << 22)
DEVI unsigned xb_ld(unsigned* p)              { return __hip_atomic_load(p, __ATOMIC_RELAXED, __HIP_MEMORY_SCOPE_AGENT); }
DEVI unsigned xb_add(unsigned* p, unsigned v) { return __hip_atomic_fetch_add(p, v, __ATOMIC_RELAXED, __HIP_MEMORY_SCOPE_AGENT); }
DEVI unsigned xb_xcc_id() { return (unsigned)__builtin_amdgcn_s_getreg((3 << 11) | 20) & 0xFu; }
#define XB_SPIN(cond, bar) do { unsigned _sp = 0; while (cond) { __builtin_amdgcn_s_sleep(1); \
    if ((++_sp & 255u) == 0u) { if (xb_ld(&(bar)[XB_TMO])) break; if (_sp > XB_SPIN_CAP) { atomicAdd(&(bar)[XB_TMO], 1u); break; } } } } while (0)
struct XcdBarrier { unsigned* bar; unsigned x; volatile LAS unsigned* st; };
DEVI XcdBarrier xcd_barrier_post(unsigned* bar, volatile LAS unsigned* st) {
    XcdBarrier b; b.bar = bar; b.x = xb_xcc_id(); b.st = st;
    if (threadIdx.x == 0) (void)xb_add(&bar[XB_XCNT(b.x)], 1u);
    return b;
}
DEVI void xcd_barrier_complete(unsigned* bar, unsigned x, unsigned& nloc, unsigned& nx) {
    const unsigned G = gridDim.x * gridDim.y * gridDim.z;
    unsigned sum, cnt, mine, sp = 0u;
    for (;;) {
        sum = 0u; cnt = 0u; mine = 0u;
#pragma unroll
        for (unsigned j = 0; j < 16; ++j) { const unsigned c = xb_ld(&bar[XB_XCNT(j)]); sum += c; cnt += (c > 0u) ? 1u : 0u; mine = (j == x) ? c : mine; }
        if (sum == G) break;
        __builtin_amdgcn_s_sleep(1);
        if ((++sp & 255u) == 0u) { if (xb_ld(&bar[XB_TMO])) break; if (sp > XB_SPIN_CAP) { atomicAdd(&bar[XB_TMO], 1u); break; } }
    }
    nloc = mine > 0u ? mine : 1u; nx = cnt > 0u ? cnt : 1u;
}
DEVI void xcd_barrier(const XcdBarrier& b) {
    asm volatile("s_waitcnt vmcnt(0)" ::: "memory");
    __syncthreads();
    if (threadIdx.x == 0) {
        unsigned* bar = b.bar;
        __builtin_amdgcn_s_waitcnt(0);
        unsigned nloc = b.st[0], nx = b.st[1];
        if (nloc == 0u) { xcd_barrier_complete(bar, b.x, nloc, nx); b.st[0] = nloc; b.st[1] = nx; }
        const unsigned old = xb_add(&bar[XB_XSUB(b.x)], 1u);
        const unsigned gen = old / nloc;
        if (old + 1u == (gen + 1u) * nloc) {
            __builtin_amdgcn_fence(__ATOMIC_RELEASE, "agent");
            asm volatile("s_waitcnt vmcnt(0)" ::: "memory");
            const unsigned og = xb_add(&bar[XB_TOP], 1u);
            const unsigned tg = og / nx;
            if (og + 1u == (tg + 1u) * nx) xb_add(&bar[XB_TOPGEN], 1u);
            else XB_SPIN(xb_ld(&bar[XB_TOPGEN]) == tg, bar);
            __builtin_amdgcn_fence(__ATOMIC_ACQUIRE, "agent");
            xb_add(&bar[XB_XGEN(b.x)], 1u);
            asm volatile("s_waitcnt vmcnt(0)" ::: "memory");
        } else {
            XB_SPIN(xb_ld(&bar[XB_XGEN(b.x)]) == gen, bar);
            __builtin_amdgcn_fence(__ATOMIC_ACQUIRE, "agent");
            asm volatile("s_waitcnt vmcnt(0)" ::: "memory");
        }
    }
    __syncthreads();
}

struct Args { const float* in[N_IN]; float* out; unsigned char* ws; };
constexpr int PTAB_OFF = MISC_OFF + 128;
struct InTab { const LAS unsigned long long* t;
    DEVI const float* operator[](int i) const { const unsigned long long v = t[i];
        const unsigned lo = __builtin_amdgcn_readfirstlane((unsigned)v), hi = __builtin_amdgcn_readfirstlane((unsigned)(v >> 32));
        return (const float*)(const __attribute__((address_space(1))) float*)(((unsigned long long)hi << 32) | lo); } };
struct PArgs { InTab in; };

struct Ctx {
    LAS unsigned char* lds;
    int tid, lane, wave, G, bid;
    unsigned char* ws; float* out;
};
DEVI int row_pos(int row) { return row < MP ? (row % TP) : TP; }
DEVI float row_rstd(const float* RS, int row) {
    const f32x4* p = (const f32x4*)(RS + (size_t)row * 16);
    const f32x4 a = p[0], b = p[1], c = p[2], d = p[3];
    const float s = ((a.x + a.y) + (a.z + a.w)) + ((b.x + b.y) + (b.z + b.w)) + ((c.x + c.y) + (c.z + c.w)) + ((d.x + d.y) + (d.z + d.w));
    return __builtin_amdgcn_rsqf(s * (1.0f / D) + 1e-6f);
}
DEVI float row_rstd_fin(const f32x4 a) {
    float s = (a.x + a.y) + (a.z + a.w);
    u32x2 r = __builtin_amdgcn_permlane16_swap(__float_as_uint(s), __float_as_uint(s), false, false); s = __uint_as_float(r.x) + __uint_as_float(r.y);
    r = __builtin_amdgcn_permlane32_swap(__float_as_uint(s), __float_as_uint(s), false, false); s = __uint_as_float(r.x) + __uint_as_float(r.y);
    return __builtin_amdgcn_rsqf(s * (1.0f / D) + 1e-6f);
}

DEVI void n_prologue(const Ctx& c, const PArgs& a) {
    float* X = (float*)(c.ws + WS_X); bf16* XB = (bf16*)(c.ws + WS_XB); float* RS = (float*)(c.ws + WS_RS);
    const int gw = c.bid * NWAVES + c.wave, NGW = c.G * NWAVES;
    for (int row = gw; row < M; row += NGW) {
        const float* src;
        if (row < MP) { const int b = row / TP, t = row % TP; src = t < NMETA ? a.in[I_META] + (size_t)t * D : a.in[I_XP] + ((size_t)b * SEQ + (t - NMETA)) * D; }
        else src = a.in[I_XS] + (size_t)(row - MP) * D;
        float ss = 0.f;
#pragma unroll
        for (int j = 0; j < 4; ++j) {
            const f32x4 v = __builtin_nontemporal_load((const f32x4*)(src + j * 256 + c.lane * 4));
            (void)X;
            u32x2 w; w.x = pk2(v.x, v.y); w.y = pk2(v.z, v.w);
            *(u32x2*)(XB + (size_t)row * D + j * 256 + c.lane * 4) = w;
            ss += (v.x * v.x + v.y * v.y) + (v.z * v.z + v.w * v.w);
        }
        ss = wave_sum(ss);
        if (c.lane < 16) RS[(size_t)row * 16 + c.lane] = c.lane == 0 ? ss : 0.f;
    }
    float* ROPE = (float*)(c.ws + WS_ROPE);
    for (int e = c.bid * NT + c.tid; e < (TP + 1) * 64; e += c.G * NT) {
        const int p = e >> 6, d = e & 63;
        const double pos = p < TP ? (double)p : 16384.0;
        const double inv = exp(-9.210340371976184 * ((double)d / 63.0));
        const double rev = pos * inv * 0.15915494309189535;
        const float fr = (float)(rev - rint(rev));
        ROPE[2 * e] = __builtin_amdgcn_cosf(fr); ROPE[2 * e + 1] = __builtin_amdgcn_sinf(fr);
    }
}

DEVI void ngemm_tile(const Ctx& c, const bf16* A, int lda, const float* W, int ldw, int ncv, int K, const float* gain, int row0, float (&acc)[4][4]) {
    LAS float* As = (LAS float*)c.lds;
    LAS float* Bs = (LAS float*)(c.lds + 8192);
#pragma unroll
    for (int j = 0; j < 4; ++j)
#pragma unroll
        for (int i = 0; i < 4; ++i) acc[j][i] = 0.f;
    const int ar = c.tid >> 4, ak = (c.tid & 15) * 2;
    for (int k0 = 0; k0 < K; k0 += 32) {
        __syncthreads();
        { const unsigned v = *(const unsigned*)(A + (size_t)(row0 + ar) * lda + k0 + ak);
          float lo = __uint_as_float(v << 16), hi = __uint_as_float(v & 0xffff0000u);
          if (gain) { lo *= gain[k0 + ak]; hi *= gain[k0 + ak + 1]; }
          As[ar * 33 + ak] = lo; As[ar * 33 + ak + 1] = hi; }
#pragma unroll
        for (int i = 0; i < 16; ++i) { const int idx = i * NT + c.tid, kk = idx >> 8, cc = idx & 255;
            Bs[idx] = cc < ncv ? W[(size_t)(k0 + kk) * ldw + cc] : 0.f; }
        __syncthreads();
#pragma unroll 8
        for (int kk = 0; kk < 32; ++kk) {
            float av[4], bv[4];
#pragma unroll
            for (int j = 0; j < 4; ++j) av[j] = As[(c.wave * 4 + j) * 33 + kk];
#pragma unroll
            for (int i = 0; i < 4; ++i) bv[i] = Bs[kk * 256 + c.lane + 64 * i];
#pragma unroll
            for (int j = 0; j < 4; ++j)
#pragma unroll
                for (int i = 0; i < 4; ++i) acc[j][i] += av[j] * bv[i];
        }
    }
}

DEVI void nepi_residual(const Ctx& c, int row0, int pn, const float (&acc)[4][4], bool write_xb) {
    float* X = (float*)(c.ws + WS_X); bf16* XB = (bf16*)(c.ws + WS_XB); float* RS = (float*)(c.ws + WS_RS);
#pragma unroll
    for (int j = 0; j < 4; ++j) { const int row = row0 + 4 * c.wave + j; float ss = 0.f;
#pragma unroll
        for (int i = 0; i < 4; ++i) { const int col = pn * 256 + c.lane + 64 * i; const float v = X[(size_t)row * D + col] + acc[j][i];
            X[(size_t)row * D + col] = v; if (write_xb) XB[(size_t)row * D + col] = f2bf(v); ss += v * v; }
        ss = wave_sum(ss);
        if (c.lane < 4) RS[(size_t)row * 16 + pn * 4 + c.lane] = c.lane == 0 ? ss : 0.f; }
}

DEVI void n_even_in(const Ctx& c, const PArgs& a, int li) {
    const int j = li >> 1;
    const bf16* XB = (const bf16*)(c.ws + WS_XB); const float* RS = (const float*)(c.ws + WS_RS); const float* ROPE = (const float*)(c.ws + WS_ROPE);
    bf16* Z = (bf16*)(c.ws + WS_Z);
    const float* W = a.in[I_EWIN] + (size_t)j * D * NIN; const float* gain = a.in[I_NMIX] + (size_t)li * D;
    const int ntn = NIN / 256, nu = (M / 32) * ntn;
    for (int u = c.bid; u < nu; u += c.G) {
        const int pn = u % ntn, row0 = (u / ntn) * 32;
        float acc[4][4];
        ngemm_tile(c, XB, D, W + pn * 256, NIN, 256, D, gain, row0, acc);
#pragma unroll
        for (int jj = 0; jj < 4; ++jj) { const int row = row0 + 4 * c.wave + jj; const float rs = row_rstd(RS, row);
            float v[4];
#pragma unroll
            for (int i = 0; i < 4; ++i) v[i] = acc[jj][i] * rs;
            if (pn < 4) {
                const float cs = ROPE[((size_t)row_pos(row) * 64 + c.lane) * 2], sn = ROPE[((size_t)row_pos(row) * 64 + c.lane) * 2 + 1];
                const float sc = pn >= 2 ? 0.08838834764831845f : 1.f;
                const float a0 = v[0] * cs - v[1] * sn, a1 = v[0] * sn + v[1] * cs, b0 = v[2] * cs - v[3] * sn, b1 = v[2] * sn + v[3] * cs;
                v[0] = a0 * sc; v[1] = a1 * sc; v[2] = b0 * sc; v[3] = b1 * sc;
            } else if (pn >= 8 && pn < 12) {
#pragma unroll
                for (int i = 0; i < 4; ++i) v[i] = siluf_(v[i]);
            } else if (pn >= 16) {
#pragma unroll
                for (int i = 0; i < 4; ++i) v[i] = geluf_(v[i]);
            }
#pragma unroll
            for (int i = 0; i < 4; ++i) Z[(size_t)row * NIN + pn * 256 + c.lane + 64 * i] = f2bf(v[i]); }
    }
}

DEVI void n_ret_unit(const Ctx& c, const PArgs& a, int j, int hd, int row0, int ntok, const float* S0, float* Sout) {
    const bf16* Z = (const bf16*)(c.ws + WS_Z); bf16* MIX = (bf16*)(c.ws + WS_MIX);
    LAS float* qs = (LAS float*)c.lds;
    LAS float* ks = qs + 8 * 128;
    LAS float* vs = ks + 8 * 128;
    LAS float* op = vs + 8 * 256;
    const int e = c.tid & 255, half = c.tid >> 8;
    const float gamma = 1.f - exp2f(-5.f - (float)hd);
    const float* gn = a.in[I_ERGN] + (size_t)j * 1024 + hd * 256;
    float S[64];
    if (S0) { const float* sp = S0 + (size_t)half * 64 * 256 + e;
#pragma unroll
        for (int d8 = 0; d8 < 8; ++d8) { asm volatile("" ::: "memory");
#pragma unroll
            for (int dd = 0; dd < 8; ++dd) S[d8 * 8 + dd] = sp[(size_t)(d8 * 8 + dd) * 256]; }
    } else {
#pragma unroll
        for (int dd = 0; dd < 64; ++dd) S[dd] = 0.f; }
    for (int t0 = 0; t0 < ntok; t0 += 8) {
        __syncthreads();
#pragma unroll
        for (int i = 0; i < 8; ++i) { const int idx = i * NT + c.tid, tt = idx >> 9, cc = idx & 511; const int row = row0 + t0 + tt;
            float v = 0.f;
            if (t0 + tt < ntok) { const int col = cc < 128 ? hd * 128 + cc : (cc < 256 ? 512 + hd * 128 + (cc - 128) : 1024 + hd * 256 + (cc - 256)); v = bf2f(Z[(size_t)row * NIN + col]); }
            if (cc < 128) qs[tt * 128 + cc] = v; else if (cc < 256) ks[tt * 128 + cc - 128] = v; else vs[tt * 256 + cc - 256] = v; }
        __syncthreads();
        for (int tt = 0; tt < 8; ++tt) {
            if (t0 + tt < ntok) {
                const float ve = vs[tt * 256 + e]; float o = 0.f;
#pragma unroll
                for (int dd = 0; dd < 64; ++dd) { S[dd] = gamma * S[dd] + ks[tt * 128 + half * 64 + dd] * ve; o += qs[tt * 128 + half * 64 + dd] * S[dd]; }
                op[(tt * 2 + half) * 256 + e] = o;
            }
        }
        __syncthreads();
        { const int tt = c.wave; const int row = row0 + t0 + tt;
          if (t0 + tt < ntok) {
              float o[4]; float s = 0.f;
#pragma unroll
              for (int i = 0; i < 4; ++i) { const int ee = c.lane + 64 * i; o[i] = op[(tt * 2) * 256 + ee] + op[(tt * 2 + 1) * 256 + ee]; s += o[i]; }
              const float mu = wave_sum(s) * (1.f / 256.f); float q = 0.f;
#pragma unroll
              for (int i = 0; i < 4; ++i) { o[i] -= mu; q += o[i] * o[i]; }
              const float rstd = __builtin_amdgcn_rsqf(wave_sum(q) * (1.f / 256.f) + 1e-6f);
#pragma unroll
              for (int i = 0; i < 4; ++i) { const int ee = c.lane + 64 * i; const float ga = bf2f(Z[(size_t)row * NIN + 2048 + hd * 256 + ee]);
                  MIX[(size_t)row * 2048 + hd * 256 + ee] = f2bf(ga * o[i] * rstd * gn[ee]); }
          } }
    }
    { float* sp = Sout + (size_t)half * 64 * 256 + e;
#pragma unroll
      for (int d8 = 0; d8 < 8; ++d8) { asm volatile("" ::: "memory");
#pragma unroll
          for (int dd = 0; dd < 8; ++dd) sp[(size_t)(d8 * 8 + dd) * 256] = S[d8 * 8 + dd]; } }
    __syncthreads();
}

DEVI void n_lru_unit(const Ctx& c, const PArgs& a, int j, int g, int row0, int ntok, const float* hist  , const float* h0  , float* out_h, float* out_conv) {
    const bf16* Z = (const bf16*)(c.ws + WS_Z); bf16* MIX = (bf16*)(c.ws + WS_MIX);
    LAS float* xcs = (LAS float*)c.lds;
    const int d = c.tid >> 2, p = c.tid & 3, ch = g * 128 + d;
    float wa[32], wx[32];
    { const float* WA = a.in[I_EWA] + ((size_t)(j * 8 + g) * 128 + 32 * p) * 128 + d; const float* WX = a.in[I_EWX] + ((size_t)(j * 8 + g) * 128 + 32 * p) * 128 + d;
#pragma unroll
      for (int cc = 0; cc < 32; ++cc) { wa[cc] = WA[(size_t)cc * 128]; wx[cc] = WX[(size_t)cc * 128]; } }
    const float* CW = a.in[I_ECW] + (size_t)j * 4 * 1024;
    const float cw0 = CW[ch], cw1 = CW[1024 + ch], cw2 = CW[2048 + ch], cw3 = CW[3072 + ch], cb = a.in[I_ECB][(size_t)j * 1024 + ch];
    const float ba = a.in[I_EBA][(size_t)j * 1024 + ch], bx = a.in[I_EBX][(size_t)j * 1024 + ch];
    const float sp = softplusf_(-a.in[I_ELAM][(size_t)j * 1024 + ch]);
    float x1 = hist ? hist[2 * 1024 + ch] : 0.f, x2 = hist ? hist[1024 + ch] : 0.f, x3 = hist ? hist[ch] : 0.f;
    float h = h0 ? h0[ch] : 0.f;
    for (int t = 0; t < ntok; ++t) {
        const int row = row0 + t;
        float xcv = 0.f;
        if (p == 0) { const float xb = bf2f(Z[(size_t)row * NIN + 3072 + ch]); xcv = cb + cw3 * xb + cw2 * x1 + cw1 * x2 + cw0 * x3; x3 = x2; x2 = x1; x1 = xb; xcs[d] = xcv; }
        __syncthreads();
        float sr = 0.f, si = 0.f;
#pragma unroll
        for (int cc = 0; cc < 32; ++cc) { const float xv = xcs[32 * p + cc]; sr += xv * wa[cc]; si += xv * wx[cc]; }
        sr += __shfl_xor(sr, 1); sr += __shfl_xor(sr, 2); si += __shfl_xor(si, 1); si += __shfl_xor(si, 2);
        if (p == 0) {
            const float r = sigmoidf_(sr + ba), ig = sigmoidf_(si + bx);
            const float la = -8.f * r * sp, av = __expf(la), u = sqrtf(-expm1f(2.f * la)) * (ig * xcv);
            h = av * h + u;
            MIX[(size_t)row * 2048 + 1024 + ch] = f2bf(h * bf2f(Z[(size_t)row * NIN + 4096 + ch]));
        }
        __syncthreads();
    }
    if (p == 0) { out_h[ch] = h; out_conv[ch] = x3; out_conv[1024 + ch] = x2; out_conv[2048 + ch] = x1; }
}

DEVI void n_even_mix(const Ctx& c, const PArgs& a, int li) {
    const int j = li >> 1;
    const int NU = 32 + 64 + 512 + 1024;
    for (int u = c.bid; u < NU; u += c.G) {
        if (u < 32 || (u >= 96 && u < 608)) {
            const bool pr = u < 32; const int v = pr ? u : u - 96, b = v >> 2, hd = v & 3;
            const float* S0 = pr ? nullptr : a.in[I_SRET] + ((size_t)(j * BS + b) * 4 + hd) * 128 * 256;
            float* So = pr ? c.out + O_RETP + ((size_t)(j * BP + b) * 4 + hd) * 128 * 256 : c.out + O_RETS + ((size_t)(j * BS + b) * 4 + hd) * 128 * 256;
            n_ret_unit(c, a, j, hd, pr ? b * TP : MP + b, pr ? TP : 1, S0, So);
        } else {
            const bool pr = u < 96; const int v = pr ? u - 32 : u - 608, b = v >> 3, g = v & 7;
            const float* hist = pr ? nullptr : a.in[I_SLCONV] + (size_t)(j * BS + b) * 3 * 1024;
            const float* h0 = pr ? nullptr : a.in[I_SLRU] + (size_t)(j * BS + b) * 1024;
            float* oh = pr ? c.out + O_LRUP + (size_t)(j * BP + b) * 1024 : c.out + O_LRUS + (size_t)(j * BS + b) * 1024;
            float* oc = pr ? c.out + O_LCONVP + (size_t)(j * BP + b) * 3 * 1024 : c.out + O_LCONVS + (size_t)(j * BS + b) * 3 * 1024;
            n_lru_unit(c, a, j, g, pr ? b * TP : MP + b, pr ? TP : 1, hist, h0, oh, oc);
        }
    }
}

DEVI void n_gemm_residual(const Ctx& c, const bf16* A, int lda, const float* W, int K, bool write_xb) {
    const int nu = (M / 32) * 4;
    for (int u = c.bid; u < nu; u += c.G) {
        const int pn = u & 3, row0 = (u >> 2) * 32;
        float acc[4][4];
        ngemm_tile(c, A, lda, W + pn * 256, D, 256, K, nullptr, row0, acc);
        nepi_residual(c, row0, pn, acc, write_xb);
    }
}

DEVI void n_ffn_up(const Ctx& c, const PArgs& a, int li) {
    const bf16* XB = (const bf16*)(c.ws + WS_XB); const float* RS = (const float*)(c.ws + WS_RS); bf16* U = (bf16*)(c.ws + WS_U);
    const float* W = a.in[I_FWUP] + (size_t)li * D * NUP; const float* gain = a.in[I_NFFN] + (size_t)li * D;
    const int ntn = NUP / 256, nu = (M / 32) * ntn;
    for (int u = c.bid; u < nu; u += c.G) {
        const int pn = u % ntn, row0 = (u / ntn) * 32;
        float acc[4][4];
        ngemm_tile(c, XB, D, W + pn * 256, NUP, 256, D, gain, row0, acc);
#pragma unroll
        for (int jj = 0; jj < 4; ++jj) { const int row = row0 + 4 * c.wave + jj; const float rs = row_rstd(RS, row);
#pragma unroll
            for (int i = 0; i < 4; ++i) U[(size_t)row * NUP + pn * 256 + c.lane + 64 * i] = f2bf(acc[jj][i] * rs); }
    }
}

DEVI void n_ffn_act(const Ctx& c, const PArgs& a, int li) {
    const bf16* U = (const bf16*)(c.ws + WS_U); bf16* ACT = (bf16*)(c.ws + WS_ACT);
    const float* CW = a.in[I_FCW] + (size_t)li * 3 * DFF; const float* CB = a.in[I_FCB] + (size_t)li * DFF;
    const size_t total = (size_t)M * DFF;
    for (size_t e = (size_t)c.bid * NT + c.tid; e < total; e += (size_t)c.G * NT) {
        const int row = (int)(e / DFF), col = (int)(e % DFF);
        const float u0 = bf2f(U[(size_t)row * NUP + col]); float u1, u2;
        if (row < MP) { const int b = row / TP, t = row % TP;
            u1 = t >= 1 ? bf2f(U[(size_t)(row - 1) * NUP + col]) : 0.f; u2 = t >= 2 ? bf2f(U[(size_t)(row - 2) * NUP + col]) : 0.f;
            if (t >= TP - 2) c.out[O_FCONVP + ((size_t)(li * BP + b) * 2 + (t - (TP - 2))) * DFF + col] = u0;
        } else { const int b = row - MP; const float* st = a.in[I_SFCONV] + (size_t)(li * BS + b) * 2 * DFF;
            u1 = st[DFF + col]; u2 = st[col];
            float* so = c.out + O_FCONVS + (size_t)(li * BS + b) * 2 * DFF; so[col] = u1; so[DFF + col] = u0; }
        const float cv = CB[col] + CW[2 * DFF + col] * u0 + CW[DFF + col] * u1 + CW[col] * u2;
        ACT[(size_t)row * DFF + col] = f2bf(geluf_(cv) * bf2f(U[(size_t)row * NUP + DFF + col]));
    }
}

DEVI void n_odd_norm(const Ctx& c, const PArgs& a, int li) {
    const int j = li >> 1;
    const bf16* XB = (const bf16*)(c.ws + WS_XB); const float* RS = (const float*)(c.ws + WS_RS); bf16* XM = (bf16*)(c.ws + WS_XMIX);
    const float* gain = a.in[I_NMIX] + (size_t)li * D; const float* mix = a.in[I_OMIX] + (size_t)j * 6 * D;
    const int gw = c.bid * NWAVES + c.wave, NGW = c.G * NWAVES;
    for (int row = gw; row < M; row += NGW) {
        const float rs = row_rstd(RS, row);
        const bool prompt = row < MP; const int b = prompt ? row / TP : row - MP, t = prompt ? row % TP : 0;
        const float rsp = (prompt && t > 0) ? row_rstd(RS, row - 1) : 0.f;
#pragma unroll
        for (int q = 0; q < 4; ++q) { const int col = q * 256 + c.lane * 4;
            const u32x2 xw_ = *(const u32x2*)(XB + (size_t)row * D + col); const f32x4 xv = (f32x4){__uint_as_float(xw_.x << 16), __uint_as_float(xw_.x & 0xffff0000u), __uint_as_float(xw_.y << 16), __uint_as_float(xw_.y & 0xffff0000u)}; const f32x4 gv = *(const f32x4*)(gain + col);
            const f32x4 h = xv * rs * gv; f32x4 hp;
            if (prompt) { if (t > 0) { const u32x2 pw_ = *(const u32x2*)(XB + (size_t)(row - 1) * D + col); hp = (f32x4){__uint_as_float(pw_.x << 16), __uint_as_float(pw_.x & 0xffff0000u), __uint_as_float(pw_.y << 16), __uint_as_float(pw_.y & 0xffff0000u)} * rsp * gv; } else hp = (f32x4){0.f, 0.f, 0.f, 0.f}; }
            else hp = *(const f32x4*)(a.in[I_SSHIFT] + (size_t)(j * BS + b) * D + col);
            const f32x4 xx = hp - h;
#pragma unroll
            for (int n = 0; n < 6; ++n) { const f32x4 mv = *(const f32x4*)(mix + (size_t)n * D + col); const f32x4 o = h + xx * mv;
                u32x2 w; w.x = pk2(o.x, o.y); w.y = pk2(o.z, o.w); *(u32x2*)(XM + ((size_t)n * M + row) * D + col) = w; }
            if (prompt) { if (t == TP - 1) *(f32x4*)(c.out + O_SHIFTP + (size_t)(j * BP + b) * D + col) = h; }
            else *(f32x4*)(c.out + O_SHIFTS + (size_t)(j * BS + b) * D + col) = h; }
    }
}

DEVI void n_odd_in(const Ctx& c, const PArgs& a, int li) {
    const int j = li >> 1;
    const bf16* XM = (const bf16*)(c.ws + WS_XMIX);
    bf16* R = (bf16*)(c.ws + WS_R); bf16* Kb = (bf16*)(c.ws + WS_K); bf16* Vb = j == 0 ? (bf16*)((unsigned char*)c.out + DO_VFIRST) : (bf16*)(c.ws + WS_V);
    bf16* LM = (bf16*)((unsigned char*)c.out + DO_LMID);
    const int nu = (M / 32) * 16;
    for (int u = c.bid; u < nu; u += c.G) {
        const int pn = u & 15, row0 = (u >> 4) * 32;
        if (pn == 13 && j == 0) continue;
        const bf16* A; const float* W; int ldw, ncv;
        if (pn < 4) { A = XM + (size_t)0 * M * D; W = a.in[I_OWR] + (size_t)j * D * D + pn * 256; ldw = D; ncv = 256; }
        else if (pn < 8) { A = XM + (size_t)2 * M * D; W = a.in[I_OWK] + (size_t)j * D * D + (pn - 4) * 256; ldw = D; ncv = 256; }
        else if (pn < 12) { A = XM + (size_t)3 * M * D; W = a.in[I_OWV] + (size_t)j * D * D + (pn - 8) * 256; ldw = D; ncv = 256; }
        else if (pn == 12) { A = XM + (size_t)5 * M * D; W = a.in[I_OG1] + (size_t)j * D * 128; ldw = 128; ncv = 128; }
        else if (pn == 13) { A = XM + (size_t)3 * M * D; W = a.in[I_OV1]; ldw = 32; ncv = 32; }
        else if (pn == 14) { A = XM + (size_t)1 * M * D; W = a.in[I_OW1] + (size_t)j * D * 64; ldw = 64; ncv = 64; }
        else { A = XM + (size_t)4 * M * D; W = a.in[I_OA1] + (size_t)j * D * 64; ldw = 64; ncv = 64; }
        float acc[4][4];
        ngemm_tile(c, A, D, W, ldw, ncv, D, nullptr, row0, acc);
#pragma unroll
        for (int jj = 0; jj < 4; ++jj) { const int row = row0 + 4 * c.wave + jj;
#pragma unroll
            for (int i = 0; i < 4; ++i) { const int cl = c.lane + 64 * i; const float v = acc[jj][i];
                if (pn < 4) R[(size_t)row * D + pn * 256 + cl] = f2bf(v);
                else if (pn < 8) Kb[(size_t)row * D + (pn - 4) * 256 + cl] = f2bf(v);
                else if (pn < 12) Vb[(size_t)row * D + (pn - 8) * 256 + cl] = f2bf(v);
                else if (pn == 12) { if (cl < 128) LM[(size_t)row * LML + cl] = f2bf(sigmoidf_(v)); }
                else if (pn == 13) { if (cl < 128) LM[(size_t)row * LML + 128 + cl] = f2bf(v); }
                else if (pn == 14) { if (cl < 128) LM[(size_t)row * LML + 256 + cl] = f2bf(tanhf_(v)); }
                else LM[(size_t)row * LML + 384 + cl] = f2bf(v); } }
    }
}

DEVI void n_odd_lora(const Ctx& c, const PArgs& a, int li) {
    const int j = li >> 1;
    const bf16* LM = (const bf16*)((unsigned char*)c.out + DO_LMID);
    float* WD = (float*)(c.ws + WS_WDEC); bf16* AG = (bf16*)(c.ws + WS_AG); bf16* VG = (bf16*)(c.ws + WS_VG); bf16* GG = (bf16*)(c.ws + WS_GG);
    const int nu = (M / 32) * 16;
    for (int u = c.bid; u < nu; u += c.G) {
        const int pn = u & 15, grp = pn >> 2, pc = pn & 3, row0 = (u >> 4) * 32;
        if (grp == 2 && j == 0) continue;
        const bf16* A; const float* W; int K;
        if (grp == 0) { A = LM + 256; W = a.in[I_OW2] + (size_t)j * 64 * D; K = 64; }
        else if (grp == 1) { A = LM + 384; W = a.in[I_OA2] + (size_t)j * 64 * D; K = 64; }
        else if (grp == 2) { A = LM + 128; W = a.in[I_OV2]; K = 32; }
        else { A = LM; W = a.in[I_OG2] + (size_t)j * 128 * D; K = 128; }
        float acc[4][4];
        ngemm_tile(c, A, LML, W + pc * 256, D, 256, K, nullptr, row0, acc);
#pragma unroll
        for (int jj = 0; jj < 4; ++jj) { const int row = row0 + 4 * c.wave + jj;
#pragma unroll
            for (int i = 0; i < 4; ++i) { const int col = pc * 256 + c.lane + 64 * i; const float v = acc[jj][i];
                if (grp == 0) { const float wl = -softplusf_(-(a.in[I_OW0][(size_t)j * D + col] + v)) - 0.5f; WD[(size_t)row * D + col] = __expf(-__expf(wl)); }
                else if (grp == 1) AG[(size_t)row * D + col] = f2bf(sigmoidf_(a.in[I_OA0][(size_t)j * D + col] + v));
                else if (grp == 2) VG[(size_t)row * D + col] = f2bf(sigmoidf_(a.in[I_OV0][col] + v));
                else GG[(size_t)row * D + col] = f2bf(v); } }
    }
}

DEVI void n_rwkv_unit(const Ctx& c, const PArgs& a, int j, int hd, int row0, int ntok, const float* S0, float* Sout) {
    const bf16* R = (const bf16*)(c.ws + WS_R); const bf16* Kb = (const bf16*)(c.ws + WS_K);
    const bf16* VF = (const bf16*)((unsigned char*)c.out + DO_VFIRST); const bf16* Vb = j == 0 ? VF : (const bf16*)(c.ws + WS_V);
    const float* WD = (const float*)(c.ws + WS_WDEC); const bf16* AG = (const bf16*)(c.ws + WS_AG); const bf16* VG = (const bf16*)(c.ws + WS_VG); const bf16* GG = (const bf16*)(c.ws + WS_GG);
    bf16* O = (bf16*)(c.ws + WS_O);
    LAS float* rs_ = (LAS float*)c.lds;
    LAS float* ws_ = rs_ + 512; LAS float* ks_ = ws_ + 512; LAS float* vs_ = ks_ + 512; LAS float* as_ = vs_ + 512; LAS float* bs_ = as_ + 512; LAS float* ys_ = bs_ + 512; LAS float* bon = ys_ + 512;
    const int i = c.tid >> 3, q = c.tid & 7;
    const int st = c.wave, sc = c.lane, ch = hd * 64 + sc;
    const float kkc = a.in[I_OKK][(size_t)j * D + ch], kac = a.in[I_OKA][(size_t)j * D + ch], rkc = a.in[I_ORK][(size_t)j * D + ch];
    const float gng = a.in[I_OGNG][(size_t)j * D + ch], gnb = a.in[I_OGNB][(size_t)j * D + ch];
    float s[8];
#pragma unroll
    for (int jj = 0; jj < 8; ++jj) s[jj] = 0.f;
    if (S0) {
#pragma unroll
        for (int jj = 0; jj < 8; ++jj) s[jj] = S0[(size_t)i * 64 + 8 * q + jj]; }
    for (int t0 = 0; t0 < ntok; t0 += 8) {
        __syncthreads();
        const int row = row0 + t0 + st; const bool valid = t0 + st < ntok;
        float gg = 0.f;
        { float r = 0.f, k = 0.f, v = 0.f, w = 1.f, ag = 0.f;
          if (valid) { const size_t o = (size_t)row * D + ch; r = bf2f(R[o]); k = bf2f(Kb[o]); v = bf2f(Vb[o]); w = WD[o]; ag = bf2f(AG[o]); gg = bf2f(GG[o]);
              if (j == 1) { const float vf = bf2f(VF[o]); v = v + (vf - v) * bf2f(VG[o]); } }
          float kk = k * kkc; const float ss = wave_sum(kk * kk); kk = kk / sqrtf(fmaxf(ss, 1e-24f));
          const float km = k * (1.f + (ag - 1.f) * kac);
          const float bsum = wave_sum(r * km * rkc);
          rs_[st * 64 + sc] = r; ws_[st * 64 + sc] = w; ks_[st * 64 + sc] = km; vs_[st * 64 + sc] = v; as_[st * 64 + sc] = -kk; bs_[st * 64 + sc] = kk * ag;
          if (sc == 0) bon[st] = bsum; }
        __syncthreads();
        for (int tt = 0; tt < 8; ++tt) {
            if (t0 + tt < ntok) {
                float sa = 0.f;
#pragma unroll
                for (int jj = 0; jj < 8; ++jj) sa += s[jj] * as_[tt * 64 + 8 * q + jj];
                sa += __shfl_xor(sa, 1); sa += __shfl_xor(sa, 2); sa += __shfl_xor(sa, 4);
                const float vi = vs_[tt * 64 + i]; float y = 0.f;
#pragma unroll
                for (int jj = 0; jj < 8; ++jj) { const int cj = tt * 64 + 8 * q + jj; s[jj] = s[jj] * ws_[cj] + sa * bs_[cj] + vi * ks_[cj]; y += s[jj] * rs_[cj]; }
                y += __shfl_xor(y, 1); y += __shfl_xor(y, 2); y += __shfl_xor(y, 4);
                if (q == 0) ys_[tt * 64 + i] = y;
            }
        }
        __syncthreads();
        if (valid) {
            const float y = ys_[st * 64 + sc];
            const float mu = wave_sum(y) * (1.f / 64.f); const float dy = y - mu; const float var = wave_sum(dy * dy) * (1.f / 64.f);
            float o = dy / sqrtf(var + 64e-5f) * gng + gnb;
            o = (o + bon[st] * vs_[st * 64 + sc]) * gg;
            O[(size_t)row * D + ch] = f2bf(o);
        }
    }
#pragma unroll
    for (int jj = 0; jj < 8; ++jj) Sout[(size_t)i * 64 + 8 * q + jj] = s[jj];
    __syncthreads();
}
DEVI void n_odd_scan(const Ctx& c, const PArgs& a, int li) {
    const int j = li >> 1;
    const int NU = 128 + 2048;
    for (int u = c.bid; u < NU; u += c.G) {
        const bool pr = u < 128; const int v = pr ? u : u - 128, b = v >> 4, hd = v & 15;
        const float* S0 = pr ? nullptr : a.in[I_SRWKV] + ((size_t)(j * BS + b) * 16 + hd) * 4096;
        float* So = pr ? c.out + O_RWKVP + ((size_t)(j * BP + b) * 16 + hd) * 4096 : c.out + O_RWKVS + ((size_t)(j * BS + b) * 16 + hd) * 4096;
        n_rwkv_unit(c, a, j, hd, pr ? b * TP : MP + b, pr ? TP : 1, S0, So);
    }
}

DEVI void n_final(const Ctx& c, const PArgs& a) {
    const bf16* XB = (const bf16*)(c.ws + WS_XB); const float* RS = (const float*)(c.ws + WS_RS); const float* gain = a.in[I_NFIN];
    const int gw = c.bid * NWAVES + c.wave, NGW = c.G * NWAVES;
    for (int row = gw; row < M; row += NGW) {
        float* dst;
        if (row < MP) { const int b = row / TP, t = row % TP; if (t < NMETA) continue; dst = c.out + O_YP + ((size_t)b * SEQ + (t - NMETA)) * D; }
        else dst = c.out + O_YS + (size_t)(row - MP) * D;
        const float rs = row_rstd(RS, row);
#pragma unroll
        for (int q = 0; q < 4; ++q) { const int col = q * 256 + c.lane * 4;
            const u32x2 xw_ = *(const u32x2*)(XB + (size_t)row * D + col); const f32x4 yv_ = (f32x4){__uint_as_float(xw_.x << 16), __uint_as_float(xw_.x & 0xffff0000u), __uint_as_float(xw_.y << 16), __uint_as_float(xw_.y & 0xffff0000u)} * rs * *(const f32x4*)(gain + col); __builtin_nontemporal_store(yv_, (f32x4*)(dst + col)); }
    }
}

namespace pg8 {
typedef short bf16x8 __attribute__((ext_vector_type(8)));
constexpr int BM = 256, BK = 64, HALF = 128, HTB = HALF * BK * 2, STAGE_BYTES = 8 * HTB, NXCD = 8, WGM = 8;
__host__ __device__ __forceinline__ int lds_byte(int r, int c) { const int st = (r >> 4) * 2 + (c >> 5), rr = r & 15, cc = c & 31, ob = rr * 64 + cc * 2; return st * 1024 + (ob ^ (((ob >> 9) & 1) << 5)); }
__host__ __device__ __forceinline__ void stage_rc(int b, int& R, int& C) { const int st = b / 1024, sb = b % 1024, swz = sb ^ (((sb >> 9) & 1) << 5); R = (st >> 1) * 16 + swz / 64; C = (st & 1) * 32 + (swz % 64) / 2; }
__host__ __device__ __forceinline__ int perm32(int rho) { const int n = rho >> 4, i = rho & 15; return 8 * (i >> 2) + 4 * n + (i & 3); }
struct Unit { int pm, pn; };
struct Gemm { const bf16* A; const bf16* Bt; int M, N, K, lda; unsigned long long asel; size_t astride; };
struct StaticOrder {
    int nM, nN, nwg, G, c;
    __device__ __forceinline__ void init(int M_, int N_, int G_, int c_) { nM = M_ / BM; nN = N_ / BM; nwg = nM * nN; G = G_; c = c_; }
    __device__ __forceinline__ bool next(int i, Unit& u) const {
        const long L = (long)i * G + c; if (L >= nwg) return false;
        int wgid = (int)L; { const int q = nwg / NXCD, r = nwg % NXCD, xcd = wgid % NXCD, off = wgid / NXCD; wgid = (xcd < r ? xcd * (q + 1) : r * (q + 1) + (xcd - r) * q) + off; }
        const int nig = WGM * nN, gid = wgid / nig, fm = gid * WGM, gsz = (nM - fm) < WGM ? (nM - fm) : WGM;
        u.pm = fm + ((wgid % nig) % gsz); u.pn = (wgid % nig) / gsz; return true;
    }
};
DEVI unsigned cvt_pk_bf16(float lo, float hi) { return pk2(lo, hi); }

template <class Epi>
DEVI void gemm_phase(LAS unsigned char* lds, const int tid, const Gemm g, const StaticOrder& S, const Epi& E) {
    const int wid = __builtin_amdgcn_readfirstlane(tid >> 6), lane = tid & 63, wr = wid >> 2, wc = wid & 3, fr = lane & 15, fq = lane >> 4;
    const int K = g.K, nt = K / BK, lda = g.lda;
    unsigned voffA[2], voffB[2];
#pragma unroll
    for (int i = 0; i < 2; ++i) { int R, C; stage_rc(tid * 16 + i * 8192, R, C); const int Rb = Epi::PERM ? ((R & ~31) + perm32(R & 31)) : R;
        voffA[i] = (unsigned)(R * lda + C) * 2u; voffB[i] = (unsigned)(Rb * K + C) * 2u; }
    const size_t kstep = (size_t)(BK * 2);
    const size_t hstepA = (size_t)HALF * lda * 2, hstepB = (size_t)HALF * K * 2;
    const size_t tstepA = 2 * hstepA, tstepB = 2 * hstepB;
    const unsigned ldsw = (unsigned)wid * 1024u;
    const int aoff = lds_byte(wr * 64 + fr, fq * 8), boff = lds_byte(wc * 32 + fr, fq * 8);
#define PG8_SA(b, h) (((b) * 2 + (h)) * HTB)
#define PG8_SB(b, h) ((4 + (b) * 2 + (h)) * HTB)
#define PG8_STAGE(bufoff, gbase, voff) do { _Pragma("unroll") for (int _i = 0; _i < 2; ++_i) \
        __builtin_amdgcn_global_load_lds((const unsigned*)((const char*)(gbase) + (voff)[_i]), (LAS unsigned*)(lds + (bufoff) + ldsw + _i * 8192), 16, 0, 0); } while (0)
#define PG8_LDA(dst, b, h) do { _Pragma("unroll") for (int m = 0; m < 4; ++m) _Pragma("unroll") for (int k = 0; k < 2; ++k) dst[m][k] = *(const LAS bf16x8*)(lds + PG8_SA(b, h) + aoff + m * 2048 + k * 1024); } while (0)
#define PG8_LDB(dst, b, h) do { _Pragma("unroll") for (int n = 0; n < 2; ++n) _Pragma("unroll") for (int k = 0; k < 2; ++k) dst[n][k] = *(const LAS bf16x8*)(lds + PG8_SB(b, h) + boff + n * 2048 + k * 1024); } while (0)
#define PG8_MMA(ai, bj, At, Bt) do { __builtin_amdgcn_s_setprio(1); _Pragma("unroll") for (int m = 0; m < 4; ++m) _Pragma("unroll") for (int n = 0; n < 2; ++n) _Pragma("unroll") for (int k = 0; k < 2; ++k) \
        acc[ai][bj][m][n] = __builtin_amdgcn_mfma_f32_16x16x32_bf16(Bt[n][k], At[m][k], acc[ai][bj][m][n], 0, 0, 0); __builtin_amdgcn_s_setprio(0); } while (0)
#define PG8_WAIT_V(n) asm volatile("s_waitcnt vmcnt(" #n ")" ::: "memory")
#define PG8_WAIT_L(n) asm volatile("s_waitcnt lgkmcnt(" #n ")" ::: "memory")
#define PG8_BAR __builtin_amdgcn_s_barrier()
#define PG8_SCHED __builtin_amdgcn_sched_barrier(0)
#define PG8_ABASE(u) ((const char*)(g.A + (size_t)((g.asel >> (4 * (u).pn)) & 15ull) * g.astride) + (size_t)(u).pm * tstepA)
    Unit cur, nxt; int ui = 0;
    if (!S.next(0, cur)) return;
    f32x4 acc[2][2][4][2];
#pragma unroll
    for (int a = 0; a < 2; ++a)
#pragma unroll
        for (int b = 0; b < 2; ++b)
#pragma unroll
            for (int m = 0; m < 4; ++m)
#pragma unroll
                for (int n = 0; n < 2; ++n) acc[a][b][m][n] = (f32x4){0.f, 0.f, 0.f, 0.f};
    bf16x8 At[4][2], B0[2][2], B1[2][2];
    const char* cA = PG8_ABASE(cur); const char* cB = (const char*)g.Bt + (size_t)cur.pn * tstepB;
    PG8_STAGE(PG8_SB(0, 0), cB, voffB); PG8_STAGE(PG8_SB(0, 1), cB + hstepB, voffB); PG8_STAGE(PG8_SA(0, 0), cA, voffA); PG8_STAGE(PG8_SA(0, 1), cA + hstepA, voffA);
    if (wr == 1) PG8_BAR;
    PG8_WAIT_V(2); PG8_BAR;
    PG8_STAGE(PG8_SB(1, 0), cB + kstep, voffB); PG8_STAGE(PG8_SA(1, 0), cA + kstep, voffA); PG8_STAGE(PG8_SB(1, 1), cB + hstepB + kstep, voffB);
    PG8_WAIT_V(6); PG8_BAR;
    for (;;) {
        const bool has_next = S.next(ui + 1, nxt);
        const char* nA = has_next ? PG8_ABASE(nxt) : cA; const char* nB = has_next ? (const char*)g.Bt + (size_t)nxt.pn * tstepB : cB;
        for (int t = 0; t < nt; t += 2) {
            const bool last = (t == nt - 2);
            const char* a1 = cA + (size_t)(t + 1) * kstep;
            const char* a2 = last ? nA : cA + (size_t)(t + 2) * kstep; const char* b2 = last ? nB : cB + (size_t)(t + 2) * kstep;
            const char* a3 = a2 + kstep; const char* b3 = b2 + kstep;
            PG8_LDB(B0, 0, 0); PG8_LDB(B1, 0, 1); PG8_SCHED; PG8_LDA(At, 0, 0); PG8_STAGE(PG8_SA(1, 1), a1 + hstepA, voffA);
            PG8_WAIT_V(8); PG8_WAIT_L(0); PG8_BAR; PG8_MMA(0, 0, At, B0); PG8_MMA(0, 1, At, B1); PG8_BAR; PG8_SCHED;
            PG8_LDA(At, 0, 1); PG8_STAGE(PG8_SB(0, 0), b2, voffB); PG8_STAGE(PG8_SB(0, 1), b2 + hstepB, voffB); PG8_STAGE(PG8_SA(0, 0), a2, voffA);
            PG8_WAIT_V(8); PG8_WAIT_L(0); PG8_BAR; PG8_MMA(1, 0, At, B0); PG8_MMA(1, 1, At, B1); PG8_BAR; PG8_SCHED;
            PG8_LDB(B0, 1, 0); PG8_LDB(B1, 1, 1); PG8_SCHED; PG8_LDA(At, 1, 0); PG8_STAGE(PG8_SA(0, 1), a2 + hstepA, voffA);
            PG8_WAIT_V(8); PG8_WAIT_L(0); PG8_BAR; PG8_MMA(0, 0, At, B0); PG8_MMA(0, 1, At, B1); PG8_BAR; PG8_SCHED;
            PG8_LDA(At, 1, 1); PG8_STAGE(PG8_SB(1, 0), b3, voffB); PG8_STAGE(PG8_SB(1, 1), b3 + hstepB, voffB); PG8_STAGE(PG8_SA(1, 0), a3, voffA);
            PG8_WAIT_V(8); PG8_WAIT_L(0); PG8_BAR; PG8_MMA(1, 0, At, B0); PG8_MMA(1, 1, At, B1); PG8_BAR; PG8_SCHED;
        }
        if (wr == 0) PG8_BAR;
        E(acc, cur, wr, wc, fr, fq);
        if (!has_next) break;
#pragma unroll
        for (int a = 0; a < 2; ++a)
#pragma unroll
            for (int b = 0; b < 2; ++b)
#pragma unroll
                for (int m = 0; m < 4; ++m)
#pragma unroll
                    for (int n = 0; n < 2; ++n) acc[a][b][m][n] = (f32x4){0.f, 0.f, 0.f, 0.f};
        cur = nxt; cA = nA; cB = nB; ++ui;
        if (wr == 1) PG8_BAR;
    }
    PG8_WAIT_V(0);
    PG8_BAR;
#undef PG8_SA
#undef PG8_SB
#undef PG8_STAGE
#undef PG8_LDA
#undef PG8_LDB
#undef PG8_MMA
#undef PG8_WAIT_V
#undef PG8_WAIT_L
#undef PG8_BAR
#undef PG8_SCHED
#undef PG8_ABASE
}
}

constexpr size_t WB_WIN = 0, WB_WOUT = 20 * MiB, WB_G5 = 28 * MiB, WB_G6 = 44 * MiB, WB_WO = 48 * MiB, WB_WUP = 52 * MiB, WB_WDN = 96 * MiB;
constexpr size_t SZ_WIN = 10 * MiB, SZ_WOUT = 4 * MiB, SZ_G5 = 8 * MiB, SZ_G6 = 2 * MiB, SZ_WO = 2 * MiB, SZ_WUP = 11 * MiB, SZ_WDN = (size_t)D * DFF * 2;
static_assert(WB_WDN + 4 * SZ_WDN <= 119 * MiB, "weight map");

struct WDesc { const float* W; const float* gain; bf16* dst; int ldw, Kv, Kd, Nv, Nd, map; };
DEVI WDesc wdesc(const PArgs& a, unsigned char* ws, int id) {
    WDesc w; w.gain = nullptr; w.map = 0; unsigned char* wb = ws + WS_WB;
    if (id < 2) { const int j = id; w.W = a.in[I_EWIN] + (size_t)j * D * NIN; w.ldw = NIN; w.Kv = w.Kd = D; w.Nv = w.Nd = NIN; w.gain = a.in[I_NMIX] + (size_t)(2 * j) * D; w.dst = (bf16*)(wb + WB_WIN + j * SZ_WIN); w.map = 1; }
    else if (id < 4) { const int j = id - 2; w.W = a.in[I_EWOUT] + (size_t)j * 2048 * D; w.ldw = D; w.Kv = w.Kd = 2048; w.Nv = w.Nd = D; w.dst = (bf16*)(wb + WB_WOUT + j * SZ_WOUT); }
    else if (id < 18) { const int q = id - 4, j = q / 7, p = q % 7; bf16* base = (bf16*)(wb + WB_G5 + j * SZ_G5); w.Kv = w.Kd = D;
        if (p < 3) { w.W = a.in[p == 0 ? I_OWR : (p == 1 ? I_OWK : I_OWV)] + (size_t)j * D * D; w.ldw = D; w.Nv = w.Nd = D; w.dst = base + (size_t)p * 1024 * D; }
        else if (p == 3) { w.W = a.in[I_OG1] + (size_t)j * D * 128; w.ldw = 128; w.Nv = 128; w.Nd = 256; w.dst = base + (size_t)3072 * D; }
        else if (p == 4) { w.W = a.in[I_OW1] + (size_t)j * D * 64; w.ldw = 64; w.Nv = 64; w.Nd = 256; w.dst = base + (size_t)3328 * D; }
        else if (p == 5) { w.W = a.in[I_OA1] + (size_t)j * D * 64; w.ldw = 64; w.Nv = 64; w.Nd = 256; w.dst = base + (size_t)3584 * D; }
        else { w.W = a.in[I_OV1]; w.ldw = 32; w.Nv = 32; w.Nd = j == 1 ? 256 : 0; w.dst = base + (size_t)3840 * D; } }
    else if (id < 26) { const int q = id - 18, j = q >> 2, p = q & 3; bf16* base = (bf16*)(wb + WB_G6 + j * SZ_G6); w.Kd = 256; w.ldw = D; w.Nv = w.Nd = D; w.dst = base + (size_t)p * 1024 * 256;
        if (p == 0) { w.W = a.in[I_OW2] + (size_t)j * 64 * D; w.Kv = 64; }
        else if (p == 1) { w.W = a.in[I_OA2] + (size_t)j * 64 * D; w.Kv = 64; }
        else if (p == 2) { w.W = a.in[I_OG2] + (size_t)j * 128 * D; w.Kv = 128; }
        else { w.W = a.in[I_OV2]; w.Kv = 32; if (j == 0) w.Nd = 0; } }
    else if (id < 28) { const int j = id - 26; w.W = a.in[I_OWO] + (size_t)j * D * D; w.ldw = D; w.Kv = w.Kd = D; w.Nv = w.Nd = D; w.dst = (bf16*)(wb + WB_WO + j * SZ_WO); }
    else if (id < 32) { const int li = id - 28; w.W = a.in[I_FWUP] + (size_t)li * D * NUP; w.ldw = NUP; w.Kv = w.Kd = D; w.Nv = w.Nd = NUP; w.gain = a.in[I_NFFN] + (size_t)li * D; w.dst = (bf16*)(wb + WB_WUP + li * SZ_WUP); w.map = FUSE_ACT ? 2 : 0; }
    else { const int li = id - 32; w.W = a.in[I_FWDN] + (size_t)li * DFF * D; w.ldw = D; w.Kv = w.Kd = DFF; w.Nv = w.Nd = D; w.dst = (bf16*)(wb + WB_WDN + li * SZ_WDN); }
    return w;
}
constexpr int N_WDESC = 36;
DEVI void wprep_item(const WDesc& w, LAS float* scr, int item, int lane) {
    const int nblk = w.Nd / 32, kb = item / nblk, nb = item % nblk, k0 = 64 * kb, n0 = 32 * nb;
    int sc0 = n0;
    if (w.map == 1 && n0 < 1024) { const int t = n0 >> 8, cp = n0 & 255; sc0 = 256 * t + ((cp & 127) >> 6) * 128 + (cp >> 7) * 64 + (cp & 63); }
    if (w.map == 2) { const int t = n0 >> 8, cp = n0 & 255; sc0 = cp < 128 ? 128 * t + cp : DFF + 128 * t + (cp - 128); }
    const bool nvalid = n0 < w.Nv;
#pragma unroll
    for (int i = 0; i < 8; ++i) { const int kk = 8 * i + (lane >> 3), k = k0 + kk; f32x4 v = (f32x4){0.f, 0.f, 0.f, 0.f};
        if (nvalid && k < w.Kv) { v = __builtin_nontemporal_load((const f32x4*)(w.W + (size_t)k * w.ldw + sc0 + 4 * (lane & 7))); if (w.gain) v = v * w.gain[k]; }
        LAS float* d = scr + kk * 33 + 4 * (lane & 7); d[0] = v.x; d[1] = v.y; d[2] = v.z; d[3] = v.w; }
    asm volatile("s_waitcnt lgkmcnt(0)" ::: "memory");
    const int cc = lane & 7;
#pragma unroll
    for (int jx = 0; jx < 4; ++jx) { const int n = (lane >> 3) + 8 * jx; const LAS float* s = scr + (8 * cc) * 33 + n;
        u32x4 o; o.x = pk2(s[0 * 33], s[1 * 33]); o.y = pk2(s[2 * 33], s[3 * 33]); o.z = pk2(s[4 * 33], s[5 * 33]); o.w = pk2(s[6 * 33], s[7 * 33]);
        *(u32x4*)(w.dst + (size_t)(n0 + n) * w.Kd + k0 + 8 * cc) = o; }
    asm volatile("s_waitcnt lgkmcnt(0)" ::: "memory");
}
DEVI void f_wprep(const Ctx& c, const PArgs& a, unsigned long long idmask, int gw, int NGW) {
    LAS float* scr = (LAS float*)(c.lds + c.wave * 16384);
#pragma unroll 1
    for (int id = 0; id < N_WDESC; ++id) {
        if (!((idmask >> id) & 1ull)) continue;
        const WDesc w = wdesc(a, c.ws, id);
        const int nitems = (w.Kd / 64) * (w.Nd / 32);
        const int start = (gw + id * 601) % NGW;
        for (int it = start; it < nitems; it += NGW) wprep_item(w, scr, it, c.lane);
    }
}
constexpr unsigned long long WM_L01 = (1ull << 1) | (1ull << 2) | (0x7full << 4) | (0xfull << 18) | (1ull << 26) | (3ull << 28) | (3ull << 32);
constexpr unsigned long long WM_L23 = (1ull << 3) | (0x7full << 11) | (0xfull << 22) | (1ull << 27) | (3ull << 30) | (3ull << 34);
static_assert((WM_L01 | WM_L23 | 1ull) == (1ull << 36) - 1 && (WM_L01 & WM_L23) == 0, "weight masks");

DEVI u32x4 pack8(const f32x4 a, const f32x4 b) { u32x4 w; w.x = pg8::cvt_pk_bf16(a[0], a[1]); w.y = pg8::cvt_pk_bf16(a[2], a[3]); w.z = pg8::cvt_pk_bf16(b[0], b[1]); w.w = pg8::cvt_pk_bf16(b[2], b[3]); return w; }
DEVI f32x4 map4(const f32x4 v, int act) {
    f32x4 o;
#pragma unroll
    for (int e = 0; e < 4; ++e) o[e] = act == 1 ? siluf_(v[e]) : act == 2 ? geluf_(v[e]) : act == 3 ? sigmoidf_(v[e]) : act == 4 ? tanhf_(v[e]) : v[e];
    return o;
}
struct EpiEvenIn {
    static constexpr bool PERM = true;
    bf16* Z; const float* RS; const float* ROPE;
    DEVI void operator()(const f32x4 (&acc)[2][2][4][2], const pg8::Unit& u, int wr, int wc, int fr, int fq) const {
        const int pn = u.pn;
        float rsv[2][4];
        { f32x4 rq[2][4];
#pragma unroll
          for (int ai = 0; ai < 2; ++ai)
#pragma unroll
            for (int m = 0; m < 4; ++m) rq[ai][m] = *(const f32x4*)(RS + (size_t)(u.pm * 256 + ai * 128 + wr * 64 + m * 16 + fr) * 16 + 4 * fq);
          asm volatile("" ::: "memory");
#pragma unroll
          for (int ai = 0; ai < 2; ++ai)
#pragma unroll
            for (int m = 0; m < 4; ++m) rsv[ai][m] = row_rstd_fin(rq[ai][m]); }
#pragma unroll
        for (int ai = 0; ai < 2; ++ai)
#pragma unroll
            for (int m = 0; m < 4; ++m) {
                const int row = u.pm * 256 + ai * 128 + wr * 64 + m * 16 + fr; const float rs = rsv[ai][m];
                if (pn < 4) {
                    const int hl = wc >> 1, d0 = (32 * wc + 8 * fq) & 63; const float sc = (pn >= 2 ? 0.08838834764831845f : 1.f) * rs;
                    const f32x4* rp = (const f32x4*)(ROPE + ((size_t)row_pos(row) * 64 + d0) * 2);
                    const f32x4 c0 = rp[0], c1 = rp[1], c2 = rp[2], c3 = rp[3];
                    const f32x4 x1a = acc[ai][0][m][0] * sc, x1b = acc[ai][0][m][1] * sc, x2a = acc[ai][1][m][0] * sc, x2b = acc[ai][1][m][1] * sc;
                    const f32x4 csa = (f32x4){c0[0], c0[2], c1[0], c1[2]}, sna = (f32x4){c0[1], c0[3], c1[1], c1[3]}, csb = (f32x4){c2[0], c2[2], c3[0], c3[2]}, snb = (f32x4){c2[1], c2[3], c3[1], c3[3]};
                    const f32x4 y1a = x1a * csa - x2a * sna, y1b = x1b * csb - x2b * snb, y2a = x1a * sna + x2a * csa, y2b = x1b * snb + x2b * csb;
                    bf16* dst = Z + (size_t)row * NIN + pn * 256 + hl * 128 + d0;
                    *(u32x4*)dst = pack8(y1a, y1b); *(u32x4*)(dst + 64) = pack8(y2a, y2b);
                } else {
                    const int act = (pn >= 8 && pn < 12) ? 1 : (pn >= 16 ? 2 : 0);
#pragma unroll
                    for (int bj = 0; bj < 2; ++bj) { bf16* dst = Z + (size_t)row * NIN + pn * 256 + bj * 128 + wc * 32 + fq * 8;
                        *(u32x4*)dst = pack8(map4(acc[ai][bj][m][0] * rs, act), map4(acc[ai][bj][m][1] * rs, act)); }
                }
            }
    }
};
struct EpiResidual {
    static constexpr bool PERM = false;
    bf16* XB; float* RS;
    DEVI void operator()(const f32x4 (&acc)[2][2][4][2], const pg8::Unit& u, int wr, int wc, int fr, int fq) const {
#pragma unroll
        for (int ai = 0; ai < 2; ++ai) {
            u32x2 xo[4][2][2];
#pragma unroll
            for (int m = 0; m < 4; ++m)
#pragma unroll
                for (int bj = 0; bj < 2; ++bj)
#pragma unroll
                    for (int n = 0; n < 2; ++n) xo[m][bj][n] = *(const u32x2*)(XB + (size_t)(u.pm * 256 + ai * 128 + wr * 64 + m * 16 + fr) * D + u.pn * 256 + bj * 128 + wc * 32 + n * 16 + fq * 4);
            asm volatile("" ::: "memory");
#pragma unroll
            for (int m = 0; m < 4; ++m) {
                const int row = u.pm * 256 + ai * 128 + wr * 64 + m * 16 + fr; float ss = 0.f;
#pragma unroll
                for (int bj = 0; bj < 2; ++bj)
#pragma unroll
                    for (int n = 0; n < 2; ++n) { const size_t o = (size_t)row * D + u.pn * 256 + bj * 128 + wc * 32 + n * 16 + fq * 4;
                        const u32x2 x_ = xo[m][bj][n];
                        f32x4 v = acc[ai][bj][m][n]; v[0] += __uint_as_float(x_.x << 16); v[1] += __uint_as_float(x_.x & 0xffff0000u); v[2] += __uint_as_float(x_.y << 16); v[3] += __uint_as_float(x_.y & 0xffff0000u);
                        u32x2 w; w.x = pk2(v[0], v[1]); w.y = pk2(v[2], v[3]); *(u32x2*)(XB + o) = w;
                        ss += (v[0] * v[0] + v[1] * v[1]) + (v[2] * v[2] + v[3] * v[3]); }
                ss += __shfl_xor(ss, 16); ss += __shfl_xor(ss, 32);
                if (fq == 0) RS[(size_t)row * 16 + u.pn * 4 + wc] = ss;
            }
        }
    }
};
struct EpiUp {
    static constexpr bool PERM = true;
    bf16* U; const float* RS;
    DEVI void operator()(const f32x4 (&acc)[2][2][4][2], const pg8::Unit& u, int wr, int wc, int fr, int fq) const {
#pragma unroll
        for (int ai = 0; ai < 2; ++ai)
#pragma unroll
            for (int m = 0; m < 4; ++m) {
                const int row = u.pm * 256 + ai * 128 + wr * 64 + m * 16 + fr; const float rs = row_rstd(RS, row);
#pragma unroll
                for (int bj = 0; bj < 2; ++bj) *(u32x4*)(U + (size_t)row * NUP + u.pn * 256 + bj * 128 + wc * 32 + fq * 8) = pack8(acc[ai][bj][m][0] * rs, acc[ai][bj][m][1] * rs);
            }
    }
};
struct EpiOddIn {
    static constexpr bool PERM = true;
    bf16 *R, *Kb, *Vb, *LM; int j;
    DEVI void operator()(const f32x4 (&acc)[2][2][4][2], const pg8::Unit& u, int wr, int wc, int fr, int fq) const {
        const int pn = u.pn; bf16* base; int pitch, off; float al, be, ga; bool ident, both;
        bf16 *r_ = R, *k_ = Kb, *v_ = Vb, *l_ = LM; asm volatile("" : "+s"(r_), "+s"(k_), "+s"(v_), "+s"(l_));
        if (pn < 12) { base = pn < 4 ? r_ : (pn < 8 ? k_ : v_); pitch = D; off = (pn & 3) * 256; ident = true; both = true; al = 1.f; be = 1.f; ga = 0.f; }
        else { base = l_; pitch = LML; off = pn == 12 ? 0 : (pn == 13 ? 256 : (pn == 14 ? 384 : 128)); ident = pn >= 14; both = pn == 14 || (pn == 12 && j == 0);
               al = pn == 13 ? 2.f : 1.f; be = al; ga = pn == 13 ? -1.f : 0.f; }
        bf16* p0 = base + off + wc * 32 + fq * 8;
#pragma unroll
        for (int ai = 0; ai < 2; ++ai)
#pragma unroll
            for (int m = 0; m < 4; ++m) {
                const int row = u.pm * 256 + ai * 128 + wr * 64 + m * 16 + fr;
#pragma unroll
                for (int bj = 0; bj < 2; ++bj) {
                    f32x4 v0 = acc[ai][bj][m][0], v1 = acc[ai][bj][m][1];
                    if (!ident) {
#pragma unroll
                        for (int e = 0; e < 4; ++e) { v0[e] = al * __builtin_amdgcn_rcpf(1.f + __expf(-be * v0[e])) + ga; v1[e] = al * __builtin_amdgcn_rcpf(1.f + __expf(-be * v1[e])) + ga; } }
                    if (bj == 0 || both) *(u32x4*)(p0 + (size_t)row * pitch + bj * 128) = pack8(v0, v1); }
            }
    }
};
struct EpiDecay {
    static constexpr bool PERM = true;
    float* WD; const float* w0;
    DEVI void operator()(const f32x4 (&acc)[2][2][4][2], const pg8::Unit& u, int wr, int wc, int fr, int fq) const {
        const int cb = u.pn * 256 + wc * 32 + fq * 8;
#pragma unroll
        for (int bj = 0; bj < 2; ++bj) {
            const f32x4 bia0 = *(const f32x4*)(w0 + cb + bj * 128), bia1 = *(const f32x4*)(w0 + cb + bj * 128 + 4);
#pragma unroll
            for (int ai = 0; ai < 2; ++ai)
#pragma unroll
                for (int m = 0; m < 4; ++m) {
                    const int row = u.pm * 256 + ai * 128 + wr * 64 + m * 16 + fr; const size_t o = (size_t)row * D + cb + bj * 128;
                    f32x4 v0_ = acc[ai][bj][m][0] + bia0, v1_ = acc[ai][bj][m][1] + bia1;
#pragma unroll
                    for (int e = 0; e < 4; ++e) { v0_[e] = __expf(-0.6065306597126334f * __builtin_amdgcn_rcpf(1.f + __expf(-v0_[e]))); v1_[e] = __expf(-0.6065306597126334f * __builtin_amdgcn_rcpf(1.f + __expf(-v1_[e]))); }
                    *(f32x4*)(WD + o) = v0_; *(f32x4*)(WD + o + 4) = v1_;
                }
        }
    }
};
struct EpiGate {
    static constexpr bool PERM = true;
    bf16* AG; const float *a0, *v0;
    DEVI void operator()(const f32x4 (&acc)[2][2][4][2], const pg8::Unit& u, int wr, int wc, int fr, int fq) const {
        const int grp = u.pn >> 2; const int cb = (u.pn & 3) * 256 + wc * 32 + fq * 8;
        const float* bp = grp == 2 ? v0 : a0; const float bsc = grp == 1 ? 0.f : 1.f;
        bf16* ob = AG + (size_t)grp * M * D;
#pragma unroll
        for (int bj = 0; bj < 2; ++bj) {
            const f32x4 bia0 = *(const f32x4*)(bp + cb + bj * 128) * bsc, bia1 = *(const f32x4*)(bp + cb + bj * 128 + 4) * bsc;
#pragma unroll
            for (int ai = 0; ai < 2; ++ai)
#pragma unroll
                for (int m = 0; m < 4; ++m) {
                    const int row = u.pm * 256 + ai * 128 + wr * 64 + m * 16 + fr; const size_t o = (size_t)row * D + cb + bj * 128;
                    f32x4 v0_ = acc[ai][bj][m][0] + bia0, v1_ = acc[ai][bj][m][1] + bia1;
                    if (grp != 1) {
#pragma unroll
                        for (int e = 0; e < 4; ++e) { v0_[e] = __builtin_amdgcn_rcpf(1.f + __expf(-v0_[e])); v1_[e] = __builtin_amdgcn_rcpf(1.f + __expf(-v1_[e])); } }
                    *(u32x4*)(ob + o) = pack8(v0_, v1_);
                }
        }
    }
};

DEVI void f_even_in(const Ctx& c, int li) {
    const int j = li >> 1;
    pg8::Gemm g{(const bf16*)(c.ws + WS_XB), (const bf16*)(c.ws + WS_WB + WB_WIN + j * SZ_WIN), M, NIN, D, D, 0ull, 0};
    pg8::StaticOrder S; S.init(M, NIN, c.G, c.bid);
    EpiEvenIn E{(bf16*)(c.ws + WS_Z), (const float*)(c.ws + WS_RS), (const float*)(c.ws + WS_ROPE)};
    pg8::gemm_phase<EpiEvenIn>(c.lds, c.tid, g, S, E);
}
DEVI void f_gemm_residual(const Ctx& c, const bf16* A, int lda, const bf16* Bt, int K, bool wxb) {
    pg8::Gemm g{A, Bt, M_MAIN, D, K, lda, 0ull, 0};
    pg8::StaticOrder S; S.init(M_MAIN, D, c.G, c.bid);
    (void)wxb; EpiResidual E{(bf16*)(c.ws + WS_XB), (float*)(c.ws + WS_RS)};
    pg8::gemm_phase<EpiResidual>(c.lds, c.tid, g, S, E);
}
DEVI void f_ffn_up(const Ctx& c, int li) {
    pg8::Gemm g{(const bf16*)(c.ws + WS_XB), (const bf16*)(c.ws + WS_WB + WB_WUP + li * SZ_WUP), M, NUP, D, D, 0ull, 0};
    pg8::StaticOrder S; S.init(M, NUP, c.G, c.bid);
    EpiUp E{(bf16*)(c.ws + WS_U), (const float*)(c.ws + WS_RS)};
    pg8::gemm_phase<EpiUp>(c.lds, c.tid, g, S, E);
}
DEVI void f_odd_in(const Ctx& c, int li) {
    const int j = li >> 1, N5 = j == 0 ? 3840 : 4096;
    pg8::Gemm g{(const bf16*)(c.ws + WS_XMIX), (const bf16*)(c.ws + WS_WB + WB_G5 + j * SZ_G5), M, N5, D, D, 0x3415333322220000ull, (size_t)M * D};
    pg8::StaticOrder S; S.init(M, N5, c.G, c.bid);
    EpiOddIn E{(bf16*)(c.ws + WS_R), (bf16*)(c.ws + WS_K), j == 0 ? (bf16*)((unsigned char*)c.out + DO_VFIRST) : (bf16*)(c.ws + WS_V), (bf16*)((unsigned char*)c.out + DO_LMID), j};
    pg8::gemm_phase<EpiOddIn>(c.lds, c.tid, g, S, E);
}
DEVI void f_odd_lora(const Ctx& c, const PArgs& a, int li) {
    const int j = li >> 1;
    const bf16* LM = (const bf16*)((unsigned char*)c.out + DO_LMID); const bf16* W6 = (const bf16*)(c.ws + WS_WB + WB_G6 + j * SZ_G6);
    int K6 = 256; asm volatile("" : "+s"(K6));
    {
        pg8::Gemm g{LM + 256, W6, M, D, K6, LML, 0ull, 0};
        pg8::StaticOrder S; S.init(M, D, c.G, c.bid);
        EpiDecay E{(float*)(c.ws + WS_WDEC), a.in[I_OW0] + (size_t)j * D};
        pg8::gemm_phase<EpiDecay>(c.lds, c.tid, g, S, E);
    }
    {
        const int N6 = j == 0 ? 2048 : 3072;
        pg8::Gemm g{LM, W6 + (size_t)1024 * 256, M, N6, K6, LML, 0x111100003333ull, 128};
        int c2 = c.bid + (c.G >> 1); if (c2 >= c.G) c2 -= c.G;
        pg8::StaticOrder S; S.init(M, N6, c.G, c2);
        EpiGate E{(bf16*)(c.ws + WS_AG), a.in[I_OA0] + (size_t)j * D, a.in[I_OV0]};
        pg8::gemm_phase<EpiGate>(c.lds, c.tid, g, S, E);
    }
}

typedef short bf16x8_t __attribute__((ext_vector_type(8)));
constexpr int LRU_XS = 0, LRU_AI = 33792, LRU_GT = LRU_AI + 128 * 136 * 2, LRU_END = LRU_GT + 128 * 256;
static_assert(LRU_END + 8 * 1024 <= RING_BYTES, "lru lds");
#define LWAIT_() asm volatile("s_waitcnt lgkmcnt(0)" ::: "memory")
#define LDS_BAR() asm volatile("s_waitcnt lgkmcnt(0)\n\ts_barrier" ::: "memory")
DEVI void f_lru_unit(const Ctx& c, const PArgs& a, int j, int g, bool sample, int b) {
    const bf16* Z = (const bf16*)(c.ws + WS_Z); bf16* MIX = (bf16*)(c.ws + WS_MIX);
    LAS unsigned char* XS = c.lds + LRU_XS; LAS unsigned char* AI = c.lds + LRU_AI; LAS unsigned char* GT = c.lds + LRU_GT;
    const int w = c.wave, fr = c.lane & 15, fq = c.lane >> 4, col = 16 * w + fr, ch = g * 128 + col;
    const int row0 = sample ? MP : b * TP, ntok = sample ? 128 : TP, nchunks = sample ? 1 : (TP + 127) / 128;
    bf16x8_t Bw[2][4];
#pragma unroll
    for (int gate = 0; gate < 2; ++gate) {
        const float* Wg = a.in[gate == 0 ? I_EWA : I_EWX] + (size_t)(j * 8 + g) * 128 * 128;
        __syncthreads();
        { f32x4 wv[8];
#pragma unroll
          for (int i = 0; i < 8; ++i) wv[i] = *(const f32x4*)(Wg + (unsigned)(i * NT + c.tid) * 4u);
          asm volatile("" ::: "memory");
#pragma unroll
          for (int i = 0; i < 8; ++i) *(LAS f32x4*)(c.lds + (unsigned)(i * NT + c.tid) * 16u) = wv[i]; }
        __syncthreads();
#pragma unroll
        for (int ks = 0; ks < 4; ++ks) { bf16x8_t vv;
#pragma unroll
            for (int jj = 0; jj < 8; ++jj) vv[jj] = (short)f2bf(*(const LAS float*)(c.lds + ((32 * ks + 8 * fq + jj) * 128 + col) * 4));
            Bw[gate][ks] = vv; }
    }
    const float ba = a.in[I_EBA][(size_t)j * 1024 + ch], bx = a.in[I_EBX][(size_t)j * 1024 + ch], sp8 = 8.f * softplusf_(-a.in[I_ELAM][(size_t)j * 1024 + ch]);
    const int cc = c.tid & 127, rq = c.tid >> 7, cch = g * 128 + cc;
    const float* CW = a.in[I_ECW] + (size_t)j * 4 * 1024;
    const float cw0 = CW[cch], cw1 = CW[1024 + cch], cw2 = CW[2048 + cch], cw3 = CW[3072 + cch], cb = a.in[I_ECB][(size_t)j * 1024 + cch];
    float carry = 0.f;
    u32x4 pfx[5], pfg[4];
    const bf16* zx = Z + (size_t)row0 * NIN + 3072 + g * 128; const bf16* zg = Z + (size_t)row0 * NIN + 4096 + g * 128;
#define LRU_PREFETCH(t0) do { _Pragma("unroll") for (int i = 0; i < 5; ++i) { const int p = i * NT + c.tid, r = p >> 4, q = p & 15; const int t = (t0) - 3 + r; \
            pfx[i] = (u32x4){0u, 0u, 0u, 0u}; if (r < 131 && t >= 0) pfx[i] = *(const u32x4*)(zx + (unsigned)(t * NIN + q * 8)); } \
        _Pragma("unroll") for (int i = 0; i < 4; ++i) { const int p = i * NT + c.tid, r = p >> 4, q = p & 15; pfg[i] = *(const u32x4*)(zg + (unsigned)(((t0) + r) * NIN + q * 8)); } } while (0)
    LRU_PREFETCH(0);
    for (int ci = 0; ci < nchunks; ++ci) {
        const int t0 = ci * 128, nv = (ntok - t0) < 128 ? (ntok - t0) : 128;
        __syncthreads();
#pragma unroll
        for (int i = 0; i < 5; ++i) { const int p = i * NT + c.tid; if (p < 131 * 16) *(LAS u32x4*)(XS + p * 16) = pfx[i]; }
#pragma unroll
        for (int i = 0; i < 4; ++i) { const int p = i * NT + c.tid; *(LAS u32x4*)(GT + p * 16) = pfg[i]; }
        __syncthreads();
        if (ci + 1 < nchunks) LRU_PREFETCH(t0 + 128);
        if (!sample) {
            float x0 = bf2f(*(const LAS bf16*)(XS + ((rq * 32 + 0) * 128 + cc) * 2)), x1 = bf2f(*(const LAS bf16*)(XS + ((rq * 32 + 1) * 128 + cc) * 2)), x2 = bf2f(*(const LAS bf16*)(XS + ((rq * 32 + 2) * 128 + cc) * 2));
#pragma unroll 8
            for (int i = 0; i < 32; ++i) { const int lr = rq * 32 + i; const float x3 = bf2f(*(const LAS bf16*)(XS + ((lr + 3) * 128 + cc) * 2));
                *(LAS bf16*)(AI + (lr * 136 + cc) * 2) = f2bf(cb + cw3 * x3 + cw2 * x2 + cw1 * x1 + cw0 * x0); x0 = x1; x1 = x2; x2 = x3; }
        } else {
            const float* SC = a.in[I_SLCONV] + (size_t)j * BS * 3 * 1024 + cch; float* SCO = c.out + O_LCONVS + (size_t)j * BS * 3 * 1024 + cch;
#pragma unroll 2
            for (int i = 0; i < 32; ++i) { const int lr = rq * 32 + i; const unsigned so = (unsigned)(lr * 3 * 1024);
                const float h0 = SC[so], h1 = SC[so + 1024u], h2 = SC[so + 2048u], x3 = bf2f(*(const LAS bf16*)(XS + ((lr + 3) * 128 + cc) * 2));
                *(LAS bf16*)(AI + (lr * 136 + cc) * 2) = f2bf(cb + cw3 * x3 + cw2 * h2 + cw1 * h1 + cw0 * h0);
                SCO[so] = h1; SCO[so + 1024u] = h2; SCO[so + 2048u] = x3; }
        }
        __syncthreads();
#pragma unroll 1
        for (int m = 0; m < 8; ++m) {
            f32x4 accr_ = (f32x4){0.f, 0.f, 0.f, 0.f}, acci_ = (f32x4){0.f, 0.f, 0.f, 0.f};
#pragma unroll
            for (int ks = 0; ks < 4; ++ks) { const bf16x8_t af = *(const LAS bf16x8_t*)(AI + ((16 * m + fr) * 136 + 32 * ks + 8 * fq) * 2);
                accr_ = __builtin_amdgcn_mfma_f32_16x16x32_bf16(af, Bw[0][ks], accr_, 0, 0, 0);
                acci_ = __builtin_amdgcn_mfma_f32_16x16x32_bf16(af, Bw[1][ks], acci_, 0, 0, 0); }
            float av[4], uv[4];
#pragma unroll
            for (int r = 0; r < 4; ++r) { const int lr = 16 * m + 4 * fq + r;
                const float xcv = bf2f(*(const LAS bf16*)(AI + (lr * 136 + col) * 2));
                const float rg = sigmoidf_(accr_[r] + ba), ig = sigmoidf_(acci_[r] + bx);
                const float la = -sp8 * rg, t2 = 2.f * la;
                const float em1 = t2 > -0.02f ? t2 * (1.f + t2 * (0.5f + t2 * 0.16666667f)) : __expf(t2) - 1.f;
                av[r] = __expf(la); uv[r] = sqrtf(-em1) * (ig * xcv); }
            float hv[4];
            if (!sample) {
                const float Ai = av[0] * av[1] * av[2] * av[3], Ui = ((uv[0] * av[1] + uv[1]) * av[2] + uv[2]) * av[3] + uv[3];
                LAS f32x2_t* cs = (LAS f32x2_t*)(c.lds + LRU_END + w * 1024 + (m & 1) * 512);
                cs[fq * 16 + fr] = (f32x2_t){Ai, Ui};
                LWAIT_();
                const f32x2_t c0 = cs[fr], c1 = cs[16 + fr], c2 = cs[32 + fr], c3 = cs[48 + fr];
                const float h0e = c0.x * carry + c0.y, h1e = c1.x * h0e + c1.y, h2e = c2.x * h1e + c2.y, h3e = c3.x * h2e + c3.y;
                const float hin = fq == 0 ? carry : (fq == 1 ? h0e : (fq == 2 ? h1e : h2e));
                carry = h3e;
                hv[0] = av[0] * hin + uv[0]; hv[1] = av[1] * hv[0] + uv[1]; hv[2] = av[2] * hv[1] + uv[2]; hv[3] = av[3] * hv[2] + uv[3];
                if (nv < 128 && m == ((TP % 128) - 1) / 16 && fq == (((TP % 128) - 1) & 15) / 4) c.out[O_LRUP + (size_t)(j * BP + b) * 1024 + ch] = hv[((TP % 128) - 1) & 3];
            } else {
#pragma unroll
                for (int r = 0; r < 4; ++r) { const int lr = 16 * m + 4 * fq + r; const unsigned so = (unsigned)(lr * 1024);
                    hv[r] = av[r] * (a.in[I_SLRU] + (size_t)j * BS * 1024 + ch)[so] + uv[r]; (c.out + O_LRUS + (size_t)j * BS * 1024 + ch)[so] = hv[r]; }
            }
#pragma unroll
            for (int r = 0; r < 4; ++r) { const int lr = 16 * m + 4 * fq + r; LAS bf16* gp = (LAS bf16*)(GT + (lr * 128 + col) * 2); *gp = f2bf(hv[r] * bf2f(*gp)); }
        }
        if (!sample && nv < 128 && c.tid < 128) {
#pragma unroll
            for (int k = 0; k < 3; ++k) c.out[O_LCONVP + ((size_t)(j * BP + b) * 3 + k) * 1024 + g * 128 + c.tid] = bf2f(*(const LAS bf16*)(XS + ((nv + k) * 128 + c.tid) * 2));
        }
        __syncthreads();
#pragma unroll
        for (int i = 0; i < 4; ++i) { const int p = i * NT + c.tid, r = p >> 4, q = p & 15;
            if (r < nv) *(u32x4*)(MIX + (size_t)(row0 + t0 + r) * 2048 + 1024 + g * 128 + q * 8) = *(const LAS u32x4*)(GT + p * 16); }
    }
#undef LRU_PREFETCH
    __syncthreads();
}

#define DPP_F(v, ctrl) __builtin_bit_cast(float, __builtin_amdgcn_update_dpp(0, __builtin_bit_cast(int, (v)), (ctrl), 0xF, 0xF, true))
DEVI float red8(float x) { x += DPP_F(x, 0xB1); x += DPP_F(x, 0x4E); x += DPP_F(x, 0x141); return x; }
DEVI float red32(float x) { x += DPP_F(x, 0xB1); x += DPP_F(x, 0x4E); x += DPP_F(x, 0x141); x += DPP_F(x, 0x140); x += __shfl_xor(x, 16); return x; }
typedef unsigned long long u64x2_t __attribute__((ext_vector_type(2)));
DEVI void tr_frag2(unsigned tile, int pitch, int krow0, int col0, int fr, int fq, bf16x8_t& f0, bf16x8_t& f1) {
    const unsigned base = tile + (unsigned)((krow0 + 8 * fq + (fr >> 2)) * pitch + (col0 + 4 * (fr & 3)) * 2);
    unsigned long long a0, a1, b0, b1;
    asm volatile("ds_read_b64_tr_b16 %0, %4\n\tds_read_b64_tr_b16 %1, %5\n\tds_read_b64_tr_b16 %2, %6\n\tds_read_b64_tr_b16 %3, %7\n\ts_waitcnt lgkmcnt(0)"
                 : "=&v"(a0), "=&v"(a1), "=&v"(b0), "=&v"(b1) : "v"(base), "v"(base + 4u * (unsigned)pitch), "v"(base + 32u * (unsigned)pitch), "v"(base + 36u * (unsigned)pitch) : "memory");
    u64x2_t v0; v0.x = a0; v0.y = a1; u64x2_t v1; v1.x = b0; v1.y = b1;
    f0 = __builtin_bit_cast(bf16x8_t, v0); f1 = __builtin_bit_cast(bf16x8_t, v1);
}
DEVI void tr_frag4(unsigned tile, int pitch, int col0, int col1, int fr, int fq, bf16x8_t& f00, bf16x8_t& f01, bf16x8_t& f10, bf16x8_t& f11) {
    const unsigned b0 = tile + (unsigned)((8 * fq + (fr >> 2)) * pitch + (col0 + 4 * (fr & 3)) * 2), b1 = b0 + (unsigned)((col1 - col0) * 2);
    unsigned long long a0, a1, a2, a3, c0, c1, c2, c3;
    asm volatile("ds_read_b64_tr_b16 %0, %8\n\tds_read_b64_tr_b16 %1, %9\n\tds_read_b64_tr_b16 %2, %10\n\tds_read_b64_tr_b16 %3, %11\n\t"
                 "ds_read_b64_tr_b16 %4, %12\n\tds_read_b64_tr_b16 %5, %13\n\tds_read_b64_tr_b16 %6, %14\n\tds_read_b64_tr_b16 %7, %15\n\ts_waitcnt lgkmcnt(0)"
                 : "=&v"(a0), "=&v"(a1), "=&v"(a2), "=&v"(a3), "=&v"(c0), "=&v"(c1), "=&v"(c2), "=&v"(c3)
                 : "v"(b0), "v"(b0 + 4u * (unsigned)pitch), "v"(b0 + 32u * (unsigned)pitch), "v"(b0 + 36u * (unsigned)pitch), "v"(b1), "v"(b1 + 4u * (unsigned)pitch), "v"(b1 + 32u * (unsigned)pitch), "v"(b1 + 36u * (unsigned)pitch) : "memory");
    u64x2_t v; v.x = a0; v.y = a1; f00 = __builtin_bit_cast(bf16x8_t, v); v.x = a2; v.y = a3; f01 = __builtin_bit_cast(bf16x8_t, v);
    v.x = c0; v.y = c1; f10 = __builtin_bit_cast(bf16x8_t, v); v.x = c2; v.y = c3; f11 = __builtin_bit_cast(bf16x8_t, v);
}
constexpr int RC = 64;
constexpr int RT_QS = 0, RT_KS = RT_QS + RC * 272, RT_KD = RT_KS + RC * 272, RT_VS = RT_KD + RC * 272, RT_PS = RT_VS + RC * 528, RT_OT = RT_PS + RC * 144, RT_END = RT_OT + RC * 528;
static_assert(RT_END <= RING_BYTES, "ret lds");
DEVI void f_ret_prompt(const Ctx& c, const PArgs& a, int j, int b, int hd) {
    const bf16* Z = (const bf16*)(c.ws + WS_Z); bf16* MIX = (bf16*)(c.ws + WS_MIX);
    const unsigned L0 = (unsigned)(size_t)c.lds;
    LAS unsigned char* QS = c.lds + RT_QS; LAS unsigned char* KS = c.lds + RT_KS; LAS unsigned char* KD = c.lds + RT_KD; LAS unsigned char* VS = c.lds + RT_VS; LAS unsigned char* PS = c.lds + RT_PS;
    const int w = c.wave;
    const float l2g0 = log2f(1.f - exp2f(-5.f - (float)hd));
    const bf16* zb = Z + (size_t)(b * TP) * NIN; const int qcol = hd * 128, kcol = 512 + hd * 128, vcol = 1024 + hd * 256;
    const float* gn = a.in[I_ERGN] + (size_t)j * 1024 + hd * 256;
    f32x4 Sacc[8][2];
#pragma unroll
    for (int db = 0; db < 8; ++db) { Sacc[db][0] = (f32x4){0.f, 0.f, 0.f, 0.f}; Sacc[db][1] = (f32x4){0.f, 0.f, 0.f, 0.f}; }
    u32x4 pf[8];
#define RET_PREFETCH(t0) do { _Pragma("unroll") for (int i = 0; i < 8; ++i) { int r, col; \
            if (i < 4) { const int p = (i & 1) * NT + c.tid; r = p >> 4; col = (i < 2 ? qcol : kcol) + (p & 15) * 8; } else { const int p = (i - 4) * NT + c.tid; r = p >> 5; col = vcol + (p & 31) * 8; } \
            pf[i] = (u32x4){0u, 0u, 0u, 0u}; if ((t0) + r < TP) pf[i] = *(const u32x4*)(zb + (unsigned)(((t0) + r) * NIN + col)); } } while (0)
    RET_PREFETCH(0);
    const int nchunks = (TP + RC - 1) / RC;
#pragma unroll 1
    for (int ci = 0; ci < nchunks; ++ci) {
        const int t0 = ci * RC, nv = (TP - t0) < RC ? (TP - t0) : RC;
        int lane_ = c.lane; float l2g = l2g0; asm volatile("" : "+v"(lane_), "+v"(l2g));
        const int fr = lane_ & 15, fq = lane_ >> 4, tid_ = w * 64 + lane_;
        LDS_BAR();
#pragma unroll
        for (int i = 0; i < 8; ++i) {
            if (i < 4) { const int p = (i & 1) * NT + tid_, r = p >> 4, q = p & 15;
                *(LAS u32x4*)((i < 2 ? QS : KS) + r * 272 + q * 16) = pf[i];
                if (i >= 2) { const float dk = __builtin_amdgcn_exp2f((float)(nv - 1 - r) * l2g); u32x4 o;
#pragma unroll
                    for (int e = 0; e < 4; ++e) { const unsigned v = pf[i][e]; o[e] = pk2(__uint_as_float(v << 16) * dk, __uint_as_float(v & 0xffff0000u) * dk); }
                    *(LAS u32x4*)(KD + r * 272 + q * 16) = o; } }
            else { const int p = (i - 4) * NT + tid_, r = p >> 5, q = p & 31; *(LAS u32x4*)(VS + r * 528 + q * 16) = pf[i]; }
        }
        LDS_BAR();
        if (ci + 1 < nchunks) RET_PREFETCH(t0 + RC);
        u32x4 gcur[4];
#pragma unroll
        for (int i = 0; i < 4; ++i) { const int p = i * NT + tid_, r = p >> 5, q = p & 31; gcur[i] = (u32x4){0u, 0u, 0u, 0u};
            if (r < nv) gcur[i] = *(const u32x4*)(zb + (unsigned)((t0 + r) * NIN + 2048 + hd * 256 + q * 8)); }
        const f32x4 gn0 = *(const f32x4*)(gn + (tid_ & 31) * 8), gn1 = *(const f32x4*)(gn + (tid_ & 31) * 8 + 4);
        { const int cb = w >> 1;
#pragma unroll
          for (int si = 0; si < 2; ++si) { const int sb = 2 * (w & 1) + si; f32x4 pacc = (f32x4){0.f, 0.f, 0.f, 0.f};
#pragma unroll
              for (int ks = 0; ks < 4; ++ks) { const bf16x8_t af = *(const LAS bf16x8_t*)(QS + (16 * cb + fr) * 272 + (32 * ks + 8 * fq) * 2);
                  const bf16x8_t bfr = *(const LAS bf16x8_t*)(KS + (16 * sb + fr) * 272 + (32 * ks + 8 * fq) * 2);
                  pacc = __builtin_amdgcn_mfma_f32_16x16x32_bf16(af, bfr, pacc, 0, 0, 0); }
#pragma unroll
              for (int r = 0; r < 4; ++r) { const int cc = 16 * cb + 4 * fq + r, ss = 16 * sb + fr; const float v = cc >= ss ? pacc[r] * __builtin_amdgcn_exp2f((float)(cc - ss) * l2g) : 0.f;
                  *(LAS bf16*)(PS + cc * 144 + ss * 2) = f2bf(v); } } }
        f32x4 Oacc[4][2];
#pragma unroll
        for (int cb = 0; cb < 4; ++cb) { Oacc[cb][0] = (f32x4){0.f, 0.f, 0.f, 0.f}; Oacc[cb][1] = (f32x4){0.f, 0.f, 0.f, 0.f}; }
#pragma unroll
        for (int kk = 0; kk < 4; ++kk) {
            bf16x8_t sb_[2];
#pragma unroll
            for (int en = 0; en < 2; ++en) { u32x4 t; t.x = pk2(Sacc[2 * kk][en][0], Sacc[2 * kk][en][1]); t.y = pk2(Sacc[2 * kk][en][2], Sacc[2 * kk][en][3]);
                t.z = pk2(Sacc[2 * kk + 1][en][0], Sacc[2 * kk + 1][en][1]); t.w = pk2(Sacc[2 * kk + 1][en][2], Sacc[2 * kk + 1][en][3]); sb_[en] = __builtin_bit_cast(bf16x8_t, t); }
#pragma unroll
            for (int cb = 0; cb < 4; ++cb) {
                const u32x2 qa = *(const LAS u32x2*)(QS + (16 * cb + fr) * 272 + (32 * kk + 4 * fq) * 2), qb = *(const LAS u32x2*)(QS + (16 * cb + fr) * 272 + (32 * kk + 16 + 4 * fq) * 2);
                u32x4 t; t.x = qa.x; t.y = qa.y; t.z = qb.x; t.w = qb.y; const bf16x8_t af = __builtin_bit_cast(bf16x8_t, t);
                Oacc[cb][0] = __builtin_amdgcn_mfma_f32_16x16x32_bf16(af, sb_[0], Oacc[cb][0], 0, 0, 0);
                Oacc[cb][1] = __builtin_amdgcn_mfma_f32_16x16x32_bf16(af, sb_[1], Oacc[cb][1], 0, 0, 0); }
        }
#pragma unroll
        for (int cb = 0; cb < 4; ++cb)
#pragma unroll
            for (int r = 0; r < 4; ++r) { const float dc = __builtin_amdgcn_exp2f((float)(16 * cb + 4 * fq + r + 1) * l2g); Oacc[cb][0][r] *= dc; Oacc[cb][1][r] *= dc; }
        LDS_BAR();
        bf16x8_t vf[2][2];
        tr_frag4(L0 + RT_VS, 528, 32 * w, 32 * w + 16, fr, fq, vf[0][0], vf[0][1], vf[1][0], vf[1][1]);
#pragma unroll
        for (int cb = 0; cb < 4; ++cb)
#pragma unroll
            for (int ks = 0; ks < 2; ++ks) { const bf16x8_t af = *(const LAS bf16x8_t*)(PS + (16 * cb + fr) * 144 + (32 * ks + 8 * fq) * 2);
                Oacc[cb][0] = __builtin_amdgcn_mfma_f32_16x16x32_bf16(af, vf[0][ks], Oacc[cb][0], 0, 0, 0);
                Oacc[cb][1] = __builtin_amdgcn_mfma_f32_16x16x32_bf16(af, vf[1][ks], Oacc[cb][1], 0, 0, 0); }
        LAS unsigned char* OT = c.lds + RT_OT;
#pragma unroll
        for (int cb = 0; cb < 4; ++cb)
#pragma unroll
            for (int en = 0; en < 2; ++en)
#pragma unroll
                for (int r = 0; r < 4; ++r) *(LAS bf16*)(OT + (16 * cb + 4 * fq + r) * 528 + (32 * w + 16 * en + fr) * 2) = f2bf(Oacc[cb][en][r]);
        { const float dS = __builtin_amdgcn_exp2f((float)nv * l2g);
#pragma unroll
          for (int d2 = 0; d2 < 4; ++d2) {
              bf16x8_t kf[2][2]; tr_frag4(L0 + RT_KD, 272, 32 * d2, 32 * d2 + 16, fr, fq, kf[0][0], kf[0][1], kf[1][0], kf[1][1]);
#pragma unroll
              for (int dd = 0; dd < 2; ++dd) { const int db = 2 * d2 + dd; Sacc[db][0] = Sacc[db][0] * dS; Sacc[db][1] = Sacc[db][1] * dS;
#pragma unroll
                  for (int ks = 0; ks < 2; ++ks) {
                      Sacc[db][0] = __builtin_amdgcn_mfma_f32_16x16x32_bf16(kf[dd][ks], vf[0][ks], Sacc[db][0], 0, 0, 0);
                      Sacc[db][1] = __builtin_amdgcn_mfma_f32_16x16x32_bf16(kf[dd][ks], vf[1][ks], Sacc[db][1], 0, 0, 0); } } } }
        LDS_BAR();
        asm volatile("" :: "v"(gcur[0]), "v"(gcur[1]), "v"(gcur[2]), "v"(gcur[3]), "v"(gn0), "v"(gn1));
#pragma unroll
        for (int i = 0; i < 4; ++i) { const int p = i * NT + tid_, r = p >> 5, q = p & 31;
            const u32x4 ov = *(const LAS u32x4*)(OT + r * 528 + q * 16);
            float o[8]; float s1 = 0.f, s2 = 0.f;
#pragma unroll
            for (int e = 0; e < 4; ++e) { o[2 * e] = __uint_as_float(ov[e] << 16); o[2 * e + 1] = __uint_as_float(ov[e] & 0xffff0000u); s1 += o[2 * e] + o[2 * e + 1]; s2 += o[2 * e] * o[2 * e] + o[2 * e + 1] * o[2 * e + 1]; }
            s1 = red32(s1); s2 = red32(s2);
            const float mu = s1 * (1.f / 256.f), var = fmaxf(s2 * (1.f / 256.f) - mu * mu, 0.f), rstd = __builtin_amdgcn_rsqf(var + 1e-6f);
            if (r < nv) { const u32x4 gv = gcur[i]; const f32x4 n0 = gn0, n1 = gn1;
                u32x4 out;
#pragma unroll
                for (int e = 0; e < 4; ++e) { const float g0 = __uint_as_float(gv[e] << 16), g1 = __uint_as_float(gv[e] & 0xffff0000u);
                    const float n_0 = e < 2 ? n0[2 * e] : n1[2 * e - 4], n_1 = e < 2 ? n0[2 * e + 1] : n1[2 * e - 3];
                    out[e] = pk2(g0 * (o[2 * e] - mu) * rstd * n_0, g1 * (o[2 * e + 1] - mu) * rstd * n_1); }
                *(u32x4*)(MIX + (size_t)(b * TP + t0 + r) * 2048 + hd * 256 + q * 8) = out; }
        }
    }
#undef RET_PREFETCH
    { const int fr = c.lane & 15, fq = c.lane >> 4; float* So = c.out + O_RETP + ((size_t)(j * BP + b) * 4 + hd) * 128 * 256 + 32 * w + fr;
#pragma unroll
      for (int db = 0; db < 8; ++db)
#pragma unroll
          for (int en = 0; en < 2; ++en)
#pragma unroll
              for (int r = 0; r < 4; ++r) So[(unsigned)((16 * db + 4 * fq + r) * 256 + 16 * en)] = Sacc[db][en][r]; }
    __syncthreads();
}
DEVI void f_ret_sample(const Ctx& c, const PArgs& a, int j, int b, int hd) {
    const bf16* Z = (const bf16*)(c.ws + WS_Z); bf16* MIX = (bf16*)(c.ws + WS_MIX);
    LAS float* qk = (LAS float*)c.lds;
    LAS float* op = qk + 256;
    const int row = MP + b, w = c.wave;
    const float gamma = 1.f - exp2f(-5.f - (float)hd);
    const float* S0 = a.in[I_SRET] + ((size_t)(j * BS + b) * 4 + hd) * 128 * 256 + 4 * c.lane; float* So = c.out + O_RETS + ((size_t)(j * BS + b) * 4 + hd) * 128 * 256 + 4 * c.lane;
    __syncthreads();
    if (c.tid < 256) qk[c.tid] = bf2f(Z[(size_t)row * NIN + (c.tid < 128 ? hd * 128 + c.tid : 512 + hd * 128 + c.tid - 128)]);
    const u32x2 vv = *(const u32x2*)(Z + (size_t)row * NIN + 1024 + hd * 256 + 4 * c.lane);
    const f32x4 v4 = (f32x4){__uint_as_float(vv.x << 16), __uint_as_float(vv.x & 0xffff0000u), __uint_as_float(vv.y << 16), __uint_as_float(vv.y & 0xffff0000u)};
    __syncthreads();
    f32x4 o4 = (f32x4){0.f, 0.f, 0.f, 0.f};
#pragma unroll 16
    for (int dd = 0; dd < 16; ++dd) { const int d = 16 * w + dd; f32x4 s = __builtin_nontemporal_load((const f32x4*)(S0 + (unsigned)(d * 256)));
        s = s * gamma + v4 * qk[128 + d]; __builtin_nontemporal_store(s, (f32x4*)(So + (unsigned)(d * 256))); o4 = o4 + s * qk[d]; }
    *(LAS f32x4*)(op + w * 256 + 4 * c.lane) = o4;
    __syncthreads();
    if (w == 0) {
        f32x4 o = (f32x4){0.f, 0.f, 0.f, 0.f};
#pragma unroll
        for (int ww = 0; ww < 8; ++ww) o = o + *(const LAS f32x4*)(op + ww * 256 + 4 * c.lane);
        const float mu = wave_sum((o.x + o.y) + (o.z + o.w)) * (1.f / 256.f); o = o - mu;
        const float rstd = __builtin_amdgcn_rsqf(wave_sum((o.x * o.x + o.y * o.y) + (o.z * o.z + o.w * o.w)) * (1.f / 256.f) + 1e-6f);
        const u32x2 gv = *(const u32x2*)(Z + (size_t)row * NIN + 2048 + hd * 256 + 4 * c.lane); const f32x4 n4 = *(const f32x4*)(a.in[I_ERGN] + (size_t)j * 1024 + hd * 256 + 4 * c.lane);
        u32x2 out; out.x = pk2(__uint_as_float(gv.x << 16) * o.x * rstd * n4.x, __uint_as_float(gv.x & 0xffff0000u) * o.y * rstd * n4.y);
        out.y = pk2(__uint_as_float(gv.y << 16) * o.z * rstd * n4.z, __uint_as_float(gv.y & 0xffff0000u) * o.w * rstd * n4.w);
        *(u32x2*)(MIX + (size_t)row * 2048 + hd * 256 + 4 * c.lane) = out;
    }
}

#ifndef WPB
#define WPB 180
#endif
#ifndef MIX_PART
#define MIX_PART 7
#endif
DEVI void f_even_mix(const Ctx& c, const PArgs& a, int li, int part) {
    const int j = li >> 1;
    if (c.bid < 32) { if (part & 1) f_ret_prompt(c, a, j, c.bid >> 2, c.bid & 3); }
    else if (c.bid < 104) { if (part & 2) { const bool pr = c.bid < 96; const int v = c.bid - 32;
        f_lru_unit(c, a, j, pr ? (v & 7) : (c.bid - 96), !pr, pr ? (v >> 3) : 0); } }
    if (part & 4) {
    if (c.bid >= 104) for (int u = c.bid - 104; u < 512; u += c.G - 104) f_ret_sample(c, a, j, u >> 2, u & 3);
    if (c.bid >= WPB && c.G > WPB) { __syncthreads(); f_wprep(c, a, li == 0 ? WM_L01 : WM_L23, (c.bid - WPB) * NWAVES + c.wave, (c.G - WPB) * NWAVES); }
    }
}

DEVI float gelu_fast(float x) { const float y = 1.5957691216057308f * (x + 0.044715f * x * x * x); return x * __builtin_amdgcn_rcpf(1.f + __expf(-y)); }
DEVI void f_ffn_act(const Ctx& c, const PArgs& a, int li) {
    const bf16* U = (const bf16*)(c.ws + WS_U); bf16* ACT = (bf16*)(c.ws + WS_ACT);
    const float* CW = a.in[I_FCW] + (size_t)li * 3 * DFF; const float* CB = a.in[I_FCB] + (size_t)li * DFF;
    constexpr int RCH = 32, NPC = DFF / 8, NRC = M / RCH, NITEM = NPC * NRC;
    for (int it = c.bid * NT + c.tid; it < NITEM; it += c.G * NT) {
        const int rc = it / NPC, pc = it - rc * NPC, col = pc * 8, r0 = rc * RCH;
        float w0[8], w1[8], w2[8], cb[8];
#pragma unroll
        for (int h = 0; h < 2; ++h) { const f32x4 a0 = *(const f32x4*)(CW + col + 4 * h), a1 = *(const f32x4*)(CW + DFF + col + 4 * h), a2 = *(const f32x4*)(CW + 2 * DFF + col + 4 * h), b0 = *(const f32x4*)(CB + col + 4 * h);
#pragma unroll
            for (int e = 0; e < 4; ++e) { w0[4 * h + e] = a0[e]; w1[4 * h + e] = a1[e]; w2[4 * h + e] = a2[e]; cb[4 * h + e] = b0[e]; } }
        const bf16* ub = U + (size_t)r0 * NUP + col; bf16* ab = ACT + (size_t)r0 * DFF + col;
        if (r0 < MP) {
            u32x4 p1 = (u32x4){0u, 0u, 0u, 0u}, p2 = p1;
            int t = r0 % TP;
            if (t >= 1) p1 = *(const u32x4*)(ub - NUP); if (t >= 2) p2 = *(const u32x4*)(ub - 2 * NUP);
#pragma unroll 1
            for (int i0 = 0; i0 < RCH; i0 += 8) {
                u32x4 ug[8], uv[8];
#pragma unroll
                for (int i = 0; i < 8; ++i) { ug[i] = *(const u32x4*)(ub + (unsigned)((i0 + i) * NUP)); uv[i] = *(const u32x4*)(ub + (unsigned)((i0 + i) * NUP + DFF)); }
#pragma unroll
                for (int i = 0; i < 8; ++i) {
                    if (t == 0) { p1 = (u32x4){0u, 0u, 0u, 0u}; p2 = p1; }
                    if (t >= TP - 2) { float* so = c.out + O_FCONVP + ((size_t)(li * BP + (r0 + i0 + i) / TP) * 2 + (t - (TP - 2))) * DFF + col;
#pragma unroll
                        for (int e = 0; e < 4; ++e) { so[2 * e] = __uint_as_float(ug[i][e] << 16); so[2 * e + 1] = __uint_as_float(ug[i][e] & 0xffff0000u); } }
                    u32x4 o;
#pragma unroll
                    for (int e = 0; e < 4; ++e) {
                        const float ca = cb[2 * e] + w2[2 * e] * __uint_as_float(ug[i][e] << 16) + w1[2 * e] * __uint_as_float(p1[e] << 16) + w0[2 * e] * __uint_as_float(p2[e] << 16);
                        const float cv = cb[2 * e + 1] + w2[2 * e + 1] * __uint_as_float(ug[i][e] & 0xffff0000u) + w1[2 * e + 1] * __uint_as_float(p1[e] & 0xffff0000u) + w0[2 * e + 1] * __uint_as_float(p2[e] & 0xffff0000u);
                        o[e] = pk2(gelu_fast(ca) * __uint_as_float(uv[i][e] << 16), gelu_fast(cv) * __uint_as_float(uv[i][e] & 0xffff0000u)); }
                    *(u32x4*)(ab + (unsigned)((i0 + i) * DFF)) = o;
                    p2 = p1; p1 = ug[i]; t = (t + 1 == TP) ? 0 : t + 1;
                }
            }
        } else {
#pragma unroll 1
            for (int i = 0; i < RCH; ++i) {
                const int row = r0 + i;
                const u32x4 ug = *(const u32x4*)(ub + (unsigned)(i * NUP)), uv = *(const u32x4*)(ub + (unsigned)(i * NUP + DFF));
                const float* st = a.in[I_SFCONV] + (size_t)(li * BS + row - MP) * 2 * DFF + col; float* so = c.out + O_FCONVS + (size_t)(li * BS + row - MP) * 2 * DFF + col;
                float f1[8], f2[8];
#pragma unroll
                for (int h = 0; h < 2; ++h) { const f32x4 s2 = *(const f32x4*)(st + 4 * h), s1 = *(const f32x4*)(st + DFF + 4 * h); *(f32x4*)(so + 4 * h) = s1;
#pragma unroll
                    for (int e = 0; e < 4; ++e) { f2[4 * h + e] = s2[e]; f1[4 * h + e] = s1[e]; } }
                u32x4 o;
#pragma unroll
                for (int e = 0; e < 4; ++e) { const float u0a = __uint_as_float(ug[e] << 16), u0b = __uint_as_float(ug[e] & 0xffff0000u);
                    so[DFF + 2 * e] = u0a; so[DFF + 2 * e + 1] = u0b;
                    const float ca = cb[2 * e] + w2[2 * e] * u0a + w1[2 * e] * f1[2 * e] + w0[2 * e] * f2[2 * e], cv = cb[2 * e + 1] + w2[2 * e + 1] * u0b + w1[2 * e + 1] * f1[2 * e + 1] + w0[2 * e + 1] * f2[2 * e + 1];
                    o[e] = pk2(gelu_fast(ca) * __uint_as_float(uv[e] << 16), gelu_fast(cv) * __uint_as_float(uv[e] & 0xffff0000u)); }
                *(u32x4*)(ab + (unsigned)(i * DFF)) = o;
            }
        }
    }
}

constexpr int RW_TG = 16;
constexpr int RW_BUF = 6 * RW_TG * 64 * 4;
constexpr int RW_Y = 2 * RW_BUF, RW_BON = RW_Y + RW_TG * 64 * 4, RW_END = RW_BON + RW_TG * 4;
DEVI void f_rwkv_prompt(const Ctx& c, const PArgs& a, int j, int b, int hd) {
    const bf16* R = (const bf16*)(c.ws + WS_R); const bf16* Kb = (const bf16*)(c.ws + WS_K);
    const bf16* VF = (const bf16*)((unsigned char*)c.out + DO_VFIRST); const bf16* Vb = j == 0 ? VF : (const bf16*)(c.ws + WS_V);
    const float* WD = (const float*)(c.ws + WS_WDEC); const bf16* AG = (const bf16*)(c.ws + WS_AG); const bf16* VG = (const bf16*)(c.ws + WS_VG); const bf16* GG = (const bf16*)(c.ws + WS_GG);
    bf16* O = (bf16*)(c.ws + WS_O);
    const int i = c.tid >> 3, q = c.tid & 7;
    const int st = c.tid >> 5, sc = (c.tid & 31) * 2, ch = hd * 64 + sc;
    const size_t rb = (size_t)(b * TP) * D + ch;
    const float kk0 = a.in[I_OKK][(size_t)j * D + ch], kk1 = a.in[I_OKK][(size_t)j * D + ch + 1], ka0 = a.in[I_OKA][(size_t)j * D + ch], ka1 = a.in[I_OKA][(size_t)j * D + ch + 1];
    const float rk0 = a.in[I_ORK][(size_t)j * D + ch], rk1 = a.in[I_ORK][(size_t)j * D + ch + 1];
    const float gg0 = a.in[I_OGNG][(size_t)j * D + ch], gg1 = a.in[I_OGNG][(size_t)j * D + ch + 1], gb0 = a.in[I_OGNB][(size_t)j * D + ch], gb1 = a.in[I_OGNB][(size_t)j * D + ch + 1];
    float s[8], z[8];
#pragma unroll
    for (int jj = 0; jj < 8; ++jj) { s[jj] = 0.f; z[jj] = 0.f; }
    unsigned pr_, pk_, pv_, pa_, pg_, pvf_ = 0u, pvg_ = 0u; float pw0, pw1;
#define RW_PREFETCH(t0) do { const unsigned o = (unsigned)(((t0) + st) * D); const bool ok = (t0) + st < TP; \
        pr_ = ok ? *(const unsigned*)(R + rb + o) : 0u; pk_ = ok ? *(const unsigned*)(Kb + rb + o) : 0u; pv_ = ok ? *(const unsigned*)(Vb + rb + o) : 0u; \
        pa_ = ok ? *(const unsigned*)(AG + rb + o) : 0u; pg_ = ok ? *(const unsigned*)(GG + rb + o) : 0u; \
        if (j == 1) { pvf_ = ok ? *(const unsigned*)(VF + rb + o) : 0u; pvg_ = ok ? *(const unsigned*)(VG + rb + o) : 0u; } \
        pw0 = ok ? WD[rb + o] : 1.f; pw1 = ok ? WD[rb + o + 1] : 1.f; } while (0)
    RW_PREFETCH(0);
    const int ngroups = (TP + RW_TG - 1) / RW_TG;
#pragma unroll 1
    for (int g = 0; g < ngroups; ++g) {
        const int t0 = g * RW_TG;
        LAS float* buf = (LAS float*)(c.lds + (g & 1) * RW_BUF);
        LAS float* ys = (LAS float*)(c.lds + RW_Y); LAS float* bon = (LAS float*)(c.lds + RW_BON);
        float gate0, gate1;
        { const float r0 = __uint_as_float(pr_ << 16), r1 = __uint_as_float(pr_ & 0xffff0000u), k0 = __uint_as_float(pk_ << 16), k1 = __uint_as_float(pk_ & 0xffff0000u);
          float v0 = __uint_as_float(pv_ << 16), v1 = __uint_as_float(pv_ & 0xffff0000u);
          const float a0 = __uint_as_float(pa_ << 16), a1 = __uint_as_float(pa_ & 0xffff0000u);
          gate0 = __uint_as_float(pg_ << 16); gate1 = __uint_as_float(pg_ & 0xffff0000u);
          if (j == 1) { const float f0 = __uint_as_float(pvf_ << 16), f1 = __uint_as_float(pvf_ & 0xffff0000u); v0 = v0 + (f0 - v0) * __uint_as_float(pvg_ << 16); v1 = v1 + (f1 - v1) * __uint_as_float(pvg_ & 0xffff0000u); }
          float q0 = k0 * kk0, q1 = k1 * kk1; const float ss = red32(q0 * q0 + q1 * q1); const float rn = __builtin_amdgcn_rsqf(fmaxf(ss, 1e-24f)); q0 *= rn; q1 *= rn;
          const float m0 = k0 * (1.f + (a0 - 1.f) * ka0), m1 = k1 * (1.f + (a1 - 1.f) * ka1);
          const float bs = red32(r0 * m0 * rk0 + r1 * m1 * rk1);
          const int o = st * 64 + sc;
          *(LAS f32x2_t*)(buf + o) = (f32x2_t){r0, r1}; *(LAS f32x2_t*)(buf + RW_TG * 64 + o) = (f32x2_t){pw0, pw1}; *(LAS f32x2_t*)(buf + 2 * RW_TG * 64 + o) = (f32x2_t){m0, m1};
          *(LAS f32x2_t*)(buf + 3 * RW_TG * 64 + o) = (f32x2_t){v0, v1}; *(LAS f32x2_t*)(buf + 4 * RW_TG * 64 + o) = (f32x2_t){-q0, -q1}; *(LAS f32x2_t*)(buf + 5 * RW_TG * 64 + o) = (f32x2_t){q0 * a0, q1 * a1};
          __syncthreads();
          if ((c.tid & 31) == 0) bon[st] = bs; }
        if (g + 1 < ngroups) RW_PREFETCH(t0 + RW_TG);
        const int nt = (TP - t0) < RW_TG ? (TP - t0) : RW_TG;
        if (c.tid < 256) {
#pragma unroll 4
        for (int tt = 0; tt < nt; ++tt) {
            const LAS float* p = buf + tt * 64 + 8 * q;
            const f32x4 ra = *(const LAS f32x4*)(p), rb2 = *(const LAS f32x4*)(p + 4), wa = *(const LAS f32x4*)(p + RW_TG * 64), wb = *(const LAS f32x4*)(p + RW_TG * 64 + 4);
            const f32x4 ka = *(const LAS f32x4*)(p + 2 * RW_TG * 64), kb2 = *(const LAS f32x4*)(p + 2 * RW_TG * 64 + 4), aa = *(const LAS f32x4*)(p + 4 * RW_TG * 64), ab = *(const LAS f32x4*)(p + 4 * RW_TG * 64 + 4);
            const f32x4 ba = *(const LAS f32x4*)(p + 5 * RW_TG * 64), bb = *(const LAS f32x4*)(p + 5 * RW_TG * 64 + 4);
            const float vi = buf[3 * RW_TG * 64 + tt * 64 + i], vj = buf[3 * RW_TG * 64 + tt * 64 + i + 32];
            const float sa = red8((s[0] * aa[0] + s[1] * aa[1]) + (s[2] * aa[2] + s[3] * aa[3]) + ((s[4] * ab[0] + s[5] * ab[1]) + (s[6] * ab[2] + s[7] * ab[3])));
            const float za = red8((z[0] * aa[0] + z[1] * aa[1]) + (z[2] * aa[2] + z[3] * aa[3]) + ((z[4] * ab[0] + z[5] * ab[1]) + (z[6] * ab[2] + z[7] * ab[3])));
#pragma unroll
            for (int jj = 0; jj < 4; ++jj) { s[jj] = s[jj] * wa[jj] + sa * ba[jj] + vi * ka[jj]; s[4 + jj] = s[4 + jj] * wb[jj] + sa * bb[jj] + vi * kb2[jj];
                z[jj] = z[jj] * wa[jj] + za * ba[jj] + vj * ka[jj]; z[4 + jj] = z[4 + jj] * wb[jj] + za * bb[jj] + vj * kb2[jj]; }
            const float y = red8((s[0] * ra[0] + s[1] * ra[1]) + (s[2] * ra[2] + s[3] * ra[3]) + ((s[4] * rb2[0] + s[5] * rb2[1]) + (s[6] * rb2[2] + s[7] * rb2[3])));
            const float y2 = red8((z[0] * ra[0] + z[1] * ra[1]) + (z[2] * ra[2] + z[3] * ra[3]) + ((z[4] * rb2[0] + z[5] * rb2[1]) + (z[6] * rb2[2] + z[7] * rb2[3])));
            if (q == 0) { ys[tt * 64 + i] = y; ys[tt * 64 + i + 32] = y2; }
        }
        }
        __syncthreads();
        if (t0 + st < TP) {
            const f32x2_t yv = *(const LAS f32x2_t*)(ys + st * 64 + sc), vv = *(const LAS f32x2_t*)(buf + 3 * RW_TG * 64 + st * 64 + sc);
            const float mu = red32(yv.x + yv.y) * (1.f / 64.f); const float d0 = yv.x - mu, d1 = yv.y - mu; const float var = red32(d0 * d0 + d1 * d1) * (1.f / 64.f);
            const float rs = 1.f / sqrtf(var + 64e-5f), bo = bon[st];
            const float o0 = (d0 * rs * gg0 + gb0 + bo * vv.x) * gate0, o1 = (d1 * rs * gg1 + gb1 + bo * vv.y) * gate1;
            *(unsigned*)(O + rb + (unsigned)((t0 + st) * D)) = pk2(o0, o1);
        }
    }
#undef RW_PREFETCH
    if (c.tid < 256) { float* So = c.out + O_RWKVP + ((size_t)(j * BP + b) * 16 + hd) * 4096 + i * 64 + 8 * q;
      *(f32x4*)So = (f32x4){s[0], s[1], s[2], s[3]}; *(f32x4*)(So + 4) = (f32x4){s[4], s[5], s[6], s[7]};
      *(f32x4*)(So + 2048) = (f32x4){z[0], z[1], z[2], z[3]}; *(f32x4*)(So + 2052) = (f32x4){z[4], z[5], z[6], z[7]}; }
    __syncthreads();
}
DEVI void f_rwkv_sample(const Ctx& c, const PArgs& a, int j, int b, int hd) {
    const bf16* R = (const bf16*)(c.ws + WS_R); const bf16* Kb = (const bf16*)(c.ws + WS_K);
    const bf16* VF = (const bf16*)((unsigned char*)c.out + DO_VFIRST); const bf16* Vb = j == 0 ? VF : (const bf16*)(c.ws + WS_V);
    const float* WD = (const float*)(c.ws + WS_WDEC); const bf16* AG = (const bf16*)(c.ws + WS_AG); const bf16* VG = (const bf16*)(c.ws + WS_VG); const bf16* GG = (const bf16*)(c.ws + WS_GG);
    bf16* O = (bf16*)(c.ws + WS_O);
    LAS float* buf = (LAS float*)c.lds;
    const int i = c.tid >> 3, q = c.tid & 7;
    const size_t so = ((size_t)(j * BS + b) * 16 + hd) * 4096 + i * 64 + 8 * q;
    const f32x4 sA = __builtin_nontemporal_load((const f32x4*)(a.in[I_SRWKV] + so)), sB = __builtin_nontemporal_load((const f32x4*)(a.in[I_SRWKV] + so + 4));
    float s[8] = {sA[0], sA[1], sA[2], sA[3], sB[0], sB[1], sB[2], sB[3]};
    float gate = 0.f;
    __syncthreads();
    if (c.tid < 64) { const int ch = hd * 64 + c.tid; const size_t o = (size_t)(MP + b) * D + ch;
        const float r = bf2f(R[o]), k = bf2f(Kb[o]), ag = bf2f(AG[o]), w = WD[o]; float v = bf2f(Vb[o]); gate = bf2f(GG[o]);
        if (j == 1) { const float vf = bf2f(VF[o]); v = v + (vf - v) * bf2f(VG[o]); }
        float kk = k * a.in[I_OKK][(size_t)j * D + ch]; const float ss = wave_sum(kk * kk); kk = kk / sqrtf(fmaxf(ss, 1e-24f));
        const float km = k * (1.f + (ag - 1.f) * a.in[I_OKA][(size_t)j * D + ch]);
        const float bs = wave_sum(r * km * a.in[I_ORK][(size_t)j * D + ch]);
        buf[c.tid] = r; buf[64 + c.tid] = w; buf[128 + c.tid] = km; buf[192 + c.tid] = v; buf[256 + c.tid] = -kk; buf[320 + c.tid] = kk * ag;
        if (c.tid == 0) buf[448] = bs; }
    __syncthreads();
    { float sa = 0.f;
#pragma unroll
      for (int jj = 0; jj < 8; ++jj) sa += s[jj] * buf[256 + 8 * q + jj];
      sa = red8(sa);
      const float vi = buf[192 + i]; float y = 0.f;
#pragma unroll
      for (int jj = 0; jj < 8; ++jj) { const int cj = 8 * q + jj; s[jj] = s[jj] * buf[64 + cj] + sa * buf[320 + cj] + vi * buf[128 + cj]; y += s[jj] * buf[cj]; }
      y = red8(y);
      if (q == 0) buf[384 + i] = y;
      float* Sout = c.out + O_RWKVS + so;
      __builtin_nontemporal_store((f32x4){s[0], s[1], s[2], s[3]}, (f32x4*)Sout); __builtin_nontemporal_store((f32x4){s[4], s[5], s[6], s[7]}, (f32x4*)(Sout + 4)); }
    __syncthreads();
    if (c.tid < 64) { const int ch = hd * 64 + c.tid;
        const float y = buf[384 + c.tid]; const float mu = wave_sum(y) * (1.f / 64.f); const float dy = y - mu; const float var = wave_sum(dy * dy) * (1.f / 64.f);
        float o = dy / sqrtf(var + 64e-5f) * a.in[I_OGNG][(size_t)j * D + ch] + a.in[I_OGNB][(size_t)j * D + ch];
        o = (o + buf[448] * buf[192 + c.tid]) * gate;
        O[(size_t)(MP + b) * D + ch] = f2bf(o); }
}
DEVI void f_odd_scan(const Ctx& c, const PArgs& a, int li) {
    const int j = li >> 1;
    if (c.bid < 128) f_rwkv_prompt(c, a, j, c.bid >> 4, c.bid & 15);
    else for (int u = c.bid - 128; u < 2048; u += c.G - 128) f_rwkv_sample(c, a, j, u >> 4, u & 15);
}

constexpr size_t DO_BON = 54 * MiB;
DEVI float red16(float x) { x += DPP_F(x, 0xB1); x += DPP_F(x, 0x4E); x += DPP_F(x, 0x141); x += DPP_F(x, 0x140); return x; }
constexpr int RW2_Y = 2 * RW_BUF, RW2_END = RW2_Y + 2 * RW_TG * 32 * 4;
DEVI void f_rwkv_prompt2(const Ctx& c, const PArgs& a, int j, int b, int hd, int half) {
    const bf16* R = (const bf16*)(c.ws + WS_R); const bf16* Kb = (const bf16*)(c.ws + WS_K);
    const bf16* VF = (const bf16*)((unsigned char*)c.out + DO_VFIRST); const bf16* Vb = j == 0 ? VF : (const bf16*)(c.ws + WS_V);
    const float* WD = (const float*)(c.ws + WS_WDEC); const bf16* AG = (const bf16*)(c.ws + WS_AG); const bf16* VG = (const bf16*)(c.ws + WS_VG);
    bf16* O = (bf16*)(c.ws + WS_O); float* BON = (float*)((unsigned char*)c.out + DO_BON);
    const int il = c.tid >> 4, q = c.tid & 15;
    const int st = c.tid >> 5, sc = (c.tid & 31) * 2, ch = hd * 64 + sc;
    const size_t rb = (size_t)(b * TP) * D + ch;
    const float kk0 = a.in[I_OKK][(size_t)j * D + ch], kk1 = a.in[I_OKK][(size_t)j * D + ch + 1], ka0 = a.in[I_OKA][(size_t)j * D + ch], ka1 = a.in[I_OKA][(size_t)j * D + ch + 1];
    const float rk0 = a.in[I_ORK][(size_t)j * D + ch], rk1 = a.in[I_ORK][(size_t)j * D + ch + 1];
    f32x4 s = (f32x4){0.f, 0.f, 0.f, 0.f};
    unsigned pr_, pk_, pv_, pa_, pvf_ = 0u, pvg_ = 0u; f32x2_t pw_;
#define RW2_PREFETCH(t0) do { const unsigned o = (unsigned)(((t0) + st) * D); const bool ok = (t0) + st < TP; \
        pr_ = ok ? *(const unsigned*)(R + rb + o) : 0u; pk_ = ok ? *(const unsigned*)(Kb + rb + o) : 0u; pv_ = ok ? *(const unsigned*)(Vb + rb + o) : 0u; pa_ = ok ? *(const unsigned*)(AG + rb + o) : 0u; \
        if (j == 1) { pvf_ = ok ? *(const unsigned*)(VF + rb + o) : 0u; pvg_ = ok ? *(const unsigned*)(VG + rb + o) : 0u; } \
        pw_ = ok ? *(const f32x2_t*)(WD + rb + o) : (f32x2_t){1.f, 1.f}; } while (0)
    RW2_PREFETCH(0);
    const int ngroups = (TP + RW_TG - 1) / RW_TG;
    LAS float* ys = (LAS float*)(c.lds + RW2_Y);
#pragma unroll 1
    for (int g = 0; g < ngroups; ++g) {
        const int t0 = g * RW_TG; const int nt = (TP - t0) < RW_TG ? (TP - t0) : RW_TG;
        LAS float* buf = (LAS float*)(c.lds + (g & 1) * RW_BUF);
        { const float r0 = __uint_as_float(pr_ << 16), r1 = __uint_as_float(pr_ & 0xffff0000u), k0 = __uint_as_float(pk_ << 16), k1 = __uint_as_float(pk_ & 0xffff0000u);
          float v0 = __uint_as_float(pv_ << 16), v1 = __uint_as_float(pv_ & 0xffff0000u);
          const float a0 = __uint_as_float(pa_ << 16), a1 = __uint_as_float(pa_ & 0xffff0000u);
          if (j == 1) { const float f0 = __uint_as_float(pvf_ << 16), f1 = __uint_as_float(pvf_ & 0xffff0000u); v0 = v0 + (f0 - v0) * __uint_as_float(pvg_ << 16); v1 = v1 + (f1 - v1) * __uint_as_float(pvg_ & 0xffff0000u); }
          float q0 = k0 * kk0, q1 = k1 * kk1; const float ss = red32(q0 * q0 + q1 * q1); const float rn = __builtin_amdgcn_rsqf(fmaxf(ss, 1e-24f)); q0 *= rn; q1 *= rn;
          const float m0 = k0 * (1.f + (a0 - 1.f) * ka0), m1 = k1 * (1.f + (a1 - 1.f) * ka1);
          const float bs = red32(r0 * m0 * rk0 + r1 * m1 * rk1);
          const int o = st * 64 + sc;
          *(LAS f32x2_t*)(buf + o) = (f32x2_t){r0, r1}; *(LAS f32x2_t*)(buf + RW_TG * 64 + o) = pw_; *(LAS f32x2_t*)(buf + 2 * RW_TG * 64 + o) = (f32x2_t){m0, m1};
          *(LAS f32x2_t*)(buf + 3 * RW_TG * 64 + o) = (f32x2_t){v0, v1}; *(LAS f32x2_t*)(buf + 4 * RW_TG * 64 + o) = (f32x2_t){-q0, -q1}; *(LAS f32x2_t*)(buf + 5 * RW_TG * 64 + o) = (f32x2_t){q0 * a0, q1 * a1};
          if (half == 0 && (c.tid & 31) == 0 && t0 + st < TP) BON[(size_t)(b * TP + t0 + st) * 16 + hd] = bs; }
        __syncthreads();
        if (g + 1 < ngroups) RW2_PREFETCH(t0 + RW_TG);
        {
            const LAS float* p = buf + 4 * q; const LAS float* pv = buf + 3 * RW_TG * 64 + 32 * half + il;
            f32x4 r4 = *(const LAS f32x4*)(p), w4 = *(const LAS f32x4*)(p + RW_TG * 64), k4 = *(const LAS f32x4*)(p + 2 * RW_TG * 64), a4 = *(const LAS f32x4*)(p + 4 * RW_TG * 64), b4 = *(const LAS f32x4*)(p + 5 * RW_TG * 64);
            float vi = pv[0];
#pragma unroll 2
            for (int tt = 0; tt < nt; ++tt) {
                const int tn = tt + 1 < nt ? tt + 1 : tt;
                const f32x4 nr4 = *(const LAS f32x4*)(p + tn * 64), nw4 = *(const LAS f32x4*)(p + RW_TG * 64 + tn * 64), nk4 = *(const LAS f32x4*)(p + 2 * RW_TG * 64 + tn * 64),
                            na4 = *(const LAS f32x4*)(p + 4 * RW_TG * 64 + tn * 64), nb4 = *(const LAS f32x4*)(p + 5 * RW_TG * 64 + tn * 64);
                const float nvi = pv[tn * 64];
                const float sa = red16((s[0] * a4[0] + s[1] * a4[1]) + (s[2] * a4[2] + s[3] * a4[3]));
                s = s * w4 + b4 * sa + k4 * vi;
                const float y = red16((s[0] * r4[0] + s[1] * r4[1]) + (s[2] * r4[2] + s[3] * r4[3]));
                if (q == 0) ys[tt * 32 + il] = y;
                r4 = nr4; w4 = nw4; k4 = nk4; a4 = na4; b4 = nb4; vi = nvi;
            }
        }
        __syncthreads();
        { const int tt = c.tid >> 5, cc = c.tid & 31; if (tt < nt) O[(size_t)(b * TP + t0 + tt) * D + hd * 64 + 32 * half + cc] = f2bf(ys[tt * 32 + cc]); }
    }
#undef RW2_PREFETCH
    { float* So = c.out + O_RWKVP + ((size_t)(j * BP + b) * 16 + hd) * 4096 + (32 * half + il) * 64 + 4 * q; *(f32x4*)So = s; }
    __syncthreads();
}
DEVI void f_rwkv_post(const Ctx& c, const PArgs& a, int li) {
    const int j = li >> 1;
    bf16* O = (bf16*)(c.ws + WS_O); const bf16* GG = (const bf16*)(c.ws + WS_GG); const bf16* VG = (const bf16*)(c.ws + WS_VG);
    const bf16* VF = (const bf16*)((unsigned char*)c.out + DO_VFIRST); const bf16* Vb = j == 0 ? VF : (const bf16*)(c.ws + WS_V); const float* BON = (const float*)((unsigned char*)c.out + DO_BON);
    const int pc = c.tid & 127, ch = pc * 8;
    const f32x4 g0 = *(const f32x4*)(a.in[I_OGNG] + (size_t)j * D + ch), g1 = *(const f32x4*)(a.in[I_OGNG] + (size_t)j * D + ch + 4), b0 = *(const f32x4*)(a.in[I_OGNB] + (size_t)j * D + ch), b1 = *(const f32x4*)(a.in[I_OGNB] + (size_t)j * D + ch + 4);
    for (int row = c.bid * 4 + (c.tid >> 7); row < MP; row += c.G * 4) {
        const size_t o = (size_t)row * D + ch;
        const u32x4 yv = *(const u32x4*)(O + o), vv = *(const u32x4*)(Vb + o), gv = *(const u32x4*)(GG + o);
        float y[8], v[8], gt[8];
#pragma unroll
        for (int e = 0; e < 4; ++e) { y[2 * e] = __uint_as_float(yv[e] << 16); y[2 * e + 1] = __uint_as_float(yv[e] & 0xffff0000u); v[2 * e] = __uint_as_float(vv[e] << 16); v[2 * e + 1] = __uint_as_float(vv[e] & 0xffff0000u);
            gt[2 * e] = __uint_as_float(gv[e] << 16); gt[2 * e + 1] = __uint_as_float(gv[e] & 0xffff0000u); }
        if (j == 1) { const u32x4 fv = *(const u32x4*)(VF + o), mv = *(const u32x4*)(VG + o);
#pragma unroll
            for (int e = 0; e < 4; ++e) { const float f0 = __uint_as_float(fv[e] << 16), f1 = __uint_as_float(fv[e] & 0xffff0000u), m0 = __uint_as_float(mv[e] << 16), m1 = __uint_as_float(mv[e] & 0xffff0000u);
                v[2 * e] = v[2 * e] + (f0 - v[2 * e]) * m0; v[2 * e + 1] = v[2 * e + 1] + (f1 - v[2 * e + 1]) * m1; } }
        float s1 = 0.f;
#pragma unroll
        for (int e = 0; e < 8; ++e) s1 += y[e];
        const float mu = red8(s1) * (1.f / 64.f); float s2 = 0.f;
#pragma unroll
        for (int e = 0; e < 8; ++e) { y[e] -= mu; s2 += y[e] * y[e]; }
        const float rs = __builtin_amdgcn_rsqf(red8(s2) * (1.f / 64.f) + 64e-5f), bo = BON[(size_t)row * 16 + (pc >> 3)];
        u32x4 out;
#pragma unroll
        for (int e = 0; e < 4; ++e) { const float gg0 = e < 2 ? g0[2 * e] : g1[2 * e - 4], gg1 = e < 2 ? g0[2 * e + 1] : g1[2 * e - 3], bb0 = e < 2 ? b0[2 * e] : b1[2 * e - 4], bb1 = e < 2 ? b0[2 * e + 1] : b1[2 * e - 3];
            out[e] = pk2((y[2 * e] * rs * gg0 + bb0 + bo * v[2 * e]) * gt[2 * e], (y[2 * e + 1] * rs * gg1 + bb1 + bo * v[2 * e + 1]) * gt[2 * e + 1]); }
        *(u32x4*)(O + o) = out;
    }
}
DEVI void f_odd_scan2(const Ctx& c, const PArgs& a, int li) {
    const int j = li >> 1;
    for (int u = c.bid; u < 256; u += c.G) f_rwkv_prompt2(c, a, j, u >> 5, (u >> 1) & 15, u & 1);
    for (int u = c.bid; u < 2048; u += c.G) f_rwkv_sample(c, a, j, u >> 4, u & 15);
}

constexpr int R_AF = 0, R_RF = 2048, R_BKF = 4096, R_VF = 8192, R_GF = 10240, R_RECA = 12288, R_RECB = 13312, R_PL = 14336, R_BON = 14592, RW3_REC = 14848;
constexpr int RW3_RING = 0, RW3_SCR = 8 * RW3_REC, RW3_SCRW = 5120, RW3_STAT = RW3_SCR + 4 * RW3_SCRW, RW3_END = RW3_STAT + 4096;
static_assert(RW3_END <= RING_BYTES, "rwkv3 lds");
#define DPP_RM(v, ctrl, rm) __builtin_bit_cast(float, __builtin_amdgcn_update_dpp(0, __builtin_bit_cast(int, (v)), (ctrl), (rm), 0xF, false))
DEVI float wsum64(float x) { x = red16(x); x += DPP_RM(x, 0x142, 0xA); x += DPP_RM(x, 0x143, 0xC); return __builtin_bit_cast(float, __builtin_amdgcn_readlane(__builtin_bit_cast(int, x), 63)); }
#define LWAIT() asm volatile("s_waitcnt lgkmcnt(0)" ::: "memory")
DEVI bf16x8_t frag_lohi(u32x2 lo, u32x2 hi) { u32x4 t; t.x = lo.x; t.y = lo.y; t.z = hi.x; t.w = hi.y; return __builtin_bit_cast(bf16x8_t, t); }
struct RwRaw { u32x2 r[4], k[4], v[4], a[4], g[4], f[4], m[4]; f32x4 w[4]; };
DEVI void rw3_load(const Ctx& c, RwRaw& q, int j, int b, int hd, int ck, int parts) {
    const bf16* R = (const bf16*)(c.ws + WS_R); const bf16* Kb = (const bf16*)(c.ws + WS_K);
    const bf16* VF_ = (const bf16*)((unsigned char*)c.out + DO_VFIRST); const bf16* Vb = j == 0 ? VF_ : (const bf16*)(c.ws + WS_V);
    const float* WD = (const float*)(c.ws + WS_WDEC); const bf16* AG = (const bf16*)(c.ws + WS_AG); const bf16* VG = (const bf16*)(c.ws + WS_VG); const bf16* GG = (const bf16*)(c.ws + WS_GG);
    const size_t rb = (size_t)(b * TP + ck * 16 + (c.lane & 15)) * D + hd * 64 + 4 * (c.lane >> 4);
#pragma unroll
    for (int n = 0; n < 4; ++n) { const size_t o = rb + 16 * n;
        if (parts & 4) { q.r[n] = *(const u32x2*)(R + o); q.k[n] = *(const u32x2*)(Kb + o); q.a[n] = *(const u32x2*)(AG + o); }
        if (parts & 2) q.w[n] = *(const f32x4*)(WD + o);
        if (parts & 1) { q.v[n] = *(const u32x2*)(Vb + o); q.g[n] = *(const u32x2*)(GG + o);
            if (j == 1) { q.f[n] = *(const u32x2*)(VF_ + o); q.m[n] = *(const u32x2*)(VG + o); } else { q.f[n] = (u32x2){0u, 0u}; q.m[n] = (u32x2){0u, 0u}; } } }
}
DEVI float bfe(u32x2 p, int e) { const unsigned u = e < 2 ? p.x : p.y; return (e & 1) ? __uint_as_float(u & 0xffff0000u) : __uint_as_float(u << 16); }
DEVI float fq_sum(float s) {
    u32x2 r = __builtin_amdgcn_permlane16_swap(__float_as_uint(s), __float_as_uint(s), false, false); s = __uint_as_float(r.x) + __uint_as_float(r.y);
    r = __builtin_amdgcn_permlane32_swap(__float_as_uint(s), __float_as_uint(s), false, false); return __uint_as_float(r.x) + __uint_as_float(r.y);
}
template <int S> DEVI float dpp_shr1(float x) { return __builtin_bit_cast(float, __builtin_amdgcn_update_dpp(0x3f800000, __builtin_bit_cast(int, x), 0x110 + S, 0xF, 0xF, false)); }
struct RwCoef { float kk[4][4], ka[4][4], rk[4][4]; };
#ifndef PREP_PRIO
#define PREP_PRIO 0
#endif
#ifndef CHAIN_PRIO
#define CHAIN_PRIO 3
#endif
constexpr int RW3_CF = 3072;
DEVI void rw3_prep(const Ctx& c, int j, int b, int hd, int ckn, RwRaw& q, LAS unsigned char* rec, LAS unsigned char* scr) {
    const int lane = c.lane, fr = lane & 15, fq = lane >> 4, t = fr;
    { const int lv = ((t >> 2) * 16 + 4 * fq) * 8 + (t & 3) * 2;
#pragma unroll
      for (int n = 0; n < 4; ++n)
#pragma unroll
        for (int e = 0; e < 4; ++e) { float v = bfe(q.v[n], e); if (j == 1) v = v + (bfe(q.f[n], e) - v) * bfe(q.m[n], e);
            *(LAS bf16*)(rec + R_VF + n * 512 + lv + e * 8) = f2bf(v);
            const unsigned gw = e < 2 ? q.g[n].x : q.g[n].y;
            *(LAS unsigned short*)(rec + R_GF + n * 512 + lv + e * 8) = (unsigned short)((e & 1) ? (gw >> 16) : gw); } }
    if (ckn >= 0) rw3_load(c, q, j, b, hd, ckn, 1);
    RwCoef cf;
#pragma unroll
    for (int n = 0; n < 4; ++n) { const f32x4 x0 = *(const LAS f32x4*)(scr + RW3_CF + (fq * 12 + n) * 16), x1 = *(const LAS f32x4*)(scr + RW3_CF + (fq * 12 + 4 + n) * 16), x2 = *(const LAS f32x4*)(scr + RW3_CF + (fq * 12 + 8 + n) * 16);
#pragma unroll
        for (int e = 0; e < 4; ++e) { cf.kk[n][e] = x0[e]; cf.ka[n][e] = x1[e]; cf.rk[n][e] = x2[e]; } }
    float ss = 0.f, bon = 0.f, P[4][4];
#pragma unroll
    for (int n = 0; n < 4; ++n)
#pragma unroll
        for (int e = 0; e < 4; ++e) { const float k = bfe(q.k[n], e), r = bfe(q.r[n], e), ag = bfe(q.a[n], e);
            const float kn = k * cf.kk[n][e]; ss += kn * kn;
            bon += r * (k * (1.f + (ag - 1.f) * cf.ka[n][e])) * cf.rk[n][e];
            P[n][e] = q.w[n][e]; }
    if (ckn >= 0) rw3_load(c, q, j, b, hd, ckn, 2);
    ss = fq_sum(ss); bon = fq_sum(bon);
    const float inv = __builtin_amdgcn_rsqf(fmaxf(ss, 1e-24f));
#pragma unroll
    for (int n = 0; n < 4; ++n)
#pragma unroll
        for (int e = 0; e < 4; ++e) { float x = P[n][e]; x = x * dpp_shr1<1>(x); x = x * dpp_shr1<2>(x); x = x * dpp_shr1<4>(x); x = x * dpp_shr1<8>(x); P[n][e] = x; }
    if (fq == 0) *(LAS float*)(rec + R_BON + t * 4) = bon;
    if (t == 15) {
#pragma unroll
        for (int n = 0; n < 4; ++n) *(LAS f32x4*)(rec + R_PL + (16 * n + 4 * fq) * 4) = (f32x4){P[n][0], P[n][1], P[n][2], P[n][3]}; }
    u32x4 afw[2], rfw[2], bfw[2], kfw[2];
#pragma unroll
    for (int kk = 0; kk < 2; ++kk) {
        float av[8], rv[8], bv[8], kv[8];
#pragma unroll
        for (int jj = 0; jj < 8; ++jj) { const int n = 2 * kk + (jj >> 2), e = jj & 3;
            const float k = bfe(q.k[n], e), r = bfe(q.r[n], e), ag = bfe(q.a[n], e);
            const float kn = k * cf.kk[n][e] * inv, km = k * (1.f + (ag - 1.f) * cf.ka[n][e]);
            const float Pn = P[n][e], Pm1 = dpp_shr1<1>(Pn), ip = rcpf_(Pn);
            av[jj] = -kn * Pm1; rv[jj] = r * Pn; bv[jj] = kn * ag * ip; kv[jj] = km * ip; }
        afw[kk] = (u32x4){pk2(av[0], av[1]), pk2(av[2], av[3]), pk2(av[4], av[5]), pk2(av[6], av[7])}; rfw[kk] = (u32x4){pk2(rv[0], rv[1]), pk2(rv[2], rv[3]), pk2(rv[4], rv[5]), pk2(rv[6], rv[7])};
        bfw[kk] = (u32x4){pk2(bv[0], bv[1]), pk2(bv[2], bv[3]), pk2(bv[4], bv[5]), pk2(bv[6], bv[7])}; kfw[kk] = (u32x4){pk2(kv[0], kv[1]), pk2(kv[2], kv[3]), pk2(kv[4], kv[5]), pk2(kv[6], kv[7])};
        *(LAS u32x4*)(rec + R_AF + (kk * 64 + lane) * 16) = afw[kk]; *(LAS u32x4*)(rec + R_RF + (kk * 64 + lane) * 16) = rfw[kk];
    }
    { const int lb = ((t >> 2) * 16 + 4 * fq) * 16 + (t & 3) * 2;
#pragma unroll
      for (int n = 0; n < 4; ++n)
#pragma unroll
        for (int e = 0; e < 4; ++e) { const int kk = n >> 1, jj = 4 * (n & 1) + e; const unsigned bw = bfw[kk][jj >> 1], kw = kfw[kk][jj >> 1];
            *(LAS unsigned short*)(rec + R_BKF + n * 1024 + lb + e * 16) = (unsigned short)((jj & 1) ? (bw >> 16) : bw);
            *(LAS unsigned short*)(rec + R_BKF + n * 1024 + lb + e * 16 + 8) = (unsigned short)((jj & 1) ? (kw >> 16) : kw);
        } }
    if (ckn >= 0) rw3_load(c, q, j, b, hd, ckn, 4);
    f32x4 Aab = (f32x4){0.f, 0.f, 0.f, 0.f}, Aak = Aab, Arb = Aab, Ark = Aab;
#pragma unroll
    for (int kk = 0; kk < 2; ++kk) {
        const bf16x8_t af = __builtin_bit_cast(bf16x8_t, afw[kk]), rf = __builtin_bit_cast(bf16x8_t, rfw[kk]), bf_ = __builtin_bit_cast(bf16x8_t, bfw[kk]), kf = __builtin_bit_cast(bf16x8_t, kfw[kk]);
        Aab = __builtin_amdgcn_mfma_f32_16x16x32_bf16(af, bf_, Aab, 0, 0, 0); Aak = __builtin_amdgcn_mfma_f32_16x16x32_bf16(af, kf, Aak, 0, 0, 0);
        Arb = __builtin_amdgcn_mfma_f32_16x16x32_bf16(rf, bf_, Arb, 0, 0, 0); Ark = __builtin_amdgcn_mfma_f32_16x16x32_bf16(rf, kf, Ark, 0, 0, 0); }
#pragma unroll
    for (int r = 0; r < 4; ++r) { const int t = 4 * fq + r;
        *(LAS float*)(scr + (t * 16 + fr) * 4) = t > fr ? Aab[r] : 0.f;
        *(LAS bf16*)(scr + 1024 + (t * 16 + fr) * 2) = f2bf(t > fr ? Aak[r] : 0.f);
        *(LAS bf16*)(scr + 1536 + (t * 16 + fr) * 2) = f2bf(t >= fr ? Arb[r] : 0.f);
        *(LAS bf16*)(scr + 2048 + (t * 16 + fr) * 2) = f2bf(t >= fr ? Ark[r] : 0.f); }
    LWAIT();
    float Tc[16];
#pragma unroll
    for (int t = 0; t < 16; ++t) {
        float acc = (t == fr) ? 1.f : 0.f, last = 0.f;
#pragma unroll
        for (int u4 = 0; u4 < (t + 3) / 4; ++u4) { const f32x4 ar = *(const LAS f32x4*)(scr + (t * 16 + 4 * u4) * 4);
#pragma unroll
            for (int e = 0; e < 4; ++e) { if (4 * u4 + e < t - 1) acc += ar[e] * Tc[4 * u4 + e]; if (4 * u4 + e == t - 1) last = ar[e]; } }
        Tc[t] = t > 0 ? acc + last * Tc[t > 0 ? t - 1 : 0] : acc; }
    if (fq == 0) {
#pragma unroll
        for (int t = 0; t < 16; ++t) *(LAS bf16*)(scr + 2560 + (t * 16 + fr) * 2) = f2bf(Tc[t]); }
    LWAIT();
    { const u32x2 ak = *(const LAS u32x2*)(scr + 1024 + (fr * 16 + 4 * fq) * 2), tt = *(const LAS u32x2*)(scr + 2560 + (fr * 16 + 4 * fq) * 2);
      const u32x2 rbv = *(const LAS u32x2*)(scr + 1536 + (fr * 16 + 4 * fq) * 2), rkv = *(const LAS u32x2*)(scr + 2048 + (fr * 16 + 4 * fq) * 2);
      *(LAS u32x4*)(rec + R_RECA + lane * 16) = (u32x4){ak.x, ak.y, tt.x, tt.y}; *(LAS u32x4*)(rec + R_RECB + lane * 16) = (u32x4){rbv.x, rbv.y, rkv.x, rkv.y}; }
    LWAIT();
}
DEVI void f_rwkv_chunked(const Ctx& c, const PArgs& a, int j, int b, int hd) {
    bf16* O = (bf16*)(c.ws + WS_O);
    const int w = c.wave, lane = c.lane, fr = lane & 15, fq = lane >> 4;
    constexpr int NCK = TP / 16, NGR = (NCK + 3) / 4;
    __syncthreads();
    if (w >= 4) {
        __builtin_amdgcn_s_setprio(PREP_PRIO);
        { LAS unsigned char* scr = c.lds + RW3_SCR + (w - 4) * RW3_SCRW;
          if (fr < 12) { const int n = fr & 3, which = fr >> 2; const size_t o = (size_t)j * D + hd * 64 + 16 * n + 4 * fq;
              const float* p0 = a.in[I_OKK]; const float* p1 = a.in[I_OKA]; const float* p2 = a.in[I_ORK];
              *(LAS f32x4*)(scr + RW3_CF + (fq * 12 + which * 4 + n) * 16) = *(const f32x4*)((which == 0 ? p0 : (which == 1 ? p1 : p2)) + o); }
          LWAIT(); }
        RwRaw q;
        rw3_load(c, q, j, b, hd, w - 4, 7);
        rw3_prep(c, j, b, hd, w, q, c.lds + RW3_RING + (w - 4) * RW3_REC, c.lds + RW3_SCR + (w - 4) * RW3_SCRW);
        __syncthreads();
#pragma unroll 1
        for (int g = 0; g < NGR; ++g) {
            const int ck = 4 * (g + 1) + (w - 4);
            if (ck < NCK) rw3_prep(c, j, b, hd, ck + 4 < NCK ? ck + 4 : -1, q, c.lds + RW3_RING + (((g + 1) & 1) * 4 + (w - 4)) * RW3_REC, c.lds + RW3_SCR + (w - 4) * RW3_SCRW);
            __syncthreads();
        }
    __builtin_amdgcn_s_setprio(0);
    } else {
        __builtin_amdgcn_s_setprio(CHAIN_PRIO);
        f32x4 G[4];
#pragma unroll
        for (int jb = 0; jb < 4; ++jb) G[jb] = (f32x4){0.f, 0.f, 0.f, 0.f};
        const int ch = hd * 64 + 16 * w + fr;
        const float gng = a.in[I_OGNG][(size_t)j * D + ch], gnb = a.in[I_OGNB][(size_t)j * D + ch];
        __syncthreads();
#pragma unroll 1
        for (int g = 0; g < NGR; ++g) {
            const int nck = (NCK - 4 * g) < 4 ? (NCK - 4 * g) : 4;
            f32x4 yk[4]; u32x2 vk[4], gk[4]; f32x4 bk[4];
            LAS float* stat = (LAS float*)(c.lds + RW3_STAT + (g & 1) * 2048);
#pragma unroll
            for (int q = 0; q < 4; ++q) {
                if (q < nck) {
                    const LAS unsigned char* rec = c.lds + RW3_RING + ((g & 1) * 4 + q) * RW3_REC;
                    bf16x8_t gb[2];
#pragma unroll
                    for (int kk = 0; kk < 2; ++kk) { u32x4 t; t.x = pk2(G[2 * kk][0], G[2 * kk][1]); t.y = pk2(G[2 * kk][2], G[2 * kk][3]); t.z = pk2(G[2 * kk + 1][0], G[2 * kk + 1][1]); t.w = pk2(G[2 * kk + 1][2], G[2 * kk + 1][3]); gb[kk] = __builtin_bit_cast(bf16x8_t, t); }
                    const u32x2 vf = *(const LAS u32x2*)(rec + R_VF + (w * 64 + lane) * 8); const u32x4 ra = *(const LAS u32x4*)(rec + R_RECA + lane * 16);
                    vk[q] = vf; gk[q] = *(const LAS u32x2*)(rec + R_GF + (w * 64 + lane) * 8); bk[q] = *(const LAS f32x4*)(rec + R_BON + 16 * fq);
                    const u32x2 z2 = (u32x2){0u, 0u};
                    f32x4 W = __builtin_amdgcn_mfma_f32_16x16x32_bf16(__builtin_bit_cast(bf16x8_t, ra), frag_lohi(vf, z2), (f32x4){0.f, 0.f, 0.f, 0.f}, 0, 0, 0);
                    W = __builtin_amdgcn_mfma_f32_16x16x32_bf16(*(const LAS bf16x8_t*)(rec + R_AF + lane * 16), gb[0], W, 0, 0, 0);
                    W = __builtin_amdgcn_mfma_f32_16x16x32_bf16(*(const LAS bf16x8_t*)(rec + R_AF + (64 + lane) * 16), gb[1], W, 0, 0, 0);
                    const u32x2 wlo = (u32x2){pk2(W[0], W[1]), pk2(W[2], W[3])};
                    const f32x4 U = __builtin_amdgcn_mfma_f32_16x16x32_bf16(frag_lohi((u32x2){ra.z, ra.w}, (u32x2){ra.x, ra.y}), frag_lohi(wlo, z2), (f32x4){0.f, 0.f, 0.f, 0.f}, 0, 0, 0);
                    const bf16x8_t ub = frag_lohi((u32x2){pk2(U[0], U[1]), pk2(U[2], U[3])}, vf);
                    f32x4 Y = __builtin_amdgcn_mfma_f32_16x16x32_bf16(*(const LAS bf16x8_t*)(rec + R_RF + lane * 16), gb[0], (f32x4){0.f, 0.f, 0.f, 0.f}, 0, 0, 0);
                    Y = __builtin_amdgcn_mfma_f32_16x16x32_bf16(*(const LAS bf16x8_t*)(rec + R_RF + (64 + lane) * 16), gb[1], Y, 0, 0, 0);
                    Y = __builtin_amdgcn_mfma_f32_16x16x32_bf16(*(const LAS bf16x8_t*)(rec + R_RECB + lane * 16), ub, Y, 0, 0, 0);
#pragma unroll
                    for (int jb = 0; jb < 4; ++jb) { G[jb] = __builtin_amdgcn_mfma_f32_16x16x32_bf16(*(const LAS bf16x8_t*)(rec + R_BKF + (jb * 64 + lane) * 16), ub, G[jb], 0, 0, 0);
                        G[jb] = G[jb] * *(const LAS f32x4*)(rec + R_PL + (16 * jb + 4 * fq) * 4); }
                    yk[q] = Y;
#pragma unroll
                    for (int r = 0; r < 4; ++r) { const float s1 = red16(Y[r]), s2 = red16(Y[r] * Y[r]); if (fr == 0) *(LAS f32x2_t*)(stat + ((q * 4 + w) * 16 + 4 * fq + r) * 2) = (f32x2_t){s1, s2}; }
                }
            }
            __syncthreads();
#pragma unroll
            for (int q = 0; q < 4; ++q) {
                if (q < nck) {
#pragma unroll
                    for (int r = 0; r < 4; ++r) { const int t = 4 * fq + r; float s1 = 0.f, s2 = 0.f;
#pragma unroll
                        for (int ww = 0; ww < 4; ++ww) { const f32x2_t sv = *(const LAS f32x2_t*)(stat + ((q * 4 + ww) * 16 + t) * 2); s1 += sv.x; s2 += sv.y; }
                        const float mu = s1 * (1.f / 64.f), var = fmaxf(s2 * (1.f / 64.f) - mu * mu, 0.f), rs = __builtin_amdgcn_rsqf(var + 64e-5f);
                        const unsigned vb_ = r < 2 ? vk[q].x : vk[q].y, gb_ = r < 2 ? gk[q].x : gk[q].y;
                        const float v = (r & 1) ? __uint_as_float(vb_ & 0xffff0000u) : __uint_as_float(vb_ << 16), gt = (r & 1) ? __uint_as_float(gb_ & 0xffff0000u) : __uint_as_float(gb_ << 16);
                        const float o = ((yk[q][r] - mu) * rs * gng + gnb + bk[q][r] * v) * gt;
                        O[(size_t)(b * TP + (4 * g + q) * 16 + t) * D + ch] = f2bf(o); }
                }
            }
        }
        float* So = c.out + O_RWKVP + ((size_t)(j * BP + b) * 16 + hd) * 4096 + (size_t)(16 * w + fr) * 64 + 4 * fq;
#pragma unroll
        for (int jb = 0; jb < 4; ++jb) *(f32x4*)(So + 16 * jb) = G[jb];
        __builtin_amdgcn_s_setprio(0);
    }
    __syncthreads();
}
#ifndef SSB
#define SSB 160
#endif
#ifndef SCAN_PART
#define SCAN_PART 3
#endif
DEVI void f_odd_scan3(const Ctx& c, const PArgs& a, int li, int part) {
    const int j = li >> 1;
    if (c.bid < 128) { if (part & 1) f_rwkv_chunked(c, a, j, c.bid >> 4, c.bid & 15); }
    else if ((part & 2) && c.bid >= SSB) for (int u = c.bid - SSB; u < 2048; u += c.G - SSB) f_rwkv_sample(c, a, j, u >> 4, u & 15);
}

template <int CTRL> DEVI float dppz(float x) { return __builtin_bit_cast(float, __builtin_amdgcn_update_dpp(0, __builtin_bit_cast(int, x), CTRL, 0xF, 0xF, true)); }
struct EpiUpAct {
    static constexpr bool PERM = true;
    bf16* U; bf16* ACT; const float* RS; const float* CW; const float* CB; float* FCP;
    DEVI void operator()(const f32x4 (&acc)[2][2][4][2], const pg8::Unit& u, int wr, int wc, int fr, int fq) const {
        const int f0 = u.pn * 128 + wc * 32 + fq * 8;
        f32x4 w0[2], w1[2], w2[2], cb[2];
#pragma unroll
        for (int n = 0; n < 2; ++n) { w0[n] = *(const f32x4*)(CW + f0 + 4 * n); w1[n] = *(const f32x4*)(CW + DFF + f0 + 4 * n); w2[n] = *(const f32x4*)(CW + 2 * DFF + f0 + 4 * n); cb[n] = *(const f32x4*)(CB + f0 + 4 * n); }
        float rsv[2][4];
        { f32x4 rq[2][4];
#pragma unroll
          for (int ai = 0; ai < 2; ++ai)
#pragma unroll
            for (int m = 0; m < 4; ++m) rq[ai][m] = *(const f32x4*)(RS + (size_t)(u.pm * 256 + ai * 128 + wr * 64 + m * 16 + fr) * 16 + 4 * fq);
          asm volatile("" ::: "memory");
#pragma unroll
          for (int ai = 0; ai < 2; ++ai)
#pragma unroll
            for (int m = 0; m < 4; ++m) rsv[ai][m] = row_rstd_fin(rq[ai][m]); }
#pragma unroll
        for (int ai = 0; ai < 2; ++ai) {
            const int rowg = u.pm * 256 + ai * 128 + wr * 64;
            const bool sample = rowg >= MP;
            f32x4 ug[4][2];
            float rs[4];
#pragma unroll
            for (int m = 0; m < 4; ++m) { rs[m] = rsv[ai][m]; ug[m][0] = acc[ai][0][m][0] * rs[m]; ug[m][1] = acc[ai][0][m][1] * rs[m]; }
#pragma unroll
            for (int m = 3; m >= 0; --m) {
                const int row = rowg + m * 16 + fr; const int tt = sample ? 16 : (rowg + m * 16) % TP;
                const f32x4 uv0 = acc[ai][1][m][0] * rs[m], uv1 = acc[ai][1][m][1] * rs[m];
                f32x4 p1[2], p2[2];
#pragma unroll
                for (int n = 0; n < 2; ++n)
#pragma unroll
                    for (int e = 0; e < 4; ++e) {
                        const float cur = ug[m][n][e];
                        float q1 = dppz<0x111>(cur), q2 = dppz<0x112>(cur);
                        if (m > 0) { const float prv = ug[m > 0 ? m - 1 : 0][n][e]; q1 += dppz<0x10F>(prv); q2 += dppz<0x10E>(prv); }
                        p1[n][e] = q1; p2[n][e] = q2;
                        if (tt == 0) { if (fr == 0) p1[n][e] = 0.f; if (fr < 2) p2[n][e] = 0.f; } }
                const bool pending = sample || (m == 0 && fr < 2);
                if (pending || (m == 3 && fr >= 14)) *(u32x4*)(U + (size_t)row * NUP + f0) = pack8(ug[m][0], ug[m][1]);
                if (pending) *(u32x4*)(U + (size_t)row * NUP + DFF + f0) = pack8(uv0, uv1);
                else {
                    f32x4 o0, o1;
#pragma unroll
                    for (int e = 0; e < 4; ++e) { o0[e] = geluf_(cb[0][e] + w2[0][e] * ug[m][0][e] + w1[0][e] * p1[0][e] + w0[0][e] * p2[0][e]) * uv0[e];
                        o1[e] = geluf_(cb[1][e] + w2[1][e] * ug[m][1][e] + w1[1][e] * p1[1][e] + w0[1][e] * p2[1][e]) * uv1[e]; }
                    *(u32x4*)(ACT + (size_t)row * DFF + f0) = pack8(o0, o1);
                    if (tt == TP - 16 && fr >= 14) { float* so = FCP + ((size_t)(row / TP) * 2 + (fr - 14)) * DFF + f0; *(f32x4*)so = ug[m][0]; *(f32x4*)(so + 4) = ug[m][1]; }
                }
            }
        }
    }
};
DEVI void f_ffn_up_act(const Ctx& c, const PArgs& a, int li) {
    pg8::Gemm g{(const bf16*)(c.ws + WS_XB), (const bf16*)(c.ws + WS_WB + WB_WUP + li * SZ_WUP), M, NUP, D, D, 0ull, 0};
    pg8::StaticOrder S; S.init(M, NUP, c.G, c.bid);
    EpiUpAct E{(bf16*)(c.ws + WS_U), (bf16*)(c.ws + WS_ACT), (const float*)(c.ws + WS_RS), a.in[I_FCW] + (size_t)li * 3 * DFF, a.in[I_FCB] + (size_t)li * DFF, c.out + O_FCONVP + (size_t)li * BP * 2 * DFF};
    pg8::gemm_phase<EpiUpAct>(c.lds, c.tid, g, S, E);
}
DEVI void f_ffn_fix(const Ctx& c, const PArgs& a, int li) {
    const bf16* U = (const bf16*)(c.ws + WS_U); bf16* ACT = (bf16*)(c.ws + WS_ACT);
    const float* CW = a.in[I_FCW] + (size_t)li * 3 * DFF; const float* CB = a.in[I_FCB] + (size_t)li * DFF;
    constexpr int NPC = DFF / 8, NROW = (MP / 64) * 2 + BS, NITEM = NPC * NROW;
    for (int it = c.bid * NT + c.tid; it < NITEM; it += c.G * NT) {
        const int ri = it / NPC, pc = it - ri * NPC, col = pc * 8;
        const int row = ri < (MP / 64) * 2 ? (ri >> 1) * 64 + (ri & 1) : MP + (ri - (MP / 64) * 2);
        const u32x4 ug = *(const u32x4*)(U + (size_t)row * NUP + col), uv = *(const u32x4*)(U + (size_t)row * NUP + DFF + col);
        float f1[8], f2[8];
        if (row < MP) { const int t = row % TP; u32x4 p1 = (u32x4){0u, 0u, 0u, 0u}, p2 = p1;
            if (t >= 1) p1 = *(const u32x4*)(U + (size_t)(row - 1) * NUP + col); if (t >= 2) p2 = *(const u32x4*)(U + (size_t)(row - 2) * NUP + col);
#pragma unroll
            for (int e = 0; e < 4; ++e) { f1[2 * e] = __uint_as_float(p1[e] << 16); f1[2 * e + 1] = __uint_as_float(p1[e] & 0xffff0000u); f2[2 * e] = __uint_as_float(p2[e] << 16); f2[2 * e + 1] = __uint_as_float(p2[e] & 0xffff0000u); }
        } else { const float* st = a.in[I_SFCONV] + (size_t)(li * BS + row - MP) * 2 * DFF + col; float* so = c.out + O_FCONVS + (size_t)(li * BS + row - MP) * 2 * DFF + col;
#pragma unroll
            for (int h = 0; h < 2; ++h) { const f32x4 s2 = *(const f32x4*)(st + 4 * h), s1 = *(const f32x4*)(st + DFF + 4 * h); *(f32x4*)(so + 4 * h) = s1;
#pragma unroll
                for (int e = 0; e < 4; ++e) { f2[4 * h + e] = s2[e]; f1[4 * h + e] = s1[e]; } }
#pragma unroll
            for (int e = 0; e < 4; ++e) { so[DFF + 2 * e] = __uint_as_float(ug[e] << 16); so[DFF + 2 * e + 1] = __uint_as_float(ug[e] & 0xffff0000u); } }
        u32x4 o;
#pragma unroll
        for (int e = 0; e < 4; ++e) { const float u0a = __uint_as_float(ug[e] << 16), u0b = __uint_as_float(ug[e] & 0xffff0000u);
            const float ca = CB[col + 2 * e] + CW[2 * DFF + col + 2 * e] * u0a + CW[DFF + col + 2 * e] * f1[2 * e] + CW[col + 2 * e] * f2[2 * e];
            const float cv = CB[col + 2 * e + 1] + CW[2 * DFF + col + 2 * e + 1] * u0b + CW[DFF + col + 2 * e + 1] * f1[2 * e + 1] + CW[col + 2 * e + 1] * f2[2 * e + 1];
            o[e] = pk2(geluf_(ca) * __uint_as_float(uv[e] << 16), geluf_(cv) * __uint_as_float(uv[e] & 0xffff0000u)); }
        *(u32x4*)(ACT + (size_t)row * DFF + col) = o;
    }
}

DEVI void f_odd_norm(const Ctx& c, const PArgs& a, int li) {
    const int j = li >> 1;
    const bf16* XB = (const bf16*)(c.ws + WS_XB); const float* RS = (const float*)(c.ws + WS_RS); bf16* XM = (bf16*)(c.ws + WS_XMIX);
    const float* gain = a.in[I_NMIX] + (size_t)li * D; const float* mix = a.in[I_OMIX] + (size_t)j * 6 * D;
    const int gw = c.bid * NWAVES + c.wave, NGW = c.G * NWAVES;
    const int r0 = (int)(((long)gw * M) / NGW), r1 = (int)(((long)(gw + 1) * M) / NGW);
    f32x4 gv[4], mv[6][4];
#pragma unroll
    for (int q = 0; q < 4; ++q) { const int col = q * 256 + c.lane * 4; gv[q] = *(const f32x4*)(gain + col);
#pragma unroll
        for (int n = 0; n < 6; ++n) mv[n][q] = *(const f32x4*)(mix + (size_t)n * D + col); }
    f32x4 hprev[4];
#pragma unroll
    for (int q = 0; q < 4; ++q) hprev[q] = (f32x4){0.f, 0.f, 0.f, 0.f};
    for (int row = r0; row < r1; ++row) {
        const float rs = row_rstd(RS, row);
        const bool prompt = row < MP; const int b = prompt ? row / TP : row - MP, t = prompt ? row % TP : 0;
        const bool need_prev = prompt && t > 0 && row == r0;
        const float rsp = need_prev ? row_rstd(RS, row - 1) : 0.f;
#pragma unroll
        for (int q = 0; q < 4; ++q) { const int col = q * 256 + c.lane * 4;
            const u32x2 xw_ = *(const u32x2*)(XB + (size_t)row * D + col);
            const f32x4 h = (f32x4){__uint_as_float(xw_.x << 16), __uint_as_float(xw_.x & 0xffff0000u), __uint_as_float(xw_.y << 16), __uint_as_float(xw_.y & 0xffff0000u)} * rs * gv[q];
            f32x4 hp = hprev[q];
            if (!prompt) hp = *(const f32x4*)(a.in[I_SSHIFT] + (size_t)(j * BS + b) * D + col);
            else if (t == 0) hp = (f32x4){0.f, 0.f, 0.f, 0.f};
            else if (need_prev) { const u32x2 pw_ = *(const u32x2*)(XB + (size_t)(row - 1) * D + col);
                hp = (f32x4){__uint_as_float(pw_.x << 16), __uint_as_float(pw_.x & 0xffff0000u), __uint_as_float(pw_.y << 16), __uint_as_float(pw_.y & 0xffff0000u)} * rsp * gv[q]; }
            const f32x4 xx = hp - h;
#pragma unroll
            for (int n = 0; n < 6; ++n) { const f32x4 o = h + xx * mv[n][q]; u32x2 w; w.x = pk2(o.x, o.y); w.y = pk2(o.z, o.w); *(u32x2*)(XM + ((size_t)n * M + row) * D + col) = w; }
            if (prompt) { if (t == TP - 1) *(f32x4*)(c.out + O_SHIFTP + (size_t)(j * BP + b) * D + col) = h; }
            else *(f32x4*)(c.out + O_SHIFTS + (size_t)(j * BS + b) * D + col) = h;
            hprev[q] = h; }
    }
}

DEVI void f_tail_residual(const Ctx& c, const bf16* A, int lda, const bf16* Bt, int K, bool wxb) {
    float* X = (float*)(c.ws + WS_X); bf16* XB = (bf16*)(c.ws + WS_XB); float* RS = (float*)(c.ws + WS_RS);
    LAS float* red = (LAS float*)c.lds;
    const int fr = c.lane & 15, fq = c.lane >> 4, nks = K / 32;
    for (int task = c.bid; task < 256; task += c.G) {
        const int row0 = M_MAIN + (task >> 4) * 16, col0 = (task & 15) * 64;
        const bf16* ap = A + (size_t)(row0 + fr) * lda + 8 * fq; const bf16* bp = Bt + (size_t)(col0 + fr) * K + 8 * fq;
        f32x4 acc[4];
#pragma unroll
        for (int nb = 0; nb < 4; ++nb) acc[nb] = (f32x4){0.f, 0.f, 0.f, 0.f};
#pragma unroll 1
        for (int ks0 = c.wave; ks0 < nks; ks0 += 32) {
            bf16x8_t af[4], bf_[4][4];
#pragma unroll
            for (int u = 0; u < 4; ++u) { const int ks = ks0 + 8 * u; const bool ok = ks < nks; const unsigned ko = (unsigned)(32 * (ok ? ks : 0));
                af[u] = *(const bf16x8_t*)(ap + ko);
#pragma unroll
                for (int nb = 0; nb < 4; ++nb) bf_[u][nb] = *(const bf16x8_t*)(bp + (unsigned)(16 * nb * K) + ko);
                if (!ok) af[u] = (bf16x8_t){0, 0, 0, 0, 0, 0, 0, 0}; }
#pragma unroll
            for (int u = 0; u < 4; ++u)
#pragma unroll
                for (int nb = 0; nb < 4; ++nb) acc[nb] = __builtin_amdgcn_mfma_f32_16x16x32_bf16(af[u], bf_[u][nb], acc[nb], 0, 0, 0);
        }
        __syncthreads();
#pragma unroll
        for (int nb = 0; nb < 4; ++nb)
#pragma unroll
            for (int r = 0; r < 4; ++r) red[(c.wave * 16 + 4 * fq + r) * 64 + 16 * nb + fr] = acc[nb][r];
        __syncthreads();
        { const int r = c.tid >> 5, cc = 2 * (c.tid & 31); float v0 = 0.f, v1 = 0.f;
#pragma unroll
          for (int w = 0; w < 8; ++w) { const f32x2_t t = *(const LAS f32x2_t*)(red + (w * 16 + r) * 64 + cc); v0 += t.x; v1 += t.y; }
          const size_t o = (size_t)(row0 + r) * D + col0 + cc;
          const unsigned xo = *(const unsigned*)(XB + o); v0 += __uint_as_float(xo << 16); v1 += __uint_as_float(xo & 0xffff0000u);
          (void)wxb; (void)X; *(unsigned*)(XB + o) = pk2(v0, v1);
          const float ss = red32(v0 * v0 + v1 * v1);
          if ((c.tid & 31) == 0) RS[(size_t)(row0 + r) * 16 + (task & 15)] = ss; }
    }
    __syncthreads();
}

__global__ void __launch_bounds__(NT, 2) hybrid_fwd(Args args) {
    extern __shared__ __attribute__((aligned(16))) unsigned char lds_raw[];
    Ctx c;
    c.lds = (LAS unsigned char*)lds_raw;
    c.tid = threadIdx.x; c.lane = c.tid & 63; c.wave = __builtin_amdgcn_readfirstlane(c.tid >> 6);
    c.G = gridDim.x; c.bid = blockIdx.x; c.ws = args.ws; c.out = args.out;
    volatile LAS unsigned* MISC = (volatile LAS unsigned*)(c.lds + MISC_OFF);
    for (int u = c.tid; u < (LDS_BYTES - LDSCTL_OFF) / 4; u += NT) ((LAS unsigned*)(c.lds + LDSCTL_OFF))[u] = 0u;
    __syncthreads();
    if (c.tid < N_IN) ((LAS unsigned long long*)(c.lds + PTAB_OFF))[c.tid] = (unsigned long long)args.in[c.tid];
    __syncthreads();
    PArgs pa; pa.in.t = (const LAS unsigned long long*)(c.lds + PTAB_OFF);
    (void)xcd_barrier_post((unsigned*)(c.ws + WS_CTL) + 4096, MISC + 8);
#define GRID_BAR() do { XcdBarrier bar_; bar_.bar = (unsigned*)(c.ws + WS_CTL) + 4096; bar_.x = xb_xcc_id(); bar_.st = (volatile LAS unsigned*)(c.lds + MISC_OFF) + 8; xcd_barrier(bar_); } while (0)
#define RETID() do { asm volatile("" : "+s"(c.wave), "+s"(c.bid), "+s"(c.G)); asm volatile("v_mbcnt_lo_u32_b32 %0, -1, 0\n\tv_mbcnt_hi_u32_b32 %0, -1, %0" : "=v"(c.lane)); c.tid = c.wave * 64 + c.lane; } while (0)
#define PHASE(body) do { RETID(); body; GRID_BAR(); } while (0)
    for (int rep = 0; rep < REP_PRO; ++rep) PHASE({ n_prologue(c, pa); f_wprep(c, pa, 1ull, c.bid * NWAVES + c.wave, c.G * NWAVES); });
#pragma unroll 1
    for (int li = 0; li < 4; ++li) {
        const int j = li >> 1;
        if ((li & 1) == 0) {
#if FAST & 1
            for (int rep = 0; rep < REP_G; ++rep) PHASE(f_even_in(c, li));
#else
            PHASE(n_even_in(c, pa, li));
#endif
#if FAST & 32
            for (int rep = 0; rep < REP_MIX; ++rep) PHASE(f_even_mix(c, pa, li, rep == 0 ? 7 : MIX_PART));
#else
            PHASE(n_even_mix(c, pa, li));
#endif
#if FAST & 2
            PHASE({ f_gemm_residual(c, (const bf16*)(c.ws + WS_MIX), 2048, (const bf16*)(c.ws + WS_WB + WB_WOUT + j * SZ_WOUT), 2048, true); RETID(); f_tail_residual(c, (const bf16*)(c.ws + WS_MIX), 2048, (const bf16*)(c.ws + WS_WB + WB_WOUT + j * SZ_WOUT), 2048, true); });
#else
            PHASE(n_gemm_residual(c, (const bf16*)(c.ws + WS_MIX), 2048, pa.in[I_EWOUT] + (size_t)j * 2048 * D, 2048, true));
#endif
        } else {
            for (int rep = 0; rep < REP_NORM; ++rep) PHASE(f_odd_norm(c, pa, li));
#if FAST & 8
            for (int rep = 0; rep < REP_G; ++rep) PHASE(f_odd_in(c, li));
#else
            PHASE(n_odd_in(c, pa, li));
#endif
#if FAST & 16
            for (int rep = 0; rep < REP_G; ++rep) PHASE(f_odd_lora(c, pa, li));
#else
            PHASE(n_odd_lora(c, pa, li));
#endif
#if FAST & 128
#if FAST & 512
            for (int rep = 0; rep < REP_SCAN; ++rep) PHASE(f_odd_scan3(c, pa, li, rep == 0 ? 3 : SCAN_PART));
#elif FAST & 256
            for (int rep = 0; rep < REP_SCAN; ++rep) { PHASE(f_odd_scan2(c, pa, li)); PHASE(f_rwkv_post(c, pa, li)); }
#else
            for (int rep = 0; rep < REP_SCAN; ++rep) PHASE(f_odd_scan(c, pa, li));
#endif
#else
            for (int rep = 0; rep < REP_SCAN; ++rep) PHASE(n_odd_scan(c, pa, li));
#endif
#if FAST & 2
            PHASE({ f_gemm_residual(c, (const bf16*)(c.ws + WS_O), D, (const bf16*)(c.ws + WS_WB + WB_WO + j * SZ_WO), D, true); RETID(); f_tail_residual(c, (const bf16*)(c.ws + WS_O), D, (const bf16*)(c.ws + WS_WB + WB_WO + j * SZ_WO), D, true); });
#else
            PHASE(n_gemm_residual(c, (const bf16*)(c.ws + WS_O), D, pa.in[I_OWO] + (size_t)j * D * D, D, true));
#endif
        }
#if FUSE_ACT
        for (int rep = 0; rep < REP_G; ++rep) PHASE(f_ffn_up_act(c, pa, li));
        PHASE(f_ffn_fix(c, pa, li));
#else
#if FAST & 4
        for (int rep = 0; rep < REP_G; ++rep) PHASE(f_ffn_up(c, li));
#else
        PHASE(n_ffn_up(c, pa, li));
#endif
#if FAST & 64
        for (int rep = 0; rep < REP_ACT; ++rep) PHASE(f_ffn_act(c, pa, li));
#else
        for (int rep = 0; rep < REP_ACT; ++rep) PHASE(n_ffn_act(c, pa, li));
#endif
#endif
#if FAST & 2
        PHASE({ f_gemm_residual(c, (const bf16*)(c.ws + WS_ACT), DFF, (const bf16*)(c.ws + WS_WB + WB_WDN + li * SZ_WDN), DFF, li == 1); RETID(); f_tail_residual(c, (const bf16*)(c.ws + WS_ACT), DFF, (const bf16*)(c.ws + WS_WB + WB_WDN + li * SZ_WDN), DFF, li == 1);   });
#else
        PHASE(n_gemm_residual(c, (const bf16*)(c.ws + WS_ACT), DFF, pa.in[I_FWDN] + (size_t)li * DFF * D, DFF, true));
#endif
    }
    RETID(); n_final(c, pa);
#undef PHASE
}

extern "C" void kernel_launch(void* const* d_in, const int* in_sizes, int n_in, void* d_out, int out_size, void* d_ws, size_t ws_size, hipStream_t stream) {
    static int grid = 0;
    if (grid == 0) {
        if (n_in != N_IN || (size_t)out_size != O_END || ws_size < WS_END) {
            fprintf(stderr, "kernel_launch: unexpected shapes: n_in %d (want %d), out %d (want %zu), ws %zu (want >= %zu)\n", n_in, (int)N_IN, out_size, (size_t)O_END, ws_size, (size_t)WS_END);
            grid = -1; return; }
        int dev = 0, cus = 0;
        if (hipGetDevice(&dev) != hipSuccess || hipDeviceGetAttribute(&cus, hipDeviceAttributeMultiprocessorCount, dev) != hipSuccess) { grid = -1; return; }
        if (hipFuncSetAttribute((const void*)hybrid_fwd, hipFuncAttributeMaxDynamicSharedMemorySize, LDS_BYTES) != hipSuccess) { fprintf(stderr, "kernel_launch: hipFuncSetAttribute failed\n"); grid = -1; return; }
        int per_cu = 0;
        (void)hipOccupancyMaxActiveBlocksPerMultiprocessor(&per_cu, (const void*)hybrid_fwd, NT, LDS_BYTES);
        (void)hipGetLastError();
        grid = cus;
    }
    if (grid < 0) return;
    if (hipMemsetAsync((char*)d_ws + WS_CTL, 0, CTL_ZERO_BYTES, stream) != hipSuccess) return;
    Args a{};
    for (int i = 0; i < N_IN; ++i) a.in[i] = (const float*)d_in[i];
    a.out = (float*)d_out; a.ws = (unsigned char*)d_ws;
    hipLaunchKernelGGL(hybrid_fwd, dim3(grid), dim3(NT), LDS_BYTES, stream, a);
}
```

```cpp
#include <hip/hip_runtime.h>
#include <cstdio>
#include <cstdint>

#define GAS __attribute__((address_space(1)))
#define LAS __attribute__((address_space(3)))
#define DEVI __device__ __forceinline__
typedef unsigned short bf16;
typedef float f32x4 __attribute__((ext_vector_type(4)));
typedef unsigned u32x2 __attribute__((ext_vector_type(2)));
typedef float f32x2_t __attribute__((ext_vector_type(2)));
typedef unsigned u32x4 __attribute__((ext_vector_type(4)));

#ifndef FAST
#define FAST 1023
#endif
#ifndef REP_SCAN
#define REP_SCAN 1
#endif
#ifndef REP_ACT
#define REP_ACT 1
#endif
#ifndef REP_MIX
#define REP_MIX 1
#endif
#ifndef REP_PRO
#define REP_PRO 1
#endif
#ifndef FUSE_ACT
#define FUSE_ACT 1
#endif
#ifndef REP_G
#define REP_G 1
#endif
#ifndef REP_NORM
#define REP_NORM 1
#endif
constexpr int D = 1024, TP = 2064, NMETA = 16, SEQ = 2048, BP = 8, BS = 128;
constexpr int MP = BP * TP;
constexpr int M = MP + BS;
constexpr int NIN = 5120, DFF = 2816, NUP = 2 * DFF;
constexpr int M_MAIN = 16384;
constexpr int LML = 640;
constexpr int NWAVES = 8, NT = NWAVES * 64;

constexpr size_t MiB = 1u << 20;
constexpr size_t WS_CTL = 0, CTL_ZERO_BYTES = 1 * MiB;
constexpr size_t WS_RS = 1 * MiB;
constexpr size_t WS_ROPE = 3 * MiB;
constexpr size_t WS_WB = 5 * MiB;
constexpr size_t WS_X = 124 * MiB;
constexpr size_t WS_R = 124 * MiB;
constexpr size_t WS_XB = 189 * MiB;
constexpr size_t WS_BIG = 222 * MiB;
constexpr size_t SZ_ACT1 = (size_t)M * D * 2;
constexpr size_t WS_Z = WS_BIG, WS_MIX = WS_BIG + 163 * MiB;
constexpr size_t WS_U = WS_BIG, WS_ACT = WS_BIG + 179 * MiB;
constexpr size_t WS_XMIX = WS_BIG, WS_K = WS_BIG + 195 * MiB, WS_V = WS_BIG + 228 * MiB;
constexpr size_t WS_WDEC = WS_BIG, WS_AG = WS_BIG + 65 * MiB, WS_GG = WS_AG + SZ_ACT1, WS_VG = WS_GG + SZ_ACT1, WS_O = WS_VG + SZ_ACT1;
constexpr size_t WS_END = WS_BIG + 270 * MiB;
static_assert(WS_O + SZ_ACT1 <= WS_K && WS_ACT + (size_t)M * DFF * 2 <= WS_END && WS_V + SZ_ACT1 <= WS_END && WS_MIX + (size_t)M * 2048 * 2 <= WS_END, "ws map");
constexpr size_t DO_VFIRST = 0, DO_LMID = 33 * MiB;
static_assert(DO_LMID + (size_t)M * LML * 2 <= (size_t)BP * SEQ * D * 4, "d_out scratch");

constexpr size_t O_YP = 0, O_YS = O_YP + (size_t)BP * SEQ * D, O_RETP = O_YS + (size_t)BS * D, O_LRUP = O_RETP + (size_t)2 * BP * 4 * 128 * 256,
    O_LCONVP = O_LRUP + (size_t)2 * BP * 1024, O_RWKVP = O_LCONVP + (size_t)2 * BP * 3 * 1024, O_SHIFTP = O_RWKVP + (size_t)2 * BP * 16 * 64 * 64,
    O_FCONVP = O_SHIFTP + (size_t)2 * BP * 1024, O_RETS = O_FCONVP + (size_t)4 * BP * 2 * DFF, O_LRUS = O_RETS + (size_t)2 * BS * 4 * 128 * 256,
    O_LCONVS = O_LRUS + (size_t)2 * BS * 1024, O_RWKVS = O_LCONVS + (size_t)2 * BS * 3 * 1024, O_SHIFTS = O_RWKVS + (size_t)2 * BS * 16 * 64 * 64,
    O_FCONVS = O_SHIFTS + (size_t)2 * BS * 1024, O_END = O_FCONVS + (size_t)4 * BS * 2 * DFF;

enum { I_XP = 0, I_XS, I_SRET, I_SLRU, I_SLCONV, I_SRWKV, I_SSHIFT, I_SFCONV, I_META, I_NMIX, I_NFFN, I_NFIN,
       I_EWIN, I_ERGN, I_ECW, I_ECB, I_EWA, I_EBA, I_EWX, I_EBX, I_ELAM, I_EWOUT,
       I_OMIX, I_OWR, I_OWK, I_OWV, I_OW0, I_OW1, I_OW2, I_OA0, I_OA1, I_OA2, I_OV0, I_OV1, I_OV2, I_OG1, I_OG2, I_OKK, I_OKA, I_ORK, I_OGNG, I_OGNB, I_OWO,
       I_FWUP, I_FCW, I_FCB, I_FWDN, N_IN };

constexpr int RING_BYTES = 143360, LDSCTL_OFF = RING_BYTES, MISC_OFF = LDSCTL_OFF + 320, LDS_BYTES = 147456;

DEVI float bf2f(bf16 v) { return __uint_as_float((unsigned)v << 16); }
typedef __bf16 hbf16x2_t __attribute__((ext_vector_type(2)));
DEVI unsigned pk2(float lo, float hi) { const f32x2_t v = (f32x2_t){lo, hi}; return __builtin_bit_cast(unsigned, __builtin_convertvector(v, hbf16x2_t)); }
DEVI bf16 f2bf(float f) { return (bf16)(pk2(f, f) & 0xffffu); }
DEVI float wave_sum(float v) {
#pragma unroll
    for (int o = 1; o < 64; o <<= 1) v += __shfl_xor(v, o);
    return v;
}
DEVI float rcpf_(float x) { return __builtin_amdgcn_rcpf(x); }
DEVI float sigmoidf_(float x) { return rcpf_(1.f + __expf(-x)); }
DEVI float siluf_(float x) { return x * rcpf_(1.f + __expf(-x)); }
DEVI float tanhf_(float x) { return 2.f * rcpf_(1.f + __expf(-2.f * x)) - 1.f; }
DEVI float geluf_(float x) { return x * rcpf_(1.f + __expf(-1.5957691216057308f * (x + 0.044715f * x * x * x))); }
DEVI float softplusf_(float x) { return fmaxf(x, 0.f) + log1pf(__expf(-fabsf(x))); }

#define XB_TMO      128
#define XB_XCNT(j)  (256  + 64 * (j))
#define XB_XSUB(j)  (1280 + 64 * (j))
#define XB_XGEN(j)  (2304 + 64 * (j))
#define XB_TOP      3328
#define XB_TOPGEN   3392
#define XCD_BAR_WORDS 3456
#define XB_SPIN_CAP (1u << 22)
DEVI unsigned xb_ld(unsigned* p)              { return __hip_atomic_load(p, __ATOMIC_RELAXED, __HIP_MEMORY_SCOPE_AGENT); }
DEVI unsigned xb_add(unsigned* p, unsigned v) { return __hip_atomic_fetch_add(p, v, __ATOMIC_RELAXED, __HIP_MEMORY_SCOPE_AGENT); }
DEVI unsigned xb_xcc_id() { return (unsigned)__builtin_amdgcn_s_getreg((3 << 11) | 20) & 0xFu; }
#define XB_SPIN(cond, bar) do { unsigned _sp = 0; while (cond) { __builtin_amdgcn_s_sleep(1); \
    if ((++_sp & 255u) == 0u) { if (xb_ld(&(bar)[XB_TMO])) break; if (_sp > XB_SPIN_CAP) { atomicAdd(&(bar)[XB_TMO], 1u); break; } } } } while (0)
struct XcdBarrier { unsigned* bar; unsigned x; volatile LAS unsigned* st; };
DEVI XcdBarrier xcd_barrier_post(unsigned* bar, volatile LAS unsigned* st) {
    XcdBarrier b; b.bar = bar; b.x = xb_xcc_id(); b.st = st;
    if (threadIdx.x == 0) (void)xb_add(&bar[XB_XCNT(b.x)], 1u);
    return b;
}
DEVI void xcd_barrier_complete(unsigned* bar, unsigned x, unsigned& nloc, unsigned& nx) {
    const unsigned G = gridDim.x * gridDim.y * gridDim.z;
    unsigned sum, cnt, mine, sp = 0u;
    for (;;) {
        sum = 0u; cnt = 0u; mine = 0u;
#pragma unroll
        for (unsigned j = 0; j < 16; ++j) { const unsigned c = xb_ld(&bar[XB_XCNT(j)]); sum += c; cnt += (c > 0u) ? 1u : 0u; mine = (j == x) ? c : mine; }
        if (sum == G) break;
        __builtin_amdgcn_s_sleep(1);
        if ((++sp & 255u) == 0u) { if (xb_ld(&bar[XB_TMO])) break; if (sp > XB_SPIN_CAP) { atomicAdd(&bar[XB_TMO], 1u); break; } }
    }
    nloc = mine > 0u ? mine : 1u; nx = cnt > 0u ? cnt : 1u;
}
DEVI void xcd_barrier(const XcdBarrier& b) {
    asm volatile("s_waitcnt vmcnt(0)" ::: "memory");
    __syncthreads();
    if (threadIdx.x == 0) {
        unsigned* bar = b.bar;
        __builtin_amdgcn_s_waitcnt(0);
        unsigned nloc = b.st[0], nx = b.st[1];
        if (nloc == 0u) { xcd_barrier_complete(bar, b.x, nloc, nx); b.st[0] = nloc; b.st[1] = nx; }
        const unsigned old = xb_add(&bar[XB_XSUB(b.x)], 1u);
        const unsigned gen = old / nloc;
        if (old + 1u == (gen + 1u) * nloc) {
            __builtin_amdgcn_fence(__ATOMIC_RELEASE, "agent");
            asm volatile("s_waitcnt vmcnt(0)" ::: "memory");
            const unsigned og = xb_add(&bar[XB_TOP], 1u);
            const unsigned tg = og / nx;
            if (og + 1u == (tg + 1u) * nx) xb_add(&bar[XB_TOPGEN], 1u);
            else XB_SPIN(xb_ld(&bar[XB_TOPGEN]) == tg, bar);
            __builtin_amdgcn_fence(__ATOMIC_ACQUIRE, "agent");
            xb_add(&bar[XB_XGEN(b.x)], 1u);
            asm volatile("s_waitcnt vmcnt(0)" ::: "memory");
        } else {
            XB_SPIN(xb_ld(&bar[XB_XGEN(b.x)]) == gen, bar);
            __builtin_amdgcn_fence(__ATOMIC_ACQUIRE, "agent");
            asm volatile("s_waitcnt vmcnt(0)" ::: "memory");
        }
    }
    __syncthreads();
}

struct Args { const float* in[N_IN]; float* out; unsigned char* ws; };
constexpr int PTAB_OFF = MISC_OFF + 128;
struct InTab { const LAS unsigned long long* t;
    DEVI const float* operator[](int i) const { const unsigned long long v = t[i];
        const unsigned lo = __builtin_amdgcn_readfirstlane((unsigned)v), hi = __builtin_amdgcn_readfirstlane((unsigned)(v >> 32));
        return (const float*)(const __attribute__((address_space(1))) float*)(((unsigned long long)hi << 32) | lo); } };
struct PArgs { InTab in; };

struct Ctx {
    LAS unsigned char* lds;
    int tid, lane, wave, G, bid;
    unsigned char* ws; float* out;
};
DEVI int row_pos(int row) { return row < MP ? (row % TP) : TP; }
DEVI float row_rstd(const float* RS, int row) {
    const f32x4* p = (const f32x4*)(RS + (size_t)row * 16);
    const f32x4 a = p[0], b = p[1], c = p[2], d = p[3];
    const float s = ((a.x + a.y) + (a.z + a.w)) + ((b.x + b.y) + (b.z + b.w)) + ((c.x + c.y) + (c.z + c.w)) + ((d.x + d.y) + (d.z + d.w));
    return __builtin_amdgcn_rsqf(s * (1.0f / D) + 1e-6f);
}
DEVI float row_rstd_fin(const f32x4 a) {
    float s = (a.x + a.y) + (a.z + a.w);
    u32x2 r = __builtin_amdgcn_permlane16_swap(__float_as_uint(s), __float_as_uint(s), false, false); s = __uint_as_float(r.x) + __uint_as_float(r.y);
    r = __builtin_amdgcn_permlane32_swap(__float_as_uint(s), __float_as_uint(s), false, false); s = __uint_as_float(r.x) + __uint_as_float(r.y);
    return __builtin_amdgcn_rsqf(s * (1.0f / D) + 1e-6f);
}

DEVI void n_prologue(const Ctx& c, const PArgs& a) {
    float* X = (float*)(c.ws + WS_X); bf16* XB = (bf16*)(c.ws + WS_XB); float* RS = (float*)(c.ws + WS_RS);
    const int gw = c.bid * NWAVES + c.wave, NGW = c.G * NWAVES;
    for (int row = gw; row < M; row += NGW) {
        const float* src;
        if (row < MP) { const int b = row / TP, t = row % TP; src = t < NMETA ? a.in[I_META] + (size_t)t * D : a.in[I_XP] + ((size_t)b * SEQ + (t - NMETA)) * D; }
        else src = a.in[I_XS] + (size_t)(row - MP) * D;
        float ss = 0.f;
#pragma unroll
        for (int j = 0; j < 4; ++j) {
            const f32x4 v = __builtin_nontemporal_load((const f32x4*)(src + j * 256 + c.lane * 4));
            (void)X;
            u32x2 w; w.x = pk2(v.x, v.y); w.y = pk2(v.z, v.w);
            *(u32x2*)(XB + (size_t)row * D + j * 256 + c.lane * 4) = w;
            ss += (v.x * v.x + v.y * v.y) + (v.z * v.z + v.w * v.w);
        }
        ss = wave_sum(ss);
        if (c.lane < 16) RS[(size_t)row * 16 + c.lane] = c.lane == 0 ? ss : 0.f;
    }
    float* ROPE = (float*)(c.ws + WS_ROPE);
    for (int e = c.bid * NT + c.tid; e < (TP + 1) * 64; e += c.G * NT) {
        const int p = e >> 6, d = e & 63;
        const double pos = p < TP ? (double)p : 16384.0;
        const double inv = exp(-9.210340371976184 * ((double)d / 63.0));
        const double rev = pos * inv * 0.15915494309189535;
        const float fr = (float)(rev - rint(rev));
        ROPE[2 * e] = __builtin_amdgcn_cosf(fr); ROPE[2 * e + 1] = __builtin_amdgcn_sinf(fr);
    }
}

DEVI void ngemm_tile(const Ctx& c, const bf16* A, int lda, const float* W, int ldw, int ncv, int K, const float* gain, int row0, float (&acc)[4][4]) {
    LAS float* As = (LAS float*)c.lds;
    LAS float* Bs = (LAS float*)(c.lds + 8192);
#pragma unroll
    for (int j = 0; j < 4; ++j)
#pragma unroll
        for (int i = 0; i < 4; ++i) acc[j][i] = 0.f;
    const int ar = c.tid >> 4, ak = (c.tid & 15) * 2;
    for (int k0 = 0; k0 < K; k0 += 32) {
        __syncthreads();
        { const unsigned v = *(const unsigned*)(A + (size_t)(row0 + ar) * lda + k0 + ak);
          float lo = __uint_as_float(v << 16), hi = __uint_as_float(v & 0xffff0000u);
          if (gain) { lo *= gain[k0 + ak]; hi *= gain[k0 + ak + 1]; }
          As[ar * 33 + ak] = lo; As[ar * 33 + ak + 1] = hi; }
#pragma unroll
        for (int i = 0; i < 16; ++i) { const int idx = i * NT + c.tid, kk = idx >> 8, cc = idx & 255;
            Bs[idx] = cc < ncv ? W[(size_t)(k0 + kk) * ldw + cc] : 0.f; }
        __syncthreads();
#pragma unroll 8
        for (int kk = 0; kk < 32; ++kk) {
            float av[4], bv[4];
#pragma unroll
            for (int j = 0; j < 4; ++j) av[j] = As[(c.wave * 4 + j) * 33 + kk];
#pragma unroll
            for (int i = 0; i < 4; ++i) bv[i] = Bs[kk * 256 + c.lane + 64 * i];
#pragma unroll
            for (int j = 0; j < 4; ++j)
#pragma unroll
                for (int i = 0; i < 4; ++i) acc[j][i] += av[j] * bv[i];
        }
    }
}

DEVI void nepi_residual(const Ctx& c, int row0, int pn, const float (&acc)[4][4], bool write_xb) {
    float* X = (float*)(c.ws + WS_X); bf16* XB = (bf16*)(c.ws + WS_XB); float* RS = (float*)(c.ws + WS_RS);
#pragma unroll
    for (int j = 0; j < 4; ++j) { const int row = row0 + 4 * c.wave + j; float ss = 0.f;
#pragma unroll
        for (int i = 0; i < 4; ++i) { const int col = pn * 256 + c.lane + 64 * i; const float v = X[(size_t)row * D + col] + acc[j][i];
            X[(size_t)row * D + col] = v; if (write_xb) XB[(size_t)row * D + col] = f2bf(v); ss += v * v; }
        ss = wave_sum(ss);
        if (c.lane < 4) RS[(size_t)row * 16 + pn * 4 + c.lane] = c.lane == 0 ? ss : 0.f; }
}

DEVI void n_even_in(const Ctx& c, const PArgs& a, int li) {
    const int j = li >> 1;
    const bf16* XB = (const bf16*)(c.ws + WS_XB); const float* RS = (const float*)(c.ws + WS_RS); const float* ROPE = (const float*)(c.ws + WS_ROPE);
    bf16* Z = (bf16*)(c.ws + WS_Z);
    const float* W = a.in[I_EWIN] + (size_t)j * D * NIN; const float* gain = a.in[I_NMIX] + (size_t)li * D;
    const int ntn = NIN / 256, nu = (M / 32) * ntn;
    for (int u = c.bid; u < nu; u += c.G) {
        const int pn = u % ntn, row0 = (u / ntn) * 32;
        float acc[4][4];
        ngemm_tile(c, XB, D, W + pn * 256, NIN, 256, D, gain, row0, acc);
#pragma unroll
        for (int jj = 0; jj < 4; ++jj) { const int row = row0 + 4 * c.wave + jj; const float rs = row_rstd(RS, row);
            float v[4];
#pragma unroll
            for (int i = 0; i < 4; ++i) v[i] = acc[jj][i] * rs;
            if (pn < 4) {
                const float cs = ROPE[((size_t)row_pos(row) * 64 + c.lane) * 2], sn = ROPE[((size_t)row_pos(row) * 64 + c.lane) * 2 + 1];
                const float sc = pn >= 2 ? 0.08838834764831845f : 1.f;
                const float a0 = v[0] * cs - v[1] * sn, a1 = v[0] * sn + v[1] * cs, b0 = v[2] * cs - v[3] * sn, b1 = v[2] * sn + v[3] * cs;
                v[0] = a0 * sc; v[1] = a1 * sc; v[2] = b0 * sc; v[3] = b1 * sc;
            } else if (pn >= 8 && pn < 12) {
#pragma unroll
                for (int i = 0; i < 4; ++i) v[i] = siluf_(v[i]);
            } else if (pn >= 16) {
#pragma unroll
                for (int i = 0; i < 4; ++i) v[i] = geluf_(v[i]);
            }
#pragma unroll
            for (int i = 0; i < 4; ++i) Z[(size_t)row * NIN + pn * 256 + c.lane + 64 * i] = f2bf(v[i]); }
    }
}

DEVI void n_ret_unit(const Ctx& c, const PArgs& a, int j, int hd, int row0, int ntok, const float* S0, float* Sout) {
    const bf16* Z = (const bf16*)(c.ws + WS_Z); bf16* MIX = (bf16*)(c.ws + WS_MIX);
    LAS float* qs = (LAS float*)c.lds;
    LAS float* ks = qs + 8 * 128;
    LAS float* vs = ks + 8 * 128;
    LAS float* op = vs + 8 * 256;
    const int e = c.tid & 255, half = c.tid >> 8;
    const float gamma = 1.f - exp2f(-5.f - (float)hd);
    const float* gn = a.in[I_ERGN] + (size_t)j * 1024 + hd * 256;
    float S[64];
    if (S0) { const float* sp = S0 + (size_t)half * 64 * 256 + e;
#pragma unroll
        for (int d8 = 0; d8 < 8; ++d8) { asm volatile("" ::: "memory");
#pragma unroll
            for (int dd = 0; dd < 8; ++dd) S[d8 * 8 + dd] = sp[(size_t)(d8 * 8 + dd) * 256]; }
    } else {
#pragma unroll
        for (int dd = 0; dd < 64; ++dd) S[dd] = 0.f; }
    for (int t0 = 0; t0 < ntok; t0 += 8) {
        __syncthreads();
#pragma unroll
        for (int i = 0; i < 8; ++i) { const int idx = i * NT + c.tid, tt = idx >> 9, cc = idx & 511; const int row = row0 + t0 + tt;
            float v = 0.f;
            if (t0 + tt < ntok) { const int col = cc < 128 ? hd * 128 + cc : (cc < 256 ? 512 + hd * 128 + (cc - 128) : 1024 + hd * 256 + (cc - 256)); v = bf2f(Z[(size_t)row * NIN + col]); }
            if (cc < 128) qs[tt * 128 + cc] = v; else if (cc < 256) ks[tt * 128 + cc - 128] = v; else vs[tt * 256 + cc - 256] = v; }
        __syncthreads();
        for (int tt = 0; tt < 8; ++tt) {
            if (t0 + tt < ntok) {
                const float ve = vs[tt * 256 + e]; float o = 0.f;
#pragma unroll
                for (int dd = 0; dd < 64; ++dd) { S[dd] = gamma * S[dd] + ks[tt * 128 + half * 64 + dd] * ve; o += qs[tt * 128 + half * 64 + dd] * S[dd]; }
                op[(tt * 2 + half) * 256 + e] = o;
            }
        }
        __syncthreads();
        { const int tt = c.wave; const int row = row0 + t0 + tt;
          if (t0 + tt < ntok) {
              float o[4]; float s = 0.f;
#pragma unroll
              for (int i = 0; i < 4; ++i) { const int ee = c.lane + 64 * i; o[i] = op[(tt * 2) * 256 + ee] + op[(tt * 2 + 1) * 256 + ee]; s += o[i]; }
              const float mu = wave_sum(s) * (1.f / 256.f); float q = 0.f;
#pragma unroll
              for (int i = 0; i < 4; ++i) { o[i] -= mu; q += o[i] * o[i]; }
              const float rstd = __builtin_amdgcn_rsqf(wave_sum(q) * (1.f / 256.f) + 1e-6f);
#pragma unroll
              for (int i = 0; i < 4; ++i) { const int ee = c.lane + 64 * i; const float ga = bf2f(Z[(size_t)row * NIN + 2048 + hd * 256 + ee]);
                  MIX[(size_t)row * 2048 + hd * 256 + ee] = f2bf(ga * o[i] * rstd * gn[ee]); }
          } }
    }
    { float* sp = Sout + (size_t)half * 64 * 256 + e;
#pragma unroll
      for (int d8 = 0; d8 < 8; ++d8) { asm volatile("" ::: "memory");
#pragma unroll
          for (int dd = 0; dd < 8; ++dd) sp[(size_t)(d8 * 8 + dd) * 256] = S[d8 * 8 + dd]; } }
    __syncthreads();
}

DEVI void n_lru_unit(const Ctx& c, const PArgs& a, int j, int g, int row0, int ntok, const float* hist  , const float* h0  , float* out_h, float* out_conv) {
    const bf16* Z = (const bf16*)(c.ws + WS_Z); bf16* MIX = (bf16*)(c.ws + WS_MIX);
    LAS float* xcs = (LAS float*)c.lds;
    const int d = c.tid >> 2, p = c.tid & 3, ch = g * 128 + d;
    float wa[32], wx[32];
    { const float* WA = a.in[I_EWA] + ((size_t)(j * 8 + g) * 128 + 32 * p) * 128 + d; const float* WX = a.in[I_EWX] + ((size_t)(j * 8 + g) * 128 + 32 * p) * 128 + d;
#pragma unroll
      for (int cc = 0; cc < 32; ++cc) { wa[cc] = WA[(size_t)cc * 128]; wx[cc] = WX[(size_t)cc * 128]; } }
    const float* CW = a.in[I_ECW] + (size_t)j * 4 * 1024;
    const float cw0 = CW[ch], cw1 = CW[1024 + ch], cw2 = CW[2048 + ch], cw3 = CW[3072 + ch], cb = a.in[I_ECB][(size_t)j * 1024 + ch];
    const float ba = a.in[I_EBA][(size_t)j * 1024 + ch], bx = a.in[I_EBX][(size_t)j * 1024 + ch];
    const float sp = softplusf_(-a.in[I_ELAM][(size_t)j * 1024 + ch]);
    float x1 = hist ? hist[2 * 1024 + ch] : 0.f, x2 = hist ? hist[1024 + ch] : 0.f, x3 = hist ? hist[ch] : 0.f;
    float h = h0 ? h0[ch] : 0.f;
    for (int t = 0; t < ntok; ++t) {
        const int row = row0 + t;
        float xcv = 0.f;
        if (p == 0) { const float xb = bf2f(Z[(size_t)row * NIN + 3072 + ch]); xcv = cb + cw3 * xb + cw2 * x1 + cw1 * x2 + cw0 * x3; x3 = x2; x2 = x1; x1 = xb; xcs[d] = xcv; }
        __syncthreads();
        float sr = 0.f, si = 0.f;
#pragma unroll
        for (int cc = 0; cc < 32; ++cc) { const float xv = xcs[32 * p + cc]; sr += xv * wa[cc]; si += xv * wx[cc]; }
        sr += __shfl_xor(sr, 1); sr += __shfl_xor(sr, 2); si += __shfl_xor(si, 1); si += __shfl_xor(si, 2);
        if (p == 0) {
            const float r = sigmoidf_(sr + ba), ig = sigmoidf_(si + bx);
            const float la = -8.f * r * sp, av = __expf(la), u = sqrtf(-expm1f(2.f * la)) * (ig * xcv);
            h = av * h + u;
            MIX[(size_t)row * 2048 + 1024 + ch] = f2bf(h * bf2f(Z[(size_t)row * NIN + 4096 + ch]));
        }
        __syncthreads();
    }
    if (p == 0) { out_h[ch] = h; out_conv[ch] = x3; out_conv[1024 + ch] = x2; out_conv[2048 + ch] = x1; }
}

DEVI void n_even_mix(const Ctx& c, const PArgs& a, int li) {
    const int j = li >> 1;
    const int NU = 32 + 64 + 512 + 1024;
    for (int u = c.bid; u < NU; u += c.G) {
        if (u < 32 || (u >= 96 && u < 608)) {
            const bool pr = u < 32; const int v = pr ? u : u - 96, b = v >> 2, hd = v & 3;
            const float* S0 = pr ? nullptr : a.in[I_SRET] + ((size_t)(j * BS + b) * 4 + hd) * 128 * 256;
            float* So = pr ? c.out + O_RETP + ((size_t)(j * BP + b) * 4 + hd) * 128 * 256 : c.out + O_RETS + ((size_t)(j * BS + b) * 4 + hd) * 128 * 256;
            n_ret_unit(c, a, j, hd, pr ? b * TP : MP + b, pr ? TP : 1, S0, So);
        } else {
            const bool pr = u < 96; const int v = pr ? u - 32 : u - 608, b = v >> 3, g = v & 7;
            const float* hist = pr ? nullptr : a.in[I_SLCONV] + (size_t)(j * BS + b) * 3 * 1024;
            const float* h0 = pr ? nullptr : a.in[I_SLRU] + (size_t)(j * BS + b) * 1024;
            float* oh = pr ? c.out + O_LRUP + (size_t)(j * BP + b) * 1024 : c.out + O_LRUS + (size_t)(j * BS + b) * 1024;
            float* oc = pr ? c.out + O_LCONVP + (size_t)(j * BP + b) * 3 * 1024 : c.out + O_LCONVS + (size_t)(j * BS + b) * 3 * 1024;
            n_lru_unit(c, a, j, g, pr ? b * TP : MP + b, pr ? TP : 1, hist, h0, oh, oc);
        }
    }
}

DEVI void n_gemm_residual(const Ctx& c, const bf16* A, int lda, const float* W, int K, bool write_xb) {
    const int nu = (M / 32) * 4;
    for (int u = c.bid; u < nu; u += c.G) {
        const int pn = u & 3, row0 = (u >> 2) * 32;
        float acc[4][4];
        ngemm_tile(c, A, lda, W + pn * 256, D, 256, K, nullptr, row0, acc);
        nepi_residual(c, row0, pn, acc, write_xb);
    }
}

DEVI void n_ffn_up(const Ctx& c, const PArgs& a, int li) {
    const bf16* XB = (const bf16*)(c.ws + WS_XB); const float* RS = (const float*)(c.ws + WS_RS); bf16* U = (bf16*)(c.ws + WS_U);
    const float* W = a.in[I_FWUP] + (size_t)li * D * NUP; const float* gain = a.in[I_NFFN] + (size_t)li * D;
    const int ntn = NUP / 256, nu = (M / 32) * ntn;
    for (int u = c.bid; u < nu; u += c.G) {
        const int pn = u % ntn, row0 = (u / ntn) * 32;
        float acc[4][4];
        ngemm_tile(c, XB, D, W + pn * 256, NUP, 256, D, gain, row0, acc);
#pragma unroll
        for (int jj = 0; jj < 4; ++jj) { const int row = row0 + 4 * c.wave + jj; const float rs = row_rstd(RS, row);
#pragma unroll
            for (int i = 0; i < 4; ++i) U[(size_t)row * NUP + pn * 256 + c.lane + 64 * i] = f2bf(acc[jj][i] * rs); }
    }
}

DEVI void n_ffn_act(const Ctx& c, const PArgs& a, int li) {
    const bf16* U = (const bf16*)(c.ws + WS_U); bf16* ACT = (bf16*)(c.ws + WS_ACT);
    const float* CW = a.in[I_FCW] + (size_t)li * 3 * DFF; const float* CB = a.in[I_FCB] + (size_t)li * DFF;
    const size_t total = (size_t)M * DFF;
    for (size_t e = (size_t)c.bid * NT + c.tid; e < total; e += (size_t)c.G * NT) {
        const int row = (int)(e / DFF), col = (int)(e % DFF);
        const float u0 = bf2f(U[(size_t)row * NUP + col]); float u1, u2;
        if (row < MP) { const int b = row / TP, t = row % TP;
            u1 = t >= 1 ? bf2f(U[(size_t)(row - 1) * NUP + col]) : 0.f; u2 = t >= 2 ? bf2f(U[(size_t)(row - 2) * NUP + col]) : 0.f;
            if (t >= TP - 2) c.out[O_FCONVP + ((size_t)(li * BP + b) * 2 + (t - (TP - 2))) * DFF + col] = u0;
        } else { const int b = row - MP; const float* st = a.in[I_SFCONV] + (size_t)(li * BS + b) * 2 * DFF;
            u1 = st[DFF + col]; u2 = st[col];
            float* so = c.out + O_FCONVS + (size_t)(li * BS + b) * 2 * DFF; so[col] = u1; so[DFF + col] = u0; }
        const float cv = CB[col] + CW[2 * DFF + col] * u0 + CW[DFF + col] * u1 + CW[col] * u2;
        ACT[(size_t)row * DFF + col] = f2bf(geluf_(cv) * bf2f(U[(size_t)row * NUP + DFF + col]));
    }
}

DEVI void n_odd_norm(const Ctx& c, const PArgs& a, int li) {
    const int j = li >> 1;
    const bf16* XB = (const bf16*)(c.ws + WS_XB); const float* RS = (const float*)(c.ws + WS_RS); bf16* XM = (bf16*)(c.ws + WS_XMIX);
    const float* gain = a.in[I_NMIX] + (size_t)li * D; const float* mix = a.in[I_OMIX] + (size_t)j * 6 * D;
    const int gw = c.bid * NWAVES + c.wave, NGW = c.G * NWAVES;
    for (int row = gw; row < M; row += NGW) {
        const float rs = row_rstd(RS, row);
        const bool prompt = row < MP; const int b = prompt ? row / TP : row - MP, t = prompt ? row % TP : 0;
        const float rsp = (prompt && t > 0) ? row_rstd(RS, row - 1) : 0.f;
#pragma unroll
        for (int q = 0; q < 4; ++q) { const int col = q * 256 + c.lane * 4;
            const u32x2 xw_ = *(const u32x2*)(XB + (size_t)row * D + col); const f32x4 xv = (f32x4){__uint_as_float(xw_.x << 16), __uint_as_float(xw_.x & 0xffff0000u), __uint_as_float(xw_.y << 16), __uint_as_float(xw_.y & 0xffff0000u)}; const f32x4 gv = *(const f32x4*)(gain + col);
            const f32x4 h = xv * rs * gv; f32x4 hp;
            if (prompt) { if (t > 0) { const u32x2 pw_ = *(const u32x2*)(XB + (size_t)(row - 1) * D + col); hp = (f32x4){__uint_as_float(pw_.x << 16), __uint_as_float(pw_.x & 0xffff0000u), __uint_as_float(pw_.y << 16), __uint_as_float(pw_.y & 0xffff0000u)} * rsp * gv; } else hp = (f32x4){0.f, 0.f, 0.f, 0.f}; }
            else hp = *(const f32x4*)(a.in[I_SSHIFT] + (size_t)(j * BS + b) * D + col);
            const f32x4 xx = hp - h;
#pragma unroll
            for (int n = 0; n < 6; ++n) { const f32x4 mv = *(const f32x4*)(mix + (size_t)n * D + col); const f32x4 o = h + xx * mv;
                u32x2 w; w.x = pk2(o.x, o.y); w.y = pk2(o.z, o.w); *(u32x2*)(XM + ((size_t)n * M + row) * D + col) = w; }
            if (prompt) { if (t == TP - 1) *(f32x4*)(c.out + O_SHIFTP + (size_t)(j * BP + b) * D + col) = h; }
            else *(f32x4*)(c.out + O_SHIFTS + (size_t)(j * BS + b) * D + col) = h; }
    }
}

DEVI void n_odd_in(const Ctx& c, const PArgs& a, int li) {
    const int j = li >> 1;
    const bf16* XM = (const bf16*)(c.ws + WS_XMIX);
    bf16* R = (bf16*)(c.ws + WS_R); bf16* Kb = (bf16*)(c.ws + WS_K); bf16* Vb = j == 0 ? (bf16*)((unsigned char*)c.out + DO_VFIRST) : (bf16*)(c.ws + WS_V);
    bf16* LM = (bf16*)((unsigned char*)c.out + DO_LMID);
    const int nu = (M / 32) * 16;
    for (int u = c.bid; u < nu; u += c.G) {
        const int pn = u & 15, row0 = (u >> 4) * 32;
        if (pn == 13 && j == 0) continue;
        const bf16* A; const float* W; int ldw, ncv;
        if (pn < 4) { A = XM + (size_t)0 * M * D; W = a.in[I_OWR] + (size_t)j * D * D + pn * 256; ldw = D; ncv = 256; }
        else if (pn < 8) { A = XM + (size_t)2 * M * D; W = a.in[I_OWK] + (size_t)j * D * D + (pn - 4) * 256; ldw = D; ncv = 256; }
        else if (pn < 12) { A = XM + (size_t)3 * M * D; W = a.in[I_OWV] + (size_t)j * D * D + (pn - 8) * 256; ldw = D; ncv = 256; }
        else if (pn == 12) { A = XM + (size_t)5 * M * D; W = a.in[I_OG1] + (size_t)j * D * 128; ldw = 128; ncv = 128; }
        else if (pn == 13) { A = XM + (size_t)3 * M * D; W = a.in[I_OV1]; ldw = 32; ncv = 32; }
        else if (pn == 14) { A = XM + (size_t)1 * M * D; W = a.in[I_OW1] + (size_t)j * D * 64; ldw = 64; ncv = 64; }
        else { A = XM + (size_t)4 * M * D; W = a.in[I_OA1] + (size_t)j * D * 64; ldw = 64; ncv = 64; }
        float acc[4][4];
        ngemm_tile(c, A, D, W, ldw, ncv, D, nullptr, row0, acc);
#pragma unroll
        for (int jj = 0; jj < 4; ++jj) { const int row = row0 + 4 * c.wave + jj;
#pragma unroll
            for (int i = 0; i < 4; ++i) { const int cl = c.lane + 64 * i; const float v = acc[jj][i];
                if (pn < 4) R[(size_t)row * D + pn * 256 + cl] = f2bf(v);
                else if (pn < 8) Kb[(size_t)row * D + (pn - 4) * 256 + cl] = f2bf(v);
                else if (pn < 12) Vb[(size_t)row * D + (pn - 8) * 256 + cl] = f2bf(v);
                else if (pn == 12) { if (cl < 128) LM[(size_t)row * LML + cl] = f2bf(sigmoidf_(v)); }
                else if (pn == 13) { if (cl < 128) LM[(size_t)row * LML + 128 + cl] = f2bf(v); }
                else if (pn == 14) { if (cl < 128) LM[(size_t)row * LML + 256 + cl] = f2bf(tanhf_(v)); }
                else LM[(size_t)row * LML + 384 + cl] = f2bf(v); } }
    }
}

DEVI void n_odd_lora(const Ctx& c, const PArgs& a, int li) {
    const int j = li >> 1;
    const bf16* LM = (const bf16*)((unsigned char*)c.out + DO_LMID);
    float* WD = (float*)(c.ws + WS_WDEC); bf16* AG = (bf16*)(c.ws + WS_AG); bf16* VG = (bf16*)(c.ws + WS_VG); bf16* GG = (bf16*)(c.ws + WS_GG);
    const int nu = (M / 32) * 16;
    for (int u = c.bid; u < nu; u += c.G) {
        const int pn = u & 15, grp = pn >> 2, pc = pn & 3, row0 = (u >> 4) * 32;
        if (grp == 2 && j == 0) continue;
        const bf16* A; const float* W; int K;
        if (grp == 0) { A = LM + 256; W = a.in[I_OW2] + (size_t)j * 64 * D; K = 64; }
        else if (grp == 1) { A = LM + 384; W = a.in[I_OA2] + (size_t)j * 64 * D; K = 64; }
        else if (grp == 2) { A = LM + 128; W = a.in[I_OV2]; K = 32; }
        else { A = LM; W = a.in[I_OG2] + (size_t)j * 128 * D; K = 128; }
        float acc[4][4];
        ngemm_tile(c, A, LML, W + pc * 256, D, 256, K, nullptr, row0, acc);
#pragma unroll
        for (int jj = 0; jj < 4; ++jj) { const int row = row0 + 4 * c.wave + jj;
#pragma unroll
            for (int i = 0; i < 4; ++i) { const int col = pc * 256 + c.lane + 64 * i; const float v = acc[jj][i];
                if (grp == 0) { const float wl = -softplusf_(-(a.in[I_OW0][(size_t)j * D + col] + v)) - 0.5f; WD[(size_t)row * D + col] = __expf(-__expf(wl)); }
                else if (grp == 1) AG[(size_t)row * D + col] = f2bf(sigmoidf_(a.in[I_OA0][(size_t)j * D + col] + v));
                else if (grp == 2) VG[(size_t)row * D + col] = f2bf(sigmoidf_(a.in[I_OV0][col] + v));
                else GG[(size_t)row * D + col] = f2bf(v); } }
    }
}

DEVI void n_rwkv_unit(const Ctx& c, const PArgs& a, int j, int hd, int row0, int ntok, const float* S0, float* Sout) {
    const bf16* R = (const bf16*)(c.ws + WS_R); const bf16* Kb = (const bf16*)(c.ws + WS_K);
    const bf16* VF = (const bf16*)((unsigned char*)c.out + DO_VFIRST); const bf16* Vb = j == 0 ? VF : (const bf16*)(c.ws + WS_V);
    const float* WD = (const float*)(c.ws + WS_WDEC); const bf16* AG = (const bf16*)(c.ws + WS_AG); const bf16* VG = (const bf16*)(c.ws + WS_VG); const bf16* GG = (const bf16*)(c.ws + WS_GG);
    bf16* O = (bf16*)(c.ws + WS_O);
    LAS float* rs_ = (LAS float*)c.lds;
    LAS float* ws_ = rs_ + 512; LAS float* ks_ = ws_ + 512; LAS float* vs_ = ks_ + 512; LAS float* as_ = vs_ + 512; LAS float* bs_ = as_ + 512; LAS float* ys_ = bs_ + 512; LAS float* bon = ys_ + 512;
    const int i = c.tid >> 3, q = c.tid & 7;
    const int st = c.wave, sc = c.lane, ch = hd * 64 + sc;
    const float kkc = a.in[I_OKK][(size_t)j * D + ch], kac = a.in[I_OKA][(size_t)j * D + ch], rkc = a.in[I_ORK][(size_t)j * D + ch];
    const float gng = a.in[I_OGNG][(size_t)j * D + ch], gnb = a.in[I_OGNB][(size_t)j * D + ch];
    float s[8];
#pragma unroll
    for (int jj = 0; jj < 8; ++jj) s[jj] = 0.f;
    if (S0) {
#pragma unroll
        for (int jj = 0; jj < 8; ++jj) s[jj] = S0[(size_t)i * 64 + 8 * q + jj]; }
    for (int t0 = 0; t0 < ntok; t0 += 8) {
        __syncthreads();
        const int row = row0 + t0 + st; const bool valid = t0 + st < ntok;
        float gg = 0.f;
        { float r = 0.f, k = 0.f, v = 0.f, w = 1.f, ag = 0.f;
          if (valid) { const size_t o = (size_t)row * D + ch; r = bf2f(R[o]); k = bf2f(Kb[o]); v = bf2f(Vb[o]); w = WD[o]; ag = bf2f(AG[o]); gg = bf2f(GG[o]);
              if (j == 1) { const float vf = bf2f(VF[o]); v = v + (vf - v) * bf2f(VG[o]); } }
          float kk = k * kkc; const float ss = wave_sum(kk * kk); kk = kk / sqrtf(fmaxf(ss, 1e-24f));
          const float km = k * (1.f + (ag - 1.f) * kac);
          const float bsum = wave_sum(r * km * rkc);
          rs_[st * 64 + sc] = r; ws_[st * 64 + sc] = w; ks_[st * 64 + sc] = km; vs_[st * 64 + sc] = v; as_[st * 64 + sc] = -kk; bs_[st * 64 + sc] = kk * ag;
          if (sc == 0) bon[st] = bsum; }
        __syncthreads();
        for (int tt = 0; tt < 8; ++tt) {
            if (t0 + tt < ntok) {
                float sa = 0.f;
#pragma unroll
                for (int jj = 0; jj < 8; ++jj) sa += s[jj] * as_[tt * 64 + 8 * q + jj];
                sa += __shfl_xor(sa, 1); sa += __shfl_xor(sa, 2); sa += __shfl_xor(sa, 4);
                const float vi = vs_[tt * 64 + i]; float y = 0.f;
#pragma unroll
                for (int jj = 0; jj < 8; ++jj) { const int cj = tt * 64 + 8 * q + jj; s[jj] = s[jj] * ws_[cj] + sa * bs_[cj] + vi * ks_[cj]; y += s[jj] * rs_[cj]; }
                y += __shfl_xor(y, 1); y += __shfl_xor(y, 2); y += __shfl_xor(y, 4);
                if (q == 0) ys_[tt * 64 + i] = y;
            }
        }
        __syncthreads();
        if (valid) {
            const float y = ys_[st * 64 + sc];
            const float mu = wave_sum(y) * (1.f / 64.f); const float dy = y - mu; const float var = wave_sum(dy * dy) * (1.f / 64.f);
            float o = dy / sqrtf(var + 64e-5f) * gng + gnb;
            o = (o + bon[st] * vs_[st * 64 + sc]) * gg;
            O[(size_t)row * D + ch] = f2bf(o);
        }
    }
#pragma unroll
    for (int jj = 0; jj < 8; ++jj) Sout[(size_t)i * 64 + 8 * q + jj] = s[jj];
    __syncthreads();
}
DEVI void n_odd_scan(const Ctx& c, const PArgs& a, int li) {
    const int j = li >> 1;
    const int NU = 128 + 2048;
    for (int u = c.bid; u < NU; u += c.G) {
        const bool pr = u < 128; const int v = pr ? u : u - 128, b = v >> 4, hd = v & 15;
        const float* S0 = pr ? nullptr : a.in[I_SRWKV] + ((size_t)(j * BS + b) * 16 + hd) * 4096;
        float* So = pr ? c.out + O_RWKVP + ((size_t)(j * BP + b) * 16 + hd) * 4096 : c.out + O_RWKVS + ((size_t)(j * BS + b) * 16 + hd) * 4096;
        n_rwkv_unit(c, a, j, hd, pr ? b * TP : MP + b, pr ? TP : 1, S0, So);
    }
}

DEVI void n_final(const Ctx& c, const PArgs& a) {
    const bf16* XB = (const bf16*)(c.ws + WS_XB); const float* RS = (const float*)(c.ws + WS_RS); const float* gain = a.in[I_NFIN];
    const int gw = c.bid * NWAVES + c.wave, NGW = c.G * NWAVES;
    for (int row = gw; row < M; row += NGW) {
        float* dst;
        if (row < MP) { const int b = row / TP, t = row % TP; if (t < NMETA) continue; dst = c.out + O_YP + ((size_t)b * SEQ + (t - NMETA)) * D; }
        else dst = c.out + O_YS + (size_t)(row - MP) * D;
        const float rs = row_rstd(RS, row);
#pragma unroll
        for (int q = 0; q < 4; ++q) { const int col = q * 256 + c.lane * 4;
            const u32x2 xw_ = *(const u32x2*)(XB + (size_t)row * D + col); const f32x4 yv_ = (f32x4){__uint_as_float(xw_.x << 16), __uint_as_float(xw_.x & 0xffff0000u), __uint_as_float(xw_.y << 16), __uint_as_float(xw_.y & 0xffff0000u)} * rs * *(const f32x4*)(gain + col); __builtin_nontemporal_store(yv_, (f32x4*)(dst + col)); }
    }
}

namespace pg8 {
typedef short bf16x8 __attribute__((ext_vector_type(8)));
constexpr int BM = 256, BK = 64, HALF = 128, HTB = HALF * BK * 2, STAGE_BYTES = 8 * HTB, NXCD = 8, WGM = 8;
__host__ __device__ __forceinline__ int lds_byte(int r, int c) { const int st = (r >> 4) * 2 + (c >> 5), rr = r & 15, cc = c & 31, ob = rr * 64 + cc * 2; return st * 1024 + (ob ^ (((ob >> 9) & 1) << 5)); }
__host__ __device__ __forceinline__ void stage_rc(int b, int& R, int& C) { const int st = b / 1024, sb = b % 1024, swz = sb ^ (((sb >> 9) & 1) << 5); R = (st >> 1) * 16 + swz / 64; C = (st & 1) * 32 + (swz % 64) / 2; }
__host__ __device__ __forceinline__ int perm32(int rho) { const int n = rho >> 4, i = rho & 15; return 8 * (i >> 2) + 4 * n + (i & 3); }
struct Unit { int pm, pn; };
struct Gemm { const bf16* A; const bf16* Bt; int M, N, K, lda; unsigned long long asel; size_t astride; };
struct StaticOrder {
    int nM, nN, nwg, G, c;
    __device__ __forceinline__ void init(int M_, int N_, int G_, int c_) { nM = M_ / BM; nN = N_ / BM; nwg = nM * nN; G = G_; c = c_; }
    __device__ __forceinline__ bool next(int i, Unit& u) const {
        const long L = (long)i * G + c; if (L >= nwg) return false;
        int wgid = (int)L; { const int q = nwg / NXCD, r = nwg % NXCD, xcd = wgid % NXCD, off = wgid / NXCD; wgid = (xcd < r ? xcd * (q + 1) : r * (q + 1) + (xcd - r) * q) + off; }
        const int nig = WGM * nN, gid = wgid / nig, fm = gid * WGM, gsz = (nM - fm) < WGM ? (nM - fm) : WGM;
        u.pm = fm + ((wgid % nig) % gsz); u.pn = (wgid % nig) / gsz; return true;
    }
};
DEVI unsigned cvt_pk_bf16(float lo, float hi) { return pk2(lo, hi); }

template <class Epi>
DEVI void gemm_phase(LAS unsigned char* lds, const int tid, const Gemm g, const StaticOrder& S, const Epi& E) {
    const int wid = __builtin_amdgcn_readfirstlane(tid >> 6), lane = tid & 63, wr = wid >> 2, wc = wid & 3, fr = lane & 15, fq = lane >> 4;
    const int K = g.K, nt = K / BK, lda = g.lda;
    unsigned voffA[2], voffB[2];
#pragma unroll
    for (int i = 0; i < 2; ++i) { int R, C; stage_rc(tid * 16 + i * 8192, R, C); const int Rb = Epi::PERM ? ((R & ~31) + perm32(R & 31)) : R;
        voffA[i] = (unsigned)(R * lda + C) * 2u; voffB[i] = (unsigned)(Rb * K + C) * 2u; }
    const size_t kstep = (size_t)(BK * 2);
    const size_t hstepA = (size_t)HALF * lda * 2, hstepB = (size_t)HALF * K * 2;
    const size_t tstepA = 2 * hstepA, tstepB = 2 * hstepB;
    const unsigned ldsw = (unsigned)wid * 1024u;
    const int aoff = lds_byte(wr * 64 + fr, fq * 8), boff = lds_byte(wc * 32 + fr, fq * 8);
#define PG8_SA(b, h) (((b) * 2 + (h)) * HTB)
#define PG8_SB(b, h) ((4 + (b) * 2 + (h)) * HTB)
#define PG8_STAGE(bufoff, gbase, voff) do { _Pragma("unroll") for (int _i = 0; _i < 2; ++_i) \
        __builtin_amdgcn_global_load_lds((const unsigned*)((const char*)(gbase) + (voff)[_i]), (LAS unsigned*)(lds + (bufoff) + ldsw + _i * 8192), 16, 0, 0); } while (0)
#define PG8_LDA(dst, b, h) do { _Pragma("unroll") for (int m = 0; m < 4; ++m) _Pragma("unroll") for (int k = 0; k < 2; ++k) dst[m][k] = *(const LAS bf16x8*)(lds + PG8_SA(b, h) + aoff + m * 2048 + k * 1024); } while (0)
#define PG8_LDB(dst, b, h) do { _Pragma("unroll") for (int n = 0; n < 2; ++n) _Pragma("unroll") for (int k = 0; k < 2; ++k) dst[n][k] = *(const LAS bf16x8*)(lds + PG8_SB(b, h) + boff + n * 2048 + k * 1024); } while (0)
#define PG8_MMA(ai, bj, At, Bt) do { __builtin_amdgcn_s_setprio(1); _Pragma("unroll") for (int m = 0; m < 4; ++m) _Pragma("unroll") for (int n = 0; n < 2; ++n) _Pragma("unroll") for (int k = 0; k < 2; ++k) \
        acc[ai][bj][m][n] = __builtin_amdgcn_mfma_f32_16x16x32_bf16(Bt[n][k], At[m][k], acc[ai][bj][m][n], 0, 0, 0); __builtin_amdgcn_s_setprio(0); } while (0)
#define PG8_WAIT_V(n) asm volatile("s_waitcnt vmcnt(" #n ")" ::: "memory")
#define PG8_WAIT_L(n) asm volatile("s_waitcnt lgkmcnt(" #n ")" ::: "memory")
#define PG8_BAR __builtin_amdgcn_s_barrier()
#define PG8_SCHED __builtin_amdgcn_sched_barrier(0)
#define PG8_ABASE(u) ((const char*)(g.A + (size_t)((g.asel >> (4 * (u).pn)) & 15ull) * g.astride) + (size_t)(u).pm * tstepA)
    Unit cur, nxt; int ui = 0;
    if (!S.next(0, cur)) return;
    f32x4 acc[2][2][4][2];
#pragma unroll
    for (int a = 0; a < 2; ++a)
#pragma unroll
        for (int b = 0; b < 2; ++b)
#pragma unroll
            for (int m = 0; m < 4; ++m)
#pragma unroll
                for (int n = 0; n < 2; ++n) acc[a][b][m][n] = (f32x4){0.f, 0.f, 0.f, 0.f};
    bf16x8 At[4][2], B0[2][2], B1[2][2];
    const char* cA = PG8_ABASE(cur); const char* cB = (const char*)g.Bt + (size_t)cur.pn * tstepB;
    PG8_STAGE(PG8_SB(0, 0), cB, voffB); PG8_STAGE(PG8_SB(0, 1), cB + hstepB, voffB); PG8_STAGE(PG8_SA(0, 0), cA, voffA); PG8_STAGE(PG8_SA(0, 1), cA + hstepA, voffA);
    if (wr == 1) PG8_BAR;
    PG8_WAIT_V(2); PG8_BAR;
    PG8_STAGE(PG8_SB(1, 0), cB + kstep, voffB); PG8_STAGE(PG8_SA(1, 0), cA + kstep, voffA); PG8_STAGE(PG8_SB(1, 1), cB + hstepB + kstep, voffB);
    PG8_WAIT_V(6); PG8_BAR;
    for (;;) {
        const bool has_next = S.next(ui + 1, nxt);
        const char* nA = has_next ? PG8_ABASE(nxt) : cA; const char* nB = has_next ? (const char*)g.Bt + (size_t)nxt.pn * tstepB : cB;
        for (int t = 0; t < nt; t += 2) {
            const bool last = (t == nt - 2);
            const char* a1 = cA + (size_t)(t + 1) * kstep;
            const char* a2 = last ? nA : cA + (size_t)(t + 2) * kstep; const char* b2 = last ? nB : cB + (size_t)(t + 2) * kstep;
            const char* a3 = a2 + kstep; const char* b3 = b2 + kstep;
            PG8_LDB(B0, 0, 0); PG8_LDB(B1, 0, 1); PG8_SCHED; PG8_LDA(At, 0, 0); PG8_STAGE(PG8_SA(1, 1), a1 + hstepA, voffA);
            PG8_WAIT_V(8); PG8_WAIT_L(0); PG8_BAR; PG8_MMA(0, 0, At, B0); PG8_MMA(0, 1, At, B1); PG8_BAR; PG8_SCHED;
            PG8_LDA(At, 0, 1); PG8_STAGE(PG8_SB(0, 0), b2, voffB); PG8_STAGE(PG8_SB(0, 1), b2 + hstepB, voffB); PG8_STAGE(PG8_SA(0, 0), a2, voffA);
            PG8_WAIT_V(8); PG8_WAIT_L(0); PG8_BAR; PG8_MMA(1, 0, At, B0); PG8_MMA(1, 1, At, B1); PG8_BAR; PG8_SCHED;
            PG8_LDB(B0, 1, 0); PG8_LDB(B1, 1, 1); PG8_SCHED; PG8_LDA(At, 1, 0); PG8_STAGE(PG8_SA(0, 1), a2 + hstepA, voffA);
            PG8_WAIT_V(8); PG8_WAIT_L(0); PG8_BAR; PG8_MMA(0, 0, At, B0); PG8_MMA(0, 1, At, B1); PG8_BAR; PG8_SCHED;
            PG8_LDA(At, 1, 1); PG8_STAGE(PG8_SB(1, 0), b3, voffB); PG8_STAGE(PG8_SB(1, 1), b3 + hstepB, voffB); PG8_STAGE(PG8_SA(1, 0), a3, voffA);
            PG8_WAIT_V(8); PG8_WAIT_L(0); PG8_BAR; PG8_MMA(1, 0, At, B0); PG8_MMA(1, 1, At, B1); PG8_BAR; PG8_SCHED;
        }
        if (wr == 0) PG8_BAR;
        E(acc, cur, wr, wc, fr, fq);
        if (!has_next) break;
#pragma unroll
        for (int a = 0; a < 2; ++a)
#pragma unroll
            for (int b = 0; b < 2; ++b)
#pragma unroll
                for (int m = 0; m < 4; ++m)
#pragma unroll
                    for (int n = 0; n < 2; ++n) acc[a][b][m][n] = (f32x4){0.f, 0.f, 0.f, 0.f};
        cur = nxt; cA = nA; cB = nB; ++ui;
        if (wr == 1) PG8_BAR;
    }
    PG8_WAIT_V(0);
    PG8_BAR;
#undef PG8_SA
#undef PG8_SB
#undef PG8_STAGE
#undef PG8_LDA
#undef PG8_LDB
#undef PG8_MMA
#undef PG8_WAIT_V
#undef PG8_WAIT_L
#undef PG8_BAR
#undef PG8_SCHED
#undef PG8_ABASE
}
}

constexpr size_t WB_WIN = 0, WB_WOUT = 20 * MiB, WB_G5 = 28 * MiB, WB_G6 = 44 * MiB, WB_WO = 48 * MiB, WB_WUP = 52 * MiB, WB_WDN = 96 * MiB;
constexpr size_t SZ_WIN = 10 * MiB, SZ_WOUT = 4 * MiB, SZ_G5 = 8 * MiB, SZ_G6 = 2 * MiB, SZ_WO = 2 * MiB, SZ_WUP = 11 * MiB, SZ_WDN = (size_t)D * DFF * 2;
static_assert(WB_WDN + 4 * SZ_WDN <= 119 * MiB, "weight map");

struct WDesc { const float* W; const float* gain; bf16* dst; int ldw, Kv, Kd, Nv, Nd, map; };
DEVI WDesc wdesc(const PArgs& a, unsigned char* ws, int id) {
    WDesc w; w.gain = nullptr; w.map = 0; unsigned char* wb = ws + WS_WB;
    if (id < 2) { const int j = id; w.W = a.in[I_EWIN] + (size_t)j * D * NIN; w.ldw = NIN; w.Kv = w.Kd = D; w.Nv = w.Nd = NIN; w.gain = a.in[I_NMIX] + (size_t)(2 * j) * D; w.dst = (bf16*)(wb + WB_WIN + j * SZ_WIN); w.map = 1; }
    else if (id < 4) { const int j = id - 2; w.W = a.in[I_EWOUT] + (size_t)j * 2048 * D; w.ldw = D; w.Kv = w.Kd = 2048; w.Nv = w.Nd = D; w.dst = (bf16*)(wb + WB_WOUT + j * SZ_WOUT); }
    else if (id < 18) { const int q = id - 4, j = q / 7, p = q % 7; bf16* base = (bf16*)(wb + WB_G5 + j * SZ_G5); w.Kv = w.Kd = D;
        if (p < 3) { w.W = a.in[p == 0 ? I_OWR : (p == 1 ? I_OWK : I_OWV)] + (size_t)j * D * D; w.ldw = D; w.Nv = w.Nd = D; w.dst = base + (size_t)p * 1024 * D; }
        else if (p == 3) { w.W = a.in[I_OG1] + (size_t)j * D * 128; w.ldw = 128; w.Nv = 128; w.Nd = 256; w.dst = base + (size_t)3072 * D; }
        else if (p == 4) { w.W = a.in[I_OW1] + (size_t)j * D * 64; w.ldw = 64; w.Nv = 64; w.Nd = 256; w.dst = base + (size_t)3328 * D; }
        else if (p == 5) { w.W = a.in[I_OA1] + (size_t)j * D * 64; w.ldw = 64; w.Nv = 64; w.Nd = 256; w.dst = base + (size_t)3584 * D; }
        else { w.W = a.in[I_OV1]; w.ldw = 32; w.Nv = 32; w.Nd = j == 1 ? 256 : 0; w.dst = base + (size_t)3840 * D; } }
    else if (id < 26) { const int q = id - 18, j = q >> 2, p = q & 3; bf16* base = (bf16*)(wb + WB_G6 + j * SZ_G6); w.Kd = 256; w.ldw = D; w.Nv = w.Nd = D; w.dst = base + (size_t)p * 1024 * 256;
        if (p == 0) { w.W = a.in[I_OW2] + (size_t)j * 64 * D; w.Kv = 64; }
        else if (p == 1) { w.W = a.in[I_OA2] + (size_t)j * 64 * D; w.Kv = 64; }
        else if (p == 2) { w.W = a.in[I_OG2] + (size_t)j * 128 * D; w.Kv = 128; }
        else { w.W = a.in[I_OV2]; w.Kv = 32; if (j == 0) w.Nd = 0; } }
    else if (id < 28) { const int j = id - 26; w.W = a.in[I_OWO] + (size_t)j * D * D; w.ldw = D; w.Kv = w.Kd = D; w.Nv = w.Nd = D; w.dst = (bf16*)(wb + WB_WO + j * SZ_WO); }
    else if (id < 32) { const int li = id - 28; w.W = a.in[I_FWUP] + (size_t)li * D * NUP; w.ldw = NUP; w.Kv = w.Kd = D; w.Nv = w.Nd = NUP; w.gain = a.in[I_NFFN] + (size_t)li * D; w.dst = (bf16*)(wb + WB_WUP + li * SZ_WUP); w.map = FUSE_ACT ? 2 : 0; }
    else { const int li = id - 32; w.W = a.in[I_FWDN] + (size_t)li * DFF * D; w.ldw = D; w.Kv = w.Kd = DFF; w.Nv = w.Nd = D; w.dst = (bf16*)(wb + WB_WDN + li * SZ_WDN); }
    return w;
}
constexpr int N_WDESC = 36;
DEVI void wprep_item(const WDesc& w, LAS float* scr, int item, int lane) {
    const int nblk = w.Nd / 32, kb = item / nblk, nb = item % nblk, k0 = 64 * kb, n0 = 32 * nb;
    int sc0 = n0;
    if (w.map == 1 && n0 < 1024) { const int t = n0 >> 8, cp = n0 & 255; sc0 = 256 * t + ((cp & 127) >> 6) * 128 + (cp >> 7) * 64 + (cp & 63); }
    if (w.map == 2) { const int t = n0 >> 8, cp = n0 & 255; sc0 = cp < 128 ? 128 * t + cp : DFF + 128 * t + (cp - 128); }
    const bool nvalid = n0 < w.Nv;
#pragma unroll
    for (int i = 0; i < 8; ++i) { const int kk = 8 * i + (lane >> 3), k = k0 + kk; f32x4 v = (f32x4){0.f, 0.f, 0.f, 0.f};
        if (nvalid && k < w.Kv) { v = __builtin_nontemporal_load((const f32x4*)(w.W + (size_t)k * w.ldw + sc0 + 4 * (lane & 7))); if (w.gain) v = v * w.gain[k]; }
        LAS float* d = scr + kk * 33 + 4 * (lane & 7); d[0] = v.x; d[1] = v.y; d[2] = v.z; d[3] = v.w; }
    asm volatile("s_waitcnt lgkmcnt(0)" ::: "memory");
    const int cc = lane & 7;
#pragma unroll
    for (int jx = 0; jx < 4; ++jx) { const int n = (lane >> 3) + 8 * jx; const LAS float* s = scr + (8 * cc) * 33 + n;
        u32x4 o; o.x = pk2(s[0 * 33], s[1 * 33]); o.y = pk2(s[2 * 33], s[3 * 33]); o.z = pk2(s[4 * 33], s[5 * 33]); o.w = pk2(s[6 * 33], s[7 * 33]);
        *(u32x4*)(w.dst + (size_t)(n0 + n) * w.Kd + k0 + 8 * cc) = o; }
    asm volatile("s_waitcnt lgkmcnt(0)" ::: "memory");
}
DEVI void f_wprep(const Ctx& c, const PArgs& a, unsigned long long idmask, int gw, int NGW) {
    LAS float* scr = (LAS float*)(c.lds + c.wave * 16384);
#pragma unroll 1
    for (int id = 0; id < N_WDESC; ++id) {
        if (!((idmask >> id) & 1ull)) continue;
        const WDesc w = wdesc(a, c.ws, id);
        const int nitems = (w.Kd / 64) * (w.Nd / 32);
        const int start = (gw + id * 601) % NGW;
        for (int it = start; it < nitems; it += NGW) wprep_item(w, scr, it, c.lane);
    }
}
constexpr unsigned long long WM_L01 = (1ull << 1) | (1ull << 2) | (0x7full << 4) | (0xfull << 18) | (1ull << 26) | (3ull << 28) | (3ull << 32);
constexpr unsigned long long WM_L23 = (1ull << 3) | (0x7full << 11) | (0xfull << 22) | (1ull << 27) | (3ull << 30) | (3ull << 34);
static_assert((WM_L01 | WM_L23 | 1ull) == (1ull << 36) - 1 && (WM_L01 & WM_L23) == 0, "weight masks");

DEVI u32x4 pack8(const f32x4 a, const f32x4 b) { u32x4 w; w.x = pg8::cvt_pk_bf16(a[0], a[1]); w.y = pg8::cvt_pk_bf16(a[2], a[3]); w.z = pg8::cvt_pk_bf16(b[0], b[1]); w.w = pg8::cvt_pk_bf16(b[2], b[3]); return w; }
DEVI f32x4 map4(const f32x4 v, int act) {
    f32x4 o;
#pragma unroll
    for (int e = 0; e < 4; ++e) o[e] = act == 1 ? siluf_(v[e]) : act == 2 ? geluf_(v[e]) : act == 3 ? sigmoidf_(v[e]) : act == 4 ? tanhf_(v[e]) : v[e];
    return o;
}
struct EpiEvenIn {
    static constexpr bool PERM = true;
    bf16* Z; const float* RS; const float* ROPE;
    DEVI void operator()(const f32x4 (&acc)[2][2][4][2], const pg8::Unit& u, int wr, int wc, int fr, int fq) const {
        const int pn = u.pn;
        float rsv[2][4];
        { f32x4 rq[2][4];
#pragma unroll
          for (int ai = 0; ai < 2; ++ai)
#pragma unroll
            for (int m = 0; m < 4; ++m) rq[ai][m] = *(const f32x4*)(RS + (size_t)(u.pm * 256 + ai * 128 + wr * 64 + m * 16 + fr) * 16 + 4 * fq);
          asm volatile("" ::: "memory");
#pragma unroll
          for (int ai = 0; ai < 2; ++ai)
#pragma unroll
            for (int m = 0; m < 4; ++m) rsv[ai][m] = row_rstd_fin(rq[ai][m]); }
#pragma unroll
        for (int ai = 0; ai < 2; ++ai)
#pragma unroll
            for (int m = 0; m < 4; ++m) {
                const int row = u.pm * 256 + ai * 128 + wr * 64 + m * 16 + fr; const float rs = rsv[ai][m];
                if (pn < 4) {
                    const int hl = wc >> 1, d0 = (32 * wc + 8 * fq) & 63; const float sc = (pn >= 2 ? 0.08838834764831845f : 1.f) * rs;
                    const f32x4* rp = (const f32x4*)(ROPE + ((size_t)row_pos(row) * 64 + d0) * 2);
                    const f32x4 c0 = rp[0], c1 = rp[1], c2 = rp[2], c3 = rp[3];
                    const f32x4 x1a = acc[ai][0][m][0] * sc, x1b = acc[ai][0][m][1] * sc, x2a = acc[ai][1][m][0] * sc, x2b = acc[ai][1][m][1] * sc;
                    const f32x4 csa = (f32x4){c0[0], c0[2], c1[0], c1[2]}, sna = (f32x4){c0[1], c0[3], c1[1], c1[3]}, csb = (f32x4){c2[0], c2[2], c3[0], c3[2]}, snb = (f32x4){c2[1], c2[3], c3[1], c3[3]};
                    const f32x4 y1a = x1a * csa - x2a * sna, y1b = x1b * csb - x2b * snb, y2a = x1a * sna + x2a * csa, y2b = x1b * snb + x2b * csb;
                    bf16* dst = Z + (size_t)row * NIN + pn * 256 + hl * 128 + d0;
                    *(u32x4*)dst = pack8(y1a, y1b); *(u32x4*)(dst + 64) = pack8(y2a, y2b);
                } else {
                    const int act = (pn >= 8 && pn < 12) ? 1 : (pn >= 16 ? 2 : 0);
#pragma unroll
                    for (int bj = 0; bj < 2; ++bj) { bf16* dst = Z + (size_t)row * NIN + pn * 256 + bj * 128 + wc * 32 + fq * 8;
                        *(u32x4*)dst = pack8(map4(acc[ai][bj][m][0] * rs, act), map4(acc[ai][bj][m][1] * rs, act)); }
                }
            }
    }
};
struct EpiResidual {
    static constexpr bool PERM = false;
    bf16* XB; float* RS;
    DEVI void operator()(const f32x4 (&acc)[2][2][4][2], const pg8::Unit& u, int wr, int wc, int fr, int fq) const {
#pragma unroll
        for (int ai = 0; ai < 2; ++ai) {
            u32x2 xo[4][2][2];
#pragma unroll
            for (int m = 0; m < 4; ++m)
#pragma unroll
                for (int bj = 0; bj < 2; ++bj)
#pragma unroll
                    for (int n = 0; n < 2; ++n) xo[m][bj][n] = *(const u32x2*)(XB + (size_t)(u.pm * 256 + ai * 128 + wr * 64 + m * 16 + fr) * D + u.pn * 256 + bj * 128 + wc * 32 + n * 16 + fq * 4);
            asm volatile("" ::: "memory");
#pragma unroll
            for (int m = 0; m < 4; ++m) {
                const int row = u.pm * 256 + ai * 128 + wr * 64 + m * 16 + fr; float ss = 0.f;
#pragma unroll
                for (int bj = 0; bj < 2; ++bj)
#pragma unroll
                    for (int n = 0; n < 2; ++n) { const size_t o = (size_t)row * D + u.pn * 256 + bj * 128 + wc * 32 + n * 16 + fq * 4;
                        const u32x2 x_ = xo[m][bj][n];
                        f32x4 v = acc[ai][bj][m][n]; v[0] += __uint_as_float(x_.x << 16); v[1] += __uint_as_float(x_.x & 0xffff0000u); v[2] += __uint_as_float(x_.y << 16); v[3] += __uint_as_float(x_.y & 0xffff0000u);
                        u32x2 w; w.x = pk2(v[0], v[1]); w.y = pk2(v[2], v[3]); *(u32x2*)(XB + o) = w;
                        ss += (v[0] * v[0] + v[1] * v[1]) + (v[2] * v[2] + v[3] * v[3]); }
                ss += __shfl_xor(ss, 16); ss += __shfl_xor(ss, 32);
                if (fq == 0) RS[(size_t)row * 16 + u.pn * 4 + wc] = ss;
            }
        }
    }
};
struct EpiUp {
    static constexpr bool PERM = true;
    bf16* U; const float* RS;
    DEVI void operator()(const f32x4 (&acc)[2][2][4][2], const pg8::Unit& u, int wr, int wc, int fr, int fq) const {
#pragma unroll
        for (int ai = 0; ai < 2; ++ai)
#pragma unroll
            for (int m = 0; m < 4; ++m) {
                const int row = u.pm * 256 + ai * 128 + wr * 64 + m * 16 + fr; const float rs = row_rstd(RS, row);
#pragma unroll
                for (int bj = 0; bj < 2; ++bj) *(u32x4*)(U + (size_t)row * NUP + u.pn * 256 + bj * 128 + wc * 32 + fq * 8) = pack8(acc[ai][bj][m][0] * rs, acc[ai][bj][m][1] * rs);
            }
    }
};
struct EpiOddIn {
    static constexpr bool PERM = true;
    bf16 *R, *Kb, *Vb, *LM; int j;
    DEVI void operator()(const f32x4 (&acc)[2][2][4][2], const pg8::Unit& u, int wr, int wc, int fr, int fq) const {
        const int pn = u.pn; bf16* base; int pitch, off; float al, be, ga; bool ident, both;
        bf16 *r_ = R, *k_ = Kb, *v_ = Vb, *l_ = LM; asm volatile("" : "+s"(r_), "+s"(k_), "+s"(v_), "+s"(l_));
        if (pn < 12) { base = pn < 4 ? r_ : (pn < 8 ? k_ : v_); pitch = D; off = (pn & 3) * 256; ident = true; both = true; al = 1.f; be = 1.f; ga = 0.f; }
        else { base = l_; pitch = LML; off = pn == 12 ? 0 : (pn == 13 ? 256 : (pn == 14 ? 384 : 128)); ident = pn >= 14; both = pn == 14 || (pn == 12 && j == 0);
               al = pn == 13 ? 2.f : 1.f; be = al; ga = pn == 13 ? -1.f : 0.f; }
        bf16* p0 = base + off + wc * 32 + fq * 8;
#pragma unroll
        for (int ai = 0; ai < 2; ++ai)
#pragma unroll
            for (int m = 0; m < 4; ++m) {
                const int row = u.pm * 256 + ai * 128 + wr * 64 + m * 16 + fr;
#pragma unroll
                for (int bj = 0; bj < 2; ++bj) {
                    f32x4 v0 = acc[ai][bj][m][0], v1 = acc[ai][bj][m][1];
                    if (!ident) {
#pragma unroll
                        for (int e = 0; e < 4; ++e) { v0[e] = al * __builtin_amdgcn_rcpf(1.f + __expf(-be * v0[e])) + ga; v1[e] = al * __builtin_amdgcn_rcpf(1.f + __expf(-be * v1[e])) + ga; } }
                    if (bj == 0 || both) *(u32x4*)(p0 + (size_t)row * pitch + bj * 128) = pack8(v0, v1); }
            }
    }
};
struct EpiDecay {
    static constexpr bool PERM = true;
    float* WD; const float* w0;
    DEVI void operator()(const f32x4 (&acc)[2][2][4][2], const pg8::Unit& u, int wr, int wc, int fr, int fq) const {
        const int cb = u.pn * 256 + wc * 32 + fq * 8;
#pragma unroll
        for (int bj = 0; bj < 2; ++bj) {
            const f32x4 bia0 = *(const f32x4*)(w0 + cb + bj * 128), bia1 = *(const f32x4*)(w0 + cb + bj * 128 + 4);
#pragma unroll
            for (int ai = 0; ai < 2; ++ai)
#pragma unroll
                for (int m = 0; m < 4; ++m) {
                    const int row = u.pm * 256 + ai * 128 + wr * 64 + m * 16 + fr; const size_t o = (size_t)row * D + cb + bj * 128;
                    f32x4 v0_ = acc[ai][bj][m][0] + bia0, v1_ = acc[ai][bj][m][1] + bia1;
#pragma unroll
                    for (int e = 0; e < 4; ++e) { v0_[e] = __expf(-0.6065306597126334f * __builtin_amdgcn_rcpf(1.f + __expf(-v0_[e]))); v1_[e] = __expf(-0.6065306597126334f * __builtin_amdgcn_rcpf(1.f + __expf(-v1_[e]))); }
                    *(f32x4*)(WD + o) = v0_; *(f32x4*)(WD + o + 4) = v1_;
                }
        }
    }
};
struct EpiGate {
    static constexpr bool PERM = true;
    bf16* AG; const float *a0, *v0;
    DEVI void operator()(const f32x4 (&acc)[2][2][4][2], const pg8::Unit& u, int wr, int wc, int fr, int fq) const {
        const int grp = u.pn >> 2; const int cb = (u.pn & 3) * 256 + wc * 32 + fq * 8;
        const float* bp = grp == 2 ? v0 : a0; const float bsc = grp == 1 ? 0.f : 1.f;
        bf16* ob = AG + (size_t)grp * M * D;
#pragma unroll
        for (int bj = 0; bj < 2; ++bj) {
            const f32x4 bia0 = *(const f32x4*)(bp + cb + bj * 128) * bsc, bia1 = *(const f32x4*)(bp + cb + bj * 128 + 4) * bsc;
#pragma unroll
            for (int ai = 0; ai < 2; ++ai)
#pragma unroll
                for (int m = 0; m < 4; ++m) {
                    const int row = u.pm * 256 + ai * 128 + wr * 64 + m * 16 + fr; const size_t o = (size_t)row * D + cb + bj * 128;
                    f32x4 v0_ = acc[ai][bj][m][0] + bia0, v1_ = acc[ai][bj][m][1] + bia1;
                    if (grp != 1) {
#pragma unroll
                        for (int e = 0; e < 4; ++e) { v0_[e] = __builtin_amdgcn_rcpf(1.f + __expf(-v0_[e])); v1_[e] = __builtin_amdgcn_rcpf(1.f + __expf(-v1_[e])); } }
                    *(u32x4*)(ob + o) = pack8(v0_, v1_);
                }
        }
    }
};

DEVI void f_even_in(const Ctx& c, int li) {
    const int j = li >> 1;
    pg8::Gemm g{(const bf16*)(c.ws + WS_XB), (const bf16*)(c.ws + WS_WB + WB_WIN + j * SZ_WIN), M, NIN, D, D, 0ull, 0};
    pg8::StaticOrder S; S.init(M, NIN, c.G, c.bid);
    EpiEvenIn E{(bf16*)(c.ws + WS_Z), (const float*)(c.ws + WS_RS), (const float*)(c.ws + WS_ROPE)};
    pg8::gemm_phase<EpiEvenIn>(c.lds, c.tid, g, S, E);
}
DEVI void f_gemm_residual(const Ctx& c, const bf16* A, int lda, const bf16* Bt, int K, bool wxb) {
    pg8::Gemm g{A, Bt, M_MAIN, D, K, lda, 0ull, 0};
    pg8::StaticOrder S; S.init(M_MAIN, D, c.G, c.bid);
    (void)wxb; EpiResidual E{(bf16*)(c.ws + WS_XB), (float*)(c.ws + WS_RS)};
    pg8::gemm_phase<EpiResidual>(c.lds, c.tid, g, S, E);
}
DEVI void f_ffn_up(const Ctx& c, int li) {
    pg8::Gemm g{(const bf16*)(c.ws + WS_XB), (const bf16*)(c.ws + WS_WB + WB_WUP + li * SZ_WUP), M, NUP, D, D, 0ull, 0};
    pg8::StaticOrder S; S.init(M, NUP, c.G, c.bid);
    EpiUp E{(bf16*)(c.ws + WS_U), (const float*)(c.ws + WS_RS)};
    pg8::gemm_phase<EpiUp>(c.lds, c.tid, g, S, E);
}
DEVI void f_odd_in(const Ctx& c, int li) {
    const int j = li >> 1, N5 = j == 0 ? 3840 : 4096;
    pg8::Gemm g{(const bf16*)(c.ws + WS_XMIX), (const bf16*)(c.ws + WS_WB + WB_G5 + j * SZ_G5), M, N5, D, D, 0x3415333322220000ull, (size_t)M * D};
    pg8::StaticOrder S; S.init(M, N5, c.G, c.bid);
    EpiOddIn E{(bf16*)(c.ws + WS_R), (bf16*)(c.ws + WS_K), j == 0 ? (bf16*)((unsigned char*)c.out + DO_VFIRST) : (bf16*)(c.ws + WS_V), (bf16*)((unsigned char*)c.out + DO_LMID), j};
    pg8::gemm_phase<EpiOddIn>(c.lds, c.tid, g, S, E);
}
DEVI void f_odd_lora(const Ctx& c, const PArgs& a, int li) {
    const int j = li >> 1;
    const bf16* LM = (const bf16*)((unsigned char*)c.out + DO_LMID); const bf16* W6 = (const bf16*)(c.ws + WS_WB + WB_G6 + j * SZ_G6);
    int K6 = 256; asm volatile("" : "+s"(K6));
    {
        pg8::Gemm g{LM + 256, W6, M, D, K6, LML, 0ull, 0};
        pg8::StaticOrder S; S.init(M, D, c.G, c.bid);
        EpiDecay E{(float*)(c.ws + WS_WDEC), a.in[I_OW0] + (size_t)j * D};
        pg8::gemm_phase<EpiDecay>(c.lds, c.tid, g, S, E);
    }
    {
        const int N6 = j == 0 ? 2048 : 3072;
        pg8::Gemm g{LM, W6 + (size_t)1024 * 256, M, N6, K6, LML, 0x111100003333ull, 128};
        int c2 = c.bid + (c.G >> 1); if (c2 >= c.G) c2 -= c.G;
        pg8::StaticOrder S; S.init(M, N6, c.G, c2);
        EpiGate E{(bf16*)(c.ws + WS_AG), a.in[I_OA0] + (size_t)j * D, a.in[I_OV0]};
        pg8::gemm_phase<EpiGate>(c.lds, c.tid, g, S, E);
    }
}

typedef short bf16x8_t __attribute__((ext_vector_type(8)));
constexpr int LRU_XS = 0, LRU_AI = 33792, LRU_GT = LRU_AI + 128 * 136 * 2, LRU_END = LRU_GT + 128 * 256;
static_assert(LRU_END + 8 * 1024 <= RING_BYTES, "lru lds");
#define LWAIT_() asm volatile("s_waitcnt lgkmcnt(0)" ::: "memory")
#define LDS_BAR() asm volatile("s_waitcnt lgkmcnt(0)\n\ts_barrier" ::: "memory")
DEVI void f_lru_unit(const Ctx& c, const PArgs& a, int j, int g, bool sample, int b) {
    const bf16* Z = (const bf16*)(c.ws + WS_Z); bf16* MIX = (bf16*)(c.ws + WS_MIX);
    LAS unsigned char* XS = c.lds + LRU_XS; LAS unsigned char* AI = c.lds + LRU_AI; LAS unsigned char* GT = c.lds + LRU_GT;
    const int w = c.wave, fr = c.lane & 15, fq = c.lane >> 4, col = 16 * w + fr, ch = g * 128 + col;
    const int row0 = sample ? MP : b * TP, ntok = sample ? 128 : TP, nchunks = sample ? 1 : (TP + 127) / 128;
    bf16x8_t Bw[2][4];
#pragma unroll
    for (int gate = 0; gate < 2; ++gate) {
        const float* Wg = a.in[gate == 0 ? I_EWA : I_EWX] + (size_t)(j * 8 + g) * 128 * 128;
        __syncthreads();
        { f32x4 wv[8];
#pragma unroll
          for (int i = 0; i < 8; ++i) wv[i] = *(const f32x4*)(Wg + (unsigned)(i * NT + c.tid) * 4u);
          asm volatile("" ::: "memory");
#pragma unroll
          for (int i = 0; i < 8; ++i) *(LAS f32x4*)(c.lds + (unsigned)(i * NT + c.tid) * 16u) = wv[i]; }
        __syncthreads();
#pragma unroll
        for (int ks = 0; ks < 4; ++ks) { bf16x8_t vv;
#pragma unroll
            for (int jj = 0; jj < 8; ++jj) vv[jj] = (short)f2bf(*(const LAS float*)(c.lds + ((32 * ks + 8 * fq + jj) * 128 + col) * 4));
            Bw[gate][ks] = vv; }
    }
    const float ba = a.in[I_EBA][(size_t)j * 1024 + ch], bx = a.in[I_EBX][(size_t)j * 1024 + ch], sp8 = 8.f * softplusf_(-a.in[I_ELAM][(size_t)j * 1024 + ch]);
    const int cc = c.tid & 127, rq = c.tid >> 7, cch = g * 128 + cc;
    const float* CW = a.in[I_ECW] + (size_t)j * 4 * 1024;
    const float cw0 = CW[cch], cw1 = CW[1024 + cch], cw2 = CW[2048 + cch], cw3 = CW[3072 + cch], cb = a.in[I_ECB][(size_t)j * 1024 + cch];
    float carry = 0.f;
    u32x4 pfx[5], pfg[4];
    const bf16* zx = Z + (size_t)row0 * NIN + 3072 + g * 128; const bf16* zg = Z + (size_t)row0 * NIN + 4096 + g * 128;
#define LRU_PREFETCH(t0) do { _Pragma("unroll") for (int i = 0; i < 5; ++i) { const int p = i * NT + c.tid, r = p >> 4, q = p & 15; const int t = (t0) - 3 + r; \
            pfx[i] = (u32x4){0u, 0u, 0u, 0u}; if (r < 131 && t >= 0) pfx[i] = *(const u32x4*)(zx + (unsigned)(t * NIN + q * 8)); } \
        _Pragma("unroll") for (int i = 0; i < 4; ++i) { const int p = i * NT + c.tid, r = p >> 4, q = p & 15; pfg[i] = *(const u32x4*)(zg + (unsigned)(((t0) + r) * NIN + q * 8)); } } while (0)
    LRU_PREFETCH(0);
    for (int ci = 0; ci < nchunks; ++ci) {
        const int t0 = ci * 128, nv = (ntok - t0) < 128 ? (ntok - t0) : 128;
        __syncthreads();
#pragma unroll
        for (int i = 0; i < 5; ++i) { const int p = i * NT + c.tid; if (p < 131 * 16) *(LAS u32x4*)(XS + p * 16) = pfx[i]; }
#pragma unroll
        for (int i = 0; i < 4; ++i) { const int p = i * NT + c.tid; *(LAS u32x4*)(GT + p * 16) = pfg[i]; }
        __syncthreads();
        if (ci + 1 < nchunks) LRU_PREFETCH(t0 + 128);
        if (!sample) {
            float x0 = bf2f(*(const LAS bf16*)(XS + ((rq * 32 + 0) * 128 + cc) * 2)), x1 = bf2f(*(const LAS bf16*)(XS + ((rq * 32 + 1) * 128 + cc) * 2)), x2 = bf2f(*(const LAS bf16*)(XS + ((rq * 32 + 2) * 128 + cc) * 2));
#pragma unroll 8
            for (int i = 0; i < 32; ++i) { const int lr = rq * 32 + i; const float x3 = bf2f(*(const LAS bf16*)(XS + ((lr + 3) * 128 + cc) * 2));
                *(LAS bf16*)(AI + (lr * 136 + cc) * 2) = f2bf(cb + cw3 * x3 + cw2 * x2 + cw1 * x1 + cw0 * x0); x0 = x1; x1 = x2; x2 = x3; }
        } else {
            const float* SC = a.in[I_SLCONV] + (size_t)j * BS * 3 * 1024 + cch; float* SCO = c.out + O_LCONVS + (size_t)j * BS * 3 * 1024 + cch;
#pragma unroll 2
            for (int i = 0; i < 32; ++i) { const int lr = rq * 32 + i; const unsigned so = (unsigned)(lr * 3 * 1024);
                const float h0 = SC[so], h1 = SC[so + 1024u], h2 = SC[so + 2048u], x3 = bf2f(*(const LAS bf16*)(XS + ((lr + 3) * 128 + cc) * 2));
                *(LAS bf16*)(AI + (lr * 136 + cc) * 2) = f2bf(cb + cw3 * x3 + cw2 * h2 + cw1 * h1 + cw0 * h0);
                SCO[so] = h1; SCO[so + 1024u] = h2; SCO[so + 2048u] = x3; }
        }
        __syncthreads();
#pragma unroll 1
        for (int m = 0; m < 8; ++m) {
            f32x4 accr_ = (f32x4){0.f, 0.f, 0.f, 0.f}, acci_ = (f32x4){0.f, 0.f, 0.f, 0.f};
#pragma unroll
            for (int ks = 0; ks < 4; ++ks) { const bf16x8_t af = *(const LAS bf16x8_t*)(AI + ((16 * m + fr) * 136 + 32 * ks + 8 * fq) * 2);
                accr_ = __builtin_amdgcn_mfma_f32_16x16x32_bf16(af, Bw[0][ks], accr_, 0, 0, 0);
                acci_ = __builtin_amdgcn_mfma_f32_16x16x32_bf16(af, Bw[1][ks], acci_, 0, 0, 0); }
            float av[4], uv[4];
#pragma unroll
            for (int r = 0; r < 4; ++r) { const int lr = 16 * m + 4 * fq + r;
                const float xcv = bf2f(*(const LAS bf16*)(AI + (lr * 136 + col) * 2));
                const float rg = sigmoidf_(accr_[r] + ba), ig = sigmoidf_(acci_[r] + bx);
                const float la = -sp8 * rg, t2 = 2.f * la;
                const float em1 = t2 > -0.02f ? t2 * (1.f + t2 * (0.5f + t2 * 0.16666667f)) : __expf(t2) - 1.f;
                av[r] = __expf(la); uv[r] = sqrtf(-em1) * (ig * xcv); }
            float hv[4];
            if (!sample) {
                const float Ai = av[0] * av[1] * av[2] * av[3], Ui = ((uv[0] * av[1] + uv[1]) * av[2] + uv[2]) * av[3] + uv[3];
                LAS f32x2_t* cs = (LAS f32x2_t*)(c.lds + LRU_END + w * 1024 + (m & 1) * 512);
                cs[fq * 16 + fr] = (f32x2_t){Ai, Ui};
                LWAIT_();
                const f32x2_t c0 = cs[fr], c1 = cs[16 + fr], c2 = cs[32 + fr], c3 = cs[48 + fr];
                const float h0e = c0.x * carry + c0.y, h1e = c1.x * h0e + c1.y, h2e = c2.x * h1e + c2.y, h3e = c3.x * h2e + c3.y;
                const float hin = fq == 0 ? carry : (fq == 1 ? h0e : (fq == 2 ? h1e : h2e));
                carry = h3e;
                hv[0] = av[0] * hin + uv[0]; hv[1] = av[1] * hv[0] + uv[1]; hv[2] = av[2] * hv[1] + uv[2]; hv[3] = av[3] * hv[2] + uv[3];
                if (nv < 128 && m == ((TP % 128) - 1) / 16 && fq == (((TP % 128) - 1) & 15) / 4) c.out[O_LRUP + (size_t)(j * BP + b) * 1024 + ch] = hv[((TP % 128) - 1) & 3];
            } else {
#pragma unroll
                for (int r = 0; r < 4; ++r) { const int lr = 16 * m + 4 * fq + r; const unsigned so = (unsigned)(lr * 1024);
                    hv[r] = av[r] * (a.in[I_SLRU] + (size_t)j * BS * 1024 + ch)[so] + uv[r]; (c.out + O_LRUS + (size_t)j * BS * 1024 + ch)[so] = hv[r]; }
            }
#pragma unroll
            for (int r = 0; r < 4; ++r) { const int lr = 16 * m + 4 * fq + r; LAS bf16* gp = (LAS bf16*)(GT + (lr * 128 + col) * 2); *gp = f2bf(hv[r] * bf2f(*gp)); }
        }
        if (!sample && nv < 128 && c.tid < 128) {
#pragma unroll
            for (int k = 0; k < 3; ++k) c.out[O_LCONVP + ((size_t)(j * BP + b) * 3 + k) * 1024 + g * 128 + c.tid] = bf2f(*(const LAS bf16*)(XS + ((nv + k) * 128 + c.tid) * 2));
        }
        __syncthreads();
#pragma unroll
        for (int i = 0; i < 4; ++i) { const int p = i * NT + c.tid, r = p >> 4, q = p & 15;
            if (r < nv) *(u32x4*)(MIX + (size_t)(row0 + t0 + r) * 2048 + 1024 + g * 128 + q * 8) = *(const LAS u32x4*)(GT + p * 16); }
    }
#undef LRU_PREFETCH
    __syncthreads();
}

#define DPP_F(v, ctrl) __builtin_bit_cast(float, __builtin_amdgcn_update_dpp(0, __builtin_bit_cast(int, (v)), (ctrl), 0xF, 0xF, true))
DEVI float red8(float x) { x += DPP_F(x, 0xB1); x += DPP_F(x, 0x4E); x += DPP_F(x, 0x141); return x; }
DEVI float red32(float x) { x += DPP_F(x, 0xB1); x += DPP_F(x, 0x4E); x += DPP_F(x, 0x141); x += DPP_F(x, 0x140); x += __shfl_xor(x, 16); return x; }
typedef unsigned long long u64x2_t __attribute__((ext_vector_type(2)));
DEVI void tr_frag2(unsigned tile, int pitch, int krow0, int col0, int fr, int fq, bf16x8_t& f0, bf16x8_t& f1) {
    const unsigned base = tile + (unsigned)((krow0 + 8 * fq + (fr >> 2)) * pitch + (col0 + 4 * (fr & 3)) * 2);
    unsigned long long a0, a1, b0, b1;
    asm volatile("ds_read_b64_tr_b16 %0, %4\n\tds_read_b64_tr_b16 %1, %5\n\tds_read_b64_tr_b16 %2, %6\n\tds_read_b64_tr_b16 %3, %7\n\ts_waitcnt lgkmcnt(0)"
                 : "=&v"(a0), "=&v"(a1), "=&v"(b0), "=&v"(b1) : "v"(base), "v"(base + 4u * (unsigned)pitch), "v"(base + 32u * (unsigned)pitch), "v"(base + 36u * (unsigned)pitch) : "memory");
    u64x2_t v0; v0.x = a0; v0.y = a1; u64x2_t v1; v1.x = b0; v1.y = b1;
    f0 = __builtin_bit_cast(bf16x8_t, v0); f1 = __builtin_bit_cast(bf16x8_t, v1);
}
DEVI void tr_frag4(unsigned tile, int pitch, int col0, int col1, int fr, int fq, bf16x8_t& f00, bf16x8_t& f01, bf16x8_t& f10, bf16x8_t& f11) {
    const unsigned b0 = tile + (unsigned)((8 * fq + (fr >> 2)) * pitch + (col0 + 4 * (fr & 3)) * 2), b1 = b0 + (unsigned)((col1 - col0) * 2);
    unsigned long long a0, a1, a2, a3, c0, c1, c2, c3;
    asm volatile("ds_read_b64_tr_b16 %0, %8\n\tds_read_b64_tr_b16 %1, %9\n\tds_read_b64_tr_b16 %2, %10\n\tds_read_b64_tr_b16 %3, %11\n\t"
                 "ds_read_b64_tr_b16 %4, %12\n\tds_read_b64_tr_b16 %5, %13\n\tds_read_b64_tr_b16 %6, %14\n\tds_read_b64_tr_b16 %7, %15\n\ts_waitcnt lgkmcnt(0)"
                 : "=&v"(a0), "=&v"(a1), "=&v"(a2), "=&v"(a3), "=&v"(c0), "=&v"(c1), "=&v"(c2), "=&v"(c3)
                 : "v"(b0), "v"(b0 + 4u * (unsigned)pitch), "v"(b0 + 32u * (unsigned)pitch), "v"(b0 + 36u * (unsigned)pitch), "v"(b1), "v"(b1 + 4u * (unsigned)pitch), "v"(b1 + 32u * (unsigned)pitch), "v"(b1 + 36u * (unsigned)pitch) : "memory");
    u64x2_t v; v.x = a0; v.y = a1; f00 = __builtin_bit_cast(bf16x8_t, v); v.x = a2; v.y = a3; f01 = __builtin_bit_cast(bf16x8_t, v);
    v.x = c0; v.y = c1; f10 = __builtin_bit_cast(bf16x8_t, v); v.x = c2; v.y = c3; f11 = __builtin_bit_cast(bf16x8_t, v);
}
constexpr int RC = 64;
constexpr int RT_QS = 0, RT_KS = RT_QS + RC * 272, RT_KD = RT_KS + RC * 272, RT_VS = RT_KD + RC * 272, RT_PS = RT_VS + RC * 528, RT_OT = RT_PS + RC * 144, RT_END = RT_OT + RC * 528;
static_assert(RT_END <= RING_BYTES, "ret lds");
DEVI void f_ret_prompt(const Ctx& c, const PArgs& a, int j, int b, int hd) {
    const bf16* Z = (const bf16*)(c.ws + WS_Z); bf16* MIX = (bf16*)(c.ws + WS_MIX);
    const unsigned L0 = (unsigned)(size_t)c.lds;
    LAS unsigned char* QS = c.lds + RT_QS; LAS unsigned char* KS = c.lds + RT_KS; LAS unsigned char* KD = c.lds + RT_KD; LAS unsigned char* VS = c.lds + RT_VS; LAS unsigned char* PS = c.lds + RT_PS;
    const int w = c.wave;
    const float l2g0 = log2f(1.f - exp2f(-5.f - (float)hd));
    const bf16* zb = Z + (size_t)(b * TP) * NIN; const int qcol = hd * 128, kcol = 512 + hd * 128, vcol = 1024 + hd * 256;
    const float* gn = a.in[I_ERGN] + (size_t)j * 1024 + hd * 256;
    f32x4 Sacc[8][2];
#pragma unroll
    for (int db = 0; db < 8; ++db) { Sacc[db][0] = (f32x4){0.f, 0.f, 0.f, 0.f}; Sacc[db][1] = (f32x4){0.f, 0.f, 0.f, 0.f}; }
    u32x4 pf[8];
#define RET_PREFETCH(t0) do { _Pragma("unroll") for (int i = 0; i < 8; ++i) { int r, col; \
            if (i < 4) { const int p = (i & 1) * NT + c.tid; r = p >> 4; col = (i < 2 ? qcol : kcol) + (p & 15) * 8; } else { const int p = (i - 4) * NT + c.tid; r = p >> 5; col = vcol + (p & 31) * 8; } \
            pf[i] = (u32x4){0u, 0u, 0u, 0u}; if ((t0) + r < TP) pf[i] = *(const u32x4*)(zb + (unsigned)(((t0) + r) * NIN + col)); } } while (0)
    RET_PREFETCH(0);
    const int nchunks = (TP + RC - 1) / RC;
#pragma unroll 1
    for (int ci = 0; ci < nchunks; ++ci) {
        const int t0 = ci * RC, nv = (TP - t0) < RC ? (TP - t0) : RC;
        int lane_ = c.lane; float l2g = l2g0; asm volatile("" : "+v"(lane_), "+v"(l2g));
        const int fr = lane_ & 15, fq = lane_ >> 4, tid_ = w * 64 + lane_;
        LDS_BAR();
#pragma unroll
        for (int i = 0; i < 8; ++i) {
            if (i < 4) { const int p = (i & 1) * NT + tid_, r = p >> 4, q = p & 15;
                *(LAS u32x4*)((i < 2 ? QS : KS) + r * 272 + q * 16) = pf[i];
                if (i >= 2) { const float dk = __builtin_amdgcn_exp2f((float)(nv - 1 - r) * l2g); u32x4 o;
#pragma unroll
                    for (int e = 0; e < 4; ++e) { const unsigned v = pf[i][e]; o[e] = pk2(__uint_as_float(v << 16) * dk, __uint_as_float(v & 0xffff0000u) * dk); }
                    *(LAS u32x4*)(KD + r * 272 + q * 16) = o; } }
            else { const int p = (i - 4) * NT + tid_, r = p >> 5, q = p & 31; *(LAS u32x4*)(VS + r * 528 + q * 16) = pf[i]; }
        }
        LDS_BAR();
        if (ci + 1 < nchunks) RET_PREFETCH(t0 + RC);
        u32x4 gcur[4];
#pragma unroll
        for (int i = 0; i < 4; ++i) { const int p = i * NT + tid_, r = p >> 5, q = p & 31; gcur[i] = (u32x4){0u, 0u, 0u, 0u};
            if (r < nv) gcur[i] = *(const u32x4*)(zb + (unsigned)((t0 + r) * NIN + 2048 + hd * 256 + q * 8)); }
        const f32x4 gn0 = *(const f32x4*)(gn + (tid_ & 31) * 8), gn1 = *(const f32x4*)(gn + (tid_ & 31) * 8 + 4);
        { const int cb = w >> 1;
#pragma unroll
          for (int si = 0; si < 2; ++si) { const int sb = 2 * (w & 1) + si; f32x4 pacc = (f32x4){0.f, 0.f, 0.f, 0.f};
#pragma unroll
              for (int ks = 0; ks < 4; ++ks) { const bf16x8_t af = *(const LAS bf16x8_t*)(QS + (16 * cb + fr) * 272 + (32 * ks + 8 * fq) * 2);
                  const bf16x8_t bfr = *(const LAS bf16x8_t*)(KS + (16 * sb + fr) * 272 + (32 * ks + 8 * fq) * 2);
                  pacc = __builtin_amdgcn_mfma_f32_16x16x32_bf16(af, bfr, pacc, 0, 0, 0); }
#pragma unroll
              for (int r = 0; r < 4; ++r) { const int cc = 16 * cb + 4 * fq + r, ss = 16 * sb + fr; const float v = cc >= ss ? pacc[r] * __builtin_amdgcn_exp2f((float)(cc - ss) * l2g) : 0.f;
                  *(LAS bf16*)(PS + cc * 144 + ss * 2) = f2bf(v); } } }
        f32x4 Oacc[4][2];
#pragma unroll
        for (int cb = 0; cb < 4; ++cb) { Oacc[cb][0] = (f32x4){0.f, 0.f, 0.f, 0.f}; Oacc[cb][1] = (f32x4){0.f, 0.f, 0.f, 0.f}; }
#pragma unroll
        for (int kk = 0; kk < 4; ++kk) {
            bf16x8_t sb_[2];
#pragma unroll
            for (int en = 0; en < 2; ++en) { u32x4 t; t.x = pk2(Sacc[2 * kk][en][0], Sacc[2 * kk][en][1]); t.y = pk2(Sacc[2 * kk][en][2], Sacc[2 * kk][en][3]);
                t.z = pk2(Sacc[2 * kk + 1][en][0], Sacc[2 * kk + 1][en][1]); t.w = pk2(Sacc[2 * kk + 1][en][2], Sacc[2 * kk + 1][en][3]); sb_[en] = __builtin_bit_cast(bf16x8_t, t); }
#pragma unroll
            for (int cb = 0; cb < 4; ++cb) {
                const u32x2 qa = *(const LAS u32x2*)(QS + (16 * cb + fr) * 272 + (32 * kk + 4 * fq) * 2), qb = *(const LAS u32x2*)(QS + (16 * cb + fr) * 272 + (32 * kk + 16 + 4 * fq) * 2);
                u32x4 t; t.x = qa.x; t.y = qa.y; t.z = qb.x; t.w = qb.y; const bf16x8_t af = __builtin_bit_cast(bf16x8_t, t);
                Oacc[cb][0] = __builtin_amdgcn_mfma_f32_16x16x32_bf16(af, sb_[0], Oacc[cb][0], 0, 0, 0);
                Oacc[cb][1] = __builtin_amdgcn_mfma_f32_16x16x32_bf16(af, sb_[1], Oacc[cb][1], 0, 0, 0); }
        }
#pragma unroll
        for (int cb = 0; cb < 4; ++cb)
#pragma unroll
            for (int r = 0; r < 4; ++r) { const float dc = __builtin_amdgcn_exp2f((float)(16 * cb + 4 * fq + r + 1) * l2g); Oacc[cb][0][r] *= dc; Oacc[cb][1][r] *= dc; }
        LDS_BAR();
        bf16x8_t vf[2][2];
        tr_frag4(L0 + RT_VS, 528, 32 * w, 32 * w + 16, fr, fq, vf[0][0], vf[0][1], vf[1][0], vf[1][1]);
#pragma unroll
        for (int cb = 0; cb < 4; ++cb)
#pragma unroll
            for (int ks = 0; ks < 2; ++ks) { const bf16x8_t af = *(const LAS bf16x8_t*)(PS + (16 * cb + fr) * 144 + (32 * ks + 8 * fq) * 2);
                Oacc[cb][0] = __builtin_amdgcn_mfma_f32_16x16x32_bf16(af, vf[0][ks], Oacc[cb][0], 0, 0, 0);
                Oacc[cb][1] = __builtin_amdgcn_mfma_f32_16x16x32_bf16(af, vf[1][ks], Oacc[cb][1], 0, 0, 0); }
        LAS unsigned char* OT = c.lds + RT_OT;
#pragma unroll
        for (int cb = 0; cb < 4; ++cb)
#pragma unroll
            for (int en = 0; en < 2; ++en)
#pragma unroll
                for (int r = 0; r < 4; ++r) *(LAS bf16*)(OT + (16 * cb + 4 * fq + r) * 528 + (32 * w + 16 * en + fr) * 2) = f2bf(Oacc[cb][en][r]);
        { const float dS = __builtin_amdgcn_exp2f((float)nv * l2g);
#pragma unroll
          for (int d2 = 0; d2 < 4; ++d2) {
              bf16x8_t kf[2][2]; tr_frag4(L0 + RT_KD, 272, 32 * d2, 32 * d2 + 16, fr, fq, kf[0][0], kf[0][1], kf[1][0], kf[1][1]);
#pragma unroll
              for (int dd = 0; dd < 2; ++dd) { const int db = 2 * d2 + dd; Sacc[db][0] = Sacc[db][0] * dS; Sacc[db][1] = Sacc[db][1] * dS;
#pragma unroll
                  for (int ks = 0; ks < 2; ++ks) {
                      Sacc[db][0] = __builtin_amdgcn_mfma_f32_16x16x32_bf16(kf[dd][ks], vf[0][ks], Sacc[db][0], 0, 0, 0);
                      Sacc[db][1] = __builtin_amdgcn_mfma_f32_16x16x32_bf16(kf[dd][ks], vf[1][ks], Sacc[db][1], 0, 0, 0); } } } }
        LDS_BAR();
        asm volatile("" :: "v"(gcur[0]), "v"(gcur[1]), "v"(gcur[2]), "v"(gcur[3]), "v"(gn0), "v"(gn1));
#pragma unroll
        for (int i = 0; i < 4; ++i) { const int p = i * NT + tid_, r = p >> 5, q = p & 31;
            const u32x4 ov = *(const LAS u32x4*)(OT + r * 528 + q * 16);
            float o[8]; float s1 = 0.f, s2 = 0.f;
#pragma unroll
            for (int e = 0; e < 4; ++e) { o[2 * e] = __uint_as_float(ov[e] << 16); o[2 * e + 1] = __uint_as_float(ov[e] & 0xffff0000u); s1 += o[2 * e] + o[2 * e + 1]; s2 += o[2 * e] * o[2 * e] + o[2 * e + 1] * o[2 * e + 1]; }
            s1 = red32(s1); s2 = red32(s2);
            const float mu = s1 * (1.f / 256.f), var = fmaxf(s2 * (1.f / 256.f) - mu * mu, 0.f), rstd = __builtin_amdgcn_rsqf(var + 1e-6f);
            if (r < nv) { const u32x4 gv = gcur[i]; const f32x4 n0 = gn0, n1 = gn1;
                u32x4 out;
#pragma unroll
                for (int e = 0; e < 4; ++e) { const float g0 = __uint_as_float(gv[e] << 16), g1 = __uint_as_float(gv[e] & 0xffff0000u);
                    const float n_0 = e < 2 ? n0[2 * e] : n1[2 * e - 4], n_1 = e < 2 ? n0[2 * e + 1] : n1[2 * e - 3];
                    out[e] = pk2(g0 * (o[2 * e] - mu) * rstd * n_0, g1 * (o[2 * e + 1] - mu) * rstd * n_1); }
                *(u32x4*)(MIX + (size_t)(b * TP + t0 + r) * 2048 + hd * 256 + q * 8) = out; }
        }
    }
#undef RET_PREFETCH
    { const int fr = c.lane & 15, fq = c.lane >> 4; float* So = c.out + O_RETP + ((size_t)(j * BP + b) * 4 + hd) * 128 * 256 + 32 * w + fr;
#pragma unroll
      for (int db = 0; db < 8; ++db)
#pragma unroll
          for (int en = 0; en < 2; ++en)
#pragma unroll
              for (int r = 0; r < 4; ++r) So[(unsigned)((16 * db + 4 * fq + r) * 256 + 16 * en)] = Sacc[db][en][r]; }
    __syncthreads();
}
DEVI void f_ret_sample(const Ctx& c, const PArgs& a, int j, int b, int hd) {
    const bf16* Z = (const bf16*)(c.ws + WS_Z); bf16* MIX = (bf16*)(c.ws + WS_MIX);
    LAS float* qk = (LAS float*)c.lds;
    LAS float* op = qk + 256;
    const int row = MP + b, w = c.wave;
    const float gamma = 1.f - exp2f(-5.f - (float)hd);
    const float* S0 = a.in[I_SRET] + ((size_t)(j * BS + b) * 4 + hd) * 128 * 256 + 4 * c.lane; float* So = c.out + O_RETS + ((size_t)(j * BS + b) * 4 + hd) * 128 * 256 + 4 * c.lane;
    __syncthreads();
    if (c.tid < 256) qk[c.tid] = bf2f(Z[(size_t)row * NIN + (c.tid < 128 ? hd * 128 + c.tid : 512 + hd * 128 + c.tid - 128)]);
    const u32x2 vv = *(const u32x2*)(Z + (size_t)row * NIN + 1024 + hd * 256 + 4 * c.lane);
    const f32x4 v4 = (f32x4){__uint_as_float(vv.x << 16), __uint_as_float(vv.x & 0xffff0000u), __uint_as_float(vv.y << 16), __uint_as_float(vv.y & 0xffff0000u)};
    __syncthreads();
    f32x4 o4 = (f32x4){0.f, 0.f, 0.f, 0.f};
#pragma unroll 16
    for (int dd = 0; dd < 16; ++dd) { const int d = 16 * w + dd; f32x4 s = __builtin_nontemporal_load((const f32x4*)(S0 + (unsigned)(d * 256)));
        s = s * gamma + v4 * qk[128 + d]; __builtin_nontemporal_store(s, (f32x4*)(So + (unsigned)(d * 256))); o4 = o4 + s * qk[d]; }
    *(LAS f32x4*)(op + w * 256 + 4 * c.lane) = o4;
    __syncthreads();
    if (w == 0) {
        f32x4 o = (f32x4){0.f, 0.f, 0.f, 0.f};
#pragma unroll
        for (int ww = 0; ww < 8; ++ww) o = o + *(const LAS f32x4*)(op + ww * 256 + 4 * c.lane);
        const float mu = wave_sum((o.x + o.y) + (o.z + o.w)) * (1.f / 256.f); o = o - mu;
        const float rstd = __builtin_amdgcn_rsqf(wave_sum((o.x * o.x + o.y * o.y) + (o.z * o.z + o.w * o.w)) * (1.f / 256.f) + 1e-6f);
        const u32x2 gv = *(const u32x2*)(Z + (size_t)row * NIN + 2048 + hd * 256 + 4 * c.lane); const f32x4 n4 = *(const f32x4*)(a.in[I_ERGN] + (size_t)j * 1024 + hd * 256 + 4 * c.lane);
        u32x2 out; out.x = pk2(__uint_as_float(gv.x << 16) * o.x * rstd * n4.x, __uint_as_float(gv.x & 0xffff0000u) * o.y * rstd * n4.y);
        out.y = pk2(__uint_as_float(gv.y << 16) * o.z * rstd * n4.z, __uint_as_float(gv.y & 0xffff0000u) * o.w * rstd * n4.w);
        *(u32x2*)(MIX + (size_t)row * 2048 + hd * 256 + 4 * c.lane) = out;
    }
}

#ifndef WPB
#define WPB 180
#endif
#ifndef MIX_PART
#define MIX_PART 7
#endif
DEVI void f_even_mix(const Ctx& c, const PArgs& a, int li, int part) {
    const int j = li >> 1;
    if (c.bid < 32) { if (part & 1) f_ret_prompt(c, a, j, c.bid >> 2, c.bid & 3); }
    else if (c.bid < 104) { if (part & 2) { const bool pr = c.bid < 96; const int v = c.bid - 32;
        f_lru_unit(c, a, j, pr ? (v & 7) : (c.bid - 96), !pr, pr ? (v >> 3) : 0); } }
    if (part & 4) {
    if (c.bid >= 104) for (int u = c.bid - 104; u < 512; u += c.G - 104) f_ret_sample(c, a, j, u >> 2, u & 3);
    if (c.bid >= WPB && c.G > WPB) { __syncthreads(); f_wprep(c, a, li == 0 ? WM_L01 : WM_L23, (c.bid - WPB) * NWAVES + c.wave, (c.G - WPB) * NWAVES); }
    }
}

DEVI float gelu_fast(float x) { const float y = 1.5957691216057308f * (x + 0.044715f * x * x * x); return x * __builtin_amdgcn_rcpf(1.f + __expf(-y)); }
DEVI void f_ffn_act(const Ctx& c, const PArgs& a, int li) {
    const bf16* U = (const bf16*)(c.ws + WS_U); bf16* ACT = (bf16*)(c.ws + WS_ACT);
    const float* CW = a.in[I_FCW] + (size_t)li * 3 * DFF; const float* CB = a.in[I_FCB] + (size_t)li * DFF;
    constexpr int RCH = 32, NPC = DFF / 8, NRC = M / RCH, NITEM = NPC * NRC;
    for (int it = c.bid * NT + c.tid; it < NITEM; it += c.G * NT) {
        const int rc = it / NPC, pc = it - rc * NPC, col = pc * 8, r0 = rc * RCH;
        float w0[8], w1[8], w2[8], cb[8];
#pragma unroll
        for (int h = 0; h < 2; ++h) { const f32x4 a0 = *(const f32x4*)(CW + col + 4 * h), a1 = *(const f32x4*)(CW + DFF + col + 4 * h), a2 = *(const f32x4*)(CW + 2 * DFF + col + 4 * h), b0 = *(const f32x4*)(CB + col + 4 * h);
#pragma unroll
            for (int e = 0; e < 4; ++e) { w0[4 * h + e] = a0[e]; w1[4 * h + e] = a1[e]; w2[4 * h + e] = a2[e]; cb[4 * h + e] = b0[e]; } }
        const bf16* ub = U + (size_t)r0 * NUP + col; bf16* ab = ACT + (size_t)r0 * DFF + col;
        if (r0 < MP) {
            u32x4 p1 = (u32x4){0u, 0u, 0u, 0u}, p2 = p1;
            int t = r0 % TP;
            if (t >= 1) p1 = *(const u32x4*)(ub - NUP); if (t >= 2) p2 = *(const u32x4*)(ub - 2 * NUP);
#pragma unroll 1
            for (int i0 = 0; i0 < RCH; i0 += 8) {
                u32x4 ug[8], uv[8];
#pragma unroll
                for (int i = 0; i < 8; ++i) { ug[i] = *(const u32x4*)(ub + (unsigned)((i0 + i) * NUP)); uv[i] = *(const u32x4*)(ub + (unsigned)((i0 + i) * NUP + DFF)); }
#pragma unroll
                for (int i = 0; i < 8; ++i) {
                    if (t == 0) { p1 = (u32x4){0u, 0u, 0u, 0u}; p2 = p1; }
                    if (t >= TP - 2) { float* so = c.out + O_FCONVP + ((size_t)(li * BP + (r0 + i0 + i) / TP) * 2 + (t - (TP - 2))) * DFF + col;
#pragma unroll
                        for (int e = 0; e < 4; ++e) { so[2 * e] = __uint_as_float(ug[i][e] << 16); so[2 * e + 1] = __uint_as_float(ug[i][e] & 0xffff0000u); } }
                    u32x4 o;
#pragma unroll
                    for (int e = 0; e < 4; ++e) {
                        const float ca = cb[2 * e] + w2[2 * e] * __uint_as_float(ug[i][e] << 16) + w1[2 * e] * __uint_as_float(p1[e] << 16) + w0[2 * e] * __uint_as_float(p2[e] << 16);
                        const float cv = cb[2 * e + 1] + w2[2 * e + 1] * __uint_as_float(ug[i][e] & 0xffff0000u) + w1[2 * e + 1] * __uint_as_float(p1[e] & 0xffff0000u) + w0[2 * e + 1] * __uint_as_float(p2[e] & 0xffff0000u);
                        o[e] = pk2(gelu_fast(ca) * __uint_as_float(uv[i][e] << 16), gelu_fast(cv) * __uint_as_float(uv[i][e] & 0xffff0000u)); }
                    *(u32x4*)(ab + (unsigned)((i0 + i) * DFF)) = o;
                    p2 = p1; p1 = ug[i]; t = (t + 1 == TP) ? 0 : t + 1;
                }
            }
        } else {
#pragma unroll 1
            for (int i = 0; i < RCH; ++i) {
                const int row = r0 + i;
                const u32x4 ug = *(const u32x4*)(ub + (unsigned)(i * NUP)), uv = *(const u32x4*)(ub + (unsigned)(i * NUP + DFF));
                const float* st = a.in[I_SFCONV] + (size_t)(li * BS + row - MP) * 2 * DFF + col; float* so = c.out + O_FCONVS + (size_t)(li * BS + row - MP) * 2 * DFF + col;
                float f1[8], f2[8];
#pragma unroll
                for (int h = 0; h < 2; ++h) { const f32x4 s2 = *(const f32x4*)(st + 4 * h), s1 = *(const f32x4*)(st + DFF + 4 * h); *(f32x4*)(so + 4 * h) = s1;
#pragma unroll
                    for (int e = 0; e < 4; ++e) { f2[4 * h + e] = s2[e]; f1[4 * h + e] = s1[e]; } }
                u32x4 o;
#pragma unroll
                for (int e = 0; e < 4; ++e) { const float u0a = __uint_as_float(ug[e] << 16), u0b = __uint_as_float(ug[e] & 0xffff0000u);
                    so[DFF + 2 * e] = u0a; so[DFF + 2 * e + 1] = u0b;
                    const float ca = cb[2 * e] + w2[2 * e] * u0a + w1[2 * e] * f1[2 * e] + w0[2 * e] * f2[2 * e], cv = cb[2 * e + 1] + w2[2 * e + 1] * u0b + w1[2 * e + 1] * f1[2 * e + 1] + w0[2 * e + 1] * f2[2 * e + 1];
                    o[e] = pk2(gelu_fast(ca) * __uint_as_float(uv[e] << 16), gelu_fast(cv) * __uint_as_float(uv[e] & 0xffff0000u)); }
                *(u32x4*)(ab + (unsigned)(i * DFF)) = o;
            }
        }
    }
}

constexpr int RW_TG = 16;
constexpr int RW_BUF = 6 * RW_TG * 64 * 4;
constexpr int RW_Y = 2 * RW_BUF, RW_BON = RW_Y + RW_TG * 64 * 4, RW_END = RW_BON + RW_TG * 4;
DEVI void f_rwkv_prompt(const Ctx& c, const PArgs& a, int j, int b, int hd) {
    const bf16* R = (const bf16*)(c.ws + WS_R); const bf16* Kb = (const bf16*)(c.ws + WS_K);
    const bf16* VF = (const bf16*)((unsigned char*)c.out + DO_VFIRST); const bf16* Vb = j == 0 ? VF : (const bf16*)(c.ws + WS_V);
    const float* WD = (const float*)(c.ws + WS_WDEC); const bf16* AG = (const bf16*)(c.ws + WS_AG); const bf16* VG = (const bf16*)(c.ws + WS_VG); const bf16* GG = (const bf16*)(c.ws + WS_GG);
    bf16* O = (bf16*)(c.ws + WS_O);
    const int i = c.tid >> 3, q = c.tid & 7;
    const int st = c.tid >> 5, sc = (c.tid & 31) * 2, ch = hd * 64 + sc;
    const size_t rb = (size_t)(b * TP) * D + ch;
    const float kk0 = a.in[I_OKK][(size_t)j * D + ch], kk1 = a.in[I_OKK][(size_t)j * D + ch + 1], ka0 = a.in[I_OKA][(size_t)j * D + ch], ka1 = a.in[I_OKA][(size_t)j * D + ch + 1];
    const float rk0 = a.in[I_ORK][(size_t)j * D + ch], rk1 = a.in[I_ORK][(size_t)j * D + ch + 1];
    const float gg0 = a.in[I_OGNG][(size_t)j * D + ch], gg1 = a.in[I_OGNG][(size_t)j * D + ch + 1], gb0 = a.in[I_OGNB][(size_t)j * D + ch], gb1 = a.in[I_OGNB][(size_t)j * D + ch + 1];
    float s[8], z[8];
#pragma unroll
    for (int jj = 0; jj < 8; ++jj) { s[jj] = 0.f; z[jj] = 0.f; }
    unsigned pr_, pk_, pv_, pa_, pg_, pvf_ = 0u, pvg_ = 0u; float pw0, pw1;
#define RW_PREFETCH(t0) do { const unsigned o = (unsigned)(((t0) + st) * D); const bool ok = (t0) + st < TP; \
        pr_ = ok ? *(const unsigned*)(R + rb + o) : 0u; pk_ = ok ? *(const unsigned*)(Kb + rb + o) : 0u; pv_ = ok ? *(const unsigned*)(Vb + rb + o) : 0u; \
        pa_ = ok ? *(const unsigned*)(AG + rb + o) : 0u; pg_ = ok ? *(const unsigned*)(GG + rb + o) : 0u; \
        if (j == 1) { pvf_ = ok ? *(const unsigned*)(VF + rb + o) : 0u; pvg_ = ok ? *(const unsigned*)(VG + rb + o) : 0u; } \
        pw0 = ok ? WD[rb + o] : 1.f; pw1 = ok ? WD[rb + o + 1] : 1.f; } while (0)
    RW_PREFETCH(0);
    const int ngroups = (TP + RW_TG - 1) / RW_TG;
#pragma unroll 1
    for (int g = 0; g < ngroups; ++g) {
        const int t0 = g * RW_TG;
        LAS float* buf = (LAS float*)(c.lds + (g & 1) * RW_BUF);
        LAS float* ys = (LAS float*)(c.lds + RW_Y); LAS float* bon = (LAS float*)(c.lds + RW_BON);
        float gate0, gate1;
        { const float r0 = __uint_as_float(pr_ << 16), r1 = __uint_as_float(pr_ & 0xffff0000u), k0 = __uint_as_float(pk_ << 16), k1 = __uint_as_float(pk_ & 0xffff0000u);
          float v0 = __uint_as_float(pv_ << 16), v1 = __uint_as_float(pv_ & 0xffff0000u);
          const float a0 = __uint_as_float(pa_ << 16), a1 = __uint_as_float(pa_ & 0xffff0000u);
          gate0 = __uint_as_float(pg_ << 16); gate1 = __uint_as_float(pg_ & 0xffff0000u);
          if (j == 1) { const float f0 = __uint_as_float(pvf_ << 16), f1 = __uint_as_float(pvf_ & 0xffff0000u); v0 = v0 + (f0 - v0) * __uint_as_float(pvg_ << 16); v1 = v1 + (f1 - v1) * __uint_as_float(pvg_ & 0xffff0000u); }
          float q0 = k0 * kk0, q1 = k1 * kk1; const float ss = red32(q0 * q0 + q1 * q1); const float rn = __builtin_amdgcn_rsqf(fmaxf(ss, 1e-24f)); q0 *= rn; q1 *= rn;
          const float m0 = k0 * (1.f + (a0 - 1.f) * ka0), m1 = k1 * (1.f + (a1 - 1.f) * ka1);
          const float bs = red32(r0 * m0 * rk0 + r1 * m1 * rk1);
          const int o = st * 64 + sc;
          *(LAS f32x2_t*)(buf + o) = (f32x2_t){r0, r1}; *(LAS f32x2_t*)(buf + RW_TG * 64 + o) = (f32x2_t){pw0, pw1}; *(LAS f32x2_t*)(buf + 2 * RW_TG * 64 + o) = (f32x2_t){m0, m1};
          *(LAS f32x2_t*)(buf + 3 * RW_TG * 64 + o) = (f32x2_t){v0, v1}; *(LAS f32x2_t*)(buf + 4 * RW_TG * 64 + o) = (f32x2_t){-q0, -q1}; *(LAS f32x2_t*)(buf + 5 * RW_TG * 64 + o) = (f32x2_t){q0 * a0, q1 * a1};
          __syncthreads();
          if ((c.tid & 31) == 0) bon[st] = bs; }
        if (g + 1 < ngroups) RW_PREFETCH(t0 + RW_TG);
        const int nt = (TP - t0) < RW_TG ? (TP - t0) : RW_TG;
        if (c.tid < 256) {
#pragma unroll 4
        for (int tt = 0; tt < nt; ++tt) {
            const LAS float* p = buf + tt * 64 + 8 * q;
            const f32x4 ra = *(const LAS f32x4*)(p), rb2 = *(const LAS f32x4*)(p + 4), wa = *(const LAS f32x4*)(p + RW_TG * 64), wb = *(const LAS f32x4*)(p + RW_TG * 64 + 4);
            const f32x4 ka = *(const LAS f32x4*)(p + 2 * RW_TG * 64), kb2 = *(const LAS f32x4*)(p + 2 * RW_TG * 64 + 4), aa = *(const LAS f32x4*)(p + 4 * RW_TG * 64), ab = *(const LAS f32x4*)(p + 4 * RW_TG * 64 + 4);
            const f32x4 ba = *(const LAS f32x4*)(p + 5 * RW_TG * 64), bb = *(const LAS f32x4*)(p + 5 * RW_TG * 64 + 4);
            const float vi = buf[3 * RW_TG * 64 + tt * 64 + i], vj = buf[3 * RW_TG * 64 + tt * 64 + i + 32];
            const float sa = red8((s[0] * aa[0] + s[1] * aa[1]) + (s[2] * aa[2] + s[3] * aa[3]) + ((s[4] * ab[0] + s[5] * ab[1]) + (s[6] * ab[2] + s[7] * ab[3])));
            const float za = red8((z[0] * aa[0] + z[1] * aa[1]) + (z[2] * aa[2] + z[3] * aa[3]) + ((z[4] * ab[0] + z[5] * ab[1]) + (z[6] * ab[2] + z[7] * ab[3])));
#pragma unroll
            for (int jj = 0; jj < 4; ++jj) { s[jj] = s[jj] * wa[jj] + sa * ba[jj] + vi * ka[jj]; s[4 + jj] = s[4 + jj] * wb[jj] + sa * bb[jj] + vi * kb2[jj];
                z[jj] = z[jj] * wa[jj] + za * ba[jj] + vj * ka[jj]; z[4 + jj] = z[4 + jj] * wb[jj] + za * bb[jj] + vj * kb2[jj]; }
            const float y = red8((s[0] * ra[0] + s[1] * ra[1]) + (s[2] * ra[2] + s[3] * ra[3]) + ((s[4] * rb2[0] + s[5] * rb2[1]) + (s[6] * rb2[2] + s[7] * rb2[3])));
            const float y2 = red8((z[0] * ra[0] + z[1] * ra[1]) + (z[2] * ra[2] + z[3] * ra[3]) + ((z[4] * rb2[0] + z[5] * rb2[1]) + (z[6] * rb2[2] + z[7] * rb2[3])));
            if (q == 0) { ys[tt * 64 + i] = y; ys[tt * 64 + i + 32] = y2; }
        }
        }
        __syncthreads();
        if (t0 + st < TP) {
            const f32x2_t yv = *(const LAS f32x2_t*)(ys + st * 64 + sc), vv = *(const LAS f32x2_t*)(buf + 3 * RW_TG * 64 + st * 64 + sc);
            const float mu = red32(yv.x + yv.y) * (1.f / 64.f); const float d0 = yv.x - mu, d1 = yv.y - mu; const float var = red32(d0 * d0 + d1 * d1) * (1.f / 64.f);
            const float rs = 1.f / sqrtf(var + 64e-5f), bo = bon[st];
            const float o0 = (d0 * rs * gg0 + gb0 + bo * vv.x) * gate0, o1 = (d1 * rs * gg1 + gb1 + bo * vv.y) * gate1;
            *(unsigned*)(O + rb + (unsigned)((t0 + st) * D)) = pk2(o0, o1);
        }
    }
#undef RW_PREFETCH
    if (c.tid < 256) { float* So = c.out + O_RWKVP + ((size_t)(j * BP + b) * 16 + hd) * 4096 + i * 64 + 8 * q;
      *(f32x4*)So = (f32x4){s[0], s[1], s[2], s[3]}; *(f32x4*)(So + 4) = (f32x4){s[4], s[5], s[6], s[7]};
      *(f32x4*)(So + 2048) = (f32x4){z[0], z[1], z[2], z[3]}; *(f32x4*)(So + 2052) = (f32x4){z[4], z[5], z[6], z[7]}; }
    __syncthreads();
}
DEVI void f_rwkv_sample(const Ctx& c, const PArgs& a, int j, int b, int hd) {
    const bf16* R = (const bf16*)(c.ws + WS_R); const bf16* Kb = (const bf16*)(c.ws + WS_K);
    const bf16* VF = (const bf16*)((unsigned char*)c.out + DO_VFIRST); const bf16* Vb = j == 0 ? VF : (const bf16*)(c.ws + WS_V);
    const float* WD = (const float*)(c.ws + WS_WDEC); const bf16* AG = (const bf16*)(c.ws + WS_AG); const bf16* VG = (const bf16*)(c.ws + WS_VG); const bf16* GG = (const bf16*)(c.ws + WS_GG);
    bf16* O = (bf16*)(c.ws + WS_O);
    LAS float* buf = (LAS float*)c.lds;
    const int i = c.tid >> 3, q = c.tid & 7;
    const size_t so = ((size_t)(j * BS + b) * 16 + hd) * 4096 + i * 64 + 8 * q;
    const f32x4 sA = __builtin_nontemporal_load((const f32x4*)(a.in[I_SRWKV] + so)), sB = __builtin_nontemporal_load((const f32x4*)(a.in[I_SRWKV] + so + 4));
    float s[8] = {sA[0], sA[1], sA[2], sA[3], sB[0], sB[1], sB[2], sB[3]};
    float gate = 0.f;
    __syncthreads();
    if (c.tid < 64) { const int ch = hd * 64 + c.tid; const size_t o = (size_t)(MP + b) * D + ch;
        const float r = bf2f(R[o]), k = bf2f(Kb[o]), ag = bf2f(AG[o]), w = WD[o]; float v = bf2f(Vb[o]); gate = bf2f(GG[o]);
        if (j == 1) { const float vf = bf2f(VF[o]); v = v + (vf - v) * bf2f(VG[o]); }
        float kk = k * a.in[I_OKK][(size_t)j * D + ch]; const float ss = wave_sum(kk * kk); kk = kk / sqrtf(fmaxf(ss, 1e-24f));
        const float km = k * (1.f + (ag - 1.f) * a.in[I_OKA][(size_t)j * D + ch]);
        const float bs = wave_sum(r * km * a.in[I_ORK][(size_t)j * D + ch]);
        buf[c.tid] = r; buf[64 + c.tid] = w; buf[128 + c.tid] = km; buf[192 + c.tid] = v; buf[256 + c.tid] = -kk; buf[320 + c.tid] = kk * ag;
        if (c.tid == 0) buf[448] = bs; }
    __syncthreads();
    { float sa = 0.f;
#pragma unroll
      for (int jj = 0; jj < 8; ++jj) sa += s[jj] * buf[256 + 8 * q + jj];
      sa = red8(sa);
      const float vi = buf[192 + i]; float y = 0.f;
#pragma unroll
      for (int jj = 0; jj < 8; ++jj) { const int cj = 8 * q + jj; s[jj] = s[jj] * buf[64 + cj] + sa * buf[320 + cj] + vi * buf[128 + cj]; y += s[jj] * buf[cj]; }
      y = red8(y);
      if (q == 0) buf[384 + i] = y;
      float* Sout = c.out + O_RWKVS + so;
      __builtin_nontemporal_store((f32x4){s[0], s[1], s[2], s[3]}, (f32x4*)Sout); __builtin_nontemporal_store((f32x4){s[4], s[5], s[6], s[7]}, (f32x4*)(Sout + 4)); }
    __syncthreads();
    if (c.tid < 64) { const int ch = hd * 64 + c.tid;
        const float y = buf[384 + c.tid]; const float mu = wave_sum(y) * (1.f / 64.f); const float dy = y - mu; const float var = wave_sum(dy * dy) * (1.f / 64.f);
        float o = dy / sqrtf(var + 64e-5f) * a.in[I_OGNG][(size_t)j * D + ch] + a.in[I_OGNB][(size_t)j * D + ch];
        o = (o + buf[448] * buf[192 + c.tid]) * gate;
        O[(size_t)(MP + b) * D + ch] = f2bf(o); }
}
DEVI void f_odd_scan(const Ctx& c, const PArgs& a, int li) {
    const int j = li >> 1;
    if (c.bid < 128) f_rwkv_prompt(c, a, j, c.bid >> 4, c.bid & 15);
    else for (int u = c.bid - 128; u < 2048; u += c.G - 128) f_rwkv_sample(c, a, j, u >> 4, u & 15);
}

constexpr size_t DO_BON = 54 * MiB;
DEVI float red16(float x) { x += DPP_F(x, 0xB1); x += DPP_F(x, 0x4E); x += DPP_F(x, 0x141); x += DPP_F(x, 0x140); return x; }
constexpr int RW2_Y = 2 * RW_BUF, RW2_END = RW2_Y + 2 * RW_TG * 32 * 4;
DEVI void f_rwkv_prompt2(const Ctx& c, const PArgs& a, int j, int b, int hd, int half) {
    const bf16* R = (const bf16*)(c.ws + WS_R); const bf16* Kb = (const bf16*)(c.ws + WS_K);
    const bf16* VF = (const bf16*)((unsigned char*)c.out + DO_VFIRST); const bf16* Vb = j == 0 ? VF : (const bf16*)(c.ws + WS_V);
    const float* WD = (const float*)(c.ws + WS_WDEC); const bf16* AG = (const bf16*)(c.ws + WS_AG); const bf16* VG = (const bf16*)(c.ws + WS_VG);
    bf16* O = (bf16*)(c.ws + WS_O); float* BON = (float*)((unsigned char*)c.out + DO_BON);
    const int il = c.tid >> 4, q = c.tid & 15;
    const int st = c.tid >> 5, sc = (c.tid & 31) * 2, ch = hd * 64 + sc;
    const size_t rb = (size_t)(b * TP) * D + ch;
    const float kk0 = a.in[I_OKK][(size_t)j * D + ch], kk1 = a.in[I_OKK][(size_t)j * D + ch + 1], ka0 = a.in[I_OKA][(size_t)j * D + ch], ka1 = a.in[I_OKA][(size_t)j * D + ch + 1];
    const float rk0 = a.in[I_ORK][(size_t)j * D + ch], rk1 = a.in[I_ORK][(size_t)j * D + ch + 1];
    f32x4 s = (f32x4){0.f, 0.f, 0.f, 0.f};
    unsigned pr_, pk_, pv_, pa_, pvf_ = 0u, pvg_ = 0u; f32x2_t pw_;
#define RW2_PREFETCH(t0) do { const unsigned o = (unsigned)(((t0) + st) * D); const bool ok = (t0) + st < TP; \
        pr_ = ok ? *(const unsigned*)(R + rb + o) : 0u; pk_ = ok ? *(const unsigned*)(Kb + rb + o) : 0u; pv_ = ok ? *(const unsigned*)(Vb + rb + o) : 0u; pa_ = ok ? *(const unsigned*)(AG + rb + o) : 0u; \
        if (j == 1) { pvf_ = ok ? *(const unsigned*)(VF + rb + o) : 0u; pvg_ = ok ? *(const unsigned*)(VG + rb + o) : 0u; } \
        pw_ = ok ? *(const f32x2_t*)(WD + rb + o) : (f32x2_t){1.f, 1.f}; } while (0)
    RW2_PREFETCH(0);
    const int ngroups = (TP + RW_TG - 1) / RW_TG;
    LAS float* ys = (LAS float*)(c.lds + RW2_Y);
#pragma unroll 1
    for (int g = 0; g < ngroups; ++g) {
        const int t0 = g * RW_TG; const int nt = (TP - t0) < RW_TG ? (TP - t0) : RW_TG;
        LAS float* buf = (LAS float*)(c.lds + (g & 1) * RW_BUF);
        { const float r0 = __uint_as_float(pr_ << 16), r1 = __uint_as_float(pr_ & 0xffff0000u), k0 = __uint_as_float(pk_ << 16), k1 = __uint_as_float(pk_ & 0xffff0000u);
          float v0 = __uint_as_float(pv_ << 16), v1 = __uint_as_float(pv_ & 0xffff0000u);
          const float a0 = __uint_as_float(pa_ << 16), a1 = __uint_as_float(pa_ & 0xffff0000u);
          if (j == 1) { const float f0 = __uint_as_float(pvf_ << 16), f1 = __uint_as_float(pvf_ & 0xffff0000u); v0 = v0 + (f0 - v0) * __uint_as_float(pvg_ << 16); v1 = v1 + (f1 - v1) * __uint_as_float(pvg_ & 0xffff0000u); }
          float q0 = k0 * kk0, q1 = k1 * kk1; const float ss = red32(q0 * q0 + q1 * q1); const float rn = __builtin_amdgcn_rsqf(fmaxf(ss, 1e-24f)); q0 *= rn; q1 *= rn;
          const float m0 = k0 * (1.f + (a0 - 1.f) * ka0), m1 = k1 * (1.f + (a1 - 1.f) * ka1);
          const float bs = red32(r0 * m0 * rk0 + r1 * m1 * rk1);
          const int o = st * 64 + sc;
          *(LAS f32x2_t*)(buf + o) = (f32x2_t){r0, r1}; *(LAS f32x2_t*)(buf + RW_TG * 64 + o) = pw_; *(LAS f32x2_t*)(buf + 2 * RW_TG * 64 + o) = (f32x2_t){m0, m1};
          *(LAS f32x2_t*)(buf + 3 * RW_TG * 64 + o) = (f32x2_t){v0, v1}; *(LAS f32x2_t*)(buf + 4 * RW_TG * 64 + o) = (f32x2_t){-q0, -q1}; *(LAS f32x2_t*)(buf + 5 * RW_TG * 64 + o) = (f32x2_t){q0 * a0, q1 * a1};
          if (half == 0 && (c.tid & 31) == 0 && t0 + st < TP) BON[(size_t)(b * TP + t0 + st) * 16 + hd] = bs; }
        __syncthreads();
        if (g + 1 < ngroups) RW2_PREFETCH(t0 + RW_TG);
        {
            const LAS float* p = buf + 4 * q; const LAS float* pv = buf + 3 * RW_TG * 64 + 32 * half + il;
            f32x4 r4 = *(const LAS f32x4*)(p), w4 = *(const LAS f32x4*)(p + RW_TG * 64), k4 = *(const LAS f32x4*)(p + 2 * RW_TG * 64), a4 = *(const LAS f32x4*)(p + 4 * RW_TG * 64), b4 = *(const LAS f32x4*)(p + 5 * RW_TG * 64);
            float vi = pv[0];
#pragma unroll 2
            for (int tt = 0; tt < nt; ++tt) {
                const int tn = tt + 1 < nt ? tt + 1 : tt;
                const f32x4 nr4 = *(const LAS f32x4*)(p + tn * 64), nw4 = *(const LAS f32x4*)(p + RW_TG * 64 + tn * 64), nk4 = *(const LAS f32x4*)(p + 2 * RW_TG * 64 + tn * 64),
                            na4 = *(const LAS f32x4*)(p + 4 * RW_TG * 64 + tn * 64), nb4 = *(const LAS f32x4*)(p + 5 * RW_TG * 64 + tn * 64);
                const float nvi = pv[tn * 64];
                const float sa = red16((s[0] * a4[0] + s[1] * a4[1]) + (s[2] * a4[2] + s[3] * a4[3]));
                s = s * w4 + b4 * sa + k4 * vi;
                const float y = red16((s[0] * r4[0] + s[1] * r4[1]) + (s[2] * r4[2] + s[3] * r4[3]));
                if (q == 0) ys[tt * 32 + il] = y;
                r4 = nr4; w4 = nw4; k4 = nk4; a4 = na4; b4 = nb4; vi = nvi;
            }
        }
        __syncthreads();
        { const int tt = c.tid >> 5, cc = c.tid & 31; if (tt < nt) O[(size_t)(b * TP + t0 + tt) * D + hd * 64 + 32 * half + cc] = f2bf(ys[tt * 32 + cc]); }
    }
#undef RW2_PREFETCH
    { float* So = c.out + O_RWKVP + ((size_t)(j * BP + b) * 16 + hd) * 4096 + (32 * half + il) * 64 + 4 * q; *(f32x4*)So = s; }
    __syncthreads();
}
DEVI void f_rwkv_post(const Ctx& c, const PArgs& a, int li) {
    const int j = li >> 1;
    bf16* O = (bf16*)(c.ws + WS_O); const bf16* GG = (const bf16*)(c.ws + WS_GG); const bf16* VG = (const bf16*)(c.ws + WS_VG);
    const bf16* VF = (const bf16*)((unsigned char*)c.out + DO_VFIRST); const bf16* Vb = j == 0 ? VF : (const bf16*)(c.ws + WS_V); const float* BON = (const float*)((unsigned char*)c.out + DO_BON);
    const int pc = c.tid & 127, ch = pc * 8;
    const f32x4 g0 = *(const f32x4*)(a.in[I_OGNG] + (size_t)j * D + ch), g1 = *(const f32x4*)(a.in[I_OGNG] + (size_t)j * D + ch + 4), b0 = *(const f32x4*)(a.in[I_OGNB] + (size_t)j * D + ch), b1 = *(const f32x4*)(a.in[I_OGNB] + (size_t)j * D + ch + 4);
    for (int row = c.bid * 4 + (c.tid >> 7); row < MP; row += c.G * 4) {
        const size_t o = (size_t)row * D + ch;
        const u32x4 yv = *(const u32x4*)(O + o), vv = *(const u32x4*)(Vb + o), gv = *(const u32x4*)(GG + o);
        float y[8], v[8], gt[8];
#pragma unroll
        for (int e = 0; e < 4; ++e) { y[2 * e] = __uint_as_float(yv[e] << 16); y[2 * e + 1] = __uint_as_float(yv[e] & 0xffff0000u); v[2 * e] = __uint_as_float(vv[e] << 16); v[2 * e + 1] = __uint_as_float(vv[e] & 0xffff0000u);
            gt[2 * e] = __uint_as_float(gv[e] << 16); gt[2 * e + 1] = __uint_as_float(gv[e] & 0xffff0000u); }
        if (j == 1) { const u32x4 fv = *(const u32x4*)(VF + o), mv = *(const u32x4*)(VG + o);
#pragma unroll
            for (int e = 0; e < 4; ++e) { const float f0 = __uint_as_float(fv[e] << 16), f1 = __uint_as_float(fv[e] & 0xffff0000u), m0 = __uint_as_float(mv[e] << 16), m1 = __uint_as_float(mv[e] & 0xffff0000u);
                v[2 * e] = v[2 * e] + (f0 - v[2 * e]) * m0; v[2 * e + 1] = v[2 * e + 1] + (f1 - v[2 * e + 1]) * m1; } }
        float s1 = 0.f;
#pragma unroll
        for (int e = 0; e < 8; ++e) s1 += y[e];
        const float mu = red8(s1) * (1.f / 64.f); float s2 = 0.f;
#pragma unroll
        for (int e = 0; e < 8; ++e) { y[e] -= mu; s2 += y[e] * y[e]; }
        const float rs = __builtin_amdgcn_rsqf(red8(s2) * (1.f / 64.f) + 64e-5f), bo = BON[(size_t)row * 16 + (pc >> 3)];
        u32x4 out;
#pragma unroll
        for (int e = 0; e < 4; ++e) { const float gg0 = e < 2 ? g0[2 * e] : g1[2 * e - 4], gg1 = e < 2 ? g0[2 * e + 1] : g1[2 * e - 3], bb0 = e < 2 ? b0[2 * e] : b1[2 * e - 4], bb1 = e < 2 ? b0[2 * e + 1] : b1[2 * e - 3];
            out[e] = pk2((y[2 * e] * rs * gg0 + bb0 + bo * v[2 * e]) * gt[2 * e], (y[2 * e + 1] * rs * gg1 + bb1 + bo * v[2 * e + 1]) * gt[2 * e + 1]); }
        *(u32x4*)(O + o) = out;
    }
}
DEVI void f_odd_scan2(const Ctx& c, const PArgs& a, int li) {
    const int j = li >> 1;
    for (int u = c.bid; u < 256; u += c.G) f_rwkv_prompt2(c, a, j, u >> 5, (u >> 1) & 15, u & 1);
    for (int u = c.bid; u < 2048; u += c.G) f_rwkv_sample(c, a, j, u >> 4, u & 15);
}

constexpr int R_AF = 0, R_RF = 2048, R_BKF = 4096, R_VF = 8192, R_GF = 10240, R_RECA = 12288, R_RECB = 13312, R_PL = 14336, R_BON = 14592, RW3_REC = 14848;
constexpr int RW3_RING = 0, RW3_SCR = 8 * RW3_REC, RW3_SCRW = 5120, RW3_STAT = RW3_SCR + 4 * RW3_SCRW, RW3_END = RW3_STAT + 4096;
static_assert(RW3_END <= RING_BYTES, "rwkv3 lds");
#define DPP_RM(v, ctrl, rm) __builtin_bit_cast(float, __builtin_amdgcn_update_dpp(0, __builtin_bit_cast(int, (v)), (ctrl), (rm), 0xF, false))
DEVI float wsum64(float x) { x = red16(x); x += DPP_RM(x, 0x142, 0xA); x += DPP_RM(x, 0x143, 0xC); return __builtin_bit_cast(float, __builtin_amdgcn_readlane(__builtin_bit_cast(int, x), 63)); }
#define LWAIT() asm volatile("s_waitcnt lgkmcnt(0)" ::: "memory")
DEVI bf16x8_t frag_lohi(u32x2 lo, u32x2 hi) { u32x4 t; t.x = lo.x; t.y = lo.y; t.z = hi.x; t.w = hi.y; return __builtin_bit_cast(bf16x8_t, t); }
struct RwRaw { u32x2 r[4], k[4], v[4], a[4], g[4], f[4], m[4]; f32x4 w[4]; };
DEVI void rw3_load(const Ctx& c, RwRaw& q, int j, int b, int hd, int ck, int parts) {
    const bf16* R = (const bf16*)(c.ws + WS_R); const bf16* Kb = (const bf16*)(c.ws + WS_K);
    const bf16* VF_ = (const bf16*)((unsigned char*)c.out + DO_VFIRST); const bf16* Vb = j == 0 ? VF_ : (const bf16*)(c.ws + WS_V);
    const float* WD = (const float*)(c.ws + WS_WDEC); const bf16* AG = (const bf16*)(c.ws + WS_AG); const bf16* VG = (const bf16*)(c.ws + WS_VG); const bf16* GG = (const bf16*)(c.ws + WS_GG);
    const size_t rb = (size_t)(b * TP + ck * 16 + (c.lane & 15)) * D + hd * 64 + 4 * (c.lane >> 4);
#pragma unroll
    for (int n = 0; n < 4; ++n) { const size_t o = rb + 16 * n;
        if (parts & 4) { q.r[n] = *(const u32x2*)(R + o); q.k[n] = *(const u32x2*)(Kb + o); q.a[n] = *(const u32x2*)(AG + o); }
        if (parts & 2) q.w[n] = *(const f32x4*)(WD + o);
        if (parts & 1) { q.v[n] = *(const u32x2*)(Vb + o); q.g[n] = *(const u32x2*)(GG + o);
            if (j == 1) { q.f[n] = *(const u32x2*)(VF_ + o); q.m[n] = *(const u32x2*)(VG + o); } else { q.f[n] = (u32x2){0u, 0u}; q.m[n] = (u32x2){0u, 0u}; } } }
}
DEVI float bfe(u32x2 p, int e) { const unsigned u = e < 2 ? p.x : p.y; return (e & 1) ? __uint_as_float(u & 0xffff0000u) : __uint_as_float(u << 16); }
DEVI float fq_sum(float s) {
    u32x2 r = __builtin_amdgcn_permlane16_swap(__float_as_uint(s), __float_as_uint(s), false, false); s = __uint_as_float(r.x) + __uint_as_float(r.y);
    r = __builtin_amdgcn_permlane32_swap(__float_as_uint(s), __float_as_uint(s), false, false); return __uint_as_float(r.x) + __uint_as_float(r.y);
}
template <int S> DEVI float dpp_shr1(float x) { return __builtin_bit_cast(float, __builtin_amdgcn_update_dpp(0x3f800000, __builtin_bit_cast(int, x), 0x110 + S, 0xF, 0xF, false)); }
struct RwCoef { float kk[4][4], ka[4][4], rk[4][4]; };
#ifndef PREP_PRIO
#define PREP_PRIO 0
#endif
#ifndef CHAIN_PRIO
#define CHAIN_PRIO 3
#endif
constexpr int RW3_CF = 3072;
DEVI void rw3_prep(const Ctx& c, int j, int b, int hd, int ckn, RwRaw& q, LAS unsigned char* rec, LAS unsigned char* scr) {
    const int lane = c.lane, fr = lane & 15, fq = lane >> 4, t = fr;
    { const int lv = ((t >> 2) * 16 + 4 * fq) * 8 + (t & 3) * 2;
#pragma unroll
      for (int n = 0; n < 4; ++n)
#pragma unroll
        for (int e = 0; e < 4; ++e) { float v = bfe(q.v[n], e); if (j == 1) v = v + (bfe(q.f[n], e) - v) * bfe(q.m[n], e);
            *(LAS bf16*)(rec + R_VF + n * 512 + lv + e * 8) = f2bf(v);
            const unsigned gw = e < 2 ? q.g[n].x : q.g[n].y;
            *(LAS unsigned short*)(rec + R_GF + n * 512 + lv + e * 8) = (unsigned short)((e & 1) ? (gw >> 16) : gw); } }
    if (ckn >= 0) rw3_load(c, q, j, b, hd, ckn, 1);
    RwCoef cf;
#pragma unroll
    for (int n = 0; n < 4; ++n) { const f32x4 x0 = *(const LAS f32x4*)(scr + RW3_CF + (fq * 12 + n) * 16), x1 = *(const LAS f32x4*)(scr + RW3_CF + (fq * 12 + 4 + n) * 16), x2 = *(const LAS f32x4*)(scr + RW3_CF + (fq * 12 + 8 + n) * 16);
#pragma unroll
        for (int e = 0; e < 4; ++e) { cf.kk[n][e] = x0[e]; cf.ka[n][e] = x1[e]; cf.rk[n][e] = x2[e]; } }
    float ss = 0.f, bon = 0.f, P[4][4];
#pragma unroll
    for (int n = 0; n < 4; ++n)
#pragma unroll
        for (int e = 0; e < 4; ++e) { const float k = bfe(q.k[n], e), r = bfe(q.r[n], e), ag = bfe(q.a[n], e);
            const float kn = k * cf.kk[n][e]; ss += kn * kn;
            bon += r * (k * (1.f + (ag - 1.f) * cf.ka[n][e])) * cf.rk[n][e];
            P[n][e] = q.w[n][e]; }
    if (ckn >= 0) rw3_load(c, q, j, b, hd, ckn, 2);
    ss = fq_sum(ss); bon = fq_sum(bon);
    const float inv = __builtin_amdgcn_rsqf(fmaxf(ss, 1e-24f));
#pragma unroll
    for (int n = 0; n < 4; ++n)
#pragma unroll
        for (int e = 0; e < 4; ++e) { float x = P[n][e]; x = x * dpp_shr1<1>(x); x = x * dpp_shr1<2>(x); x = x * dpp_shr1<4>(x); x = x * dpp_shr1<8>(x); P[n][e] = x; }
    if (fq == 0) *(LAS float*)(rec + R_BON + t * 4) = bon;
    if (t == 15) {
#pragma unroll
        for (int n = 0; n < 4; ++n) *(LAS f32x4*)(rec + R_PL + (16 * n + 4 * fq) * 4) = (f32x4){P[n][0], P[n][1], P[n][2], P[n][3]}; }
    u32x4 afw[2], rfw[2], bfw[2], kfw[2];
#pragma unroll
    for (int kk = 0; kk < 2; ++kk) {
        float av[8], rv[8], bv[8], kv[8];
#pragma unroll
        for (int jj = 0; jj < 8; ++jj) { const int n = 2 * kk + (jj >> 2), e = jj & 3;
            const float k = bfe(q.k[n], e), r = bfe(q.r[n], e), ag = bfe(q.a[n], e);
            const float kn = k * cf.kk[n][e] * inv, km = k * (1.f + (ag - 1.f) * cf.ka[n][e]);
            const float Pn = P[n][e], Pm1 = dpp_shr1<1>(Pn), ip = rcpf_(Pn);
            av[jj] = -kn * Pm1; rv[jj] = r * Pn; bv[jj] = kn * ag * ip; kv[jj] = km * ip; }
        afw[kk] = (u32x4){pk2(av[0], av[1]), pk2(av[2], av[3]), pk2(av[4], av[5]), pk2(av[6], av[7])}; rfw[kk] = (u32x4){pk2(rv[0], rv[1]), pk2(rv[2], rv[3]), pk2(rv[4], rv[5]), pk2(rv[6], rv[7])};
        bfw[kk] = (u32x4){pk2(bv[0], bv[1]), pk2(bv[2], bv[3]), pk2(bv[4], bv[5]), pk2(bv[6], bv[7])}; kfw[kk] = (u32x4){pk2(kv[0], kv[1]), pk2(kv[2], kv[3]), pk2(kv[4], kv[5]), pk2(kv[6], kv[7])};
        *(LAS u32x4*)(rec + R_AF + (kk * 64 + lane) * 16) = afw[kk]; *(LAS u32x4*)(rec + R_RF + (kk * 64 + lane) * 16) = rfw[kk];
    }
    { const int lb = ((t >> 2) * 16 + 4 * fq) * 16 + (t & 3) * 2;
#pragma unroll
      for (int n = 0; n < 4; ++n)
#pragma unroll
        for (int e = 0; e < 4; ++e) { const int kk = n >> 1, jj = 4 * (n & 1) + e; const unsigned bw = bfw[kk][jj >> 1], kw = kfw[kk][jj >> 1];
            *(LAS unsigned short*)(rec + R_BKF + n * 1024 + lb + e * 16) = (unsigned short)((jj & 1) ? (bw >> 16) : bw);
            *(LAS unsigned short*)(rec + R_BKF + n * 1024 + lb + e * 16 + 8) = (unsigned short)((jj & 1) ? (kw >> 16) : kw);
        } }
    if (ckn >= 0) rw3_load(c, q, j, b, hd, ckn, 4);
    f32x4 Aab = (f32x4){0.f, 0.f, 0.f, 0.f}, Aak = Aab, Arb = Aab, Ark = Aab;
#pragma unroll
    for (int kk = 0; kk < 2; ++kk) {
        const bf16x8_t af = __builtin_bit_cast(bf16x8_t, afw[kk]), rf = __builtin_bit_cast(bf16x8_t, rfw[kk]), bf_ = __builtin_bit_cast(bf16x8_t, bfw[kk]), kf = __builtin_bit_cast(bf16x8_t, kfw[kk]);
        Aab = __builtin_amdgcn_mfma_f32_16x16x32_bf16(af, bf_, Aab, 0, 0, 0); Aak = __builtin_amdgcn_mfma_f32_16x16x32_bf16(af, kf, Aak, 0, 0, 0);
        Arb = __builtin_amdgcn_mfma_f32_16x16x32_bf16(rf, bf_, Arb, 0, 0, 0); Ark = __builtin_amdgcn_mfma_f32_16x16x32_bf16(rf, kf, Ark, 0, 0, 0); }
#pragma unroll
    for (int r = 0; r < 4; ++r) { const int t = 4 * fq + r;
        *(LAS float*)(scr + (t * 16 + fr) * 4) = t > fr ? Aab[r] : 0.f;
        *(LAS bf16*)(scr + 1024 + (t * 16 + fr) * 2) = f2bf(t > fr ? Aak[r] : 0.f);
        *(LAS bf16*)(scr + 1536 + (t * 16 + fr) * 2) = f2bf(t >= fr ? Arb[r] : 0.f);
        *(LAS bf16*)(scr + 2048 + (t * 16 + fr) * 2) = f2bf(t >= fr ? Ark[r] : 0.f); }
    LWAIT();
    float Tc[16];
#pragma unroll
    for (int t = 0; t < 16; ++t) {
        float acc = (t == fr) ? 1.f : 0.f, last = 0.f;
#pragma unroll
        for (int u4 = 0; u4 < (t + 3) / 4; ++u4) { const f32x4 ar = *(const LAS f32x4*)(scr + (t * 16 + 4 * u4) * 4);
#pragma unroll
            for (int e = 0; e < 4; ++e) { if (4 * u4 + e < t - 1) acc += ar[e] * Tc[4 * u4 + e]; if (4 * u4 + e == t - 1) last = ar[e]; } }
        Tc[t] = t > 0 ? acc + last * Tc[t > 0 ? t - 1 : 0] : acc; }
    if (fq == 0) {
#pragma unroll
        for (int t = 0; t < 16; ++t) *(LAS bf16*)(scr + 2560 + (t * 16 + fr) * 2) = f2bf(Tc[t]); }
    LWAIT();
    { const u32x2 ak = *(const LAS u32x2*)(scr + 1024 + (fr * 16 + 4 * fq) * 2), tt = *(const LAS u32x2*)(scr + 2560 + (fr * 16 + 4 * fq) * 2);
      const u32x2 rbv = *(const LAS u32x2*)(scr + 1536 + (fr * 16 + 4 * fq) * 2), rkv = *(const LAS u32x2*)(scr + 2048 + (fr * 16 + 4 * fq) * 2);
      *(LAS u32x4*)(rec + R_RECA + lane * 16) = (u32x4){ak.x, ak.y, tt.x, tt.y}; *(LAS u32x4*)(rec + R_RECB + lane * 16) = (u32x4){rbv.x, rbv.y, rkv.x, rkv.y}; }
    LWAIT();
}
DEVI void f_rwkv_chunked(const Ctx& c, const PArgs& a, int j, int b, int hd) {
    bf16* O = (bf16*)(c.ws + WS_O);
    const int w = c.wave, lane = c.lane, fr = lane & 15, fq = lane >> 4;
    constexpr int NCK = TP / 16, NGR = (NCK + 3) / 4;
    __syncthreads();
    if (w >= 4) {
        __builtin_amdgcn_s_setprio(PREP_PRIO);
        { LAS unsigned char* scr = c.lds + RW3_SCR + (w - 4) * RW3_SCRW;
          if (fr < 12) { const int n = fr & 3, which = fr >> 2; const size_t o = (size_t)j * D + hd * 64 + 16 * n + 4 * fq;
              const float* p0 = a.in[I_OKK]; const float* p1 = a.in[I_OKA]; const float* p2 = a.in[I_ORK];
              *(LAS f32x4*)(scr + RW3_CF + (fq * 12 + which * 4 + n) * 16) = *(const f32x4*)((which == 0 ? p0 : (which == 1 ? p1 : p2)) + o); }
          LWAIT(); }
        RwRaw q;
        rw3_load(c, q, j, b, hd, w - 4, 7);
        rw3_prep(c, j, b, hd, w, q, c.lds + RW3_RING + (w - 4) * RW3_REC, c.lds + RW3_SCR + (w - 4) * RW3_SCRW);
        __syncthreads();
#pragma unroll 1
        for (int g = 0; g < NGR; ++g) {
            const int ck = 4 * (g + 1) + (w - 4);
            if (ck < NCK) rw3_prep(c, j, b, hd, ck + 4 < NCK ? ck + 4 : -1, q, c.lds + RW3_RING + (((g + 1) & 1) * 4 + (w - 4)) * RW3_REC, c.lds + RW3_SCR + (w - 4) * RW3_SCRW);
            __syncthreads();
        }
    __builtin_amdgcn_s_setprio(0);
    } else {
        __builtin_amdgcn_s_setprio(CHAIN_PRIO);
        f32x4 G[4];
#pragma unroll
        for (int jb = 0; jb < 4; ++jb) G[jb] = (f32x4){0.f, 0.f, 0.f, 0.f};
        const int ch = hd * 64 + 16 * w + fr;
        const float gng = a.in[I_OGNG][(size_t)j * D + ch], gnb = a.in[I_OGNB][(size_t)j * D + ch];
        __syncthreads();
#pragma unroll 1
        for (int g = 0; g < NGR; ++g) {
            const int nck = (NCK - 4 * g) < 4 ? (NCK - 4 * g) : 4;
            f32x4 yk[4]; u32x2 vk[4], gk[4]; f32x4 bk[4];
            LAS float* stat = (LAS float*)(c.lds + RW3_STAT + (g & 1) * 2048);
#pragma unroll
            for (int q = 0; q < 4; ++q) {
                if (q < nck) {
                    const LAS unsigned char* rec = c.lds + RW3_RING + ((g & 1) * 4 + q) * RW3_REC;
                    bf16x8_t gb[2];
#pragma unroll
                    for (int kk = 0; kk < 2; ++kk) { u32x4 t; t.x = pk2(G[2 * kk][0], G[2 * kk][1]); t.y = pk2(G[2 * kk][2], G[2 * kk][3]); t.z = pk2(G[2 * kk + 1][0], G[2 * kk + 1][1]); t.w = pk2(G[2 * kk + 1][2], G[2 * kk + 1][3]); gb[kk] = __builtin_bit_cast(bf16x8_t, t); }
                    const u32x2 vf = *(const LAS u32x2*)(rec + R_VF + (w * 64 + lane) * 8); const u32x4 ra = *(const LAS u32x4*)(rec + R_RECA + lane * 16);
                    vk[q] = vf; gk[q] = *(const LAS u32x2*)(rec + R_GF + (w * 64 + lane) * 8); bk[q] = *(const LAS f32x4*)(rec + R_BON + 16 * fq);
                    const u32x2 z2 = (u32x2){0u, 0u};
                    f32x4 W = __builtin_amdgcn_mfma_f32_16x16x32_bf16(__builtin_bit_cast(bf16x8_t, ra), frag_lohi(vf, z2), (f32x4){0.f, 0.f, 0.f, 0.f}, 0, 0, 0);
                    W = __builtin_amdgcn_mfma_f32_16x16x32_bf16(*(const LAS bf16x8_t*)(rec + R_AF + lane * 16), gb[0], W, 0, 0, 0);
                    W = __builtin_amdgcn_mfma_f32_16x16x32_bf16(*(const LAS bf16x8_t*)(rec + R_AF + (64 + lane) * 16), gb[1], W, 0, 0, 0);
                    const u32x2 wlo = (u32x2){pk2(W[0], W[1]), pk2(W[2], W[3])};
                    const f32x4 U = __builtin_amdgcn_mfma_f32_16x16x32_bf16(frag_lohi((u32x2){ra.z, ra.w}, (u32x2){ra.x, ra.y}), frag_lohi(wlo, z2), (f32x4){0.f, 0.f, 0.f, 0.f}, 0, 0, 0);
                    const bf16x8_t ub = frag_lohi((u32x2){pk2(U[0], U[1]), pk2(U[2], U[3])}, vf);
                    f32x4 Y = __builtin_amdgcn_mfma_f32_16x16x32_bf16(*(const LAS bf16x8_t*)(rec + R_RF + lane * 16), gb[0], (f32x4){0.f, 0.f, 0.f, 0.f}, 0, 0, 0);
                    Y = __builtin_amdgcn_mfma_f32_16x16x32_bf16(*(const LAS bf16x8_t*)(rec + R_RF + (64 + lane) * 16), gb[1], Y, 0, 0, 0);
                    Y = __builtin_amdgcn_mfma_f32_16x16x32_bf16(*(const LAS bf16x8_t*)(rec + R_RECB + lane * 16), ub, Y, 0, 0, 0);
#pragma unroll
                    for (int jb = 0; jb < 4; ++jb) { G[jb] = __builtin_amdgcn_mfma_f32_16x16x32_bf16(*(const LAS bf16x8_t*)(rec + R_BKF + (jb * 64 + lane) * 16), ub, G[jb], 0, 0, 0);
                        G[jb] = G[jb] * *(const LAS f32x4*)(rec + R_PL + (16 * jb + 4 * fq) * 4); }
                    yk[q] = Y;
#pragma unroll
                    for (int r = 0; r < 4; ++r) { const float s1 = red16(Y[r]), s2 = red16(Y[r] * Y[r]); if (fr == 0) *(LAS f32x2_t*)(stat + ((q * 4 + w) * 16 + 4 * fq + r) * 2) = (f32x2_t){s1, s2}; }
                }
            }
            __syncthreads();
#pragma unroll
            for (int q = 0; q < 4; ++q) {
                if (q < nck) {
#pragma unroll
                    for (int r = 0; r < 4; ++r) { const int t = 4 * fq + r; float s1 = 0.f, s2 = 0.f;
#pragma unroll
                        for (int ww = 0; ww < 4; ++ww) { const f32x2_t sv = *(const LAS f32x2_t*)(stat + ((q * 4 + ww) * 16 + t) * 2); s1 += sv.x; s2 += sv.y; }
                        const float mu = s1 * (1.f / 64.f), var = fmaxf(s2 * (1.f / 64.f) - mu * mu, 0.f), rs = __builtin_amdgcn_rsqf(var + 64e-5f);
                        const unsigned vb_ = r < 2 ? vk[q].x : vk[q].y, gb_ = r < 2 ? gk[q].x : gk[q].y;
                        const float v = (r & 1) ? __uint_as_float(vb_ & 0xffff0000u) : __uint_as_float(vb_ << 16), gt = (r & 1) ? __uint_as_float(gb_ & 0xffff0000u) : __uint_as_float(gb_ << 16);
                        const float o = ((yk[q][r] - mu) * rs * gng + gnb + bk[q][r] * v) * gt;
                        O[(size_t)(b * TP + (4 * g + q) * 16 + t) * D + ch] = f2bf(o); }
                }
            }
        }
        float* So = c.out + O_RWKVP + ((size_t)(j * BP + b) * 16 + hd) * 4096 + (size_t)(16 * w + fr) * 64 + 4 * fq;
#pragma unroll
        for (int jb = 0; jb < 4; ++jb) *(f32x4*)(So + 16 * jb) = G[jb];
        __builtin_amdgcn_s_setprio(0);
    }
    __syncthreads();
}
#ifndef SSB
#define SSB 160
#endif
#ifndef SCAN_PART
#define SCAN_PART 3
#endif
DEVI void f_odd_scan3(const Ctx& c, const PArgs& a, int li, int part) {
    const int j = li >> 1;
    if (c.bid < 128) { if (part & 1) f_rwkv_chunked(c, a, j, c.bid >> 4, c.bid & 15); }
    else if ((part & 2) && c.bid >= SSB) for (int u = c.bid - SSB; u < 2048; u += c.G - SSB) f_rwkv_sample(c, a, j, u >> 4, u & 15);
}

template <int CTRL> DEVI float dppz(float x) { return __builtin_bit_cast(float, __builtin_amdgcn_update_dpp(0, __builtin_bit_cast(int, x), CTRL, 0xF, 0xF, true)); }
struct EpiUpAct {
    static constexpr bool PERM = true;
    bf16* U; bf16* ACT; const float* RS; const float* CW; const float* CB; float* FCP;
    DEVI void operator()(const f32x4 (&acc)[2][2][4][2], const pg8::Unit& u, int wr, int wc, int fr, int fq) const {
        const int f0 = u.pn * 128 + wc * 32 + fq * 8;
        f32x4 w0[2], w1[2], w2[2], cb[2];
#pragma unroll
        for (int n = 0; n < 2; ++n) { w0[n] = *(const f32x4*)(CW + f0 + 4 * n); w1[n] = *(const f32x4*)(CW + DFF + f0 + 4 * n); w2[n] = *(const f32x4*)(CW + 2 * DFF + f0 + 4 * n); cb[n] = *(const f32x4*)(CB + f0 + 4 * n); }
        float rsv[2][4];
        { f32x4 rq[2][4];
#pragma unroll
          for (int ai = 0; ai < 2; ++ai)
#pragma unroll
            for (int m = 0; m < 4; ++m) rq[ai][m] = *(const f32x4*)(RS + (size_t)(u.pm * 256 + ai * 128 + wr * 64 + m * 16 + fr) * 16 + 4 * fq);
          asm volatile("" ::: "memory");
#pragma unroll
          for (int ai = 0; ai < 2; ++ai)
#pragma unroll
            for (int m = 0; m < 4; ++m) rsv[ai][m] = row_rstd_fin(rq[ai][m]); }
#pragma unroll
        for (int ai = 0; ai < 2; ++ai) {
            const int rowg = u.pm * 256 + ai * 128 + wr * 64;
            const bool sample = rowg >= MP;
            f32x4 ug[4][2];
            float rs[4];
#pragma unroll
            for (int m = 0; m < 4; ++m) { rs[m] = rsv[ai][m]; ug[m][0] = acc[ai][0][m][0] * rs[m]; ug[m][1] = acc[ai][0][m][1] * rs[m]; }
#pragma unroll
            for (int m = 3; m >= 0; --m) {
                const int row = rowg + m * 16 + fr; const int tt = sample ? 16 : (rowg + m * 16) % TP;
                const f32x4 uv0 = acc[ai][1][m][0] * rs[m], uv1 = acc[ai][1][m][1] * rs[m];
                f32x4 p1[2], p2[2];
#pragma unroll
                for (int n = 0; n < 2; ++n)
#pragma unroll
                    for (int e = 0; e < 4; ++e) {
                        const float cur = ug[m][n][e];
                        float q1 = dppz<0x111>(cur), q2 = dppz<0x112>(cur);
                        if (m > 0) { const float prv = ug[m > 0 ? m - 1 : 0][n][e]; q1 += dppz<0x10F>(prv); q2 += dppz<0x10E>(prv); }
                        p1[n][e] = q1; p2[n][e] = q2;
                        if (tt == 0) { if (fr == 0) p1[n][e] = 0.f; if (fr < 2) p2[n][e] = 0.f; } }
                const bool pending = sample || (m == 0 && fr < 2);
                if (pending || (m == 3 && fr >= 14)) *(u32x4*)(U + (size_t)row * NUP + f0) = pack8(ug[m][0], ug[m][1]);
                if (pending) *(u32x4*)(U + (size_t)row * NUP + DFF + f0) = pack8(uv0, uv1);
                else {
                    f32x4 o0, o1;
#pragma unroll
                    for (int e = 0; e < 4; ++e) { o0[e] = geluf_(cb[0][e] + w2[0][e] * ug[m][0][e] + w1[0][e] * p1[0][e] + w0[0][e] * p2[0][e]) * uv0[e];
                        o1[e] = geluf_(cb[1][e] + w2[1][e] * ug[m][1][e] + w1[1][e] * p1[1][e] + w0[1][e] * p2[1][e]) * uv1[e]; }
                    *(u32x4*)(ACT + (size_t)row * DFF + f0) = pack8(o0, o1);
                    if (tt == TP - 16 && fr >= 14) { float* so = FCP + ((size_t)(row / TP) * 2 + (fr - 14)) * DFF + f0; *(f32x4*)so = ug[m][0]; *(f32x4*)(so + 4) = ug[m][1]; }
                }
            }
        }
    }
};
DEVI void f_ffn_up_act(const Ctx& c, const PArgs& a, int li) {
    pg8::Gemm g{(const bf16*)(c.ws + WS_XB), (const bf16*)(c.ws + WS_WB + WB_WUP + li * SZ_WUP), M, NUP, D, D, 0ull, 0};
    pg8::StaticOrder S; S.init(M, NUP, c.G, c.bid);
    EpiUpAct E{(bf16*)(c.ws + WS_U), (bf16*)(c.ws + WS_ACT), (const float*)(c.ws + WS_RS), a.in[I_FCW] + (size_t)li * 3 * DFF, a.in[I_FCB] + (size_t)li * DFF, c.out + O_FCONVP + (size_t)li * BP * 2 * DFF};
    pg8::gemm_phase<EpiUpAct>(c.lds, c.tid, g, S, E);
}
DEVI void f_ffn_fix(const Ctx& c, const PArgs& a, int li) {
    const bf16* U = (const bf16*)(c.ws + WS_U); bf16* ACT = (bf16*)(c.ws + WS_ACT);
    const float* CW = a.in[I_FCW] + (size_t)li * 3 * DFF; const float* CB = a.in[I_FCB] + (size_t)li * DFF;
    constexpr int NPC = DFF / 8, NROW = (MP / 64) * 2 + BS, NITEM = NPC * NROW;
    for (int it = c.bid * NT + c.tid; it < NITEM; it += c.G * NT) {
        const int ri = it / NPC, pc = it - ri * NPC, col = pc * 8;
        const int row = ri < (MP / 64) * 2 ? (ri >> 1) * 64 + (ri & 1) : MP + (ri - (MP / 64) * 2);
        const u32x4 ug = *(const u32x4*)(U + (size_t)row * NUP + col), uv = *(const u32x4*)(U + (size_t)row * NUP + DFF + col);
        float f1[8], f2[8];
        if (row < MP) { const int t = row % TP; u32x4 p1 = (u32x4){0u, 0u, 0u, 0u}, p2 = p1;
            if (t >= 1) p1 = *(const u32x4*)(U + (size_t)(row - 1) * NUP + col); if (t >= 2) p2 = *(const u32x4*)(U + (size_t)(row - 2) * NUP + col);
#pragma unroll
            for (int e = 0; e < 4; ++e) { f1[2 * e] = __uint_as_float(p1[e] << 16); f1[2 * e + 1] = __uint_as_float(p1[e] & 0xffff0000u); f2[2 * e] = __uint_as_float(p2[e] << 16); f2[2 * e + 1] = __uint_as_float(p2[e] & 0xffff0000u); }
        } else { const float* st = a.in[I_SFCONV] + (size_t)(li * BS + row - MP) * 2 * DFF + col; float* so = c.out + O_FCONVS + (size_t)(li * BS + row - MP) * 2 * DFF + col;
#pragma unroll
            for (int h = 0; h < 2; ++h) { const f32x4 s2 = *(const f32x4*)(st + 4 * h), s1 = *(const f32x4*)(st + DFF + 4 * h); *(f32x4*)(so + 4 * h) = s1;
#pragma unroll
                for (int e = 0; e < 4; ++e) { f2[4 * h + e] = s2[e]; f1[4 * h + e] = s1[e]; } }
#pragma unroll
            for (int e = 0; e < 4; ++e) { so[DFF + 2 * e] = __uint_as_float(ug[e] << 16); so[DFF + 2 * e + 1] = __uint_as_float(ug[e] & 0xffff0000u); } }
        u32x4 o;
#pragma unroll
        for (int e = 0; e < 4; ++e) { const float u0a = __uint_as_float(ug[e] << 16), u0b = __uint_as_float(ug[e] & 0xffff0000u);
            const float ca = CB[col + 2 * e] + CW[2 * DFF + col + 2 * e] * u0a + CW[DFF + col + 2 * e] * f1[2 * e] + CW[col + 2 * e] * f2[2 * e];
            const float cv = CB[col + 2 * e + 1] + CW[2 * DFF + col + 2 * e + 1] * u0b + CW[DFF + col + 2 * e + 1] * f1[2 * e + 1] + CW[col + 2 * e + 1] * f2[2 * e + 1];
            o[e] = pk2(geluf_(ca) * __uint_as_float(uv[e] << 16), geluf_(cv) * __uint_as_float(uv[e] & 0xffff0000u)); }
        *(u32x4*)(ACT + (size_t)row * DFF + col) = o;
    }
}

DEVI void f_odd_norm(const Ctx& c, const PArgs& a, int li) {
    const int j = li >> 1;
    const bf16* XB = (const bf16*)(c.ws + WS_XB); const float* RS = (const float*)(c.ws + WS_RS); bf16* XM = (bf16*)(c.ws + WS_XMIX);
    const float* gain = a.in[I_NMIX] + (size_t)li * D; const float* mix = a.in[I_OMIX] + (size_t)j * 6 * D;
    const int gw = c.bid * NWAVES + c.wave, NGW = c.G * NWAVES;
    const int r0 = (int)(((long)gw * M) / NGW), r1 = (int)(((long)(gw + 1) * M) / NGW);
    f32x4 gv[4], mv[6][4];
#pragma unroll
    for (int q = 0; q < 4; ++q) { const int col = q * 256 + c.lane * 4; gv[q] = *(const f32x4*)(gain + col);
#pragma unroll
        for (int n = 0; n < 6; ++n) mv[n][q] = *(const f32x4*)(mix + (size_t)n * D + col); }
    f32x4 hprev[4];
#pragma unroll
    for (int q = 0; q < 4; ++q) hprev[q] = (f32x4){0.f, 0.f, 0.f, 0.f};
    for (int rowp = r0; rowp < r1; rowp += 2) {
        f32x4 rq[2][4]; u32x2 xw[2][4];
#pragma unroll
        for (int h2 = 0; h2 < 2; ++h2) { const int row = (rowp + h2 < r1) ? rowp + h2 : rowp;
            const f32x4* rp = (const f32x4*)(RS + (size_t)row * 16); rq[h2][0] = rp[0]; rq[h2][1] = rp[1]; rq[h2][2] = rp[2]; rq[h2][3] = rp[3];
#pragma unroll
            for (int q = 0; q < 4; ++q) xw[h2][q] = *(const u32x2*)(XB + (size_t)row * D + q * 256 + c.lane * 4); }
        asm volatile("" ::: "memory");
#pragma unroll
        for (int h2 = 0; h2 < 2; ++h2) { const int row = rowp + h2;
          if (row < r1) {
            const bool prompt = row < MP; const int b = prompt ? row / TP : row - MP, t = prompt ? row % TP : 0;
            const bool need_prev = prompt && t > 0 && row == r0;
            const f32x4 q0 = rq[h2][0], q1 = rq[h2][1], q2 = rq[h2][2], q3 = rq[h2][3];
            const float rs = __builtin_amdgcn_rsqf((((q0.x + q0.y) + (q0.z + q0.w)) + ((q1.x + q1.y) + (q1.z + q1.w)) + ((q2.x + q2.y) + (q2.z + q2.w)) + ((q3.x + q3.y) + (q3.z + q3.w))) * (1.0f / D) + 1e-6f);
            const float rsp = need_prev ? row_rstd(RS, row - 1) : 0.f;
#pragma unroll
            for (int q = 0; q < 4; ++q) { const int col = q * 256 + c.lane * 4;
                const u32x2 xw_ = xw[h2][q];
                const f32x4 h = (f32x4){__uint_as_float(xw_.x << 16), __uint_as_float(xw_.x & 0xffff0000u), __uint_as_float(xw_.y << 16), __uint_as_float(xw_.y & 0xffff0000u)} * rs * gv[q];
                f32x4 hp = hprev[q];
                if (!prompt) hp = *(const f32x4*)(a.in[I_SSHIFT] + (size_t)(j * BS + b) * D + col);
                else if (t == 0) hp = (f32x4){0.f, 0.f, 0.f, 0.f};
                else if (need_prev) { const u32x2 pw_ = *(const u32x2*)(XB + (size_t)(row - 1) * D + col);
                    hp = (f32x4){__uint_as_float(pw_.x << 16), __uint_as_float(pw_.x & 0xffff0000u), __uint_as_float(pw_.y << 16), __uint_as_float(pw_.y & 0xffff0000u)} * rsp * gv[q]; }
                const f32x4 xx = hp - h;
#pragma unroll
                for (int n = 0; n < 6; ++n) { const f32x4 o = h + xx * mv[n][q]; u32x2 w; w.x = pk2(o.x, o.y); w.y = pk2(o.z, o.w); *(u32x2*)(XM + ((size_t)n * M + row) * D + col) = w; }
                if (prompt) { if (t == TP - 1) *(f32x4*)(c.out + O_SHIFTP + (size_t)(j * BP + b) * D + col) = h; }
                else *(f32x4*)(c.out + O_SHIFTS + (size_t)(j * BS + b) * D + col) = h;
                hprev[q] = h; } } }
    }
}

DEVI void f_tail_residual(const Ctx& c, const bf16* A, int lda, const bf16* Bt, int K, bool wxb) {
    float* X = (float*)(c.ws + WS_X); bf16* XB = (bf16*)(c.ws + WS_XB); float* RS = (float*)(c.ws + WS_RS);
    LAS float* red = (LAS float*)c.lds;
    const int fr = c.lane & 15, fq = c.lane >> 4, nks = K / 32;
    for (int task = c.bid; task < 256; task += c.G) {
        const int row0 = M_MAIN + (task >> 4) * 16, col0 = (task & 15) * 64;
        const bf16* ap = A + (size_t)(row0 + fr) * lda + 8 * fq; const bf16* bp = Bt + (size_t)(col0 + fr) * K + 8 * fq;
        f32x4 acc[4];
#pragma unroll
        for (int nb = 0; nb < 4; ++nb) acc[nb] = (f32x4){0.f, 0.f, 0.f, 0.f};
#pragma unroll 1
        for (int ks0 = c.wave; ks0 < nks; ks0 += 32) {
            bf16x8_t af[4], bf_[4][4];
#pragma unroll
            for (int u = 0; u < 4; ++u) { const int ks = ks0 + 8 * u; const bool ok = ks < nks; const unsigned ko = (unsigned)(32 * (ok ? ks : 0));
                af[u] = *(const bf16x8_t*)(ap + ko);
#pragma unroll
                for (int nb = 0; nb < 4; ++nb) bf_[u][nb] = *(const bf16x8_t*)(bp + (unsigned)(16 * nb * K) + ko);
                if (!ok) af[u] = (bf16x8_t){0, 0, 0, 0, 0, 0, 0, 0}; }
#pragma unroll
            for (int u = 0; u < 4; ++u)
#pragma unroll
                for (int nb = 0; nb < 4; ++nb) acc[nb] = __builtin_amdgcn_mfma_f32_16x16x32_bf16(af[u], bf_[u][nb], acc[nb], 0, 0, 0);
        }
        __syncthreads();
#pragma unroll
        for (int nb = 0; nb < 4; ++nb)
#pragma unroll
            for (int r = 0; r < 4; ++r) red[(c.wave * 16 + 4 * fq + r) * 64 + 16 * nb + fr] = acc[nb][r];
        __syncthreads();
        { const int r = c.tid >> 5, cc = 2 * (c.tid & 31); float v0 = 0.f, v1 = 0.f;
#pragma unroll
          for (int w = 0; w < 8; ++w) { const f32x2_t t = *(const LAS f32x2_t*)(red + (w * 16 + r) * 64 + cc); v0 += t.x; v1 += t.y; }
          const size_t o = (size_t)(row0 + r) * D + col0 + cc;
          const unsigned xo = *(const unsigned*)(XB + o); v0 += __uint_as_float(xo << 16); v1 += __uint_as_float(xo & 0xffff0000u);
          (void)wxb; (void)X; *(unsigned*)(XB + o) = pk2(v0, v1);
          const float ss = red32(v0 * v0 + v1 * v1);
          if ((c.tid & 31) == 0) RS[(size_t)(row0 + r) * 16 + (task & 15)] = ss; }
    }
    __syncthreads();
}

__global__ void __launch_bounds__(NT, 2) hybrid_fwd(Args args) {
    extern __shared__ __attribute__((aligned(16))) unsigned char lds_raw[];
    Ctx c;
    c.lds = (LAS unsigned char*)lds_raw;
    c.tid = threadIdx.x; c.lane = c.tid & 63; c.wave = __builtin_amdgcn_readfirstlane(c.tid >> 6);
    c.G = gridDim.x; c.bid = blockIdx.x; c.ws = args.ws; c.out = args.out;
    volatile LAS unsigned* MISC = (volatile LAS unsigned*)(c.lds + MISC_OFF);
    for (int u = c.tid; u < (LDS_BYTES - LDSCTL_OFF) / 4; u += NT) ((LAS unsigned*)(c.lds + LDSCTL_OFF))[u] = 0u;
    __syncthreads();
    if (c.tid < N_IN) ((LAS unsigned long long*)(c.lds + PTAB_OFF))[c.tid] = (unsigned long long)args.in[c.tid];
    __syncthreads();
    PArgs pa; pa.in.t = (const LAS unsigned long long*)(c.lds + PTAB_OFF);
    (void)xcd_barrier_post((unsigned*)(c.ws + WS_CTL) + 4096, MISC + 8);
#define GRID_BAR() do { XcdBarrier bar_; bar_.bar = (unsigned*)(c.ws + WS_CTL) + 4096; bar_.x = xb_xcc_id(); bar_.st = (volatile LAS unsigned*)(c.lds + MISC_OFF) + 8; xcd_barrier(bar_); } while (0)
#define RETID() do { asm volatile("" : "+s"(c.wave), "+s"(c.bid), "+s"(c.G)); asm volatile("v_mbcnt_lo_u32_b32 %0, -1, 0\n\tv_mbcnt_hi_u32_b32 %0, -1, %0" : "=v"(c.lane)); c.tid = c.wave * 64 + c.lane; } while (0)
#define PHASE(body) do { RETID(); body; GRID_BAR(); } while (0)
    for (int rep = 0; rep < REP_PRO; ++rep) PHASE({ n_prologue(c, pa); f_wprep(c, pa, 1ull, c.bid * NWAVES + c.wave, c.G * NWAVES); });
#pragma unroll 1
    for (int li = 0; li < 4; ++li) {
        const int j = li >> 1;
        if ((li & 1) == 0) {
#if FAST & 1
            for (int rep = 0; rep < REP_G; ++rep) PHASE(f_even_in(c, li));
#else
            PHASE(n_even_in(c, pa, li));
#endif
#if FAST & 32
            for (int rep = 0; rep < REP_MIX; ++rep) PHASE(f_even_mix(c, pa, li, rep == 0 ? 7 : MIX_PART));
#else
            PHASE(n_even_mix(c, pa, li));
#endif
#if FAST & 2
            PHASE({ f_gemm_residual(c, (const bf16*)(c.ws + WS_MIX), 2048, (const bf16*)(c.ws + WS_WB + WB_WOUT + j * SZ_WOUT), 2048, true); RETID(); f_tail_residual(c, (const bf16*)(c.ws + WS_MIX), 2048, (const bf16*)(c.ws + WS_WB + WB_WOUT + j * SZ_WOUT), 2048, true); });
#else
            PHASE(n_gemm_residual(c, (const bf16*)(c.ws + WS_MIX), 2048, pa.in[I_EWOUT] + (size_t)j * 2048 * D, 2048, true));
#endif
        } else {
            for (int rep = 0; rep < REP_NORM; ++rep) PHASE(f_odd_norm(c, pa, li));
#if FAST & 8
            for (int rep = 0; rep < REP_G; ++rep) PHASE(f_odd_in(c, li));
#else
            PHASE(n_odd_in(c, pa, li));
#endif
#if FAST & 16
            for (int rep = 0; rep < REP_G; ++rep) PHASE(f_odd_lora(c, pa, li));
#else
            PHASE(n_odd_lora(c, pa, li));
#endif
#if FAST & 128
#if FAST & 512
            for (int rep = 0; rep < REP_SCAN; ++rep) PHASE(f_odd_scan3(c, pa, li, rep == 0 ? 3 : SCAN_PART));
#elif FAST & 256
            for (int rep = 0; rep < REP_SCAN; ++rep) { PHASE(f_odd_scan2(c, pa, li)); PHASE(f_rwkv_post(c, pa, li)); }
#else
            for (int rep = 0; rep < REP_SCAN; ++rep) PHASE(f_odd_scan(c, pa, li));
#endif
#else
            for (int rep = 0; rep < REP_SCAN; ++rep) PHASE(n_odd_scan(c, pa, li));
#endif
#if FAST & 2
            PHASE({ f_gemm_residual(c, (const bf16*)(c.ws + WS_O), D, (const bf16*)(c.ws + WS_WB + WB_WO + j * SZ_WO), D, true); RETID(); f_tail_residual(c, (const bf16*)(c.ws + WS_O), D, (const bf16*)(c.ws + WS_WB + WB_WO + j * SZ_WO), D, true); });
#else
            PHASE(n_gemm_residual(c, (const bf16*)(c.ws + WS_O), D, pa.in[I_OWO] + (size_t)j * D * D, D, true));
#endif
        }
#if FUSE_ACT
        for (int rep = 0; rep < REP_G; ++rep) PHASE(f_ffn_up_act(c, pa, li));
        PHASE(f_ffn_fix(c, pa, li));
#else
#if FAST & 4
        for (int rep = 0; rep < REP_G; ++rep) PHASE(f_ffn_up(c, li));
#else
        PHASE(n_ffn_up(c, pa, li));
#endif
#if FAST & 64
        for (int rep = 0; rep < REP_ACT; ++rep) PHASE(f_ffn_act(c, pa, li));
#else
        for (int rep = 0; rep < REP_ACT; ++rep) PHASE(n_ffn_act(c, pa, li));
#endif
#endif
#if FAST & 2
        PHASE({ f_gemm_residual(c, (const bf16*)(c.ws + WS_ACT), DFF, (const bf16*)(c.ws + WS_WB + WB_WDN + li * SZ_WDN), DFF, li == 1); RETID(); f_tail_residual(c, (const bf16*)(c.ws + WS_ACT), DFF, (const bf16*)(c.ws + WS_WB + WB_WDN + li * SZ_WDN), DFF, li == 1);   });
#else
        PHASE(n_gemm_residual(c, (const bf16*)(c.ws + WS_ACT), DFF, pa.in[I_FWDN] + (size_t)li * DFF * D, DFF, true));
#endif
    }
    RETID(); n_final(c, pa);
#undef PHASE
}

extern "C" void kernel_launch(void* const* d_in, const int* in_sizes, int n_in, void* d_out, int out_size, void* d_ws, size_t ws_size, hipStream_t stream) {
    static int grid = 0;
    if (grid == 0) {
        if (n_in != N_IN || (size_t)out_size != O_END || ws_size < WS_END) {
            fprintf(stderr, "kernel_launch: unexpected shapes: n_in %d (want %d), out %d (want %zu), ws %zu (want >= %zu)\n", n_in, (int)N_IN, out_size, (size_t)O_END, ws_size, (size_t)WS_END);
            grid = -1; return; }
        int dev = 0, cus = 0;
        if (hipGetDevice(&dev) != hipSuccess || hipDeviceGetAttribute(&cus, hipDeviceAttributeMultiprocessorCount, dev) != hipSuccess) { grid = -1; return; }
        if (hipFuncSetAttribute((const void*)hybrid_fwd, hipFuncAttributeMaxDynamicSharedMemorySize, LDS_BYTES) != hipSuccess) { fprintf(stderr, "kernel_launch: hipFuncSetAttribute failed\n"); grid = -1; return; }
        int per_cu = 0;
        (void)hipOccupancyMaxActiveBlocksPerMultiprocessor(&per_cu, (const void*)hybrid_fwd, NT, LDS_BYTES);
        (void)hipGetLastError();
        grid = cus;
    }
    if (grid < 0) return;
    if (hipMemsetAsync((char*)d_ws + WS_CTL, 0, CTL_ZERO_BYTES, stream) != hipSuccess) return;
    Args a{};
    for (int i = 0; i < N_IN; ++i) a.in[i] = (const float*)d_in[i];
    a.out = (float*)d_out; a.ws = (unsigned char*)d_ws;
    hipLaunchKernelGGL(hybrid_fwd, dim3(grid), dim3(NT), LDS_BYTES, stream, a);
}
```
